# Optimizing an MI355X kernel written in HIP

```python
import math
import jax, jax.numpy as jnp
from jax import lax
import numpy as np

D_MODEL = 1024
BATCH = 4
SEQ = 4096
DEPTH = 2

D_MIX = D_MODEL
CONV_HEADS = 4
CONV_DIM = 256
CONV_WIDTH = 3
POOL_WINDOWS = (2, 4, 8, 16)
N_POOL_GROUPS = 4
POOL_GROUP = 64
POOL_DIM = N_POOL_GROUPS * POOL_GROUP
ATTN_HEADS = 8
HEAD_DIM = 64
ATTN_DIM = ATTN_HEADS * HEAD_DIM
IDX_HEADS = 8
IDX_DIM = 32
INDEX_TOPK_MAX = 256
Q_BLOCK = 128
IN_SPLITS = (CONV_DIM, CONV_DIM, CONV_DIM, POOL_DIM, ATTN_DIM, ATTN_DIM, ATTN_DIM,
             IDX_HEADS * IDX_DIM, IDX_DIM, IDX_HEADS)
D_IN = 3 * CONV_DIM + POOL_DIM + 3 * ATTN_DIM + IDX_HEADS * IDX_DIM + IDX_DIM + IDX_HEADS
V_COL_OFFSET = 3 * CONV_DIM + POOL_DIM + 2 * ATTN_DIM
N_EXPERTS = 32
TOP_K = 4
D_FF = D_MODEL
SWIGLU_ALPHA = 1.702
SWIGLU_LIMIT = 7.0
MOE_BLOCK = 128
LN_EPS = 1e-5
DN_ALPHA = (2.0 * DEPTH) ** 0.25
DN_BETA = (8.0 * DEPTH) ** -0.25

kernel_name = "hybrid_conv_pool_dsa_moe_deepnorm"


def layernorm(x, g, b):
    xf = x.astype(jnp.float32)
    mu = jnp.mean(xf, axis=-1, keepdims=True)
    var = jnp.mean(jnp.square(xf - mu), axis=-1, keepdims=True)
    return ((xf - mu) * lax.rsqrt(var + LN_EPS) * g + b).astype(x.dtype)


def short_gated_conv(h, gate_b, gate_c, conv_w):
    u = gate_c * h
    y = lax.conv_general_dilated(
        u, conv_w[:, None, :].astype(u.dtype), window_strides=(1,),
        padding=[(CONV_WIDTH - 1, 0)], dimension_numbers=("NWC", "WIO", "NWC"),
        feature_group_count=u.shape[-1])
    return gate_b * y


def multiscale_pool(p, w_pool, pool_scale):
    B, S, _ = p.shape
    pg = p.reshape(B, S, N_POOL_GROUPS, POOL_GROUP)
    pf = pg.astype(jnp.float32)
    cs = jnp.cumsum(pf, axis=1)
    t = jnp.arange(1, S + 1, dtype=jnp.float32)
    means = []
    for g, w in enumerate(POOL_WINDOWS):
        c = cs[:, :, g]
        prev = jnp.pad(c, ((0, 0), (w, 0), (0, 0)))[:, :S]
        cnt = jnp.minimum(t, float(w))[None, :, None]
        means.append((c - prev) / cnt)
    mixed = (jnp.stack(means, axis=2) - pf).astype(p.dtype)
    y = jnp.einsum("bsgc,gcd->bsgd", mixed, w_pool)
    return y.reshape(B, S, POOL_DIM) * pool_scale


def indexed_sparse_attention(q, k, v, q_idx, k_idx, w_idx):
    B, S, H, Dh = q.shape
    n_sel = min(INDEX_TOPK_MAX, S // 4)
    nb = S // Q_BLOCK
    slopes = 2.0 ** (-8.0 * jnp.arange(1, H + 1, dtype=jnp.float32) / H)
    k_idx32 = k_idx.astype(jnp.float32)
    key_pos = jnp.arange(S)
    idx_scale = (IDX_HEADS ** -0.5) * (IDX_DIM ** -0.5)

    def to_blocks(a):
        return jnp.moveaxis(a.reshape((B, nb, Q_BLOCK) + a.shape[2:]), 1, 0)

    def block(args):
        qb, qib, wib, tpos = args
        s = jnp.einsum("bqhd,bsd->bqsh", qib.astype(jnp.float32), k_idx32)
        score = jnp.einsum("bqsh,bqh->bqs", jax.nn.relu(s), wib.astype(jnp.float32) * idx_scale)
        causal = key_pos[None, :] <= tpos[:, None]
        score = jnp.where(causal[None], score, -jnp.inf)
        _, sel = lax.top_k(score, n_sel)
        k_sel = jax.vmap(lambda kb, ib: kb[ib])(k, sel)
        v_sel = jax.vmap(lambda vb, ib: vb[ib])(v, sel)
        logits = jnp.einsum("bqhd,bqkhd->bqhk", qb, k_sel).astype(jnp.float32) * (Dh ** -0.5)
        dist = (tpos[None, :, None] - sel).astype(jnp.float32)
        logits = logits - slopes[None, None, :, None] * dist[:, :, None, :]
        valid = sel <= tpos[None, :, None]
        logits = jnp.where(valid[:, :, None, :], logits, -jnp.inf)
        probs = jax.nn.softmax(logits, axis=-1).astype(v.dtype)
        return jnp.einsum("bqhk,bqkhd->bqhd", probs, v_sel)

    tpos_blocks = jnp.arange(S).reshape(nb, Q_BLOCK)
    out = lax.map(block, (to_blocks(q), to_blocks(q_idx), to_blocks(w_idx), tpos_blocks))
    return jnp.moveaxis(out, 0, 1).reshape(B, S, H * Dh)


def hybrid_mixer(x, w_in, conv_w, w_pool, pool_scale, idx_kn_g, idx_kn_b, w_out):
    B, S, _ = x.shape
    proj = jnp.einsum("bsd,dn->bsn", x, w_in)
    cuts = np.cumsum(IN_SPLITS)[:-1].tolist()
    h, gb, gc, p, q, k, v, qi, ki, wi = jnp.split(proj, cuts, axis=-1)
    y_conv = short_gated_conv(h, gb, gc, conv_w)
    y_pool = multiscale_pool(p, w_pool, pool_scale)
    ki = layernorm(ki, idx_kn_g, idx_kn_b)
    y_attn = indexed_sparse_attention(
        q.reshape(B, S, ATTN_HEADS, HEAD_DIM), k.reshape(B, S, ATTN_HEADS, HEAD_DIM),
        v.reshape(B, S, ATTN_HEADS, HEAD_DIM), qi.reshape(B, S, IDX_HEADS, IDX_DIM), ki, wi)
    cat = jnp.concatenate([y_conv, y_pool, y_attn], axis=-1)
    return jnp.einsum("bsm,md->bsd", cat, w_out)


def moe_ffn(x, router_w, router_b, w_gu, b_gu, w_down, b_down):
    B, S, D = x.shape
    T = B * S
    xt = x.reshape(T, D)
    logits = (xt @ router_w + router_b).astype(jnp.float32)
    top_val, top_idx = lax.top_k(logits, TOP_K)
    gates = jax.nn.softmax(top_val, axis=-1).astype(x.dtype)
    n = T * TOP_K
    flat_e = top_idx.reshape(n)
    order = jnp.argsort(flat_e)
    sorted_e = flat_e[order]
    counts = jnp.bincount(flat_e, length=N_EXPERTS)
    starts = jnp.cumsum(counts) - counts
    padded = (counts + MOE_BLOCK - 1) // MOE_BLOCK * MOE_BLOCK
    pad_ends = jnp.cumsum(padded)
    pad_starts = pad_ends - padded
    dest_sorted = pad_starts[sorted_e] + jnp.arange(n) - starts[sorted_e]
    dest = jnp.zeros((n,), jnp.int32).at[order].set(dest_sorted.astype(jnp.int32))
    n_rows = (n + MOE_BLOCK - 1) // MOE_BLOCK * MOE_BLOCK + N_EXPERTS * MOE_BLOCK
    n_blocks = n_rows // MOE_BLOCK
    row_token = jnp.zeros((n_rows,), jnp.int32).at[dest].set(
        jnp.arange(n, dtype=jnp.int32) // TOP_K)
    block_expert = jnp.clip(
        jnp.searchsorted(pad_ends, jnp.arange(n_blocks) * MOE_BLOCK, side="right"),
        0, N_EXPERTS - 1)
    xs = xt[row_token].reshape(n_blocks, MOE_BLOCK, D)

    def expert_block(args):
        xb, e = args
        hcat = xb @ w_gu[e] + b_gu[e]
        gate, up = jnp.split(hcat, 2, axis=-1)
        gate = jnp.minimum(gate, SWIGLU_LIMIT)
        up = jnp.clip(up, -SWIGLU_LIMIT, SWIGLU_LIMIT)
        act = gate * jax.nn.sigmoid(SWIGLU_ALPHA * gate) * (up + 1.0)
        return act @ w_down[e] + b_down[e]

    ys = lax.map(expert_block, (xs, block_expert)).reshape(n_rows, D)
    y = ys[dest].reshape(T, TOP_K, D)
    return jnp.einsum("tk,tkd->td", gates, y).reshape(B, S, D)


def setup_inputs(seed: int = 0) -> dict:
    key = jax.random.key(seed)
    ks = jax.random.split(key, 20)
    f32 = jnp.float32

    def nrm(k, shape, scale):
        return jax.random.normal(k, shape, f32) * scale

    x = nrm(ks[0], (BATCH, SEQ, D_MODEL), 1.0)
    col_scale = jnp.ones((D_IN,), f32).at[V_COL_OFFSET:V_COL_OFFSET + ATTN_DIM].set(DN_BETA)
    w_in = nrm(ks[1], (DEPTH, D_MODEL, D_IN), D_MODEL ** -0.5) * col_scale
    conv_w = nrm(ks[2], (DEPTH, CONV_WIDTH, CONV_DIM), CONV_WIDTH ** -0.5)
    w_pool = nrm(ks[3], (DEPTH, N_POOL_GROUPS, POOL_GROUP, POOL_GROUP), POOL_GROUP ** -0.5)
    pool_scale = 1.0 + nrm(ks[4], (DEPTH, POOL_DIM), 0.02)
    idx_kn_g = 1.0 + nrm(ks[5], (DEPTH, IDX_DIM), 0.02)
    idx_kn_b = nrm(ks[6], (DEPTH, IDX_DIM), 0.02)
    w_out = nrm(ks[7], (DEPTH, D_MIX, D_MODEL), D_MIX ** -0.5) * DN_BETA
    ln1_g = 1.0 + nrm(ks[8], (DEPTH, D_MODEL), 0.02)
    ln1_b = nrm(ks[9], (DEPTH, D_MODEL), 0.02)
    router_w = nrm(ks[10], (DEPTH, D_MODEL, N_EXPERTS), D_MODEL ** -0.5)
    router_b = nrm(ks[11], (DEPTH, N_EXPERTS), 0.01)
    w_gu = nrm(ks[12], (DEPTH, N_EXPERTS, D_MODEL, 2 * D_FF), D_MODEL ** -0.5)
    b_gu = nrm(ks[13], (DEPTH, N_EXPERTS, 2 * D_FF), 0.01)
    w_down = nrm(ks[14], (DEPTH, N_EXPERTS, D_FF, D_MODEL), D_FF ** -0.5) * DN_BETA
    b_down = nrm(ks[15], (DEPTH, N_EXPERTS, D_MODEL), 0.01)
    ln2_g = 1.0 + nrm(ks[16], (DEPTH, D_MODEL), 0.02)
    ln2_b = nrm(ks[17], (DEPTH, D_MODEL), 0.02)
    return {"x": x, "w_in": w_in, "conv_w": conv_w, "w_pool": w_pool,
            "pool_scale": pool_scale, "idx_kn_g": idx_kn_g, "idx_kn_b": idx_kn_b,
            "w_out": w_out, "ln1_g": ln1_g, "ln1_b": ln1_b, "router_w": router_w,
            "router_b": router_b, "w_gu": w_gu, "b_gu": b_gu, "w_down": w_down,
            "b_down": b_down, "ln2_g": ln2_g, "ln2_b": ln2_b}


def reference(x, w_in, conv_w, w_pool, pool_scale, idx_kn_g, idx_kn_b, w_out,
              ln1_g, ln1_b, router_w, router_b, w_gu, b_gu, w_down, b_down,
              ln2_g, ln2_b):
    for l in range(DEPTH):
        mix = hybrid_mixer(x, w_in[l], conv_w[l], w_pool[l], pool_scale[l],
                           idx_kn_g[l], idx_kn_b[l], w_out[l])
        x = layernorm(DN_ALPHA * x + mix, ln1_g[l], ln1_b[l])
        ffn = moe_ffn(x, router_w[l], router_b[l], w_gu[l], b_gu[l], w_down[l], b_down[l])
        x = layernorm(DN_ALPHA * x + ffn, ln2_g[l], ln2_b[l])
    return x
```

```cpp
#include <hip/hip_runtime.h>
#include <cstdio>
#include <cstdint>

namespace pg8 {
#define PG8_LAS __attribute__((address_space(3)))
typedef unsigned short bf16_t;
typedef short bf16x8 __attribute__((ext_vector_type(8)));
typedef float f32x4 __attribute__((ext_vector_type(4)));
typedef unsigned u32x4 __attribute__((ext_vector_type(4)));
constexpr int BM = 256, BK = 64, HALF = 128, HTB = HALF * BK * 2  , STAGE_BYTES = 8 * HTB, NXCD = 8, WGM = 8;

__host__ __device__ __forceinline__ int lds_byte(int r, int c) { const int st = (r >> 4) * 2 + (c >> 5), rr = r & 15, cc = c & 31, ob = rr * 64 + cc * 2; return st * 1024 + (ob ^ (((ob >> 9) & 1) << 5)); }
__host__ __device__ __forceinline__ void stage_rc(int b, int& R, int& C) { const int st = b / 1024, sb = b % 1024, swz = sb ^ (((sb >> 9) & 1) << 5); R = (st >> 1) * 16 + swz / 64; C = (st & 1) * 32 + (swz % 64) / 2; }
__host__ __device__ __forceinline__ int perm32(int rho) { const int n = rho >> 4, i = rho & 15; return 8 * (i >> 2) + 4 * n + (i & 3); }

struct Unit { int pm, pn; };
struct Gemm { const bf16_t* A; const bf16_t* Bt; int M, N, K; };

struct StaticOrder {
    int nM, nN, nwg, G, c;
    __host__ __device__ void init(int M, int N, int G_, int c_) { nM = M / BM; nN = N / BM; nwg = nM * nN; G = G_; c = c_; }
    __host__ __device__ bool next(int i, Unit& u) const {
        const long L = (long)i * G + c; if (L >= nwg) return false;
        int wgid = (int)L; { const int q = nwg / NXCD, r = nwg % NXCD, xcd = wgid % NXCD, off = wgid / NXCD; wgid = (xcd < r ? xcd * (q + 1) : r * (q + 1) + (xcd - r) * q) + off; }
        const int nig = WGM * nN, gid = wgid / nig, fm = gid * WGM, gsz = (nM - fm) < WGM ? (nM - fm) : WGM;
        u.pm = fm + ((wgid % nig) % gsz); u.pn = (wgid % nig) / gsz; return true;
    }
    __device__ __forceinline__ void a_ready(const Unit&) const {}
    __device__ __forceinline__ void done(const Unit&) const {}
};

__device__ __forceinline__ unsigned cvt_pk_bf16(float lo, float hi) { unsigned r; asm volatile("v_cvt_pk_bf16_f32 %0, %1, %2" : "=v"(r) : "v"(lo), "v"(hi)); return r; }
typedef float f32x2 __attribute__((ext_vector_type(2)));
__device__ __forceinline__ f32x2 gelu_pk(f32x2 v) {
    const f32x2 av = __builtin_elementwise_abs(v), d = av * 0.2316418882f + 1.0f;
    f32x2 t; t.x = __builtin_amdgcn_rcpf(d.x); t.y = __builtin_amdgcn_rcpf(d.y);
    f32x2 q = t * 0.5307027145f + (-0.7265760135f); q = q * t + 0.7107068705f; q = q * t + (-0.142248368f); q = q * t + 0.127414796f; q = q * t;
    const f32x2 s = (v * v) * (-0.72134752044f);
    f32x2 e; e.x = __builtin_amdgcn_exp2f(s.x); e.y = __builtin_amdgcn_exp2f(s.y);
    const f32x2 m = v * (q * e), r = v - m;
    f32x2 o; o.x = v.x < 0.f ? m.x : r.x; o.y = v.y < 0.f ? m.y : r.y; return o;
}

template <int ACT  > struct EpiBf16 {
    static constexpr bool PERM = true, AFTER_DRAIN = false; static_assert(ACT == 0 || ACT == 1, "EpiBf16: ACT is 0 (none) or 1 (gelu_pk)");
    bf16_t* O; int ldc; const float* bias; int split_cols; size_t split_stride; float scale0;
    __device__ __forceinline__ void operator()(const f32x4 (&acc)[2][2][4][2], const Unit& u, int wr, int wc, int fr, int fq) const {
        const int row0 = u.pm * BM + wr * 64 + fr; int colt = u.pn * BM; bf16_t* base = O;
        float sc = 1.f; if (split_cols) { const int t = colt / split_cols; base += (size_t)t * split_stride; colt -= t * split_cols; if (t == 0) sc = scale0; }
        const int col0 = colt + wc * 32 + 8 * fq, bcol0 = u.pn * BM + wc * 32 + 8 * fq;
        f32x4 bv[2][2];
#pragma unroll
        for (int bj = 0; bj < 2; ++bj)
#pragma unroll
            for (int n = 0; n < 2; ++n) bv[bj][n] = bias ? *(const f32x4*)(bias + bcol0 + bj * HALF + 4 * n) : (f32x4){0.f, 0.f, 0.f, 0.f};
#pragma unroll
        for (int ai = 0; ai < 2; ++ai)
#pragma unroll
            for (int m = 0; m < 4; ++m) { bf16_t* rowp = base + (size_t)(row0 + ai * HALF + m * 16) * ldc + col0;
#pragma unroll
                for (int bj = 0; bj < 2; ++bj) { f32x4 v0 = acc[ai][bj][m][0] + bv[bj][0], v1 = acc[ai][bj][m][1] + bv[bj][1];
                    if (ACT == 1) { f32x2 a = gelu_pk((f32x2){v0[0], v0[1]}), b = gelu_pk((f32x2){v0[2], v0[3]}), c = gelu_pk((f32x2){v1[0], v1[1]}), d = gelu_pk((f32x2){v1[2], v1[3]});
                        v0 = (f32x4){a.x, a.y, b.x, b.y}; v1 = (f32x4){c.x, c.y, d.x, d.y}; }
                    v0 = v0 * sc; v1 = v1 * sc; u32x4 w; w.x = cvt_pk_bf16(v0[0], v0[1]); w.y = cvt_pk_bf16(v0[2], v0[3]); w.z = cvt_pk_bf16(v1[0], v1[1]); w.w = cvt_pk_bf16(v1[2], v1[3]);
                    *(u32x4*)(rowp + bj * HALF) = w; } }
    }
};

struct PanelStats {
    unsigned* xbuf;
    unsigned* cnt;
    unsigned* tmo;
    int ntn; float eps;
    unsigned code;
    __device__ __forceinline__ bool run(const f32x4 (&v)[2][2][4][2], const Unit& u, int wr, int wc, int fr, int fq, PG8_LAS unsigned char* lds, int wid, int lane) const {
        typedef float f32x2v __attribute__((ext_vector_type(2)));
        PG8_LAS f32x2v* P = (PG8_LAS f32x2v*)lds;
        PG8_LAS f32x2v* S = (PG8_LAS f32x2v*)(lds + 8192);
        PG8_LAS unsigned* flag = (PG8_LAS unsigned*)(lds + 8192 + 2048);
#pragma unroll
        for (int ai = 0; ai < 2; ++ai)
#pragma unroll
            for (int m = 0; m < 4; ++m) {
                float s = 0.f;
#pragma unroll
                for (int bj = 0; bj < 2; ++bj)
#pragma unroll
                    for (int n = 0; n < 2; ++n) { const f32x4 x = v[ai][bj][m][n]; s += (x[0] + x[1]) + (x[2] + x[3]); }
                s += __shfl_xor(s, 16); s += __shfl_xor(s, 32);
                const float mw = s * (1.0f / 64.0f); float q = 0.f;
#pragma unroll
                for (int bj = 0; bj < 2; ++bj)
#pragma unroll
                    for (int n = 0; n < 2; ++n) { const f32x4 d = v[ai][bj][m][n] - mw; q += (d[0] * d[0] + d[1] * d[1]) + (d[2] * d[2] + d[3] * d[3]); }
                q += __shfl_xor(q, 16); q += __shfl_xor(q, 32);
                if (fq == 0) P[(ai * HALF + wr * 64 + m * 16 + fr) * 4 + wc] = (f32x2v){mw, q};
            }
        asm volatile("s_waitcnt lgkmcnt(0)" ::: "memory"); __builtin_amdgcn_s_barrier(); asm volatile("" ::: "memory");
#if defined(BROKEN_EXCHANGE_NO_WAIT)
#warning BROKEN CONTROL BUILD: the row-statistics exchange does not wait; results are wrong by design
        if (blockIdx.x >= 64) { const long long t0_ = clock64(); while (clock64() - t0_ < 60000) __builtin_amdgcn_s_sleep(8); }
#endif
        const int row = wid * 32 + (lane & 31);
        if (lane < 32) {
            const f32x2v a = P[row * 4 + 0], b = P[row * 4 + 1], c = P[row * 4 + 2], d = P[row * 4 + 3];
            const float mt = (a.x + b.x + c.x + d.x) * 0.25f;
            const float da = a.x - mt, db = b.x - mt, dc = c.x - mt, dd = d.x - mt;
            const float m2 = (a.y + b.y) + (c.y + d.y) + 64.0f * ((da * da + db * db) + (dc * dc + dd * dd));
            unsigned long long* slot = (unsigned long long*)xbuf + ((size_t)(u.pm * BM + row) * 4 + u.pn);
            __hip_atomic_store(slot, ((unsigned long long)__float_as_uint(m2) << 32) | __float_as_uint(mt), __ATOMIC_RELAXED, __HIP_MEMORY_SCOPE_AGENT);
        }
        asm volatile("s_waitcnt vmcnt(0)" ::: "memory");
        if (lane == 0) __hip_atomic_fetch_add(cnt + 64 * u.pm, 1u, __ATOMIC_RELAXED, __HIP_MEMORY_SCOPE_AGENT);
        if (wid == 0) {
            bool dead = false; const unsigned long long t0 = __builtin_amdgcn_s_memrealtime(); const unsigned want = 8u * (unsigned)ntn;
            for (;;) {
#if defined(BROKEN_EXCHANGE_NO_WAIT)
                break;
#endif
                if ((unsigned)__builtin_amdgcn_readfirstlane(__hip_atomic_load(cnt + 64 * u.pm, __ATOMIC_RELAXED, __HIP_MEMORY_SCOPE_AGENT)) >= want) break;
                if (__builtin_amdgcn_s_memrealtime() - t0 > 2000000ull) {
                    if (lane == 0) { unsigned expect = 0u; __hip_atomic_compare_exchange_strong(tmo + 1, &expect, code | (unsigned)(u.pm & 0xff), __ATOMIC_RELAXED, __ATOMIC_RELAXED, __HIP_MEMORY_SCOPE_AGENT);
                                     __hip_atomic_store(tmo, 1u, __ATOMIC_RELAXED, __HIP_MEMORY_SCOPE_AGENT); }
                    dead = true; break; }
                __builtin_amdgcn_s_sleep(2);
            }
            __builtin_amdgcn_fence(__ATOMIC_ACQUIRE, "agent");
            if (lane == 0) flag[0] = dead ? 1u : 0u;
        }
        asm volatile("s_waitcnt vmcnt(0) lgkmcnt(0)" ::: "memory"); __builtin_amdgcn_s_barrier(); asm volatile("" ::: "memory");
        const bool bad = flag[0] != 0u;
        if (lane < 32) {
            const unsigned long long* slot = (const unsigned long long*)xbuf + (size_t)(u.pm * BM + row) * 4; float mt[4], m2[4]; float ms = 0.f;
#pragma unroll
            for (int t = 0; t < 4; ++t) { if (t < ntn) { const unsigned long long w = __hip_atomic_load(slot + t, __ATOMIC_RELAXED, __HIP_MEMORY_SCOPE_AGENT); mt[t] = __uint_as_float((unsigned)w); m2[t] = __uint_as_float((unsigned)(w >> 32)); } else { mt[t] = 0.f; m2[t] = 0.f; } ms += mt[t]; }
            const float mean = ms / (float)ntn; float q = 0.f;
#pragma unroll
            for (int t = 0; t < 4; ++t) if (t < ntn) { const float dm = mt[t] - mean; q += m2[t] + 256.0f * dm * dm; }
            S[row] = (f32x2v){mean, 1.0f / sqrtf(q / (256.0f * (float)ntn) + eps)};
        }
        asm volatile("s_waitcnt lgkmcnt(0)" ::: "memory"); __builtin_amdgcn_s_barrier(); asm volatile("" ::: "memory");
        return bad;
    }
};
struct EpiLnRes {
    static constexpr bool PERM = false, AFTER_DRAIN = true;
    const float* base; float* out; int ldc; const float* bias; PanelStats st; unsigned poison;
    __device__ __forceinline__ void fused(f32x4 (&acc)[2][2][4][2], const Unit& u, int wr, int wc, int fr, int fq, PG8_LAS unsigned char* lds, int wid, int lane) const {
        typedef float f32x2v __attribute__((ext_vector_type(2)));
        const PG8_LAS f32x2v* S = (const PG8_LAS f32x2v*)(lds + 8192);
        const int col0 = u.pn * BM + wc * 32 + 4 * fq;
#pragma unroll
        for (int bj = 0; bj < 2; ++bj)
#pragma unroll
            for (int n = 0; n < 2; ++n) { const f32x4 bv = bias ? *(const f32x4*)(bias + col0 + bj * HALF + n * 16) : (f32x4){0.f, 0.f, 0.f, 0.f};
#pragma unroll
                for (int ai = 0; ai < 2; ++ai)
#pragma unroll
                    for (int m = 0; m < 4; ++m) acc[ai][bj][m][n] += bv; }
        f32x4 pre[4][2][2];
#pragma unroll
        for (int m = 0; m < 4; ++m) { const size_t off = (size_t)(u.pm * BM + wr * 64 + m * 16 + fr) * ldc + col0;
#pragma unroll
            for (int bj = 0; bj < 2; ++bj)
#pragma unroll
                for (int n = 0; n < 2; ++n) pre[m][bj][n] = *(const f32x4*)(base + off + bj * HALF + n * 16); }
        const bool bad = st.run(acc, u, wr, wc, fr, fq, lds, wid, lane) || poison != 0u;
        const float qnan = __builtin_nanf("");
#pragma unroll
        for (int ai = 0; ai < 2; ++ai)
#pragma unroll
            for (int m = 0; m < 4; ++m) { const int r = ai * HALF + wr * 64 + m * 16 + fr; const f32x2v sr = S[r]; const size_t off = (size_t)(u.pm * BM + r) * ldc + col0;
#pragma unroll
                for (int bj = 0; bj < 2; ++bj)
#pragma unroll
                    for (int n = 0; n < 2; ++n) { const f32x4 bs = ai == 0 ? pre[m][bj][n] : *(const f32x4*)(base + off + bj * HALF + n * 16); f32x4 o = bs + (acc[ai][bj][m][n] - sr.x) * sr.y;
                        if (bad) o = (f32x4){qnan, qnan, qnan, qnan}; *(f32x4*)(out + off + bj * HALF + n * 16) = o; }
                if (m & 1) asm volatile("" ::: "memory"); }
    }
};
struct EpiLnResLn {
    static constexpr bool PERM = false, AFTER_DRAIN = true;
    const float* base; float* out; bf16_t* xn; int ldc; const float* bias; PanelStats st1, st2; unsigned poison;
    __device__ __forceinline__ void fused(f32x4 (&acc)[2][2][4][2], const Unit& u, int wr, int wc, int fr, int fq, PG8_LAS unsigned char* lds, int wid, int lane) const {
        typedef float f32x2v __attribute__((ext_vector_type(2))); typedef unsigned u32x2v __attribute__((ext_vector_type(2)));
        const PG8_LAS f32x2v* S = (const PG8_LAS f32x2v*)(lds + 8192);
        const int col0 = u.pn * BM + wc * 32 + 4 * fq;
#pragma unroll
        for (int bj = 0; bj < 2; ++bj)
#pragma unroll
            for (int n = 0; n < 2; ++n) { const f32x4 bv = bias ? *(const f32x4*)(bias + col0 + bj * HALF + n * 16) : (f32x4){0.f, 0.f, 0.f, 0.f};
#pragma unroll
                for (int ai = 0; ai < 2; ++ai)
#pragma unroll
                    for (int m = 0; m < 4; ++m) acc[ai][bj][m][n] += bv; }
        bool bad = st1.run(acc, u, wr, wc, fr, fq, lds, wid, lane) || poison != 0u;
        const float qnan = __builtin_nanf("");
#pragma unroll
        for (int ai = 0; ai < 2; ++ai)
#pragma unroll
            for (int m = 0; m < 4; ++m) { const int r = ai * HALF + wr * 64 + m * 16 + fr; const f32x2v sr = S[r]; const size_t off = (size_t)(u.pm * BM + r) * ldc + col0;
#pragma unroll
                for (int bj = 0; bj < 2; ++bj)
#pragma unroll
                    for (int n = 0; n < 2; ++n) { const f32x4 bs = *(const f32x4*)(base + off + bj * HALF + n * 16); acc[ai][bj][m][n] = bs + (acc[ai][bj][m][n] - sr.x) * sr.y; }
                asm volatile("" : "+v"(acc[ai][0][m][0]), "+v"(acc[ai][0][m][1]), "+v"(acc[ai][1][m][0]), "+v"(acc[ai][1][m][1]));
                if (m & 1) asm volatile("" ::: "memory"); }
        const bool bad1 = bad;
        bad = st2.run(acc, u, wr, wc, fr, fq, lds, wid, lane) || bad;
#pragma unroll
        for (int ai = 0; ai < 2; ++ai)
#pragma unroll
            for (int m = 0; m < 4; ++m) { const int r = ai * HALF + wr * 64 + m * 16 + fr; const f32x2v sr = S[r]; const size_t off = (size_t)(u.pm * BM + r) * ldc + col0;
#pragma unroll
                for (int bj = 0; bj < 2; ++bj)
#pragma unroll
                    for (int n = 0; n < 2; ++n) { const f32x4 x1 = acc[ai][bj][m][n]; *(f32x4*)(out + off + bj * HALF + n * 16) = bad1 ? (f32x4){qnan, qnan, qnan, qnan} : x1;
                        const f32x4 o = (x1 - sr.x) * sr.y; u32x2v w; w.x = cvt_pk_bf16(o[0], o[1]); w.y = cvt_pk_bf16(o[2], o[3]);
                        if (bad) { w.x = 0x7fc07fc0u; w.y = 0x7fc07fc0u; } *(u32x2v*)(xn + off + bj * HALF + n * 16) = w; }
                asm volatile("" ::: "memory"); }
    }
};

template <class Epi, class Sched, bool ALIGN_EPI = false, bool SP2 = false>
__device__ __forceinline__ void gemm_phase(PG8_LAS unsigned char* lds, const Gemm g, const Sched& S, const Epi& E) {
    const int tid = threadIdx.x, wid = __builtin_amdgcn_readfirstlane(tid >> 6), lane = tid & 63, wr = wid >> 2, wc = wid & 3, fr = lane & 15, fq = lane >> 4;
    const int K = g.K, nt = K / BK;
    unsigned voffA[2], voffB[2];
#pragma unroll
    for (int i = 0; i < 2; ++i) { int R, C; stage_rc(tid * 16 + i * 8192, R, C); const int Rb = Epi::PERM ? ((R & ~31) + perm32(R & 31)) : R;
        voffA[i] = (unsigned)(R * K + C) * 2u; voffB[i] = (unsigned)(Rb * K + C) * 2u; }
    const size_t kstep = (size_t)(BK * 2);
    const size_t hstep = (size_t)HALF * K * 2;
    const size_t tstep = 2 * hstep;
    const unsigned ldsw = (unsigned)wid * 1024u;
    const int aoff = lds_byte(wr * 64 + fr, fq * 8), boff = lds_byte(wc * 32 + fr, fq * 8);
#define PG8_SA(b, h) (((b) * 2 + (h)) * HTB)
#define PG8_SB(b, h) ((4 + (b) * 2 + (h)) * HTB)
#define PG8_STAGE(bufoff, gbase, voff) do { _Pragma("unroll") for (int _i = 0; _i < 2; ++_i) \
        __builtin_amdgcn_global_load_lds((const unsigned*)((const char*)(gbase) + (voff)[_i]), (PG8_LAS unsigned*)(lds + (bufoff) + ldsw + _i * 8192), 16, 0, 0); } while (0)
#define PG8_LDA(dst, b, h) do { _Pragma("unroll") for (int m = 0; m < 4; ++m) _Pragma("unroll") for (int k = 0; k < 2; ++k) dst[m][k] = *(const PG8_LAS bf16x8*)(lds + PG8_SA(b, h) + aoff + m * 2048 + k * 1024); } while (0)
#define PG8_LDB(dst, b, h) do { _Pragma("unroll") for (int n = 0; n < 2; ++n) _Pragma("unroll") for (int k = 0; k < 2; ++k) dst[n][k] = *(const PG8_LAS bf16x8*)(lds + PG8_SB(b, h) + boff + n * 2048 + k * 1024); } while (0)
#define PG8_MMA(ai, bj, At, Bt) do { __builtin_amdgcn_s_setprio(1); _Pragma("unroll") for (int m = 0; m < 4; ++m) _Pragma("unroll") for (int n = 0; n < 2; ++n) _Pragma("unroll") for (int k = 0; k < 2; ++k) \
        acc[ai][bj][m][n] = __builtin_amdgcn_mfma_f32_16x16x32_bf16(Bt[n][k], At[m][k], acc[ai][bj][m][n], 0, 0, 0); __builtin_amdgcn_s_setprio(0); } while (0)
#define PG8_WAIT_V(n) asm volatile("s_waitcnt vmcnt(" #n ")" ::: "memory")
#define PG8_WAIT_L(n) asm volatile("s_waitcnt lgkmcnt(" #n ")" ::: "memory")
#define PG8_BAR __builtin_amdgcn_s_barrier()
#define PG8_SCHED __builtin_amdgcn_sched_barrier(0)
    Unit cur, nxt; int ui = 0;
    if (!S.next(0, cur)) return;
    f32x4 acc[2][2][4][2];
#pragma unroll
    for (int a = 0; a < 2; ++a)
#pragma unroll
        for (int b = 0; b < 2; ++b)
#pragma unroll
            for (int m = 0; m < 4; ++m)
#pragma unroll
                for (int n = 0; n < 2; ++n) acc[a][b][m][n] = (f32x4){0.f, 0.f, 0.f, 0.f};
    bf16x8 At[4][2], B0[2][2], B1[2][2];
    const char* cA = (const char*)g.A + (size_t)cur.pm * tstep; const char* cB = (const char*)g.Bt + (size_t)cur.pn * tstep;
    S.a_ready(cur);
    if constexpr (SP2) {
        PG8_STAGE(PG8_SB(0, 0), cB, voffB); PG8_STAGE(PG8_SB(0, 1), cB + hstep, voffB); PG8_STAGE(PG8_SA(0, 0), cA, voffA); PG8_STAGE(PG8_SA(0, 1), cA + hstep, voffA);
        if (wr == 1) PG8_BAR;
        PG8_WAIT_V(2); PG8_BAR;
        PG8_STAGE(PG8_SB(1, 0), cB + kstep, voffB); PG8_STAGE(PG8_SA(1, 0), cA + kstep, voffA); PG8_STAGE(PG8_SB(1, 1), cB + hstep + kstep, voffB);
        PG8_WAIT_V(6); PG8_BAR;
    } else {
        PG8_STAGE(PG8_SB(0, 0), cB, voffB); PG8_STAGE(PG8_SA(0, 0), cA, voffA); PG8_STAGE(PG8_SB(0, 1), cB + hstep, voffB); PG8_STAGE(PG8_SA(0, 1), cA + hstep, voffA);
        if (wr == 1) PG8_BAR;
        PG8_WAIT_V(4); PG8_BAR;
        PG8_STAGE(PG8_SB(1, 0), cB + kstep, voffB); PG8_STAGE(PG8_SA(1, 0), cA + kstep, voffA); PG8_STAGE(PG8_SB(1, 1), cB + hstep + kstep, voffB);
        PG8_WAIT_V(6); PG8_BAR;
    }
    for (;;) {
        const bool has_next = S.next(ui + 1, nxt);
        const char* nA = has_next ? (const char*)g.A + (size_t)nxt.pm * tstep : cA; const char* nB = has_next ? (const char*)g.Bt + (size_t)nxt.pn * tstep : cB;
        for (int t = 0; t < nt; t += 2) {
            const bool last = (t == nt - 2);
            const char* a1 = cA + (size_t)(t + 1) * kstep;
            const char* a2 = last ? nA : cA + (size_t)(t + 2) * kstep; const char* b2 = last ? nB : cB + (size_t)(t + 2) * kstep;
            const char* a3 = a2 + kstep; const char* b3 = b2 + kstep;
            if (last && has_next) S.a_ready(nxt);
            if constexpr (SP2) {
            PG8_LDB(B0, 0, 0); PG8_LDB(B1, 0, 1); PG8_SCHED; PG8_LDA(At, 0, 0); PG8_STAGE(PG8_SA(1, 1), a1 + hstep, voffA);
            PG8_WAIT_V(8); PG8_WAIT_L(0); PG8_BAR; PG8_MMA(0, 0, At, B0); PG8_MMA(0, 1, At, B1); PG8_BAR; PG8_SCHED;
            PG8_LDA(At, 0, 1); PG8_STAGE(PG8_SB(0, 0), b2, voffB); PG8_STAGE(PG8_SB(0, 1), b2 + hstep, voffB); PG8_STAGE(PG8_SA(0, 0), a2, voffA);
            PG8_WAIT_V(8); PG8_WAIT_L(0); PG8_BAR; PG8_MMA(1, 0, At, B0); PG8_MMA(1, 1, At, B1); PG8_BAR; PG8_SCHED;
            PG8_LDB(B0, 1, 0); PG8_LDB(B1, 1, 1); PG8_SCHED; PG8_LDA(At, 1, 0); PG8_STAGE(PG8_SA(0, 1), a2 + hstep, voffA);
            PG8_WAIT_V(8); PG8_WAIT_L(0); PG8_BAR; PG8_MMA(0, 0, At, B0); PG8_MMA(0, 1, At, B1); PG8_BAR; PG8_SCHED;
            PG8_LDA(At, 1, 1); PG8_STAGE(PG8_SB(1, 0), b3, voffB); PG8_STAGE(PG8_SB(1, 1), b3 + hstep, voffB); PG8_STAGE(PG8_SA(1, 0), a3, voffA);
            PG8_WAIT_V(8); PG8_WAIT_L(0); PG8_BAR; PG8_MMA(1, 0, At, B0); PG8_MMA(1, 1, At, B1); PG8_BAR; PG8_SCHED;
            } else {
            PG8_LDB(B0, 0, 0); PG8_SCHED; PG8_LDA(At, 0, 0); PG8_STAGE(PG8_SA(1, 1), a1 + hstep, voffA);
            PG8_WAIT_L(8); PG8_BAR; PG8_WAIT_L(0); PG8_MMA(0, 0, At, B0); PG8_BAR; PG8_SCHED;
            PG8_LDB(B1, 0, 1); PG8_STAGE(PG8_SB(0, 0), b2, voffB);
            PG8_BAR; PG8_WAIT_L(0); PG8_MMA(0, 1, At, B1); PG8_BAR;
            PG8_LDA(At, 0, 1); PG8_STAGE(PG8_SA(0, 0), a2, voffA);
            PG8_BAR; PG8_WAIT_L(0); PG8_MMA(1, 0, At, B0); PG8_BAR; PG8_SCHED;
            PG8_STAGE(PG8_SB(0, 1), b2 + hstep, voffB);
            PG8_WAIT_V(6); PG8_BAR; PG8_MMA(1, 1, At, B1); PG8_BAR;
            PG8_LDB(B0, 1, 0); PG8_SCHED; PG8_LDA(At, 1, 0); PG8_STAGE(PG8_SA(0, 1), a2 + hstep, voffA);
            PG8_WAIT_L(8); PG8_BAR; PG8_WAIT_L(0); PG8_MMA(0, 0, At, B0); PG8_BAR; PG8_SCHED;
            PG8_LDB(B1, 1, 1); PG8_STAGE(PG8_SB(1, 0), b3, voffB);
            PG8_BAR; PG8_WAIT_L(0); PG8_MMA(0, 1, At, B1); PG8_BAR;
            PG8_LDA(At, 1, 1); PG8_STAGE(PG8_SA(1, 0), a3, voffA);
            PG8_BAR; PG8_WAIT_L(0); PG8_MMA(1, 0, At, B0); PG8_BAR; PG8_SCHED;
            PG8_STAGE(PG8_SB(1, 1), b3 + hstep, voffB);
            PG8_WAIT_V(6); PG8_BAR; PG8_MMA(1, 1, At, B1); PG8_BAR;
            }
        }
        if constexpr (ALIGN_EPI) { if (wr == 0) PG8_BAR; }
        if constexpr (!Epi::AFTER_DRAIN) { E(acc, cur, wr, wc, fr, fq); S.done(cur); }
        if (!has_next) break;
#pragma unroll
        for (int a = 0; a < 2; ++a)
#pragma unroll
            for (int b = 0; b < 2; ++b)
#pragma unroll
                for (int m = 0; m < 4; ++m)
#pragma unroll
                    for (int n = 0; n < 2; ++n) acc[a][b][m][n] = (f32x4){0.f, 0.f, 0.f, 0.f};
        cur = nxt; cA = nA; cB = nB; ++ui;
        if constexpr (ALIGN_EPI) { if (wr == 1) PG8_BAR; }
    }
    PG8_WAIT_V(0);
    if constexpr (!ALIGN_EPI) { if (wr == 0) PG8_BAR; }
    PG8_BAR;
    if constexpr (Epi::AFTER_DRAIN) { E.fused(acc, cur, wr, wc, fr, fq, lds, wid, lane); S.done(cur); }
#undef PG8_SA
#undef PG8_SB
#undef PG8_STAGE
#undef PG8_LDA
#undef PG8_LDB
#undef PG8_MMA
#undef PG8_WAIT_V
#undef PG8_WAIT_L
#undef PG8_BAR
#undef PG8_SCHED
}
}
#ifndef PG8_SP2
#define PG8_SP2 true
#endif
#ifndef PG8_ALIGN
#define PG8_ALIGN true
#endif
constexpr int NWAVES = 8;
constexpr int NB = 4, SEQ = 4096, T = NB * SEQ, D = 1024, NIN = 2856, NINP = 3072, NE = 32, DEPTH = 2;
constexpr int C_H = 0, C_GB = 256, C_GC = 512, C_P = 768, C_Q = 1024, C_K = 1536, C_V = 2048, C_QI = 2560, C_KI = 2816, C_WI = 2848;
constexpr int NSEL = 256;
constexpr int MAXROWS = 4 * T + NE * 256;
constexpr float ATT_C2 = 0.125f * 1.4426950408889634f;
constexpr float LN_EPS = 1e-5f, DN_ALPHA = 1.41421356237309515f;
enum { IN_X = 0, IN_WIN, IN_CONVW, IN_WPOOL, IN_PSCALE, IN_KNG, IN_KNB, IN_WOUT, IN_LN1G, IN_LN1B, IN_RW, IN_RB, IN_WGU, IN_BGU, IN_WDN, IN_BDN, IN_LN2G, IN_LN2B, N_IN };

constexpr size_t MiB = 1u << 20;
constexpr size_t WS_CTL = 0, CTL_ZERO_BYTES = 1 * MiB;
constexpr size_t WS_WIN = 2 * MiB;
constexpr size_t WS_WOUT = 14 * MiB;
constexpr size_t WS_WGU = 18 * MiB;
constexpr size_t WS_WDN = 274 * MiB;
constexpr size_t WS_XB = 402 * MiB;
constexpr size_t WS_XF = 434 * MiB;
constexpr size_t WS_Y1 = 498 * MiB;
constexpr size_t WS_PROJ = 562 * MiB;
constexpr size_t WS_CAT = 658 * MiB;
constexpr size_t WS_KIN = 690 * MiB;
constexpr size_t WS_MASK = 691 * MiB;
constexpr size_t WS_ROUTE = 699 * MiB;
constexpr size_t WS_CNTW = 699 * MiB + 256 * 1024;
constexpr size_t WS_SC = 700 * MiB;
constexpr size_t WS_XS = 956 * MiB;
constexpr size_t WS_ACT = 1100 * MiB;
constexpr size_t WS_YS = 1244 * MiB;
constexpr size_t WS_END = 1388 * MiB;
constexpr int CW_TMO = 0;
constexpr int CW_CNT = 1024;
constexpr int CW_BAR = 4096;
constexpr int RING_BYTES = 131072;
constexpr int TAB_OFF = RING_BYTES;
constexpr int MISC_OFF = RING_BYTES + 1024;
constexpr int LDS_BYTES = 147456;

#define GAS __attribute__((address_space(1)))
#define LAS __attribute__((address_space(3)))
typedef unsigned short bf16;
typedef unsigned v4u __attribute__((ext_vector_type(4)));
typedef unsigned v2u __attribute__((ext_vector_type(2)));
typedef float f32x4 __attribute__((ext_vector_type(4)));
typedef short bf16x8 __attribute__((ext_vector_type(8)));
typedef GAS unsigned gu32;
typedef unsigned long long u64;
#define RLX_AGENT __ATOMIC_RELAXED, __HIP_MEMORY_SCOPE_AGENT
#define LDS_WAIT() asm volatile("s_waitcnt lgkmcnt(0)" ::: "memory")
#define VM_WAIT() asm volatile("s_waitcnt vmcnt(0)" ::: "memory")
__device__ __forceinline__ unsigned f2bf(float f) { unsigned u = __builtin_bit_cast(unsigned, f); return (u + 0x7fffu + ((u >> 16) & 1u)) >> 16; }
__device__ __forceinline__ unsigned pk2(float lo, float hi) { return f2bf(lo) | (f2bf(hi) << 16); }
__device__ __forceinline__ float bf2f(bf16 v) { return __builtin_bit_cast(float, (unsigned)v << 16); }
__device__ __forceinline__ float bflo(unsigned w) { return __builtin_bit_cast(float, w << 16); }
__device__ __forceinline__ float bfhi(unsigned w) { return __builtin_bit_cast(float, w & 0xffff0000u); }
__device__ __forceinline__ float wave_sum(float v) {
#pragma unroll
    for (int o = 1; o < 64; o <<= 1) v += __shfl_xor(v, o);
    return v;
}
__device__ __forceinline__ float wave_max(float v) {
#pragma unroll
    for (int o = 1; o < 64; o <<= 1) v = fmaxf(v, __shfl_xor(v, o));
    return v;
}
__device__ __forceinline__ float sum32(float v) {
#pragma unroll
    for (int o = 1; o < 32; o <<= 1) v += __shfl_xor(v, o);
    return v;
}
#define XB_TMO      128
#define XB_XCNT(j)  (256  + 64 * (j))
#define XB_XSUB(j)  (1280 + 64 * (j))
#define XB_XGEN(j)  (2304 + 64 * (j))
#define XB_TOP      3328
#define XB_TOPGEN   3392
#define XCD_BAR_WORDS 3456
#define XB_SPIN_CAP (1u << 18)

__device__ __forceinline__ unsigned xb_ld(unsigned* p)              { return __hip_atomic_load(p, __ATOMIC_RELAXED, __HIP_MEMORY_SCOPE_AGENT); }
__device__ __forceinline__ unsigned xb_add(unsigned* p, unsigned v) { return __hip_atomic_fetch_add(p, v, __ATOMIC_RELAXED, __HIP_MEMORY_SCOPE_AGENT); }
__device__ __forceinline__ unsigned xb_xcc_id() { return (unsigned)__builtin_amdgcn_s_getreg((3 << 11) | 20) & 0xFu; }
#define XB_SPIN(cond, bar) do { unsigned _sp = 0; while (cond) { __builtin_amdgcn_s_sleep(1); \
    if ((++_sp & 255u) == 0u) { if (xb_ld(&(bar)[XB_TMO])) break; if (_sp > XB_SPIN_CAP) { atomicAdd(&(bar)[XB_TMO], 1u); break; } } } } while (0)

struct XcdBarrier {
    unsigned* bar; unsigned x;
    volatile LAS unsigned* st;
};

__device__ __forceinline__ XcdBarrier xcd_barrier_post(unsigned* bar, volatile LAS unsigned* st) {
    XcdBarrier b; b.bar = bar; b.x = xb_xcc_id(); b.st = st;
    if (threadIdx.x == 0) (void)xb_add(&bar[XB_XCNT(b.x)], 1u);
    return b;
}
__device__ __forceinline__ void xcd_barrier_complete(unsigned* bar, unsigned x, unsigned& nloc, unsigned& nx) {
    const unsigned G = gridDim.x * gridDim.y * gridDim.z;
    unsigned sum, cnt, mine, sp = 0u;
    for (;;) {
        sum = 0u; cnt = 0u; mine = 0u;
#pragma unroll
        for (unsigned j = 0; j < 16; ++j) { const unsigned c = xb_ld(&bar[XB_XCNT(j)]); sum += c; cnt += (c > 0u) ? 1u : 0u; mine = (j == x) ? c : mine; }
        if (sum == G) break;
        __builtin_amdgcn_s_sleep(1);
        if ((++sp & 255u) == 0u) { if (xb_ld(&bar[XB_TMO])) break; if (sp > XB_SPIN_CAP) { atomicAdd(&bar[XB_TMO], 1u); break; } }
    }
    nloc = mine > 0u ? mine : 1u; nx = cnt > 0u ? cnt : 1u;
}

__device__ __forceinline__ void xcd_barrier(const XcdBarrier& b) {
    asm volatile("s_waitcnt vmcnt(0)" ::: "memory");
    __syncthreads();
    if (threadIdx.x == 0) {
        unsigned* bar = b.bar;
        __builtin_amdgcn_s_waitcnt(0);
        unsigned nloc = b.st[0], nx = b.st[1];
        if (nloc == 0u) { xcd_barrier_complete(bar, b.x, nloc, nx); b.st[0] = nloc; b.st[1] = nx; }
        const unsigned old = xb_add(&bar[XB_XSUB(b.x)], 1u);
        const unsigned gen = old / nloc;
        if (old + 1u == (gen + 1u) * nloc) {
            __builtin_amdgcn_fence(__ATOMIC_RELEASE, "agent");
            asm volatile("s_waitcnt vmcnt(0)" ::: "memory");
            const unsigned og = xb_add(&bar[XB_TOP], 1u);
            const unsigned tg = og / nx;
            if (og + 1u == (tg + 1u) * nx) xb_add(&bar[XB_TOPGEN], 1u);
            else XB_SPIN(xb_ld(&bar[XB_TOPGEN]) == tg, bar);
            __builtin_amdgcn_fence(__ATOMIC_ACQUIRE, "agent");
            xb_add(&bar[XB_XGEN(b.x)], 1u);
            asm volatile("s_waitcnt vmcnt(0)" ::: "memory");
        } else {
            XB_SPIN(xb_ld(&bar[XB_XGEN(b.x)]) == gen, bar);
            __builtin_amdgcn_fence(__ATOMIC_ACQUIRE, "agent");
            asm volatile("s_waitcnt vmcnt(0)" ::: "memory");
        }
    }
    __syncthreads();
}
struct Args { const float* in[N_IN]; float* out; unsigned char* ws; int ph_lo, ph_hi; };
struct Frame {
    LAS unsigned char* lds;
    gu32* ctl;
    unsigned char* ws;
    int tid, lane, wave, vcu, G;
};
#define WSP(type, off) ((type*)(F.ws + (off)))
__device__ __forceinline__ const float* uni(const float* p) { const u64 v = (u64)p; return (const float*)(((u64)(unsigned)__builtin_amdgcn_readfirstlane((int)(v >> 32)) << 32) | (u64)(unsigned)__builtin_amdgcn_readfirstlane((int)v)); }
__device__ __forceinline__ Frame make_frame(unsigned char* ws_, LAS unsigned char* lds_) {
    Frame F; const u64 v = (u64)ws_;
    F.ws = (unsigned char*)(((u64)(unsigned)__builtin_amdgcn_readfirstlane((int)(v >> 32)) << 32) | (u64)(unsigned)__builtin_amdgcn_readfirstlane((int)v));
    F.lds = (LAS unsigned char*)(unsigned)__builtin_amdgcn_readfirstlane((int)(unsigned)(uintptr_t)lds_);
    F.ctl = (gu32*)(F.ws + WS_CTL);
    F.tid = threadIdx.x; F.lane = F.tid & 63; F.wave = __builtin_amdgcn_readfirstlane(F.tid >> 6);
    F.G = gridDim.x; { const int bx = blockIdx.x; F.vcu = (F.G % 8 == 0) ? (bx % 8) * (F.G / 8) + bx / 8 : bx; }
    return F;
}
struct In6 { const float* p[6]; };

__device__ __forceinline__ void tr_item(const float* W, int K, int N, bf16* WT, size_t drow0, int k0, int n0, LAS float* scr, int lane, float scale = 1.f) {
    const int nn = n0 + (lane & 31); const bool ok = nn < N;
#pragma unroll 8
    for (int i = 0; i < 32; ++i) { const int kk = 2 * i + (lane >> 5); scr[kk * 33 + (lane & 31)] = ok ? W[(size_t)(k0 + kk) * N + nn] * scale : 0.f; }
    LDS_WAIT(); asm volatile("" ::: "memory");
    const int c = lane & 7;
#pragma unroll
    for (int j = 0; j < 4; ++j) { const int n = (lane >> 3) + 8 * j; const LAS float* s = scr + (8 * c) * 33 + n;
        v4u o; o.x = pk2(s[0 * 33], s[1 * 33]); o.y = pk2(s[2 * 33], s[3 * 33]); o.z = pk2(s[4 * 33], s[5 * 33]); o.w = pk2(s[6 * 33], s[7 * 33]);
        *(v4u*)(WT + (drow0 + n) * K + k0 + 8 * c) = o; }
    LDS_WAIT(); asm volatile("" ::: "memory");
}
__device__ __forceinline__ void p_prologue(Frame& F, const In6& A) {
    LAS float* scr = (LAS float*)(F.lds + F.wave * 16384);
    const int gw = F.vcu * NWAVES + F.wave, NGW = F.G * NWAVES, lane = F.lane;
    constexpr int I_IN = 16 * 96, I_OUT = 16 * 32, I_GU = NE * 16 * 64, I_DN = NE * 16 * 32, I_L = I_IN + I_OUT + I_GU + I_DN;
    for (int it = gw; it < DEPTH * I_L; it += NGW) {
        const int l = it / I_L; int r = it % I_L;
        if (r < I_IN) { const int kb = r / 96, nb = r % 96; tr_item(A.p[0] + (size_t)l * D * NIN, D, NIN, WSP(bf16, WS_WIN) + (size_t)l * NINP * D, (size_t)nb * 32, kb * 64, nb * 32, scr, lane, (nb * 32 >= C_Q && nb * 32 < C_K) ? ATT_C2 : 1.f); continue; }
        r -= I_IN;
        if (r < I_OUT) { const int kb = r / 32, nb = r % 32; tr_item(A.p[1] + (size_t)l * D * D, D, D, WSP(bf16, WS_WOUT) + (size_t)l * D * D, (size_t)nb * 32, kb * 64, nb * 32, scr, lane); continue; }
        r -= I_OUT;
        if (r < I_GU) { const int e = r / 1024, rr = r % 1024, kb = rr / 64, nb = rr % 64, n0 = nb * 32;
            const int dr = n0 < 1024 ? (n0 / 128) * 256 + (n0 % 128) : ((n0 - 1024) / 128) * 256 + 128 + ((n0 - 1024) % 128);
            tr_item(A.p[2] + (size_t)(l * NE + e) * D * 2048, D, 2048, WSP(bf16, WS_WGU) + (size_t)l * NE * 2048 * D, (size_t)e * 2048 + dr, kb * 64, n0, scr, lane); continue; }
        r -= I_GU;
        { const int e = r / 512, rr = r % 512, kb = rr / 32, nb = rr % 32;
            tr_item(A.p[3] + (size_t)(l * NE + e) * D * D, D, D, WSP(bf16, WS_WDN) + (size_t)l * NE * D * D, (size_t)e * 1024 + nb * 32, kb * 64, nb * 32, scr, lane); }
    }
    const float* x = A.p[4]; bf16* xb = WSP(bf16, WS_XB);
    for (int m = gw; m < T; m += NGW) {
        const f32x4* xr = (const f32x4*)(x + (size_t)m * D) + lane; u64* o8 = (u64*)(xb + (size_t)m * D) + lane;
#pragma unroll
        for (int j = 0; j < 4; ++j) { const f32x4 v = xr[64 * j]; o8[64 * j] = (u64)pk2(v.x, v.y) | ((u64)pk2(v.z, v.w) << 32); }
    }
}

__device__ __forceinline__ void p_local(Frame& F, const In6& A, int l) {
    LAS float* mixed = (LAS float*)F.lds;
    LAS float* wp = (LAS float*)(F.lds + 65536);
    const float* wpool = A.p[0] + (size_t)l * 4 * 64 * 64;
    for (int i = F.tid; i < 16384; i += 512) wp[i] = wpool[i];
    const float* convw = A.p[1] + l * 768; const float* pscale = A.p[2] + l * 256;
    const float* kng = A.p[3] + l * 32; const float* knb = A.p[4] + l * 32;
    const bf16* PROJ = WSP(bf16, WS_PROJ); bf16* CAT = WSP(bf16, WS_CAT); bf16* KIN = WSP(bf16, WS_KIN);
    for (int u = F.vcu; u < T / 64; u += F.G) {
        const int t0 = u * 64, s0 = t0 & (SEQ - 1), rowb = t0 - s0;
        __syncthreads();
        for (int idx = F.tid; idx < 64 * 256; idx += 512) {
            const int tt = idx >> 8, c = idx & 255, s = s0 + tt; const size_t rt = (size_t)(t0 + tt) * NINP;
            float acc = 0.f;
#pragma unroll
            for (int j = 0; j < 3; ++j) { const int sp = s - 2 + j; if (sp >= 0) { const size_t rr = (size_t)(rowb + sp) * NINP; acc += convw[j * 256 + c] * (bf2f(PROJ[rr + C_GC + c]) * bf2f(PROJ[rr + C_H + c])); } }
            CAT[(size_t)(t0 + tt) * D + c] = (bf16)f2bf(bf2f(PROJ[rt + C_GB + c]) * acc);
            const int g = c >> 6, w = 2 << g; const int lo = (s - w + 1) > 0 ? (s - w + 1) : 0; float sum = 0.f;
            for (int j = lo; j <= s; ++j) sum += bf2f(PROJ[(size_t)(rowb + j) * NINP + C_P + c]);
            const float cnt = (float)((s + 1) < w ? (s + 1) : w);
            mixed[tt * 256 + c] = sum / cnt - bf2f(PROJ[rt + C_P + c]);
        }
        for (int idx = F.tid; idx < 64 * 32; idx += 512) {
            const int tt = idx >> 5, dd = idx & 31; const float v = bf2f(PROJ[(size_t)(t0 + tt) * NINP + C_KI + dd]);
            const float mean = sum32(v) * (1.f / 32.f); const float dv = v - mean; const float var = sum32(dv * dv) * (1.f / 32.f);
            KIN[(size_t)(t0 + tt) * 32 + dd] = (bf16)f2bf(dv * rsqrtf(var + LN_EPS) * kng[dd] + knb[dd]);
        }
        __syncthreads();
        for (int idx = F.tid; idx < 64 * 256; idx += 512) {
            const int tt = idx >> 8, o = idx & 255, g = o >> 6, d = o & 63; float acc = 0.f;
            const LAS float* mx = mixed + tt * 256 + g * 64; const LAS float* wv = wp + g * 4096 + d;
#pragma unroll 8
            for (int c = 0; c < 64; ++c) acc += mx[c] * wv[c * 64];
            CAT[(size_t)(t0 + tt) * D + 256 + o] = (bf16)f2bf(acc * pscale[o]);
        }
    }
    __syncthreads();
}

__device__ __forceinline__ void p_scores(Frame& F) {
    const int lane = F.lane, wave = F.wave, l15 = lane & 15, l4 = lane >> 4;
    const bf16* PROJ = WSP(bf16, WS_PROJ); const bf16* KIN = WSP(bf16, WS_KIN); float* SC = WSP(float, WS_SC);
    for (int ui = F.vcu; ui < T / 16; ui += F.G) {
        const int r = ui >> 8, cc = ui & 255, b = cc & 3, j = cc >> 2; const int qb = (r & 1) ? r * 64 + 63 - j : r * 64 + j;
        const size_t rowq = (size_t)(b * SEQ + qb * 16 + l15);
        bf16x8 bq[8]; float wq[8];
#pragma unroll
        for (int h = 0; h < 8; ++h) { bq[h] = *(const bf16x8*)(PROJ + rowq * NINP + C_QI + h * 32 + 8 * l4); wq[h] = bf2f(PROJ[rowq * NINP + C_WI + h]) * 0.0625f; }
        float* srow = SC + rowq * SEQ + 4 * l4;
        for (int kt = wave; kt <= qb; kt += NWAVES) {
            const bf16x8 a = *(const bf16x8*)(KIN + (size_t)(b * SEQ + kt * 16 + l15) * 32 + 8 * l4);
            f32x4 sc = (f32x4){0.f, 0.f, 0.f, 0.f};
#pragma unroll
            for (int h = 0; h < 8; ++h) { const f32x4 d = __builtin_amdgcn_mfma_f32_16x16x32_bf16(a, bq[h], (f32x4){0.f, 0.f, 0.f, 0.f}, 0, 0, 0);
                sc.x += fmaxf(d.x, 0.f) * wq[h]; sc.y += fmaxf(d.y, 0.f) * wq[h]; sc.z += fmaxf(d.z, 0.f) * wq[h]; sc.w += fmaxf(d.w, 0.f) * wq[h]; }
            *(f32x4*)(srow + kt * 16) = sc;
        }
    }
}

__device__ __forceinline__ unsigned sortable(float v) { const unsigned u = __builtin_bit_cast(unsigned, v); return (u & 0x80000000u) ? ~u : (u | 0x80000000u); }
__device__ __forceinline__ void p_select(Frame& F) {
    const int gw = F.vcu * NWAVES + F.wave, NGW = F.G * NWAVES, lane = F.lane;
    const u64 lt = (1ull << lane) - 1ull;
    const float* SC = WSP(float, WS_SC); unsigned* MASK = WSP(unsigned, WS_MASK);
    for (int t = gw; t < T; t += NGW) {
        const int s = t & (SEQ - 1); u64* mrow = (u64*)MASK + ((size_t)(t >> 12) * 64) * SEQ + s;
        if (s < NSEL) { const int base = 64 * lane; u64 m; if (s >= base + 63) m = ~0ull; else if (s < base) m = 0ull; else m = (2ull << (s - base)) - 1ull; mrow[(size_t)lane * SEQ] = m; continue; }
        unsigned u[64]; const float* srow = SC + (size_t)t * SEQ;
#pragma unroll
        for (int g4 = 0; g4 < 4; ++g4) { const float* pg = srow + lane + g4 * 1024; asm volatile("" : "+v"(pg));
#pragma unroll
            for (int jj = 0; jj < 16; ++jj) { const int j = g4 * 16 + jj; const int k = lane + 64 * j; const float v = pg[jj * 64]; u[j] = k <= s ? sortable(v) : 0u; } }
        unsigned prefix = 0u;
        for (int bit = 31; bit >= 0; --bit) { const unsigned cand = prefix | (1u << bit); int cnt = 0;
#pragma unroll
            for (int j0 = 0; j0 < 64; j0 += 8) {
#pragma unroll
                for (int j = j0; j < j0 + 8; ++j) cnt += __popcll(__ballot(u[j] >= cand));
                __builtin_amdgcn_sched_barrier(0); }
            if (cnt >= NSEL) prefix = cand; }
        int ngt = 0;
#pragma unroll
        for (int j0 = 0; j0 < 64; j0 += 8) {
#pragma unroll
            for (int j = j0; j < j0 + 8; ++j) ngt += __popcll(__ballot(u[j] > prefix));
            __builtin_amdgcn_sched_barrier(0); }
        const int need = NSEL - ngt; int base = 0; unsigned mlo = 0u, mhi = 0u;
#pragma unroll
        for (int j0 = 0; j0 < 64; j0 += 4) {
#pragma unroll
            for (int j = j0; j < j0 + 4; ++j) { const bool eq = u[j] == prefix; const u64 em = __ballot(eq); const int rank = base + __popcll(em & lt);
                const bool sel = (u[j] > prefix) || (eq && rank < need); const u64 m = __ballot(sel); asm volatile("s_nop 4\n\tv_writelane_b32 %0, %2, %4\n\tv_writelane_b32 %1, %3, %4" : "+v"(mlo), "+v"(mhi) : "s"((unsigned)m), "s"((unsigned)(m >> 32)), "n"(j)); base += __popcll(em); }
            __builtin_amdgcn_sched_barrier(0); }
        mrow[(size_t)lane * SEQ] = (u64)mlo | ((u64)mhi << 32);
    }
}

namespace att {
typedef float f32x16 __attribute__((ext_vector_type(16)));
typedef short s16x4 __attribute__((ext_vector_type(4)));
constexpr int NSLOT = 3, SLOTB = 8192, LDS_K = 0, LDS_V = NSLOT * SLOTB, LDS_WS = 2 * NSLOT * SLOTB, LDS_OST = LDS_WS + 8 * 64 * 4, LDS_BYTES_ATT = LDS_OST + 8 * 4096;
constexpr float THR = 8.f;
__device__ __forceinline__ int crow(int r, int hi) { return (r & 3) + 8 * (r >> 2) + 4 * hi; }
__device__ __forceinline__ unsigned cvtpk(float lo, float hi) { typedef float f2 __attribute__((ext_vector_type(2))); typedef __bf16 b2 __attribute__((ext_vector_type(2))); f2 v = {lo, hi}; b2 b = __builtin_convertvector(v, b2); return __builtin_bit_cast(unsigned, b); }
__device__ __forceinline__ float rowmax(const f32x16& p0, const f32x16& p1) {
    float a = fmaxf(fmaxf(p0[0], p0[1]), p1[0]), b = fmaxf(fmaxf(p0[2], p0[3]), p1[1]); a = fmaxf(fmaxf(a, p1[2]), p1[3]);
#pragma unroll
    for (int r = 4; r < 16; r += 4) { a = fmaxf(fmaxf(a, p0[r]), p0[r + 1]); b = fmaxf(fmaxf(b, p0[r + 2]), p0[r + 3]); a = fmaxf(fmaxf(a, p1[r]), p1[r + 1]); b = fmaxf(fmaxf(b, p1[r + 2]), p1[r + 3]); }
    const float m = fmaxf(a, b);
    return fmaxf(m, __shfl_xor(m, 32));
}
__device__ __forceinline__ void pv(f32x16* o, int vb, bf16x8 pa0, bf16x8 pa1, bf16x8 pa2, bf16x8 pa3) {
#pragma unroll
    for (int d0 = 0; d0 < 2; ++d0) { s16x4 lo[4], hi[4];
#pragma unroll
        for (int ks = 0; ks < 4; ++ks) {
            asm volatile("ds_read_b64_tr_b16 %0,%1 offset:%c2" : "=&v"(lo[ks]) : "v"(vb), "i"(d0 * 4096 + ks * 1024) : "memory");
            asm volatile("ds_read_b64_tr_b16 %0,%1 offset:%c2" : "=&v"(hi[ks]) : "v"(vb), "i"(d0 * 4096 + ks * 1024 + 512) : "memory"); }
        asm volatile("s_waitcnt lgkmcnt(0)" ::: "memory"); __builtin_amdgcn_sched_barrier(0);
#define ATT_PK(k) (bf16x8){lo[k][0], lo[k][1], lo[k][2], lo[k][3], hi[k][0], hi[k][1], hi[k][2], hi[k][3]}
        o[d0] = __builtin_amdgcn_mfma_f32_32x32x16_bf16(pa0, ATT_PK(0), o[d0], 0, 0, 0);
        o[d0] = __builtin_amdgcn_mfma_f32_32x32x16_bf16(pa1, ATT_PK(1), o[d0], 0, 0, 0);
        o[d0] = __builtin_amdgcn_mfma_f32_32x32x16_bf16(pa2, ATT_PK(2), o[d0], 0, 0, 0);
        o[d0] = __builtin_amdgcn_mfma_f32_32x32x16_bf16(pa3, ATT_PK(3), o[d0], 0, 0, 0);
#undef ATT_PK
    }
}
}
__device__ __forceinline__ void p_attn_dense(Frame& F) {
    using namespace att;
    const int tid = F.tid, lane = tid & 63, r32 = lane & 31, hi = lane >> 5, wid = F.wave;
    const bf16* PROJ = WSP(bf16, WS_PROJ); bf16* CAT = WSP(bf16, WS_CAT); const u64* MASKT = WSP(u64, WS_MASK);
    LAS unsigned char* shm = F.lds;
    LAS float* wsf = (LAS float*)(shm + LDS_WS) + wid * 64;
    const float NEGINF = -INFINITY;
    for (int ui = 0; ui < 2; ++ui) {
        const int v = F.vcu; if (v >= 256) break;
        const int bh = v >> 3, sidx = v & 7, b = bh >> 3, h = bh & 7, qb = ui == 0 ? sidx : 15 - sidx;
        const size_t rowbase = (size_t)b * SEQ; const int q0 = qb * 256, NT = (q0 + 256) / 64;
        const float slope2 = exp2f(-(float)(h + 1)) * 1.4426950408889634f;
        const bf16* Kh = PROJ + rowbase * NINP + C_K + h * 64; const bf16* Vh = PROJ + rowbase * NINP + C_V + h * 64;
        const bf16* ksrc = Kh + (size_t)lane * NINP + wid * 8;
        const bf16* vsrc = Vh + (size_t)(16 * (wid & 3) + (lane >> 2)) * NINP + (wid >> 2) * 32 + (lane & 3) * 8;
#define ATT_DMA(t, slot) do { __builtin_amdgcn_global_load_lds((const unsigned*)(ksrc + (size_t)(t) * 64 * NINP), (LAS unsigned*)(shm + LDS_K + (slot) * SLOTB + wid * 1024), 16, 0, 0); \
                              __builtin_amdgcn_global_load_lds((const unsigned*)(vsrc + (size_t)(t) * 64 * NINP), (LAS unsigned*)(shm + LDS_V + (slot) * SLOTB + wid * 1024), 16, 0, 0); } while (0)
        ATT_DMA(0, 0); ATT_DMA(1, 1);
        const bf16* Qw = PROJ + (rowbase + q0 + wid * 32) * NINP + C_Q + h * 64;
        bf16x8 qr[4];
#pragma unroll
        for (int d0 = 0; d0 < 4; ++d0) qr[d0] = *(const bf16x8*)(Qw + (size_t)r32 * NINP + d0 * 16 + hi * 8);
        const u64* mq = MASKT + ((size_t)b * 64) * SEQ + q0 + wid * 32 + r32;
        u64 mnext = mq[0];
        f32x16 c0, c1, o[2]; o[0] = f32x16{}; o[1] = f32x16{};
#pragma unroll
        for (int r = 0; r < 16; ++r) { c0[r] = slope2 * (float)crow(r, hi); c1[r] = slope2 * (float)(crow(r, hi) + 32); }
        float l_reg = 0.f;
        const int qlast = q0 + wid * 32 + 31;
        const int vb0 = (int)(unsigned)(uintptr_t)(shm + LDS_V) + ((lane >> 4) & 1) * 32 + (lane & 3) * 8 + (4 * hi + ((lane & 15) >> 2)) * 64;
        int slot = 0;
        for (int t = 0; t < NT; ++t) {
            if (t + 1 < NT) asm volatile("s_waitcnt vmcnt(2)" ::: "memory"); else asm volatile("s_waitcnt vmcnt(0)" ::: "memory");
            asm volatile("s_waitcnt lgkmcnt(0)" ::: "memory"); __builtin_amdgcn_s_barrier(); asm volatile("" ::: "memory");
#ifdef ATT_NOMASK
            const u64 mcur = ~0ull + (mnext & 0ull);
#else
            const u64 mcur = mnext;
#endif
            if (t + 1 < NT) mnext = mq[(size_t)(t + 1) * SEQ];
            __builtin_amdgcn_sched_barrier(0);
            if (t + 2 < NT) { const int s2 = slot + 2 >= NSLOT ? slot + 2 - NSLOT : slot + 2; ATT_DMA(t + 2, s2); }
            __builtin_amdgcn_sched_barrier(0);
            if (t * 64 <= qlast) {
                const LAS unsigned char* kb = shm + LDS_K + slot * SLOTB + hi * 1024 + r32 * 16;
                f32x16 p0 = c0, p1 = c1;
#pragma unroll
                for (int d0 = 0; d0 < 4; ++d0) { const bf16x8 k0 = *(const LAS bf16x8*)(kb + d0 * 2048), k1 = *(const LAS bf16x8*)(kb + d0 * 2048 + 512);
                    p0 = __builtin_amdgcn_mfma_f32_32x32x16_bf16(k0, qr[d0], p0, 0, 0, 0); p1 = __builtin_amdgcn_mfma_f32_32x32x16_bf16(k1, qr[d0], p1, 0, 0, 0); }
                const unsigned w0 = (unsigned)mcur >> (4 * hi), w1 = (unsigned)(mcur >> 32) >> (4 * hi);
#pragma unroll
                for (int r = 0; r < 16; ++r) { const int cr = (r & 3) + 8 * (r >> 2);
                    p0[r] = ((w0 >> cr) & 1u) ? p0[r] : NEGINF; p1[r] = ((w1 >> cr) & 1u) ? p1[r] : NEGINF; }
                const float rm = rowmax(p0, p1); bool resc = false;
                if (__any(rm > THR)) { const float dl = fmaxf(rm, 0.f);
#pragma unroll
                    for (int r = 0; r < 16; ++r) { p0[r] -= dl; p1[r] -= dl; c0[r] -= dl; c1[r] -= dl; }
                    const float f = __builtin_amdgcn_exp2f(-dl); l_reg *= f; if (hi == 0) wsf[r32] = f; resc = true; }
                float sacc = 0.f;
#pragma unroll
                for (int r = 0; r < 16; ++r) { p0[r] = __builtin_amdgcn_exp2f(p0[r]); p1[r] = __builtin_amdgcn_exp2f(p1[r]); sacc += p0[r] + p1[r]; }
                l_reg += sacc;
                if (resc) { asm volatile("s_waitcnt lgkmcnt(0)" ::: "memory");
#pragma unroll
                    for (int d_ = 0; d_ < 2; ++d_)
#pragma unroll
                        for (int r = 0; r < 16; ++r) o[d_][r] *= wsf[crow(r, hi)]; }
                const v4u pw0 = (v4u){cvtpk(p0[0], p0[1]), cvtpk(p0[2], p0[3]), cvtpk(p0[4], p0[5]), cvtpk(p0[6], p0[7])}, pw1 = (v4u){cvtpk(p0[8], p0[9]), cvtpk(p0[10], p0[11]), cvtpk(p0[12], p0[13]), cvtpk(p0[14], p0[15])};
                const v4u pw2 = (v4u){cvtpk(p1[0], p1[1]), cvtpk(p1[2], p1[3]), cvtpk(p1[4], p1[5]), cvtpk(p1[6], p1[7])}, pw3 = (v4u){cvtpk(p1[8], p1[9]), cvtpk(p1[10], p1[11]), cvtpk(p1[12], p1[13]), cvtpk(p1[14], p1[15])};
                __builtin_amdgcn_sched_barrier(0);
                pv(o, vb0 + slot * SLOTB, __builtin_bit_cast(bf16x8, pw0), __builtin_bit_cast(bf16x8, pw1), __builtin_bit_cast(bf16x8, pw2), __builtin_bit_cast(bf16x8, pw3));
            }
            const float step = 64.f * slope2;
#pragma unroll
            for (int r = 0; r < 16; ++r) { c0[r] += step; c1[r] += step; }
            slot = slot + 1 >= NSLOT ? 0 : slot + 1;
        }
        l_reg += __shfl_xor(l_reg, 32);
        if (hi == 0) wsf[32 + r32] = l_reg;
        asm volatile("s_waitcnt lgkmcnt(0)" ::: "memory");
        float rli[16];
#pragma unroll
        for (int r = 0; r < 16; ++r) rli[r] = 1.f / wsf[32 + crow(r, hi)];
        bf16* Ow = CAT + (rowbase + q0 + wid * 32) * D + 512 + h * 64;
        { LAS bf16* stg = (LAS bf16*)(shm + LDS_OST) + wid * 2048;
#pragma unroll
            for (int r = 0; r < 16; ++r) { const int orow = crow(r, hi);
#pragma unroll
                for (int d0 = 0; d0 < 2; ++d0) stg[orow * 64 + d0 * 32 + r32] = (bf16)f2bf(o[d0][r] * rli[r]); }
            asm volatile("s_waitcnt lgkmcnt(0)" ::: "memory");
#pragma unroll
            for (int i = 0; i < 4; ++i) { const int row = i * 8 + (lane >> 3), ch = lane & 7; const v4u vv = *(const LAS v4u*)(stg + row * 64 + ch * 8); *(v4u*)(Ow + (size_t)row * D + ch * 8) = vv; } }
        asm volatile("s_waitcnt vmcnt(0) lgkmcnt(0)" ::: "memory"); __builtin_amdgcn_s_barrier(); asm volatile("" ::: "memory");
#undef ATT_DMA
    }
}

struct EpiResid {
    static constexpr bool PERM = false, AFTER_DRAIN = false;
    const float* resid; float* out; int ldc; float alpha;
    __device__ __forceinline__ void operator()(const pg8::f32x4 (&acc)[2][2][4][2], const pg8::Unit& u, int wr, int wc, int fr, int fq) const {
        const int col0 = u.pn * 256 + wc * 32 + 4 * fq;
#pragma unroll
        for (int ai = 0; ai < 2; ++ai)
#pragma unroll
            for (int m = 0; m < 4; ++m) { const size_t off = (size_t)(u.pm * 256 + ai * 128 + wr * 64 + m * 16 + fr) * ldc + col0;
#pragma unroll
                for (int bj = 0; bj < 2; ++bj)
#pragma unroll
                    for (int n = 0; n < 2; ++n) { const f32x4 xr = *(const f32x4*)(resid + off + bj * 128 + n * 16); *(f32x4*)(out + off + bj * 128 + n * 16) = xr * alpha + acc[ai][bj][m][n]; }
                if (m & 1) asm volatile("" ::: "memory"); }
    }
};
struct EpiSwiglu {
    static constexpr bool PERM = true, AFTER_DRAIN = false;
    bf16* O; const float* bias;
    __device__ __forceinline__ void operator()(const pg8::f32x4 (&acc)[2][2][4][2], const pg8::Unit& u, int wr, int wc, int fr, int fq) const {
        const int e = u.pn >> 3, nt = u.pn & 7; const int colg = nt * 128 + wc * 32 + 8 * fq;
        f32x4 bg[2], bu[2];
#pragma unroll
        for (int n = 0; n < 2; ++n) { bg[n] = *(const f32x4*)(bias + (size_t)e * 2048 + colg + 4 * n); bu[n] = *(const f32x4*)(bias + (size_t)e * 2048 + 1024 + colg + 4 * n); }
#pragma unroll
        for (int ai = 0; ai < 2; ++ai)
#pragma unroll
            for (int m = 0; m < 4; ++m) { const size_t row = (size_t)(u.pm * 256 + ai * 128 + wr * 64 + m * 16 + fr); float a8[8];
#pragma unroll
                for (int n = 0; n < 2; ++n)
#pragma unroll
                    for (int i = 0; i < 4; ++i) { float g = acc[ai][0][m][n][i] + bg[n][i], up = acc[ai][1][m][n][i] + bu[n][i];
                        g = fminf(g, 7.f); up = fminf(fmaxf(up, -7.f), 7.f);
                        a8[n * 4 + i] = g * (up + 1.f) / (1.f + __expf(-1.702f * g)); }
                v4u w; w.x = pk2(a8[0], a8[1]); w.y = pk2(a8[2], a8[3]); w.z = pk2(a8[4], a8[5]); w.w = pk2(a8[6], a8[7]);
                *(v4u*)(O + row * 1024 + colg) = w; }
    }
};
struct MoeSched {
    const LAS int* tab; int n;
    __device__ __forceinline__ bool next(int i, pg8::Unit& u) const {
        if (i >= n) return false;
        const int v = __builtin_amdgcn_readfirstlane(tab[1 + i]); u.pm = v >> 16; u.pn = v & 0xffff; return true;
    }
    __device__ __forceinline__ void a_ready(const pg8::Unit&) const {}
    __device__ __forceinline__ void done(const pg8::Unit&) const {}
};
__device__ __forceinline__ int moe_table(Frame& F, int l, int ntn) {
    LAS int* tab = (LAS int*)(F.lds + TAB_OFF);
    if (F.wave == 0) {
        const int lane = F.lane; const int cnt = lane < NE ? (int)__hip_atomic_load(F.ctl + CW_CNT + 64 * l + lane, RLX_AGENT) : 0; const int mt = (cnt + 255) >> 8; int incl = mt;
#pragma unroll
        for (int o = 1; o < 64; o <<= 1) { const int v = __shfl_up(incl, o); if (lane >= o) incl += v; }
        const int total = __shfl(incl, 63) * ntn; const int c = (int)blockIdx.x, G = F.G;
        const int nmine = c < total ? (total - c + G - 1) / G : 0;
        for (int i0 = 0; i0 < nmine && i0 < 200; i0 += 64) { const int i = i0 + lane; const int L = i * G + c; int e = 0;
            for (int k = 0; k < NE; ++k) { const int endk = __shfl(incl, k) * ntn; e += (L >= endk) ? 1 : 0; }
            e = e < NE ? e : NE - 1;
            const int excl_e = __shfl(incl, e) - __shfl(mt, e); int mte = __shfl(mt, e); mte = mte > 0 ? mte : 1; const int idx = L - excl_e * ntn;
            if (i < nmine && i < 200) tab[1 + i] = ((excl_e + idx % mte) << 16) | (e * ntn + idx / mte); }
        if (lane == 0) tab[0] = nmine < 200 ? nmine : 200;
    }
    __syncthreads();
    return __builtin_amdgcn_readfirstlane(tab[0]);
}

__device__ __forceinline__ void p_router(Frame& F, const In6& A, int l) {
    const int gw = F.vcu * NWAVES + F.wave, NGW = F.G * NWAVES, lane = F.lane, wave = F.wave;
    const int TPW = T / NGW;
    LAS float* xs = (LAS float*)(F.lds + wave * 4096);
    float* Y1 = WSP(float, WS_Y1); bf16* XB = WSP(bf16, WS_XB);
    int* TOPE = WSP(int, WS_ROUTE); float* GATE = (float*)(TOPE + 8 * T); int* CNTW = WSP(int, WS_CNTW);
    const float* g1 = A.p[0] + l * D; const float* b1 = A.p[1] + l * D;
    const float* RW = A.p[2] + (size_t)l * D * NE; const float* RB = A.p[3] + l * NE;
    const int e = lane & 31, half = lane >> 5; int cntw = 0;
    for (int ti = 0; ti < TPW; ++ti) { const int t = gw * TPW + ti;
        f32x4* yr = (f32x4*)(Y1 + (size_t)t * D) + lane; f32x4 v[4]; float s = 0.f;
#pragma unroll
        for (int j = 0; j < 4; ++j) { v[j] = yr[64 * j]; s += (v[j].x + v[j].y) + (v[j].z + v[j].w); }
        const float mean = wave_sum(s) * (1.f / D); float s2 = 0.f;
#pragma unroll
        for (int j = 0; j < 4; ++j) { v[j] = v[j] - mean; s2 += (v[j].x * v[j].x + v[j].y * v[j].y) + (v[j].z * v[j].z + v[j].w * v[j].w); }
        const float rstd = rsqrtf(wave_sum(s2) * (1.f / D) + LN_EPS);
        u64* o8 = (u64*)(XB + (size_t)t * D) + lane;
#pragma unroll
        for (int j = 0; j < 4; ++j) { const f32x4 gg = ((const f32x4*)g1)[lane + 64 * j], bb = ((const f32x4*)b1)[lane + 64 * j]; const f32x4 y = v[j] * rstd * gg + bb;
            yr[64 * j] = y; o8[64 * j] = (u64)pk2(y.x, y.y) | ((u64)pk2(y.z, y.w) << 32); ((LAS f32x4*)xs)[lane + 64 * j] = y; }
        LDS_WAIT(); asm volatile("" ::: "memory");
        float acc = 0.f; const LAS float* xh = xs + half * 512; const float* rw = RW + (size_t)half * 512 * NE + e;
#pragma unroll 8
        for (int d = 0; d < 512; ++d) acc += xh[d] * rw[(size_t)d * NE];
        acc += __shfl_xor(acc, 32);
        float cur = acc + RB[e]; float sv[4]; int se[4];
#pragma unroll
        for (int k = 0; k < 4; ++k) { float bv = cur; int bi = e;
#pragma unroll
            for (int o = 16; o >= 1; o >>= 1) { const float ov = __shfl_xor(bv, o); const int oi = __shfl_xor(bi, o); if (ov > bv || (ov == bv && oi < bi)) { bv = ov; bi = oi; } }
            sv[k] = bv; se[k] = bi; if (e == bi) { cur = -INFINITY; cntw += 1; } }
        const float e1 = expf(sv[1] - sv[0]), e2 = expf(sv[2] - sv[0]), e3 = expf(sv[3] - sv[0]); const float inv = 1.f / (1.f + e1 + e2 + e3);
        if (lane < 4) { const int ek = lane == 0 ? se[0] : lane == 1 ? se[1] : lane == 2 ? se[2] : se[3]; const float gk = (lane == 0 ? 1.f : lane == 1 ? e1 : lane == 2 ? e2 : e3) * inv;
            TOPE[4 * t + lane] = ek; GATE[4 * t + lane] = gk; }
        LDS_WAIT(); asm volatile("" ::: "memory");
    }
    if (lane < NE) CNTW[gw * NE + lane] = cntw;
}

__device__ __forceinline__ void p_gather(Frame& F, int l) {
    const int gw = F.vcu * NWAVES + F.wave, NGW = F.G * NWAVES, lane = F.lane, tid = F.tid;
    const int TPW = T / NGW, NIT = TPW * 4;
    const int* CNTW = WSP(int, WS_CNTW);
    LAS int* red = (LAS int*)F.lds;
    LAS int* baseE = red + 1024; LAS int* totE = baseE + 32;
    { const int e = tid & 31, part = tid >> 5, first = F.vcu * NWAVES; int sb = 0, st = 0;
        for (int g = part; g < NGW; g += 16) { const int c = CNTW[g * NE + e]; st += c; sb += g < first ? c : 0; }
        red[part * 32 + e] = sb; red[512 + part * 32 + e] = st; }
    __syncthreads();
    if (tid < 32) { int sb = 0, st = 0;
#pragma unroll
        for (int p = 0; p < 16; ++p) { sb += red[p * 32 + tid]; st += red[512 + p * 32 + tid]; }
        baseE[tid] = sb; totE[tid] = st;
        if (F.vcu == 0) __hip_atomic_store(F.ctl + CW_CNT + 64 * l + tid, (unsigned)st, RLX_AGENT); }
    __syncthreads();
    int mybase = 0, tot = 0;
    if (lane < NE) { mybase = baseE[lane]; tot = totE[lane]; for (int w = 0; w < F.wave; ++w) mybase += CNTW[(F.vcu * NWAVES + w) * NE + lane]; }
    const int mt = (tot + 255) >> 8; int incl = mt;
#pragma unroll
    for (int o = 1; o < 64; o <<= 1) { const int v = __shfl_up(incl, o); if (lane >= o) incl += v; }
    const int pstart = (incl - mt) * 256;
    const int* TOPE = WSP(int, WS_ROUTE); int* ROWOF = (int*)(TOPE + 12 * T);
    const bf16* XB = WSP(bf16, WS_XB); bf16* XS = WSP(bf16, WS_XS);
    const int it0 = gw * NIT; const int ei = lane < NIT ? TOPE[it0 + lane] : 0; int rk = 0;
    for (int j = 0; j < NIT; ++j) { const int ej = __shfl(ei, j); rk += (j < lane && ej == ei) ? 1 : 0; }
    const int row = __shfl(pstart, ei) + __shfl(mybase, ei) + rk;
    if (lane < NIT) ROWOF[it0 + lane] = row;
    for (int j = 0; j < NIT; ++j) { const int rj = __shfl(row, j);
        const v4u* src = (const v4u*)(XB + (size_t)((it0 + j) >> 2) * D) + lane; v4u* dst = (v4u*)(XS + (size_t)rj * D) + lane;
        dst[0] = src[0]; dst[64] = src[64]; }
    __syncthreads();
}

__device__ __forceinline__ void p_combine(Frame& F, const In6& A, int l, float* xout) {
    const int gw = F.vcu * NWAVES + F.wave, NGW = F.G * NWAVES, lane = F.lane;
    const int* ROWOF = WSP(int, WS_ROUTE) + 12 * T; const float* GATE = (const float*)(WSP(int, WS_ROUTE) + 8 * T);
    const float* X1 = WSP(float, WS_Y1); const bf16* YS = WSP(bf16, WS_YS); bf16* XB = WSP(bf16, WS_XB);
    const float* g2 = A.p[0] + l * D; const float* b2 = A.p[1] + l * D;
    for (int t = gw; t < T; t += NGW) {
        const f32x4* xr = (const f32x4*)(X1 + (size_t)t * D) + lane; f32x4 v[4];
#pragma unroll
        for (int j = 0; j < 4; ++j) v[j] = xr[64 * j] * DN_ALPHA;
#pragma unroll
        for (int k = 0; k < 4; ++k) { const int row = ROWOF[4 * t + k]; const float gk = GATE[4 * t + k]; const v2u* yr = (const v2u*)(YS + (size_t)row * D) + lane;
#pragma unroll
            for (int j = 0; j < 4; ++j) { const v2u w = yr[64 * j]; v[j].x += gk * bflo(w.x); v[j].y += gk * bfhi(w.x); v[j].z += gk * bflo(w.y); v[j].w += gk * bfhi(w.y); } }
        float s = 0.f;
#pragma unroll
        for (int j = 0; j < 4; ++j) s += (v[j].x + v[j].y) + (v[j].z + v[j].w);
        const float mean = wave_sum(s) * (1.f / D); float s2 = 0.f;
#pragma unroll
        for (int j = 0; j < 4; ++j) { v[j] = v[j] - mean; s2 += (v[j].x * v[j].x + v[j].y * v[j].y) + (v[j].z * v[j].z + v[j].w * v[j].w); }
        const float rstd = rsqrtf(wave_sum(s2) * (1.f / D) + LN_EPS);
        f32x4* orow = (f32x4*)(xout + (size_t)t * D) + lane; u64* o8 = (u64*)(XB + (size_t)t * D) + lane;
#pragma unroll
        for (int j = 0; j < 4; ++j) { const f32x4 gg = ((const f32x4*)g2)[lane + 64 * j], bb = ((const f32x4*)b2)[lane + 64 * j]; const f32x4 y = v[j] * rstd * gg + bb;
            orow[64 * j] = y; o8[64 * j] = (u64)pk2(y.x, y.y) | ((u64)pk2(y.z, y.w) << 32); }
    }
}


#define NI __device__ __forceinline__
NI void ph_prologue(unsigned char* ws, LAS unsigned char* lds, const float* a0, const float* a1, const float* a2, const float* a3, const float* a4) { Frame F = make_frame(ws, lds); In6 I{{uni(a0), uni(a1), uni(a2), uni(a3), uni(a4), nullptr}}; p_prologue(F, I); }
NI void ph_local(unsigned char* ws, LAS unsigned char* lds, int l, const float* a0, const float* a1, const float* a2, const float* a3, const float* a4) { Frame F = make_frame(ws, lds); In6 I{{uni(a0), uni(a1), uni(a2), uni(a3), uni(a4), nullptr}}; p_local(F, I, __builtin_amdgcn_readfirstlane(l)); }
NI void ph_scores(unsigned char* ws, LAS unsigned char* lds) { Frame F = make_frame(ws, lds); p_scores(F); }
NI void ph_select(unsigned char* ws, LAS unsigned char* lds) { Frame F = make_frame(ws, lds); p_select(F); }
NI void ph_attn(unsigned char* ws, LAS unsigned char* lds) { Frame F = make_frame(ws, lds); p_attn_dense(F); }
NI void ph_router(unsigned char* ws, LAS unsigned char* lds, int l, const float* a0, const float* a1, const float* a2, const float* a3) { Frame F = make_frame(ws, lds); In6 I{{uni(a0), uni(a1), uni(a2), uni(a3), nullptr, nullptr}}; p_router(F, I, __builtin_amdgcn_readfirstlane(l)); }
NI void ph_gather(unsigned char* ws, LAS unsigned char* lds, int l) { Frame F = make_frame(ws, lds); p_gather(F, __builtin_amdgcn_readfirstlane(l)); }
NI void ph_combine(unsigned char* ws, LAS unsigned char* lds, int l, const float* a0, const float* a1, float* xout) { Frame F = make_frame(ws, lds); In6 I{{uni(a0), uni(a1), nullptr, nullptr, nullptr, nullptr}}; p_combine(F, I, __builtin_amdgcn_readfirstlane(l), (float*)uni(xout)); }

NI void ph_gemm_in(unsigned char* ws, LAS unsigned char* lds, int l_) {
    Frame F = make_frame(ws, lds); const int l = __builtin_amdgcn_readfirstlane(l_);
    pg8::Gemm g{WSP(bf16, WS_XB), WSP(bf16, WS_WIN) + (size_t)l * NINP * D, T, NINP, D}; pg8::StaticOrder S; S.init(T, NINP, F.G, (int)blockIdx.x);
    pg8::EpiBf16<0> E{WSP(bf16, WS_PROJ), NINP, nullptr, 0, 0, 1.f};
    pg8::gemm_phase<pg8::EpiBf16<0>, pg8::StaticOrder, PG8_ALIGN, PG8_SP2>(F.lds, g, S, E);
}
NI void ph_gemm_out(unsigned char* ws, LAS unsigned char* lds, int l_, const float* xin) {
    Frame F = make_frame(ws, lds); const int l = __builtin_amdgcn_readfirstlane(l_);
    pg8::Gemm g{WSP(bf16, WS_CAT), WSP(bf16, WS_WOUT) + (size_t)l * D * D, T, D, D}; pg8::StaticOrder S; S.init(T, D, F.G, (int)blockIdx.x);
    EpiResid E{uni(xin), WSP(float, WS_Y1), D, DN_ALPHA};
    pg8::gemm_phase<EpiResid, pg8::StaticOrder, PG8_ALIGN, PG8_SP2>(F.lds, g, S, E);
}
NI void ph_gemm_moe1(unsigned char* ws, LAS unsigned char* lds, int l_, const float* bgu) {
    Frame F = make_frame(ws, lds); const int l = __builtin_amdgcn_readfirstlane(l_);
    const int nun = moe_table(F, l, 8);
    pg8::Gemm g{WSP(bf16, WS_XS), WSP(bf16, WS_WGU) + (size_t)l * NE * 2048 * D, MAXROWS, NE * 2048, D};
    MoeSched S{(const LAS int*)(F.lds + TAB_OFF), nun};
    EpiSwiglu E{WSP(bf16, WS_ACT), uni(bgu) + (size_t)l * NE * 2048};
    pg8::gemm_phase<EpiSwiglu, MoeSched, PG8_ALIGN, PG8_SP2>(F.lds, g, S, E);
}
NI void ph_gemm_moe2(unsigned char* ws, LAS unsigned char* lds, int l_, const float* bdn) {
    Frame F = make_frame(ws, lds); const int l = __builtin_amdgcn_readfirstlane(l_);
    const int nun = moe_table(F, l, 4);
    pg8::Gemm g{WSP(bf16, WS_ACT), WSP(bf16, WS_WDN) + (size_t)l * NE * D * D, MAXROWS, NE * D, D};
    MoeSched S{(const LAS int*)(F.lds + TAB_OFF), nun};
    pg8::EpiBf16<0> E{WSP(bf16, WS_YS), D, uni(bdn) + (size_t)l * NE * D, D, 0, 1.f};
    pg8::gemm_phase<pg8::EpiBf16<0>, MoeSched, PG8_ALIGN, PG8_SP2>(F.lds, g, S, E);
}

__device__ __forceinline__ const float* karg_in(int i) { return ((const float* const volatile*)__builtin_amdgcn_kernarg_segment_ptr())[i]; }
__device__ __forceinline__ float* karg_out() { return ((float* const volatile*)__builtin_amdgcn_kernarg_segment_ptr())[N_IN]; }
#ifndef PHMASK
#define PHMASK 0xFFF
#endif
constexpr int PH_PER_LAYER = 11, N_PHASES = 1 + DEPTH * PH_PER_LAYER;
#define IN(k) (lo <= (k) && (k) < hi)
#define SEAM(k) do { if (IN(k) && IN((k) + 1)) xcd_barrier(bar); } while (0)
template <int l> __device__ __forceinline__ void layer_phases(Frame& F, const XcdBarrier& bar, int lo, int hi) {
        const int p0 = 1 + l * PH_PER_LAYER;
        const float* xin = l == 0 ? karg_in(IN_X) : WSP(float, WS_XF);
        float* xout = l == DEPTH - 1 ? karg_out() : WSP(float, WS_XF);
        if (((PHMASK >> 0) & 1) && IN(p0 + 0)) { asm volatile("; PHASE_BEGIN_0"); ph_gemm_in(F.ws, F.lds, l); SEAM(p0 + 0); }
        if (((PHMASK >> 1) & 1) && IN(p0 + 1)) { asm volatile("; PHASE_BEGIN_1"); ph_local(F.ws, F.lds, l, karg_in(IN_WPOOL), karg_in(IN_CONVW), karg_in(IN_PSCALE), karg_in(IN_KNG), karg_in(IN_KNB)); SEAM(p0 + 1); }
        if (((PHMASK >> 2) & 1) && IN(p0 + 2)) { asm volatile("; PHASE_BEGIN_2"); ph_scores(F.ws, F.lds); SEAM(p0 + 2); }
        if (((PHMASK >> 3) & 1) && IN(p0 + 3)) { asm volatile("; PHASE_BEGIN_3"); ph_select(F.ws, F.lds); SEAM(p0 + 3); }
        if (((PHMASK >> 4) & 1) && IN(p0 + 4)) { asm volatile("; PHASE_BEGIN_4"); ph_attn(F.ws, F.lds); SEAM(p0 + 4); }
        if (((PHMASK >> 5) & 1) && IN(p0 + 5)) { asm volatile("; PHASE_BEGIN_5"); ph_gemm_out(F.ws, F.lds, l, xin); SEAM(p0 + 5); }
        if (((PHMASK >> 6) & 1) && IN(p0 + 6)) { asm volatile("; PHASE_BEGIN_6"); ph_router(F.ws, F.lds, l, karg_in(IN_LN1G), karg_in(IN_LN1B), karg_in(IN_RW), karg_in(IN_RB)); SEAM(p0 + 6); }
        if (((PHMASK >> 7) & 1) && IN(p0 + 7)) { asm volatile("; PHASE_BEGIN_7"); ph_gather(F.ws, F.lds, l); SEAM(p0 + 7); }
        if (((PHMASK >> 8) & 1) && IN(p0 + 8)) { asm volatile("; PHASE_BEGIN_8"); ph_gemm_moe1(F.ws, F.lds, l, karg_in(IN_BGU)); SEAM(p0 + 8); }
        if (((PHMASK >> 9) & 1) && IN(p0 + 9)) { asm volatile("; PHASE_BEGIN_9"); ph_gemm_moe2(F.ws, F.lds, l, karg_in(IN_BDN)); SEAM(p0 + 9); }
        if (((PHMASK >> 10) & 1) && IN(p0 + 10)) { asm volatile("; PHASE_BEGIN_10"); ph_combine(F.ws, F.lds, l, karg_in(IN_LN2G), karg_in(IN_LN2B), xout); SEAM(p0 + 10); }
}
#undef IN
#undef SEAM
__global__ void __launch_bounds__(NWAVES * 64, 2) fwd_kernel(Args A) {
    extern __shared__ __attribute__((aligned(16))) unsigned char lds[];
    Frame F;
    F.lds = (LAS unsigned char*)lds;
    F.tid = threadIdx.x; F.lane = F.tid & 63; F.wave = __builtin_amdgcn_readfirstlane(F.tid >> 6);
    F.G = gridDim.x; { const int bx = blockIdx.x; F.vcu = (F.G % 8 == 0) ? (bx % 8) * (F.G / 8) + bx / 8 : bx; }
    F.ws = A.ws; F.ctl = (gu32*)(A.ws + WS_CTL);
    volatile LAS unsigned* MISC = (volatile LAS unsigned*)(F.lds + MISC_OFF);
    if (F.tid < 32) MISC[F.tid] = 0u;
    __syncthreads();
    const int lo = A.ph_lo, hi = A.ph_hi;
    const bool multi = (hi - lo) > 1;
    XcdBarrier bar; bar.bar = (unsigned*)(F.ctl + CW_BAR); bar.x = 0; bar.st = nullptr;
    if (multi) bar = xcd_barrier_post((unsigned*)(F.ctl + CW_BAR), MISC + 8);
#define IN(k) (lo <= (k) && (k) < hi)
#define SEAM(k) do { if (IN(k) && IN((k) + 1)) xcd_barrier(bar); } while (0)

    if (((PHMASK >> 11) & 1) && IN(0)) { asm volatile("; PHASE_BEGIN_11"); ph_prologue(F.ws, F.lds, karg_in(IN_WIN), karg_in(IN_WOUT), karg_in(IN_WGU), karg_in(IN_WDN), karg_in(IN_X)); SEAM(0); }
    layer_phases<0>(F, bar, lo, hi);
    layer_phases<1>(F, bar, lo, hi);
#undef IN
#undef SEAM
}


#ifdef DUMP_OFF
__global__ void dump_kernel(const unsigned* w, size_t nwords, float* out, int n) {
    const int i = blockIdx.x * blockDim.x + threadIdx.x; if (i >= n) return;
#ifdef DUMP_NAN_ALL
    { bool bad = false; for (size_t j = (size_t)i; j < nwords; j += (size_t)n) { const unsigned x = w[j]; bad |= ((x & 0x7f80u) == 0x7f80u) || ((x & 0x7f800000u) == 0x7f800000u); } out[i] = bad ? 1e6f : 0.f; return; }
#endif
#ifdef DUMP_MASKCHECK
    { out[i] = 0.f; if ((i & 1023) == 0) { const int t = i >> 10, sq = t & 4095; const unsigned long long* mt = (const unsigned long long*)w + ((size_t)(t >> 12) * 64) * 4096 + sq; int pc = 0; bool beyond = false;
        for (int j = 0; j < 64; ++j) { const unsigned long long m = mt[(size_t)j * 4096]; pc += __popcll(m); for (int bb = 0; bb < 64; ++bb) if (((m >> bb) & 1ull) && 64 * j + bb > sq) beyond = true; }
        const int expect = sq + 1 < 256 ? sq + 1 : 256;
#if DUMP_MASKCHECK == 1
        if (pc != expect) out[i] = 1e6f;
#else
        if (beyond) out[i] = 1e6f;
#endif
      } return; }
#endif
#ifdef DUMP_NANCHECK
#if DUMP_NANCHECK == 2
    { size_t wi = (size_t)i;
#ifdef DUMP_ROWW
      wi = ((size_t)i / DUMP_COLW) * DUMP_ROWW + ((size_t)i % DUMP_COLW);
#endif
      if (wi >= nwords) { out[i] = 0.f; return; } const unsigned x = w[wi]; const bool bad = ((x & 0x7f80u) == 0x7f80u) || ((x & 0x7f800000u) == 0x7f800000u);
#ifdef DUMP_LOC
      { const int sq = (int)(wi / 512) & 4095; out[i] = bad ? 1000.f * (float)(DUMP_LOC == 1 ? sq + 1 : 4096 - sq) : 0.f; return; }
#endif
      out[i] = bad ? 1e6f : 0.f; return; }
#else
    { const float v = ((const float*)w)[i]; out[i] = (v == v && fabsf(v) < 1e30f) ? 0.f : 1e6f; return; }
#endif
#endif
#ifdef DUMP_VIA_ROWOF
    unsigned h; { const unsigned short* src = (const unsigned short*)w; const int* rowof = (const int*)((const char*)w - (size_t)(DUMP_OFF) + WS_ROUTE) + 12 * T; const int t = i >> 10, c = i & 1023;
        h = 0u; for (int k = 0; k < 4; ++k) h = h * 0x9E3779B1u + src[(size_t)rowof[4 * t + k] * 1024 + c]; }
#elif defined(DUMP_ROWW)
    unsigned h = 0u; { const size_t row = (size_t)i / DUMP_COLW, cw = (size_t)i % DUMP_COLW; if (row * DUMP_ROWW + cw < nwords) h = w[row * DUMP_ROWW + cw]; }
#else
    unsigned h = 0u; int k = 1; for (size_t j = (size_t)i; j < nwords; j += (size_t)n, k += 2) h ^= w[j] * (unsigned)k;
#endif
    out[i] = (float)((h ^ (h >> 11) ^ (h >> 22)) & 0xFFFFFu);
}
#endif
#ifndef MK_ONE_LAUNCH
#define MK_ONE_LAUNCH 0
#endif
extern "C" void kernel_launch(void* const* d_in, const int* in_sizes, int n_in, void* d_out, int out_size, void* d_ws, size_t ws_size, hipStream_t stream) {
    static int grid = 0;
    if (grid == 0) {
        if (n_in != N_IN || in_sizes[0] != T * D || out_size != T * D || ws_size < WS_END) { fprintf(stderr, "kernel_launch: unexpected shapes (n_in %d, in0 %d, out %d, ws %zu, need %zu); nothing launched\n", n_in, n_in > 0 ? in_sizes[0] : -1, out_size, ws_size, (size_t)WS_END); grid = -1; return; }
        int dev = 0, cus = 0, per_cu = 0;
        if (hipGetDevice(&dev) != hipSuccess || hipDeviceGetAttribute(&cus, hipDeviceAttributeMultiprocessorCount, dev) != hipSuccess) { grid = -1; return; }
        if (hipFuncSetAttribute((const void*)fwd_kernel, hipFuncAttributeMaxDynamicSharedMemorySize, LDS_BYTES) != hipSuccess) { fprintf(stderr, "kernel_launch: hipFuncSetAttribute failed\n"); grid = -1; return; }
        if (hipOccupancyMaxActiveBlocksPerMultiprocessor(&per_cu, (const void*)fwd_kernel, NWAVES * 64, LDS_BYTES) != hipSuccess || per_cu < 1) fprintf(stderr, "kernel_launch: occupancy query reports %d\n", per_cu);
        (void)hipGetLastError();
        grid = cus;
        if (grid != 256) { fprintf(stderr, "kernel_launch: built for 256 CUs, found %d; nothing launched\n", cus); grid = -1; return; }
    }
    if (grid < 0) return;
    if (hipMemsetAsync((char*)d_ws + WS_CTL, 0, CTL_ZERO_BYTES, stream) != hipSuccess) return;
    Args a{};
    for (int i = 0; i < N_IN; ++i) a.in[i] = (const float*)d_in[i];
    a.out = (float*)d_out; a.ws = (unsigned char*)d_ws;
#if MK_ONE_LAUNCH
    a.ph_lo = 0; a.ph_hi = N_PHASES;
    hipLaunchKernelGGL(fwd_kernel, dim3(grid), dim3(NWAVES * 64), LDS_BYTES, stream, a);
#else
#ifdef DUMP_OFF
    for (int p = 0; p < DUMP_STOP; ++p) { a.ph_lo = p; a.ph_hi = p + 1; hipLaunchKernelGGL(fwd_kernel, dim3(grid), dim3(NWAVES * 64), LDS_BYTES, stream, a); }
    hipLaunchKernelGGL(dump_kernel, dim3((T * D + 255) / 256), dim3(256), 0, stream, (const unsigned*)((const char*)d_ws + (size_t)(DUMP_OFF)), (size_t)(DUMP_WORDS), (float*)d_out, T * D);
    return;
#endif
    for (int p = 0; p < N_PHASES; ++p) { a.ph_lo = p; a.ph_hi = p + 1; hipLaunchKernelGGL(fwd_kernel, dim3(grid), dim3(NWAVES * 64), LDS_BYTES, stream, a); }
#endif
}
```

```cpp
#include <hip/hip_runtime.h>
#include <cstdio>
#include <cstdint>

#define MK_ONE_LAUNCH 1
#ifndef WT_STORES
#define WT_STORES 0
#endif
__device__ __forceinline__ void st16_wt(void* p, unsigned x, unsigned y, unsigned z, unsigned w) {
    typedef unsigned u4_ __attribute__((ext_vector_type(4))); const u4_ v = {x, y, z, w};
#if WT_STORES
    asm volatile("global_store_dwordx4 %0, %1, off sc1\n\ts_nop 2" :: "v"((__attribute__((address_space(1))) void*)p), "v"(v) : "memory");
#else
    *(__attribute__((address_space(1))) u4_*)p = v;
#endif
}
__device__ __forceinline__ void st8_wt(void* p, unsigned x, unsigned y) {
    typedef unsigned u2_ __attribute__((ext_vector_type(2))); const u2_ v = {x, y};
#if WT_STORES
    asm volatile("global_store_dwordx2 %0, %1, off sc1" :: "v"((__attribute__((address_space(1))) void*)p), "v"(v) : "memory");
#else
    *(__attribute__((address_space(1))) u2_*)p = v;
#endif
}
namespace pg8 {
#define PG8_LAS __attribute__((address_space(3)))
typedef unsigned short bf16_t;
typedef short bf16x8 __attribute__((ext_vector_type(8)));
typedef float f32x4 __attribute__((ext_vector_type(4)));
typedef unsigned u32x4 __attribute__((ext_vector_type(4)));
typedef int v4i_t __attribute__((ext_vector_type(4)));
typedef int v8i_t __attribute__((ext_vector_type(8)));
constexpr int BM = 256, BK = 64, HALF = 128, HTB = HALF * BK * 2  , STAGE_BYTES = 8 * HTB, NXCD = 8, WGM = 8;

__host__ __device__ __forceinline__ int lds_byte(int r, int c) { const int st = (r >> 4) * 2 + (c >> 5), rr = r & 15, cc = c & 31, ob = rr * 64 + cc * 2; return st * 1024 + (ob ^ (((ob >> 9) & 1) << 5)); }
__host__ __device__ __forceinline__ void stage_rc(int b, int& R, int& C) { const int st = b / 1024, sb = b % 1024, swz = sb ^ (((sb >> 9) & 1) << 5); R = (st >> 1) * 16 + swz / 64; C = (st & 1) * 32 + (swz % 64) / 2; }
__host__ __device__ __forceinline__ int perm32(int rho) { const int n = rho >> 4, i = rho & 15; return 8 * (i >> 2) + 4 * n + (i & 3); }

struct Unit { int pm, pn; };
struct Gemm { const bf16_t* A; const bf16_t* Bt; int M, N, K; };

struct StaticOrder {
    int nM, nN, nwg, G, c;
    __host__ __device__ void init(int M, int N, int G_, int c_) { nM = M / BM; nN = N / BM; nwg = nM * nN; G = G_; c = c_; }
    __host__ __device__ bool next(int i, Unit& u) const {
        const long L = (long)i * G + c; if (L >= nwg) return false;
        int wgid = (int)L; { const int q = nwg / NXCD, r = nwg % NXCD, xcd = wgid % NXCD, off = wgid / NXCD; wgid = (xcd < r ? xcd * (q + 1) : r * (q + 1) + (xcd - r) * q) + off; }
        const int nig = WGM * nN, gid = wgid / nig, fm = gid * WGM, gsz = (nM - fm) < WGM ? (nM - fm) : WGM;
        u.pm = fm + ((wgid % nig) % gsz); u.pn = (wgid % nig) / gsz; return true;
    }
    __device__ __forceinline__ void a_ready(const Unit&) const {}
    __device__ __forceinline__ void done(const Unit&) const {}
};

__device__ __forceinline__ unsigned cvt_pk_bf16(float lo, float hi) { unsigned r; asm volatile("v_cvt_pk_bf16_f32 %0, %1, %2" : "=v"(r) : "v"(lo), "v"(hi)); return r; }
typedef float f32x2 __attribute__((ext_vector_type(2)));
__device__ __forceinline__ f32x2 gelu_pk(f32x2 v) {
    const f32x2 av = __builtin_elementwise_abs(v), d = av * 0.2316418882f + 1.0f;
    f32x2 t; t.x = __builtin_amdgcn_rcpf(d.x); t.y = __builtin_amdgcn_rcpf(d.y);
    f32x2 q = t * 0.5307027145f + (-0.7265760135f); q = q * t + 0.7107068705f; q = q * t + (-0.142248368f); q = q * t + 0.127414796f; q = q * t;
    const f32x2 s = (v * v) * (-0.72134752044f);
    f32x2 e; e.x = __builtin_amdgcn_exp2f(s.x); e.y = __builtin_amdgcn_exp2f(s.y);
    const f32x2 m = v * (q * e), r = v - m;
    f32x2 o; o.x = v.x < 0.f ? m.x : r.x; o.y = v.y < 0.f ? m.y : r.y; return o;
}

template <int ACT  > struct EpiBf16 {
    static constexpr bool PERM = true, AFTER_DRAIN = false; static_assert(ACT == 0 || ACT == 1, "EpiBf16: ACT is 0 (none) or 1 (gelu_pk)");
    bf16_t* O; int ldc; const float* bias; int split_cols; size_t split_stride; float scale0;
    __device__ __forceinline__ void operator()(const f32x4 (&acc)[2][2][4][2], const Unit& u, int wr, int wc, int fr, int fq) const {
        const int row0 = u.pm * BM + wr * 64 + fr; int colt = u.pn * BM; bf16_t* base = O;
        float sc = 1.f; if (split_cols) { const int t = colt / split_cols; base += (size_t)t * split_stride; colt -= t * split_cols; if (t == 0) sc = scale0; }
        const int col0 = colt + wc * 32 + 8 * fq, bcol0 = u.pn * BM + wc * 32 + 8 * fq;
        f32x4 bv[2][2];
#pragma unroll
        for (int bj = 0; bj < 2; ++bj)
#pragma unroll
            for (int n = 0; n < 2; ++n) bv[bj][n] = bias ? *(const __attribute__((address_space(1))) f32x4*)(bias + bcol0 + bj * HALF + 4 * n) : (f32x4){0.f, 0.f, 0.f, 0.f};
#pragma unroll
        for (int ai = 0; ai < 2; ++ai)
#pragma unroll
            for (int m = 0; m < 4; ++m) { bf16_t* rowp = base + (size_t)(row0 + ai * HALF + m * 16) * ldc + col0;
#pragma unroll
                for (int bj = 0; bj < 2; ++bj) { f32x4 v0 = acc[ai][bj][m][0] + bv[bj][0], v1 = acc[ai][bj][m][1] + bv[bj][1];
                    if (ACT == 1) { f32x2 a = gelu_pk((f32x2){v0[0], v0[1]}), b = gelu_pk((f32x2){v0[2], v0[3]}), c = gelu_pk((f32x2){v1[0], v1[1]}), d = gelu_pk((f32x2){v1[2], v1[3]});
                        v0 = (f32x4){a.x, a.y, b.x, b.y}; v1 = (f32x4){c.x, c.y, d.x, d.y}; }
                    v0 = v0 * sc; v1 = v1 * sc; u32x4 w; w.x = cvt_pk_bf16(v0[0], v0[1]); w.y = cvt_pk_bf16(v0[2], v0[3]); w.z = cvt_pk_bf16(v1[0], v1[1]); w.w = cvt_pk_bf16(v1[2], v1[3]);
                    st16_wt(rowp + bj * HALF, w.x, w.y, w.z, w.w); } }
    }
};

struct PanelStats {
    unsigned* xbuf;
    unsigned* cnt;
    unsigned* tmo;
    int ntn; float eps;
    unsigned code;
    __device__ __forceinline__ bool run(const f32x4 (&v)[2][2][4][2], const Unit& u, int wr, int wc, int fr, int fq, PG8_LAS unsigned char* lds, int wid, int lane) const {
        typedef float f32x2v __attribute__((ext_vector_type(2)));
        PG8_LAS f32x2v* P = (PG8_LAS f32x2v*)lds;
        PG8_LAS f32x2v* S = (PG8_LAS f32x2v*)(lds + 8192);
        PG8_LAS unsigned* flag = (PG8_LAS unsigned*)(lds + 8192 + 2048);
#pragma unroll
        for (int ai = 0; ai < 2; ++ai)
#pragma unroll
            for (int m = 0; m < 4; ++m) {
                float s = 0.f;
#pragma unroll
                for (int bj = 0; bj < 2; ++bj)
#pragma unroll
                    for (int n = 0; n < 2; ++n) { const f32x4 x = v[ai][bj][m][n]; s += (x[0] + x[1]) + (x[2] + x[3]); }
                s += __shfl_xor(s, 16); s += __shfl_xor(s, 32);
                const float mw = s * (1.0f / 64.0f); float q = 0.f;
#pragma unroll
                for (int bj = 0; bj < 2; ++bj)
#pragma unroll
                    for (int n = 0; n < 2; ++n) { const f32x4 d = v[ai][bj][m][n] - mw; q += (d[0] * d[0] + d[1] * d[1]) + (d[2] * d[2] + d[3] * d[3]); }
                q += __shfl_xor(q, 16); q += __shfl_xor(q, 32);
                if (fq == 0) P[(ai * HALF + wr * 64 + m * 16 + fr) * 4 + wc] = (f32x2v){mw, q};
            }
        asm volatile("s_waitcnt lgkmcnt(0)" ::: "memory"); __builtin_amdgcn_s_barrier(); asm volatile("" ::: "memory");
#if defined(BROKEN_EXCHANGE_NO_WAIT)
#warning BROKEN CONTROL BUILD: the row-statistics exchange does not wait; results are wrong by design
        if (blockIdx.x >= 64) { const long long t0_ = clock64(); while (clock64() - t0_ < 60000) __builtin_amdgcn_s_sleep(8); }
#endif
        const int row = wid * 32 + (lane & 31);
        if (lane < 32) {
            const f32x2v a = P[row * 4 + 0], b = P[row * 4 + 1], c = P[row * 4 + 2], d = P[row * 4 + 3];
            const float mt = (a.x + b.x + c.x + d.x) * 0.25f;
            const float da = a.x - mt, db = b.x - mt, dc = c.x - mt, dd = d.x - mt;
            const float m2 = (a.y + b.y) + (c.y + d.y) + 64.0f * ((da * da + db * db) + (dc * dc + dd * dd));
            unsigned long long* slot = (unsigned long long*)xbuf + ((size_t)(u.pm * BM + row) * 4 + u.pn);
            __hip_atomic_store(slot, ((unsigned long long)__float_as_uint(m2) << 32) | __float_as_uint(mt), __ATOMIC_RELAXED, __HIP_MEMORY_SCOPE_AGENT);
        }
        asm volatile("s_waitcnt vmcnt(0)" ::: "memory");
        if (lane == 0) __hip_atomic_fetch_add(cnt + 64 * u.pm, 1u, __ATOMIC_RELAXED, __HIP_MEMORY_SCOPE_AGENT);
        if (wid == 0) {
            bool dead = false; const unsigned long long t0 = __builtin_amdgcn_s_memrealtime(); const unsigned want = 8u * (unsigned)ntn;
            for (;;) {
#if defined(BROKEN_EXCHANGE_NO_WAIT)
                break;
#endif
                if ((unsigned)__builtin_amdgcn_readfirstlane(__hip_atomic_load(cnt + 64 * u.pm, __ATOMIC_RELAXED, __HIP_MEMORY_SCOPE_AGENT)) >= want) break;
                if (__builtin_amdgcn_s_memrealtime() - t0 > 2000000ull) {
                    if (lane == 0) { unsigned expect = 0u; __hip_atomic_compare_exchange_strong(tmo + 1, &expect, code | (unsigned)(u.pm & 0xff), __ATOMIC_RELAXED, __ATOMIC_RELAXED, __HIP_MEMORY_SCOPE_AGENT);
                                     __hip_atomic_store(tmo, 1u, __ATOMIC_RELAXED, __HIP_MEMORY_SCOPE_AGENT); }
                    dead = true; break; }
                __builtin_amdgcn_s_sleep(2);
            }
            __builtin_amdgcn_fence(__ATOMIC_ACQUIRE, "agent");
            if (lane == 0) flag[0] = dead ? 1u : 0u;
        }
        asm volatile("s_waitcnt vmcnt(0) lgkmcnt(0)" ::: "memory"); __builtin_amdgcn_s_barrier(); asm volatile("" ::: "memory");
        const bool bad = flag[0] != 0u;
        if (lane < 32) {
            const unsigned long long* slot = (const unsigned long long*)xbuf + (size_t)(u.pm * BM + row) * 4; float mt[4], m2[4]; float ms = 0.f;
#pragma unroll
            for (int t = 0; t < 4; ++t) { if (t < ntn) { const unsigned long long w = __hip_atomic_load(slot + t, __ATOMIC_RELAXED, __HIP_MEMORY_SCOPE_AGENT); mt[t] = __uint_as_float((unsigned)w); m2[t] = __uint_as_float((unsigned)(w >> 32)); } else { mt[t] = 0.f; m2[t] = 0.f; } ms += mt[t]; }
            const float mean = ms / (float)ntn; float q = 0.f;
#pragma unroll
            for (int t = 0; t < 4; ++t) if (t < ntn) { const float dm = mt[t] - mean; q += m2[t] + 256.0f * dm * dm; }
            S[row] = (f32x2v){mean, 1.0f / sqrtf(q / (256.0f * (float)ntn) + eps)};
        }
        asm volatile("s_waitcnt lgkmcnt(0)" ::: "memory"); __builtin_amdgcn_s_barrier(); asm volatile("" ::: "memory");
        return bad;
    }
};
struct EpiLnRes {
    static constexpr bool PERM = false, AFTER_DRAIN = true;
    const float* base; float* out; int ldc; const float* bias; PanelStats st; unsigned poison;
    __device__ __forceinline__ void fused(f32x4 (&acc)[2][2][4][2], const Unit& u, int wr, int wc, int fr, int fq, PG8_LAS unsigned char* lds, int wid, int lane) const {
        typedef float f32x2v __attribute__((ext_vector_type(2)));
        const PG8_LAS f32x2v* S = (const PG8_LAS f32x2v*)(lds + 8192);
        const int col0 = u.pn * BM + wc * 32 + 4 * fq;
#pragma unroll
        for (int bj = 0; bj < 2; ++bj)
#pragma unroll
            for (int n = 0; n < 2; ++n) { const f32x4 bv = bias ? *(const f32x4*)(bias + col0 + bj * HALF + n * 16) : (f32x4){0.f, 0.f, 0.f, 0.f};
#pragma unroll
                for (int ai = 0; ai < 2; ++ai)
#pragma unroll
                    for (int m = 0; m < 4; ++m) acc[ai][bj][m][n] += bv; }
        f32x4 pre[4][2][2];
#pragma unroll
        for (int m = 0; m < 4; ++m) { const size_t off = (size_t)(u.pm * BM + wr * 64 + m * 16 + fr) * ldc + col0;
#pragma unroll
            for (int bj = 0; bj < 2; ++bj)
#pragma unroll
                for (int n = 0; n < 2; ++n) pre[m][bj][n] = *(const f32x4*)(base + off + bj * HALF + n * 16); }
        const bool bad = st.run(acc, u, wr, wc, fr, fq, lds, wid, lane) || poison != 0u;
        const float qnan = __builtin_nanf("");
#pragma unroll
        for (int ai = 0; ai < 2; ++ai)
#pragma unroll
            for (int m = 0; m < 4; ++m) { const int r = ai * HALF + wr * 64 + m * 16 + fr; const f32x2v sr = S[r]; const size_t off = (size_t)(u.pm * BM + r) * ldc + col0;
#pragma unroll
                for (int bj = 0; bj < 2; ++bj)
#pragma unroll
                    for (int n = 0; n < 2; ++n) { const f32x4 bs = ai == 0 ? pre[m][bj][n] : *(const f32x4*)(base + off + bj * HALF + n * 16); f32x4 o = bs + (acc[ai][bj][m][n] - sr.x) * sr.y;
                        if (bad) o = (f32x4){qnan, qnan, qnan, qnan}; *(f32x4*)(out + off + bj * HALF + n * 16) = o; }
                if (m & 1) asm volatile("" ::: "memory"); }
    }
};
struct EpiLnResLn {
    static constexpr bool PERM = false, AFTER_DRAIN = true;
    const float* base; float* out; bf16_t* xn; int ldc; const float* bias; PanelStats st1, st2; unsigned poison;
    __device__ __forceinline__ void fused(f32x4 (&acc)[2][2][4][2], const Unit& u, int wr, int wc, int fr, int fq, PG8_LAS unsigned char* lds, int wid, int lane) const {
        typedef float f32x2v __attribute__((ext_vector_type(2))); typedef unsigned u32x2v __attribute__((ext_vector_type(2)));
        const PG8_LAS f32x2v* S = (const PG8_LAS f32x2v*)(lds + 8192);
        const int col0 = u.pn * BM + wc * 32 + 4 * fq;
#pragma unroll
        for (int bj = 0; bj < 2; ++bj)
#pragma unroll
            for (int n = 0; n < 2; ++n) { const f32x4 bv = bias ? *(const f32x4*)(bias + col0 + bj * HALF + n * 16) : (f32x4){0.f, 0.f, 0.f, 0.f};
#pragma unroll
                for (int ai = 0; ai < 2; ++ai)
#pragma unroll
                    for (int m = 0; m < 4; ++m) acc[ai][bj][m][n] += bv; }
        bool bad = st1.run(acc, u, wr, wc, fr, fq, lds, wid, lane) || poison != 0u;
        const float qnan = __builtin_nanf("");
#pragma unroll
        for (int ai = 0; ai < 2; ++ai)
#pragma unroll
            for (int m = 0; m < 4; ++m) { const int r = ai * HALF + wr * 64 + m * 16 + fr; const f32x2v sr = S[r]; const size_t off = (size_t)(u.pm * BM + r) * ldc + col0;
#pragma unroll
                for (int bj = 0; bj < 2; ++bj)
#pragma unroll
                    for (int n = 0; n < 2; ++n) { const f32x4 bs = *(const f32x4*)(base + off + bj * HALF + n * 16); acc[ai][bj][m][n] = bs + (acc[ai][bj][m][n] - sr.x) * sr.y; }
                asm volatile("" : "+v"(acc[ai][0][m][0]), "+v"(acc[ai][0][m][1]), "+v"(acc[ai][1][m][0]), "+v"(acc[ai][1][m][1]));
                if (m & 1) asm volatile("" ::: "memory"); }
        const bool bad1 = bad;
        bad = st2.run(acc, u, wr, wc, fr, fq, lds, wid, lane) || bad;
#pragma unroll
        for (int ai = 0; ai < 2; ++ai)
#pragma unroll
            for (int m = 0; m < 4; ++m) { const int r = ai * HALF + wr * 64 + m * 16 + fr; const f32x2v sr = S[r]; const size_t off = (size_t)(u.pm * BM + r) * ldc + col0;
#pragma unroll
                for (int bj = 0; bj < 2; ++bj)
#pragma unroll
                    for (int n = 0; n < 2; ++n) { const f32x4 x1 = acc[ai][bj][m][n]; *(f32x4*)(out + off + bj * HALF + n * 16) = bad1 ? (f32x4){qnan, qnan, qnan, qnan} : x1;
                        const f32x4 o = (x1 - sr.x) * sr.y; u32x2v w; w.x = cvt_pk_bf16(o[0], o[1]); w.y = cvt_pk_bf16(o[2], o[3]);
                        if (bad) { w.x = 0x7fc07fc0u; w.y = 0x7fc07fc0u; } *(u32x2v*)(xn + off + bj * HALF + n * 16) = w; }
                asm volatile("" ::: "memory"); }
    }
};

__device__ __forceinline__ void glds_saddr(unsigned voff, const char* sbase, unsigned lds_dst) { unsigned keep;
    asm volatile("s_mov_b32 %0, m0\n\ts_mov_b32 m0, %3\n\ts_nop 0\n\tglobal_load_lds_dwordx4 %1, %2\n\ts_mov_b32 m0, %0" : "=&s"(keep) : "v"(voff), "s"(sbase), "s"(lds_dst) : "memory"); }
template <class Epi, class Sched, bool ALIGN_EPI = false, bool SP2 = false, int EB = 2, bool GATHER = false>
__device__ __forceinline__ void gemm_phase(PG8_LAS unsigned char* lds, const Gemm g, const Sched& S, const Epi& E, const int* rowtok = nullptr) {
    static_assert(!GATHER || (EB == 1 && SP2), "gathered A rows: fp8 path (SGPR-base staging) with the two-super-phase loop only");
    const int tid = threadIdx.x, wid = __builtin_amdgcn_readfirstlane(tid >> 6), lane = tid & 63, wr = wid >> 2, wc = wid & 3, fr = lane & 15, fq = lane >> 4;
    const int K = g.K, nt = K * EB / (BK * 2);
    unsigned voffA[2], voffB[2]; int gR[2]; unsigned gC[2];
#pragma unroll
    for (int i = 0; i < 2; ++i) { int R, C; stage_rc(tid * 16 + i * 8192, R, C); const int Rb = Epi::PERM ? ((R & ~31) + perm32(R & 31)) : R;
        voffA[i] = (unsigned)(R * K * EB + C * 2); voffB[i] = (unsigned)(Rb * K * EB + C * 2); gR[i] = R; gC[i] = (unsigned)(C * 2); }
    const size_t kstep = (size_t)(BK * 2);
    const size_t hstep = (size_t)HALF * K * EB;
    const size_t tstep = 2 * hstep;
    const unsigned ldsw = (unsigned)wid * 1024u; const unsigned lds0 = (unsigned)(uintptr_t)lds;
    const int aoff = lds_byte(wr * 64 + fr, fq * 8), boff = lds_byte(wc * 32 + fr, fq * 8);
#define PG8_SA(b, h) (((b) * 2 + (h)) * HTB)
#define PG8_SB(b, h) ((4 + (b) * 2 + (h)) * HTB)
#define PG8_STAGE(bufoff, gbase, voff) do { if constexpr (EB == 2) { _Pragma("unroll") for (int _i = 0; _i < 2; ++_i) \
        __builtin_amdgcn_global_load_lds((const unsigned*)((const char*)(gbase) + (voff)[_i]), (PG8_LAS unsigned*)(lds + (bufoff) + ldsw + _i * 8192), 16, 0, 0); } \
        else { _Pragma("unroll") for (int _i = 0; _i < 2; ++_i) glds_saddr((voff)[_i], (const char*)(gbase), (unsigned)__builtin_amdgcn_readfirstlane((int)(lds0 + (unsigned)(bufoff) + ldsw + (unsigned)(_i * 8192)))); } } while (0)
#define PG8_GLOAD(vo, u) do { _Pragma("unroll") for (int _h = 0; _h < 2; ++_h) _Pragma("unroll") for (int _i = 0; _i < 2; ++_i) vo[_h][_i] = (unsigned)rowtok[(size_t)(u).pm * BM + _h * HALF + gR[_i]] * (unsigned)(K * EB) + gC[_i]; } while (0)
#define PG8_STAGE_A(bufoff, pplain, kofs, h, VS) do { if constexpr (!GATHER) { PG8_STAGE(bufoff, pplain, voffA); } else { _Pragma("unroll") for (int _i = 0; _i < 2; ++_i) \
        glds_saddr(VS[h][_i], (const char*)g.A + (kofs), (unsigned)__builtin_amdgcn_readfirstlane((int)(lds0 + (unsigned)(bufoff) + ldsw + (unsigned)(_i * 8192)))); } } while (0)
#define PG8_LD8(p) __builtin_shufflevector(*(const PG8_LAS v4i_t*)(p), *(const PG8_LAS v4i_t*)((p) + 1024), 0, 1, 2, 3, 4, 5, 6, 7)
#define PG8_LDA(dst, b, h) do { if constexpr (EB == 2) { _Pragma("unroll") for (int m = 0; m < 4; ++m) _Pragma("unroll") for (int k = 0; k < 2; ++k) dst[m][k] = *(const PG8_LAS bf16x8*)(lds + PG8_SA(b, h) + aoff + m * 2048 + k * 1024); } \
        else { _Pragma("unroll") for (int m = 0; m < 4; ++m) dst##8[m] = PG8_LD8(lds + PG8_SA(b, h) + aoff + m * 2048); } } while (0)
#define PG8_LDB(dst, b, h) do { if constexpr (EB == 2) { _Pragma("unroll") for (int n = 0; n < 2; ++n) _Pragma("unroll") for (int k = 0; k < 2; ++k) dst[n][k] = *(const PG8_LAS bf16x8*)(lds + PG8_SB(b, h) + boff + n * 2048 + k * 1024); } \
        else { _Pragma("unroll") for (int n = 0; n < 2; ++n) dst##8[n] = PG8_LD8(lds + PG8_SB(b, h) + boff + n * 2048); } } while (0)
#define PG8_CAT8(x, y) __builtin_shufflevector(__builtin_bit_cast(v4i_t, x), __builtin_bit_cast(v4i_t, y), 0, 1, 2, 3, 4, 5, 6, 7)
#define PG8_MMA(ai, bj, At, Bt) do { __builtin_amdgcn_s_setprio(1); if constexpr (EB == 2) { _Pragma("unroll") for (int m = 0; m < 4; ++m) _Pragma("unroll") for (int n = 0; n < 2; ++n) _Pragma("unroll") for (int k = 0; k < 2; ++k) \
        acc[ai][bj][m][n] = __builtin_amdgcn_mfma_f32_16x16x32_bf16(Bt[n][k], At[m][k], acc[ai][bj][m][n], 0, 0, 0); } else { _Pragma("unroll") for (int m = 0; m < 4; ++m) _Pragma("unroll") for (int n = 0; n < 2; ++n) \
        asm volatile("v_mfma_scale_f32_16x16x128_f8f6f4 %0, %1, %2, %0, %3, %3 op_sel_hi:[0,0,0]" : "+v"(acc[ai][bj][m][n]) : "v"(Bt##8[n]), "v"(At##8[m]), "v"(mx_one)); }     __builtin_amdgcn_s_setprio(0); } while (0)
#define PG8_WAIT_V(n) asm volatile("s_waitcnt vmcnt(" #n ")" ::: "memory")
#define PG8_WAIT_L(n) asm volatile("s_waitcnt lgkmcnt(" #n ")" ::: "memory")
#define PG8_BAR __builtin_amdgcn_s_barrier()
#define PG8_SCHED __builtin_amdgcn_sched_barrier(0)
    Unit cur, nxt; int ui = 0;
    if (!S.next(0, cur)) return;
    f32x4 acc[2][2][4][2];
#pragma unroll
    for (int a = 0; a < 2; ++a)
#pragma unroll
        for (int b = 0; b < 2; ++b)
#pragma unroll
            for (int m = 0; m < 4; ++m)
#pragma unroll
                for (int n = 0; n < 2; ++n) acc[a][b][m][n] = (f32x4){0.f, 0.f, 0.f, 0.f};
    const int mx_one = 0x7f7f7f7f;
    bf16x8 At[4][2], B0[2][2], B1[2][2]; v8i_t At8[4], B08[2], B18[2];
    const char* cA = (const char*)g.A + (size_t)cur.pm * tstep; const char* cB = (const char*)g.Bt + (size_t)cur.pn * tstep;
    S.a_ready(cur);
    unsigned voffC[2][2], voffN[2][2];
    if constexpr (GATHER) PG8_GLOAD(voffC, cur);
    if constexpr (SP2) {
        PG8_STAGE(PG8_SB(0, 0), cB, voffB); PG8_STAGE(PG8_SB(0, 1), cB + hstep, voffB); PG8_STAGE_A(PG8_SA(0, 0), cA, 0, 0, voffC); PG8_STAGE_A(PG8_SA(0, 1), cA + hstep, 0, 1, voffC);
        if (wr == 1) PG8_BAR;
        PG8_WAIT_V(2); PG8_BAR;
        PG8_STAGE(PG8_SB(1, 0), cB + kstep, voffB); PG8_STAGE_A(PG8_SA(1, 0), cA + kstep, kstep, 0, voffC); PG8_STAGE(PG8_SB(1, 1), cB + hstep + kstep, voffB);
        PG8_WAIT_V(6); PG8_BAR;
    } else {
        PG8_STAGE(PG8_SB(0, 0), cB, voffB); PG8_STAGE(PG8_SA(0, 0), cA, voffA); PG8_STAGE(PG8_SB(0, 1), cB + hstep, voffB); PG8_STAGE(PG8_SA(0, 1), cA + hstep, voffA);
        if (wr == 1) PG8_BAR;
        PG8_WAIT_V(4); PG8_BAR;
        PG8_STAGE(PG8_SB(1, 0), cB + kstep, voffB); PG8_STAGE(PG8_SA(1, 0), cA + kstep, voffA); PG8_STAGE(PG8_SB(1, 1), cB + hstep + kstep, voffB);
        PG8_WAIT_V(6); PG8_BAR;
    }
    for (;;) {
        const bool has_next = S.next(ui + 1, nxt);
        if constexpr (GATHER) { if (has_next) PG8_GLOAD(voffN, nxt); else { _Pragma("unroll") for (int _h = 0; _h < 2; ++_h) _Pragma("unroll") for (int _i = 0; _i < 2; ++_i) voffN[_h][_i] = voffC[_h][_i]; } }
        const char* nA = has_next ? (const char*)g.A + (size_t)nxt.pm * tstep : cA; const char* nB = has_next ? (const char*)g.Bt + (size_t)nxt.pn * tstep : cB;
#pragma nounroll
        for (int t = 0; t < nt; t += 2) {
            const bool last = (t == nt - 2);
            const char* a1 = cA + (size_t)(t + 1) * kstep;
            const char* a2 = last ? nA : cA + (size_t)(t + 2) * kstep; const char* b2 = last ? nB : cB + (size_t)(t + 2) * kstep;
            const char* a3 = a2 + kstep; const char* b3 = b2 + kstep;
            const size_t k2 = last ? (size_t)0 : (size_t)(t + 2) * kstep; unsigned voffS[2][2];
            if constexpr (GATHER) { _Pragma("unroll") for (int _h = 0; _h < 2; ++_h) _Pragma("unroll") for (int _i = 0; _i < 2; ++_i) voffS[_h][_i] = last ? voffN[_h][_i] : voffC[_h][_i]; }
            if (last && has_next) S.a_ready(nxt);
            if constexpr (SP2) {
            PG8_LDB(B0, 0, 0); PG8_LDB(B1, 0, 1); PG8_SCHED; PG8_LDA(At, 0, 0); PG8_STAGE_A(PG8_SA(1, 1), a1 + hstep, (size_t)(t + 1) * kstep, 1, voffC);
            PG8_WAIT_V(8); PG8_WAIT_L(0); PG8_BAR; PG8_MMA(0, 0, At, B0); PG8_MMA(0, 1, At, B1); PG8_BAR; PG8_SCHED;
            PG8_LDA(At, 0, 1); PG8_STAGE(PG8_SB(0, 0), b2, voffB); PG8_STAGE(PG8_SB(0, 1), b2 + hstep, voffB); PG8_STAGE_A(PG8_SA(0, 0), a2, k2, 0, voffS);
            PG8_WAIT_V(8); PG8_WAIT_L(0); PG8_BAR; PG8_MMA(1, 0, At, B0); PG8_MMA(1, 1, At, B1); PG8_BAR; PG8_SCHED;
            PG8_LDB(B0, 1, 0); PG8_LDB(B1, 1, 1); PG8_SCHED; PG8_LDA(At, 1, 0); PG8_STAGE_A(PG8_SA(0, 1), a2 + hstep, k2, 1, voffS);
            PG8_WAIT_V(8); PG8_WAIT_L(0); PG8_BAR; PG8_MMA(0, 0, At, B0); PG8_MMA(0, 1, At, B1); PG8_BAR; PG8_SCHED;
            PG8_LDA(At, 1, 1); PG8_STAGE(PG8_SB(1, 0), b3, voffB); PG8_STAGE(PG8_SB(1, 1), b3 + hstep, voffB); PG8_STAGE_A(PG8_SA(1, 0), a3, k2 + kstep, 0, voffS);
            PG8_WAIT_V(8); PG8_WAIT_L(0); PG8_BAR; PG8_MMA(1, 0, At, B0); PG8_MMA(1, 1, At, B1); PG8_BAR; PG8_SCHED;
            } else {
            PG8_LDB(B0, 0, 0); PG8_SCHED; PG8_LDA(At, 0, 0); PG8_STAGE(PG8_SA(1, 1), a1 + hstep, voffA);
            PG8_WAIT_L(8); PG8_BAR; PG8_WAIT_L(0); PG8_MMA(0, 0, At, B0); PG8_BAR; PG8_SCHED;
            PG8_LDB(B1, 0, 1); PG8_STAGE(PG8_SB(0, 0), b2, voffB);
            PG8_BAR; PG8_WAIT_L(0); PG8_MMA(0, 1, At, B1); PG8_BAR;
            PG8_LDA(At, 0, 1); PG8_STAGE(PG8_SA(0, 0), a2, voffA);
            PG8_BAR; PG8_WAIT_L(0); PG8_MMA(1, 0, At, B0); PG8_BAR; PG8_SCHED;
            PG8_STAGE(PG8_SB(0, 1), b2 + hstep, voffB);
            PG8_WAIT_V(6); PG8_BAR; PG8_MMA(1, 1, At, B1); PG8_BAR;
            PG8_LDB(B0, 1, 0); PG8_SCHED; PG8_LDA(At, 1, 0); PG8_STAGE(PG8_SA(0, 1), a2 + hstep, voffA);
            PG8_WAIT_L(8); PG8_BAR; PG8_WAIT_L(0); PG8_MMA(0, 0, At, B0); PG8_BAR; PG8_SCHED;
            PG8_LDB(B1, 1, 1); PG8_STAGE(PG8_SB(1, 0), b3, voffB);
            PG8_BAR; PG8_WAIT_L(0); PG8_MMA(0, 1, At, B1); PG8_BAR;
            PG8_LDA(At, 1, 1); PG8_STAGE(PG8_SA(1, 0), a3, voffA);
            PG8_BAR; PG8_WAIT_L(0); PG8_MMA(1, 0, At, B0); PG8_BAR; PG8_SCHED;
            PG8_STAGE(PG8_SB(1, 1), b3 + hstep, voffB);
            PG8_WAIT_V(6); PG8_BAR; PG8_MMA(1, 1, At, B1); PG8_BAR;
            }
        }
        if constexpr (ALIGN_EPI) { if (wr == 0) PG8_BAR; }
        if constexpr (EB == 1) asm volatile("s_nop 15\n\ts_nop 15" ::: "memory");
        if constexpr (!Epi::AFTER_DRAIN) { E(acc, cur, wr, wc, fr, fq); S.done(cur); }
        if (!has_next) break;
#pragma unroll
        for (int a = 0; a < 2; ++a)
#pragma unroll
            for (int b = 0; b < 2; ++b)
#pragma unroll
                for (int m = 0; m < 4; ++m)
#pragma unroll
                    for (int n = 0; n < 2; ++n) acc[a][b][m][n] = (f32x4){0.f, 0.f, 0.f, 0.f};
        cur = nxt; cA = nA; cB = nB; ++ui;
        if constexpr (GATHER) { _Pragma("unroll") for (int _h = 0; _h < 2; ++_h) _Pragma("unroll") for (int _i = 0; _i < 2; ++_i) voffC[_h][_i] = voffN[_h][_i]; }
        if constexpr (ALIGN_EPI) { if (wr == 1) PG8_BAR; }
    }
    PG8_WAIT_V(0);
    if constexpr (!ALIGN_EPI) { if (wr == 0) PG8_BAR; }
    PG8_BAR;
    if constexpr (Epi::AFTER_DRAIN) { E.fused(acc, cur, wr, wc, fr, fq, lds, wid, lane); S.done(cur); }
#undef PG8_SA
#undef PG8_SB
#undef PG8_STAGE
#undef PG8_LDA
#undef PG8_GLOAD
#undef PG8_STAGE_A
#undef PG8_LD8
#undef PG8_LDB
#undef PG8_MMA
#undef PG8_CAT8
#undef PG8_WAIT_V
#undef PG8_WAIT_L
#undef PG8_BAR
#undef PG8_SCHED
}
}
#ifndef PG8_SP2
#define PG8_SP2 true
#endif
#ifndef MOE_SP2
#define MOE_SP2 true
#endif
#ifndef PG8_ALIGN
#define PG8_ALIGN true
#endif
constexpr int NWAVES = 8;
constexpr int NB = 4, SEQ = 4096, T = NB * SEQ, D = 1024, NIN = 2856, NINP = 3072, NE = 32, DEPTH = 2;
constexpr int C_H = 0, C_GB = 256, C_GC = 512, C_P = 768, C_Q = 1024, C_K = 1536, C_V = 2048, C_QI = 2560, C_KI = 2816, C_WI = 2848;
constexpr int NSEL = 256;
#ifndef SEL_CAND_CAP
#define SEL_CAND_CAP 64
#endif
constexpr int MAXROWS = 4 * T + NE * 256;
constexpr float ATT_C2 = 0.125f * 1.4426950408889634f;
constexpr float LN_EPS = 1e-5f, DN_ALPHA = 1.41421356237309515f;
enum { IN_X = 0, IN_WIN, IN_CONVW, IN_WPOOL, IN_PSCALE, IN_KNG, IN_KNB, IN_WOUT, IN_LN1G, IN_LN1B, IN_RW, IN_RB, IN_WGU, IN_BGU, IN_WDN, IN_BDN, IN_LN2G, IN_LN2B, N_IN };

constexpr size_t MiB = 1u << 20;
constexpr size_t WS_CTL = 0, CTL_ZERO_BYTES = 32768;
constexpr size_t WS_WIN = 2 * MiB;
constexpr size_t WS_WOUT = 14 * MiB;
constexpr size_t WS_WGU = 18 * MiB;
constexpr size_t WS_WDN = 274 * MiB;
constexpr size_t WS_XB = 402 * MiB;
constexpr size_t WS_XF = 434 * MiB;
constexpr size_t WS_Y1 = 498 * MiB;
constexpr size_t WS_PROJ = 562 * MiB;
constexpr size_t WS_CAT = 658 * MiB;
constexpr size_t WS_KIN = 690 * MiB;
constexpr size_t WS_MASK = 691 * MiB;
constexpr size_t WS_ROUTE = 699 * MiB;
constexpr size_t WS_CNTW = 699 * MiB + 256 * 1024;
constexpr size_t WS_SC = 700 * MiB;
constexpr size_t WS_XS = 956 * MiB;
constexpr size_t WS_ACT = 1100 * MiB;
constexpr size_t WS_YS = 1244 * MiB;
constexpr size_t WS_XB8 = 1388 * MiB;
constexpr size_t WS_END = 1404 * MiB;
constexpr int CW_TMO = 0;
constexpr int CW_CNT = 1024;
constexpr int CW_BAR = 4096;
constexpr int RING_BYTES = 131072;
constexpr int TAB_OFF = RING_BYTES;
constexpr int MISC_OFF = RING_BYTES + 1024;
constexpr int LDS_BYTES = 147456;

#define GAS __attribute__((address_space(1)))
#define LAS __attribute__((address_space(3)))
typedef unsigned short bf16;
typedef unsigned v4u __attribute__((ext_vector_type(4)));
typedef unsigned v2u __attribute__((ext_vector_type(2)));
typedef float f32x4 __attribute__((ext_vector_type(4)));
typedef short bf16x8 __attribute__((ext_vector_type(8)));
typedef GAS unsigned gu32;
typedef unsigned long long u64;
#define RLX_AGENT __ATOMIC_RELAXED, __HIP_MEMORY_SCOPE_AGENT
#define LDS_WAIT() asm volatile("s_waitcnt lgkmcnt(0)" ::: "memory")
#define VM_WAIT() asm volatile("s_waitcnt vmcnt(0)" ::: "memory")
__device__ __forceinline__ unsigned f2bf(float f) { unsigned u = __builtin_bit_cast(unsigned, f); return (u + 0x7fffu + ((u >> 16) & 1u)) >> 16; }
__device__ __forceinline__ unsigned pk2(float lo, float hi) { return f2bf(lo) | (f2bf(hi) << 16); }
__device__ __forceinline__ unsigned pk4_fp8(float a, float b, float c, float d) { int w = 0; w = __builtin_amdgcn_cvt_pk_fp8_f32(a, b, w, false); w = __builtin_amdgcn_cvt_pk_fp8_f32(c, d, w, true); return (unsigned)w; }
constexpr float WGU_SCALE = 32.f, WDN_SCALE = 64.f;
__device__ __forceinline__ float bf2f(bf16 v) { return __builtin_bit_cast(float, (unsigned)v << 16); }
__device__ __forceinline__ float bflo(unsigned w) { return __builtin_bit_cast(float, w << 16); }
__device__ __forceinline__ float bfhi(unsigned w) { return __builtin_bit_cast(float, w & 0xffff0000u); }
template <int CTRL> __device__ __forceinline__ float dppx(float v) { return __builtin_bit_cast(float, __builtin_amdgcn_update_dpp(0, __builtin_bit_cast(int, v), CTRL, 0xf, 0xf, false)); }
__device__ __forceinline__ float wave_sum(float v) {
    v += dppx<0xB1>(v); v += dppx<0x4E>(v); v += dppx<0x141>(v); v += dppx<0x140>(v);
    const float a = __builtin_bit_cast(float, __builtin_amdgcn_readlane(__builtin_bit_cast(int, v), 0)), b = __builtin_bit_cast(float, __builtin_amdgcn_readlane(__builtin_bit_cast(int, v), 16));
    const float c = __builtin_bit_cast(float, __builtin_amdgcn_readlane(__builtin_bit_cast(int, v), 32)), d = __builtin_bit_cast(float, __builtin_amdgcn_readlane(__builtin_bit_cast(int, v), 48));
    return (a + b) + (c + d);
}
__device__ __forceinline__ float wave_max(float v) {
#pragma unroll
    for (int o = 1; o < 64; o <<= 1) v = fmaxf(v, __shfl_xor(v, o));
    return v;
}
__device__ __forceinline__ float wave_max_dpp(float v) {
    v = fmaxf(v, dppx<0xB1>(v)); v = fmaxf(v, dppx<0x4E>(v)); v = fmaxf(v, dppx<0x141>(v)); v = fmaxf(v, dppx<0x140>(v));
    const float a = __builtin_bit_cast(float, __builtin_amdgcn_readlane(__builtin_bit_cast(int, v), 0)), b = __builtin_bit_cast(float, __builtin_amdgcn_readlane(__builtin_bit_cast(int, v), 16));
    const float c = __builtin_bit_cast(float, __builtin_amdgcn_readlane(__builtin_bit_cast(int, v), 32)), d = __builtin_bit_cast(float, __builtin_amdgcn_readlane(__builtin_bit_cast(int, v), 48));
    return fmaxf(fmaxf(a, b), fmaxf(c, d));
}
__device__ __forceinline__ float sum32(float v) {
#pragma unroll
    for (int o = 1; o < 32; o <<= 1) v += __shfl_xor(v, o);
    return v;
}
#define XB_TMO      128
#define XB_XCNT(j)  (256  + 64 * (j))
#define XB_XSUB(j)  (1280 + 64 * (j))
#define XB_XGEN(j)  (2304 + 64 * (j))
#define XB_TOP      3328
#define XB_TOPGEN   3392
#define XCD_BAR_WORDS 3456
#define XB_SPIN_CAP (1u << 18)

__device__ __forceinline__ unsigned xb_ld(unsigned* p)              { return __hip_atomic_load(p, __ATOMIC_RELAXED, __HIP_MEMORY_SCOPE_AGENT); }
__device__ __forceinline__ unsigned xb_add(unsigned* p, unsigned v) { return __hip_atomic_fetch_add(p, v, __ATOMIC_RELAXED, __HIP_MEMORY_SCOPE_AGENT); }
__device__ __forceinline__ unsigned xb_xcc_id() { return (unsigned)__builtin_amdgcn_s_getreg((3 << 11) | 20) & 0xFu; }
#define XB_SPIN(cond, bar) do { unsigned _sp = 0; while (cond) { __builtin_amdgcn_s_sleep(1); \
    if ((++_sp & 255u) == 0u) { if (xb_ld(&(bar)[XB_TMO])) break; if (_sp > XB_SPIN_CAP) { atomicAdd(&(bar)[XB_TMO], 1u); break; } } } } while (0)

struct XcdBarrier {
    unsigned* bar; unsigned x;
    volatile LAS unsigned* st;
};

__device__ __forceinline__ XcdBarrier xcd_barrier_post(unsigned* bar, volatile LAS unsigned* st) {
    XcdBarrier b; b.bar = bar; b.x = xb_xcc_id(); b.st = st;
    if (threadIdx.x == 0) (void)xb_add(&bar[XB_XCNT(b.x)], 1u);
    return b;
}
__device__ __forceinline__ void xcd_barrier_complete(unsigned* bar, unsigned x, unsigned& nloc, unsigned& nx) {
    const unsigned G = gridDim.x * gridDim.y * gridDim.z;
    unsigned sum, cnt, mine, sp = 0u;
    for (;;) {
        sum = 0u; cnt = 0u; mine = 0u;
#pragma unroll
        for (unsigned j = 0; j < 16; ++j) { const unsigned c = xb_ld(&bar[XB_XCNT(j)]); sum += c; cnt += (c > 0u) ? 1u : 0u; mine = (j == x) ? c : mine; }
        if (sum == G) break;
        __builtin_amdgcn_s_sleep(1);
        if ((++sp & 255u) == 0u) { if (xb_ld(&bar[XB_TMO])) break; if (sp > XB_SPIN_CAP) { atomicAdd(&bar[XB_TMO], 1u); break; } }
    }
    nloc = mine > 0u ? mine : 1u; nx = cnt > 0u ? cnt : 1u;
}

__device__ __forceinline__ void xcd_barrier(const XcdBarrier& b) {
    asm volatile("s_waitcnt vmcnt(0)" ::: "memory");
    __syncthreads();
    if (threadIdx.x == 0) {
        unsigned* bar = b.bar;
        __builtin_amdgcn_s_waitcnt(0);
        unsigned nloc = b.st[0], nx = b.st[1];
        if (nloc == 0u) { xcd_barrier_complete(bar, b.x, nloc, nx); b.st[0] = nloc; b.st[1] = nx; }
        const unsigned old = xb_add(&bar[XB_XSUB(b.x)], 1u);
        const unsigned gen = old / nloc;
        if (old + 1u == (gen + 1u) * nloc) {
            __builtin_amdgcn_fence(__ATOMIC_RELEASE, "agent");
            asm volatile("s_waitcnt vmcnt(0)" ::: "memory");
            const unsigned og = xb_add(&bar[XB_TOP], 1u);
            const unsigned tg = og / nx;
            if (og + 1u == (tg + 1u) * nx) xb_add(&bar[XB_TOPGEN], 1u);
            else XB_SPIN(xb_ld(&bar[XB_TOPGEN]) == tg, bar);
            __builtin_amdgcn_fence(__ATOMIC_ACQUIRE, "agent");
            xb_add(&bar[XB_XGEN(b.x)], 1u);
            asm volatile("s_waitcnt vmcnt(0)" ::: "memory");
        } else {
            XB_SPIN(xb_ld(&bar[XB_XGEN(b.x)]) == gen, bar);
            __builtin_amdgcn_fence(__ATOMIC_ACQUIRE, "agent");
            asm volatile("s_waitcnt vmcnt(0)" ::: "memory");
        }
    }
    __syncthreads();
}
struct Args { const float* in[N_IN]; float* out; unsigned char* ws; int ph_lo, ph_hi; };
struct Frame {
    LAS unsigned char* lds;
    gu32* ctl;
    unsigned char* ws;
    int tid, lane, wave, vcu, G;
};
#define WSP(type, off) ((type*)(GAS type*)(F.ws + (off)))
__device__ __forceinline__ const float* uni(const float* p) { const u64 v = (u64)p; return (const float*)(const GAS float*)(((u64)(unsigned)__builtin_amdgcn_readfirstlane((int)(v >> 32)) << 32) | (u64)(unsigned)__builtin_amdgcn_readfirstlane((int)v)); }
__device__ __forceinline__ Frame make_frame(unsigned char* ws_, LAS unsigned char* lds_) {
    Frame F; const u64 v = (u64)ws_;
    F.ws = (unsigned char*)(((u64)(unsigned)__builtin_amdgcn_readfirstlane((int)(v >> 32)) << 32) | (u64)(unsigned)__builtin_amdgcn_readfirstlane((int)v));
    F.lds = (LAS unsigned char*)(unsigned)__builtin_amdgcn_readfirstlane((int)(unsigned)(uintptr_t)lds_);
    F.ctl = (gu32*)(F.ws + WS_CTL);
    { int t_ = threadIdx.x; asm volatile("" : "+v"(t_)); F.tid = t_; }
    F.lane = F.tid & 63; F.wave = __builtin_amdgcn_readfirstlane(F.tid >> 6);
    F.G = gridDim.x; { const int bx = blockIdx.x; F.vcu = (F.G % 8 == 0) ? (bx % 8) * (F.G / 8) + bx / 8 : bx; }
    return F;
}
struct In6 { const float* p[6]; };

__device__ __forceinline__ void tr_block(Frame& F, const float* W_, int N, bf16* WT, int k0, int n0, int mode  , size_t drow_base, float scale) {
    LAS unsigned* img = (LAS unsigned*)F.lds; const int lane = F.lane, wave = F.wave, tid = F.tid; const GAS float* W = (const GAS float*)W_;
    f32x4 va[4][2], vb[4][2];
#pragma unroll
    for (int i = 0; i < 4; ++i) { const int kp = wave * 4 + i; const GAS float* r0 = W + (size_t)(k0 + 2 * kp) * N + n0; const GAS float* r1 = r0 + N;
#pragma unroll
        for (int q = 0; q < 2; ++q) { const int c4 = lane + 64 * q; va[i][q] = (f32x4){0.f, 0.f, 0.f, 0.f}; vb[i][q] = va[i][q];
            if (n0 + 4 * c4 < N) { va[i][q] = __builtin_nontemporal_load((const GAS f32x4*)(r0 + 4 * c4)); vb[i][q] = __builtin_nontemporal_load((const GAS f32x4*)(r1 + 4 * c4)); } } }
#pragma unroll
    for (int i = 0; i < 4; ++i) { const int kp = wave * 4 + i;
#pragma unroll
        for (int q = 0; q < 2; ++q) { const int c4 = lane + 64 * q; const f32x4 a = va[i][q], b = vb[i][q];
            v4u o; o.x = pk2(a.x * scale, b.x * scale); o.y = pk2(a.y * scale, b.y * scale); o.z = pk2(a.z * scale, b.z * scale); o.w = pk2(a.w * scale, b.w * scale);
            *(LAS v4u*)(img + kp * 516 + 4 * c4) = o; } }
    __syncthreads();
    const int c = tid & 7;
#pragma unroll
    for (int i = 0; i < 8; ++i) { const int n = (tid >> 3) + 64 * i; const LAS unsigned* p = img + (4 * c) * 516 + n;
        v4u o; o.x = p[0]; o.y = p[516]; o.z = p[2 * 516]; o.w = p[3 * 516];
        const int ng = n0 + n; size_t dr;
        if (mode == 1) dr = ng < 1024 ? (size_t)((ng >> 7) * 256 + (ng & 127)) : (size_t)((((ng - 1024) >> 7) * 256) + 128 + ((ng - 1024) & 127)); else dr = (size_t)ng;
        *(GAS v4u*)((GAS bf16*)WT + (drow_base + dr) * D + k0 + 8 * c) = o; }
    __syncthreads();
}
__device__ __forceinline__ void tr_block8(Frame& F, const float* W_, int N, unsigned char* WT, int k0, int n0, int mode, size_t drow_base, float scale) {
    LAS unsigned* img = (LAS unsigned*)F.lds; const int lane = F.lane, wave = F.wave, tid = F.tid; const GAS float* W = (const GAS float*)W_;
    f32x4 vv[4][2][4];
#pragma unroll
    for (int i = 0; i < 4; ++i) { const int kq = wave * 4 + i; const GAS float* r0 = W + (size_t)(k0 + 4 * kq) * N + n0;
#pragma unroll
        for (int q = 0; q < 2; ++q) { const int c4 = lane + 64 * q;
#pragma unroll
            for (int j = 0; j < 4; ++j) vv[i][q][j] = __builtin_nontemporal_load((const GAS f32x4*)(r0 + (size_t)j * N + 4 * c4)); } }
#pragma unroll
    for (int i = 0; i < 4; ++i) { const int kq = wave * 4 + i;
#pragma unroll
        for (int q = 0; q < 2; ++q) { const int c4 = lane + 64 * q; const f32x4 a = vv[i][q][0] * scale, b = vv[i][q][1] * scale, c = vv[i][q][2] * scale, d = vv[i][q][3] * scale;
            v4u o; o.x = pk4_fp8(a.x, b.x, c.x, d.x); o.y = pk4_fp8(a.y, b.y, c.y, d.y); o.z = pk4_fp8(a.z, b.z, c.z, d.z); o.w = pk4_fp8(a.w, b.w, c.w, d.w);
            *(LAS v4u*)(img + kq * 516 + 4 * c4) = o; } }
    __syncthreads();
    const int c = tid & 7;
#pragma unroll
    for (int i = 0; i < 8; ++i) { const int n = (tid >> 3) + 64 * i; const LAS unsigned* p = img + (4 * c) * 516 + n;
        v4u o; o.x = p[0]; o.y = p[516]; o.z = p[2 * 516]; o.w = p[3 * 516];
        const int ng = n0 + n; size_t dr;
        if (mode == 1) dr = ng < 1024 ? (size_t)((ng >> 7) * 256 + (ng & 127)) : (size_t)((((ng - 1024) >> 7) * 256) + 128 + ((ng - 1024) & 127)); else dr = (size_t)ng;
        *(GAS v4u*)((GAS unsigned char*)WT + (drow_base + dr) * D + k0 + 16 * c) = o; }
    __syncthreads();
}
__device__ __forceinline__ void p_prologue(Frame& F, const In6& A) {
    constexpr int I_IN = 16 * 6, I_OUT = 16 * 2, I_GU = NE * 8 * 4, I_DN = NE * 8 * 2, I_L = I_IN + I_OUT + I_GU + I_DN;
    for (int it = F.vcu; it < DEPTH * I_L; it += F.G) {
        const int l = it / I_L; int r = it % I_L;
        if (r < I_IN) { const int kb = r / 6, nb = r % 6; tr_block(F, A.p[0] + (size_t)l * D * NIN, NIN, WSP(bf16, WS_WIN) + (size_t)l * NINP * D, kb * 64, nb * 512, 0, 0, nb == 2 ? ATT_C2 : 1.f); continue; }
        r -= I_IN;
        if (r < I_OUT) { const int kb = r / 2, nb = r % 2; tr_block(F, A.p[1] + (size_t)l * D * D, D, WSP(bf16, WS_WOUT) + (size_t)l * D * D, kb * 64, nb * 512, 0, 0, 1.f); continue; }
        r -= I_OUT;
        if (r < I_GU) { const int e = r / 32, rr = r % 32, kb = rr / 4, nb = rr % 4; tr_block8(F, A.p[2] + (size_t)(l * NE + e) * D * 2048, 2048, WSP(unsigned char, WS_WGU) + (size_t)l * NE * 2048 * D * 2, kb * 128, nb * 512, 1, (size_t)e * 2048, WGU_SCALE); continue; }
        r -= I_GU;
        { const int e = r / 16, rr = r % 16, kb = rr / 2, nb = rr % 2; tr_block8(F, A.p[3] + (size_t)(l * NE + e) * D * D, D, WSP(unsigned char, WS_WDN) + (size_t)l * NE * D * D * 2, kb * 128, nb * 512, 0, (size_t)e * 1024, WDN_SCALE); }
    }
    const int gw = F.vcu * NWAVES + F.wave, NGW = F.G * NWAVES, lane = F.lane;
    const GAS float* x = (const GAS float*)A.p[4]; GAS bf16* xb = (GAS bf16*)WSP(bf16, WS_XB);
    for (int m = gw; m < T; m += 2 * NGW) {
        const GAS f32x4* xr = (const GAS f32x4*)(x + (size_t)m * D) + lane; GAS u64* o8 = (GAS u64*)(xb + (size_t)m * D) + lane;
        const GAS f32x4* xr2 = xr + (size_t)NGW * (D / 4); GAS u64* o82 = o8 + (size_t)NGW * (D / 4);
        f32x4 v[4], w[4];
#pragma unroll
        for (int j = 0; j < 4; ++j) { v[j] = __builtin_nontemporal_load(xr + 64 * j); w[j] = __builtin_nontemporal_load(xr2 + 64 * j); }
#pragma unroll
        for (int j = 0; j < 4; ++j) { o8[64 * j] = (u64)pk2(v[j].x, v[j].y) | ((u64)pk2(v[j].z, v[j].w) << 32); o82[64 * j] = (u64)pk2(w[j].x, w[j].y) | ((u64)pk2(w[j].z, w[j].w) << 32); }
    }
}

__device__ __forceinline__ void bf8_to_f(const v4u q, float (&f)[8]) { f[0] = bflo(q.x); f[1] = bfhi(q.x); f[2] = bflo(q.y); f[3] = bfhi(q.y); f[4] = bflo(q.z); f[5] = bfhi(q.z); f[6] = bflo(q.w); f[7] = bfhi(q.w); }
__device__ __forceinline__ void p_local(Frame& F, const In6& A, int l) {
    typedef float f32x16 __attribute__((ext_vector_type(16)));
    constexpr int MROW = 528, WROW = 144;
    LAS unsigned char* mixb = F.lds;
    LAS unsigned char* wpt = F.lds + 64 * MROW;
    const GAS float* wpool = (const GAS float*)(A.p[0] + (size_t)l * 4 * 64 * 64);
    const GAS float* convw = (const GAS float*)(A.p[1] + l * 768); const GAS float* pscale = (const GAS float*)(A.p[2] + l * 256);
    const GAS float* kng = (const GAS float*)(A.p[3] + l * 32); const GAS float* knb = (const GAS float*)(A.p[4] + l * 32);
    const GAS bf16* PROJ = (const GAS bf16*)(F.ws + WS_PROJ); GAS bf16* CAT = (GAS bf16*)(F.ws + WS_CAT); GAS bf16* KIN = (GAS bf16*)(F.ws + WS_KIN);
    const int tid = F.tid, lane = F.lane, wave = F.wave;
    for (int u = F.vcu; u < T / 64; u += F.G) {
        const int t0 = u * 64, s0 = t0 & (SEQ - 1), rowb = t0 - s0;
        __syncthreads();
        f32x4 wr0[4], wr1[4];
#pragma unroll
        for (int i = 0; i < 4; ++i) { const int item = tid + 512 * i, g = item >> 9, cp = (item >> 4) & 31, dq = item & 15;
            wr0[i] = *(const GAS f32x4*)(wpool + g * 4096 + (2 * cp) * 64 + 4 * dq); wr1[i] = *(const GAS f32x4*)(wpool + g * 4096 + (2 * cp + 1) * 64 + 4 * dq); }
        const int cga = tid & 31, tga = tid >> 5, ca0 = cga * 8, sfa = s0 + tga * 4;
        v4u ah[6], ag[6], ab[4];
#pragma unroll
        for (int i = -2; i < 4; ++i) { const int sq = sfa + i; ah[i + 2] = (v4u){0u, 0u, 0u, 0u}; ag[i + 2] = ah[i + 2];
            if (sq >= 0) { const GAS bf16* pr = PROJ + (size_t)(rowb + sq) * NINP; ah[i + 2] = *(const GAS v4u*)(pr + C_H + ca0); ag[i + 2] = *(const GAS v4u*)(pr + C_GC + ca0);
                if (i >= 0) ab[i] = *(const GAS v4u*)(pr + C_GB + ca0); } }
        const int cgb = tid & 63, tgb = tid >> 6, cb0 = cgb * 4, wwin = 2 << (cgb >> 4), sfb = s0 + tgb * 8;
        v2u bq[23];
#pragma unroll
        for (int i = 0; i < 23; ++i) { const int sq = sfb - 15 + i; bq[i] = (v2u){0u, 0u}; if (sq >= 0) bq[i] = *(const GAS v2u*)(PROJ + (size_t)(rowb + sq) * NINP + C_P + cb0); }
        bf16 ck[4];
#pragma unroll
        for (int i = 0; i < 4; ++i) { const int idx = tid + 512 * i; ck[i] = PROJ[(size_t)(t0 + (idx >> 5)) * NINP + C_KI + (idx & 31)]; }
        const float kg = kng[tid & 31], kb = knb[tid & 31];
        float w0[8], w1[8], w2[8];
#pragma unroll
        for (int i = 0; i < 8; ++i) { w0[i] = convw[ca0 + i]; w1[i] = convw[256 + ca0 + i]; w2[i] = convw[512 + ca0 + i]; }
#pragma unroll
        for (int i = 0; i < 4; ++i) { const int item = tid + 512 * i, g = item >> 9, cp = (item >> 4) & 31, dq = item & 15;
#pragma unroll
            for (int k = 0; k < 4; ++k) *(LAS unsigned*)(wpt + (g * 64 + 4 * dq + k) * WROW + cp * 4) = pk2(wr0[i][k], wr1[i][k]); }
        {
            float up2[8], up1[8];
#pragma unroll
            for (int i = 0; i < 8; ++i) { up2[i] = 0.f; up1[i] = 0.f; }
#pragma unroll
            for (int i = -2; i < 4; ++i) { const int sq = sfa + i; float h8[8], g8[8], uu[8];
                bf8_to_f(ah[i + 2], h8); bf8_to_f(ag[i + 2], g8);
#pragma unroll
                for (int k = 0; k < 8; ++k) uu[k] = g8[k] * h8[k];
                if (i >= 0) { float b8[8], y[8]; bf8_to_f(ab[i], b8);
#pragma unroll
                    for (int k = 0; k < 8; ++k) y[k] = b8[k] * (w0[k] * up2[k] + w1[k] * up1[k] + w2[k] * uu[k]);
                    v4u o; o.x = pk2(y[0], y[1]); o.y = pk2(y[2], y[3]); o.z = pk2(y[4], y[5]); o.w = pk2(y[6], y[7]);
                    *(GAS v4u*)(CAT + (size_t)(rowb + sq) * D + ca0) = o; }
#pragma unroll
                for (int k = 0; k < 8; ++k) { up2[k] = up1[k]; up1[k] = uu[k]; } }
        }
        {
            float pv[23][4];
#pragma unroll
            for (int i = 0; i < 23; ++i) { pv[i][0] = bflo(bq[i].x); pv[i][1] = bfhi(bq[i].x); pv[i][2] = bflo(bq[i].y); pv[i][3] = bfhi(bq[i].y); }
#pragma unroll
            for (int i = 0; i < 8; ++i) { const int sq = sfb + i; float a0 = 0.f, a1 = 0.f, a2 = 0.f, a3 = 0.f;
#pragma unroll
                for (int j = 0; j < 16; ++j) { const bool on = j < wwin; a0 += on ? pv[15 + i - j][0] : 0.f; a1 += on ? pv[15 + i - j][1] : 0.f; a2 += on ? pv[15 + i - j][2] : 0.f; a3 += on ? pv[15 + i - j][3] : 0.f; }
                const float rc = 1.f / (float)((sq + 1) < wwin ? (sq + 1) : wwin);
                *(LAS v2u*)(mixb + (tgb * 8 + i) * MROW + cb0 * 2) = (v2u){pk2(a0 * rc - pv[15 + i][0], a1 * rc - pv[15 + i][1]), pk2(a2 * rc - pv[15 + i][2], a3 * rc - pv[15 + i][3])}; }
        }
#pragma unroll
        for (int i = 0; i < 4; ++i) {
            const int idx = tid + 512 * i, tt = idx >> 5, dd = idx & 31; const float v = bf2f(ck[i]);
            const float mean = sum32(v) * (1.f / 32.f); const float dv = v - mean; const float var = sum32(dv * dv) * (1.f / 32.f);
            KIN[(size_t)(t0 + tt) * 32 + dd] = (bf16)f2bf(dv * rsqrtf(var + LN_EPS) * kg + kb);
        }
        __syncthreads();
        {
            const int g = wave >> 1, th = wave & 1, r32 = lane & 31, hi = lane >> 5;
            f32x16 acc[2]; acc[0] = f32x16{}; acc[1] = f32x16{};
#pragma unroll
            for (int kk = 0; kk < 4; ++kk) { const bf16x8 bfr = *(const LAS bf16x8*)(mixb + (th * 32 + r32) * MROW + (g * 64 + kk * 16 + hi * 8) * 2);
#pragma unroll
                for (int dh = 0; dh < 2; ++dh) { const bf16x8 afr = *(const LAS bf16x8*)(wpt + (g * 64 + dh * 32 + r32) * WROW + (kk * 16 + hi * 8) * 2);
                    acc[dh] = __builtin_amdgcn_mfma_f32_32x32x16_bf16(afr, bfr, acc[dh], 0, 0, 0); } }
            GAS bf16* orow = CAT + (size_t)(t0 + th * 32 + r32) * D + 256 + g * 64;
#pragma unroll
            for (int dh = 0; dh < 2; ++dh)
#pragma unroll
                for (int rq = 0; rq < 4; ++rq) { const int d0 = dh * 32 + 8 * rq + 4 * hi; const f32x4 sc = *(const GAS f32x4*)(pscale + g * 64 + d0);
                    *(GAS v2u*)(orow + d0) = (v2u){pk2(acc[dh][4 * rq] * sc.x, acc[dh][4 * rq + 1] * sc.y), pk2(acc[dh][4 * rq + 2] * sc.z, acc[dh][4 * rq + 3] * sc.w)}; }
        }
    }
    __syncthreads();
}

constexpr int SCS = SEQ;
__device__ __forceinline__ unsigned sortable(float v) { const unsigned u = __builtin_bit_cast(unsigned, v); return (u & 0x80000000u) ? ~u : (u | 0x80000000u); }
__device__ __forceinline__ void select_row(int t, const GAS float* SC, GAS unsigned* MASK, LAS unsigned* hist, LAS float* ckey, LAS int* cidx, int lane) {
    const u64 lt = (1ull << lane) - 1ull; const float NINF = -INFINITY;
    const int s = t & (SEQ - 1); GAS u64* mrow = (GAS u64*)MASK + ((size_t)(t >> 12) * 64) * SEQ + s;
    if (s < NSEL) { const int base = 64 * lane; u64 m; if (s >= base + 63) m = ~0ull; else if (s < base) m = 0ull; else m = (2ull << (s - base)) - 1ull; mrow[(size_t)lane * SEQ] = m; return; }
    const int jmax = s >> 6, jb = jmax & ~7;
    float v[64]; const GAS float* srow = SC + (size_t)t * SCS + lane;
#pragma unroll
    for (int j0 = 0; j0 < 64; j0 += 8) {
        if (j0 < jb) {
#pragma unroll
            for (int j = j0; j < j0 + 8; ++j) v[j] = srow[64 * j];
        } else if (j0 == jb) {
#pragma unroll
            for (int j = j0; j < j0 + 8; ++j) { const float x = srow[64 * j]; v[j] = (lane + 64 * j <= s) ? x : NINF; }
        } else {
#pragma unroll
            for (int j = j0; j < j0 + 8; ++j) v[j] = NINF;
        }
    }
    {
    float vmx = NINF, vmn = INFINITY;
#pragma unroll
    for (int j0 = 0; j0 < 64; j0 += 8) {
        if (j0 < jb) {
#pragma unroll
            for (int j = j0; j < j0 + 8; ++j) { vmx = fmaxf(vmx, v[j]); vmn = fminf(vmn, v[j]); }
        } else if (j0 == jb) {
#pragma unroll
            for (int j = j0; j < j0 + 8; ++j) { vmx = fmaxf(vmx, v[j]); vmn = fminf(vmn, v[j] == NINF ? INFINITY : v[j]); }
        }
    }
    vmx = wave_max_dpp(vmx); vmn = -wave_max_dpp(-vmn);
    const float scale = 1023.f / fmaxf(vmx - vmn, 1e-30f), off = -vmn * scale;
#pragma unroll
    for (int i = 0; i < 4; ++i) ((LAS v4u*)hist)[i * 64 + lane] = (v4u){0u, 0u, 0u, 0u};
    LDS_WAIT(); asm volatile("" ::: "memory");
    unsigned bp[32];
#pragma unroll
    for (int j0 = 0; j0 < 64; j0 += 8) {
        if (j0 < jb) {
#pragma unroll
            for (int j = j0; j < j0 + 8; ++j) { unsigned bb = (unsigned)fmaf(v[j], scale, off); bb = bb < 1023u ? bb : 1023u; __hip_atomic_fetch_add(hist + bb, 1u, __ATOMIC_RELAXED, __HIP_MEMORY_SCOPE_WORKGROUP);
                if (j & 1) bp[j >> 1] |= bb << 16; else bp[j >> 1] = bb; }
        } else if (j0 == jb) {
#pragma unroll
            for (int j = j0; j < j0 + 8; ++j) { unsigned bb = (unsigned)fmaf(v[j], scale, off); bb = bb < 1023u ? bb : 1023u; if (v[j] != NINF) __hip_atomic_fetch_add(hist + bb, 1u, __ATOMIC_RELAXED, __HIP_MEMORY_SCOPE_WORKGROUP);
                if (j & 1) bp[j >> 1] |= bb << 16; else bp[j >> 1] = bb; }
        } else {
#pragma unroll
            for (int j = j0; j < j0 + 8; j += 2) bp[j >> 1] = 0u;
        }
    }
    LDS_WAIT(); asm volatile("" ::: "memory");
    unsigned hb[16];
#pragma unroll
    for (int i = 0; i < 4; ++i) { const v4u q = ((const LAS v4u*)hist)[lane * 4 + i]; hb[4 * i] = q.x; hb[4 * i + 1] = q.y; hb[4 * i + 2] = q.z; hb[4 * i + 3] = q.w; }
    int own = 0;
#pragma unroll
    for (int i = 0; i < 16; ++i) own += (int)hb[i];
    int suf = own;
#pragma unroll
    for (int o = 1; o < 64; o <<= 1) { const int x = __shfl_down(suf, o); if (lane + o < 64) suf += x; }
    const u64 ge = __ballot(suf >= NSEL); const int L = 63 - __builtin_clzll(ge);
    int acc = suf - own, tb = 0, ca = 0, found = 0;
#pragma unroll
    for (int i = 15; i >= 0; --i) { if (!found) { if (acc + (int)hb[i] >= NSEL) { found = 1; tb = lane * 16 + i; ca = acc; } else acc += (int)hb[i]; } }
    const int TB = __builtin_amdgcn_readlane(tb, L), CA = __builtin_amdgcn_readlane(ca, L);
    const int need = NSEL - CA;
    int cbase = 0; unsigned mlo = 0u, mhi = 0u;
#pragma unroll
    for (int j0 = 0; j0 < 64; j0 += 8) {
        if (j0 <= jb) {
#pragma unroll
            for (int j = j0; j < j0 + 8; ++j) { const int bb = (int)((j & 1) ? (bp[j >> 1] >> 16) : (bp[j >> 1] & 0xffffu));
                const u64 am = __ballot(bb > TB); const u64 cm = __ballot(bb == TB);
                asm volatile("s_nop 4\n\tv_writelane_b32 %0, %2, %4\n\tv_writelane_b32 %1, %3, %4" : "+v"(mlo), "+v"(mhi) : "s"((unsigned)am), "s"((unsigned)(am >> 32)), "n"(j));
                if (cm) { const int pos = cbase + __popcll(cm & lt); if (bb == TB && pos < 64) { ckey[pos] = v[j]; cidx[pos] = lane + 64 * j; } cbase += __popcll(cm); } }
        }
    }
    LDS_WAIT(); asm volatile("" ::: "memory");
    if (cbase <= SEL_CAND_CAP) {
        LAS unsigned* mw = hist;
        mw[2 * lane] = mlo; mw[2 * lane + 1] = mhi;
        const float myk = lane < cbase ? ckey[lane] : NINF; const int myi = lane < cbase ? cidx[lane] : 0x7fffffff; int rank = 0;
        for (int c = 0; c < cbase; ++c) { const float ok = __builtin_bit_cast(float, __builtin_amdgcn_readlane(__builtin_bit_cast(int, myk), c)); const int oi = __builtin_amdgcn_readlane(myi, c); rank += (ok > myk || (ok == myk && oi < myi)) ? 1 : 0; }
        LDS_WAIT(); asm volatile("" ::: "memory");
        if (lane < cbase && rank < need && myk != NINF) __hip_atomic_fetch_or(mw + (myi >> 5), 1u << (myi & 31), __ATOMIC_RELAXED, __HIP_MEMORY_SCOPE_WORKGROUP);
        LDS_WAIT(); asm volatile("" ::: "memory");
        mrow[(size_t)lane * SEQ] = (u64)mw[2 * lane] | ((u64)mw[2 * lane + 1] << 32);
        LDS_WAIT(); asm volatile("" ::: "memory");
        return;
    }
    unsigned prefix = 0u;
    for (int bit = 31; bit >= 0; --bit) { const unsigned cand = prefix | (1u << bit); int cnt = 0;
#pragma unroll
        for (int j0 = 0; j0 < 64; j0 += 8) {
#pragma unroll
            for (int j = j0; j < j0 + 8; ++j) cnt += __popcll(__ballot(v[j] != NINF && sortable(v[j]) >= cand));
            __builtin_amdgcn_sched_barrier(0); }
        if (cnt >= NSEL) prefix = cand; }
    int ngt = 0;
#pragma unroll
    for (int j = 0; j < 64; ++j) ngt += __popcll(__ballot(v[j] != NINF && sortable(v[j]) > prefix));
    int rem = NSEL - ngt, last = 0;
#pragma unroll
    for (int j = 0; j < 64; ++j) { const u64 em = __ballot(v[j] != NINF && sortable(v[j]) == prefix); const int c = __popcll(em);
        if (rem > 0 && c > 0) { if (c >= rem) { u64 x = em; for (int q = 1; q < rem; ++q) x &= x - 1ull; last = 64 * j + __builtin_ctzll(x); rem = 0; } else rem -= c; } }
    const unsigned pb = (prefix & 0x80000000u) ? (prefix & 0x7fffffffu) : ~prefix; const float Tv = __builtin_bit_cast(float, pb); const int Tidx = last;
    mlo = 0u; mhi = 0u;
#pragma unroll
    for (int j = 0; j < 64; ++j) { const bool sel = (v[j] > Tv) || (v[j] == Tv && lane + 64 * j <= Tidx); const u64 m = __ballot(sel);
        asm volatile("s_nop 4\n\tv_writelane_b32 %0, %2, %4\n\tv_writelane_b32 %1, %3, %4" : "+v"(mlo), "+v"(mhi) : "s"((unsigned)m), "s"((unsigned)(m >> 32)), "n"(j)); }
    mrow[(size_t)lane * SEQ] = (u64)mlo | ((u64)mhi << 32);
    return;
    }
}
__device__ __forceinline__ float relu_i(float x) { const int b = __builtin_bit_cast(int, x); return __builtin_bit_cast(float, b > 0 ? b : 0); }
__device__ __forceinline__ void p_index(Frame& F) {
    const int wave = F.wave;
    const GAS bf16* PROJ = (const GAS bf16*)(F.ws + WS_PROJ); const GAS bf16* KIN = (const GAS bf16*)(F.ws + WS_KIN); GAS float* SC = (GAS float*)(F.ws + WS_SC); GAS unsigned* MASK = (GAS unsigned*)(F.ws + WS_MASK);
    LAS unsigned* hist = (LAS unsigned*)(F.lds + wave * 4096);
    LAS float* ckey = (LAS float*)(F.lds + 32768 + wave * 1024); LAS int* cidx = (LAS int*)(ckey + 64);
    for (int ui = 0; ui < 2; ++ui) {
        const int v = F.vcu; if (v >= 256) break;
        const int b = v & 3, j = v >> 2, qb = ui == 0 ? j : 127 - j, q0 = qb * 32;
        int lane = F.tid & 63; asm volatile("" : "+v"(lane)); const int l15 = lane & 15, l4 = lane >> 4;
        bf16x8 bq[2][8]; float wq[2][8];
#pragma unroll
        for (int hq = 0; hq < 2; ++hq) { const size_t rowq = (size_t)(b * SEQ + q0 + 16 * hq + l15);
#pragma unroll
            for (int h = 0; h < 8; ++h) { bq[hq][h] = *(const GAS bf16x8*)(PROJ + rowq * NINP + C_QI + h * 32 + 8 * l4); wq[hq][h] = bf2f(PROJ[rowq * NINP + C_WI + h]) * 0.0625f; } }
        GAS float* srow = SC + (size_t)(b * SEQ + q0 + l15) * SCS + 4 * l4;
        const int ktl = 2 * qb + 1; const GAS bf16* kin0 = KIN + (size_t)(b * SEQ + l15) * 32 + 8 * l4;
        bf16x8 a = *(const GAS bf16x8*)(kin0 + (size_t)((wave <= ktl ? wave : ktl) * 16) * 32);
        for (int kt = wave; kt <= ktl; kt += NWAVES) {
            const int ktn = kt + NWAVES <= ktl ? kt + NWAVES : kt;
            const bf16x8 an = *(const GAS bf16x8*)(kin0 + (size_t)(ktn * 16) * 32);
#pragma unroll
            for (int hq = 0; hq < 2; ++hq) { f32x4 sc = (f32x4){0.f, 0.f, 0.f, 0.f};
#pragma unroll
                for (int h = 0; h < 8; ++h) { const f32x4 d = __builtin_amdgcn_mfma_f32_16x16x32_bf16(a, bq[hq][h], (f32x4){0.f, 0.f, 0.f, 0.f}, 0, 0, 0);
                    sc.x += relu_i(d.x) * wq[hq][h]; sc.y += relu_i(d.y) * wq[hq][h]; sc.z += relu_i(d.z) * wq[hq][h]; sc.w += relu_i(d.w) * wq[hq][h]; }
                *(GAS f32x4*)(srow + (size_t)(16 * hq) * SCS + kt * 16) = sc; }
            a = an;
        }
        asm volatile("s_waitcnt vmcnt(0)" ::: "memory"); __syncthreads();
        int lane_s = F.tid & 63; asm volatile("" : "+v"(lane_s));
        for (int r = 0; r < 4; ++r) select_row(b * SEQ + q0 + wave * 4 + r, SC, MASK, hist, ckey, cidx, lane_s);
#ifdef EXP_DUP_SELECT
        for (int r = 0; r < 4; ++r) select_row(b * SEQ + q0 + wave * 4 + r, SC, MASK, hist, ckey, cidx, lane_s);
#endif
    }
}

namespace att {
typedef float f32x16 __attribute__((ext_vector_type(16)));
typedef short s16x4 __attribute__((ext_vector_type(4)));
constexpr int NSLOT = 3, SLOTB = 8192, LDS_K = 0, LDS_V = NSLOT * SLOTB, LDS_WS = 2 * NSLOT * SLOTB, LDS_OST = LDS_WS + 8 * 64 * 4, LDS_BYTES_ATT = LDS_OST + 8 * 4096;
constexpr float THR = 100.f;
__device__ __forceinline__ int crow(int r, int hi) { return (r & 3) + 8 * (r >> 2) + 4 * hi; }
__device__ __forceinline__ unsigned cvtpk(float lo, float hi) { typedef float f2 __attribute__((ext_vector_type(2))); typedef __bf16 b2 __attribute__((ext_vector_type(2))); f2 v = {lo, hi}; b2 b = __builtin_convertvector(v, b2); return __builtin_bit_cast(unsigned, b); }
__device__ __forceinline__ float rowmax(const f32x16& p0, const f32x16& p1) {
    float a = fmaxf(fmaxf(p0[0], p0[1]), p1[0]), b = fmaxf(fmaxf(p0[2], p0[3]), p1[1]); a = fmaxf(fmaxf(a, p1[2]), p1[3]);
#pragma unroll
    for (int r = 4; r < 16; r += 4) { a = fmaxf(fmaxf(a, p0[r]), p0[r + 1]); b = fmaxf(fmaxf(b, p0[r + 2]), p0[r + 3]); a = fmaxf(fmaxf(a, p1[r]), p1[r + 1]); b = fmaxf(fmaxf(b, p1[r + 2]), p1[r + 3]); }
    const float m = fmaxf(a, b);
    return fmaxf(m, __shfl_xor(m, 32));
}
__device__ __forceinline__ void pv(f32x16* o, int vb, bf16x8 pa0, bf16x8 pa1, bf16x8 pa2, bf16x8 pa3) {
#pragma unroll
    for (int d0 = 0; d0 < 2; ++d0) { s16x4 lo[4], hi[4];
#pragma unroll
        for (int ks = 0; ks < 4; ++ks) {
            asm volatile("ds_read_b64_tr_b16 %0,%1 offset:%c2" : "=&v"(lo[ks]) : "v"(vb), "i"(d0 * 4096 + ks * 1024) : "memory");
            asm volatile("ds_read_b64_tr_b16 %0,%1 offset:%c2" : "=&v"(hi[ks]) : "v"(vb), "i"(d0 * 4096 + ks * 1024 + 512) : "memory"); }
        asm volatile("s_waitcnt lgkmcnt(0)" ::: "memory"); __builtin_amdgcn_sched_barrier(0);
#define ATT_PK(k) (bf16x8){lo[k][0], lo[k][1], lo[k][2], lo[k][3], hi[k][0], hi[k][1], hi[k][2], hi[k][3]}
        o[d0] = __builtin_amdgcn_mfma_f32_32x32x16_bf16(pa0, ATT_PK(0), o[d0], 0, 0, 0);
        o[d0] = __builtin_amdgcn_mfma_f32_32x32x16_bf16(pa1, ATT_PK(1), o[d0], 0, 0, 0);
        o[d0] = __builtin_amdgcn_mfma_f32_32x32x16_bf16(pa2, ATT_PK(2), o[d0], 0, 0, 0);
        o[d0] = __builtin_amdgcn_mfma_f32_32x32x16_bf16(pa3, ATT_PK(3), o[d0], 0, 0, 0);
#undef ATT_PK
    }
}
}
template <bool grpB> __device__ __forceinline__ void attn_units(Frame& F) {
    using namespace att;
    const int tid = F.tid, lane = tid & 63, r32 = lane & 31, hi = lane >> 5, wid = F.wave;
    const GAS bf16* PROJ = (const GAS bf16*)(F.ws + WS_PROJ); GAS bf16* CAT = (GAS bf16*)(F.ws + WS_CAT); const GAS u64* MASKT = (const GAS u64*)(F.ws + WS_MASK);
    LAS unsigned char* shm = F.lds;
    constexpr int NSV = 4, LDS_V2 = NSLOT * SLOTB, LDS_WS2 = LDS_V2 + NSV * SLOTB, LDS_OST2 = LDS_WS2 + 8 * 64 * 4;
    LAS float* wsf = (LAS float*)(shm + LDS_WS2) + wid * 64;
    const float NEGINF = -INFINITY;
    for (int ui = 0; ui < 2; ++ui) {
        const int v = F.vcu; if (v >= 256) break;
        const int bh = v >> 3, sidx = v & 7, b = bh >> 3, h = bh & 7, qb = ui == 0 ? sidx : 15 - sidx;
        const size_t rowbase = (size_t)b * SEQ; const int q0 = qb * 256, NT = (q0 + 256) / 64;
        const float slope2 = exp2f(-(float)(h + 1)) * 1.4426950408889634f;
        const GAS bf16* Kh = PROJ + rowbase * NINP + C_K + h * 64; const GAS bf16* Vh = PROJ + rowbase * NINP + C_V + h * 64;
        const GAS bf16* ksrc = Kh + (size_t)lane * NINP + wid * 8;
        const GAS bf16* vsrc = Vh + (size_t)(16 * (wid & 3) + (lane >> 2)) * NINP + (wid >> 2) * 32 + (lane & 3) * 8;
#define ATT_DMA(t, ks, vs) do { __builtin_amdgcn_global_load_lds((const GAS unsigned*)(ksrc + (size_t)(t) * 64 * NINP), (LAS unsigned*)(shm + LDS_K + (ks) * SLOTB + wid * 1024), 16, 0, 0); \
                        __builtin_amdgcn_global_load_lds((const GAS unsigned*)(vsrc + (size_t)(t) * 64 * NINP), (LAS unsigned*)(shm + LDS_V2 + (vs) * SLOTB + wid * 1024), 16, 0, 0); } while (0)
        ATT_DMA(0, 0, 0); ATT_DMA(1, 1, 1);
        const GAS bf16* Qw = PROJ + (rowbase + q0 + wid * 32) * NINP + C_Q + h * 64;
        bf16x8 qr[4];
#pragma unroll
        for (int d0 = 0; d0 < 4; ++d0) qr[d0] = *(const GAS bf16x8*)(Qw + (size_t)r32 * NINP + d0 * 16 + hi * 8);
        const GAS u64* mq = MASKT + ((size_t)b * 64) * SEQ + q0 + wid * 32 + r32;
        u64 mnext = mq[0], mprev = 0ull;
        f32x16 o[2], p0 = f32x16{}, p1 = f32x16{}; o[0] = f32x16{}; o[1] = f32x16{};
        float l_reg = 0.f, sq = 0.f;
        const unsigned sl_hi = __builtin_bit_cast(unsigned, slope2) & 0xffff0000u; const unsigned sl_lo = f2bf(slope2 - __builtin_bit_cast(float, sl_hi));
        bf16x8 kx0, kx1;
        { const unsigned j0 = hi ? 0u : (f2bf((float)r32) * 0x10001u), j1 = hi ? 0u : (f2bf((float)(r32 + 32)) * 0x10001u), one2 = hi ? 0u : 0x3f803f80u, one1 = hi ? 0u : 0x3f80u;
          kx0 = __builtin_bit_cast(bf16x8, (v4u){j0, one2, one1, 0u}); kx1 = __builtin_bit_cast(bf16x8, (v4u){j1, one2, one1, 0u}); }
        const int qlast = q0 + wid * 32 + 31;
        const int vb0 = (int)(unsigned)(uintptr_t)(shm + LDS_V2) + ((lane >> 4) & 1) * 32 + (lane & 3) * 8 + (4 * hi + ((lane & 15) >> 2)) * 64;
#define ATT_QK(ks) do { const LAS unsigned char* kb = shm + LDS_K + (ks) * SLOTB + hi * 1024 + r32 * 16; \
            { const unsigned u0_ = __builtin_bit_cast(unsigned, sq), a1_ = u0_ & 0xffff0000u; const float r1_ = sq - __builtin_bit_cast(float, a1_); const unsigned u1_ = __builtin_bit_cast(unsigned, r1_), a2_ = u1_ & 0xffff0000u; \
              const float r2_ = r1_ - __builtin_bit_cast(float, a2_); const unsigned a3_ = __builtin_bit_cast(unsigned, r2_) >> 16; \
              const bf16x8 qx = __builtin_bit_cast(bf16x8, (v4u){hi ? 0u : ((sl_hi >> 16) | (sl_lo << 16)), hi ? 0u : ((a1_ >> 16) | a2_), hi ? 0u : a3_, 0u}); \
              const f32x16 z_ = f32x16{}; p0 = __builtin_amdgcn_mfma_f32_32x32x16_bf16(kx0, qx, z_, 0, 0, 0); p1 = __builtin_amdgcn_mfma_f32_32x32x16_bf16(kx1, qx, z_, 0, 0, 0); } \
            _Pragma("unroll") for (int d0 = 0; d0 < 4; ++d0) { const bf16x8 k0 = *(const LAS bf16x8*)(kb + d0 * 2048), k1 = *(const LAS bf16x8*)(kb + d0 * 2048 + 512); \
                p0 = __builtin_amdgcn_mfma_f32_32x32x16_bf16(k0, qr[d0], p0, 0, 0, 0); p1 = __builtin_amdgcn_mfma_f32_32x32x16_bf16(k1, qr[d0], p1, 0, 0, 0); } } while (0)
#define ATT_SMPV(vs, mw) do { const unsigned w0 = (unsigned)(mw) >> (4 * hi), w1 = (unsigned)((mw) >> 32) >> (4 * hi); \
            asm volatile("s_nop 15\n\ts_nop 7" : "+v"(p0), "+v"(p1));   \
            _Pragma("unroll") for (int r = 0; r < 16; ++r) { const int cr = (r & 3) + 8 * (r >> 2); const int k0_ = __builtin_amdgcn_sbfe((int)w0, cr, 1), k1_ = __builtin_amdgcn_sbfe((int)w1, cr, 1); \
                asm("v_bfi_b32 %0, %1, %0, %2" : "+v"(p0[r]) : "v"(k0_), "v"(NEGINF)); asm("v_bfi_b32 %0, %1, %0, %2" : "+v"(p1[r]) : "v"(k1_), "v"(NEGINF)); } \
            const float rm = rowmax(p0, p1); bool resc = false; \
            if (__any(rm > THR)) { const float dl = fmaxf(rm, 0.f); \
                _Pragma("unroll") for (int r = 0; r < 16; ++r) { p0[r] -= dl; p1[r] -= dl; } sq -= dl; \
                const float f = __builtin_amdgcn_exp2f(-dl); l_reg *= f; if (hi == 0) wsf[r32] = f; resc = true; } \
            float sacc = 0.f; \
            _Pragma("unroll") for (int r = 0; r < 16; ++r) { p0[r] = __builtin_amdgcn_exp2f(p0[r]); p1[r] = __builtin_amdgcn_exp2f(p1[r]); sacc += p0[r] + p1[r]; } \
            l_reg += sacc; \
            if (resc) { asm volatile("s_waitcnt lgkmcnt(0)" ::: "memory"); \
                _Pragma("unroll") for (int d_ = 0; d_ < 2; ++d_) _Pragma("unroll") for (int r = 0; r < 16; ++r) o[d_][r] *= wsf[crow(r, hi)]; } \
            const v4u pw0 = (v4u){cvtpk(p0[0], p0[1]), cvtpk(p0[2], p0[3]), cvtpk(p0[4], p0[5]), cvtpk(p0[6], p0[7])}, pw1 = (v4u){cvtpk(p0[8], p0[9]), cvtpk(p0[10], p0[11]), cvtpk(p0[12], p0[13]), cvtpk(p0[14], p0[15])}; \
            const v4u pw2 = (v4u){cvtpk(p1[0], p1[1]), cvtpk(p1[2], p1[3]), cvtpk(p1[4], p1[5]), cvtpk(p1[6], p1[7])}, pw3 = (v4u){cvtpk(p1[8], p1[9]), cvtpk(p1[10], p1[11]), cvtpk(p1[12], p1[13]), cvtpk(p1[14], p1[15])}; \
            __builtin_amdgcn_sched_barrier(0); \
            pv(o, vb0 + (vs) * SLOTB, __builtin_bit_cast(bf16x8, pw0), __builtin_bit_cast(bf16x8, pw1), __builtin_bit_cast(bf16x8, pw2), __builtin_bit_cast(bf16x8, pw3)); } while (0)
        if constexpr (grpB) __builtin_amdgcn_s_setprio(1);
        const float step = 64.f * slope2;
        int ks = 0, vs = 0;
        u64 mcur = 0ull;
#define ATT_SYNC(t) do { if ((t) + 1 < NT) asm volatile("s_waitcnt vmcnt(2)" ::: "memory"); else asm volatile("s_waitcnt vmcnt(0)" ::: "memory"); \
            asm volatile("s_waitcnt lgkmcnt(0)" ::: "memory"); __builtin_amdgcn_s_barrier(); asm volatile("" ::: "memory"); \
            mprev = mcur; mcur = mnext; if ((t) + 1 < NT) mnext = mq[(size_t)((t) + 1) * SEQ]; \
            __builtin_amdgcn_sched_barrier(0); \
            if ((t) + 2 < NT) ATT_DMA((t) + 2, ks + 2 >= NSLOT ? ks + 2 - NSLOT : ks + 2, vs + 2 >= NSV ? vs + 2 - NSV : vs + 2); \
            __builtin_amdgcn_sched_barrier(0); } while (0)
#define ATT_ADV() do { sq += step; ks = ks + 1 >= NSLOT ? 0 : ks + 1; vs = vs + 1 >= NSV ? 0 : vs + 1; } while (0)
        const int tmax = qlast >> 6;
        if constexpr (!grpB) {
            int t = 0;
            for (; t <= tmax; ++t) { ATT_SYNC(t); ATT_QK(ks); ATT_SMPV(vs, mcur); ATT_ADV(); }
            for (; t < NT; ++t) { ATT_SYNC(t); ATT_ADV(); }
        } else {
            ATT_SYNC(0); ATT_QK(ks); ATT_ADV();
            int t = 1;
            for (; t <= tmax; ++t) { ATT_SYNC(t); ATT_SMPV(vs == 0 ? NSV - 1 : vs - 1, mprev); ATT_QK(ks); ATT_ADV(); }
            if (t < NT) { ATT_SYNC(t); ATT_SMPV(vs == 0 ? NSV - 1 : vs - 1, mprev); ATT_ADV(); ++t;
                for (; t < NT; ++t) { ATT_SYNC(t); ATT_ADV(); } }
            else { ATT_SMPV(vs == 0 ? NSV - 1 : vs - 1, mcur); }
        }
#undef ATT_SYNC
#undef ATT_ADV
        __builtin_amdgcn_s_setprio(0);
        l_reg += __shfl_xor(l_reg, 32);
        if (hi == 0) wsf[32 + r32] = l_reg;
        asm volatile("s_waitcnt lgkmcnt(0)" ::: "memory");
        float rli[16];
#pragma unroll
        for (int r = 0; r < 16; ++r) rli[r] = 1.f / wsf[32 + crow(r, hi)];
        GAS bf16* Ow = CAT + (rowbase + q0 + wid * 32) * D + 512 + h * 64;
        { LAS bf16* stg = (LAS bf16*)(shm + LDS_OST2) + wid * 2048;
#pragma unroll
            for (int r = 0; r < 16; ++r) { const int orow = crow(r, hi);
#pragma unroll
                for (int d0 = 0; d0 < 2; ++d0) stg[orow * 64 + d0 * 32 + r32] = (bf16)f2bf(o[d0][r] * rli[r]); }
            asm volatile("s_waitcnt lgkmcnt(0)" ::: "memory");
#pragma unroll
            for (int i = 0; i < 4; ++i) { const int row = i * 8 + (lane >> 3), ch = lane & 7; const v4u vv = *(const LAS v4u*)(stg + row * 64 + ch * 8); *(GAS v4u*)(Ow + (size_t)row * D + ch * 8) = vv; } }
        asm volatile("s_waitcnt vmcnt(0) lgkmcnt(0)" ::: "memory"); __builtin_amdgcn_s_barrier(); asm volatile("" ::: "memory");
#undef ATT_DMA
#undef ATT_QK
#undef ATT_SMPV
    }
}

__device__ __forceinline__ void p_attn_dense(Frame& F) { if (F.wave >= 4) attn_units<true>(F); else attn_units<false>(F); }

struct EpiResid {
    static constexpr bool PERM = true, AFTER_DRAIN = false;
    const bf16* resid; bf16* out; float alpha;
    __device__ __forceinline__ void operator()(const pg8::f32x4 (&acc)[2][2][4][2], const pg8::Unit& u, int wr, int wc, int fr, int fq) const {
        const int col0 = u.pn * 256 + wc * 32 + 8 * fq;
#pragma unroll
        for (int ai = 0; ai < 2; ++ai)
#pragma unroll
            for (int m = 0; m < 4; ++m) { const size_t off = (size_t)(u.pm * 256 + ai * 128 + wr * 64 + m * 16 + fr) * D + col0;
#pragma unroll
                for (int bj = 0; bj < 2; ++bj) { const v4u xr = *(const GAS v4u*)(resid + off + bj * 128); const f32x4 a0 = acc[ai][bj][m][0], a1 = acc[ai][bj][m][1];
                    v4u w; w.x = pk2(bflo(xr.x) * alpha + a0[0], bfhi(xr.x) * alpha + a0[1]); w.y = pk2(bflo(xr.y) * alpha + a0[2], bfhi(xr.y) * alpha + a0[3]);
                    w.z = pk2(bflo(xr.z) * alpha + a1[0], bfhi(xr.z) * alpha + a1[1]); w.w = pk2(bflo(xr.w) * alpha + a1[2], bfhi(xr.w) * alpha + a1[3]);
                    st16_wt(out + off + bj * 128, w.x, w.y, w.z, w.w); }
                if (m & 1) asm volatile("" ::: "memory"); }
    }
};
struct EpiSwiglu {
    static constexpr bool PERM = true, AFTER_DRAIN = false;
    unsigned char* O; const float* bias;
    __device__ __forceinline__ void operator()(const pg8::f32x4 (&acc)[2][2][4][2], const pg8::Unit& u, int wr, int wc, int fr, int fq) const {
        const int e = u.pn >> 3, nt = u.pn & 7; const int colg = nt * 128 + wc * 32 + 8 * fq;
        f32x4 bg[2], bu[2];
#pragma unroll
        for (int n = 0; n < 2; ++n) { bg[n] = *(const GAS f32x4*)(bias + (size_t)e * 2048 + colg + 4 * n); bu[n] = *(const GAS f32x4*)(bias + (size_t)e * 2048 + 1024 + colg + 4 * n); }
#pragma unroll
        for (int ai = 0; ai < 2; ++ai)
#pragma unroll
            for (int m = 0; m < 4; ++m) { const size_t row = (size_t)(u.pm * 256 + ai * 128 + wr * 64 + m * 16 + fr); float a8[8];
#pragma unroll
                for (int n = 0; n < 2; ++n)
#pragma unroll
                    for (int i = 0; i < 4; ++i) { float g = fmaf(acc[ai][0][m][n][i], 1.f / WGU_SCALE, bg[n][i]), up = fmaf(acc[ai][1][m][n][i], 1.f / WGU_SCALE, bu[n][i]);
                        g = fminf(g, 7.f); up = fminf(fmaxf(up, -7.f), 7.f);
                        a8[n * 4 + i] = g * (up + 1.f) * __builtin_amdgcn_rcpf(1.f + __builtin_amdgcn_exp2f(-1.702f * 1.4426950408889634f * g)); }
                v2u w; w.x = pk4_fp8(a8[0], a8[1], a8[2], a8[3]); w.y = pk4_fp8(a8[4], a8[5], a8[6], a8[7]);
                st8_wt(O + row * 1024 + colg, w.x, w.y); }
    }
};
struct EpiDown {
    static constexpr bool PERM = true, AFTER_DRAIN = false;
    bf16* O; const float* bias;
    __device__ __forceinline__ void operator()(const pg8::f32x4 (&acc)[2][2][4][2], const pg8::Unit& u, int wr, int wc, int fr, int fq) const {
        const int col0 = (u.pn & 3) * 256 + wc * 32 + 8 * fq; const float* bp = bias + (size_t)(u.pn >> 2) * 1024 + col0;
        f32x4 bv[2][2];
#pragma unroll
        for (int bj = 0; bj < 2; ++bj)
#pragma unroll
            for (int n = 0; n < 2; ++n) bv[bj][n] = *(const GAS f32x4*)(bp + bj * 128 + 4 * n);
#pragma unroll
        for (int ai = 0; ai < 2; ++ai)
#pragma unroll
            for (int m = 0; m < 4; ++m) { bf16* rowp = O + (size_t)(u.pm * 256 + ai * 128 + wr * 64 + m * 16 + fr) * 1024 + col0;
#pragma unroll
                for (int bj = 0; bj < 2; ++bj) { const f32x4 v0 = acc[ai][bj][m][0] * (1.f / WDN_SCALE) + bv[bj][0], v1 = acc[ai][bj][m][1] * (1.f / WDN_SCALE) + bv[bj][1];
                    v4u w; w.x = pk2(v0[0], v0[1]); w.y = pk2(v0[2], v0[3]); w.z = pk2(v1[0], v1[1]); w.w = pk2(v1[2], v1[3]);
                    st16_wt(rowp + bj * 128, w.x, w.y, w.z, w.w); } }
    }
};
struct MoeSched {
    const LAS int* tab; int n;
    __device__ __forceinline__ bool next(int i, pg8::Unit& u) const {
        if (i >= n) return false;
        const int v = __builtin_amdgcn_readfirstlane(tab[1 + i]); u.pm = v >> 16; u.pn = v & 0xffff; return true;
    }
    __device__ __forceinline__ void a_ready(const pg8::Unit&) const {}
    __device__ __forceinline__ void done(const pg8::Unit&) const {}
};
#ifndef MOE_UNIT_OWNER
#define MOE_UNIT_OWNER F.vcu
#endif
__device__ __forceinline__ int moe_table(Frame& F, int l, int ntn) {
    LAS int* tab = (LAS int*)(F.lds + TAB_OFF);
    if (F.wave == 0) {
        const int lane = F.lane; const int cnt = lane < NE ? (int)__hip_atomic_load(F.ctl + CW_CNT + 64 * l + lane, RLX_AGENT) : 0; const int mt = (cnt + 255) >> 8; int incl = mt;
#pragma unroll
        for (int o = 1; o < 64; o <<= 1) { const int v = __shfl_up(incl, o); if (lane >= o) incl += v; }
        const int total = __shfl(incl, 63) * ntn; const int c = MOE_UNIT_OWNER;
        const int xcd = c >> 5, jw = c & 31, uq = total >> 3, ur = total & 7, cntx = uq + (xcd < ur ? 1 : 0), basex = xcd * uq + (xcd < ur ? xcd : ur);
        const int nmine = jw < cntx ? (cntx - jw + 31) >> 5 : 0;
        for (int i0 = 0; i0 < nmine && i0 < 200; i0 += 64) { const int i = i0 + lane; const int L = basex + i * 32 + jw; int e = 0;
            for (int k = 0; k < NE; ++k) { const int endk = __shfl(incl, k) * ntn; e += (L >= endk) ? 1 : 0; }
            e = e < NE ? e : NE - 1;
            const int excl_e = __shfl(incl, e) - __shfl(mt, e); int mte = __shfl(mt, e); mte = mte > 0 ? mte : 1; const int idx = L - excl_e * ntn;
            if (i < nmine && i < 200) tab[1 + i] = ((excl_e + idx % mte) << 16) | (e * ntn + idx / mte); }
        if (lane == 0) tab[0] = nmine < 200 ? nmine : 200;
    }
    __syncthreads();
    return __builtin_amdgcn_readfirstlane(tab[0]);
}

__device__ __forceinline__ void p_router(Frame& F, const In6& A, int l) {
    const int lane = F.lane, wave = F.wave, tid = F.tid;
    constexpr int XROW = 2064;
    LAS unsigned char* XH = F.lds; LAS unsigned char* XL = F.lds + 16 * XROW;
    LAS float* part = (LAS float*)(F.lds + 2 * 16 * XROW);
    LAS int* cnt = (LAS int*)(F.lds + 2 * 16 * XROW + 16384);
    LAS float* lgs = (LAS float*)(F.lds + 2 * 16 * XROW + 16384 + 1024);
    LAS float* top = lgs + 512;
    const GAS bf16* Y1 = (const GAS bf16*)(F.ws + WS_Y1); GAS bf16* X1B = (GAS bf16*)(F.ws + WS_Y1 + 32 * MiB); GAS unsigned* XB8 = (GAS unsigned*)(F.ws + WS_XB8);
    GAS int* TOPE = (GAS int*)(F.ws + WS_ROUTE); GAS float* GATE = (GAS float*)(TOPE + 8 * T); GAS int* CNTW = (GAS int*)(F.ws + WS_CNTW);
    const GAS float* g1 = (const GAS float*)(A.p[0] + l * D); const GAS float* b1 = (const GAS float*)(A.p[1] + l * D);
    const GAS float* RW = (const GAS float*)(A.p[2] + (size_t)l * D * NE); const GAS float* RB = (const GAS float*)(A.p[3] + l * NE);
    if (tid < 256) cnt[tid] = 0;
    bf16x8 wh[4][2], wl[4][2];
#pragma unroll
    for (int st = 0; st < 4; ++st)
#pragma unroll
        for (int hf = 0; hf < 2; ++hf) { const GAS float* wp = RW + (size_t)(wave * 128 + st * 32 + (lane >> 4) * 8) * NE + (lane & 15) + 16 * hf;
#pragma unroll
            for (int j = 0; j < 8; ++j) { const float w = wp[(size_t)j * NE]; const unsigned h = f2bf(w); const float r = w - __builtin_bit_cast(float, h << 16); wh[st][hf][j] = (short)h; wl[st][hf][j] = (short)f2bf(r); } }
    f32x4 g1v[4], b1v[4];
#pragma unroll
    for (int j = 0; j < 4; ++j) { g1v[j] = ((const GAS f32x4*)g1)[lane + 64 * j]; b1v[j] = ((const GAS f32x4*)b1)[lane + 64 * j]; }
    const float rb_e = RB[tid & 31];
    v2u yq[2][4];
#pragma unroll
    for (int i = 0; i < 2; ++i) { const GAS v2u* yr = (const GAS v2u*)(Y1 + (size_t)(F.vcu * 64 + wave * 2 + i) * D) + lane;
#pragma unroll
        for (int j = 0; j < 4; ++j) yq[i][j] = yr[64 * j]; }
    for (int g = 0; g < 4; ++g) {
        const int t0 = F.vcu * 64 + g * 16;
#pragma unroll
        for (int i = 0; i < 2; ++i) { const int tl = wave * 2 + i, t = t0 + tl;
            GAS u64* xr1 = (GAS u64*)(X1B + (size_t)t * D) + lane; f32x4 v[4]; float s = 0.f;
#pragma unroll
            for (int j = 0; j < 4; ++j) { const v2u q = yq[i][j]; v[j] = (f32x4){bflo(q.x), bfhi(q.x), bflo(q.y), bfhi(q.y)}; s += (v[j].x + v[j].y) + (v[j].z + v[j].w); }
            if (g < 3) { const GAS v2u* yr = (const GAS v2u*)(Y1 + (size_t)(t + 16) * D) + lane;
#pragma unroll
                for (int j = 0; j < 4; ++j) yq[i][j] = yr[64 * j]; }
            const float mean = wave_sum(s) * (1.f / D); float s2 = 0.f;
#pragma unroll
            for (int j = 0; j < 4; ++j) { v[j] = v[j] - mean; s2 += (v[j].x * v[j].x + v[j].y * v[j].y) + (v[j].z * v[j].z + v[j].w * v[j].w); }
            const float rstd = rsqrtf(wave_sum(s2) * (1.f / D) + LN_EPS);
            GAS unsigned* o8 = XB8 + (size_t)t * (D / 4) + lane;
#pragma unroll
            for (int j = 0; j < 4; ++j) { const f32x4 y = v[j] * rstd * g1v[j] + b1v[j];
                o8[64 * j] = pk4_fp8(y.x, y.y, y.z, y.w);
                const unsigned h0 = f2bf(y.x), h1 = f2bf(y.y), h2 = f2bf(y.z), h3 = f2bf(y.w);
                const u64 hp = (u64)(h0 | (h1 << 16)) | ((u64)(h2 | (h3 << 16)) << 32); xr1[64 * j] = hp;
                const float r0 = y.x - __builtin_bit_cast(float, h0 << 16), r1 = y.y - __builtin_bit_cast(float, h1 << 16), r2 = y.z - __builtin_bit_cast(float, h2 << 16), r3 = y.w - __builtin_bit_cast(float, h3 << 16);
                *(LAS u64*)(XH + tl * XROW + (lane + 64 * j) * 8) = hp;
                *(LAS u64*)(XL + tl * XROW + (lane + 64 * j) * 8) = (u64)pk2(r0, r1) | ((u64)pk2(r2, r3) << 32); } }
        __syncthreads();
        f32x4 acc[2]; acc[0] = (f32x4){0.f, 0.f, 0.f, 0.f}; acc[1] = acc[0];
#pragma unroll
        for (int st = 0; st < 4; ++st) { const int boff = (lane & 15) * XROW + (wave * 128 + st * 32 + (lane >> 4) * 8) * 2;
            const bf16x8 bh = *(const LAS bf16x8*)(XH + boff), bl = *(const LAS bf16x8*)(XL + boff);
#pragma unroll
            for (int hf = 0; hf < 2; ++hf) { acc[hf] = __builtin_amdgcn_mfma_f32_16x16x32_bf16(wh[st][hf], bh, acc[hf], 0, 0, 0); acc[hf] = __builtin_amdgcn_mfma_f32_16x16x32_bf16(wh[st][hf], bl, acc[hf], 0, 0, 0);
                acc[hf] = __builtin_amdgcn_mfma_f32_16x16x32_bf16(wl[st][hf], bh, acc[hf], 0, 0, 0); } }
#pragma unroll
        for (int hf = 0; hf < 2; ++hf)
#pragma unroll
            for (int r = 0; r < 4; ++r) part[((wave * 2 + hf) * 16 + 4 * (lane >> 4) + r) * 16 + (lane & 15)] = acc[hf][r];
        __syncthreads();
        { const int tl = tid >> 5, e = tid & 31, t = t0 + tl; float lg = rb_e;
#pragma unroll
            for (int w = 0; w < 8; ++w) lg += part[((w * 2 + (e >> 4)) * 16 + (e & 15)) * 16 + tl];
            lgs[tl * 32 + e] = lg;
            LDS_WAIT(); asm volatile("" ::: "memory");
            int rank = 0;
#pragma unroll
            for (int q = 0; q < 8; ++q) { const f32x4 o = *(const LAS f32x4*)(lgs + tl * 32 + 4 * q);
#pragma unroll
                for (int i = 0; i < 4; ++i) { const int eo = 4 * q + i; rank += (o[i] > lg || (o[i] == lg && eo < e)) ? 1 : 0; } }
            if (rank < 4) { top[tl * 4 + rank] = lg; __hip_atomic_fetch_add(cnt + ((g * 16 + tl) >> 3) * 32 + e, 1, __ATOMIC_RELAXED, __HIP_MEMORY_SCOPE_WORKGROUP); }
            LDS_WAIT(); asm volatile("" ::: "memory");
            const f32x4 sv = *(const LAS f32x4*)(top + tl * 4);
            const float e1 = expf(sv[1] - sv[0]), e2 = expf(sv[2] - sv[0]), e3 = expf(sv[3] - sv[0]); const float inv = 1.f / (1.f + e1 + e2 + e3);
            if (rank < 4) { const float gk = (rank == 0 ? 1.f : rank == 1 ? e1 : rank == 2 ? e2 : e3) * inv; TOPE[4 * t + rank] = e; GATE[4 * t + rank] = gk; } }
    }
    __syncthreads();
    if (tid < 256) CNTW[(F.vcu * NWAVES + (tid >> 5)) * NE + (tid & 31)] = cnt[tid];
    __syncthreads();
}

__device__ __forceinline__ void p_gather(Frame& F, int l) {
    const int gw = F.vcu * NWAVES + F.wave, NGW = F.G * NWAVES, lane = F.lane, tid = F.tid;
    const int TPW = T / NGW, NIT = TPW * 4;
    const GAS int* CNTW = (const GAS int*)(F.ws + WS_CNTW);
    LAS int* red = (LAS int*)F.lds;
    LAS int* baseE = red + 1024; LAS int* totE = baseE + 32;
    { const int e = tid & 31, part = tid >> 5, first = F.vcu * NWAVES; int sb = 0, st = 0;
        for (int g0 = part; g0 < NGW; g0 += 256) { int c[16];
#pragma unroll
            for (int k = 0; k < 16; ++k) c[k] = g0 + 16 * k < NGW ? CNTW[(g0 + 16 * k) * NE + e] : 0;
#pragma unroll
            for (int k = 0; k < 16; ++k) { st += c[k]; sb += g0 + 16 * k < first ? c[k] : 0; } }
        red[part * 32 + e] = sb; red[512 + part * 32 + e] = st; }
    __syncthreads();
    if (tid < 32) { int sb = 0, st = 0;
#pragma unroll
        for (int p = 0; p < 16; ++p) { sb += red[p * 32 + tid]; st += red[512 + p * 32 + tid]; }
        baseE[tid] = sb; totE[tid] = st;
        if (F.vcu == 0) __hip_atomic_store(F.ctl + CW_CNT + 64 * l + tid, (unsigned)st, RLX_AGENT); }
    __syncthreads();
    int mybase = 0, tot = 0;
    if (lane < NE) { mybase = baseE[lane]; tot = totE[lane]; int cw[NWAVES - 1];
#pragma unroll
        for (int w = 0; w < NWAVES - 1; ++w) cw[w] = CNTW[(F.vcu * NWAVES + w) * NE + lane];
#pragma unroll
        for (int w = 0; w < NWAVES - 1; ++w) mybase += w < F.wave ? cw[w] : 0; }
    const int mt = (tot + 255) >> 8; int incl = mt;
#pragma unroll
    for (int o = 1; o < 64; o <<= 1) { const int v = __shfl_up(incl, o); if (lane >= o) incl += v; }
    const int pstart = (incl - mt) * 256;
    const GAS int* TOPE = (const GAS int*)(F.ws + WS_ROUTE); GAS int* ROWOF = (GAS int*)(F.ws + WS_ROUTE) + 12 * T; GAS int* ROWTOK = (GAS int*)(F.ws + WS_XS);
    if (F.vcu < NE && F.wave == 0) {
        const int e = F.vcu; const int ps = __builtin_amdgcn_readlane(pstart, e), te = __builtin_amdgcn_readlane(tot, e), me = __builtin_amdgcn_readlane(mt, e);
        for (int i = te + lane; i < me * 256; i += 64) ROWTOK[ps + i] = 0; }
    const int it0 = gw * NIT; const int ei = lane < NIT ? TOPE[it0 + lane] : 0; int rk = 0;
    for (int j = 0; j < NIT; ++j) { const int ej = __shfl(ei, j); rk += (j < lane && ej == ei) ? 1 : 0; }
    const int row = __shfl(pstart, ei) + __shfl(mybase, ei) + rk;
    if (lane < NIT) { ROWOF[it0 + lane] = row; ROWTOK[row] = (it0 + lane) >> 2; }
    __syncthreads();
}

__device__ __forceinline__ void p_combine(Frame& F, const In6& A, int l, float* xout_) {
    constexpr int TPW = 8;
    const int gw = F.vcu * NWAVES + F.wave, NGW = F.G * NWAVES, lane = F.lane;
    const GAS int* ROWOF = (const GAS int*)(F.ws + WS_ROUTE) + 12 * T; const GAS float* GATE = (const GAS float*)(F.ws + WS_ROUTE) + 8 * T;
    const GAS bf16* X1B = (const GAS bf16*)(F.ws + WS_Y1 + 32 * MiB); const GAS bf16* YS = (const GAS bf16*)(F.ws + WS_YS); GAS bf16* XB = (GAS bf16*)(F.ws + WS_XB);
    GAS float* xout = (GAS float*)xout_;
    const GAS f32x4* g2 = (const GAS f32x4*)(A.p[0] + l * D) + lane; const GAS f32x4* b2 = (const GAS f32x4*)(A.p[1] + l * D) + lane;
    int rowv = 0; float gatev = 0.f;
    if (lane < 4 * TPW) { const int tk = gw + (lane >> 2) * NGW; rowv = ROWOF[4 * tk + (lane & 3)]; gatev = GATE[4 * tk + (lane & 3)]; }
    f32x4 gg[4], bb[4];
#pragma unroll
    for (int j = 0; j < 4; ++j) { gg[j] = g2[64 * j]; bb[j] = b2[64 * j]; }
    v2u xq[2][4], yq[2][4][4];
#define CMB_ISSUE(k, bf) do { const int t_ = gw + (k) * NGW; const GAS v2u* xr_ = (const GAS v2u*)(X1B + (size_t)t_ * D) + lane; \
        _Pragma("unroll") for (int j = 0; j < 4; ++j) xq[bf][j] = xr_[64 * j]; \
        _Pragma("unroll") for (int c = 0; c < 4; ++c) { const int row_ = __builtin_amdgcn_readlane(rowv, 4 * (k) + c); const GAS v2u* yr_ = (const GAS v2u*)(YS + (size_t)row_ * D) + lane; \
            _Pragma("unroll") for (int j = 0; j < 4; ++j) yq[bf][c][j] = yr_[64 * j]; } } while (0)
    CMB_ISSUE(0, 0);
#pragma unroll
    for (int k = 0; k < TPW; ++k) {
        const int bf = k & 1, t = gw + k * NGW;
        if (k + 1 < TPW) { if (bf == 0) CMB_ISSUE(k + 1, 1); else CMB_ISSUE(k + 1, 0); }
        f32x4 v[4];
#pragma unroll
        for (int j = 0; j < 4; ++j) { const v2u q = xq[bf][j]; v[j] = (f32x4){bflo(q.x), bfhi(q.x), bflo(q.y), bfhi(q.y)} * DN_ALPHA; }
#pragma unroll
        for (int c = 0; c < 4; ++c) { const float gk = __builtin_bit_cast(float, __builtin_amdgcn_readlane(__builtin_bit_cast(int, gatev), 4 * k + c));
#pragma unroll
            for (int j = 0; j < 4; ++j) { const v2u w = yq[bf][c][j]; v[j].x += gk * bflo(w.x); v[j].y += gk * bfhi(w.x); v[j].z += gk * bflo(w.y); v[j].w += gk * bfhi(w.y); } }
        float s = 0.f;
#pragma unroll
        for (int j = 0; j < 4; ++j) s += (v[j].x + v[j].y) + (v[j].z + v[j].w);
        const float mean = wave_sum(s) * (1.f / D); float s2 = 0.f;
#pragma unroll
        for (int j = 0; j < 4; ++j) { v[j] = v[j] - mean; s2 += (v[j].x * v[j].x + v[j].y * v[j].y) + (v[j].z * v[j].z + v[j].w * v[j].w); }
        const float rstd = rsqrtf(wave_sum(s2) * (1.f / D) + LN_EPS);
        GAS f32x4* orow = (GAS f32x4*)(xout + (size_t)t * D) + lane; GAS u64* o8 = (GAS u64*)(XB + (size_t)t * D) + lane;
#pragma unroll
        for (int j = 0; j < 4; ++j) { const f32x4 y = v[j] * rstd * gg[j] + bb[j];
            if (xout_) orow[64 * j] = y; else o8[64 * j] = (u64)pk2(y.x, y.y) | ((u64)pk2(y.z, y.w) << 32); }
        __builtin_amdgcn_sched_barrier(0);
    }
#undef CMB_ISSUE
}


#define NI __device__ __forceinline__
NI void ph_prologue(unsigned char* ws, LAS unsigned char* lds, const float* a0, const float* a1, const float* a2, const float* a3, const float* a4) { Frame F = make_frame(ws, lds); In6 I{{uni(a0), uni(a1), uni(a2), uni(a3), uni(a4), nullptr}}; p_prologue(F, I); }
NI void ph_local(unsigned char* ws, LAS unsigned char* lds, int l, const float* a0, const float* a1, const float* a2, const float* a3, const float* a4) { Frame F = make_frame(ws, lds); In6 I{{uni(a0), uni(a1), uni(a2), uni(a3), uni(a4), nullptr}}; p_local(F, I, __builtin_amdgcn_readfirstlane(l)); }
NI void ph_scores(unsigned char* ws, LAS unsigned char* lds) { Frame F = make_frame(ws, lds); p_index(F); }
NI void ph_attn(unsigned char* ws, LAS unsigned char* lds) { Frame F = make_frame(ws, lds); p_attn_dense(F); }
NI void ph_router(unsigned char* ws, LAS unsigned char* lds, int l, const float* a0, const float* a1, const float* a2, const float* a3) { Frame F = make_frame(ws, lds); In6 I{{uni(a0), uni(a1), uni(a2), uni(a3), nullptr, nullptr}}; p_router(F, I, __builtin_amdgcn_readfirstlane(l)); }
NI void ph_gather(unsigned char* ws, LAS unsigned char* lds, int l) { Frame F = make_frame(ws, lds); p_gather(F, __builtin_amdgcn_readfirstlane(l)); }
NI void ph_combine(unsigned char* ws, LAS unsigned char* lds, int l, const float* a0, const float* a1, float* xout) { Frame F = make_frame(ws, lds); In6 I{{uni(a0), uni(a1), nullptr, nullptr, nullptr, nullptr}}; p_combine(F, I, __builtin_amdgcn_readfirstlane(l), (float*)uni(xout)); }

NI void ph_gemm_in(unsigned char* ws, LAS unsigned char* lds, int l_) {
    Frame F = make_frame(ws, lds); const int l = __builtin_amdgcn_readfirstlane(l_);
    pg8::Gemm g{WSP(bf16, WS_XB), WSP(bf16, WS_WIN) + (size_t)l * NINP * D, T, NINP, D}; pg8::StaticOrder S; S.init(T, NINP, F.G, (int)blockIdx.x);
    pg8::EpiBf16<0> E{WSP(bf16, WS_PROJ), NINP, nullptr, 0, 0, 1.f};
    pg8::gemm_phase<pg8::EpiBf16<0>, pg8::StaticOrder, PG8_ALIGN, PG8_SP2>(F.lds, g, S, E);
}
NI void ph_gemm_out(unsigned char* ws, LAS unsigned char* lds, int l_, const float* xin) {
    Frame F = make_frame(ws, lds); const int l = __builtin_amdgcn_readfirstlane(l_);
    pg8::Gemm g{WSP(bf16, WS_CAT), WSP(bf16, WS_WOUT) + (size_t)l * D * D, T, D, D}; pg8::StaticOrder S; S.init(T, D, F.G, (int)blockIdx.x);
    EpiResid E{WSP(bf16, WS_XB), WSP(bf16, WS_Y1), DN_ALPHA};
    pg8::gemm_phase<EpiResid, pg8::StaticOrder, PG8_ALIGN, PG8_SP2>(F.lds, g, S, E);
}
NI void ph_gemm_moe1(unsigned char* ws, LAS unsigned char* lds, int l_, const float* bgu) {
    Frame F = make_frame(ws, lds); const int l = __builtin_amdgcn_readfirstlane(l_);
    const int nun = moe_table(F, l, 8);
    pg8::Gemm g{WSP(bf16, WS_XB8), (const bf16*)(WSP(unsigned char, WS_WGU) + (size_t)l * NE * 2048 * D * 2), MAXROWS, NE * 2048, D};
    MoeSched S{(const LAS int*)(F.lds + TAB_OFF), nun};
    EpiSwiglu E{WSP(unsigned char, WS_ACT), uni(bgu) + (size_t)l * NE * 2048};
    pg8::gemm_phase<EpiSwiglu, MoeSched, PG8_ALIGN, true, 1, true>(F.lds, g, S, E, WSP(int, WS_XS));
}
NI void ph_gemm_moe2(unsigned char* ws, LAS unsigned char* lds, int l_, const float* bdn) {
    Frame F = make_frame(ws, lds); const int l = __builtin_amdgcn_readfirstlane(l_);
    const int nun = moe_table(F, l, 4);
    pg8::Gemm g{WSP(bf16, WS_ACT), (const bf16*)(WSP(unsigned char, WS_WDN) + (size_t)l * NE * D * D * 2), MAXROWS, NE * D, D};
    MoeSched S{(const LAS int*)(F.lds + TAB_OFF), nun};
    EpiDown E{WSP(bf16, WS_YS), uni(bdn) + (size_t)l * NE * D};
    pg8::gemm_phase<EpiDown, MoeSched, PG8_ALIGN, MOE_SP2, 1>(F.lds, g, S, E);
}

__device__ __forceinline__ const float* karg_in(int i) { return ((const float* const volatile*)__builtin_amdgcn_kernarg_segment_ptr())[i]; }
__device__ __forceinline__ float* karg_out() { return ((float* const volatile*)__builtin_amdgcn_kernarg_segment_ptr())[N_IN]; }
#ifndef PHMASK
#define PHMASK 0x7FF
#endif
constexpr int PH_PER_LAYER = 10, N_PHASES = 1 + DEPTH * PH_PER_LAYER;
#define IN(k) (lo <= (k) && (k) < hi)
#define SEAM(k) do { if (IN(k) && IN((k) + 1)) xcd_barrier(bar); } while (0)
template <int l> __device__ __forceinline__ void layer_phases(Frame& F, const XcdBarrier& bar, int lo, int hi) {
        const int p0 = 1 + l * PH_PER_LAYER;
        const float* xin = nullptr;
        float* xout = l == DEPTH - 1 ? karg_out() : nullptr;
        if (((PHMASK >> 0) & 1) && IN(p0 + 0)) { asm volatile("; PHASE_BEGIN_0"); ph_gemm_in(F.ws, F.lds, l); SEAM(p0 + 0); }
        if (((PHMASK >> 1) & 1) && IN(p0 + 1)) { asm volatile("; PHASE_BEGIN_1"); ph_local(F.ws, F.lds, l, karg_in(IN_WPOOL), karg_in(IN_CONVW), karg_in(IN_PSCALE), karg_in(IN_KNG), karg_in(IN_KNB)); SEAM(p0 + 1); }
        if (((PHMASK >> 2) & 1) && IN(p0 + 2)) { asm volatile("; PHASE_BEGIN_2"); ph_scores(F.ws, F.lds); SEAM(p0 + 2); }
        if (((PHMASK >> 3) & 1) && IN(p0 + 3)) { asm volatile("; PHASE_BEGIN_3"); ph_attn(F.ws, F.lds); SEAM(p0 + 3); }
        if (((PHMASK >> 4) & 1) && IN(p0 + 4)) { asm volatile("; PHASE_BEGIN_4"); ph_gemm_out(F.ws, F.lds, l, xin); SEAM(p0 + 4); }
        if (((PHMASK >> 5) & 1) && IN(p0 + 5)) { asm volatile("; PHASE_BEGIN_5"); ph_router(F.ws, F.lds, l, karg_in(IN_LN1G), karg_in(IN_LN1B), karg_in(IN_RW), karg_in(IN_RB)); SEAM(p0 + 5); }
        if (((PHMASK >> 6) & 1) && IN(p0 + 6)) { asm volatile("; PHASE_BEGIN_6"); ph_gather(F.ws, F.lds, l); SEAM(p0 + 6); }
        if (((PHMASK >> 7) & 1) && IN(p0 + 7)) { asm volatile("; PHASE_BEGIN_7"); ph_gemm_moe1(F.ws, F.lds, l, karg_in(IN_BGU)); SEAM(p0 + 7); }
        if (((PHMASK >> 8) & 1) && IN(p0 + 8)) { asm volatile("; PHASE_BEGIN_8"); ph_gemm_moe2(F.ws, F.lds, l, karg_in(IN_BDN)); SEAM(p0 + 8); }
        if (((PHMASK >> 9) & 1) && IN(p0 + 9)) { asm volatile("; PHASE_BEGIN_9"); ph_combine(F.ws, F.lds, l, karg_in(IN_LN2G), karg_in(IN_LN2B), xout); SEAM(p0 + 9); }
}
#undef IN
#undef SEAM
__global__ void __launch_bounds__(NWAVES * 64, 2) fwd_kernel(Args A) {
    extern __shared__ __attribute__((aligned(16))) unsigned char lds[];
    Frame F;
    F.lds = (LAS unsigned char*)lds;
    F.tid = threadIdx.x; F.lane = F.tid & 63; F.wave = __builtin_amdgcn_readfirstlane(F.tid >> 6);
    F.G = gridDim.x; { const int bx = blockIdx.x; F.vcu = (F.G % 8 == 0) ? (bx % 8) * (F.G / 8) + bx / 8 : bx; }
    F.ws = A.ws; F.ctl = (gu32*)(A.ws + WS_CTL);
    volatile LAS unsigned* MISC = (volatile LAS unsigned*)(F.lds + MISC_OFF);
    if (F.tid < 32) MISC[F.tid] = 0u;
    __syncthreads();
    const int lo = A.ph_lo, hi = A.ph_hi;
    const bool multi = (hi - lo) > 1;
    XcdBarrier bar; bar.bar = (unsigned*)(F.ctl + CW_BAR); bar.x = 0; bar.st = nullptr;
    if (multi) bar = xcd_barrier_post((unsigned*)(F.ctl + CW_BAR), MISC + 8);
#define IN(k) (lo <= (k) && (k) < hi)
#define SEAM(k) do { if (IN(k) && IN((k) + 1)) xcd_barrier(bar); } while (0)

    if (((PHMASK >> 10) & 1) && IN(0)) { asm volatile("; PHASE_BEGIN_11"); ph_prologue(F.ws, F.lds, karg_in(IN_WIN), karg_in(IN_WOUT), karg_in(IN_WGU), karg_in(IN_WDN), karg_in(IN_X)); SEAM(0); }
    layer_phases<0>(F, bar, lo, hi);
    layer_phases<1>(F, bar, lo, hi);
#undef IN
#undef SEAM
}


#ifdef DUMP_OFF
__global__ void dump_kernel(const unsigned* w, size_t nwords, float* out, int n) {
    const int i = blockIdx.x * blockDim.x + threadIdx.x; if (i >= n) return;
#ifdef DUMP_NAN_ALL
    { bool bad = false; for (size_t j = (size_t)i; j < nwords; j += (size_t)n) { const unsigned x = w[j]; bad |= ((x & 0x7f80u) == 0x7f80u) || ((x & 0x7f800000u) == 0x7f800000u); } out[i] = bad ? 1e6f : 0.f; return; }
#endif
#ifdef DUMP_MASKCHECK
    { out[i] = 0.f; if ((i & 1023) == 0) { const int t = i >> 10, sq = t & 4095; const unsigned long long* mt = (const unsigned long long*)w + ((size_t)(t >> 12) * 64) * 4096 + sq; int pc = 0; bool beyond = false;
        for (int j = 0; j < 64; ++j) { const unsigned long long m = mt[(size_t)j * 4096]; pc += __popcll(m); for (int bb = 0; bb < 64; ++bb) if (((m >> bb) & 1ull) && 64 * j + bb > sq) beyond = true; }
        const int expect = sq + 1 < 256 ? sq + 1 : 256;
#if DUMP_MASKCHECK == 1
        if (pc != expect) out[i] = 1e6f;
#else
        if (beyond) out[i] = 1e6f;
#endif
      } return; }
#endif
#ifdef DUMP_NANCHECK
#if DUMP_NANCHECK == 2
    { size_t wi = (size_t)i;
#ifdef DUMP_ROWW
      wi = ((size_t)i / DUMP_COLW) * DUMP_ROWW + ((size_t)i % DUMP_COLW);
#endif
      if (wi >= nwords) { out[i] = 0.f; return; } const unsigned x = w[wi]; const bool bad = ((x & 0x7f80u) == 0x7f80u) || ((x & 0x7f800000u) == 0x7f800000u);
#ifdef DUMP_LOC
      { const int sq = (int)(wi / 512) & 4095; out[i] = bad ? 1000.f * (float)(DUMP_LOC == 1 ? sq + 1 : 4096 - sq) : 0.f; return; }
#endif
      out[i] = bad ? 1e6f : 0.f; return; }
#else
    { const float v = ((const float*)w)[i]; out[i] = (v == v && fabsf(v) < 1e30f) ? 0.f : 1e6f; return; }
#endif
#endif
#ifdef DUMP_VIA_ROWOF
    unsigned h; { const unsigned short* src = (const unsigned short*)w; const int* rowof = (const int*)((const char*)w - (size_t)(DUMP_OFF) + WS_ROUTE) + 12 * T; const int t = i >> 10, c = i & 1023;
        h = 0u; for (int k = 0; k < 4; ++k) h = h * 0x9E3779B1u + src[(size_t)rowof[4 * t + k] * 1024 + c]; }
#elif defined(DUMP_ROWW)
    unsigned h = 0u; { const size_t row = (size_t)i / DUMP_COLW, cw = (size_t)i % DUMP_COLW; if (row * DUMP_ROWW + cw < nwords) h = w[row * DUMP_ROWW + cw]; }
#else
    unsigned h = 0u; int k = 1; for (size_t j = (size_t)i; j < nwords; j += (size_t)n, k += 2) h ^= w[j] * (unsigned)k;
#endif
    out[i] = (float)((h ^ (h >> 11) ^ (h >> 22)) & 0xFFFFFu);
}
#endif
#ifndef MK_ONE_LAUNCH
#define MK_ONE_LAUNCH 0
#endif
extern "C" void kernel_launch(void* const* d_in, const int* in_sizes, int n_in, void* d_out, int out_size, void* d_ws, size_t ws_size, hipStream_t stream) {
    static int grid = 0;
    if (grid == 0) {
        if (n_in != N_IN || in_sizes[0] != T * D || out_size != T * D || ws_size < WS_END) { fprintf(stderr, "kernel_launch: unexpected shapes (n_in %d, in0 %d, out %d, ws %zu, need %zu); nothing launched\n", n_in, n_in > 0 ? in_sizes[0] : -1, out_size, ws_size, (size_t)WS_END); grid = -1; return; }
        int dev = 0, cus = 0, per_cu = 0;
        if (hipGetDevice(&dev) != hipSuccess || hipDeviceGetAttribute(&cus, hipDeviceAttributeMultiprocessorCount, dev) != hipSuccess) { grid = -1; return; }
        if (hipFuncSetAttribute((const void*)fwd_kernel, hipFuncAttributeMaxDynamicSharedMemorySize, LDS_BYTES) != hipSuccess) { fprintf(stderr, "kernel_launch: hipFuncSetAttribute failed\n"); grid = -1; return; }
        if (hipOccupancyMaxActiveBlocksPerMultiprocessor(&per_cu, (const void*)fwd_kernel, NWAVES * 64, LDS_BYTES) != hipSuccess || per_cu < 1) fprintf(stderr, "kernel_launch: occupancy query reports %d\n", per_cu);
        (void)hipGetLastError();
        grid = cus;
        if (grid != 256) { fprintf(stderr, "kernel_launch: built for 256 CUs, found %d; nothing launched\n", cus); grid = -1; return; }
    }
    if (grid < 0) return;
    if (hipMemsetAsync((char*)d_ws + WS_CTL, 0, CTL_ZERO_BYTES, stream) != hipSuccess) return;
    Args a{};
    for (int i = 0; i < N_IN; ++i) a.in[i] = (const float*)d_in[i];
    a.out = (float*)d_out; a.ws = (unsigned char*)d_ws;
#if MK_ONE_LAUNCH
    a.ph_lo = 0; a.ph_hi = N_PHASES;
    hipLaunchKernelGGL(fwd_kernel, dim3(grid), dim3(NWAVES * 64), LDS_BYTES, stream, a);
#else
#ifdef DUMP_OFF
    for (int p = 0; p < DUMP_STOP; ++p) { a.ph_lo = p; a.ph_hi = p + 1; hipLaunchKernelGGL(fwd_kernel, dim3(grid), dim3(NWAVES * 64), LDS_BYTES, stream, a); }
    hipLaunchKernelGGL(dump_kernel, dim3((T * D + 255) / 256), dim3(256), 0, stream, (const unsigned*)((const char*)d_ws + (size_t)(DUMP_OFF)), (size_t)(DUMP_WORDS), (float*)d_out, T * D);
    return;
#endif
    for (int p = 0; p < N_PHASES; ++p) { a.ph_lo = p; a.ph_hi = p + 1; hipLaunchKernelGGL(fwd_kernel, dim3(grid), dim3(NWAVES * 64), LDS_BYTES, stream, a);
#ifdef DBL_PHASE
        if ((p == 0 && DBL_PHASE == 10) || (p > 0 && (p - 1) % PH_PER_LAYER == DBL_PHASE)) hipLaunchKernelGGL(fwd_kernel, dim3(grid), dim3(NWAVES * 64), LDS_BYTES, stream, a);
#endif
    }
#endif
}
```

```cpp
#include <hip/hip_runtime.h>
#include <cstdio>
#include <cstdint>

#define MK_ONE_LAUNCH 1
#define BAR_EARLY_INV 1
#ifndef WT_STORES
#define WT_STORES 0
#endif
__device__ __forceinline__ void st16_wt(void* p, unsigned x, unsigned y, unsigned z, unsigned w) {
    typedef unsigned u4_ __attribute__((ext_vector_type(4))); const u4_ v = {x, y, z, w};
#if WT_STORES
    asm volatile("global_store_dwordx4 %0, %1, off sc1\n\ts_nop 2" :: "v"((__attribute__((address_space(1))) void*)p), "v"(v) : "memory");
#else
    *(__attribute__((address_space(1))) u4_*)p = v;
#endif
}
__device__ __forceinline__ void st8_wt(void* p, unsigned x, unsigned y) {
    typedef unsigned u2_ __attribute__((ext_vector_type(2))); const u2_ v = {x, y};
#if WT_STORES
    asm volatile("global_store_dwordx2 %0, %1, off sc1" :: "v"((__attribute__((address_space(1))) void*)p), "v"(v) : "memory");
#else
    *(__attribute__((address_space(1))) u2_*)p = v;
#endif
}
namespace pg8 {
#define PG8_LAS __attribute__((address_space(3)))
typedef unsigned short bf16_t;
typedef short bf16x8 __attribute__((ext_vector_type(8)));
typedef float f32x4 __attribute__((ext_vector_type(4)));
typedef unsigned u32x4 __attribute__((ext_vector_type(4)));
typedef int v4i_t __attribute__((ext_vector_type(4)));
typedef int v8i_t __attribute__((ext_vector_type(8)));
constexpr int BM = 256, BK = 64, HALF = 128, HTB = HALF * BK * 2  , STAGE_BYTES = 8 * HTB, NXCD = 8, WGM = 8;

__host__ __device__ __forceinline__ int lds_byte(int r, int c) { const int st = (r >> 4) * 2 + (c >> 5), rr = r & 15, cc = c & 31, ob = rr * 64 + cc * 2; return st * 1024 + (ob ^ (((ob >> 9) & 1) << 5)); }
__host__ __device__ __forceinline__ void stage_rc(int b, int& R, int& C) { const int st = b / 1024, sb = b % 1024, swz = sb ^ (((sb >> 9) & 1) << 5); R = (st >> 1) * 16 + swz / 64; C = (st & 1) * 32 + (swz % 64) / 2; }
__host__ __device__ __forceinline__ int perm32(int rho) { const int n = rho >> 4, i = rho & 15; return 8 * (i >> 2) + 4 * n + (i & 3); }

struct Unit { int pm, pn; };
struct Gemm { const bf16_t* A; const bf16_t* Bt; int M, N, K; };

struct StaticOrder {
    int nM, nN, nwg, G, c;
    __host__ __device__ void init(int M, int N, int G_, int c_) { nM = M / BM; nN = N / BM; nwg = nM * nN; G = G_; c = c_; }
    __host__ __device__ bool next(int i, Unit& u) const {
        const long L = (long)i * G + c; if (L >= nwg) return false;
        int wgid = (int)L; { const int q = nwg / NXCD, r = nwg % NXCD, xcd = wgid % NXCD, off = wgid / NXCD; wgid = (xcd < r ? xcd * (q + 1) : r * (q + 1) + (xcd - r) * q) + off; }
        const int nig = WGM * nN, gid = wgid / nig, fm = gid * WGM, gsz = (nM - fm) < WGM ? (nM - fm) : WGM;
        u.pm = fm + ((wgid % nig) % gsz); u.pn = (wgid % nig) / gsz; return true;
    }
    __device__ __forceinline__ void a_ready(const Unit&) const {}
    __device__ __forceinline__ void done(const Unit&) const {}
};

__device__ __forceinline__ unsigned cvt_pk_bf16(float lo, float hi) { unsigned r; asm volatile("v_cvt_pk_bf16_f32 %0, %1, %2" : "=v"(r) : "v"(lo), "v"(hi)); return r; }
typedef float f32x2 __attribute__((ext_vector_type(2)));
__device__ __forceinline__ f32x2 gelu_pk(f32x2 v) {
    const f32x2 av = __builtin_elementwise_abs(v), d = av * 0.2316418882f + 1.0f;
    f32x2 t; t.x = __builtin_amdgcn_rcpf(d.x); t.y = __builtin_amdgcn_rcpf(d.y);
    f32x2 q = t * 0.5307027145f + (-0.7265760135f); q = q * t + 0.7107068705f; q = q * t + (-0.142248368f); q = q * t + 0.127414796f; q = q * t;
    const f32x2 s = (v * v) * (-0.72134752044f);
    f32x2 e; e.x = __builtin_amdgcn_exp2f(s.x); e.y = __builtin_amdgcn_exp2f(s.y);
    const f32x2 m = v * (q * e), r = v - m;
    f32x2 o; o.x = v.x < 0.f ? m.x : r.x; o.y = v.y < 0.f ? m.y : r.y; return o;
}

template <int ACT  > struct EpiBf16 {
    static constexpr bool PERM = true, AFTER_DRAIN = false; static_assert(ACT == 0 || ACT == 1, "EpiBf16: ACT is 0 (none) or 1 (gelu_pk)");
    bf16_t* O; int ldc; const float* bias; int split_cols; size_t split_stride; float scale0;
    __device__ __forceinline__ void operator()(const f32x4 (&acc)[2][2][4][2], const Unit& u, int wr, int wc, int fr, int fq) const {
        const int row0 = u.pm * BM + wr * 64 + fr; int colt = u.pn * BM; bf16_t* base = O;
        float sc = 1.f; if (split_cols) { const int t = colt / split_cols; base += (size_t)t * split_stride; colt -= t * split_cols; if (t == 0) sc = scale0; }
        const int col0 = colt + wc * 32 + 8 * fq, bcol0 = u.pn * BM + wc * 32 + 8 * fq;
        f32x4 bv[2][2];
#pragma unroll
        for (int bj = 0; bj < 2; ++bj)
#pragma unroll
            for (int n = 0; n < 2; ++n) bv[bj][n] = bias ? *(const __attribute__((address_space(1))) f32x4*)(bias + bcol0 + bj * HALF + 4 * n) : (f32x4){0.f, 0.f, 0.f, 0.f};
#pragma unroll
        for (int ai = 0; ai < 2; ++ai)
#pragma unroll
            for (int m = 0; m < 4; ++m) { bf16_t* rowp = base + (size_t)(row0 + ai * HALF + m * 16) * ldc + col0;
#pragma unroll
                for (int bj = 0; bj < 2; ++bj) { f32x4 v0 = acc[ai][bj][m][0] + bv[bj][0], v1 = acc[ai][bj][m][1] + bv[bj][1];
                    if (ACT == 1) { f32x2 a = gelu_pk((f32x2){v0[0], v0[1]}), b = gelu_pk((f32x2){v0[2], v0[3]}), c = gelu_pk((f32x2){v1[0], v1[1]}), d = gelu_pk((f32x2){v1[2], v1[3]});
                        v0 = (f32x4){a.x, a.y, b.x, b.y}; v1 = (f32x4){c.x, c.y, d.x, d.y}; }
                    v0 = v0 * sc; v1 = v1 * sc; u32x4 w; w.x = cvt_pk_bf16(v0[0], v0[1]); w.y = cvt_pk_bf16(v0[2], v0[3]); w.z = cvt_pk_bf16(v1[0], v1[1]); w.w = cvt_pk_bf16(v1[2], v1[3]);
                    st16_wt(rowp + bj * HALF, w.x, w.y, w.z, w.w); } }
    }
};

struct PanelStats {
    unsigned* xbuf;
    unsigned* cnt;
    unsigned* tmo;
    int ntn; float eps;
    unsigned code;
    __device__ __forceinline__ bool run(const f32x4 (&v)[2][2][4][2], const Unit& u, int wr, int wc, int fr, int fq, PG8_LAS unsigned char* lds, int wid, int lane) const {
        typedef float f32x2v __attribute__((ext_vector_type(2)));
        PG8_LAS f32x2v* P = (PG8_LAS f32x2v*)lds;
        PG8_LAS f32x2v* S = (PG8_LAS f32x2v*)(lds + 8192);
        PG8_LAS unsigned* flag = (PG8_LAS unsigned*)(lds + 8192 + 2048);
#pragma unroll
        for (int ai = 0; ai < 2; ++ai)
#pragma unroll
            for (int m = 0; m < 4; ++m) {
                float s = 0.f;
#pragma unroll
                for (int bj = 0; bj < 2; ++bj)
#pragma unroll
                    for (int n = 0; n < 2; ++n) { const f32x4 x = v[ai][bj][m][n]; s += (x[0] + x[1]) + (x[2] + x[3]); }
                s += __shfl_xor(s, 16); s += __shfl_xor(s, 32);
                const float mw = s * (1.0f / 64.0f); float q = 0.f;
#pragma unroll
                for (int bj = 0; bj < 2; ++bj)
#pragma unroll
                    for (int n = 0; n < 2; ++n) { const f32x4 d = v[ai][bj][m][n] - mw; q += (d[0] * d[0] + d[1] * d[1]) + (d[2] * d[2] + d[3] * d[3]); }
                q += __shfl_xor(q, 16); q += __shfl_xor(q, 32);
                if (fq == 0) P[(ai * HALF + wr * 64 + m * 16 + fr) * 4 + wc] = (f32x2v){mw, q};
            }
        asm volatile("s_waitcnt lgkmcnt(0)" ::: "memory"); __builtin_amdgcn_s_barrier(); asm volatile("" ::: "memory");
#if defined(BROKEN_EXCHANGE_NO_WAIT)
#warning BROKEN CONTROL BUILD: the row-statistics exchange does not wait; results are wrong by design
        if (blockIdx.x >= 64) { const long long t0_ = clock64(); while (clock64() - t0_ < 60000) __builtin_amdgcn_s_sleep(8); }
#endif
        const int row = wid * 32 + (lane & 31);
        if (lane < 32) {
            const f32x2v a = P[row * 4 + 0], b = P[row * 4 + 1], c = P[row * 4 + 2], d = P[row * 4 + 3];
            const float mt = (a.x + b.x + c.x + d.x) * 0.25f;
            const float da = a.x - mt, db = b.x - mt, dc = c.x - mt, dd = d.x - mt;
            const float m2 = (a.y + b.y) + (c.y + d.y) + 64.0f * ((da * da + db * db) + (dc * dc + dd * dd));
            unsigned long long* slot = (unsigned long long*)xbuf + ((size_t)(u.pm * BM + row) * 4 + u.pn);
            __hip_atomic_store(slot, ((unsigned long long)__float_as_uint(m2) << 32) | __float_as_uint(mt), __ATOMIC_RELAXED, __HIP_MEMORY_SCOPE_AGENT);
        }
        asm volatile("s_waitcnt vmcnt(0)" ::: "memory");
        if (lane == 0) __hip_atomic_fetch_add(cnt + 64 * u.pm, 1u, __ATOMIC_RELAXED, __HIP_MEMORY_SCOPE_AGENT);
        if (wid == 0) {
            bool dead = false; const unsigned long long t0 = __builtin_amdgcn_s_memrealtime(); const unsigned want = 8u * (unsigned)ntn;
            for (;;) {
#if defined(BROKEN_EXCHANGE_NO_WAIT)
                break;
#endif
                if ((unsigned)__builtin_amdgcn_readfirstlane(__hip_atomic_load(cnt + 64 * u.pm, __ATOMIC_RELAXED, __HIP_MEMORY_SCOPE_AGENT)) >= want) break;
                if (__builtin_amdgcn_s_memrealtime() - t0 > 2000000ull) {
                    if (lane == 0) { unsigned expect = 0u; __hip_atomic_compare_exchange_strong(tmo + 1, &expect, code | (unsigned)(u.pm & 0xff), __ATOMIC_RELAXED, __ATOMIC_RELAXED, __HIP_MEMORY_SCOPE_AGENT);
                                     __hip_atomic_store(tmo, 1u, __ATOMIC_RELAXED, __HIP_MEMORY_SCOPE_AGENT); }
                    dead = true; break; }
                __builtin_amdgcn_s_sleep(2);
            }
            __builtin_amdgcn_fence(__ATOMIC_ACQUIRE, "agent");
            if (lane == 0) flag[0] = dead ? 1u : 0u;
        }
        asm volatile("s_waitcnt vmcnt(0) lgkmcnt(0)" ::: "memory"); __builtin_amdgcn_s_barrier(); asm volatile("" ::: "memory");
        const bool bad = flag[0] != 0u;
        if (lane < 32) {
            const unsigned long long* slot = (const unsigned long long*)xbuf + (size_t)(u.pm * BM + row) * 4; float mt[4], m2[4]; float ms = 0.f;
#pragma unroll
            for (int t = 0; t < 4; ++t) { if (t < ntn) { const unsigned long long w = __hip_atomic_load(slot + t, __ATOMIC_RELAXED, __HIP_MEMORY_SCOPE_AGENT); mt[t] = __uint_as_float((unsigned)w); m2[t] = __uint_as_float((unsigned)(w >> 32)); } else { mt[t] = 0.f; m2[t] = 0.f; } ms += mt[t]; }
            const float mean = ms / (float)ntn; float q = 0.f;
#pragma unroll
            for (int t = 0; t < 4; ++t) if (t < ntn) { const float dm = mt[t] - mean; q += m2[t] + 256.0f * dm * dm; }
            S[row] = (f32x2v){mean, 1.0f / sqrtf(q / (256.0f * (float)ntn) + eps)};
        }
        asm volatile("s_waitcnt lgkmcnt(0)" ::: "memory"); __builtin_amdgcn_s_barrier(); asm volatile("" ::: "memory");
        return bad;
    }
};
struct EpiLnRes {
    static constexpr bool PERM = false, AFTER_DRAIN = true;
    const float* base; float* out; int ldc; const float* bias; PanelStats st; unsigned poison;
    __device__ __forceinline__ void fused(f32x4 (&acc)[2][2][4][2], const Unit& u, int wr, int wc, int fr, int fq, PG8_LAS unsigned char* lds, int wid, int lane) const {
        typedef float f32x2v __attribute__((ext_vector_type(2)));
        const PG8_LAS f32x2v* S = (const PG8_LAS f32x2v*)(lds + 8192);
        const int col0 = u.pn * BM + wc * 32 + 4 * fq;
#pragma unroll
        for (int bj = 0; bj < 2; ++bj)
#pragma unroll
            for (int n = 0; n < 2; ++n) { const f32x4 bv = bias ? *(const f32x4*)(bias + col0 + bj * HALF + n * 16) : (f32x4){0.f, 0.f, 0.f, 0.f};
#pragma unroll
                for (int ai = 0; ai < 2; ++ai)
#pragma unroll
                    for (int m = 0; m < 4; ++m) acc[ai][bj][m][n] += bv; }
        f32x4 pre[4][2][2];
#pragma unroll
        for (int m = 0; m < 4; ++m) { const size_t off = (size_t)(u.pm * BM + wr * 64 + m * 16 + fr) * ldc + col0;
#pragma unroll
            for (int bj = 0; bj < 2; ++bj)
#pragma unroll
                for (int n = 0; n < 2; ++n) pre[m][bj][n] = *(const f32x4*)(base + off + bj * HALF + n * 16); }
        const bool bad = st.run(acc, u, wr, wc, fr, fq, lds, wid, lane) || poison != 0u;
        const float qnan = __builtin_nanf("");
#pragma unroll
        for (int ai = 0; ai < 2; ++ai)
#pragma unroll
            for (int m = 0; m < 4; ++m) { const int r = ai * HALF + wr * 64 + m * 16 + fr; const f32x2v sr = S[r]; const size_t off = (size_t)(u.pm * BM + r) * ldc + col0;
#pragma unroll
                for (int bj = 0; bj < 2; ++bj)
#pragma unroll
                    for (int n = 0; n < 2; ++n) { const f32x4 bs = ai == 0 ? pre[m][bj][n] : *(const f32x4*)(base + off + bj * HALF + n * 16); f32x4 o = bs + (acc[ai][bj][m][n] - sr.x) * sr.y;
                        if (bad) o = (f32x4){qnan, qnan, qnan, qnan}; *(f32x4*)(out + off + bj * HALF + n * 16) = o; }
                if (m & 1) asm volatile("" ::: "memory"); }
    }
};
struct EpiLnResLn {
    static constexpr bool PERM = false, AFTER_DRAIN = true;
    const float* base; float* out; bf16_t* xn; int ldc; const float* bias; PanelStats st1, st2; unsigned poison;
    __device__ __forceinline__ void fused(f32x4 (&acc)[2][2][4][2], const Unit& u, int wr, int wc, int fr, int fq, PG8_LAS unsigned char* lds, int wid, int lane) const {
        typedef float f32x2v __attribute__((ext_vector_type(2))); typedef unsigned u32x2v __attribute__((ext_vector_type(2)));
        const PG8_LAS f32x2v* S = (const PG8_LAS f32x2v*)(lds + 8192);
        const int col0 = u.pn * BM + wc * 32 + 4 * fq;
#pragma unroll
        for (int bj = 0; bj < 2; ++bj)
#pragma unroll
            for (int n = 0; n < 2; ++n) { const f32x4 bv = bias ? *(const f32x4*)(bias + col0 + bj * HALF + n * 16) : (f32x4){0.f, 0.f, 0.f, 0.f};
#pragma unroll
                for (int ai = 0; ai < 2; ++ai)
#pragma unroll
                    for (int m = 0; m < 4; ++m) acc[ai][bj][m][n] += bv; }
        bool bad = st1.run(acc, u, wr, wc, fr, fq, lds, wid, lane) || poison != 0u;
        const float qnan = __builtin_nanf("");
#pragma unroll
        for (int ai = 0; ai < 2; ++ai)
#pragma unroll
            for (int m = 0; m < 4; ++m) { const int r = ai * HALF + wr * 64 + m * 16 + fr; const f32x2v sr = S[r]; const size_t off = (size_t)(u.pm * BM + r) * ldc + col0;
#pragma unroll
                for (int bj = 0; bj < 2; ++bj)
#pragma unroll
                    for (int n = 0; n < 2; ++n) { const f32x4 bs = *(const f32x4*)(base + off + bj * HALF + n * 16); acc[ai][bj][m][n] = bs + (acc[ai][bj][m][n] - sr.x) * sr.y; }
                asm volatile("" : "+v"(acc[ai][0][m][0]), "+v"(acc[ai][0][m][1]), "+v"(acc[ai][1][m][0]), "+v"(acc[ai][1][m][1]));
                if (m & 1) asm volatile("" ::: "memory"); }
        const bool bad1 = bad;
        bad = st2.run(acc, u, wr, wc, fr, fq, lds, wid, lane) || bad;
#pragma unroll
        for (int ai = 0; ai < 2; ++ai)
#pragma unroll
            for (int m = 0; m < 4; ++m) { const int r = ai * HALF + wr * 64 + m * 16 + fr; const f32x2v sr = S[r]; const size_t off = (size_t)(u.pm * BM + r) * ldc + col0;
#pragma unroll
                for (int bj = 0; bj < 2; ++bj)
#pragma unroll
                    for (int n = 0; n < 2; ++n) { const f32x4 x1 = acc[ai][bj][m][n]; *(f32x4*)(out + off + bj * HALF + n * 16) = bad1 ? (f32x4){qnan, qnan, qnan, qnan} : x1;
                        const f32x4 o = (x1 - sr.x) * sr.y; u32x2v w; w.x = cvt_pk_bf16(o[0], o[1]); w.y = cvt_pk_bf16(o[2], o[3]);
                        if (bad) { w.x = 0x7fc07fc0u; w.y = 0x7fc07fc0u; } *(u32x2v*)(xn + off + bj * HALF + n * 16) = w; }
                asm volatile("" ::: "memory"); }
    }
};

__device__ __forceinline__ void glds_saddr(unsigned voff, const char* sbase, unsigned lds_dst) { unsigned keep;
    asm volatile("s_mov_b32 %0, m0\n\ts_mov_b32 m0, %3\n\ts_nop 0\n\tglobal_load_lds_dwordx4 %1, %2\n\ts_mov_b32 m0, %0" : "=&s"(keep) : "v"(voff), "s"(sbase), "s"(lds_dst) : "memory"); }
template <class Epi, class Sched, bool ALIGN_EPI = false, bool SP2 = false, int EB = 2, bool GATHER = false>
__device__ __forceinline__ void gemm_phase(PG8_LAS unsigned char* lds, const Gemm g, const Sched& S, const Epi& E, const int* rowtok = nullptr) {
    static_assert(!GATHER || (EB == 1 && SP2), "gathered A rows: fp8 path (SGPR-base staging) with the two-super-phase loop only");
    const int tid = threadIdx.x, wid = __builtin_amdgcn_readfirstlane(tid >> 6), lane = tid & 63, wr = wid >> 2, wc = wid & 3, fr = lane & 15, fq = lane >> 4;
    const int K = g.K, nt = K * EB / (BK * 2);
    unsigned voffA[2], voffB[2]; int gR[2]; unsigned gC[2];
#pragma unroll
    for (int i = 0; i < 2; ++i) { int R, C; stage_rc(tid * 16 + i * 8192, R, C); const int Rb = Epi::PERM ? ((R & ~31) + perm32(R & 31)) : R;
        voffA[i] = (unsigned)(R * K * EB + C * 2); voffB[i] = (unsigned)(Rb * K * EB + C * 2); gR[i] = R; gC[i] = (unsigned)(C * 2); }
    const size_t kstep = (size_t)(BK * 2);
    const size_t hstep = (size_t)HALF * K * EB;
    const size_t tstep = 2 * hstep;
    const unsigned ldsw = (unsigned)wid * 1024u; const unsigned lds0 = (unsigned)(uintptr_t)lds;
    const int aoff = lds_byte(wr * 64 + fr, fq * 8), boff = lds_byte(wc * 32 + fr, fq * 8);
#define PG8_SA(b, h) (((b) * 2 + (h)) * HTB)
#define PG8_SB(b, h) ((4 + (b) * 2 + (h)) * HTB)
#define PG8_STAGE(bufoff, gbase, voff) do { if constexpr (EB == 2) { _Pragma("unroll") for (int _i = 0; _i < 2; ++_i) \
        __builtin_amdgcn_global_load_lds((const unsigned*)((const char*)(gbase) + (voff)[_i]), (PG8_LAS unsigned*)(lds + (bufoff) + ldsw + _i * 8192), 16, 0, 0); } \
        else { _Pragma("unroll") for (int _i = 0; _i < 2; ++_i) glds_saddr((voff)[_i], (const char*)(gbase), (unsigned)__builtin_amdgcn_readfirstlane((int)(lds0 + (unsigned)(bufoff) + ldsw + (unsigned)(_i * 8192)))); } } while (0)
#define PG8_GLOAD(vo, u) do { _Pragma("unroll") for (int _h = 0; _h < 2; ++_h) _Pragma("unroll") for (int _i = 0; _i < 2; ++_i) vo[_h][_i] = (unsigned)rowtok[(size_t)(u).pm * BM + _h * HALF + gR[_i]] * (unsigned)(K * EB) + gC[_i]; } while (0)
#define PG8_STAGE_A(bufoff, pplain, kofs, h, VS) do { if constexpr (!GATHER) { PG8_STAGE(bufoff, pplain, voffA); } else { _Pragma("unroll") for (int _i = 0; _i < 2; ++_i) \
        glds_saddr(VS[h][_i], (const char*)g.A + (kofs), (unsigned)__builtin_amdgcn_readfirstlane((int)(lds0 + (unsigned)(bufoff) + ldsw + (unsigned)(_i * 8192)))); } } while (0)
#define PG8_LD8(p) __builtin_shufflevector(*(const PG8_LAS v4i_t*)(p), *(const PG8_LAS v4i_t*)((p) + 1024), 0, 1, 2, 3, 4, 5, 6, 7)
#define PG8_LDA(dst, b, h) do { if constexpr (EB == 2) { _Pragma("unroll") for (int m = 0; m < 4; ++m) _Pragma("unroll") for (int k = 0; k < 2; ++k) dst[m][k] = *(const PG8_LAS bf16x8*)(lds + PG8_SA(b, h) + aoff + m * 2048 + k * 1024); } \
        else { _Pragma("unroll") for (int m = 0; m < 4; ++m) dst##8[m] = PG8_LD8(lds + PG8_SA(b, h) + aoff + m * 2048); } } while (0)
#define PG8_LDB(dst, b, h) do { if constexpr (EB == 2) { _Pragma("unroll") for (int n = 0; n < 2; ++n) _Pragma("unroll") for (int k = 0; k < 2; ++k) dst[n][k] = *(const PG8_LAS bf16x8*)(lds + PG8_SB(b, h) + boff + n * 2048 + k * 1024); } \
        else { _Pragma("unroll") for (int n = 0; n < 2; ++n) dst##8[n] = PG8_LD8(lds + PG8_SB(b, h) + boff + n * 2048); } } while (0)
#define PG8_CAT8(x, y) __builtin_shufflevector(__builtin_bit_cast(v4i_t, x), __builtin_bit_cast(v4i_t, y), 0, 1, 2, 3, 4, 5, 6, 7)
#define PG8_MMA(ai, bj, At, Bt) do { __builtin_amdgcn_s_setprio(1); if constexpr (EB == 2) { _Pragma("unroll") for (int m = 0; m < 4; ++m) _Pragma("unroll") for (int n = 0; n < 2; ++n) _Pragma("unroll") for (int k = 0; k < 2; ++k) \
        acc[ai][bj][m][n] = __builtin_amdgcn_mfma_f32_16x16x32_bf16(Bt[n][k], At[m][k], acc[ai][bj][m][n], 0, 0, 0); } else { _Pragma("unroll") for (int m = 0; m < 4; ++m) _Pragma("unroll") for (int n = 0; n < 2; ++n) \
        asm volatile("v_mfma_scale_f32_16x16x128_f8f6f4 %0, %1, %2, %0, %3, %3 op_sel_hi:[0,0,0]" : "+v"(acc[ai][bj][m][n]) : "v"(Bt##8[n]), "v"(At##8[m]), "v"(mx_one)); }     __builtin_amdgcn_s_setprio(0); } while (0)
#define PG8_WAIT_V(n) asm volatile("s_waitcnt vmcnt(" #n ")" ::: "memory")
#define PG8_WAIT_L(n) asm volatile("s_waitcnt lgkmcnt(" #n ")" ::: "memory")
#define PG8_BAR __builtin_amdgcn_s_barrier()
#define PG8_SCHED __builtin_amdgcn_sched_barrier(0)
    Unit cur, nxt; int ui = 0;
    if (!S.next(0, cur)) return;
    f32x4 acc[2][2][4][2];
#pragma unroll
    for (int a = 0; a < 2; ++a)
#pragma unroll
        for (int b = 0; b < 2; ++b)
#pragma unroll
            for (int m = 0; m < 4; ++m)
#pragma unroll
                for (int n = 0; n < 2; ++n) acc[a][b][m][n] = (f32x4){0.f, 0.f, 0.f, 0.f};
    const int mx_one = 0x7f7f7f7f;
    bf16x8 At[4][2], B0[2][2], B1[2][2]; v8i_t At8[4], B08[2], B18[2];
    const char* cA = (const char*)g.A + (size_t)cur.pm * tstep; const char* cB = (const char*)g.Bt + (size_t)cur.pn * tstep;
    S.a_ready(cur);
    unsigned voffC[2][2], voffN[2][2];
    if constexpr (GATHER) PG8_GLOAD(voffC, cur);
    if constexpr (SP2) {
        PG8_STAGE(PG8_SB(0, 0), cB, voffB); PG8_STAGE(PG8_SB(0, 1), cB + hstep, voffB); PG8_STAGE_A(PG8_SA(0, 0), cA, 0, 0, voffC); PG8_STAGE_A(PG8_SA(0, 1), cA + hstep, 0, 1, voffC);
        if (wr == 1) PG8_BAR;
        PG8_WAIT_V(2); PG8_BAR;
        PG8_STAGE(PG8_SB(1, 0), cB + kstep, voffB); PG8_STAGE_A(PG8_SA(1, 0), cA + kstep, kstep, 0, voffC); PG8_STAGE(PG8_SB(1, 1), cB + hstep + kstep, voffB);
        PG8_WAIT_V(6); PG8_BAR;
    } else {
        PG8_STAGE(PG8_SB(0, 0), cB, voffB); PG8_STAGE(PG8_SA(0, 0), cA, voffA); PG8_STAGE(PG8_SB(0, 1), cB + hstep, voffB); PG8_STAGE(PG8_SA(0, 1), cA + hstep, voffA);
        if (wr == 1) PG8_BAR;
        PG8_WAIT_V(4); PG8_BAR;
        PG8_STAGE(PG8_SB(1, 0), cB + kstep, voffB); PG8_STAGE(PG8_SA(1, 0), cA + kstep, voffA); PG8_STAGE(PG8_SB(1, 1), cB + hstep + kstep, voffB);
        PG8_WAIT_V(6); PG8_BAR;
    }
    for (;;) {
        const bool has_next = S.next(ui + 1, nxt);
        if constexpr (GATHER) { if (has_next) PG8_GLOAD(voffN, nxt); else { _Pragma("unroll") for (int _h = 0; _h < 2; ++_h) _Pragma("unroll") for (int _i = 0; _i < 2; ++_i) voffN[_h][_i] = voffC[_h][_i]; } }
        const char* nA = has_next ? (const char*)g.A + (size_t)nxt.pm * tstep : cA; const char* nB = has_next ? (const char*)g.Bt + (size_t)nxt.pn * tstep : cB;
#pragma nounroll
        for (int t = 0; t < nt; t += 2) {
            const bool last = (t == nt - 2);
            const char* a1 = cA + (size_t)(t + 1) * kstep;
            const char* a2 = last ? nA : cA + (size_t)(t + 2) * kstep; const char* b2 = last ? nB : cB + (size_t)(t + 2) * kstep;
            const char* a3 = a2 + kstep; const char* b3 = b2 + kstep;
            const size_t k2 = last ? (size_t)0 : (size_t)(t + 2) * kstep; unsigned voffS[2][2];
            if constexpr (GATHER) { _Pragma("unroll") for (int _h = 0; _h < 2; ++_h) _Pragma("unroll") for (int _i = 0; _i < 2; ++_i) voffS[_h][_i] = last ? voffN[_h][_i] : voffC[_h][_i]; }
            if (last && has_next) S.a_ready(nxt);
            if constexpr (SP2) {
            PG8_LDB(B0, 0, 0); PG8_LDB(B1, 0, 1); PG8_SCHED; PG8_LDA(At, 0, 0); PG8_STAGE_A(PG8_SA(1, 1), a1 + hstep, (size_t)(t + 1) * kstep, 1, voffC);
            PG8_WAIT_V(8); PG8_WAIT_L(0); PG8_BAR; PG8_MMA(0, 0, At, B0); PG8_MMA(0, 1, At, B1); PG8_BAR; PG8_SCHED;
            PG8_LDA(At, 0, 1); PG8_STAGE(PG8_SB(0, 0), b2, voffB); PG8_STAGE(PG8_SB(0, 1), b2 + hstep, voffB); PG8_STAGE_A(PG8_SA(0, 0), a2, k2, 0, voffS);
            PG8_WAIT_V(8); PG8_WAIT_L(0); PG8_BAR; PG8_MMA(1, 0, At, B0); PG8_MMA(1, 1, At, B1); PG8_BAR; PG8_SCHED;
            PG8_LDB(B0, 1, 0); PG8_LDB(B1, 1, 1); PG8_SCHED; PG8_LDA(At, 1, 0); PG8_STAGE_A(PG8_SA(0, 1), a2 + hstep, k2, 1, voffS);
            PG8_WAIT_V(8); PG8_WAIT_L(0); PG8_BAR; PG8_MMA(0, 0, At, B0); PG8_MMA(0, 1, At, B1); PG8_BAR; PG8_SCHED;
            PG8_LDA(At, 1, 1); PG8_STAGE(PG8_SB(1, 0), b3, voffB); PG8_STAGE(PG8_SB(1, 1), b3 + hstep, voffB); PG8_STAGE_A(PG8_SA(1, 0), a3, k2 + kstep, 0, voffS);
            PG8_WAIT_V(8); PG8_WAIT_L(0); PG8_BAR; PG8_MMA(1, 0, At, B0); PG8_MMA(1, 1, At, B1); PG8_BAR; PG8_SCHED;
            } else {
            PG8_LDB(B0, 0, 0); PG8_SCHED; PG8_LDA(At, 0, 0); PG8_STAGE(PG8_SA(1, 1), a1 + hstep, voffA);
            PG8_WAIT_L(8); PG8_BAR; PG8_WAIT_L(0); PG8_MMA(0, 0, At, B0); PG8_BAR; PG8_SCHED;
            PG8_LDB(B1, 0, 1); PG8_STAGE(PG8_SB(0, 0), b2, voffB);
            PG8_BAR; PG8_WAIT_L(0); PG8_MMA(0, 1, At, B1); PG8_BAR;
            PG8_LDA(At, 0, 1); PG8_STAGE(PG8_SA(0, 0), a2, voffA);
            PG8_BAR; PG8_WAIT_L(0); PG8_MMA(1, 0, At, B0); PG8_BAR; PG8_SCHED;
            PG8_STAGE(PG8_SB(0, 1), b2 + hstep, voffB);
            PG8_WAIT_V(6); PG8_BAR; PG8_MMA(1, 1, At, B1); PG8_BAR;
            PG8_LDB(B0, 1, 0); PG8_SCHED; PG8_LDA(At, 1, 0); PG8_STAGE(PG8_SA(0, 1), a2 + hstep, voffA);
            PG8_WAIT_L(8); PG8_BAR; PG8_WAIT_L(0); PG8_MMA(0, 0, At, B0); PG8_BAR; PG8_SCHED;
            PG8_LDB(B1, 1, 1); PG8_STAGE(PG8_SB(1, 0), b3, voffB);
            PG8_BAR; PG8_WAIT_L(0); PG8_MMA(0, 1, At, B1); PG8_BAR;
            PG8_LDA(At, 1, 1); PG8_STAGE(PG8_SA(1, 0), a3, voffA);
            PG8_BAR; PG8_WAIT_L(0); PG8_MMA(1, 0, At, B0); PG8_BAR; PG8_SCHED;
            PG8_STAGE(PG8_SB(1, 1), b3 + hstep, voffB);
            PG8_WAIT_V(6); PG8_BAR; PG8_MMA(1, 1, At, B1); PG8_BAR;
            }
        }
        if constexpr (ALIGN_EPI) { if (wr == 0) PG8_BAR; }
        if constexpr (EB == 1) asm volatile("s_nop 15\n\ts_nop 15" ::: "memory");
        if constexpr (!Epi::AFTER_DRAIN) { E(acc, cur, wr, wc, fr, fq); S.done(cur); }
        if (!has_next) break;
#pragma unroll
        for (int a = 0; a < 2; ++a)
#pragma unroll
            for (int b = 0; b < 2; ++b)
#pragma unroll
                for (int m = 0; m < 4; ++m)
#pragma unroll
                    for (int n = 0; n < 2; ++n) acc[a][b][m][n] = (f32x4){0.f, 0.f, 0.f, 0.f};
        cur = nxt; cA = nA; cB = nB; ++ui;
        if constexpr (GATHER) { _Pragma("unroll") for (int _h = 0; _h < 2; ++_h) _Pragma("unroll") for (int _i = 0; _i < 2; ++_i) voffC[_h][_i] = voffN[_h][_i]; }
        if constexpr (ALIGN_EPI) { if (wr == 1) PG8_BAR; }
    }
    PG8_WAIT_V(0);
    if constexpr (!ALIGN_EPI) { if (wr == 0) PG8_BAR; }
    PG8_BAR;
    if constexpr (Epi::AFTER_DRAIN) { E.fused(acc, cur, wr, wc, fr, fq, lds, wid, lane); S.done(cur); }
#undef PG8_SA
#undef PG8_SB
#undef PG8_STAGE
#undef PG8_LDA
#undef PG8_GLOAD
#undef PG8_STAGE_A
#undef PG8_LD8
#undef PG8_LDB
#undef PG8_MMA
#undef PG8_CAT8
#undef PG8_WAIT_V
#undef PG8_WAIT_L
#undef PG8_BAR
#undef PG8_SCHED
}
}
#ifndef PG8_SP2
#define PG8_SP2 true
#endif
#ifndef MOE_SP2
#define MOE_SP2 true
#endif
#ifndef PG8_ALIGN
#define PG8_ALIGN true
#endif
constexpr int NWAVES = 8;
constexpr int NB = 4, SEQ = 4096, T = NB * SEQ, D = 1024, NIN = 2856, NINP = 3072, NE = 32, DEPTH = 2;
constexpr int C_H = 0, C_GB = 256, C_GC = 512, C_P = 768, C_Q = 1024, C_K = 1536, C_V = 2048, C_QI = 2560, C_KI = 2816, C_WI = 2848;
constexpr int NSEL = 256;
#ifndef SEL_CAND_CAP
#define SEL_CAND_CAP 64
#endif
constexpr int MAXROWS = 4 * T + NE * 256;
constexpr float ATT_C2 = 0.125f * 1.4426950408889634f;
constexpr float LN_EPS = 1e-5f, DN_ALPHA = 1.41421356237309515f;
enum { IN_X = 0, IN_WIN, IN_CONVW, IN_WPOOL, IN_PSCALE, IN_KNG, IN_KNB, IN_WOUT, IN_LN1G, IN_LN1B, IN_RW, IN_RB, IN_WGU, IN_BGU, IN_WDN, IN_BDN, IN_LN2G, IN_LN2B, N_IN };

constexpr size_t MiB = 1u << 20;
constexpr size_t WS_CTL = 0, CTL_ZERO_BYTES = 1 * MiB;
constexpr size_t WS_WIN = 2 * MiB;
constexpr size_t WS_WOUT = 14 * MiB;
constexpr size_t WS_WGU = 18 * MiB;
constexpr size_t WS_WDN = 274 * MiB;
constexpr size_t WS_XB = 402 * MiB;
constexpr size_t WS_XF = 434 * MiB;
constexpr size_t WS_Y1 = 498 * MiB;
constexpr size_t WS_PROJ = 562 * MiB;
constexpr size_t WS_CAT = 658 * MiB;
constexpr size_t WS_KIN = 690 * MiB;
constexpr size_t WS_MASK = 691 * MiB;
constexpr size_t WS_ROUTE = 699 * MiB;
constexpr size_t WS_CNTW = 699 * MiB + 256 * 1024;
constexpr size_t WS_SC = 700 * MiB;
constexpr size_t WS_XS = 956 * MiB;
constexpr size_t WS_ACT = 1100 * MiB;
constexpr size_t WS_YS = 1244 * MiB;
constexpr size_t WS_XB8 = 1388 * MiB;
constexpr size_t WS_END = 1404 * MiB;
constexpr int CW_TMO = 0;
constexpr int CW_CNT = 1024;
constexpr int CW_BAR = 4096;
constexpr int RING_BYTES = 131072;
constexpr int TAB_OFF = RING_BYTES;
constexpr int MISC_OFF = RING_BYTES + 1024;
constexpr int LDS_BYTES = 147456;

#define GAS __attribute__((address_space(1)))
#define LAS __attribute__((address_space(3)))
typedef unsigned short bf16;
typedef unsigned v4u __attribute__((ext_vector_type(4)));
typedef unsigned v2u __attribute__((ext_vector_type(2)));
typedef float f32x4 __attribute__((ext_vector_type(4)));
typedef short bf16x8 __attribute__((ext_vector_type(8)));
typedef GAS unsigned gu32;
typedef unsigned long long u64;
#define RLX_AGENT __ATOMIC_RELAXED, __HIP_MEMORY_SCOPE_AGENT
#define LDS_WAIT() asm volatile("s_waitcnt lgkmcnt(0)" ::: "memory")
#define VM_WAIT() asm volatile("s_waitcnt vmcnt(0)" ::: "memory")
__device__ __forceinline__ unsigned f2bf(float f) { unsigned u = __builtin_bit_cast(unsigned, f); return (u + 0x7fffu + ((u >> 16) & 1u)) >> 16; }
__device__ __forceinline__ unsigned pk2(float lo, float hi) { return f2bf(lo) | (f2bf(hi) << 16); }
__device__ __forceinline__ unsigned pk4_fp8(float a, float b, float c, float d) { int w = 0; w = __builtin_amdgcn_cvt_pk_fp8_f32(a, b, w, false); w = __builtin_amdgcn_cvt_pk_fp8_f32(c, d, w, true); return (unsigned)w; }
constexpr float WGU_SCALE = 32.f, WDN_SCALE = 64.f;
__device__ __forceinline__ float bf2f(bf16 v) { return __builtin_bit_cast(float, (unsigned)v << 16); }
__device__ __forceinline__ float bflo(unsigned w) { return __builtin_bit_cast(float, w << 16); }
__device__ __forceinline__ float bfhi(unsigned w) { return __builtin_bit_cast(float, w & 0xffff0000u); }
template <int CTRL> __device__ __forceinline__ float dppx(float v) { return __builtin_bit_cast(float, __builtin_amdgcn_update_dpp(0, __builtin_bit_cast(int, v), CTRL, 0xf, 0xf, false)); }
__device__ __forceinline__ float wave_sum(float v) {
    v += dppx<0xB1>(v); v += dppx<0x4E>(v); v += dppx<0x141>(v); v += dppx<0x140>(v);
    const float a = __builtin_bit_cast(float, __builtin_amdgcn_readlane(__builtin_bit_cast(int, v), 0)), b = __builtin_bit_cast(float, __builtin_amdgcn_readlane(__builtin_bit_cast(int, v), 16));
    const float c = __builtin_bit_cast(float, __builtin_amdgcn_readlane(__builtin_bit_cast(int, v), 32)), d = __builtin_bit_cast(float, __builtin_amdgcn_readlane(__builtin_bit_cast(int, v), 48));
    return (a + b) + (c + d);
}
__device__ __forceinline__ float wave_max(float v) {
#pragma unroll
    for (int o = 1; o < 64; o <<= 1) v = fmaxf(v, __shfl_xor(v, o));
    return v;
}
__device__ __forceinline__ float wave_max_dpp(float v) {
    v = fmaxf(v, dppx<0xB1>(v)); v = fmaxf(v, dppx<0x4E>(v)); v = fmaxf(v, dppx<0x141>(v)); v = fmaxf(v, dppx<0x140>(v));
    const float a = __builtin_bit_cast(float, __builtin_amdgcn_readlane(__builtin_bit_cast(int, v), 0)), b = __builtin_bit_cast(float, __builtin_amdgcn_readlane(__builtin_bit_cast(int, v), 16));
    const float c = __builtin_bit_cast(float, __builtin_amdgcn_readlane(__builtin_bit_cast(int, v), 32)), d = __builtin_bit_cast(float, __builtin_amdgcn_readlane(__builtin_bit_cast(int, v), 48));
    return fmaxf(fmaxf(a, b), fmaxf(c, d));
}
__device__ __forceinline__ float sum32(float v) {
#pragma unroll
    for (int o = 1; o < 32; o <<= 1) v += __shfl_xor(v, o);
    return v;
}
#define XB_TMO      128
#define XB_XCNT(j)  (256  + 64 * (j))
#define XB_XSUB(j)  (1280 + 64 * (j))
#define XB_XGEN(j)  (2304 + 64 * (j))
#define XB_TOP      3328
#define XB_TOPGEN   3392
#define XCD_BAR_WORDS 3456
#define XB_SPIN_CAP (1u << 18)

__device__ __forceinline__ unsigned xb_ld(unsigned* p)              { return __hip_atomic_load(p, __ATOMIC_RELAXED, __HIP_MEMORY_SCOPE_AGENT); }
__device__ __forceinline__ unsigned xb_add(unsigned* p, unsigned v) { return __hip_atomic_fetch_add(p, v, __ATOMIC_RELAXED, __HIP_MEMORY_SCOPE_AGENT); }
__device__ __forceinline__ unsigned xb_xcc_id() { return (unsigned)__builtin_amdgcn_s_getreg((3 << 11) | 20) & 0xFu; }
#define XB_SPIN(cond, bar) do { unsigned _sp = 0; while (cond) { __builtin_amdgcn_s_sleep(1); \
    if ((++_sp & 255u) == 0u) { if (xb_ld(&(bar)[XB_TMO])) break; if (_sp > XB_SPIN_CAP) { atomicAdd(&(bar)[XB_TMO], 1u); break; } } } } while (0)

struct XcdBarrier {
    unsigned* bar; unsigned x;
    volatile LAS unsigned* st;
};

__device__ __forceinline__ XcdBarrier xcd_barrier_post(unsigned* bar, volatile LAS unsigned* st) {
    XcdBarrier b; b.bar = bar; b.x = xb_xcc_id(); b.st = st;
    if (threadIdx.x == 0) (void)xb_add(&bar[XB_XCNT(b.x)], 1u);
    return b;
}
__device__ __forceinline__ void xcd_barrier_complete(unsigned* bar, unsigned x, unsigned& nloc, unsigned& nx) {
    const unsigned G = gridDim.x * gridDim.y * gridDim.z;
    unsigned sum, cnt, mine, sp = 0u;
    for (;;) {
        sum = 0u; cnt = 0u; mine = 0u;
#pragma unroll
        for (unsigned j = 0; j < 16; ++j) { const unsigned c = xb_ld(&bar[XB_XCNT(j)]); sum += c; cnt += (c > 0u) ? 1u : 0u; mine = (j == x) ? c : mine; }
        if (sum == G) break;
        __builtin_amdgcn_s_sleep(1);
        if ((++sp & 255u) == 0u) { if (xb_ld(&bar[XB_TMO])) break; if (sp > XB_SPIN_CAP) { atomicAdd(&bar[XB_TMO], 1u); break; } }
    }
    nloc = mine > 0u ? mine : 1u; nx = cnt > 0u ? cnt : 1u;
}

__device__ __forceinline__ void xcd_barrier(const XcdBarrier& b) {
    asm volatile("s_waitcnt vmcnt(0)" ::: "memory");
    __syncthreads();
    if (threadIdx.x == 0) {
        unsigned* bar = b.bar;
        __builtin_amdgcn_s_waitcnt(0);
        unsigned nloc = b.st[0], nx = b.st[1];
        if (nloc == 0u) { xcd_barrier_complete(bar, b.x, nloc, nx); b.st[0] = nloc; b.st[1] = nx; }
        const unsigned old = xb_add(&bar[XB_XSUB(b.x)], 1u);
        const unsigned gen = old / nloc;
        if (old + 1u == (gen + 1u) * nloc) {
            __builtin_amdgcn_fence(__ATOMIC_RELEASE, "agent");
            asm volatile("s_waitcnt vmcnt(0)" ::: "memory");
            const unsigned og = xb_add(&bar[XB_TOP], 1u);
            const unsigned tg = og / nx;
            if (og + 1u == (tg + 1u) * nx) xb_add(&bar[XB_TOPGEN], 1u);
            else XB_SPIN(xb_ld(&bar[XB_TOPGEN]) == tg, bar);
            __builtin_amdgcn_fence(__ATOMIC_ACQUIRE, "agent");
#ifdef BAR_EARLY_INV
            asm volatile("s_waitcnt vmcnt(0)" ::: "memory");
#endif
            xb_add(&bar[XB_XGEN(b.x)], 1u);
            asm volatile("s_waitcnt vmcnt(0)" ::: "memory");
        } else {
#ifdef BAR_EARLY_INV
            __builtin_amdgcn_fence(__ATOMIC_ACQUIRE, "agent"); asm volatile("s_waitcnt vmcnt(0)" ::: "memory");
            XB_SPIN(xb_ld(&bar[XB_XGEN(b.x)]) == gen, bar);
            asm volatile("" ::: "memory");
#else
            XB_SPIN(xb_ld(&bar[XB_XGEN(b.x)]) == gen, bar);
            __builtin_amdgcn_fence(__ATOMIC_ACQUIRE, "agent");
            asm volatile("s_waitcnt vmcnt(0)" ::: "memory");
#endif
        }
    }
    __syncthreads();
}
struct Args { const float* in[N_IN]; float* out; unsigned char* ws; int ph_lo, ph_hi; };
struct Frame {
    LAS unsigned char* lds;
    gu32* ctl;
    unsigned char* ws;
    int tid, lane, wave, vcu, G;
};
#define WSP(type, off) ((type*)(GAS type*)(F.ws + (off)))
__device__ __forceinline__ const float* uni(const float* p) { const u64 v = (u64)p; return (const float*)(const GAS float*)(((u64)(unsigned)__builtin_amdgcn_readfirstlane((int)(v >> 32)) << 32) | (u64)(unsigned)__builtin_amdgcn_readfirstlane((int)v)); }
__device__ __forceinline__ Frame make_frame(unsigned char* ws_, LAS unsigned char* lds_) {
    Frame F; const u64 v = (u64)ws_;
    F.ws = (unsigned char*)(((u64)(unsigned)__builtin_amdgcn_readfirstlane((int)(v >> 32)) << 32) | (u64)(unsigned)__builtin_amdgcn_readfirstlane((int)v));
    F.lds = (LAS unsigned char*)(unsigned)__builtin_amdgcn_readfirstlane((int)(unsigned)(uintptr_t)lds_);
    F.ctl = (gu32*)(F.ws + WS_CTL);
    { int t_ = threadIdx.x; asm volatile("" : "+v"(t_)); F.tid = t_; }
    F.lane = F.tid & 63; F.wave = __builtin_amdgcn_readfirstlane(F.tid >> 6);
    F.G = gridDim.x; { const int bx = blockIdx.x; F.vcu = (F.G % 8 == 0) ? (bx % 8) * (F.G / 8) + bx / 8 : bx; }
    return F;
}
struct In6 { const float* p[6]; };

__device__ __forceinline__ void tr_block(Frame& F, const float* W_, int N, bf16* WT, int k0, int n0, int mode  , size_t drow_base, float scale) {
    LAS unsigned* img = (LAS unsigned*)F.lds; const int lane = F.lane, wave = F.wave, tid = F.tid; const GAS float* W = (const GAS float*)W_;
    f32x4 va[4][2], vb[4][2];
#pragma unroll
    for (int i = 0; i < 4; ++i) { const int kp = wave * 4 + i; const GAS float* r0 = W + (size_t)(k0 + 2 * kp) * N + n0; const GAS float* r1 = r0 + N;
#pragma unroll
        for (int q = 0; q < 2; ++q) { const int c4 = lane + 64 * q; va[i][q] = (f32x4){0.f, 0.f, 0.f, 0.f}; vb[i][q] = va[i][q];
            if (n0 + 4 * c4 < N) { va[i][q] = __builtin_nontemporal_load((const GAS f32x4*)(r0 + 4 * c4)); vb[i][q] = __builtin_nontemporal_load((const GAS f32x4*)(r1 + 4 * c4)); } } }
#pragma unroll
    for (int i = 0; i < 4; ++i) { const int kp = wave * 4 + i;
#pragma unroll
        for (int q = 0; q < 2; ++q) { const int c4 = lane + 64 * q; const f32x4 a = va[i][q], b = vb[i][q];
            v4u o; o.x = pk2(a.x * scale, b.x * scale); o.y = pk2(a.y * scale, b.y * scale); o.z = pk2(a.z * scale, b.z * scale); o.w = pk2(a.w * scale, b.w * scale);
            *(LAS v4u*)(img + kp * 516 + 4 * c4) = o; } }
    __syncthreads();
    const int c = tid & 7;
#pragma unroll
    for (int i = 0; i < 8; ++i) { const int n = (tid >> 3) + 64 * i; const LAS unsigned* p = img + (4 * c) * 516 + n;
        v4u o; o.x = p[0]; o.y = p[516]; o.z = p[2 * 516]; o.w = p[3 * 516];
        const int ng = n0 + n; size_t dr;
        if (mode == 1) dr = ng < 1024 ? (size_t)((ng >> 7) * 256 + (ng & 127)) : (size_t)((((ng - 1024) >> 7) * 256) + 128 + ((ng - 1024) & 127)); else dr = (size_t)ng;
        *(GAS v4u*)((GAS bf16*)WT + (drow_base + dr) * D + k0 + 8 * c) = o; }
    __syncthreads();
}
__device__ __forceinline__ void tr_block8(Frame& F, const float* W_, int N, unsigned char* WT, int k0, int n0, int mode, size_t drow_base, float scale) {
    LAS unsigned* img = (LAS unsigned*)F.lds; const int lane = F.lane, wave = F.wave, tid = F.tid; const GAS float* W = (const GAS float*)W_;
    f32x4 vv[4][2][4];
#pragma unroll
    for (int i = 0; i < 4; ++i) { const int kq = wave * 4 + i; const GAS float* r0 = W + (size_t)(k0 + 4 * kq) * N + n0;
#pragma unroll
        for (int q = 0; q < 2; ++q) { const int c4 = lane + 64 * q;
#pragma unroll
            for (int j = 0; j < 4; ++j) vv[i][q][j] = __builtin_nontemporal_load((const GAS f32x4*)(r0 + (size_t)j * N + 4 * c4)); } }
#pragma unroll
    for (int i = 0; i < 4; ++i) { const int kq = wave * 4 + i;
#pragma unroll
        for (int q = 0; q < 2; ++q) { const int c4 = lane + 64 * q; const f32x4 a = vv[i][q][0] * scale, b = vv[i][q][1] * scale, c = vv[i][q][2] * scale, d = vv[i][q][3] * scale;
            v4u o; o.x = pk4_fp8(a.x, b.x, c.x, d.x); o.y = pk4_fp8(a.y, b.y, c.y, d.y); o.z = pk4_fp8(a.z, b.z, c.z, d.z); o.w = pk4_fp8(a.w, b.w, c.w, d.w);
            *(LAS v4u*)(img + kq * 516 + 4 * c4) = o; } }
    __syncthreads();
    const int c = tid & 7;
#pragma unroll
    for (int i = 0; i < 8; ++i) { const int n = (tid >> 3) + 64 * i; const LAS unsigned* p = img + (4 * c) * 516 + n;
        v4u o; o.x = p[0]; o.y = p[516]; o.z = p[2 * 516]; o.w = p[3 * 516];
        const int ng = n0 + n; size_t dr;
        if (mode == 1) dr = ng < 1024 ? (size_t)((ng >> 7) * 256 + (ng & 127)) : (size_t)((((ng - 1024) >> 7) * 256) + 128 + ((ng - 1024) & 127)); else dr = (size_t)ng;
        *(GAS v4u*)((GAS unsigned char*)WT + (drow_base + dr) * D + k0 + 16 * c) = o; }
    __syncthreads();
}
__device__ __forceinline__ void p_prologue(Frame& F, const In6& A) {
    constexpr int I_IN = 16 * 6, I_OUT = 16 * 2, I_GU = NE * 8 * 4, I_DN = NE * 8 * 2, I_L = I_IN + I_OUT + I_GU + I_DN;
    for (int it = F.vcu; it < DEPTH * I_L; it += F.G) {
        const int l = it / I_L; int r = it % I_L;
        if (r < I_IN) { const int kb = r / 6, nb = r % 6; tr_block(F, A.p[0] + (size_t)l * D * NIN, NIN, WSP(bf16, WS_WIN) + (size_t)l * NINP * D, kb * 64, nb * 512, 0, 0, nb == 2 ? ATT_C2 : 1.f); continue; }
        r -= I_IN;
        if (r < I_OUT) { const int kb = r / 2, nb = r % 2; tr_block(F, A.p[1] + (size_t)l * D * D, D, WSP(bf16, WS_WOUT) + (size_t)l * D * D, kb * 64, nb * 512, 0, 0, 1.f); continue; }
        r -= I_OUT;
        if (r < I_GU) { const int e = r / 32, rr = r % 32, kb = rr / 4, nb = rr % 4; tr_block8(F, A.p[2] + (size_t)(l * NE + e) * D * 2048, 2048, WSP(unsigned char, WS_WGU) + (size_t)l * NE * 2048 * D * 2, kb * 128, nb * 512, 1, (size_t)e * 2048, WGU_SCALE); continue; }
        r -= I_GU;
        { const int e = r / 16, rr = r % 16, kb = rr / 2, nb = rr % 2; tr_block8(F, A.p[3] + (size_t)(l * NE + e) * D * D, D, WSP(unsigned char, WS_WDN) + (size_t)l * NE * D * D * 2, kb * 128, nb * 512, 0, (size_t)e * 1024, WDN_SCALE); }
    }
    const int gw = F.vcu * NWAVES + F.wave, NGW = F.G * NWAVES, lane = F.lane;
    const GAS float* x = (const GAS float*)A.p[4]; GAS bf16* xb = (GAS bf16*)WSP(bf16, WS_XB);
    for (int m = gw; m < T; m += 2 * NGW) {
        const GAS f32x4* xr = (const GAS f32x4*)(x + (size_t)m * D) + lane; GAS u64* o8 = (GAS u64*)(xb + (size_t)m * D) + lane;
        const GAS f32x4* xr2 = xr + (size_t)NGW * (D / 4); GAS u64* o82 = o8 + (size_t)NGW * (D / 4);
        f32x4 v[4], w[4];
#pragma unroll
        for (int j = 0; j < 4; ++j) { v[j] = __builtin_nontemporal_load(xr + 64 * j); w[j] = __builtin_nontemporal_load(xr2 + 64 * j); }
#pragma unroll
        for (int j = 0; j < 4; ++j) { o8[64 * j] = (u64)pk2(v[j].x, v[j].y) | ((u64)pk2(v[j].z, v[j].w) << 32); o82[64 * j] = (u64)pk2(w[j].x, w[j].y) | ((u64)pk2(w[j].z, w[j].w) << 32); }
    }
}

__device__ __forceinline__ void bf8_to_f(const v4u q, float (&f)[8]) { f[0] = bflo(q.x); f[1] = bfhi(q.x); f[2] = bflo(q.y); f[3] = bfhi(q.y); f[4] = bflo(q.z); f[5] = bfhi(q.z); f[6] = bflo(q.w); f[7] = bfhi(q.w); }
__device__ __forceinline__ void p_local(Frame& F, const In6& A, int l) {
    typedef float f32x16 __attribute__((ext_vector_type(16)));
    constexpr int MROW = 528, WROW = 144;
    LAS unsigned char* mixb = F.lds;
    LAS unsigned char* wpt = F.lds + 64 * MROW;
    const GAS float* wpool = (const GAS float*)(A.p[0] + (size_t)l * 4 * 64 * 64);
    const GAS float* convw = (const GAS float*)(A.p[1] + l * 768); const GAS float* pscale = (const GAS float*)(A.p[2] + l * 256);
    const GAS float* kng = (const GAS float*)(A.p[3] + l * 32); const GAS float* knb = (const GAS float*)(A.p[4] + l * 32);
    const GAS bf16* PROJ = (const GAS bf16*)(F.ws + WS_PROJ); GAS bf16* CAT = (GAS bf16*)(F.ws + WS_CAT); GAS bf16* KIN = (GAS bf16*)(F.ws + WS_KIN);
    const int tid = F.tid, lane = F.lane, wave = F.wave;
    for (int u = F.vcu; u < T / 64; u += F.G) {
        const int t0 = u * 64, s0 = t0 & (SEQ - 1), rowb = t0 - s0;
        __syncthreads();
        f32x4 wr0[4], wr1[4];
#pragma unroll
        for (int i = 0; i < 4; ++i) { const int item = tid + 512 * i, g = item >> 9, cp = (item >> 4) & 31, dq = item & 15;
            wr0[i] = *(const GAS f32x4*)(wpool + g * 4096 + (2 * cp) * 64 + 4 * dq); wr1[i] = *(const GAS f32x4*)(wpool + g * 4096 + (2 * cp + 1) * 64 + 4 * dq); }
        const int cga = tid & 31, tga = tid >> 5, ca0 = cga * 8, sfa = s0 + tga * 4;
        v4u ah[6], ag[6], ab[4];
#pragma unroll
        for (int i = -2; i < 4; ++i) { const int sq = sfa + i; ah[i + 2] = (v4u){0u, 0u, 0u, 0u}; ag[i + 2] = ah[i + 2];
            if (sq >= 0) { const GAS bf16* pr = PROJ + (size_t)(rowb + sq) * NINP; ah[i + 2] = *(const GAS v4u*)(pr + C_H + ca0); ag[i + 2] = *(const GAS v4u*)(pr + C_GC + ca0);
                if (i >= 0) ab[i] = *(const GAS v4u*)(pr + C_GB + ca0); } }
        const int cgb = tid & 63, tgb = tid >> 6, cb0 = cgb * 4, wwin = 2 << (cgb >> 4), sfb = s0 + tgb * 8;
        v2u bq[23];
#pragma unroll
        for (int i = 0; i < 23; ++i) { const int sq = sfb - 15 + i; bq[i] = (v2u){0u, 0u}; if (sq >= 0) bq[i] = *(const GAS v2u*)(PROJ + (size_t)(rowb + sq) * NINP + C_P + cb0); }
        bf16 ck[4];
#pragma unroll
        for (int i = 0; i < 4; ++i) { const int idx = tid + 512 * i; ck[i] = PROJ[(size_t)(t0 + (idx >> 5)) * NINP + C_KI + (idx & 31)]; }
        const float kg = kng[tid & 31], kb = knb[tid & 31];
        float w0[8], w1[8], w2[8];
#pragma unroll
        for (int i = 0; i < 8; ++i) { w0[i] = convw[ca0 + i]; w1[i] = convw[256 + ca0 + i]; w2[i] = convw[512 + ca0 + i]; }
#pragma unroll
        for (int i = 0; i < 4; ++i) { const int item = tid + 512 * i, g = item >> 9, cp = (item >> 4) & 31, dq = item & 15;
#pragma unroll
            for (int k = 0; k < 4; ++k) *(LAS unsigned*)(wpt + (g * 64 + 4 * dq + k) * WROW + cp * 4) = pk2(wr0[i][k], wr1[i][k]); }
        {
            float up2[8], up1[8];
#pragma unroll
            for (int i = 0; i < 8; ++i) { up2[i] = 0.f; up1[i] = 0.f; }
#pragma unroll
            for (int i = -2; i < 4; ++i) { const int sq = sfa + i; float h8[8], g8[8], uu[8];
                bf8_to_f(ah[i + 2], h8); bf8_to_f(ag[i + 2], g8);
#pragma unroll
                for (int k = 0; k < 8; ++k) uu[k] = g8[k] * h8[k];
                if (i >= 0) { float b8[8], y[8]; bf8_to_f(ab[i], b8);
#pragma unroll
                    for (int k = 0; k < 8; ++k) y[k] = b8[k] * (w0[k] * up2[k] + w1[k] * up1[k] + w2[k] * uu[k]);
                    v4u o; o.x = pk2(y[0], y[1]); o.y = pk2(y[2], y[3]); o.z = pk2(y[4], y[5]); o.w = pk2(y[6], y[7]);
                    *(GAS v4u*)(CAT + (size_t)(rowb + sq) * D + ca0) = o; }
#pragma unroll
                for (int k = 0; k < 8; ++k) { up2[k] = up1[k]; up1[k] = uu[k]; } }
        }
        {
            float pv[23][4];
#pragma unroll
            for (int i = 0; i < 23; ++i) { pv[i][0] = bflo(bq[i].x); pv[i][1] = bfhi(bq[i].x); pv[i][2] = bflo(bq[i].y); pv[i][3] = bfhi(bq[i].y); }
#pragma unroll
            for (int i = 0; i < 8; ++i) { const int sq = sfb + i; float a0 = 0.f, a1 = 0.f, a2 = 0.f, a3 = 0.f;
#pragma unroll
                for (int j = 0; j < 16; ++j) { const bool on = j < wwin; a0 += on ? pv[15 + i - j][0] : 0.f; a1 += on ? pv[15 + i - j][1] : 0.f; a2 += on ? pv[15 + i - j][2] : 0.f; a3 += on ? pv[15 + i - j][3] : 0.f; }
                const float rc = 1.f / (float)((sq + 1) < wwin ? (sq + 1) : wwin);
                *(LAS v2u*)(mixb + (tgb * 8 + i) * MROW + cb0 * 2) = (v2u){pk2(a0 * rc - pv[15 + i][0], a1 * rc - pv[15 + i][1]), pk2(a2 * rc - pv[15 + i][2], a3 * rc - pv[15 + i][3])}; }
        }
#pragma unroll
        for (int i = 0; i < 4; ++i) {
            const int idx = tid + 512 * i, tt = idx >> 5, dd = idx & 31; const float v = bf2f(ck[i]);
            const float mean = sum32(v) * (1.f / 32.f); const float dv = v - mean; const float var = sum32(dv * dv) * (1.f / 32.f);
            KIN[(size_t)(t0 + tt) * 32 + dd] = (bf16)f2bf(dv * rsqrtf(var + LN_EPS) * kg + kb);
        }
        __syncthreads();
        {
            const int g = wave >> 1, th = wave & 1, r32 = lane & 31, hi = lane >> 5;
            f32x16 acc[2]; acc[0] = f32x16{}; acc[1] = f32x16{};
#pragma unroll
            for (int kk = 0; kk < 4; ++kk) { const bf16x8 bfr = *(const LAS bf16x8*)(mixb + (th * 32 + r32) * MROW + (g * 64 + kk * 16 + hi * 8) * 2);
#pragma unroll
                for (int dh = 0; dh < 2; ++dh) { const bf16x8 afr = *(const LAS bf16x8*)(wpt + (g * 64 + dh * 32 + r32) * WROW + (kk * 16 + hi * 8) * 2);
                    acc[dh] = __builtin_amdgcn_mfma_f32_32x32x16_bf16(afr, bfr, acc[dh], 0, 0, 0); } }
            GAS bf16* orow = CAT + (size_t)(t0 + th * 32 + r32) * D + 256 + g * 64;
#pragma unroll
            for (int dh = 0; dh < 2; ++dh)
#pragma unroll
                for (int rq = 0; rq < 4; ++rq) { const int d0 = dh * 32 + 8 * rq + 4 * hi; const f32x4 sc = *(const GAS f32x4*)(pscale + g * 64 + d0);
                    *(GAS v2u*)(orow + d0) = (v2u){pk2(acc[dh][4 * rq] * sc.x, acc[dh][4 * rq + 1] * sc.y), pk2(acc[dh][4 * rq + 2] * sc.z, acc[dh][4 * rq + 3] * sc.w)}; }
        }
    }
    __syncthreads();
}

constexpr int SCS = SEQ;
__device__ __forceinline__ unsigned sortable(float v) { const unsigned u = __builtin_bit_cast(unsigned, v); return (u & 0x80000000u) ? ~u : (u | 0x80000000u); }
__device__ __forceinline__ void select_row(int t, const GAS float* SC, GAS unsigned* MASK, LAS unsigned* hist, LAS float* ckey, LAS int* cidx, int lane) {
    const u64 lt = (1ull << lane) - 1ull; const float NINF = -INFINITY;
    const int s = t & (SEQ - 1); GAS u64* mrow = (GAS u64*)MASK + ((size_t)(t >> 12) * 64) * SEQ + s;
    if (s < NSEL) { const int base = 64 * lane; u64 m; if (s >= base + 63) m = ~0ull; else if (s < base) m = 0ull; else m = (2ull << (s - base)) - 1ull; mrow[(size_t)lane * SEQ] = m; return; }
    const int jmax = s >> 6, jb = jmax & ~7;
    float v[64]; const GAS float* srow = SC + (size_t)t * SCS + lane;
#pragma unroll
    for (int j0 = 0; j0 < 64; j0 += 8) {
        if (j0 < jb) {
#pragma unroll
            for (int j = j0; j < j0 + 8; ++j) v[j] = srow[64 * j];
        } else if (j0 == jb) {
#pragma unroll
            for (int j = j0; j < j0 + 8; ++j) { const float x = srow[64 * j]; v[j] = (lane + 64 * j <= s) ? x : NINF; }
        } else {
#pragma unroll
            for (int j = j0; j < j0 + 8; ++j) v[j] = NINF;
        }
    }
    {
    float vmx = NINF, vmn = INFINITY;
#pragma unroll
    for (int j0 = 0; j0 < 64; j0 += 8) {
        if (j0 < jb) {
#pragma unroll
            for (int j = j0; j < j0 + 8; ++j) { vmx = fmaxf(vmx, v[j]); vmn = fminf(vmn, v[j]); }
        } else if (j0 == jb) {
#pragma unroll
            for (int j = j0; j < j0 + 8; ++j) { vmx = fmaxf(vmx, v[j]); vmn = fminf(vmn, v[j] == NINF ? INFINITY : v[j]); }
        }
    }
    vmx = wave_max_dpp(vmx); vmn = -wave_max_dpp(-vmn);
    const float scale = 1023.f / fmaxf(vmx - vmn, 1e-30f), off = -vmn * scale;
#pragma unroll
    for (int i = 0; i < 4; ++i) ((LAS v4u*)hist)[i * 64 + lane] = (v4u){0u, 0u, 0u, 0u};
    LDS_WAIT(); asm volatile("" ::: "memory");
    unsigned bp[32];
#pragma unroll
    for (int j0 = 0; j0 < 64; j0 += 8) {
        if (j0 < jb) {
#pragma unroll
            for (int j = j0; j < j0 + 8; ++j) { unsigned bb = (unsigned)fmaf(v[j], scale, off); bb = bb < 1023u ? bb : 1023u; __hip_atomic_fetch_add(hist + bb, 1u, __ATOMIC_RELAXED, __HIP_MEMORY_SCOPE_WORKGROUP);
                if (j & 1) bp[j >> 1] |= bb << 16; else bp[j >> 1] = bb; }
        } else if (j0 == jb) {
#pragma unroll
            for (int j = j0; j < j0 + 8; ++j) { unsigned bb = (unsigned)fmaf(v[j], scale, off); bb = bb < 1023u ? bb : 1023u; if (v[j] != NINF) __hip_atomic_fetch_add(hist + bb, 1u, __ATOMIC_RELAXED, __HIP_MEMORY_SCOPE_WORKGROUP);
                if (j & 1) bp[j >> 1] |= bb << 16; else bp[j >> 1] = bb; }
        } else {
#pragma unroll
            for (int j = j0; j < j0 + 8; j += 2) bp[j >> 1] = 0u;
        }
    }
    LDS_WAIT(); asm volatile("" ::: "memory");
    unsigned hb[16];
#pragma unroll
    for (int i = 0; i < 4; ++i) { const v4u q = ((const LAS v4u*)hist)[lane * 4 + i]; hb[4 * i] = q.x; hb[4 * i + 1] = q.y; hb[4 * i + 2] = q.z; hb[4 * i + 3] = q.w; }
    int own = 0;
#pragma unroll
    for (int i = 0; i < 16; ++i) own += (int)hb[i];
    int suf = own;
#pragma unroll
    for (int o = 1; o < 64; o <<= 1) { const int x = __shfl_down(suf, o); if (lane + o < 64) suf += x; }
    const u64 ge = __ballot(suf >= NSEL); const int L = 63 - __builtin_clzll(ge);
    int acc = suf - own, tb = 0, ca = 0, found = 0;
#pragma unroll
    for (int i = 15; i >= 0; --i) { if (!found) { if (acc + (int)hb[i] >= NSEL) { found = 1; tb = lane * 16 + i; ca = acc; } else acc += (int)hb[i]; } }
    const int TB = __builtin_amdgcn_readlane(tb, L), CA = __builtin_amdgcn_readlane(ca, L);
    const int need = NSEL - CA;
    int cbase = 0; unsigned mlo = 0u, mhi = 0u;
#pragma unroll
    for (int j0 = 0; j0 < 64; j0 += 8) {
        if (j0 <= jb) {
#pragma unroll
            for (int j = j0; j < j0 + 8; ++j) { const int bb = (int)((j & 1) ? (bp[j >> 1] >> 16) : (bp[j >> 1] & 0xffffu));
                const u64 am = __ballot(bb > TB); const u64 cm = __ballot(bb == TB);
                asm volatile("s_nop 4\n\tv_writelane_b32 %0, %2, %4\n\tv_writelane_b32 %1, %3, %4" : "+v"(mlo), "+v"(mhi) : "s"((unsigned)am), "s"((unsigned)(am >> 32)), "n"(j));
                if (cm) { const int pos = cbase + __popcll(cm & lt); if (bb == TB && pos < 64) { ckey[pos] = v[j]; cidx[pos] = lane + 64 * j; } cbase += __popcll(cm); } }
        }
    }
    LDS_WAIT(); asm volatile("" ::: "memory");
    if (cbase <= SEL_CAND_CAP) {
        LAS unsigned* mw = hist;
        mw[2 * lane] = mlo; mw[2 * lane + 1] = mhi;
        const float myk = lane < cbase ? ckey[lane] : NINF; const int myi = lane < cbase ? cidx[lane] : 0x7fffffff; int rank = 0;
        for (int c = 0; c < cbase; ++c) { const float ok = __builtin_bit_cast(float, __builtin_amdgcn_readlane(__builtin_bit_cast(int, myk), c)); const int oi = __builtin_amdgcn_readlane(myi, c); rank += (ok > myk || (ok == myk && oi < myi)) ? 1 : 0; }
        LDS_WAIT(); asm volatile("" ::: "memory");
        if (lane < cbase && rank < need && myk != NINF) __hip_atomic_fetch_or(mw + (myi >> 5), 1u << (myi & 31), __ATOMIC_RELAXED, __HIP_MEMORY_SCOPE_WORKGROUP);
        LDS_WAIT(); asm volatile("" ::: "memory");
        mrow[(size_t)lane * SEQ] = (u64)mw[2 * lane] | ((u64)mw[2 * lane + 1] << 32);
        LDS_WAIT(); asm volatile("" ::: "memory");
        return;
    }
    unsigned prefix = 0u;
    for (int bit = 31; bit >= 0; --bit) { const unsigned cand = prefix | (1u << bit); int cnt = 0;
#pragma unroll
        for (int j0 = 0; j0 < 64; j0 += 8) {
#pragma unroll
            for (int j = j0; j < j0 + 8; ++j) cnt += __popcll(__ballot(v[j] != NINF && sortable(v[j]) >= cand));
            __builtin_amdgcn_sched_barrier(0); }
        if (cnt >= NSEL) prefix = cand; }
    int ngt = 0;
#pragma unroll
    for (int j = 0; j < 64; ++j) ngt += __popcll(__ballot(v[j] != NINF && sortable(v[j]) > prefix));
    int rem = NSEL - ngt, last = 0;
#pragma unroll
    for (int j = 0; j < 64; ++j) { const u64 em = __ballot(v[j] != NINF && sortable(v[j]) == prefix); const int c = __popcll(em);
        if (rem > 0 && c > 0) { if (c >= rem) { u64 x = em; for (int q = 1; q < rem; ++q) x &= x - 1ull; last = 64 * j + __builtin_ctzll(x); rem = 0; } else rem -= c; } }
    const unsigned pb = (prefix & 0x80000000u) ? (prefix & 0x7fffffffu) : ~prefix; const float Tv = __builtin_bit_cast(float, pb); const int Tidx = last;
    mlo = 0u; mhi = 0u;
#pragma unroll
    for (int j = 0; j < 64; ++j) { const bool sel = (v[j] > Tv) || (v[j] == Tv && lane + 64 * j <= Tidx); const u64 m = __ballot(sel);
        asm volatile("s_nop 4\n\tv_writelane_b32 %0, %2, %4\n\tv_writelane_b32 %1, %3, %4" : "+v"(mlo), "+v"(mhi) : "s"((unsigned)m), "s"((unsigned)(m >> 32)), "n"(j)); }
    mrow[(size_t)lane * SEQ] = (u64)mlo | ((u64)mhi << 32);
    return;
    }
}
__device__ __forceinline__ float relu_i(float x) { const int b = __builtin_bit_cast(int, x); return __builtin_bit_cast(float, b > 0 ? b : 0); }
__device__ __forceinline__ void p_index(Frame& F) {
    const int wave = F.wave;
    const GAS bf16* PROJ = (const GAS bf16*)(F.ws + WS_PROJ); const GAS bf16* KIN = (const GAS bf16*)(F.ws + WS_KIN); GAS float* SC = (GAS float*)(F.ws + WS_SC); GAS unsigned* MASK = (GAS unsigned*)(F.ws + WS_MASK);
    LAS unsigned* hist = (LAS unsigned*)(F.lds + wave * 4096);
    LAS float* ckey = (LAS float*)(F.lds + 32768 + wave * 1024); LAS int* cidx = (LAS int*)(ckey + 64);
    for (int ui = 0; ui < 2; ++ui) {
        const int v = F.vcu; if (v >= 256) break;
        const int b = v & 3, j = v >> 2, qb = ui == 0 ? j : 127 - j, q0 = qb * 32;
        int lane = F.tid & 63; asm volatile("" : "+v"(lane)); const int l15 = lane & 15, l4 = lane >> 4;
        bf16x8 bq[2][8]; float wq[2][8];
#pragma unroll
        for (int hq = 0; hq < 2; ++hq) { const size_t rowq = (size_t)(b * SEQ + q0 + 16 * hq + l15);
#pragma unroll
            for (int h = 0; h < 8; ++h) { bq[hq][h] = *(const GAS bf16x8*)(PROJ + rowq * NINP + C_QI + h * 32 + 8 * l4); wq[hq][h] = bf2f(PROJ[rowq * NINP + C_WI + h]) * 0.0625f; } }
        GAS float* srow = SC + (size_t)(b * SEQ + q0 + l15) * SCS + 4 * l4;
        const int ktl = 2 * qb + 1; const GAS bf16* kin0 = KIN + (size_t)(b * SEQ + l15) * 32 + 8 * l4;
        bf16x8 a = *(const GAS bf16x8*)(kin0 + (size_t)((wave <= ktl ? wave : ktl) * 16) * 32);
        for (int kt = wave; kt <= ktl; kt += NWAVES) {
            const int ktn = kt + NWAVES <= ktl ? kt + NWAVES : kt;
            const bf16x8 an = *(const GAS bf16x8*)(kin0 + (size_t)(ktn * 16) * 32);
#pragma unroll
            for (int hq = 0; hq < 2; ++hq) { f32x4 sc = (f32x4){0.f, 0.f, 0.f, 0.f};
#pragma unroll
                for (int h = 0; h < 8; ++h) { const f32x4 d = __builtin_amdgcn_mfma_f32_16x16x32_bf16(a, bq[hq][h], (f32x4){0.f, 0.f, 0.f, 0.f}, 0, 0, 0);
                    sc.x += relu_i(d.x) * wq[hq][h]; sc.y += relu_i(d.y) * wq[hq][h]; sc.z += relu_i(d.z) * wq[hq][h]; sc.w += relu_i(d.w) * wq[hq][h]; }
                *(GAS f32x4*)(srow + (size_t)(16 * hq) * SCS + kt * 16) = sc; }
            a = an;
        }
        asm volatile("s_waitcnt vmcnt(0)" ::: "memory"); __syncthreads();
        int lane_s = F.tid & 63; asm volatile("" : "+v"(lane_s));
        for (int r = 0; r < 4; ++r) select_row(b * SEQ + q0 + wave * 4 + r, SC, MASK, hist, ckey, cidx, lane_s);
#ifdef EXP_DUP_SELECT
        for (int r = 0; r < 4; ++r) select_row(b * SEQ + q0 + wave * 4 + r, SC, MASK, hist, ckey, cidx, lane_s);
#endif
    }
}

namespace att {
typedef float f32x16 __attribute__((ext_vector_type(16)));
typedef short s16x4 __attribute__((ext_vector_type(4)));
constexpr int NSLOT = 3, SLOTB = 8192, LDS_K = 0, LDS_V = NSLOT * SLOTB, LDS_WS = 2 * NSLOT * SLOTB, LDS_OST = LDS_WS + 8 * 64 * 4, LDS_BYTES_ATT = LDS_OST + 8 * 4096;
constexpr float THR = 100.f;
__device__ __forceinline__ int crow(int r, int hi) { return (r & 3) + 8 * (r >> 2) + 4 * hi; }
__device__ __forceinline__ unsigned cvtpk(float lo, float hi) { typedef float f2 __attribute__((ext_vector_type(2))); typedef __bf16 b2 __attribute__((ext_vector_type(2))); f2 v = {lo, hi}; b2 b = __builtin_convertvector(v, b2); return __builtin_bit_cast(unsigned, b); }
__device__ __forceinline__ float rowmax(const f32x16& p0, const f32x16& p1) {
    float a = fmaxf(fmaxf(p0[0], p0[1]), p1[0]), b = fmaxf(fmaxf(p0[2], p0[3]), p1[1]); a = fmaxf(fmaxf(a, p1[2]), p1[3]);
#pragma unroll
    for (int r = 4; r < 16; r += 4) { a = fmaxf(fmaxf(a, p0[r]), p0[r + 1]); b = fmaxf(fmaxf(b, p0[r + 2]), p0[r + 3]); a = fmaxf(fmaxf(a, p1[r]), p1[r + 1]); b = fmaxf(fmaxf(b, p1[r + 2]), p1[r + 3]); }
    const float m = fmaxf(a, b);
    return fmaxf(m, __shfl_xor(m, 32));
}
__device__ __forceinline__ void pv(f32x16* o, int vb, bf16x8 pa0, bf16x8 pa1, bf16x8 pa2, bf16x8 pa3) {
#pragma unroll
    for (int d0 = 0; d0 < 2; ++d0) { s16x4 lo[4], hi[4];
#pragma unroll
        for (int ks = 0; ks < 4; ++ks) {
            asm volatile("ds_read_b64_tr_b16 %0,%1 offset:%c2" : "=&v"(lo[ks]) : "v"(vb), "i"(d0 * 4096 + ks * 1024) : "memory");
            asm volatile("ds_read_b64_tr_b16 %0,%1 offset:%c2" : "=&v"(hi[ks]) : "v"(vb), "i"(d0 * 4096 + ks * 1024 + 512) : "memory"); }
        asm volatile("s_waitcnt lgkmcnt(0)" ::: "memory"); __builtin_amdgcn_sched_barrier(0);
#define ATT_PK(k) (bf16x8){lo[k][0], lo[k][1], lo[k][2], lo[k][3], hi[k][0], hi[k][1], hi[k][2], hi[k][3]}
        o[d0] = __builtin_amdgcn_mfma_f32_32x32x16_bf16(pa0, ATT_PK(0), o[d0], 0, 0, 0);
        o[d0] = __builtin_amdgcn_mfma_f32_32x32x16_bf16(pa1, ATT_PK(1), o[d0], 0, 0, 0);
        o[d0] = __builtin_amdgcn_mfma_f32_32x32x16_bf16(pa2, ATT_PK(2), o[d0], 0, 0, 0);
        o[d0] = __builtin_amdgcn_mfma_f32_32x32x16_bf16(pa3, ATT_PK(3), o[d0], 0, 0, 0);
#undef ATT_PK
    }
}
}
template <bool grpB> __device__ __forceinline__ void attn_units(Frame& F) {
    using namespace att;
    const int tid = F.tid, lane = tid & 63, r32 = lane & 31, hi = lane >> 5, wid = F.wave;
    const GAS bf16* PROJ = (const GAS bf16*)(F.ws + WS_PROJ); GAS bf16* CAT = (GAS bf16*)(F.ws + WS_CAT); const GAS u64* MASKT = (const GAS u64*)(F.ws + WS_MASK);
    LAS unsigned char* shm = F.lds;
    constexpr int NSV = 4, LDS_V2 = NSLOT * SLOTB, LDS_WS2 = LDS_V2 + NSV * SLOTB, LDS_OST2 = LDS_WS2 + 8 * 64 * 4;
    LAS float* wsf = (LAS float*)(shm + LDS_WS2) + wid * 64;
    const float NEGINF = -INFINITY;
    for (int ui = 0; ui < 2; ++ui) {
        const int v = F.vcu; if (v >= 256) break;
        const int bh = v >> 3, sidx = v & 7, b = bh >> 3, h = bh & 7, qb = ui == 0 ? sidx : 15 - sidx;
        const size_t rowbase = (size_t)b * SEQ; const int q0 = qb * 256, NT = (q0 + 256) / 64;
        const float slope2 = exp2f(-(float)(h + 1)) * 1.4426950408889634f;
        const GAS bf16* Kh = PROJ + rowbase * NINP + C_K + h * 64; const GAS bf16* Vh = PROJ + rowbase * NINP + C_V + h * 64;
        const GAS bf16* ksrc = Kh + (size_t)lane * NINP + wid * 8;
        const GAS bf16* vsrc = Vh + (size_t)(16 * (wid & 3) + (lane >> 2)) * NINP + (wid >> 2) * 32 + (lane & 3) * 8;
#define ATT_DMA(t, ks, vs) do { __builtin_amdgcn_global_load_lds((const GAS unsigned*)(ksrc + (size_t)(t) * 64 * NINP), (LAS unsigned*)(shm + LDS_K + (ks) * SLOTB + wid * 1024), 16, 0, 0); \
                        __builtin_amdgcn_global_load_lds((const GAS unsigned*)(vsrc + (size_t)(t) * 64 * NINP), (LAS unsigned*)(shm + LDS_V2 + (vs) * SLOTB + wid * 1024), 16, 0, 0); } while (0)
        ATT_DMA(0, 0, 0); ATT_DMA(1, 1, 1);
        const GAS bf16* Qw = PROJ + (rowbase + q0 + wid * 32) * NINP + C_Q + h * 64;
        bf16x8 qr[4];
#pragma unroll
        for (int d0 = 0; d0 < 4; ++d0) qr[d0] = *(const GAS bf16x8*)(Qw + (size_t)r32 * NINP + d0 * 16 + hi * 8);
        const GAS u64* mq = MASKT + ((size_t)b * 64) * SEQ + q0 + wid * 32 + r32;
        u64 mnext = mq[0], mprev = 0ull;
        f32x16 o[2], p0 = f32x16{}, p1 = f32x16{}; o[0] = f32x16{}; o[1] = f32x16{};
        float l_reg = 0.f, sq = 0.f;
        const unsigned sl_hi = __builtin_bit_cast(unsigned, slope2) & 0xffff0000u; const unsigned sl_lo = f2bf(slope2 - __builtin_bit_cast(float, sl_hi));
        bf16x8 kx0, kx1;
        { const unsigned j0 = hi ? 0u : (f2bf((float)r32) * 0x10001u), j1 = hi ? 0u : (f2bf((float)(r32 + 32)) * 0x10001u), one2 = hi ? 0u : 0x3f803f80u, one1 = hi ? 0u : 0x3f80u;
          kx0 = __builtin_bit_cast(bf16x8, (v4u){j0, one2, one1, 0u}); kx1 = __builtin_bit_cast(bf16x8, (v4u){j1, one2, one1, 0u}); }
        const int qlast = q0 + wid * 32 + 31;
        const int vb0 = (int)(unsigned)(uintptr_t)(shm + LDS_V2) + ((lane >> 4) & 1) * 32 + (lane & 3) * 8 + (4 * hi + ((lane & 15) >> 2)) * 64;
#define ATT_QK(ks) do { const LAS unsigned char* kb = shm + LDS_K + (ks) * SLOTB + hi * 1024 + r32 * 16; \
            { const unsigned u0_ = __builtin_bit_cast(unsigned, sq), a1_ = u0_ & 0xffff0000u; const float r1_ = sq - __builtin_bit_cast(float, a1_); const unsigned u1_ = __builtin_bit_cast(unsigned, r1_), a2_ = u1_ & 0xffff0000u; \
              const float r2_ = r1_ - __builtin_bit_cast(float, a2_); const unsigned a3_ = __builtin_bit_cast(unsigned, r2_) >> 16; \
              const bf16x8 qx = __builtin_bit_cast(bf16x8, (v4u){hi ? 0u : ((sl_hi >> 16) | (sl_lo << 16)), hi ? 0u : ((a1_ >> 16) | a2_), hi ? 0u : a3_, 0u}); \
              const f32x16 z_ = f32x16{}; p0 = __builtin_amdgcn_mfma_f32_32x32x16_bf16(kx0, qx, z_, 0, 0, 0); p1 = __builtin_amdgcn_mfma_f32_32x32x16_bf16(kx1, qx, z_, 0, 0, 0); } \
            _Pragma("unroll") for (int d0 = 0; d0 < 4; ++d0) { const bf16x8 k0 = *(const LAS bf16x8*)(kb + d0 * 2048), k1 = *(const LAS bf16x8*)(kb + d0 * 2048 + 512); \
                p0 = __builtin_amdgcn_mfma_f32_32x32x16_bf16(k0, qr[d0], p0, 0, 0, 0); p1 = __builtin_amdgcn_mfma_f32_32x32x16_bf16(k1, qr[d0], p1, 0, 0, 0); } } while (0)
#define ATT_SMPV(vs, mw) do { const unsigned w0 = (unsigned)(mw) >> (4 * hi), w1 = (unsigned)((mw) >> 32) >> (4 * hi); \
            asm volatile("s_nop 15\n\ts_nop 7" : "+v"(p0), "+v"(p1));   \
            _Pragma("unroll") for (int r = 0; r < 16; ++r) { const int cr = (r & 3) + 8 * (r >> 2); const int k0_ = __builtin_amdgcn_sbfe((int)w0, cr, 1), k1_ = __builtin_amdgcn_sbfe((int)w1, cr, 1); \
                asm("v_bfi_b32 %0, %1, %0, %2" : "+v"(p0[r]) : "v"(k0_), "v"(NEGINF)); asm("v_bfi_b32 %0, %1, %0, %2" : "+v"(p1[r]) : "v"(k1_), "v"(NEGINF)); } \
            const float rm = rowmax(p0, p1); bool resc = false; \
            if (__any(rm > THR)) { const float dl = fmaxf(rm, 0.f); \
                _Pragma("unroll") for (int r = 0; r < 16; ++r) { p0[r] -= dl; p1[r] -= dl; } sq -= dl; \
                const float f = __builtin_amdgcn_exp2f(-dl); l_reg *= f; if (hi == 0) wsf[r32] = f; resc = true; } \
            float sacc = 0.f; \
            _Pragma("unroll") for (int r = 0; r < 16; ++r) { p0[r] = __builtin_amdgcn_exp2f(p0[r]); p1[r] = __builtin_amdgcn_exp2f(p1[r]); sacc += p0[r] + p1[r]; } \
            l_reg += sacc; \
            if (resc) { asm volatile("s_waitcnt lgkmcnt(0)" ::: "memory"); \
                _Pragma("unroll") for (int d_ = 0; d_ < 2; ++d_) _Pragma("unroll") for (int r = 0; r < 16; ++r) o[d_][r] *= wsf[crow(r, hi)]; } \
            const v4u pw0 = (v4u){cvtpk(p0[0], p0[1]), cvtpk(p0[2], p0[3]), cvtpk(p0[4], p0[5]), cvtpk(p0[6], p0[7])}, pw1 = (v4u){cvtpk(p0[8], p0[9]), cvtpk(p0[10], p0[11]), cvtpk(p0[12], p0[13]), cvtpk(p0[14], p0[15])}; \
            const v4u pw2 = (v4u){cvtpk(p1[0], p1[1]), cvtpk(p1[2], p1[3]), cvtpk(p1[4], p1[5]), cvtpk(p1[6], p1[7])}, pw3 = (v4u){cvtpk(p1[8], p1[9]), cvtpk(p1[10], p1[11]), cvtpk(p1[12], p1[13]), cvtpk(p1[14], p1[15])}; \
            __builtin_amdgcn_sched_barrier(0); \
            pv(o, vb0 + (vs) * SLOTB, __builtin_bit_cast(bf16x8, pw0), __builtin_bit_cast(bf16x8, pw1), __builtin_bit_cast(bf16x8, pw2), __builtin_bit_cast(bf16x8, pw3)); } while (0)
        if constexpr (grpB) __builtin_amdgcn_s_setprio(1);
        const float step = 64.f * slope2;
        int ks = 0, vs = 0;
        u64 mcur = 0ull;
#define ATT_SYNC(t) do { if ((t) + 1 < NT) asm volatile("s_waitcnt vmcnt(2)" ::: "memory"); else asm volatile("s_waitcnt vmcnt(0)" ::: "memory"); \
            asm volatile("s_waitcnt lgkmcnt(0)" ::: "memory"); __builtin_amdgcn_s_barrier(); asm volatile("" ::: "memory"); \
            mprev = mcur; mcur = mnext; if ((t) + 1 < NT) mnext = mq[(size_t)((t) + 1) * SEQ]; \
            __builtin_amdgcn_sched_barrier(0); \
            if ((t) + 2 < NT) ATT_DMA((t) + 2, ks + 2 >= NSLOT ? ks + 2 - NSLOT : ks + 2, vs + 2 >= NSV ? vs + 2 - NSV : vs + 2); \
            __builtin_amdgcn_sched_barrier(0); } while (0)
#define ATT_ADV() do { sq += step; ks = ks + 1 >= NSLOT ? 0 : ks + 1; vs = vs + 1 >= NSV ? 0 : vs + 1; } while (0)
        const int tmax = qlast >> 6;
        if constexpr (!grpB) {
            int t = 0;
            for (; t <= tmax; ++t) { ATT_SYNC(t); ATT_QK(ks); ATT_SMPV(vs, mcur); ATT_ADV(); }
            for (; t < NT; ++t) { ATT_SYNC(t); ATT_ADV(); }
        } else {
            ATT_SYNC(0); ATT_QK(ks); ATT_ADV();
            int t = 1;
            for (; t <= tmax; ++t) { ATT_SYNC(t); ATT_SMPV(vs == 0 ? NSV - 1 : vs - 1, mprev); ATT_QK(ks); ATT_ADV(); }
            if (t < NT) { ATT_SYNC(t); ATT_SMPV(vs == 0 ? NSV - 1 : vs - 1, mprev); ATT_ADV(); ++t;
                for (; t < NT; ++t) { ATT_SYNC(t); ATT_ADV(); } }
            else { ATT_SMPV(vs == 0 ? NSV - 1 : vs - 1, mcur); }
        }
#undef ATT_SYNC
#undef ATT_ADV
        __builtin_amdgcn_s_setprio(0);
        l_reg += __shfl_xor(l_reg, 32);
        if (hi == 0) wsf[32 + r32] = l_reg;
        asm volatile("s_waitcnt lgkmcnt(0)" ::: "memory");
        float rli[16];
#pragma unroll
        for (int r = 0; r < 16; ++r) rli[r] = 1.f / wsf[32 + crow(r, hi)];
        GAS bf16* Ow = CAT + (rowbase + q0 + wid * 32) * D + 512 + h * 64;
        { LAS bf16* stg = (LAS bf16*)(shm + LDS_OST2) + wid * 2048;
#pragma unroll
            for (int r = 0; r < 16; ++r) { const int orow = crow(r, hi);
#pragma unroll
                for (int d0 = 0; d0 < 2; ++d0) stg[orow * 64 + d0 * 32 + r32] = (bf16)f2bf(o[d0][r] * rli[r]); }
            asm volatile("s_waitcnt lgkmcnt(0)" ::: "memory");
#pragma unroll
            for (int i = 0; i < 4; ++i) { const int row = i * 8 + (lane >> 3), ch = lane & 7; const v4u vv = *(const LAS v4u*)(stg + row * 64 + ch * 8); *(GAS v4u*)(Ow + (size_t)row * D + ch * 8) = vv; } }
        asm volatile("s_waitcnt vmcnt(0) lgkmcnt(0)" ::: "memory"); __builtin_amdgcn_s_barrier(); asm volatile("" ::: "memory");
#undef ATT_DMA
#undef ATT_QK
#undef ATT_SMPV
    }
}

__device__ __forceinline__ void p_attn_dense(Frame& F) { if (F.wave >= 4) attn_units<true>(F); else attn_units<false>(F); }

struct EpiResid {
    static constexpr bool PERM = true, AFTER_DRAIN = false;
    const bf16* resid; bf16* out; float alpha;
    __device__ __forceinline__ void operator()(const pg8::f32x4 (&acc)[2][2][4][2], const pg8::Unit& u, int wr, int wc, int fr, int fq) const {
        const int col0 = u.pn * 256 + wc * 32 + 8 * fq;
#pragma unroll
        for (int ai = 0; ai < 2; ++ai)
#pragma unroll
            for (int m = 0; m < 4; ++m) { const size_t off = (size_t)(u.pm * 256 + ai * 128 + wr * 64 + m * 16 + fr) * D + col0;
#pragma unroll
                for (int bj = 0; bj < 2; ++bj) { const v4u xr = *(const GAS v4u*)(resid + off + bj * 128); const f32x4 a0 = acc[ai][bj][m][0], a1 = acc[ai][bj][m][1];
                    v4u w; w.x = pk2(bflo(xr.x) * alpha + a0[0], bfhi(xr.x) * alpha + a0[1]); w.y = pk2(bflo(xr.y) * alpha + a0[2], bfhi(xr.y) * alpha + a0[3]);
                    w.z = pk2(bflo(xr.z) * alpha + a1[0], bfhi(xr.z) * alpha + a1[1]); w.w = pk2(bflo(xr.w) * alpha + a1[2], bfhi(xr.w) * alpha + a1[3]);
                    st16_wt(out + off + bj * 128, w.x, w.y, w.z, w.w); }
                if (m & 1) asm volatile("" ::: "memory"); }
    }
};
struct EpiSwiglu {
    static constexpr bool PERM = true, AFTER_DRAIN = false;
    unsigned char* O; const float* bias;
    __device__ __forceinline__ void operator()(const pg8::f32x4 (&acc)[2][2][4][2], const pg8::Unit& u, int wr, int wc, int fr, int fq) const {
        const int e = u.pn >> 3, nt = u.pn & 7; const int colg = nt * 128 + wc * 32 + 8 * fq;
        f32x4 bg[2], bu[2];
#pragma unroll
        for (int n = 0; n < 2; ++n) { bg[n] = *(const GAS f32x4*)(bias + (size_t)e * 2048 + colg + 4 * n); bu[n] = *(const GAS f32x4*)(bias + (size_t)e * 2048 + 1024 + colg + 4 * n); }
#pragma unroll
        for (int ai = 0; ai < 2; ++ai)
#pragma unroll
            for (int m = 0; m < 4; ++m) { const size_t row = (size_t)(u.pm * 256 + ai * 128 + wr * 64 + m * 16 + fr); float a8[8];
#pragma unroll
                for (int n = 0; n < 2; ++n)
#pragma unroll
                    for (int i = 0; i < 4; ++i) { float g = fmaf(acc[ai][0][m][n][i], 1.f / WGU_SCALE, bg[n][i]), up = fmaf(acc[ai][1][m][n][i], 1.f / WGU_SCALE, bu[n][i]);
                        g = fminf(g, 7.f); up = fminf(fmaxf(up, -7.f), 7.f);
                        a8[n * 4 + i] = g * (up + 1.f) * __builtin_amdgcn_rcpf(1.f + __builtin_amdgcn_exp2f(-1.702f * 1.4426950408889634f * g)); }
                v2u w; w.x = pk4_fp8(a8[0], a8[1], a8[2], a8[3]); w.y = pk4_fp8(a8[4], a8[5], a8[6], a8[7]);
                st8_wt(O + row * 1024 + colg, w.x, w.y); }
    }
};
struct EpiDown {
    static constexpr bool PERM = true, AFTER_DRAIN = false;
    bf16* O; const float* bias;
    __device__ __forceinline__ void operator()(const pg8::f32x4 (&acc)[2][2][4][2], const pg8::Unit& u, int wr, int wc, int fr, int fq) const {
        const int col0 = (u.pn & 3) * 256 + wc * 32 + 8 * fq; const float* bp = bias + (size_t)(u.pn >> 2) * 1024 + col0;
        f32x4 bv[2][2];
#pragma unroll
        for (int bj = 0; bj < 2; ++bj)
#pragma unroll
            for (int n = 0; n < 2; ++n) bv[bj][n] = *(const GAS f32x4*)(bp + bj * 128 + 4 * n);
#pragma unroll
        for (int ai = 0; ai < 2; ++ai)
#pragma unroll
            for (int m = 0; m < 4; ++m) { bf16* rowp = O + (size_t)(u.pm * 256 + ai * 128 + wr * 64 + m * 16 + fr) * 1024 + col0;
#pragma unroll
                for (int bj = 0; bj < 2; ++bj) { const f32x4 v0 = acc[ai][bj][m][0] * (1.f / WDN_SCALE) + bv[bj][0], v1 = acc[ai][bj][m][1] * (1.f / WDN_SCALE) + bv[bj][1];
                    v4u w; w.x = pk2(v0[0], v0[1]); w.y = pk2(v0[2], v0[3]); w.z = pk2(v1[0], v1[1]); w.w = pk2(v1[2], v1[3]);
                    st16_wt(rowp + bj * 128, w.x, w.y, w.z, w.w); } }
    }
};
struct MoeSched {
    const LAS int* tab; int n;
    __device__ __forceinline__ bool next(int i, pg8::Unit& u) const {
        if (i >= n) return false;
        const int v = __builtin_amdgcn_readfirstlane(tab[1 + i]); u.pm = v >> 16; u.pn = v & 0xffff; return true;
    }
    __device__ __forceinline__ void a_ready(const pg8::Unit&) const {}
    __device__ __forceinline__ void done(const pg8::Unit&) const {}
};
#ifndef MOE_UNIT_OWNER
#define MOE_UNIT_OWNER F.vcu
#endif
__device__ __forceinline__ int moe_table(Frame& F, int l, int ntn) {
    LAS int* tab = (LAS int*)(F.lds + TAB_OFF);
    if (F.wave == 0) {
        const int lane = F.lane; const int cnt = lane < NE ? (int)__hip_atomic_load(F.ctl + CW_CNT + 64 * l + lane, RLX_AGENT) : 0; const int mt = (cnt + 255) >> 8; int incl = mt;
#pragma unroll
        for (int o = 1; o < 64; o <<= 1) { const int v = __shfl_up(incl, o); if (lane >= o) incl += v; }
        const int total = __shfl(incl, 63) * ntn; const int c = MOE_UNIT_OWNER;
        const int xcd = c >> 5, jw = c & 31, uq = total >> 3, ur = total & 7, cntx = uq + (xcd < ur ? 1 : 0), basex = xcd * uq + (xcd < ur ? xcd : ur);
        const int nmine = jw < cntx ? (cntx - jw + 31) >> 5 : 0;
        for (int i0 = 0; i0 < nmine && i0 < 200; i0 += 64) { const int i = i0 + lane; const int L = basex + i * 32 + jw; int e = 0;
            for (int k = 0; k < NE; ++k) { const int endk = __shfl(incl, k) * ntn; e += (L >= endk) ? 1 : 0; }
            e = e < NE ? e : NE - 1;
            const int excl_e = __shfl(incl, e) - __shfl(mt, e); int mte = __shfl(mt, e); mte = mte > 0 ? mte : 1; const int idx = L - excl_e * ntn;
            if (i < nmine && i < 200) tab[1 + i] = ((excl_e + idx % mte) << 16) | (e * ntn + idx / mte); }
        if (lane == 0) tab[0] = nmine < 200 ? nmine : 200;
    }
    __syncthreads();
    return __builtin_amdgcn_readfirstlane(tab[0]);
}

__device__ __forceinline__ void p_router(Frame& F, const In6& A, int l) {
    const int lane = F.lane, wave = F.wave, tid = F.tid;
    constexpr int XROW = 2064;
    LAS unsigned char* XH = F.lds; LAS unsigned char* XL = F.lds + 16 * XROW;
    LAS float* part = (LAS float*)(F.lds + 2 * 16 * XROW);
    LAS int* cnt = (LAS int*)(F.lds + 2 * 16 * XROW + 16384);
    LAS float* lgs = (LAS float*)(F.lds + 2 * 16 * XROW + 16384 + 1024);
    LAS float* top = lgs + 512;
    const GAS bf16* Y1 = (const GAS bf16*)(F.ws + WS_Y1); GAS bf16* X1B = (GAS bf16*)(F.ws + WS_Y1 + 32 * MiB); GAS unsigned* XB8 = (GAS unsigned*)(F.ws + WS_XB8);
    GAS int* TOPE = (GAS int*)(F.ws + WS_ROUTE); GAS float* GATE = (GAS float*)(TOPE + 8 * T); GAS int* CNTW = (GAS int*)(F.ws + WS_CNTW);
    const GAS float* g1 = (const GAS float*)(A.p[0] + l * D); const GAS float* b1 = (const GAS float*)(A.p[1] + l * D);
    const GAS float* RW = (const GAS float*)(A.p[2] + (size_t)l * D * NE); const GAS float* RB = (const GAS float*)(A.p[3] + l * NE);
    if (tid < 256) cnt[tid] = 0;
    bf16x8 wh[4][2], wl[4][2];
#pragma unroll
    for (int st = 0; st < 4; ++st)
#pragma unroll
        for (int hf = 0; hf < 2; ++hf) { const GAS float* wp = RW + (size_t)(wave * 128 + st * 32 + (lane >> 4) * 8) * NE + (lane & 15) + 16 * hf;
#pragma unroll
            for (int j = 0; j < 8; ++j) { const float w = wp[(size_t)j * NE]; const unsigned h = f2bf(w); const float r = w - __builtin_bit_cast(float, h << 16); wh[st][hf][j] = (short)h; wl[st][hf][j] = (short)f2bf(r); } }
    f32x4 g1v[4], b1v[4];
#pragma unroll
    for (int j = 0; j < 4; ++j) { g1v[j] = ((const GAS f32x4*)g1)[lane + 64 * j]; b1v[j] = ((const GAS f32x4*)b1)[lane + 64 * j]; }
    const float rb_e = RB[tid & 31];
    v2u yq[2][4];
#pragma unroll
    for (int i = 0; i < 2; ++i) { const GAS v2u* yr = (const GAS v2u*)(Y1 + (size_t)(F.vcu * 64 + wave * 2 + i) * D) + lane;
#pragma unroll
        for (int j = 0; j < 4; ++j) yq[i][j] = yr[64 * j]; }
    for (int g = 0; g < 4; ++g) {
        const int t0 = F.vcu * 64 + g * 16;
#pragma unroll
        for (int i = 0; i < 2; ++i) { const int tl = wave * 2 + i, t = t0 + tl;
            GAS u64* xr1 = (GAS u64*)(X1B + (size_t)t * D) + lane; f32x4 v[4]; float s = 0.f;
#pragma unroll
            for (int j = 0; j < 4; ++j) { const v2u q = yq[i][j]; v[j] = (f32x4){bflo(q.x), bfhi(q.x), bflo(q.y), bfhi(q.y)}; s += (v[j].x + v[j].y) + (v[j].z + v[j].w); }
            if (g < 3) { const GAS v2u* yr = (const GAS v2u*)(Y1 + (size_t)(t + 16) * D) + lane;
#pragma unroll
                for (int j = 0; j < 4; ++j) yq[i][j] = yr[64 * j]; }
            const float mean = wave_sum(s) * (1.f / D); float s2 = 0.f;
#pragma unroll
            for (int j = 0; j < 4; ++j) { v[j] = v[j] - mean; s2 += (v[j].x * v[j].x + v[j].y * v[j].y) + (v[j].z * v[j].z + v[j].w * v[j].w); }
            const float rstd = rsqrtf(wave_sum(s2) * (1.f / D) + LN_EPS);
            GAS unsigned* o8 = XB8 + (size_t)t * (D / 4) + lane;
#pragma unroll
            for (int j = 0; j < 4; ++j) { const f32x4 y = v[j] * rstd * g1v[j] + b1v[j];
                o8[64 * j] = pk4_fp8(y.x, y.y, y.z, y.w);
                const unsigned h0 = f2bf(y.x), h1 = f2bf(y.y), h2 = f2bf(y.z), h3 = f2bf(y.w);
                const u64 hp = (u64)(h0 | (h1 << 16)) | ((u64)(h2 | (h3 << 16)) << 32); xr1[64 * j] = hp;
                const float r0 = y.x - __builtin_bit_cast(float, h0 << 16), r1 = y.y - __builtin_bit_cast(float, h1 << 16), r2 = y.z - __builtin_bit_cast(float, h2 << 16), r3 = y.w - __builtin_bit_cast(float, h3 << 16);
                *(LAS u64*)(XH + tl * XROW + (lane + 64 * j) * 8) = hp;
                *(LAS u64*)(XL + tl * XROW + (lane + 64 * j) * 8) = (u64)pk2(r0, r1) | ((u64)pk2(r2, r3) << 32); } }
        __syncthreads();
        f32x4 acc[2]; acc[0] = (f32x4){0.f, 0.f, 0.f, 0.f}; acc[1] = acc[0];
#pragma unroll
        for (int st = 0; st < 4; ++st) { const int boff = (lane & 15) * XROW + (wave * 128 + st * 32 + (lane >> 4) * 8) * 2;
            const bf16x8 bh = *(const LAS bf16x8*)(XH + boff), bl = *(const LAS bf16x8*)(XL + boff);
#pragma unroll
            for (int hf = 0; hf < 2; ++hf) { acc[hf] = __builtin_amdgcn_mfma_f32_16x16x32_bf16(wh[st][hf], bh, acc[hf], 0, 0, 0); acc[hf] = __builtin_amdgcn_mfma_f32_16x16x32_bf16(wh[st][hf], bl, acc[hf], 0, 0, 0);
                acc[hf] = __builtin_amdgcn_mfma_f32_16x16x32_bf16(wl[st][hf], bh, acc[hf], 0, 0, 0); } }
#pragma unroll
        for (int hf = 0; hf < 2; ++hf)
#pragma unroll
            for (int r = 0; r < 4; ++r) part[((wave * 2 + hf) * 16 + 4 * (lane >> 4) + r) * 16 + (lane & 15)] = acc[hf][r];
        __syncthreads();
        { const int tl = tid >> 5, e = tid & 31, t = t0 + tl; float lg = rb_e;
#pragma unroll
            for (int w = 0; w < 8; ++w) lg += part[((w * 2 + (e >> 4)) * 16 + (e & 15)) * 16 + tl];
            lgs[tl * 32 + e] = lg;
            LDS_WAIT(); asm volatile("" ::: "memory");
            int rank = 0;
#pragma unroll
            for (int q = 0; q < 8; ++q) { const f32x4 o = *(const LAS f32x4*)(lgs + tl * 32 + 4 * q);
#pragma unroll
                for (int i = 0; i < 4; ++i) { const int eo = 4 * q + i; rank += (o[i] > lg || (o[i] == lg && eo < e)) ? 1 : 0; } }
            if (rank < 4) { top[tl * 4 + rank] = lg; __hip_atomic_fetch_add(cnt + ((g * 16 + tl) >> 3) * 32 + e, 1, __ATOMIC_RELAXED, __HIP_MEMORY_SCOPE_WORKGROUP); }
            LDS_WAIT(); asm volatile("" ::: "memory");
            const f32x4 sv = *(const LAS f32x4*)(top + tl * 4);
            const float e1 = expf(sv[1] - sv[0]), e2 = expf(sv[2] - sv[0]), e3 = expf(sv[3] - sv[0]); const float inv = 1.f / (1.f + e1 + e2 + e3);
            if (rank < 4) { const float gk = (rank == 0 ? 1.f : rank == 1 ? e1 : rank == 2 ? e2 : e3) * inv; TOPE[4 * t + rank] = e; GATE[4 * t + rank] = gk; } }
    }
    __syncthreads();
    if (tid < 256) CNTW[(F.vcu * NWAVES + (tid >> 5)) * NE + (tid & 31)] = cnt[tid];
    __syncthreads();
}

__device__ __forceinline__ void p_gather(Frame& F, int l) {
    const int gw = F.vcu * NWAVES + F.wave, NGW = F.G * NWAVES, lane = F.lane, tid = F.tid;
    const int TPW = T / NGW, NIT = TPW * 4;
    const GAS int* CNTW = (const GAS int*)(F.ws + WS_CNTW);
    LAS int* red = (LAS int*)F.lds;
    LAS int* baseE = red + 1024; LAS int* totE = baseE + 32;
    { const int e = tid & 31, part = tid >> 5, first = F.vcu * NWAVES; int sb = 0, st = 0;
        for (int g0 = part; g0 < NGW; g0 += 256) { int c[16];
#pragma unroll
            for (int k = 0; k < 16; ++k) c[k] = g0 + 16 * k < NGW ? CNTW[(g0 + 16 * k) * NE + e] : 0;
#pragma unroll
            for (int k = 0; k < 16; ++k) { st += c[k]; sb += g0 + 16 * k < first ? c[k] : 0; } }
        red[part * 32 + e] = sb; red[512 + part * 32 + e] = st; }
    __syncthreads();
    if (tid < 32) { int sb = 0, st = 0;
#pragma unroll
        for (int p = 0; p < 16; ++p) { sb += red[p * 32 + tid]; st += red[512 + p * 32 + tid]; }
        baseE[tid] = sb; totE[tid] = st;
        if (F.vcu == 0) __hip_atomic_store(F.ctl + CW_CNT + 64 * l + tid, (unsigned)st, RLX_AGENT); }
    __syncthreads();
    int mybase = 0, tot = 0;
    if (lane < NE) { mybase = baseE[lane]; tot = totE[lane]; int cw[NWAVES - 1];
#pragma unroll
        for (int w = 0; w < NWAVES - 1; ++w) cw[w] = CNTW[(F.vcu * NWAVES + w) * NE + lane];
#pragma unroll
        for (int w = 0; w < NWAVES - 1; ++w) mybase += w < F.wave ? cw[w] : 0; }
    const int mt = (tot + 255) >> 8; int incl = mt;
#pragma unroll
    for (int o = 1; o < 64; o <<= 1) { const int v = __shfl_up(incl, o); if (lane >= o) incl += v; }
    const int pstart = (incl - mt) * 256;
    const GAS int* TOPE = (const GAS int*)(F.ws + WS_ROUTE); GAS int* ROWOF = (GAS int*)(F.ws + WS_ROUTE) + 12 * T; GAS int* ROWTOK = (GAS int*)(F.ws + WS_XS);
    if (F.vcu < NE && F.wave == 0) {
        const int e = F.vcu; const int ps = __builtin_amdgcn_readlane(pstart, e), te = __builtin_amdgcn_readlane(tot, e), me = __builtin_amdgcn_readlane(mt, e);
        for (int i = te + lane; i < me * 256; i += 64) ROWTOK[ps + i] = 0; }
    const int it0 = gw * NIT; const int ei = lane < NIT ? TOPE[it0 + lane] : 0; int rk = 0;
    for (int j = 0; j < NIT; ++j) { const int ej = __shfl(ei, j); rk += (j < lane && ej == ei) ? 1 : 0; }
    const int row = __shfl(pstart, ei) + __shfl(mybase, ei) + rk;
    if (lane < NIT) { ROWOF[it0 + lane] = row; ROWTOK[row] = (it0 + lane) >> 2; }
    __syncthreads();
}

__device__ __forceinline__ void p_combine(Frame& F, const In6& A, int l, float* xout_) {
    constexpr int TPW = 8;
    const int gw = F.vcu * NWAVES + F.wave, NGW = F.G * NWAVES, lane = F.lane;
    const GAS int* ROWOF = (const GAS int*)(F.ws + WS_ROUTE) + 12 * T; const GAS float* GATE = (const GAS float*)(F.ws + WS_ROUTE) + 8 * T;
    const GAS bf16* X1B = (const GAS bf16*)(F.ws + WS_Y1 + 32 * MiB); const GAS bf16* YS = (const GAS bf16*)(F.ws + WS_YS); GAS bf16* XB = (GAS bf16*)(F.ws + WS_XB);
    GAS float* xout = (GAS float*)xout_;
    const GAS f32x4* g2 = (const GAS f32x4*)(A.p[0] + l * D) + lane; const GAS f32x4* b2 = (const GAS f32x4*)(A.p[1] + l * D) + lane;
    int rowv = 0; float gatev = 0.f;
    if (lane < 4 * TPW) { const int tk = gw + (lane >> 2) * NGW; rowv = ROWOF[4 * tk + (lane & 3)]; gatev = GATE[4 * tk + (lane & 3)]; }
    f32x4 gg[4], bb[4];
#pragma unroll
    for (int j = 0; j < 4; ++j) { gg[j] = g2[64 * j]; bb[j] = b2[64 * j]; }
    v2u xq[2][4], yq[2][4][4];
#define CMB_ISSUE(k, bf) do { const int t_ = gw + (k) * NGW; const GAS v2u* xr_ = (const GAS v2u*)(X1B + (size_t)t_ * D) + lane; \
        _Pragma("unroll") for (int j = 0; j < 4; ++j) xq[bf][j] = xr_[64 * j]; \
        _Pragma("unroll") for (int c = 0; c < 4; ++c) { const int row_ = __builtin_amdgcn_readlane(rowv, 4 * (k) + c); const GAS v2u* yr_ = (const GAS v2u*)(YS + (size_t)row_ * D) + lane; \
            _Pragma("unroll") for (int j = 0; j < 4; ++j) yq[bf][c][j] = yr_[64 * j]; } } while (0)
    CMB_ISSUE(0, 0);
#pragma unroll
    for (int k = 0; k < TPW; ++k) {
        const int bf = k & 1, t = gw + k * NGW;
        if (k + 1 < TPW) { if (bf == 0) CMB_ISSUE(k + 1, 1); else CMB_ISSUE(k + 1, 0); }
        f32x4 v[4];
#pragma unroll
        for (int j = 0; j < 4; ++j) { const v2u q = xq[bf][j]; v[j] = (f32x4){bflo(q.x), bfhi(q.x), bflo(q.y), bfhi(q.y)} * DN_ALPHA; }
#pragma unroll
        for (int c = 0; c < 4; ++c) { const float gk = __builtin_bit_cast(float, __builtin_amdgcn_readlane(__builtin_bit_cast(int, gatev), 4 * k + c));
#pragma unroll
            for (int j = 0; j < 4; ++j) { const v2u w = yq[bf][c][j]; v[j].x += gk * bflo(w.x); v[j].y += gk * bfhi(w.x); v[j].z += gk * bflo(w.y); v[j].w += gk * bfhi(w.y); } }
        float s = 0.f;
#pragma unroll
        for (int j = 0; j < 4; ++j) s += (v[j].x + v[j].y) + (v[j].z + v[j].w);
        const float mean = wave_sum(s) * (1.f / D); float s2 = 0.f;
#pragma unroll
        for (int j = 0; j < 4; ++j) { v[j] = v[j] - mean; s2 += (v[j].x * v[j].x + v[j].y * v[j].y) + (v[j].z * v[j].z + v[j].w * v[j].w); }
        const float rstd = rsqrtf(wave_sum(s2) * (1.f / D) + LN_EPS);
        GAS f32x4* orow = (GAS f32x4*)(xout + (size_t)t * D) + lane; GAS u64* o8 = (GAS u64*)(XB + (size_t)t * D) + lane;
#pragma unroll
        for (int j = 0; j < 4; ++j) { const f32x4 y = v[j] * rstd * gg[j] + bb[j];
            if (xout_) orow[64 * j] = y; else o8[64 * j] = (u64)pk2(y.x, y.y) | ((u64)pk2(y.z, y.w) << 32); }
        __builtin_amdgcn_sched_barrier(0);
    }
#undef CMB_ISSUE
}


#define NI __device__ __forceinline__
NI void ph_prologue(unsigned char* ws, LAS unsigned char* lds, const float* a0, const float* a1, const float* a2, const float* a3, const float* a4) { Frame F = make_frame(ws, lds); In6 I{{uni(a0), uni(a1), uni(a2), uni(a3), uni(a4), nullptr}}; p_prologue(F, I); }
NI void ph_local(unsigned char* ws, LAS unsigned char* lds, int l, const float* a0, const float* a1, const float* a2, const float* a3, const float* a4) { Frame F = make_frame(ws, lds); In6 I{{uni(a0), uni(a1), uni(a2), uni(a3), uni(a4), nullptr}}; p_local(F, I, __builtin_amdgcn_readfirstlane(l)); }
NI void ph_scores(unsigned char* ws, LAS unsigned char* lds) { Frame F = make_frame(ws, lds); p_index(F); }
NI void ph_attn(unsigned char* ws, LAS unsigned char* lds) { Frame F = make_frame(ws, lds); p_attn_dense(F); }
NI void ph_router(unsigned char* ws, LAS unsigned char* lds, int l, const float* a0, const float* a1, const float* a2, const float* a3) { Frame F = make_frame(ws, lds); In6 I{{uni(a0), uni(a1), uni(a2), uni(a3), nullptr, nullptr}}; p_router(F, I, __builtin_amdgcn_readfirstlane(l)); }
NI void ph_gather(unsigned char* ws, LAS unsigned char* lds, int l) { Frame F = make_frame(ws, lds); p_gather(F, __builtin_amdgcn_readfirstlane(l)); }
NI void ph_combine(unsigned char* ws, LAS unsigned char* lds, int l, const float* a0, const float* a1, float* xout) { Frame F = make_frame(ws, lds); In6 I{{uni(a0), uni(a1), nullptr, nullptr, nullptr, nullptr}}; p_combine(F, I, __builtin_amdgcn_readfirstlane(l), (float*)uni(xout)); }

NI void ph_gemm_in(unsigned char* ws, LAS unsigned char* lds, int l_) {
    Frame F = make_frame(ws, lds); const int l = __builtin_amdgcn_readfirstlane(l_);
    pg8::Gemm g{WSP(bf16, WS_XB), WSP(bf16, WS_WIN) + (size_t)l * NINP * D, T, NINP, D}; pg8::StaticOrder S; S.init(T, NINP, F.G, (int)blockIdx.x);
    pg8::EpiBf16<0> E{WSP(bf16, WS_PROJ), NINP, nullptr, 0, 0, 1.f};
    pg8::gemm_phase<pg8::EpiBf16<0>, pg8::StaticOrder, PG8_ALIGN, PG8_SP2>(F.lds, g, S, E);
}
NI void ph_gemm_out(unsigned char* ws, LAS unsigned char* lds, int l_, const float* xin) {
    Frame F = make_frame(ws, lds); const int l = __builtin_amdgcn_readfirstlane(l_);
    pg8::Gemm g{WSP(bf16, WS_CAT), WSP(bf16, WS_WOUT) + (size_t)l * D * D, T, D, D}; pg8::StaticOrder S; S.init(T, D, F.G, (int)blockIdx.x);
    EpiResid E{WSP(bf16, WS_XB), WSP(bf16, WS_Y1), DN_ALPHA};
    pg8::gemm_phase<EpiResid, pg8::StaticOrder, PG8_ALIGN, PG8_SP2>(F.lds, g, S, E);
}
NI void ph_gemm_moe1(unsigned char* ws, LAS unsigned char* lds, int l_, const float* bgu) {
    Frame F = make_frame(ws, lds); const int l = __builtin_amdgcn_readfirstlane(l_);
    const int nun = moe_table(F, l, 8);
    pg8::Gemm g{WSP(bf16, WS_XB8), (const bf16*)(WSP(unsigned char, WS_WGU) + (size_t)l * NE * 2048 * D * 2), MAXROWS, NE * 2048, D};
    MoeSched S{(const LAS int*)(F.lds + TAB_OFF), nun};
    EpiSwiglu E{WSP(unsigned char, WS_ACT), uni(bgu) + (size_t)l * NE * 2048};
    pg8::gemm_phase<EpiSwiglu, MoeSched, PG8_ALIGN, true, 1, true>(F.lds, g, S, E, WSP(int, WS_XS));
}
NI void ph_gemm_moe2(unsigned char* ws, LAS unsigned char* lds, int l_, const float* bdn) {
    Frame F = make_frame(ws, lds); const int l = __builtin_amdgcn_readfirstlane(l_);
    const int nun = moe_table(F, l, 4);
    pg8::Gemm g{WSP(bf16, WS_ACT), (const bf16*)(WSP(unsigned char, WS_WDN) + (size_t)l * NE * D * D * 2), MAXROWS, NE * D, D};
    MoeSched S{(const LAS int*)(F.lds + TAB_OFF), nun};
    EpiDown E{WSP(bf16, WS_YS), uni(bdn) + (size_t)l * NE * D};
    pg8::gemm_phase<EpiDown, MoeSched, PG8_ALIGN, MOE_SP2, 1>(F.lds, g, S, E);
}

__device__ __forceinline__ const float* karg_in(int i) { return ((const float* const volatile*)__builtin_amdgcn_kernarg_segment_ptr())[i]; }
__device__ __forceinline__ float* karg_out() { return ((float* const volatile*)__builtin_amdgcn_kernarg_segment_ptr())[N_IN]; }
#ifndef PHMASK
#define PHMASK 0x7FF
#endif
constexpr int PH_PER_LAYER = 10, N_PHASES = 1 + DEPTH * PH_PER_LAYER;
#define IN(k) (lo <= (k) && (k) < hi)
#define SEAM(k) do { if (IN(k) && IN((k) + 1)) xcd_barrier(bar); } while (0)
template <int l> __device__ __forceinline__ void layer_phases(Frame& F, const XcdBarrier& bar, int lo, int hi) {
        const int p0 = 1 + l * PH_PER_LAYER;
        const float* xin = nullptr;
        float* xout = l == DEPTH - 1 ? karg_out() : nullptr;
        if (((PHMASK >> 0) & 1) && IN(p0 + 0)) { asm volatile("; PHASE_BEGIN_0"); ph_gemm_in(F.ws, F.lds, l); SEAM(p0 + 0); }
        if (((PHMASK >> 1) & 1) && IN(p0 + 1)) { asm volatile("; PHASE_BEGIN_1"); ph_local(F.ws, F.lds, l, karg_in(IN_WPOOL), karg_in(IN_CONVW), karg_in(IN_PSCALE), karg_in(IN_KNG), karg_in(IN_KNB)); SEAM(p0 + 1); }
        if (((PHMASK >> 2) & 1) && IN(p0 + 2)) { asm volatile("; PHASE_BEGIN_2"); ph_scores(F.ws, F.lds); SEAM(p0 + 2); }
        if (((PHMASK >> 3) & 1) && IN(p0 + 3)) { asm volatile("; PHASE_BEGIN_3"); ph_attn(F.ws, F.lds); SEAM(p0 + 3); }
        if (((PHMASK >> 4) & 1) && IN(p0 + 4)) { asm volatile("; PHASE_BEGIN_4"); ph_gemm_out(F.ws, F.lds, l, xin); SEAM(p0 + 4); }
        if (((PHMASK >> 5) & 1) && IN(p0 + 5)) { asm volatile("; PHASE_BEGIN_5"); ph_router(F.ws, F.lds, l, karg_in(IN_LN1G), karg_in(IN_LN1B), karg_in(IN_RW), karg_in(IN_RB)); SEAM(p0 + 5); }
        if (((PHMASK >> 6) & 1) && IN(p0 + 6)) { asm volatile("; PHASE_BEGIN_6"); ph_gather(F.ws, F.lds, l); SEAM(p0 + 6); }
        if (((PHMASK >> 7) & 1) && IN(p0 + 7)) { asm volatile("; PHASE_BEGIN_7"); ph_gemm_moe1(F.ws, F.lds, l, karg_in(IN_BGU)); SEAM(p0 + 7); }
        if (((PHMASK >> 8) & 1) && IN(p0 + 8)) { asm volatile("; PHASE_BEGIN_8"); ph_gemm_moe2(F.ws, F.lds, l, karg_in(IN_BDN)); SEAM(p0 + 8); }
        if (((PHMASK >> 9) & 1) && IN(p0 + 9)) { asm volatile("; PHASE_BEGIN_9"); ph_combine(F.ws, F.lds, l, karg_in(IN_LN2G), karg_in(IN_LN2B), xout); SEAM(p0 + 9); }
}
#undef IN
#undef SEAM
__global__ void __launch_bounds__(NWAVES * 64, 2) fwd_kernel(Args A) {
    extern __shared__ __attribute__((aligned(16))) unsigned char lds[];
    Frame F;
    F.lds = (LAS unsigned char*)lds;
    F.tid = threadIdx.x; F.lane = F.tid & 63; F.wave = __builtin_amdgcn_readfirstlane(F.tid >> 6);
    F.G = gridDim.x; { const int bx = blockIdx.x; F.vcu = (F.G % 8 == 0) ? (bx % 8) * (F.G / 8) + bx / 8 : bx; }
    F.ws = A.ws; F.ctl = (gu32*)(A.ws + WS_CTL);
    volatile LAS unsigned* MISC = (volatile LAS unsigned*)(F.lds + MISC_OFF);
    if (F.tid < 32) MISC[F.tid] = 0u;
    __syncthreads();
    const int lo = A.ph_lo, hi = A.ph_hi;
    const bool multi = (hi - lo) > 1;
    XcdBarrier bar; bar.bar = (unsigned*)(F.ctl + CW_BAR); bar.x = 0; bar.st = nullptr;
    if (multi) bar = xcd_barrier_post((unsigned*)(F.ctl + CW_BAR), MISC + 8);
#define IN(k) (lo <= (k) && (k) < hi)
#define SEAM(k) do { if (IN(k) && IN((k) + 1)) xcd_barrier(bar); } while (0)

    if (((PHMASK >> 10) & 1) && IN(0)) { asm volatile("; PHASE_BEGIN_11"); ph_prologue(F.ws, F.lds, karg_in(IN_WIN), karg_in(IN_WOUT), karg_in(IN_WGU), karg_in(IN_WDN), karg_in(IN_X)); SEAM(0); }
    layer_phases<0>(F, bar, lo, hi);
    layer_phases<1>(F, bar, lo, hi);
#undef IN
#undef SEAM
}


#ifdef DUMP_OFF
__global__ void dump_kernel(const unsigned* w, size_t nwords, float* out, int n) {
    const int i = blockIdx.x * blockDim.x + threadIdx.x; if (i >= n) return;
#ifdef DUMP_NAN_ALL
    { bool bad = false; for (size_t j = (size_t)i; j < nwords; j += (size_t)n) { const unsigned x = w[j]; bad |= ((x & 0x7f80u) == 0x7f80u) || ((x & 0x7f800000u) == 0x7f800000u); } out[i] = bad ? 1e6f : 0.f; return; }
#endif
#ifdef DUMP_MASKCHECK
    { out[i] = 0.f; if ((i & 1023) == 0) { const int t = i >> 10, sq = t & 4095; const unsigned long long* mt = (const unsigned long long*)w + ((size_t)(t >> 12) * 64) * 4096 + sq; int pc = 0; bool beyond = false;
        for (int j = 0; j < 64; ++j) { const unsigned long long m = mt[(size_t)j * 4096]; pc += __popcll(m); for (int bb = 0; bb < 64; ++bb) if (((m >> bb) & 1ull) && 64 * j + bb > sq) beyond = true; }
        const int expect = sq + 1 < 256 ? sq + 1 : 256;
#if DUMP_MASKCHECK == 1
        if (pc != expect) out[i] = 1e6f;
#else
        if (beyond) out[i] = 1e6f;
#endif
      } return; }
#endif
#ifdef DUMP_NANCHECK
#if DUMP_NANCHECK == 2
    { size_t wi = (size_t)i;
#ifdef DUMP_ROWW
      wi = ((size_t)i / DUMP_COLW) * DUMP_ROWW + ((size_t)i % DUMP_COLW);
#endif
      if (wi >= nwords) { out[i] = 0.f; return; } const unsigned x = w[wi]; const bool bad = ((x & 0x7f80u) == 0x7f80u) || ((x & 0x7f800000u) == 0x7f800000u);
#ifdef DUMP_LOC
      { const int sq = (int)(wi / 512) & 4095; out[i] = bad ? 1000.f * (float)(DUMP_LOC == 1 ? sq + 1 : 4096 - sq) : 0.f; return; }
#endif
      out[i] = bad ? 1e6f : 0.f; return; }
#else
    { const float v = ((const float*)w)[i]; out[i] = (v == v && fabsf(v) < 1e30f) ? 0.f : 1e6f; return; }
#endif
#endif
#ifdef DUMP_VIA_ROWOF
    unsigned h; { const unsigned short* src = (const unsigned short*)w; const int* rowof = (const int*)((const char*)w - (size_t)(DUMP_OFF) + WS_ROUTE) + 12 * T; const int t = i >> 10, c = i & 1023;
        h = 0u; for (int k = 0; k < 4; ++k) h = h * 0x9E3779B1u + src[(size_t)rowof[4 * t + k] * 1024 + c]; }
#elif defined(DUMP_ROWW)
    unsigned h = 0u; { const size_t row = (size_t)i / DUMP_COLW, cw = (size_t)i % DUMP_COLW; if (row * DUMP_ROWW + cw < nwords) h = w[row * DUMP_ROWW + cw]; }
#else
    unsigned h = 0u; int k = 1; for (size_t j = (size_t)i; j < nwords; j += (size_t)n, k += 2) h ^= w[j] * (unsigned)k;
#endif
    out[i] = (float)((h ^ (h >> 11) ^ (h >> 22)) & 0xFFFFFu);
}
#endif
#ifndef MK_ONE_LAUNCH
#define MK_ONE_LAUNCH 0
#endif
extern "C" void kernel_launch(void* const* d_in, const int* in_sizes, int n_in, void* d_out, int out_size, void* d_ws, size_t ws_size, hipStream_t stream) {
    static int grid = 0;
    if (grid == 0) {
        if (n_in != N_IN || in_sizes[0] != T * D || out_size != T * D || ws_size < WS_END) { fprintf(stderr, "kernel_launch: unexpected shapes (n_in %d, in0 %d, out %d, ws %zu, need %zu); nothing launched\n", n_in, n_in > 0 ? in_sizes[0] : -1, out_size, ws_size, (size_t)WS_END); grid = -1; return; }
        int dev = 0, cus = 0, per_cu = 0;
        if (hipGetDevice(&dev) != hipSuccess || hipDeviceGetAttribute(&cus, hipDeviceAttributeMultiprocessorCount, dev) != hipSuccess) { grid = -1; return; }
        if (hipFuncSetAttribute((const void*)fwd_kernel, hipFuncAttributeMaxDynamicSharedMemorySize, LDS_BYTES) != hipSuccess) { fprintf(stderr, "kernel_launch: hipFuncSetAttribute failed\n"); grid = -1; return; }
        if (hipOccupancyMaxActiveBlocksPerMultiprocessor(&per_cu, (const void*)fwd_kernel, NWAVES * 64, LDS_BYTES) != hipSuccess || per_cu < 1) fprintf(stderr, "kernel_launch: occupancy query reports %d\n", per_cu);
        (void)hipGetLastError();
        grid = cus;
        if (grid != 256) { fprintf(stderr, "kernel_launch: built for 256 CUs, found %d; nothing launched\n", cus); grid = -1; return; }
    }
    if (grid < 0) return;
    if (hipMemsetAsync((char*)d_ws + WS_CTL, 0, CTL_ZERO_BYTES, stream) != hipSuccess) return;
    Args a{};
    for (int i = 0; i < N_IN; ++i) a.in[i] = (const float*)d_in[i];
    a.out = (float*)d_out; a.ws = (unsigned char*)d_ws;
#if MK_ONE_LAUNCH
    a.ph_lo = 0; a.ph_hi = N_PHASES;
    hipLaunchKernelGGL(fwd_kernel, dim3(grid), dim3(NWAVES * 64), LDS_BYTES, stream, a);
#else
#ifdef DUMP_OFF
    for (int p = 0; p < DUMP_STOP; ++p) { a.ph_lo = p; a.ph_hi = p + 1; hipLaunchKernelGGL(fwd_kernel, dim3(grid), dim3(NWAVES * 64), LDS_BYTES, stream, a); }
    hipLaunchKernelGGL(dump_kernel, dim3((T * D + 255) / 256), dim3(256), 0, stream, (const unsigned*)((const char*)d_ws + (size_t)(DUMP_OFF)), (size_t)(DUMP_WORDS), (float*)d_out, T * D);
    return;
#endif
    for (int p = 0; p < N_PHASES; ++p) { a.ph_lo = p; a.ph_hi = p + 1; hipLaunchKernelGGL(fwd_kernel, dim3(grid), dim3(NWAVES * 64), LDS_BYTES, stream, a);
#ifdef DBL_PHASE
        if ((p == 0 && DBL_PHASE == 10) || (p > 0 && (p - 1) % PH_PER_LAYER == DBL_PHASE)) hipLaunchKernelGGL(fwd_kernel, dim3(grid), dim3(NWAVES * 64), LDS_BYTES, stream, a);
#endif
    }
#endif
}
```

```cpp
#include <hip/hip_runtime.h>
#include <cstdio>
#include <cstdint>

#define MK_ONE_LAUNCH 1
#define BAR_EARLY_INV 1
#ifndef WT_STORES
#define WT_STORES 0
#endif
__device__ __forceinline__ void st16_wt(void* p, unsigned x, unsigned y, unsigned z, unsigned w) {
    typedef unsigned u4_ __attribute__((ext_vector_type(4))); const u4_ v = {x, y, z, w};
#if WT_STORES
    asm volatile("global_store_dwordx4 %0, %1, off sc1\n\ts_nop 2" :: "v"((__attribute__((address_space(1))) void*)p), "v"(v) : "memory");
#else
    *(__attribute__((address_space(1))) u4_*)p = v;
#endif
}
__device__ __forceinline__ void st8_wt(void* p, unsigned x, unsigned y) {
    typedef unsigned u2_ __attribute__((ext_vector_type(2))); const u2_ v = {x, y};
#if WT_STORES
    asm volatile("global_store_dwordx2 %0, %1, off sc1" :: "v"((__attribute__((address_space(1))) void*)p), "v"(v) : "memory");
#else
    *(__attribute__((address_space(1))) u2_*)p = v;
#endif
}
namespace pg8 {
#define PG8_LAS __attribute__((address_space(3)))
typedef unsigned short bf16_t;
typedef short bf16x8 __attribute__((ext_vector_type(8)));
typedef float f32x4 __attribute__((ext_vector_type(4)));
typedef unsigned u32x4 __attribute__((ext_vector_type(4)));
typedef int v4i_t __attribute__((ext_vector_type(4)));
typedef int v8i_t __attribute__((ext_vector_type(8)));
constexpr int BM = 256, BK = 64, HALF = 128, HTB = HALF * BK * 2  , STAGE_BYTES = 8 * HTB, NXCD = 8, WGM = 8;

__host__ __device__ __forceinline__ int lds_byte(int r, int c) { const int st = (r >> 4) * 2 + (c >> 5), rr = r & 15, cc = c & 31, ob = rr * 64 + cc * 2; return st * 1024 + (ob ^ (((ob >> 9) & 1) << 5)); }
__host__ __device__ __forceinline__ void stage_rc(int b, int& R, int& C) { const int st = b / 1024, sb = b % 1024, swz = sb ^ (((sb >> 9) & 1) << 5); R = (st >> 1) * 16 + swz / 64; C = (st & 1) * 32 + (swz % 64) / 2; }
__host__ __device__ __forceinline__ int perm32(int rho) { const int n = rho >> 4, i = rho & 15; return 8 * (i >> 2) + 4 * n + (i & 3); }

struct Unit { int pm, pn; };
struct Gemm { const bf16_t* A; const bf16_t* Bt; int M, N, K; };

struct StaticOrder {
    int nM, nN, nwg, G, c;
    __host__ __device__ void init(int M, int N, int G_, int c_) { nM = M / BM; nN = N / BM; nwg = nM * nN; G = G_; c = c_; }
    __host__ __device__ bool next(int i, Unit& u) const {
        const long L = (long)i * G + c; if (L >= nwg) return false;
        int wgid = (int)L; { const int q = nwg / NXCD, r = nwg % NXCD, xcd = wgid % NXCD, off = wgid / NXCD; wgid = (xcd < r ? xcd * (q + 1) : r * (q + 1) + (xcd - r) * q) + off; }
        const int nig = WGM * nN, gid = wgid / nig, fm = gid * WGM, gsz = (nM - fm) < WGM ? (nM - fm) : WGM;
        u.pm = fm + ((wgid % nig) % gsz); u.pn = (wgid % nig) / gsz; return true;
    }
    __device__ __forceinline__ void a_ready(const Unit&) const {}
    __device__ __forceinline__ void done(const Unit&) const {}
};

__device__ __forceinline__ unsigned cvt_pk_bf16(float lo, float hi) { unsigned r; asm volatile("v_cvt_pk_bf16_f32 %0, %1, %2" : "=v"(r) : "v"(lo), "v"(hi)); return r; }
typedef float f32x2 __attribute__((ext_vector_type(2)));
__device__ __forceinline__ f32x2 gelu_pk(f32x2 v) {
    const f32x2 av = __builtin_elementwise_abs(v), d = av * 0.2316418882f + 1.0f;
    f32x2 t; t.x = __builtin_amdgcn_rcpf(d.x); t.y = __builtin_amdgcn_rcpf(d.y);
    f32x2 q = t * 0.5307027145f + (-0.7265760135f); q = q * t + 0.7107068705f; q = q * t + (-0.142248368f); q = q * t + 0.127414796f; q = q * t;
    const f32x2 s = (v * v) * (-0.72134752044f);
    f32x2 e; e.x = __builtin_amdgcn_exp2f(s.x); e.y = __builtin_amdgcn_exp2f(s.y);
    const f32x2 m = v * (q * e), r = v - m;
    f32x2 o; o.x = v.x < 0.f ? m.x : r.x; o.y = v.y < 0.f ? m.y : r.y; return o;
}

template <int ACT  > struct EpiBf16 {
    static constexpr bool PERM = true, AFTER_DRAIN = false; static_assert(ACT == 0 || ACT == 1, "EpiBf16: ACT is 0 (none) or 1 (gelu_pk)");
    bf16_t* O; int ldc; const float* bias; int split_cols; size_t split_stride; float scale0;
    __device__ __forceinline__ void operator()(const f32x4 (&acc)[2][2][4][2], const Unit& u, int wr, int wc, int fr, int fq) const {
        const int row0 = u.pm * BM + wr * 64 + fr; int colt = u.pn * BM; bf16_t* base = O;
        float sc = 1.f; if (split_cols) { const int t = colt / split_cols; base += (size_t)t * split_stride; colt -= t * split_cols; if (t == 0) sc = scale0; }
        const int col0 = colt + wc * 32 + 8 * fq, bcol0 = u.pn * BM + wc * 32 + 8 * fq;
        f32x4 bv[2][2];
#pragma unroll
        for (int bj = 0; bj < 2; ++bj)
#pragma unroll
            for (int n = 0; n < 2; ++n) bv[bj][n] = bias ? *(const __attribute__((address_space(1))) f32x4*)(bias + bcol0 + bj * HALF + 4 * n) : (f32x4){0.f, 0.f, 0.f, 0.f};
#pragma unroll
        for (int ai = 0; ai < 2; ++ai)
#pragma unroll
            for (int m = 0; m < 4; ++m) { bf16_t* rowp = base + (size_t)(row0 + ai * HALF + m * 16) * ldc + col0;
#pragma unroll
                for (int bj = 0; bj < 2; ++bj) { f32x4 v0 = acc[ai][bj][m][0] + bv[bj][0], v1 = acc[ai][bj][m][1] + bv[bj][1];
                    if (ACT == 1) { f32x2 a = gelu_pk((f32x2){v0[0], v0[1]}), b = gelu_pk((f32x2){v0[2], v0[3]}), c = gelu_pk((f32x2){v1[0], v1[1]}), d = gelu_pk((f32x2){v1[2], v1[3]});
                        v0 = (f32x4){a.x, a.y, b.x, b.y}; v1 = (f32x4){c.x, c.y, d.x, d.y}; }
                    v0 = v0 * sc; v1 = v1 * sc; u32x4 w; w.x = cvt_pk_bf16(v0[0], v0[1]); w.y = cvt_pk_bf16(v0[2], v0[3]); w.z = cvt_pk_bf16(v1[0], v1[1]); w.w = cvt_pk_bf16(v1[2], v1[3]);
                    st16_wt(rowp + bj * HALF, w.x, w.y, w.z, w.w); } }
    }
};

struct PanelStats {
    unsigned* xbuf;
    unsigned* cnt;
    unsigned* tmo;
    int ntn; float eps;
    unsigned code;
    __device__ __forceinline__ bool run(const f32x4 (&v)[2][2][4][2], const Unit& u, int wr, int wc, int fr, int fq, PG8_LAS unsigned char* lds, int wid, int lane) const {
        typedef float f32x2v __attribute__((ext_vector_type(2)));
        PG8_LAS f32x2v* P = (PG8_LAS f32x2v*)lds;
        PG8_LAS f32x2v* S = (PG8_LAS f32x2v*)(lds + 8192);
        PG8_LAS unsigned* flag = (PG8_LAS unsigned*)(lds + 8192 + 2048);
#pragma unroll
        for (int ai = 0; ai < 2; ++ai)
#pragma unroll
            for (int m = 0; m < 4; ++m) {
                float s = 0.f;
#pragma unroll
                for (int bj = 0; bj < 2; ++bj)
#pragma unroll
                    for (int n = 0; n < 2; ++n) { const f32x4 x = v[ai][bj][m][n]; s += (x[0] + x[1]) + (x[2] + x[3]); }
                s += __shfl_xor(s, 16); s += __shfl_xor(s, 32);
                const float mw = s * (1.0f / 64.0f); float q = 0.f;
#pragma unroll
                for (int bj = 0; bj < 2; ++bj)
#pragma unroll
                    for (int n = 0; n < 2; ++n) { const f32x4 d = v[ai][bj][m][n] - mw; q += (d[0] * d[0] + d[1] * d[1]) + (d[2] * d[2] + d[3] * d[3]); }
                q += __shfl_xor(q, 16); q += __shfl_xor(q, 32);
                if (fq == 0) P[(ai * HALF + wr * 64 + m * 16 + fr) * 4 + wc] = (f32x2v){mw, q};
            }
        asm volatile("s_waitcnt lgkmcnt(0)" ::: "memory"); __builtin_amdgcn_s_barrier(); asm volatile("" ::: "memory");
#if defined(BROKEN_EXCHANGE_NO_WAIT)
#warning BROKEN CONTROL BUILD: the row-statistics exchange does not wait; results are wrong by design
        if (blockIdx.x >= 64) { const long long t0_ = clock64(); while (clock64() - t0_ < 60000) __builtin_amdgcn_s_sleep(8); }
#endif
        const int row = wid * 32 + (lane & 31);
        if (lane < 32) {
            const f32x2v a = P[row * 4 + 0], b = P[row * 4 + 1], c = P[row * 4 + 2], d = P[row * 4 + 3];
            const float mt = (a.x + b.x + c.x + d.x) * 0.25f;
            const float da = a.x - mt, db = b.x - mt, dc = c.x - mt, dd = d.x - mt;
            const float m2 = (a.y + b.y) + (c.y + d.y) + 64.0f * ((da * da + db * db) + (dc * dc + dd * dd));
            unsigned long long* slot = (unsigned long long*)xbuf + ((size_t)(u.pm * BM + row) * 4 + u.pn);
            __hip_atomic_store(slot, ((unsigned long long)__float_as_uint(m2) << 32) | __float_as_uint(mt), __ATOMIC_RELAXED, __HIP_MEMORY_SCOPE_AGENT);
        }
        asm volatile("s_waitcnt vmcnt(0)" ::: "memory");
        if (lane == 0) __hip_atomic_fetch_add(cnt + 64 * u.pm, 1u, __ATOMIC_RELAXED, __HIP_MEMORY_SCOPE_AGENT);
        if (wid == 0) {
            bool dead = false; const unsigned long long t0 = __builtin_amdgcn_s_memrealtime(); const unsigned want = 8u * (unsigned)ntn;
            for (;;) {
#if defined(BROKEN_EXCHANGE_NO_WAIT)
                break;
#endif
                if ((unsigned)__builtin_amdgcn_readfirstlane(__hip_atomic_load(cnt + 64 * u.pm, __ATOMIC_RELAXED, __HIP_MEMORY_SCOPE_AGENT)) >= want) break;
                if (__builtin_amdgcn_s_memrealtime() - t0 > 2000000ull) {
                    if (lane == 0) { unsigned expect = 0u; __hip_atomic_compare_exchange_strong(tmo + 1, &expect, code | (unsigned)(u.pm & 0xff), __ATOMIC_RELAXED, __ATOMIC_RELAXED, __HIP_MEMORY_SCOPE_AGENT);
                                     __hip_atomic_store(tmo, 1u, __ATOMIC_RELAXED, __HIP_MEMORY_SCOPE_AGENT); }
                    dead = true; break; }
                __builtin_amdgcn_s_sleep(2);
            }
            __builtin_amdgcn_fence(__ATOMIC_ACQUIRE, "agent");
            if (lane == 0) flag[0] = dead ? 1u : 0u;
        }
        asm volatile("s_waitcnt vmcnt(0) lgkmcnt(0)" ::: "memory"); __builtin_amdgcn_s_barrier(); asm volatile("" ::: "memory");
        const bool bad = flag[0] != 0u;
        if (lane < 32) {
            const unsigned long long* slot = (const unsigned long long*)xbuf + (size_t)(u.pm * BM + row) * 4; float mt[4], m2[4]; float ms = 0.f;
#pragma unroll
            for (int t = 0; t < 4; ++t) { if (t < ntn) { const unsigned long long w = __hip_atomic_load(slot + t, __ATOMIC_RELAXED, __HIP_MEMORY_SCOPE_AGENT); mt[t] = __uint_as_float((unsigned)w); m2[t] = __uint_as_float((unsigned)(w >> 32)); } else { mt[t] = 0.f; m2[t] = 0.f; } ms += mt[t]; }
            const float mean = ms / (float)ntn; float q = 0.f;
#pragma unroll
            for (int t = 0; t < 4; ++t) if (t < ntn) { const float dm = mt[t] - mean; q += m2[t] + 256.0f * dm * dm; }
            S[row] = (f32x2v){mean, 1.0f / sqrtf(q / (256.0f * (float)ntn) + eps)};
        }
        asm volatile("s_waitcnt lgkmcnt(0)" ::: "memory"); __builtin_amdgcn_s_barrier(); asm volatile("" ::: "memory");
        return bad;
    }
};
struct EpiLnRes {
    static constexpr bool PERM = false, AFTER_DRAIN = true;
    const float* base; float* out; int ldc; const float* bias; PanelStats st; unsigned poison;
    __device__ __forceinline__ void fused(f32x4 (&acc)[2][2][4][2], const Unit& u, int wr, int wc, int fr, int fq, PG8_LAS unsigned char* lds, int wid, int lane) const {
        typedef float f32x2v __attribute__((ext_vector_type(2)));
        const PG8_LAS f32x2v* S = (const PG8_LAS f32x2v*)(lds + 8192);
        const int col0 = u.pn * BM + wc * 32 + 4 * fq;
#pragma unroll
        for (int bj = 0; bj < 2; ++bj)
#pragma unroll
            for (int n = 0; n < 2; ++n) { const f32x4 bv = bias ? *(const f32x4*)(bias + col0 + bj * HALF + n * 16) : (f32x4){0.f, 0.f, 0.f, 0.f};
#pragma unroll
                for (int ai = 0; ai < 2; ++ai)
#pragma unroll
                    for (int m = 0; m < 4; ++m) acc[ai][bj][m][n] += bv; }
        f32x4 pre[4][2][2];
#pragma unroll
        for (int m = 0; m < 4; ++m) { const size_t off = (size_t)(u.pm * BM + wr * 64 + m * 16 + fr) * ldc + col0;
#pragma unroll
            for (int bj = 0; bj < 2; ++bj)
#pragma unroll
                for (int n = 0; n < 2; ++n) pre[m][bj][n] = *(const f32x4*)(base + off + bj * HALF + n * 16); }
        const bool bad = st.run(acc, u, wr, wc, fr, fq, lds, wid, lane) || poison != 0u;
        const float qnan = __builtin_nanf("");
#pragma unroll
        for (int ai = 0; ai < 2; ++ai)
#pragma unroll
            for (int m = 0; m < 4; ++m) { const int r = ai * HALF + wr * 64 + m * 16 + fr; const f32x2v sr = S[r]; const size_t off = (size_t)(u.pm * BM + r) * ldc + col0;
#pragma unroll
                for (int bj = 0; bj < 2; ++bj)
#pragma unroll
                    for (int n = 0; n < 2; ++n) { const f32x4 bs = ai == 0 ? pre[m][bj][n] : *(const f32x4*)(base + off + bj * HALF + n * 16); f32x4 o = bs + (acc[ai][bj][m][n] - sr.x) * sr.y;
                        if (bad) o = (f32x4){qnan, qnan, qnan, qnan}; *(f32x4*)(out + off + bj * HALF + n * 16) = o; }
                if (m & 1) asm volatile("" ::: "memory"); }
    }
};
struct EpiLnResLn {
    static constexpr bool PERM = false, AFTER_DRAIN = true;
    const float* base; float* out; bf16_t* xn; int ldc; const float* bias; PanelStats st1, st2; unsigned poison;
    __device__ __forceinline__ void fused(f32x4 (&acc)[2][2][4][2], const Unit& u, int wr, int wc, int fr, int fq, PG8_LAS unsigned char* lds, int wid, int lane) const {
        typedef float f32x2v __attribute__((ext_vector_type(2))); typedef unsigned u32x2v __attribute__((ext_vector_type(2)));
        const PG8_LAS f32x2v* S = (const PG8_LAS f32x2v*)(lds + 8192);
        const int col0 = u.pn * BM + wc * 32 + 4 * fq;
#pragma unroll
        for (int bj = 0; bj < 2; ++bj)
#pragma unroll
            for (int n = 0; n < 2; ++n) { const f32x4 bv = bias ? *(const f32x4*)(bias + col0 + bj * HALF + n * 16) : (f32x4){0.f, 0.f, 0.f, 0.f};
#pragma unroll
                for (int ai = 0; ai < 2; ++ai)
#pragma unroll
                    for (int m = 0; m < 4; ++m) acc[ai][bj][m][n] += bv; }
        bool bad = st1.run(acc, u, wr, wc, fr, fq, lds, wid, lane) || poison != 0u;
        const float qnan = __builtin_nanf("");
#pragma unroll
        for (int ai = 0; ai < 2; ++ai)
#pragma unroll
            for (int m = 0; m < 4; ++m) { const int r = ai * HALF + wr * 64 + m * 16 + fr; const f32x2v sr = S[r]; const size_t off = (size_t)(u.pm * BM + r) * ldc + col0;
#pragma unroll
                for (int bj = 0; bj < 2; ++bj)
#pragma unroll
                    for (int n = 0; n < 2; ++n) { const f32x4 bs = *(const f32x4*)(base + off + bj * HALF + n * 16); acc[ai][bj][m][n] = bs + (acc[ai][bj][m][n] - sr.x) * sr.y; }
                asm volatile("" : "+v"(acc[ai][0][m][0]), "+v"(acc[ai][0][m][1]), "+v"(acc[ai][1][m][0]), "+v"(acc[ai][1][m][1]));
                if (m & 1) asm volatile("" ::: "memory"); }
        const bool bad1 = bad;
        bad = st2.run(acc, u, wr, wc, fr, fq, lds, wid, lane) || bad;
#pragma unroll
        for (int ai = 0; ai < 2; ++ai)
#pragma unroll
            for (int m = 0; m < 4; ++m) { const int r = ai * HALF + wr * 64 + m * 16 + fr; const f32x2v sr = S[r]; const size_t off = (size_t)(u.pm * BM + r) * ldc + col0;
#pragma unroll
                for (int bj = 0; bj < 2; ++bj)
#pragma unroll
                    for (int n = 0; n < 2; ++n) { const f32x4 x1 = acc[ai][bj][m][n]; *(f32x4*)(out + off + bj * HALF + n * 16) = bad1 ? (f32x4){qnan, qnan, qnan, qnan} : x1;
                        const f32x4 o = (x1 - sr.x) * sr.y; u32x2v w; w.x = cvt_pk_bf16(o[0], o[1]); w.y = cvt_pk_bf16(o[2], o[3]);
                        if (bad) { w.x = 0x7fc07fc0u; w.y = 0x7fc07fc0u; } *(u32x2v*)(xn + off + bj * HALF + n * 16) = w; }
                asm volatile("" ::: "memory"); }
    }
};

__device__ __forceinline__ void glds_saddr(unsigned voff, const char* sbase, unsigned lds_dst) { unsigned keep;
    asm volatile("s_mov_b32 %0, m0\n\ts_mov_b32 m0, %3\n\ts_nop 0\n\tglobal_load_lds_dwordx4 %1, %2\n\ts_mov_b32 m0, %0" : "=&s"(keep) : "v"(voff), "s"(sbase), "s"(lds_dst) : "memory"); }
template <class Epi, class Sched, bool ALIGN_EPI = false, bool SP2 = false, int EB = 2, bool GATHER = false>
__device__ __forceinline__ void gemm_phase(PG8_LAS unsigned char* lds, const Gemm g, const Sched& S, const Epi& E, const int* rowtok = nullptr) {
    static_assert(!GATHER || (EB == 1 && SP2), "gathered A rows: fp8 path (SGPR-base staging) with the two-super-phase loop only");
    const int tid = threadIdx.x, wid = __builtin_amdgcn_readfirstlane(tid >> 6), lane = tid & 63, wr = wid >> 2, wc = wid & 3, fr = lane & 15, fq = lane >> 4;
    const int K = g.K, nt = K * EB / (BK * 2);
    unsigned voffA[2], voffB[2]; int gR[2]; unsigned gC[2];
#pragma unroll
    for (int i = 0; i < 2; ++i) { int R, C; stage_rc(tid * 16 + i * 8192, R, C); const int Rb = Epi::PERM ? ((R & ~31) + perm32(R & 31)) : R;
        voffA[i] = (unsigned)(R * K * EB + C * 2); voffB[i] = (unsigned)(Rb * K * EB + C * 2); gR[i] = R; gC[i] = (unsigned)(C * 2); }
    const size_t kstep = (size_t)(BK * 2);
    const size_t hstep = (size_t)HALF * K * EB;
    const size_t tstep = 2 * hstep;
    const unsigned ldsw = (unsigned)wid * 1024u; const unsigned lds0 = (unsigned)(uintptr_t)lds;
    const int aoff = lds_byte(wr * 64 + fr, fq * 8), boff = lds_byte(wc * 32 + fr, fq * 8);
#define PG8_SA(b, h) (((b) * 2 + (h)) * HTB)
#define PG8_SB(b, h) ((4 + (b) * 2 + (h)) * HTB)
#define PG8_STAGE(bufoff, gbase, voff) do { if constexpr (EB == 2) { _Pragma("unroll") for (int _i = 0; _i < 2; ++_i) \
        __builtin_amdgcn_global_load_lds((const unsigned*)((const char*)(gbase) + (voff)[_i]), (PG8_LAS unsigned*)(lds + (bufoff) + ldsw + _i * 8192), 16, 0, 0); } \
        else { _Pragma("unroll") for (int _i = 0; _i < 2; ++_i) glds_saddr((voff)[_i], (const char*)(gbase), (unsigned)__builtin_amdgcn_readfirstlane((int)(lds0 + (unsigned)(bufoff) + ldsw + (unsigned)(_i * 8192)))); } } while (0)
#define PG8_GLOAD(vo, u) do { _Pragma("unroll") for (int _h = 0; _h < 2; ++_h) _Pragma("unroll") for (int _i = 0; _i < 2; ++_i) vo[_h][_i] = (unsigned)rowtok[(size_t)(u).pm * BM + _h * HALF + gR[_i]] * (unsigned)(K * EB) + gC[_i]; } while (0)
#define PG8_STAGE_A(bufoff, pplain, kofs, h, VS) do { if constexpr (!GATHER) { PG8_STAGE(bufoff, pplain, voffA); } else { _Pragma("unroll") for (int _i = 0; _i < 2; ++_i) \
        glds_saddr(VS[h][_i], (const char*)g.A + (kofs), (unsigned)__builtin_amdgcn_readfirstlane((int)(lds0 + (unsigned)(bufoff) + ldsw + (unsigned)(_i * 8192)))); } } while (0)
#define PG8_LD8(p) __builtin_shufflevector(*(const PG8_LAS v4i_t*)(p), *(const PG8_LAS v4i_t*)((p) + 1024), 0, 1, 2, 3, 4, 5, 6, 7)
#define PG8_LDA(dst, b, h) do { if constexpr (EB == 2) { _Pragma("unroll") for (int m = 0; m < 4; ++m) _Pragma("unroll") for (int k = 0; k < 2; ++k) dst[m][k] = *(const PG8_LAS bf16x8*)(lds + PG8_SA(b, h) + aoff + m * 2048 + k * 1024); } \
        else { _Pragma("unroll") for (int m = 0; m < 4; ++m) dst##8[m] = PG8_LD8(lds + PG8_SA(b, h) + aoff + m * 2048); } } while (0)
#define PG8_LDB(dst, b, h) do { if constexpr (EB == 2) { _Pragma("unroll") for (int n = 0; n < 2; ++n) _Pragma("unroll") for (int k = 0; k < 2; ++k) dst[n][k] = *(const PG8_LAS bf16x8*)(lds + PG8_SB(b, h) + boff + n * 2048 + k * 1024); } \
        else { _Pragma("unroll") for (int n = 0; n < 2; ++n) dst##8[n] = PG8_LD8(lds + PG8_SB(b, h) + boff + n * 2048); } } while (0)
#define PG8_CAT8(x, y) __builtin_shufflevector(__builtin_bit_cast(v4i_t, x), __builtin_bit_cast(v4i_t, y), 0, 1, 2, 3, 4, 5, 6, 7)
#define PG8_MMA(ai, bj, At, Bt) do { __builtin_amdgcn_s_setprio(1); if constexpr (EB == 2) { _Pragma("unroll") for (int m = 0; m < 4; ++m) _Pragma("unroll") for (int n = 0; n < 2; ++n) _Pragma("unroll") for (int k = 0; k < 2; ++k) \
        acc[ai][bj][m][n] = __builtin_amdgcn_mfma_f32_16x16x32_bf16(Bt[n][k], At[m][k], acc[ai][bj][m][n], 0, 0, 0); } else { _Pragma("unroll") for (int m = 0; m < 4; ++m) _Pragma("unroll") for (int n = 0; n < 2; ++n) \
        asm volatile("v_mfma_scale_f32_16x16x128_f8f6f4 %0, %1, %2, %0, %3, %3 op_sel_hi:[0,0,0]" : "+v"(acc[ai][bj][m][n]) : "v"(Bt##8[n]), "v"(At##8[m]), "v"(mx_one)); }     __builtin_amdgcn_s_setprio(0); } while (0)
#define PG8_WAIT_V(n) asm volatile("s_waitcnt vmcnt(" #n ")" ::: "memory")
#define PG8_WAIT_L(n) asm volatile("s_waitcnt lgkmcnt(" #n ")" ::: "memory")
#define PG8_BAR __builtin_amdgcn_s_barrier()
#define PG8_SCHED __builtin_amdgcn_sched_barrier(0)
    Unit cur, nxt; int ui = 0;
    if (!S.next(0, cur)) return;
    f32x4 acc[2][2][4][2];
#pragma unroll
    for (int a = 0; a < 2; ++a)
#pragma unroll
        for (int b = 0; b < 2; ++b)
#pragma unroll
            for (int m = 0; m < 4; ++m)
#pragma unroll
                for (int n = 0; n < 2; ++n) acc[a][b][m][n] = (f32x4){0.f, 0.f, 0.f, 0.f};
    const int mx_one = 0x7f7f7f7f;
    bf16x8 At[4][2], B0[2][2], B1[2][2]; v8i_t At8[4], B08[2], B18[2];
    const char* cA = (const char*)g.A + (size_t)cur.pm * tstep; const char* cB = (const char*)g.Bt + (size_t)cur.pn * tstep;
    S.a_ready(cur);
    unsigned voffC[2][2], voffN[2][2];
    if constexpr (GATHER) PG8_GLOAD(voffC, cur);
    if constexpr (SP2) {
        PG8_STAGE(PG8_SB(0, 0), cB, voffB); PG8_STAGE(PG8_SB(0, 1), cB + hstep, voffB); PG8_STAGE_A(PG8_SA(0, 0), cA, 0, 0, voffC); PG8_STAGE_A(PG8_SA(0, 1), cA + hstep, 0, 1, voffC);
        if (wr == 1) PG8_BAR;
        PG8_WAIT_V(2); PG8_BAR;
        PG8_STAGE(PG8_SB(1, 0), cB + kstep, voffB); PG8_STAGE_A(PG8_SA(1, 0), cA + kstep, kstep, 0, voffC); PG8_STAGE(PG8_SB(1, 1), cB + hstep + kstep, voffB);
        PG8_WAIT_V(6); PG8_BAR;
    } else {
        PG8_STAGE(PG8_SB(0, 0), cB, voffB); PG8_STAGE(PG8_SA(0, 0), cA, voffA); PG8_STAGE(PG8_SB(0, 1), cB + hstep, voffB); PG8_STAGE(PG8_SA(0, 1), cA + hstep, voffA);
        if (wr == 1) PG8_BAR;
        PG8_WAIT_V(4); PG8_BAR;
        PG8_STAGE(PG8_SB(1, 0), cB + kstep, voffB); PG8_STAGE(PG8_SA(1, 0), cA + kstep, voffA); PG8_STAGE(PG8_SB(1, 1), cB + hstep + kstep, voffB);
        PG8_WAIT_V(6); PG8_BAR;
    }
    for (;;) {
        const bool has_next = S.next(ui + 1, nxt);
        if constexpr (GATHER) { if (has_next) PG8_GLOAD(voffN, nxt); else { _Pragma("unroll") for (int _h = 0; _h < 2; ++_h) _Pragma("unroll") for (int _i = 0; _i < 2; ++_i) voffN[_h][_i] = voffC[_h][_i]; } }
        const char* nA = has_next ? (const char*)g.A + (size_t)nxt.pm * tstep : cA; const char* nB = has_next ? (const char*)g.Bt + (size_t)nxt.pn * tstep : cB;
#pragma nounroll
        for (int t = 0; t < nt; t += 2) {
            const bool last = (t == nt - 2);
            const char* a1 = cA + (size_t)(t + 1) * kstep;
            const char* a2 = last ? nA : cA + (size_t)(t + 2) * kstep; const char* b2 = last ? nB : cB + (size_t)(t + 2) * kstep;
            const char* a3 = a2 + kstep; const char* b3 = b2 + kstep;
            const size_t k2 = last ? (size_t)0 : (size_t)(t + 2) * kstep; unsigned voffS[2][2];
            if constexpr (GATHER) { _Pragma("unroll") for (int _h = 0; _h < 2; ++_h) _Pragma("unroll") for (int _i = 0; _i < 2; ++_i) voffS[_h][_i] = last ? voffN[_h][_i] : voffC[_h][_i]; }
            if (last && has_next) S.a_ready(nxt);
            if constexpr (SP2) {
            PG8_LDB(B0, 0, 0); PG8_LDB(B1, 0, 1); PG8_SCHED; PG8_LDA(At, 0, 0); PG8_STAGE_A(PG8_SA(1, 1), a1 + hstep, (size_t)(t + 1) * kstep, 1, voffC);
            PG8_WAIT_V(8); PG8_WAIT_L(0); PG8_BAR; PG8_MMA(0, 0, At, B0); PG8_MMA(0, 1, At, B1); PG8_BAR; PG8_SCHED;
            PG8_LDA(At, 0, 1); PG8_STAGE(PG8_SB(0, 0), b2, voffB); PG8_STAGE(PG8_SB(0, 1), b2 + hstep, voffB); PG8_STAGE_A(PG8_SA(0, 0), a2, k2, 0, voffS);
            PG8_WAIT_V(8); PG8_WAIT_L(0); PG8_BAR; PG8_MMA(1, 0, At, B0); PG8_MMA(1, 1, At, B1); PG8_BAR; PG8_SCHED;
            PG8_LDB(B0, 1, 0); PG8_LDB(B1, 1, 1); PG8_SCHED; PG8_LDA(At, 1, 0); PG8_STAGE_A(PG8_SA(0, 1), a2 + hstep, k2, 1, voffS);
            PG8_WAIT_V(8); PG8_WAIT_L(0); PG8_BAR; PG8_MMA(0, 0, At, B0); PG8_MMA(0, 1, At, B1); PG8_BAR; PG8_SCHED;
            PG8_LDA(At, 1, 1); PG8_STAGE(PG8_SB(1, 0), b3, voffB); PG8_STAGE(PG8_SB(1, 1), b3 + hstep, voffB); PG8_STAGE_A(PG8_SA(1, 0), a3, k2 + kstep, 0, voffS);
            PG8_WAIT_V(8); PG8_WAIT_L(0); PG8_BAR; PG8_MMA(1, 0, At, B0); PG8_MMA(1, 1, At, B1); PG8_BAR; PG8_SCHED;
            } else {
            PG8_LDB(B0, 0, 0); PG8_SCHED; PG8_LDA(At, 0, 0); PG8_STAGE(PG8_SA(1, 1), a1 + hstep, voffA);
            PG8_WAIT_L(8); PG8_BAR; PG8_WAIT_L(0); PG8_MMA(0, 0, At, B0); PG8_BAR; PG8_SCHED;
            PG8_LDB(B1, 0, 1); PG8_STAGE(PG8_SB(0, 0), b2, voffB);
            PG8_BAR; PG8_WAIT_L(0); PG8_MMA(0, 1, At, B1); PG8_BAR;
            PG8_LDA(At, 0, 1); PG8_STAGE(PG8_SA(0, 0), a2, voffA);
            PG8_BAR; PG8_WAIT_L(0); PG8_MMA(1, 0, At, B0); PG8_BAR; PG8_SCHED;
            PG8_STAGE(PG8_SB(0, 1), b2 + hstep, voffB);
            PG8_WAIT_V(6); PG8_BAR; PG8_MMA(1, 1, At, B1); PG8_BAR;
            PG8_LDB(B0, 1, 0); PG8_SCHED; PG8_LDA(At, 1, 0); PG8_STAGE(PG8_SA(0, 1), a2 + hstep, voffA);
            PG8_WAIT_L(8); PG8_BAR; PG8_WAIT_L(0); PG8_MMA(0, 0, At, B0); PG8_BAR; PG8_SCHED;
            PG8_LDB(B1, 1, 1); PG8_STAGE(PG8_SB(1, 0), b3, voffB);
            PG8_BAR; PG8_WAIT_L(0); PG8_MMA(0, 1, At, B1); PG8_BAR;
            PG8_LDA(At, 1, 1); PG8_STAGE(PG8_SA(1, 0), a3, voffA);
            PG8_BAR; PG8_WAIT_L(0); PG8_MMA(1, 0, At, B0); PG8_BAR; PG8_SCHED;
            PG8_STAGE(PG8_SB(1, 1), b3 + hstep, voffB);
            PG8_WAIT_V(6); PG8_BAR; PG8_MMA(1, 1, At, B1); PG8_BAR;
            }
        }
        if constexpr (ALIGN_EPI) { if (wr == 0) PG8_BAR; }
        if constexpr (EB == 1) asm volatile("s_nop 15\n\ts_nop 15" ::: "memory");
        if constexpr (!Epi::AFTER_DRAIN) { E(acc, cur, wr, wc, fr, fq); S.done(cur); }
        if (!has_next) break;
#pragma unroll
        for (int a = 0; a < 2; ++a)
#pragma unroll
            for (int b = 0; b < 2; ++b)
#pragma unroll
                for (int m = 0; m < 4; ++m)
#pragma unroll
                    for (int n = 0; n < 2; ++n) acc[a][b][m][n] = (f32x4){0.f, 0.f, 0.f, 0.f};
        cur = nxt; cA = nA; cB = nB; ++ui;
        if constexpr (GATHER) { _Pragma("unroll") for (int _h = 0; _h < 2; ++_h) _Pragma("unroll") for (int _i = 0; _i < 2; ++_i) voffC[_h][_i] = voffN[_h][_i]; }
        if constexpr (ALIGN_EPI) { if (wr == 1) PG8_BAR; }
    }
    PG8_WAIT_V(0);
    if constexpr (!ALIGN_EPI) { if (wr == 0) PG8_BAR; }
    PG8_BAR;
    if constexpr (Epi::AFTER_DRAIN) { E.fused(acc, cur, wr, wc, fr, fq, lds, wid, lane); S.done(cur); }
#undef PG8_SA
#undef PG8_SB
#undef PG8_STAGE
#undef PG8_LDA
#undef PG8_GLOAD
#undef PG8_STAGE_A
#undef PG8_LD8
#undef PG8_LDB
#undef PG8_MMA
#undef PG8_CAT8
#undef PG8_WAIT_V
#undef PG8_WAIT_L
#undef PG8_BAR
#undef PG8_SCHED
}
}
#ifndef PG8_SP2
#define PG8_SP2 true
#endif
#ifndef MOE_SP2
#define MOE_SP2 true
#endif
#ifndef PG8_ALIGN
#define PG8_ALIGN true
#endif
constexpr int NWAVES = 8;
constexpr int NB = 4, SEQ = 4096, T = NB * SEQ, D = 1024, NIN = 2856, NINP = 3072, NE = 32, DEPTH = 2;
constexpr int C_H = 0, C_GB = 256, C_GC = 512, C_P = 768, C_Q = 1024, C_K = 1536, C_V = 2048, C_QI = 2560, C_KI = 2816, C_WI = 2848;
constexpr int NSEL = 256;
#ifndef SEL_CAND_CAP
#define SEL_CAND_CAP 64
#endif
constexpr int MAXROWS = 4 * T + NE * 256;
constexpr float ATT_C2 = 0.125f * 1.4426950408889634f;
constexpr float LN_EPS = 1e-5f, DN_ALPHA = 1.41421356237309515f;
enum { IN_X = 0, IN_WIN, IN_CONVW, IN_WPOOL, IN_PSCALE, IN_KNG, IN_KNB, IN_WOUT, IN_LN1G, IN_LN1B, IN_RW, IN_RB, IN_WGU, IN_BGU, IN_WDN, IN_BDN, IN_LN2G, IN_LN2B, N_IN };

constexpr size_t MiB = 1u << 20;
constexpr size_t WS_CTL = 0, CTL_ZERO_BYTES = 1 * MiB;
constexpr size_t WS_WIN = 2 * MiB;
constexpr size_t WS_WOUT = 14 * MiB;
constexpr size_t WS_WGU = 18 * MiB;
constexpr size_t WS_WDN = 274 * MiB;
constexpr size_t WS_XB = 402 * MiB;
constexpr size_t WS_XF = 434 * MiB;
constexpr size_t WS_Y1 = 498 * MiB;
constexpr size_t WS_PROJ = 562 * MiB;
constexpr size_t WS_CAT = 658 * MiB;
constexpr size_t WS_KIN = 690 * MiB;
constexpr size_t WS_MASK = 691 * MiB;
constexpr size_t WS_ROUTE = 699 * MiB;
constexpr size_t WS_CNTW = 699 * MiB + 256 * 1024;
constexpr size_t WS_SC = 700 * MiB;
constexpr size_t WS_XS = 956 * MiB;
constexpr size_t WS_ACT = 1100 * MiB;
constexpr size_t WS_YS = 1244 * MiB;
constexpr size_t WS_XB8 = 1388 * MiB;
constexpr size_t WS_END = 1404 * MiB;
constexpr int CW_TMO = 0;
constexpr int CW_CNT = 1024;
constexpr int CW_BAR = 4096;
constexpr int RING_BYTES = 131072;
constexpr int TAB_OFF = RING_BYTES;
constexpr int MISC_OFF = RING_BYTES + 1024;
constexpr int LDS_BYTES = 147456;

#define GAS __attribute__((address_space(1)))
#define LAS __attribute__((address_space(3)))
typedef unsigned short bf16;
typedef unsigned v4u __attribute__((ext_vector_type(4)));
typedef unsigned v2u __attribute__((ext_vector_type(2)));
typedef float f32x4 __attribute__((ext_vector_type(4)));
typedef short bf16x8 __attribute__((ext_vector_type(8)));
typedef GAS unsigned gu32;
typedef unsigned long long u64;
#define RLX_AGENT __ATOMIC_RELAXED, __HIP_MEMORY_SCOPE_AGENT
#define LDS_WAIT() asm volatile("s_waitcnt lgkmcnt(0)" ::: "memory")
#define VM_WAIT() asm volatile("s_waitcnt vmcnt(0)" ::: "memory")
__device__ __forceinline__ unsigned f2bf(float f) { unsigned u = __builtin_bit_cast(unsigned, f); return (u + 0x7fffu + ((u >> 16) & 1u)) >> 16; }
__device__ __forceinline__ unsigned pk2(float lo, float hi) { return f2bf(lo) | (f2bf(hi) << 16); }
__device__ __forceinline__ unsigned pk4_fp8(float a, float b, float c, float d) { int w = 0; w = __builtin_amdgcn_cvt_pk_fp8_f32(a, b, w, false); w = __builtin_amdgcn_cvt_pk_fp8_f32(c, d, w, true); return (unsigned)w; }
constexpr float WGU_SCALE = 32.f, WDN_SCALE = 64.f;
__device__ __forceinline__ float bf2f(bf16 v) { return __builtin_bit_cast(float, (unsigned)v << 16); }
__device__ __forceinline__ float bflo(unsigned w) { return __builtin_bit_cast(float, w << 16); }
__device__ __forceinline__ float bfhi(unsigned w) { return __builtin_bit_cast(float, w & 0xffff0000u); }
template <int CTRL> __device__ __forceinline__ float dppx(float v) { return __builtin_bit_cast(float, __builtin_amdgcn_update_dpp(0, __builtin_bit_cast(int, v), CTRL, 0xf, 0xf, false)); }
__device__ __forceinline__ float wave_sum(float v) {
    v += dppx<0xB1>(v); v += dppx<0x4E>(v); v += dppx<0x141>(v); v += dppx<0x140>(v);
    const float a = __builtin_bit_cast(float, __builtin_amdgcn_readlane(__builtin_bit_cast(int, v), 0)), b = __builtin_bit_cast(float, __builtin_amdgcn_readlane(__builtin_bit_cast(int, v), 16));
    const float c = __builtin_bit_cast(float, __builtin_amdgcn_readlane(__builtin_bit_cast(int, v), 32)), d = __builtin_bit_cast(float, __builtin_amdgcn_readlane(__builtin_bit_cast(int, v), 48));
    return (a + b) + (c + d);
}
__device__ __forceinline__ float wave_max(float v) {
#pragma unroll
    for (int o = 1; o < 64; o <<= 1) v = fmaxf(v, __shfl_xor(v, o));
    return v;
}
__device__ __forceinline__ float wave_max_dpp(float v) {
    v = fmaxf(v, dppx<0xB1>(v)); v = fmaxf(v, dppx<0x4E>(v)); v = fmaxf(v, dppx<0x141>(v)); v = fmaxf(v, dppx<0x140>(v));
    const float a = __builtin_bit_cast(float, __builtin_amdgcn_readlane(__builtin_bit_cast(int, v), 0)), b = __builtin_bit_cast(float, __builtin_amdgcn_readlane(__builtin_bit_cast(int, v), 16));
    const float c = __builtin_bit_cast(float, __builtin_amdgcn_readlane(__builtin_bit_cast(int, v), 32)), d = __builtin_bit_cast(float, __builtin_amdgcn_readlane(__builtin_bit_cast(int, v), 48));
    return fmaxf(fmaxf(a, b), fmaxf(c, d));
}
__device__ __forceinline__ float sum32(float v) {
#pragma unroll
    for (int o = 1; o < 32; o <<= 1) v += __shfl_xor(v, o);
    return v;
}
#define XB_TMO      128
#define XB_XCNT(j)  (256  + 64 * (j))
#define XB_XSUB(j)  (1280 + 64 * (j))
#define XB_XGEN(j)  (2304 + 64 * (j))
#define XB_TOP      3328
#define XB_TOPGEN   3392
#define XCD_BAR_WORDS 3456
#define XB_SPIN_CAP (1u << 18)

__device__ __forceinline__ unsigned xb_ld(unsigned* p)              { return __hip_atomic_load(p, __ATOMIC_RELAXED, __HIP_MEMORY_SCOPE_AGENT); }
__device__ __forceinline__ unsigned xb_add(unsigned* p, unsigned v) { return __hip_atomic_fetch_add(p, v, __ATOMIC_RELAXED, __HIP_MEMORY_SCOPE_AGENT); }
__device__ __forceinline__ unsigned xb_xcc_id() { return (unsigned)__builtin_amdgcn_s_getreg((3 << 11) | 20) & 0xFu; }
#define XB_SPIN(cond, bar) do { unsigned _sp = 0; while (cond) { __builtin_amdgcn_s_sleep(1); \
    if ((++_sp & 255u) == 0u) { if (xb_ld(&(bar)[XB_TMO])) break; if (_sp > XB_SPIN_CAP) { atomicAdd(&(bar)[XB_TMO], 1u); break; } } } } while (0)

struct XcdBarrier {
    unsigned* bar; unsigned x;
    volatile LAS unsigned* st;
};

__device__ __forceinline__ XcdBarrier xcd_barrier_post(unsigned* bar, volatile LAS unsigned* st) {
    XcdBarrier b; b.bar = bar; b.x = xb_xcc_id(); b.st = st;
    if (threadIdx.x == 0) (void)xb_add(&bar[XB_XCNT(b.x)], 1u);
    return b;
}
__device__ __forceinline__ void xcd_barrier_complete(unsigned* bar, unsigned x, unsigned& nloc, unsigned& nx) {
    const unsigned G = gridDim.x * gridDim.y * gridDim.z;
    unsigned sum, cnt, mine, sp = 0u;
    for (;;) {
        sum = 0u; cnt = 0u; mine = 0u;
#pragma unroll
        for (unsigned j = 0; j < 16; ++j) { const unsigned c = xb_ld(&bar[XB_XCNT(j)]); sum += c; cnt += (c > 0u) ? 1u : 0u; mine = (j == x) ? c : mine; }
        if (sum == G) break;
        __builtin_amdgcn_s_sleep(1);
        if ((++sp & 255u) == 0u) { if (xb_ld(&bar[XB_TMO])) break; if (sp > XB_SPIN_CAP) { atomicAdd(&bar[XB_TMO], 1u); break; } }
    }
    nloc = mine > 0u ? mine : 1u; nx = cnt > 0u ? cnt : 1u;
}

__device__ __forceinline__ void xcd_barrier(const XcdBarrier& b) {
    asm volatile("s_waitcnt vmcnt(0)" ::: "memory");
    __syncthreads();
    if (threadIdx.x == 0) {
        unsigned* bar = b.bar;
        __builtin_amdgcn_s_waitcnt(0);
        unsigned nloc = b.st[0], nx = b.st[1];
        if (nloc == 0u) { xcd_barrier_complete(bar, b.x, nloc, nx); b.st[0] = nloc; b.st[1] = nx; }
        const unsigned old = xb_add(&bar[XB_XSUB(b.x)], 1u);
        const unsigned gen = old / nloc;
        if (old + 1u == (gen + 1u) * nloc) {
            __builtin_amdgcn_fence(__ATOMIC_RELEASE, "agent");
            asm volatile("s_waitcnt vmcnt(0)" ::: "memory");
#ifdef BAR_EARLY_INV
            __builtin_amdgcn_fence(__ATOMIC_ACQUIRE, "agent");
            (void)xb_add(&bar[XB_TOP], 1u);
            { const unsigned target = (gen + 1u) * nx; XB_SPIN(xb_ld(&bar[XB_TOP]) < target, bar); }
            xb_add(&bar[XB_XGEN(b.x)], 1u);
            asm volatile("s_waitcnt vmcnt(0)" ::: "memory");
#else
            const unsigned og = xb_add(&bar[XB_TOP], 1u);
            const unsigned tg = og / nx;
            if (og + 1u == (tg + 1u) * nx) xb_add(&bar[XB_TOPGEN], 1u);
            else XB_SPIN(xb_ld(&bar[XB_TOPGEN]) == tg, bar);
            __builtin_amdgcn_fence(__ATOMIC_ACQUIRE, "agent");
            xb_add(&bar[XB_XGEN(b.x)], 1u);
            asm volatile("s_waitcnt vmcnt(0)" ::: "memory");
#endif
        } else {
#ifdef BAR_EARLY_INV
            __builtin_amdgcn_fence(__ATOMIC_ACQUIRE, "agent"); asm volatile("s_waitcnt vmcnt(0)" ::: "memory");
            XB_SPIN(xb_ld(&bar[XB_XGEN(b.x)]) == gen, bar);
            asm volatile("" ::: "memory");
#else
            XB_SPIN(xb_ld(&bar[XB_XGEN(b.x)]) == gen, bar);
            __builtin_amdgcn_fence(__ATOMIC_ACQUIRE, "agent");
            asm volatile("s_waitcnt vmcnt(0)" ::: "memory");
#endif
        }
    }
    __syncthreads();
}
struct Args { const float* in[N_IN]; float* out; unsigned char* ws; int ph_lo, ph_hi; };
struct Frame {
    LAS unsigned char* lds;
    gu32* ctl;
    unsigned char* ws;
    int tid, lane, wave, vcu, G;
};
#define WSP(type, off) ((type*)(GAS type*)(F.ws + (off)))
__device__ __forceinline__ const float* uni(const float* p) { const u64 v = (u64)p; return (const float*)(const GAS float*)(((u64)(unsigned)__builtin_amdgcn_readfirstlane((int)(v >> 32)) << 32) | (u64)(unsigned)__builtin_amdgcn_readfirstlane((int)v)); }
__device__ __forceinline__ Frame make_frame(unsigned char* ws_, LAS unsigned char* lds_) {
    Frame F; const u64 v = (u64)ws_;
    F.ws = (unsigned char*)(((u64)(unsigned)__builtin_amdgcn_readfirstlane((int)(v >> 32)) << 32) | (u64)(unsigned)__builtin_amdgcn_readfirstlane((int)v));
    F.lds = (LAS unsigned char*)(unsigned)__builtin_amdgcn_readfirstlane((int)(unsigned)(uintptr_t)lds_);
    F.ctl = (gu32*)(F.ws + WS_CTL);
    { int t_ = threadIdx.x; asm volatile("" : "+v"(t_)); F.tid = t_; }
    F.lane = F.tid & 63; F.wave = __builtin_amdgcn_readfirstlane(F.tid >> 6);
    F.G = gridDim.x; { const int bx = blockIdx.x; F.vcu = (F.G % 8 == 0) ? (bx % 8) * (F.G / 8) + bx / 8 : bx; }
    return F;
}
struct In6 { const float* p[6]; };

__device__ __forceinline__ void tr_block(Frame& F, const float* W_, int N, bf16* WT, int k0, int n0, int mode  , size_t drow_base, float scale) {
    LAS unsigned* img = (LAS unsigned*)F.lds; const int lane = F.lane, wave = F.wave, tid = F.tid; const GAS float* W = (const GAS float*)W_;
    f32x4 va[4][2], vb[4][2];
#pragma unroll
    for (int i = 0; i < 4; ++i) { const int kp = wave * 4 + i; const GAS float* r0 = W + (size_t)(k0 + 2 * kp) * N + n0; const GAS float* r1 = r0 + N;
#pragma unroll
        for (int q = 0; q < 2; ++q) { const int c4 = lane + 64 * q; va[i][q] = (f32x4){0.f, 0.f, 0.f, 0.f}; vb[i][q] = va[i][q];
            if (n0 + 4 * c4 < N) { va[i][q] = __builtin_nontemporal_load((const GAS f32x4*)(r0 + 4 * c4)); vb[i][q] = __builtin_nontemporal_load((const GAS f32x4*)(r1 + 4 * c4)); } } }
#pragma unroll
    for (int i = 0; i < 4; ++i) { const int kp = wave * 4 + i;
#pragma unroll
        for (int q = 0; q < 2; ++q) { const int c4 = lane + 64 * q; const f32x4 a = va[i][q], b = vb[i][q];
            v4u o; o.x = pk2(a.x * scale, b.x * scale); o.y = pk2(a.y * scale, b.y * scale); o.z = pk2(a.z * scale, b.z * scale); o.w = pk2(a.w * scale, b.w * scale);
            *(LAS v4u*)(img + kp * 516 + 4 * c4) = o; } }
    __syncthreads();
    const int c = tid & 7;
#pragma unroll
    for (int i = 0; i < 8; ++i) { const int n = (tid >> 3) + 64 * i; const LAS unsigned* p = img + (4 * c) * 516 + n;
        v4u o; o.x = p[0]; o.y = p[516]; o.z = p[2 * 516]; o.w = p[3 * 516];
        const int ng = n0 + n; size_t dr;
        if (mode == 1) dr = ng < 1024 ? (size_t)((ng >> 7) * 256 + (ng & 127)) : (size_t)((((ng - 1024) >> 7) * 256) + 128 + ((ng - 1024) & 127)); else dr = (size_t)ng;
        *(GAS v4u*)((GAS bf16*)WT + (drow_base + dr) * D + k0 + 8 * c) = o; }
    __syncthreads();
}
__device__ __forceinline__ void tr_block8(Frame& F, const float* W_, int N, unsigned char* WT, int k0, int n0, int mode, size_t drow_base, float scale) {
    LAS unsigned* img = (LAS unsigned*)F.lds; const int lane = F.lane, wave = F.wave, tid = F.tid; const GAS float* W = (const GAS float*)W_;
    f32x4 vv[4][2][4];
#pragma unroll
    for (int i = 0; i < 4; ++i) { const int kq = wave * 4 + i; const GAS float* r0 = W + (size_t)(k0 + 4 * kq) * N + n0;
#pragma unroll
        for (int q = 0; q < 2; ++q) { const int c4 = lane + 64 * q;
#pragma unroll
            for (int j = 0; j < 4; ++j) vv[i][q][j] = __builtin_nontemporal_load((const GAS f32x4*)(r0 + (size_t)j * N + 4 * c4)); } }
#pragma unroll
    for (int i = 0; i < 4; ++i) { const int kq = wave * 4 + i;
#pragma unroll
        for (int q = 0; q < 2; ++q) { const int c4 = lane + 64 * q; const f32x4 a = vv[i][q][0] * scale, b = vv[i][q][1] * scale, c = vv[i][q][2] * scale, d = vv[i][q][3] * scale;
            v4u o; o.x = pk4_fp8(a.x, b.x, c.x, d.x); o.y = pk4_fp8(a.y, b.y, c.y, d.y); o.z = pk4_fp8(a.z, b.z, c.z, d.z); o.w = pk4_fp8(a.w, b.w, c.w, d.w);
            *(LAS v4u*)(img + kq * 516 + 4 * c4) = o; } }
    __syncthreads();
    const int c = tid & 7;
#pragma unroll
    for (int i = 0; i < 8; ++i) { const int n = (tid >> 3) + 64 * i; const LAS unsigned* p = img + (4 * c) * 516 + n;
        v4u o; o.x = p[0]; o.y = p[516]; o.z = p[2 * 516]; o.w = p[3 * 516];
        const int ng = n0 + n; size_t dr;
        if (mode == 1) dr = ng < 1024 ? (size_t)((ng >> 7) * 256 + (ng & 127)) : (size_t)((((ng - 1024) >> 7) * 256) + 128 + ((ng - 1024) & 127)); else dr = (size_t)ng;
        *(GAS v4u*)((GAS unsigned char*)WT + (drow_base + dr) * D + k0 + 16 * c) = o; }
    __syncthreads();
}
__device__ __forceinline__ void p_prologue(Frame& F, const In6& A) {
    constexpr int I_IN = 16 * 6, I_OUT = 16 * 2, I_GU = NE * 8 * 4, I_DN = NE * 8 * 2, I_L = I_IN + I_OUT + I_GU + I_DN;
    for (int it = F.vcu; it < DEPTH * I_L; it += F.G) {
        const int l = it / I_L; int r = it % I_L;
        if (r < I_IN) { const int kb = r / 6, nb = r % 6; tr_block(F, A.p[0] + (size_t)l * D * NIN, NIN, WSP(bf16, WS_WIN) + (size_t)l * NINP * D, kb * 64, nb * 512, 0, 0, nb == 2 ? ATT_C2 : 1.f); continue; }
        r -= I_IN;
        if (r < I_OUT) { const int kb = r / 2, nb = r % 2; tr_block(F, A.p[1] + (size_t)l * D * D, D, WSP(bf16, WS_WOUT) + (size_t)l * D * D, kb * 64, nb * 512, 0, 0, 1.f); continue; }
        r -= I_OUT;
        if (r < I_GU) { const int e = r / 32, rr = r % 32, kb = rr / 4, nb = rr % 4; tr_block8(F, A.p[2] + (size_t)(l * NE + e) * D * 2048, 2048, WSP(unsigned char, WS_WGU) + (size_t)l * NE * 2048 * D * 2, kb * 128, nb * 512, 1, (size_t)e * 2048, WGU_SCALE); continue; }
        r -= I_GU;
        { const int e = r / 16, rr = r % 16, kb = rr / 2, nb = rr % 2; tr_block8(F, A.p[3] + (size_t)(l * NE + e) * D * D, D, WSP(unsigned char, WS_WDN) + (size_t)l * NE * D * D * 2, kb * 128, nb * 512, 0, (size_t)e * 1024, WDN_SCALE); }
    }
    const int gw = F.vcu * NWAVES + F.wave, NGW = F.G * NWAVES, lane = F.lane;
    const GAS float* x = (const GAS float*)A.p[4]; GAS bf16* xb = (GAS bf16*)WSP(bf16, WS_XB);
    for (int m = gw; m < T; m += 2 * NGW) {
        const GAS f32x4* xr = (const GAS f32x4*)(x + (size_t)m * D) + lane; GAS u64* o8 = (GAS u64*)(xb + (size_t)m * D) + lane;
        const GAS f32x4* xr2 = xr + (size_t)NGW * (D / 4); GAS u64* o82 = o8 + (size_t)NGW * (D / 4);
        f32x4 v[4], w[4];
#pragma unroll
        for (int j = 0; j < 4; ++j) { v[j] = __builtin_nontemporal_load(xr + 64 * j); w[j] = __builtin_nontemporal_load(xr2 + 64 * j); }
#pragma unroll
        for (int j = 0; j < 4; ++j) { o8[64 * j] = (u64)pk2(v[j].x, v[j].y) | ((u64)pk2(v[j].z, v[j].w) << 32); o82[64 * j] = (u64)pk2(w[j].x, w[j].y) | ((u64)pk2(w[j].z, w[j].w) << 32); }
    }
}

__device__ __forceinline__ void bf8_to_f(const v4u q, float (&f)[8]) { f[0] = bflo(q.x); f[1] = bfhi(q.x); f[2] = bflo(q.y); f[3] = bfhi(q.y); f[4] = bflo(q.z); f[5] = bfhi(q.z); f[6] = bflo(q.w); f[7] = bfhi(q.w); }
__device__ __forceinline__ void p_local(Frame& F, const In6& A, int l) {
    typedef float f32x16 __attribute__((ext_vector_type(16)));
    constexpr int MROW = 528, WROW = 144;
    LAS unsigned char* mixb = F.lds;
    LAS unsigned char* wpt = F.lds + 64 * MROW;
    const GAS float* wpool = (const GAS float*)(A.p[0] + (size_t)l * 4 * 64 * 64);
    const GAS float* convw = (const GAS float*)(A.p[1] + l * 768); const GAS float* pscale = (const GAS float*)(A.p[2] + l * 256);
    const GAS float* kng = (const GAS float*)(A.p[3] + l * 32); const GAS float* knb = (const GAS float*)(A.p[4] + l * 32);
    const GAS bf16* PROJ = (const GAS bf16*)(F.ws + WS_PROJ); GAS bf16* CAT = (GAS bf16*)(F.ws + WS_CAT); GAS bf16* KIN = (GAS bf16*)(F.ws + WS_KIN);
    const int tid = F.tid, lane = F.lane, wave = F.wave;
    for (int u = F.vcu; u < T / 64; u += F.G) {
        const int t0 = u * 64, s0 = t0 & (SEQ - 1), rowb = t0 - s0;
        __syncthreads();
        f32x4 wr0[4], wr1[4];
#pragma unroll
        for (int i = 0; i < 4; ++i) { const int item = tid + 512 * i, g = item >> 9, cp = (item >> 4) & 31, dq = item & 15;
            wr0[i] = *(const GAS f32x4*)(wpool + g * 4096 + (2 * cp) * 64 + 4 * dq); wr1[i] = *(const GAS f32x4*)(wpool + g * 4096 + (2 * cp + 1) * 64 + 4 * dq); }
        const int cga = tid & 31, tga = tid >> 5, ca0 = cga * 8, sfa = s0 + tga * 4;
        v4u ah[6], ag[6], ab[4];
#pragma unroll
        for (int i = -2; i < 4; ++i) { const int sq = sfa + i; ah[i + 2] = (v4u){0u, 0u, 0u, 0u}; ag[i + 2] = ah[i + 2];
            if (sq >= 0) { const GAS bf16* pr = PROJ + (size_t)(rowb + sq) * NINP; ah[i + 2] = *(const GAS v4u*)(pr + C_H + ca0); ag[i + 2] = *(const GAS v4u*)(pr + C_GC + ca0);
                if (i >= 0) ab[i] = *(const GAS v4u*)(pr + C_GB + ca0); } }
        const int cgb = tid & 63, tgb = tid >> 6, cb0 = cgb * 4, wwin = 2 << (cgb >> 4), sfb = s0 + tgb * 8;
        v2u bq[23];
#pragma unroll
        for (int i = 0; i < 23; ++i) { const int sq = sfb - 15 + i; bq[i] = (v2u){0u, 0u}; if (sq >= 0) bq[i] = *(const GAS v2u*)(PROJ + (size_t)(rowb + sq) * NINP + C_P + cb0); }
        bf16 ck[4];
#pragma unroll
        for (int i = 0; i < 4; ++i) { const int idx = tid + 512 * i; ck[i] = PROJ[(size_t)(t0 + (idx >> 5)) * NINP + C_KI + (idx & 31)]; }
        const float kg = kng[tid & 31], kb = knb[tid & 31];
        float w0[8], w1[8], w2[8];
#pragma unroll
        for (int i = 0; i < 8; ++i) { w0[i] = convw[ca0 + i]; w1[i] = convw[256 + ca0 + i]; w2[i] = convw[512 + ca0 + i]; }
#pragma unroll
        for (int i = 0; i < 4; ++i) { const int item = tid + 512 * i, g = item >> 9, cp = (item >> 4) & 31, dq = item & 15;
#pragma unroll
            for (int k = 0; k < 4; ++k) *(LAS unsigned*)(wpt + (g * 64 + 4 * dq + k) * WROW + cp * 4) = pk2(wr0[i][k], wr1[i][k]); }
        {
            float up2[8], up1[8];
#pragma unroll
            for (int i = 0; i < 8; ++i) { up2[i] = 0.f; up1[i] = 0.f; }
#pragma unroll
            for (int i = -2; i < 4; ++i) { const int sq = sfa + i; float h8[8], g8[8], uu[8];
                bf8_to_f(ah[i + 2], h8); bf8_to_f(ag[i + 2], g8);
#pragma unroll
                for (int k = 0; k < 8; ++k) uu[k] = g8[k] * h8[k];
                if (i >= 0) { float b8[8], y[8]; bf8_to_f(ab[i], b8);
#pragma unroll
                    for (int k = 0; k < 8; ++k) y[k] = b8[k] * (w0[k] * up2[k] + w1[k] * up1[k] + w2[k] * uu[k]);
                    v4u o; o.x = pk2(y[0], y[1]); o.y = pk2(y[2], y[3]); o.z = pk2(y[4], y[5]); o.w = pk2(y[6], y[7]);
                    *(GAS v4u*)(CAT + (size_t)(rowb + sq) * D + ca0) = o; }
#pragma unroll
                for (int k = 0; k < 8; ++k) { up2[k] = up1[k]; up1[k] = uu[k]; } }
        }
        {
            float pv[23][4];
#pragma unroll
            for (int i = 0; i < 23; ++i) { pv[i][0] = bflo(bq[i].x); pv[i][1] = bfhi(bq[i].x); pv[i][2] = bflo(bq[i].y); pv[i][3] = bfhi(bq[i].y); }
#pragma unroll
            for (int i = 0; i < 8; ++i) { const int sq = sfb + i; float a0 = 0.f, a1 = 0.f, a2 = 0.f, a3 = 0.f;
#pragma unroll
                for (int j = 0; j < 16; ++j) { const bool on = j < wwin; a0 += on ? pv[15 + i - j][0] : 0.f; a1 += on ? pv[15 + i - j][1] : 0.f; a2 += on ? pv[15 + i - j][2] : 0.f; a3 += on ? pv[15 + i - j][3] : 0.f; }
                const float rc = 1.f / (float)((sq + 1) < wwin ? (sq + 1) : wwin);
                *(LAS v2u*)(mixb + (tgb * 8 + i) * MROW + cb0 * 2) = (v2u){pk2(a0 * rc - pv[15 + i][0], a1 * rc - pv[15 + i][1]), pk2(a2 * rc - pv[15 + i][2], a3 * rc - pv[15 + i][3])}; }
        }
#pragma unroll
        for (int i = 0; i < 4; ++i) {
            const int idx = tid + 512 * i, tt = idx >> 5, dd = idx & 31; const float v = bf2f(ck[i]);
            const float mean = sum32(v) * (1.f / 32.f); const float dv = v - mean; const float var = sum32(dv * dv) * (1.f / 32.f);
            KIN[(size_t)(t0 + tt) * 32 + dd] = (bf16)f2bf(dv * rsqrtf(var + LN_EPS) * kg + kb);
        }
        __syncthreads();
        {
            const int g = wave >> 1, th = wave & 1, r32 = lane & 31, hi = lane >> 5;
            f32x16 acc[2]; acc[0] = f32x16{}; acc[1] = f32x16{};
#pragma unroll
            for (int kk = 0; kk < 4; ++kk) { const bf16x8 bfr = *(const LAS bf16x8*)(mixb + (th * 32 + r32) * MROW + (g * 64 + kk * 16 + hi * 8) * 2);
#pragma unroll
                for (int dh = 0; dh < 2; ++dh) { const bf16x8 afr = *(const LAS bf16x8*)(wpt + (g * 64 + dh * 32 + r32) * WROW + (kk * 16 + hi * 8) * 2);
                    acc[dh] = __builtin_amdgcn_mfma_f32_32x32x16_bf16(afr, bfr, acc[dh], 0, 0, 0); } }
            GAS bf16* orow = CAT + (size_t)(t0 + th * 32 + r32) * D + 256 + g * 64;
#pragma unroll
            for (int dh = 0; dh < 2; ++dh)
#pragma unroll
                for (int rq = 0; rq < 4; ++rq) { const int d0 = dh * 32 + 8 * rq + 4 * hi; const f32x4 sc = *(const GAS f32x4*)(pscale + g * 64 + d0);
                    *(GAS v2u*)(orow + d0) = (v2u){pk2(acc[dh][4 * rq] * sc.x, acc[dh][4 * rq + 1] * sc.y), pk2(acc[dh][4 * rq + 2] * sc.z, acc[dh][4 * rq + 3] * sc.w)}; }
        }
    }
    __syncthreads();
}

constexpr int SCS = SEQ;
__device__ __forceinline__ unsigned sortable(float v) { const unsigned u = __builtin_bit_cast(unsigned, v); return (u & 0x80000000u) ? ~u : (u | 0x80000000u); }
__device__ __forceinline__ void select_row(int t, const GAS float* SC, GAS unsigned* MASK, LAS unsigned* hist, LAS float* ckey, LAS int* cidx, int lane) {
    const u64 lt = (1ull << lane) - 1ull; const float NINF = -INFINITY;
    const int s = t & (SEQ - 1); GAS u64* mrow = (GAS u64*)MASK + ((size_t)(t >> 12) * 64) * SEQ + s;
    if (s < NSEL) { const int base = 64 * lane; u64 m; if (s >= base + 63) m = ~0ull; else if (s < base) m = 0ull; else m = (2ull << (s - base)) - 1ull; mrow[(size_t)lane * SEQ] = m; return; }
    const int jmax = s >> 6, jb = jmax & ~7;
    float v[64]; const GAS float* srow = SC + (size_t)t * SCS + lane;
#pragma unroll
    for (int j0 = 0; j0 < 64; j0 += 8) {
        if (j0 < jb) {
#pragma unroll
            for (int j = j0; j < j0 + 8; ++j) v[j] = srow[64 * j];
        } else if (j0 == jb) {
#pragma unroll
            for (int j = j0; j < j0 + 8; ++j) { const float x = srow[64 * j]; v[j] = (lane + 64 * j <= s) ? x : NINF; }
        } else {
#pragma unroll
            for (int j = j0; j < j0 + 8; ++j) v[j] = NINF;
        }
    }
    {
    float vmx = NINF, vmn = INFINITY;
#pragma unroll
    for (int j0 = 0; j0 < 64; j0 += 8) {
        if (j0 < jb) {
#pragma unroll
            for (int j = j0; j < j0 + 8; ++j) { vmx = fmaxf(vmx, v[j]); vmn = fminf(vmn, v[j]); }
        } else if (j0 == jb) {
#pragma unroll
            for (int j = j0; j < j0 + 8; ++j) { vmx = fmaxf(vmx, v[j]); vmn = fminf(vmn, v[j] == NINF ? INFINITY : v[j]); }
        }
    }
    vmx = wave_max_dpp(vmx); vmn = -wave_max_dpp(-vmn);
    const float scale = 1023.f / fmaxf(vmx - vmn, 1e-30f), off = -vmn * scale;
#pragma unroll
    for (int i = 0; i < 4; ++i) ((LAS v4u*)hist)[i * 64 + lane] = (v4u){0u, 0u, 0u, 0u};
    LDS_WAIT(); asm volatile("" ::: "memory");
    unsigned bp[32];
#pragma unroll
    for (int j0 = 0; j0 < 64; j0 += 8) {
        if (j0 < jb) {
#pragma unroll
            for (int j = j0; j < j0 + 8; ++j) { unsigned bb = (unsigned)fmaf(v[j], scale, off); bb = bb < 1023u ? bb : 1023u; __hip_atomic_fetch_add(hist + bb, 1u, __ATOMIC_RELAXED, __HIP_MEMORY_SCOPE_WORKGROUP);
                if (j & 1) bp[j >> 1] |= bb << 16; else bp[j >> 1] = bb; }
        } else if (j0 == jb) {
#pragma unroll
            for (int j = j0; j < j0 + 8; ++j) { unsigned bb = (unsigned)fmaf(v[j], scale, off); bb = bb < 1023u ? bb : 1023u; if (v[j] != NINF) __hip_atomic_fetch_add(hist + bb, 1u, __ATOMIC_RELAXED, __HIP_MEMORY_SCOPE_WORKGROUP);
                if (j & 1) bp[j >> 1] |= bb << 16; else bp[j >> 1] = bb; }
        } else {
#pragma unroll
            for (int j = j0; j < j0 + 8; j += 2) bp[j >> 1] = 0u;
        }
    }
    LDS_WAIT(); asm volatile("" ::: "memory");
    unsigned hb[16];
#pragma unroll
    for (int i = 0; i < 4; ++i) { const v4u q = ((const LAS v4u*)hist)[lane * 4 + i]; hb[4 * i] = q.x; hb[4 * i + 1] = q.y; hb[4 * i + 2] = q.z; hb[4 * i + 3] = q.w; }
    int own = 0;
#pragma unroll
    for (int i = 0; i < 16; ++i) own += (int)hb[i];
    int suf = own;
#pragma unroll
    for (int o = 1; o < 64; o <<= 1) { const int x = __shfl_down(suf, o); if (lane + o < 64) suf += x; }
    const u64 ge = __ballot(suf >= NSEL); const int L = 63 - __builtin_clzll(ge);
    int acc = suf - own, tb = 0, ca = 0, found = 0;
#pragma unroll
    for (int i = 15; i >= 0; --i) { if (!found) { if (acc + (int)hb[i] >= NSEL) { found = 1; tb = lane * 16 + i; ca = acc; } else acc += (int)hb[i]; } }
    const int TB = __builtin_amdgcn_readlane(tb, L), CA = __builtin_amdgcn_readlane(ca, L);
    const int need = NSEL - CA;
    int cbase = 0; unsigned mlo = 0u, mhi = 0u;
#pragma unroll
    for (int j0 = 0; j0 < 64; j0 += 8) {
        if (j0 <= jb) {
#pragma unroll
            for (int j = j0; j < j0 + 8; ++j) { const int bb = (int)((j & 1) ? (bp[j >> 1] >> 16) : (bp[j >> 1] & 0xffffu));
                const u64 am = __ballot(bb > TB); const u64 cm = __ballot(bb == TB);
                asm volatile("s_nop 4\n\tv_writelane_b32 %0, %2, %4\n\tv_writelane_b32 %1, %3, %4" : "+v"(mlo), "+v"(mhi) : "s"((unsigned)am), "s"((unsigned)(am >> 32)), "n"(j));
                if (cm) { const int pos = cbase + __popcll(cm & lt); if (bb == TB && pos < 64) { ckey[pos] = v[j]; cidx[pos] = lane + 64 * j; } cbase += __popcll(cm); } }
        }
    }
    LDS_WAIT(); asm volatile("" ::: "memory");
    if (cbase <= SEL_CAND_CAP) {
        LAS unsigned* mw = hist;
        mw[2 * lane] = mlo; mw[2 * lane + 1] = mhi;
        const float myk = lane < cbase ? ckey[lane] : NINF; const int myi = lane < cbase ? cidx[lane] : 0x7fffffff; int rank = 0;
        for (int c = 0; c < cbase; ++c) { const float ok = __builtin_bit_cast(float, __builtin_amdgcn_readlane(__builtin_bit_cast(int, myk), c)); const int oi = __builtin_amdgcn_readlane(myi, c); rank += (ok > myk || (ok == myk && oi < myi)) ? 1 : 0; }
        LDS_WAIT(); asm volatile("" ::: "memory");
        if (lane < cbase && rank < need && myk != NINF) __hip_atomic_fetch_or(mw + (myi >> 5), 1u << (myi & 31), __ATOMIC_RELAXED, __HIP_MEMORY_SCOPE_WORKGROUP);
        LDS_WAIT(); asm volatile("" ::: "memory");
        mrow[(size_t)lane * SEQ] = (u64)mw[2 * lane] | ((u64)mw[2 * lane + 1] << 32);
        LDS_WAIT(); asm volatile("" ::: "memory");
        return;
    }
    unsigned prefix = 0u;
    for (int bit = 31; bit >= 0; --bit) { const unsigned cand = prefix | (1u << bit); int cnt = 0;
#pragma unroll
        for (int j0 = 0; j0 < 64; j0 += 8) {
#pragma unroll
            for (int j = j0; j < j0 + 8; ++j) cnt += __popcll(__ballot(v[j] != NINF && sortable(v[j]) >= cand));
            __builtin_amdgcn_sched_barrier(0); }
        if (cnt >= NSEL) prefix = cand; }
    int ngt = 0;
#pragma unroll
    for (int j = 0; j < 64; ++j) ngt += __popcll(__ballot(v[j] != NINF && sortable(v[j]) > prefix));
    int rem = NSEL - ngt, last = 0;
#pragma unroll
    for (int j = 0; j < 64; ++j) { const u64 em = __ballot(v[j] != NINF && sortable(v[j]) == prefix); const int c = __popcll(em);
        if (rem > 0 && c > 0) { if (c >= rem) { u64 x = em; for (int q = 1; q < rem; ++q) x &= x - 1ull; last = 64 * j + __builtin_ctzll(x); rem = 0; } else rem -= c; } }
    const unsigned pb = (prefix & 0x80000000u) ? (prefix & 0x7fffffffu) : ~prefix; const float Tv = __builtin_bit_cast(float, pb); const int Tidx = last;
    mlo = 0u; mhi = 0u;
#pragma unroll
    for (int j = 0; j < 64; ++j) { const bool sel = (v[j] > Tv) || (v[j] == Tv && lane + 64 * j <= Tidx); const u64 m = __ballot(sel);
        asm volatile("s_nop 4\n\tv_writelane_b32 %0, %2, %4\n\tv_writelane_b32 %1, %3, %4" : "+v"(mlo), "+v"(mhi) : "s"((unsigned)m), "s"((unsigned)(m >> 32)), "n"(j)); }
    mrow[(size_t)lane * SEQ] = (u64)mlo | ((u64)mhi << 32);
    return;
    }
}
__device__ __forceinline__ float relu_i(float x) { const int b = __builtin_bit_cast(int, x); return __builtin_bit_cast(float, b > 0 ? b : 0); }
__device__ __forceinline__ void p_index(Frame& F) {
    const int wave = F.wave;
    const GAS bf16* PROJ = (const GAS bf16*)(F.ws + WS_PROJ); const GAS bf16* KIN = (const GAS bf16*)(F.ws + WS_KIN); GAS float* SC = (GAS float*)(F.ws + WS_SC); GAS unsigned* MASK = (GAS unsigned*)(F.ws + WS_MASK);
    LAS unsigned* hist = (LAS unsigned*)(F.lds + wave * 4096);
    LAS float* ckey = (LAS float*)(F.lds + 32768 + wave * 1024); LAS int* cidx = (LAS int*)(ckey + 64);
    for (int ui = 0; ui < 2; ++ui) {
        const int v = F.vcu; if (v >= 256) break;
        const int b = v & 3, j = v >> 2, qb = ui == 0 ? j : 127 - j, q0 = qb * 32;
        int lane = F.tid & 63; asm volatile("" : "+v"(lane)); const int l15 = lane & 15, l4 = lane >> 4;
        bf16x8 bq[2][8]; float wq[2][8];
#pragma unroll
        for (int hq = 0; hq < 2; ++hq) { const size_t rowq = (size_t)(b * SEQ + q0 + 16 * hq + l15);
#pragma unroll
            for (int h = 0; h < 8; ++h) { bq[hq][h] = *(const GAS bf16x8*)(PROJ + rowq * NINP + C_QI + h * 32 + 8 * l4); wq[hq][h] = bf2f(PROJ[rowq * NINP + C_WI + h]) * 0.0625f; } }
        GAS float* srow = SC + (size_t)(b * SEQ + q0 + l15) * SCS + 4 * l4;
        const int ktl = 2 * qb + 1; const GAS bf16* kin0 = KIN + (size_t)(b * SEQ + l15) * 32 + 8 * l4;
        bf16x8 a = *(const GAS bf16x8*)(kin0 + (size_t)((wave <= ktl ? wave : ktl) * 16) * 32);
        for (int kt = wave; kt <= ktl; kt += NWAVES) {
            const int ktn = kt + NWAVES <= ktl ? kt + NWAVES : kt;
            const bf16x8 an = *(const GAS bf16x8*)(kin0 + (size_t)(ktn * 16) * 32);
#pragma unroll
            for (int hq = 0; hq < 2; ++hq) { f32x4 sc = (f32x4){0.f, 0.f, 0.f, 0.f};
#pragma unroll
                for (int h = 0; h < 8; ++h) { const f32x4 d = __builtin_amdgcn_mfma_f32_16x16x32_bf16(a, bq[hq][h], (f32x4){0.f, 0.f, 0.f, 0.f}, 0, 0, 0);
                    sc.x += relu_i(d.x) * wq[hq][h]; sc.y += relu_i(d.y) * wq[hq][h]; sc.z += relu_i(d.z) * wq[hq][h]; sc.w += relu_i(d.w) * wq[hq][h]; }
                *(GAS f32x4*)(srow + (size_t)(16 * hq) * SCS + kt * 16) = sc; }
            a = an;
        }
        asm volatile("s_waitcnt vmcnt(0)" ::: "memory"); __syncthreads();
        int lane_s = F.tid & 63; asm volatile("" : "+v"(lane_s));
        for (int r = 0; r < 4; ++r) select_row(b * SEQ + q0 + wave * 4 + r, SC, MASK, hist, ckey, cidx, lane_s);
#ifdef EXP_DUP_SELECT
        for (int r = 0; r < 4; ++r) select_row(b * SEQ + q0 + wave * 4 + r, SC, MASK, hist, ckey, cidx, lane_s);
#endif
    }
}

namespace att {
typedef float f32x16 __attribute__((ext_vector_type(16)));
typedef short s16x4 __attribute__((ext_vector_type(4)));
constexpr int NSLOT = 3, SLOTB = 8192, LDS_K = 0, LDS_V = NSLOT * SLOTB, LDS_WS = 2 * NSLOT * SLOTB, LDS_OST = LDS_WS + 8 * 64 * 4, LDS_BYTES_ATT = LDS_OST + 8 * 4096;
constexpr float THR = 100.f;
__device__ __forceinline__ int crow(int r, int hi) { return (r & 3) + 8 * (r >> 2) + 4 * hi; }
__device__ __forceinline__ unsigned cvtpk(float lo, float hi) { typedef float f2 __attribute__((ext_vector_type(2))); typedef __bf16 b2 __attribute__((ext_vector_type(2))); f2 v = {lo, hi}; b2 b = __builtin_convertvector(v, b2); return __builtin_bit_cast(unsigned, b); }
__device__ __forceinline__ float rowmax(const f32x16& p0, const f32x16& p1) {
    float a = fmaxf(fmaxf(p0[0], p0[1]), p1[0]), b = fmaxf(fmaxf(p0[2], p0[3]), p1[1]); a = fmaxf(fmaxf(a, p1[2]), p1[3]);
#pragma unroll
    for (int r = 4; r < 16; r += 4) { a = fmaxf(fmaxf(a, p0[r]), p0[r + 1]); b = fmaxf(fmaxf(b, p0[r + 2]), p0[r + 3]); a = fmaxf(fmaxf(a, p1[r]), p1[r + 1]); b = fmaxf(fmaxf(b, p1[r + 2]), p1[r + 3]); }
    const float m = fmaxf(a, b);
    return fmaxf(m, __shfl_xor(m, 32));
}
__device__ __forceinline__ void pv(f32x16* o, int vb, bf16x8 pa0, bf16x8 pa1, bf16x8 pa2, bf16x8 pa3) {
#pragma unroll
    for (int d0 = 0; d0 < 2; ++d0) { s16x4 lo[4], hi[4];
#pragma unroll
        for (int ks = 0; ks < 4; ++ks) {
            asm volatile("ds_read_b64_tr_b16 %0,%1 offset:%c2" : "=&v"(lo[ks]) : "v"(vb), "i"(d0 * 4096 + ks * 1024) : "memory");
            asm volatile("ds_read_b64_tr_b16 %0,%1 offset:%c2" : "=&v"(hi[ks]) : "v"(vb), "i"(d0 * 4096 + ks * 1024 + 512) : "memory"); }
        asm volatile("s_waitcnt lgkmcnt(0)" ::: "memory"); __builtin_amdgcn_sched_barrier(0);
#define ATT_PK(k) (bf16x8){lo[k][0], lo[k][1], lo[k][2], lo[k][3], hi[k][0], hi[k][1], hi[k][2], hi[k][3]}
        o[d0] = __builtin_amdgcn_mfma_f32_32x32x16_bf16(pa0, ATT_PK(0), o[d0], 0, 0, 0);
        o[d0] = __builtin_amdgcn_mfma_f32_32x32x16_bf16(pa1, ATT_PK(1), o[d0], 0, 0, 0);
        o[d0] = __builtin_amdgcn_mfma_f32_32x32x16_bf16(pa2, ATT_PK(2), o[d0], 0, 0, 0);
        o[d0] = __builtin_amdgcn_mfma_f32_32x32x16_bf16(pa3, ATT_PK(3), o[d0], 0, 0, 0);
#undef ATT_PK
    }
}
}
template <bool grpB> __device__ __forceinline__ void attn_units(Frame& F) {
    using namespace att;
    const int tid = F.tid, lane = tid & 63, r32 = lane & 31, hi = lane >> 5, wid = F.wave;
    const GAS bf16* PROJ = (const GAS bf16*)(F.ws + WS_PROJ); GAS bf16* CAT = (GAS bf16*)(F.ws + WS_CAT); const GAS u64* MASKT = (const GAS u64*)(F.ws + WS_MASK);
    LAS unsigned char* shm = F.lds;
    constexpr int NSV = 4, LDS_V2 = NSLOT * SLOTB, LDS_WS2 = LDS_V2 + NSV * SLOTB, LDS_OST2 = LDS_WS2 + 8 * 64 * 4;
    LAS float* wsf = (LAS float*)(shm + LDS_WS2) + wid * 64;
    const float NEGINF = -INFINITY;
    for (int ui = 0; ui < 2; ++ui) {
        const int v = F.vcu; if (v >= 256) break;
        const int bh = v >> 3, sidx = v & 7, b = bh >> 3, h = bh & 7, qb = ui == 0 ? sidx : 15 - sidx;
        const size_t rowbase = (size_t)b * SEQ; const int q0 = qb * 256, NT = (q0 + 256) / 64;
        const float slope2 = exp2f(-(float)(h + 1)) * 1.4426950408889634f;
        const GAS bf16* Kh = PROJ + rowbase * NINP + C_K + h * 64; const GAS bf16* Vh = PROJ + rowbase * NINP + C_V + h * 64;
        const GAS bf16* ksrc = Kh + (size_t)lane * NINP + wid * 8;
        const GAS bf16* vsrc = Vh + (size_t)(16 * (wid & 3) + (lane >> 2)) * NINP + (wid >> 2) * 32 + (lane & 3) * 8;
#define ATT_DMA(t, ks, vs) do { __builtin_amdgcn_global_load_lds((const GAS unsigned*)(ksrc + (size_t)(t) * 64 * NINP), (LAS unsigned*)(shm + LDS_K + (ks) * SLOTB + wid * 1024), 16, 0, 0); \
                        __builtin_amdgcn_global_load_lds((const GAS unsigned*)(vsrc + (size_t)(t) * 64 * NINP), (LAS unsigned*)(shm + LDS_V2 + (vs) * SLOTB + wid * 1024), 16, 0, 0); } while (0)
        ATT_DMA(0, 0, 0); ATT_DMA(1, 1, 1);
        const GAS bf16* Qw = PROJ + (rowbase + q0 + wid * 32) * NINP + C_Q + h * 64;
        bf16x8 qr[4];
#pragma unroll
        for (int d0 = 0; d0 < 4; ++d0) qr[d0] = *(const GAS bf16x8*)(Qw + (size_t)r32 * NINP + d0 * 16 + hi * 8);
        const GAS u64* mq = MASKT + ((size_t)b * 64) * SEQ + q0 + wid * 32 + r32;
        u64 mnext = mq[0], mprev = 0ull;
        f32x16 o[2], p0 = f32x16{}, p1 = f32x16{}; o[0] = f32x16{}; o[1] = f32x16{};
        float l_reg = 0.f, sq = 0.f;
        const unsigned sl_hi = __builtin_bit_cast(unsigned, slope2) & 0xffff0000u; const unsigned sl_lo = f2bf(slope2 - __builtin_bit_cast(float, sl_hi));
        bf16x8 kx0, kx1;
        { const unsigned j0 = hi ? 0u : (f2bf((float)r32) * 0x10001u), j1 = hi ? 0u : (f2bf((float)(r32 + 32)) * 0x10001u), one2 = hi ? 0u : 0x3f803f80u, one1 = hi ? 0u : 0x3f80u;
          kx0 = __builtin_bit_cast(bf16x8, (v4u){j0, one2, one1, 0u}); kx1 = __builtin_bit_cast(bf16x8, (v4u){j1, one2, one1, 0u}); }
        const int qlast = q0 + wid * 32 + 31;
        const int vb0 = (int)(unsigned)(uintptr_t)(shm + LDS_V2) + ((lane >> 4) & 1) * 32 + (lane & 3) * 8 + (4 * hi + ((lane & 15) >> 2)) * 64;
#define ATT_QK(ks) do { const LAS unsigned char* kb = shm + LDS_K + (ks) * SLOTB + hi * 1024 + r32 * 16; \
            { const unsigned u0_ = __builtin_bit_cast(unsigned, sq), a1_ = u0_ & 0xffff0000u; const float r1_ = sq - __builtin_bit_cast(float, a1_); const unsigned u1_ = __builtin_bit_cast(unsigned, r1_), a2_ = u1_ & 0xffff0000u; \
              const float r2_ = r1_ - __builtin_bit_cast(float, a2_); const unsigned a3_ = __builtin_bit_cast(unsigned, r2_) >> 16; \
              const bf16x8 qx = __builtin_bit_cast(bf16x8, (v4u){hi ? 0u : ((sl_hi >> 16) | (sl_lo << 16)), hi ? 0u : ((a1_ >> 16) | a2_), hi ? 0u : a3_, 0u}); \
              const f32x16 z_ = f32x16{}; p0 = __builtin_amdgcn_mfma_f32_32x32x16_bf16(kx0, qx, z_, 0, 0, 0); p1 = __builtin_amdgcn_mfma_f32_32x32x16_bf16(kx1, qx, z_, 0, 0, 0); } \
            _Pragma("unroll") for (int d0 = 0; d0 < 4; ++d0) { const bf16x8 k0 = *(const LAS bf16x8*)(kb + d0 * 2048), k1 = *(const LAS bf16x8*)(kb + d0 * 2048 + 512); \
                p0 = __builtin_amdgcn_mfma_f32_32x32x16_bf16(k0, qr[d0], p0, 0, 0, 0); p1 = __builtin_amdgcn_mfma_f32_32x32x16_bf16(k1, qr[d0], p1, 0, 0, 0); } } while (0)
#define ATT_SMPV(vs, mw) do { const unsigned w0 = (unsigned)(mw) >> (4 * hi), w1 = (unsigned)((mw) >> 32) >> (4 * hi); \
            asm volatile("s_nop 15\n\ts_nop 7" : "+v"(p0), "+v"(p1));   \
            _Pragma("unroll") for (int r = 0; r < 16; ++r) { const int cr = (r & 3) + 8 * (r >> 2); const int k0_ = __builtin_amdgcn_sbfe((int)w0, cr, 1), k1_ = __builtin_amdgcn_sbfe((int)w1, cr, 1); \
                asm("v_bfi_b32 %0, %1, %0, %2" : "+v"(p0[r]) : "v"(k0_), "v"(NEGINF)); asm("v_bfi_b32 %0, %1, %0, %2" : "+v"(p1[r]) : "v"(k1_), "v"(NEGINF)); } \
            const float rm = rowmax(p0, p1); bool resc = false; \
            if (__any(rm > THR)) { const float dl = fmaxf(rm, 0.f); \
                _Pragma("unroll") for (int r = 0; r < 16; ++r) { p0[r] -= dl; p1[r] -= dl; } sq -= dl; \
                const float f = __builtin_amdgcn_exp2f(-dl); l_reg *= f; if (hi == 0) wsf[r32] = f; resc = true; } \
            float sacc = 0.f; \
            _Pragma("unroll") for (int r = 0; r < 16; ++r) { p0[r] = __builtin_amdgcn_exp2f(p0[r]); p1[r] = __builtin_amdgcn_exp2f(p1[r]); sacc += p0[r] + p1[r]; } \
            l_reg += sacc; \
            if (resc) { asm volatile("s_waitcnt lgkmcnt(0)" ::: "memory"); \
                _Pragma("unroll") for (int d_ = 0; d_ < 2; ++d_) _Pragma("unroll") for (int r = 0; r < 16; ++r) o[d_][r] *= wsf[crow(r, hi)]; } \
            const v4u pw0 = (v4u){cvtpk(p0[0], p0[1]), cvtpk(p0[2], p0[3]), cvtpk(p0[4], p0[5]), cvtpk(p0[6], p0[7])}, pw1 = (v4u){cvtpk(p0[8], p0[9]), cvtpk(p0[10], p0[11]), cvtpk(p0[12], p0[13]), cvtpk(p0[14], p0[15])}; \
            const v4u pw2 = (v4u){cvtpk(p1[0], p1[1]), cvtpk(p1[2], p1[3]), cvtpk(p1[4], p1[5]), cvtpk(p1[6], p1[7])}, pw3 = (v4u){cvtpk(p1[8], p1[9]), cvtpk(p1[10], p1[11]), cvtpk(p1[12], p1[13]), cvtpk(p1[14], p1[15])}; \
            __builtin_amdgcn_sched_barrier(0); \
            pv(o, vb0 + (vs) * SLOTB, __builtin_bit_cast(bf16x8, pw0), __builtin_bit_cast(bf16x8, pw1), __builtin_bit_cast(bf16x8, pw2), __builtin_bit_cast(bf16x8, pw3)); } while (0)
        if constexpr (grpB) __builtin_amdgcn_s_setprio(1);
        const float step = 64.f * slope2;
        int ks = 0, vs = 0;
        u64 mcur = 0ull;
#define ATT_SYNC(t) do { if ((t) + 1 < NT) asm volatile("s_waitcnt vmcnt(2)" ::: "memory"); else asm volatile("s_waitcnt vmcnt(0)" ::: "memory"); \
            asm volatile("s_waitcnt lgkmcnt(0)" ::: "memory"); __builtin_amdgcn_s_barrier(); asm volatile("" ::: "memory"); \
            mprev = mcur; mcur = mnext; if ((t) + 1 < NT) mnext = mq[(size_t)((t) + 1) * SEQ]; \
            __builtin_amdgcn_sched_barrier(0); \
            if ((t) + 2 < NT) ATT_DMA((t) + 2, ks + 2 >= NSLOT ? ks + 2 - NSLOT : ks + 2, vs + 2 >= NSV ? vs + 2 - NSV : vs + 2); \
            __builtin_amdgcn_sched_barrier(0); } while (0)
#define ATT_ADV() do { sq += step; ks = ks + 1 >= NSLOT ? 0 : ks + 1; vs = vs + 1 >= NSV ? 0 : vs + 1; } while (0)
        const int tmax = qlast >> 6;
        if constexpr (!grpB) {
            int t = 0;
            for (; t <= tmax; ++t) { ATT_SYNC(t); ATT_QK(ks); ATT_SMPV(vs, mcur); ATT_ADV(); }
            for (; t < NT; ++t) { ATT_SYNC(t); ATT_ADV(); }
        } else {
            ATT_SYNC(0); ATT_QK(ks); ATT_ADV();
            int t = 1;
            for (; t <= tmax; ++t) { ATT_SYNC(t); ATT_SMPV(vs == 0 ? NSV - 1 : vs - 1, mprev); ATT_QK(ks); ATT_ADV(); }
            if (t < NT) { ATT_SYNC(t); ATT_SMPV(vs == 0 ? NSV - 1 : vs - 1, mprev); ATT_ADV(); ++t;
                for (; t < NT; ++t) { ATT_SYNC(t); ATT_ADV(); } }
            else { ATT_SMPV(vs == 0 ? NSV - 1 : vs - 1, mcur); }
        }
#undef ATT_SYNC
#undef ATT_ADV
        __builtin_amdgcn_s_setprio(0);
        l_reg += __shfl_xor(l_reg, 32);
        if (hi == 0) wsf[32 + r32] = l_reg;
        asm volatile("s_waitcnt lgkmcnt(0)" ::: "memory");
        float rli[16];
#pragma unroll
        for (int r = 0; r < 16; ++r) rli[r] = 1.f / wsf[32 + crow(r, hi)];
        GAS bf16* Ow = CAT + (rowbase + q0 + wid * 32) * D + 512 + h * 64;
        { LAS bf16* stg = (LAS bf16*)(shm + LDS_OST2) + wid * 2048;
#pragma unroll
            for (int r = 0; r < 16; ++r) { const int orow = crow(r, hi);
#pragma unroll
                for (int d0 = 0; d0 < 2; ++d0) stg[orow * 64 + d0 * 32 + r32] = (bf16)f2bf(o[d0][r] * rli[r]); }
            asm volatile("s_waitcnt lgkmcnt(0)" ::: "memory");
#pragma unroll
            for (int i = 0; i < 4; ++i) { const int row = i * 8 + (lane >> 3), ch = lane & 7; const v4u vv = *(const LAS v4u*)(stg + row * 64 + ch * 8); *(GAS v4u*)(Ow + (size_t)row * D + ch * 8) = vv; } }
        asm volatile("s_waitcnt vmcnt(0) lgkmcnt(0)" ::: "memory"); __builtin_amdgcn_s_barrier(); asm volatile("" ::: "memory");
#undef ATT_DMA
#undef ATT_QK
#undef ATT_SMPV
    }
}

__device__ __forceinline__ void p_attn_dense(Frame& F) { if (F.wave >= 4) attn_units<true>(F); else attn_units<false>(F); }

struct EpiResid {
    static constexpr bool PERM = true, AFTER_DRAIN = false;
    const bf16* resid; bf16* out; float alpha;
    __device__ __forceinline__ void operator()(const pg8::f32x4 (&acc)[2][2][4][2], const pg8::Unit& u, int wr, int wc, int fr, int fq) const {
        const int col0 = u.pn * 256 + wc * 32 + 8 * fq;
#pragma unroll
        for (int ai = 0; ai < 2; ++ai)
#pragma unroll
            for (int m = 0; m < 4; ++m) { const size_t off = (size_t)(u.pm * 256 + ai * 128 + wr * 64 + m * 16 + fr) * D + col0;
#pragma unroll
                for (int bj = 0; bj < 2; ++bj) { const v4u xr = *(const GAS v4u*)(resid + off + bj * 128); const f32x4 a0 = acc[ai][bj][m][0], a1 = acc[ai][bj][m][1];
                    v4u w; w.x = pk2(bflo(xr.x) * alpha + a0[0], bfhi(xr.x) * alpha + a0[1]); w.y = pk2(bflo(xr.y) * alpha + a0[2], bfhi(xr.y) * alpha + a0[3]);
                    w.z = pk2(bflo(xr.z) * alpha + a1[0], bfhi(xr.z) * alpha + a1[1]); w.w = pk2(bflo(xr.w) * alpha + a1[2], bfhi(xr.w) * alpha + a1[3]);
                    st16_wt(out + off + bj * 128, w.x, w.y, w.z, w.w); }
                if (m & 1) asm volatile("" ::: "memory"); }
    }
};
struct EpiSwiglu {
    static constexpr bool PERM = true, AFTER_DRAIN = false;
    unsigned char* O; const float* bias;
    __device__ __forceinline__ void operator()(const pg8::f32x4 (&acc)[2][2][4][2], const pg8::Unit& u, int wr, int wc, int fr, int fq) const {
        const int e = u.pn >> 3, nt = u.pn & 7; const int colg = nt * 128 + wc * 32 + 8 * fq;
        f32x4 bg[2], bu[2];
#pragma unroll
        for (int n = 0; n < 2; ++n) { bg[n] = *(const GAS f32x4*)(bias + (size_t)e * 2048 + colg + 4 * n); bu[n] = *(const GAS f32x4*)(bias + (size_t)e * 2048 + 1024 + colg + 4 * n); }
#pragma unroll
        for (int ai = 0; ai < 2; ++ai)
#pragma unroll
            for (int m = 0; m < 4; ++m) { const size_t row = (size_t)(u.pm * 256 + ai * 128 + wr * 64 + m * 16 + fr); float a8[8];
#pragma unroll
                for (int n = 0; n < 2; ++n)
#pragma unroll
                    for (int i = 0; i < 4; ++i) { float g = fmaf(acc[ai][0][m][n][i], 1.f / WGU_SCALE, bg[n][i]), up = fmaf(acc[ai][1][m][n][i], 1.f / WGU_SCALE, bu[n][i]);
                        g = fminf(g, 7.f); up = fminf(fmaxf(up, -7.f), 7.f);
                        a8[n * 4 + i] = g * (up + 1.f) * __builtin_amdgcn_rcpf(1.f + __builtin_amdgcn_exp2f(-1.702f * 1.4426950408889634f * g)); }
                v2u w; w.x = pk4_fp8(a8[0], a8[1], a8[2], a8[3]); w.y = pk4_fp8(a8[4], a8[5], a8[6], a8[7]);
                st8_wt(O + row * 1024 + colg, w.x, w.y); }
    }
};
struct EpiDown {
    static constexpr bool PERM = true, AFTER_DRAIN = false;
    bf16* O; const float* bias;
    __device__ __forceinline__ void operator()(const pg8::f32x4 (&acc)[2][2][4][2], const pg8::Unit& u, int wr, int wc, int fr, int fq) const {
        const int col0 = (u.pn & 3) * 256 + wc * 32 + 8 * fq; const float* bp = bias + (size_t)(u.pn >> 2) * 1024 + col0;
        f32x4 bv[2][2];
#pragma unroll
        for (int bj = 0; bj < 2; ++bj)
#pragma unroll
            for (int n = 0; n < 2; ++n) bv[bj][n] = *(const GAS f32x4*)(bp + bj * 128 + 4 * n);
#pragma unroll
        for (int ai = 0; ai < 2; ++ai)
#pragma unroll
            for (int m = 0; m < 4; ++m) { bf16* rowp = O + (size_t)(u.pm * 256 + ai * 128 + wr * 64 + m * 16 + fr) * 1024 + col0;
#pragma unroll
                for (int bj = 0; bj < 2; ++bj) { const f32x4 v0 = acc[ai][bj][m][0] * (1.f / WDN_SCALE) + bv[bj][0], v1 = acc[ai][bj][m][1] * (1.f / WDN_SCALE) + bv[bj][1];
                    v4u w; w.x = pk2(v0[0], v0[1]); w.y = pk2(v0[2], v0[3]); w.z = pk2(v1[0], v1[1]); w.w = pk2(v1[2], v1[3]);
                    st16_wt(rowp + bj * 128, w.x, w.y, w.z, w.w); } }
    }
};
struct MoeSched {
    const LAS int* tab; int n;
    __device__ __forceinline__ bool next(int i, pg8::Unit& u) const {
        if (i >= n) return false;
        const int v = __builtin_amdgcn_readfirstlane(tab[1 + i]); u.pm = v >> 16; u.pn = v & 0xffff; return true;
    }
    __device__ __forceinline__ void a_ready(const pg8::Unit&) const {}
    __device__ __forceinline__ void done(const pg8::Unit&) const {}
};
#ifndef MOE_UNIT_OWNER
#define MOE_UNIT_OWNER F.vcu
#endif
__device__ __forceinline__ int moe_table(Frame& F, int l, int ntn) {
    LAS int* tab = (LAS int*)(F.lds + TAB_OFF);
    if (F.wave == 0) {
        const int lane = F.lane; const int cnt = lane < NE ? (int)__hip_atomic_load(F.ctl + CW_CNT + 64 * l + lane, RLX_AGENT) : 0; const int mt = (cnt + 255) >> 8; int incl = mt;
#pragma unroll
        for (int o = 1; o < 64; o <<= 1) { const int v = __shfl_up(incl, o); if (lane >= o) incl += v; }
        const int total = __shfl(incl, 63) * ntn; const int c = MOE_UNIT_OWNER;
        const int xcd = c >> 5, jw = c & 31, uq = total >> 3, ur = total & 7, cntx = uq + (xcd < ur ? 1 : 0), basex = xcd * uq + (xcd < ur ? xcd : ur);
        const int nmine = jw < cntx ? (cntx - jw + 31) >> 5 : 0;
        for (int i0 = 0; i0 < nmine && i0 < 200; i0 += 64) { const int i = i0 + lane; const int L = basex + i * 32 + jw; int e = 0;
            for (int k = 0; k < NE; ++k) { const int endk = __shfl(incl, k) * ntn; e += (L >= endk) ? 1 : 0; }
            e = e < NE ? e : NE - 1;
            const int excl_e = __shfl(incl, e) - __shfl(mt, e); int mte = __shfl(mt, e); mte = mte > 0 ? mte : 1; const int idx = L - excl_e * ntn;
            if (i < nmine && i < 200) tab[1 + i] = ((excl_e + idx % mte) << 16) | (e * ntn + idx / mte); }
        if (lane == 0) tab[0] = nmine < 200 ? nmine : 200;
    }
    __syncthreads();
    return __builtin_amdgcn_readfirstlane(tab[0]);
}

__device__ __forceinline__ void p_router(Frame& F, const In6& A, int l) {
    const int lane = F.lane, wave = F.wave, tid = F.tid;
    constexpr int XROW = 2064;
    LAS unsigned char* XH = F.lds; LAS unsigned char* XL = F.lds + 16 * XROW;
    LAS float* part = (LAS float*)(F.lds + 2 * 16 * XROW);
    LAS int* cnt = (LAS int*)(F.lds + 2 * 16 * XROW + 16384);
    LAS float* lgs = (LAS float*)(F.lds + 2 * 16 * XROW + 16384 + 1024);
    LAS float* top = lgs + 512;
    const GAS bf16* Y1 = (const GAS bf16*)(F.ws + WS_Y1); GAS bf16* X1B = (GAS bf16*)(F.ws + WS_Y1 + 32 * MiB); GAS unsigned* XB8 = (GAS unsigned*)(F.ws + WS_XB8);
    GAS int* TOPE = (GAS int*)(F.ws + WS_ROUTE); GAS float* GATE = (GAS float*)(TOPE + 8 * T); GAS int* CNTW = (GAS int*)(F.ws + WS_CNTW);
    const GAS float* g1 = (const GAS float*)(A.p[0] + l * D); const GAS float* b1 = (const GAS float*)(A.p[1] + l * D);
    const GAS float* RW = (const GAS float*)(A.p[2] + (size_t)l * D * NE); const GAS float* RB = (const GAS float*)(A.p[3] + l * NE);
    if (tid < 256) cnt[tid] = 0;
    bf16x8 wh[4][2], wl[4][2];
#pragma unroll
    for (int st = 0; st < 4; ++st)
#pragma unroll
        for (int hf = 0; hf < 2; ++hf) { const GAS float* wp = RW + (size_t)(wave * 128 + st * 32 + (lane >> 4) * 8) * NE + (lane & 15) + 16 * hf;
#pragma unroll
            for (int j = 0; j < 8; ++j) { const float w = wp[(size_t)j * NE]; const unsigned h = f2bf(w); const float r = w - __builtin_bit_cast(float, h << 16); wh[st][hf][j] = (short)h; wl[st][hf][j] = (short)f2bf(r); } }
    f32x4 g1v[4], b1v[4];
#pragma unroll
    for (int j = 0; j < 4; ++j) { g1v[j] = ((const GAS f32x4*)g1)[lane + 64 * j]; b1v[j] = ((const GAS f32x4*)b1)[lane + 64 * j]; }
    const float rb_e = RB[tid & 31];
    v2u yq[2][4];
#pragma unroll
    for (int i = 0; i < 2; ++i) { const GAS v2u* yr = (const GAS v2u*)(Y1 + (size_t)(F.vcu * 64 + wave * 2 + i) * D) + lane;
#pragma unroll
        for (int j = 0; j < 4; ++j) yq[i][j] = yr[64 * j]; }
    for (int g = 0; g < 4; ++g) {
        const int t0 = F.vcu * 64 + g * 16;
#pragma unroll
        for (int i = 0; i < 2; ++i) { const int tl = wave * 2 + i, t = t0 + tl;
            GAS u64* xr1 = (GAS u64*)(X1B + (size_t)t * D) + lane; f32x4 v[4]; float s = 0.f;
#pragma unroll
            for (int j = 0; j < 4; ++j) { const v2u q = yq[i][j]; v[j] = (f32x4){bflo(q.x), bfhi(q.x), bflo(q.y), bfhi(q.y)}; s += (v[j].x + v[j].y) + (v[j].z + v[j].w); }
            if (g < 3) { const GAS v2u* yr = (const GAS v2u*)(Y1 + (size_t)(t + 16) * D) + lane;
#pragma unroll
                for (int j = 0; j < 4; ++j) yq[i][j] = yr[64 * j]; }
            const float mean = wave_sum(s) * (1.f / D); float s2 = 0.f;
#pragma unroll
            for (int j = 0; j < 4; ++j) { v[j] = v[j] - mean; s2 += (v[j].x * v[j].x + v[j].y * v[j].y) + (v[j].z * v[j].z + v[j].w * v[j].w); }
            const float rstd = rsqrtf(wave_sum(s2) * (1.f / D) + LN_EPS);
            GAS unsigned* o8 = XB8 + (size_t)t * (D / 4) + lane;
#pragma unroll
            for (int j = 0; j < 4; ++j) { const f32x4 y = v[j] * rstd * g1v[j] + b1v[j];
                o8[64 * j] = pk4_fp8(y.x, y.y, y.z, y.w);
                const unsigned h0 = f2bf(y.x), h1 = f2bf(y.y), h2 = f2bf(y.z), h3 = f2bf(y.w);
                const u64 hp = (u64)(h0 | (h1 << 16)) | ((u64)(h2 | (h3 << 16)) << 32); xr1[64 * j] = hp;
                const float r0 = y.x - __builtin_bit_cast(float, h0 << 16), r1 = y.y - __builtin_bit_cast(float, h1 << 16), r2 = y.z - __builtin_bit_cast(float, h2 << 16), r3 = y.w - __builtin_bit_cast(float, h3 << 16);
                *(LAS u64*)(XH + tl * XROW + (lane + 64 * j) * 8) = hp;
                *(LAS u64*)(XL + tl * XROW + (lane + 64 * j) * 8) = (u64)pk2(r0, r1) | ((u64)pk2(r2, r3) << 32); } }
        __syncthreads();
        f32x4 acc[2]; acc[0] = (f32x4){0.f, 0.f, 0.f, 0.f}; acc[1] = acc[0];
#pragma unroll
        for (int st = 0; st < 4; ++st) { const int boff = (lane & 15) * XROW + (wave * 128 + st * 32 + (lane >> 4) * 8) * 2;
            const bf16x8 bh = *(const LAS bf16x8*)(XH + boff), bl = *(const LAS bf16x8*)(XL + boff);
#pragma unroll
            for (int hf = 0; hf < 2; ++hf) { acc[hf] = __builtin_amdgcn_mfma_f32_16x16x32_bf16(wh[st][hf], bh, acc[hf], 0, 0, 0); acc[hf] = __builtin_amdgcn_mfma_f32_16x16x32_bf16(wh[st][hf], bl, acc[hf], 0, 0, 0);
                acc[hf] = __builtin_amdgcn_mfma_f32_16x16x32_bf16(wl[st][hf], bh, acc[hf], 0, 0, 0); } }
#pragma unroll
        for (int hf = 0; hf < 2; ++hf)
#pragma unroll
            for (int r = 0; r < 4; ++r) part[((wave * 2 + hf) * 16 + 4 * (lane >> 4) + r) * 16 + (lane & 15)] = acc[hf][r];
        __syncthreads();
        { const int tl = tid >> 5, e = tid & 31, t = t0 + tl; float lg = rb_e;
#pragma unroll
            for (int w = 0; w < 8; ++w) lg += part[((w * 2 + (e >> 4)) * 16 + (e & 15)) * 16 + tl];
            lgs[tl * 32 + e] = lg;
            LDS_WAIT(); asm volatile("" ::: "memory");
            int rank = 0;
#pragma unroll
            for (int q = 0; q < 8; ++q) { const f32x4 o = *(const LAS f32x4*)(lgs + tl * 32 + 4 * q);
#pragma unroll
                for (int i = 0; i < 4; ++i) { const int eo = 4 * q + i; rank += (o[i] > lg || (o[i] == lg && eo < e)) ? 1 : 0; } }
            if (rank < 4) { top[tl * 4 + rank] = lg; __hip_atomic_fetch_add(cnt + ((g * 16 + tl) >> 3) * 32 + e, 1, __ATOMIC_RELAXED, __HIP_MEMORY_SCOPE_WORKGROUP); }
            LDS_WAIT(); asm volatile("" ::: "memory");
            const f32x4 sv = *(const LAS f32x4*)(top + tl * 4);
            const float e1 = expf(sv[1] - sv[0]), e2 = expf(sv[2] - sv[0]), e3 = expf(sv[3] - sv[0]); const float inv = 1.f / (1.f + e1 + e2 + e3);
            if (rank < 4) { const float gk = (rank == 0 ? 1.f : rank == 1 ? e1 : rank == 2 ? e2 : e3) * inv; TOPE[4 * t + rank] = e; GATE[4 * t + rank] = gk; } }
    }
    __syncthreads();
    if (tid < 256) CNTW[(F.vcu * NWAVES + (tid >> 5)) * NE + (tid & 31)] = cnt[tid];
    __syncthreads();
}

__device__ __forceinline__ void p_gather(Frame& F, int l) {
    const int gw = F.vcu * NWAVES + F.wave, NGW = F.G * NWAVES, lane = F.lane, tid = F.tid;
    const int TPW = T / NGW, NIT = TPW * 4;
    const GAS int* CNTW = (const GAS int*)(F.ws + WS_CNTW);
    LAS int* red = (LAS int*)F.lds;
    LAS int* baseE = red + 1024; LAS int* totE = baseE + 32;
    { const int e = tid & 31, part = tid >> 5, first = F.vcu * NWAVES; int sb = 0, st = 0;
        for (int g0 = part; g0 < NGW; g0 += 256) { int c[16];
#pragma unroll
            for (int k = 0; k < 16; ++k) c[k] = g0 + 16 * k < NGW ? CNTW[(g0 + 16 * k) * NE + e] : 0;
#pragma unroll
            for (int k = 0; k < 16; ++k) { st += c[k]; sb += g0 + 16 * k < first ? c[k] : 0; } }
        red[part * 32 + e] = sb; red[512 + part * 32 + e] = st; }
    __syncthreads();
    if (tid < 32) { int sb = 0, st = 0;
#pragma unroll
        for (int p = 0; p < 16; ++p) { sb += red[p * 32 + tid]; st += red[512 + p * 32 + tid]; }
        baseE[tid] = sb; totE[tid] = st;
        if (F.vcu == 0) __hip_atomic_store(F.ctl + CW_CNT + 64 * l + tid, (unsigned)st, RLX_AGENT); }
    __syncthreads();
    int mybase = 0, tot = 0;
    if (lane < NE) { mybase = baseE[lane]; tot = totE[lane]; int cw[NWAVES - 1];
#pragma unroll
        for (int w = 0; w < NWAVES - 1; ++w) cw[w] = CNTW[(F.vcu * NWAVES + w) * NE + lane];
#pragma unroll
        for (int w = 0; w < NWAVES - 1; ++w) mybase += w < F.wave ? cw[w] : 0; }
    const int mt = (tot + 255) >> 8; int incl = mt;
#pragma unroll
    for (int o = 1; o < 64; o <<= 1) { const int v = __shfl_up(incl, o); if (lane >= o) incl += v; }
    const int pstart = (incl - mt) * 256;
    const GAS int* TOPE = (const GAS int*)(F.ws + WS_ROUTE); GAS int* ROWOF = (GAS int*)(F.ws + WS_ROUTE) + 12 * T; GAS int* ROWTOK = (GAS int*)(F.ws + WS_XS);
    if (F.vcu < NE && F.wave == 0) {
        const int e = F.vcu; const int ps = __builtin_amdgcn_readlane(pstart, e), te = __builtin_amdgcn_readlane(tot, e), me = __builtin_amdgcn_readlane(mt, e);
        for (int i = te + lane; i < me * 256; i += 64) ROWTOK[ps + i] = 0; }
    const int it0 = gw * NIT; const int ei = lane < NIT ? TOPE[it0 + lane] : 0; int rk = 0;
    for (int j = 0; j < NIT; ++j) { const int ej = __shfl(ei, j); rk += (j < lane && ej == ei) ? 1 : 0; }
    const int row = __shfl(pstart, ei) + __shfl(mybase, ei) + rk;
    if (lane < NIT) { ROWOF[it0 + lane] = row; ROWTOK[row] = (it0 + lane) >> 2; }
    __syncthreads();
}

__device__ __forceinline__ void p_combine(Frame& F, const In6& A, int l, float* xout_) {
    constexpr int TPW = 8;
    const int gw = F.vcu * NWAVES + F.wave, NGW = F.G * NWAVES, lane = F.lane;
    const GAS int* ROWOF = (const GAS int*)(F.ws + WS_ROUTE) + 12 * T; const GAS float* GATE = (const GAS float*)(F.ws + WS_ROUTE) + 8 * T;
    const GAS bf16* X1B = (const GAS bf16*)(F.ws + WS_Y1 + 32 * MiB); const GAS bf16* YS = (const GAS bf16*)(F.ws + WS_YS); GAS bf16* XB = (GAS bf16*)(F.ws + WS_XB);
    GAS float* xout = (GAS float*)xout_;
    const GAS f32x4* g2 = (const GAS f32x4*)(A.p[0] + l * D) + lane; const GAS f32x4* b2 = (const GAS f32x4*)(A.p[1] + l * D) + lane;
    int rowv = 0; float gatev = 0.f;
    if (lane < 4 * TPW) { const int tk = gw + (lane >> 2) * NGW; rowv = ROWOF[4 * tk + (lane & 3)]; gatev = GATE[4 * tk + (lane & 3)]; }
    f32x4 gg[4], bb[4];
#pragma unroll
    for (int j = 0; j < 4; ++j) { gg[j] = g2[64 * j]; bb[j] = b2[64 * j]; }
    v2u xq[2][4], yq[2][4][4];
#define CMB_ISSUE(k, bf) do { const int t_ = gw + (k) * NGW; const GAS v2u* xr_ = (const GAS v2u*)(X1B + (size_t)t_ * D) + lane; \
        _Pragma("unroll") for (int j = 0; j < 4; ++j) xq[bf][j] = xr_[64 * j]; \
        _Pragma("unroll") for (int c = 0; c < 4; ++c) { const int row_ = __builtin_amdgcn_readlane(rowv, 4 * (k) + c); const GAS v2u* yr_ = (const GAS v2u*)(YS + (size_t)row_ * D) + lane; \
            _Pragma("unroll") for (int j = 0; j < 4; ++j) yq[bf][c][j] = yr_[64 * j]; } } while (0)
    CMB_ISSUE(0, 0);
#pragma unroll
    for (int k = 0; k < TPW; ++k) {
        const int bf = k & 1, t = gw + k * NGW;
        if (k + 1 < TPW) { if (bf == 0) CMB_ISSUE(k + 1, 1); else CMB_ISSUE(k + 1, 0); }
        f32x4 v[4];
#pragma unroll
        for (int j = 0; j < 4; ++j) { const v2u q = xq[bf][j]; v[j] = (f32x4){bflo(q.x), bfhi(q.x), bflo(q.y), bfhi(q.y)} * DN_ALPHA; }
#pragma unroll
        for (int c = 0; c < 4; ++c) { const float gk = __builtin_bit_cast(float, __builtin_amdgcn_readlane(__builtin_bit_cast(int, gatev), 4 * k + c));
#pragma unroll
            for (int j = 0; j < 4; ++j) { const v2u w = yq[bf][c][j]; v[j].x += gk * bflo(w.x); v[j].y += gk * bfhi(w.x); v[j].z += gk * bflo(w.y); v[j].w += gk * bfhi(w.y); } }
        float s = 0.f;
#pragma unroll
        for (int j = 0; j < 4; ++j) s += (v[j].x + v[j].y) + (v[j].z + v[j].w);
        const float mean = wave_sum(s) * (1.f / D); float s2 = 0.f;
#pragma unroll
        for (int j = 0; j < 4; ++j) { v[j] = v[j] - mean; s2 += (v[j].x * v[j].x + v[j].y * v[j].y) + (v[j].z * v[j].z + v[j].w * v[j].w); }
        const float rstd = rsqrtf(wave_sum(s2) * (1.f / D) + LN_EPS);
        GAS f32x4* orow = (GAS f32x4*)(xout + (size_t)t * D) + lane; GAS u64* o8 = (GAS u64*)(XB + (size_t)t * D) + lane;
#pragma unroll
        for (int j = 0; j < 4; ++j) { const f32x4 y = v[j] * rstd * gg[j] + bb[j];
            if (xout_) orow[64 * j] = y; else o8[64 * j] = (u64)pk2(y.x, y.y) | ((u64)pk2(y.z, y.w) << 32); }
        __builtin_amdgcn_sched_barrier(0);
    }
#undef CMB_ISSUE
}


#define NI __device__ __forceinline__
NI void ph_prologue(unsigned char* ws, LAS unsigned char* lds, const float* a0, const float* a1, const float* a2, const float* a3, const float* a4) { Frame F = make_frame(ws, lds); In6 I{{uni(a0), uni(a1), uni(a2), uni(a3), uni(a4), nullptr}}; p_prologue(F, I); }
NI void ph_local(unsigned char* ws, LAS unsigned char* lds, int l, const float* a0, const float* a1, const float* a2, const float* a3, const float* a4) { Frame F = make_frame(ws, lds); In6 I{{uni(a0), uni(a1), uni(a2), uni(a3), uni(a4), nullptr}}; p_local(F, I, __builtin_amdgcn_readfirstlane(l)); }
NI void ph_scores(unsigned char* ws, LAS unsigned char* lds) { Frame F = make_frame(ws, lds); p_index(F); }
NI void ph_attn(unsigned char* ws, LAS unsigned char* lds) { Frame F = make_frame(ws, lds); p_attn_dense(F); }
NI void ph_router(unsigned char* ws, LAS unsigned char* lds, int l, const float* a0, const float* a1, const float* a2, const float* a3) { Frame F = make_frame(ws, lds); In6 I{{uni(a0), uni(a1), uni(a2), uni(a3), nullptr, nullptr}}; p_router(F, I, __builtin_amdgcn_readfirstlane(l)); }
NI void ph_gather(unsigned char* ws, LAS unsigned char* lds, int l) { Frame F = make_frame(ws, lds); p_gather(F, __builtin_amdgcn_readfirstlane(l)); }
NI void ph_combine(unsigned char* ws, LAS unsigned char* lds, int l, const float* a0, const float* a1, float* xout) { Frame F = make_frame(ws, lds); In6 I{{uni(a0), uni(a1), nullptr, nullptr, nullptr, nullptr}}; p_combine(F, I, __builtin_amdgcn_readfirstlane(l), (float*)uni(xout)); }

NI void ph_gemm_in(unsigned char* ws, LAS unsigned char* lds, int l_) {
    Frame F = make_frame(ws, lds); const int l = __builtin_amdgcn_readfirstlane(l_);
    pg8::Gemm g{WSP(bf16, WS_XB), WSP(bf16, WS_WIN) + (size_t)l * NINP * D, T, NINP, D}; pg8::StaticOrder S; S.init(T, NINP, F.G, (int)blockIdx.x);
    pg8::EpiBf16<0> E{WSP(bf16, WS_PROJ), NINP, nullptr, 0, 0, 1.f};
    pg8::gemm_phase<pg8::EpiBf16<0>, pg8::StaticOrder, PG8_ALIGN, PG8_SP2>(F.lds, g, S, E);
}
NI void ph_gemm_out(unsigned char* ws, LAS unsigned char* lds, int l_, const float* xin) {
    Frame F = make_frame(ws, lds); const int l = __builtin_amdgcn_readfirstlane(l_);
    pg8::Gemm g{WSP(bf16, WS_CAT), WSP(bf16, WS_WOUT) + (size_t)l * D * D, T, D, D}; pg8::StaticOrder S; S.init(T, D, F.G, (int)blockIdx.x);
    EpiResid E{WSP(bf16, WS_XB), WSP(bf16, WS_Y1), DN_ALPHA};
    pg8::gemm_phase<EpiResid, pg8::StaticOrder, PG8_ALIGN, PG8_SP2>(F.lds, g, S, E);
}
NI void ph_gemm_moe1(unsigned char* ws, LAS unsigned char* lds, int l_, const float* bgu) {
    Frame F = make_frame(ws, lds); const int l = __builtin_amdgcn_readfirstlane(l_);
    const int nun = moe_table(F, l, 8);
    pg8::Gemm g{WSP(bf16, WS_XB8), (const bf16*)(WSP(unsigned char, WS_WGU) + (size_t)l * NE * 2048 * D * 2), MAXROWS, NE * 2048, D};
    MoeSched S{(const LAS int*)(F.lds + TAB_OFF), nun};
    EpiSwiglu E{WSP(unsigned char, WS_ACT), uni(bgu) + (size_t)l * NE * 2048};
    pg8::gemm_phase<EpiSwiglu, MoeSched, PG8_ALIGN, true, 1, true>(F.lds, g, S, E, WSP(int, WS_XS));
}
NI void ph_gemm_moe2(unsigned char* ws, LAS unsigned char* lds, int l_, const float* bdn) {
    Frame F = make_frame(ws, lds); const int l = __builtin_amdgcn_readfirstlane(l_);
    const int nun = moe_table(F, l, 4);
    pg8::Gemm g{WSP(bf16, WS_ACT), (const bf16*)(WSP(unsigned char, WS_WDN) + (size_t)l * NE * D * D * 2), MAXROWS, NE * D, D};
    MoeSched S{(const LAS int*)(F.lds + TAB_OFF), nun};
    EpiDown E{WSP(bf16, WS_YS), uni(bdn) + (size_t)l * NE * D};
    pg8::gemm_phase<EpiDown, MoeSched, PG8_ALIGN, MOE_SP2, 1>(F.lds, g, S, E);
}

__device__ __forceinline__ const float* karg_in(int i) { return ((const float* const volatile*)__builtin_amdgcn_kernarg_segment_ptr())[i]; }
__device__ __forceinline__ float* karg_out() { return ((float* const volatile*)__builtin_amdgcn_kernarg_segment_ptr())[N_IN]; }
#ifndef PHMASK
#define PHMASK 0x7FF
#endif
constexpr int PH_PER_LAYER = 10, N_PHASES = 1 + DEPTH * PH_PER_LAYER;
#define IN(k) (lo <= (k) && (k) < hi)
#define SEAM(k) do { if (IN(k) && IN((k) + 1)) xcd_barrier(bar); } while (0)
template <int l> __device__ __forceinline__ void layer_phases(Frame& F, const XcdBarrier& bar, int lo, int hi) {
        const int p0 = 1 + l * PH_PER_LAYER;
        const float* xin = nullptr;
        float* xout = l == DEPTH - 1 ? karg_out() : nullptr;
        if (((PHMASK >> 0) & 1) && IN(p0 + 0)) { asm volatile("; PHASE_BEGIN_0"); ph_gemm_in(F.ws, F.lds, l); SEAM(p0 + 0); }
        if (((PHMASK >> 1) & 1) && IN(p0 + 1)) { asm volatile("; PHASE_BEGIN_1"); ph_local(F.ws, F.lds, l, karg_in(IN_WPOOL), karg_in(IN_CONVW), karg_in(IN_PSCALE), karg_in(IN_KNG), karg_in(IN_KNB)); SEAM(p0 + 1); }
        if (((PHMASK >> 2) & 1) && IN(p0 + 2)) { asm volatile("; PHASE_BEGIN_2"); ph_scores(F.ws, F.lds); SEAM(p0 + 2); }
        if (((PHMASK >> 3) & 1) && IN(p0 + 3)) { asm volatile("; PHASE_BEGIN_3"); ph_attn(F.ws, F.lds); SEAM(p0 + 3); }
        if (((PHMASK >> 4) & 1) && IN(p0 + 4)) { asm volatile("; PHASE_BEGIN_4"); ph_gemm_out(F.ws, F.lds, l, xin); SEAM(p0 + 4); }
        if (((PHMASK >> 5) & 1) && IN(p0 + 5)) { asm volatile("; PHASE_BEGIN_5"); ph_router(F.ws, F.lds, l, karg_in(IN_LN1G), karg_in(IN_LN1B), karg_in(IN_RW), karg_in(IN_RB)); SEAM(p0 + 5); }
        if (((PHMASK >> 6) & 1) && IN(p0 + 6)) { asm volatile("; PHASE_BEGIN_6"); ph_gather(F.ws, F.lds, l); SEAM(p0 + 6); }
        if (((PHMASK >> 7) & 1) && IN(p0 + 7)) { asm volatile("; PHASE_BEGIN_7"); ph_gemm_moe1(F.ws, F.lds, l, karg_in(IN_BGU)); SEAM(p0 + 7); }
        if (((PHMASK >> 8) & 1) && IN(p0 + 8)) { asm volatile("; PHASE_BEGIN_8"); ph_gemm_moe2(F.ws, F.lds, l, karg_in(IN_BDN)); SEAM(p0 + 8); }
        if (((PHMASK >> 9) & 1) && IN(p0 + 9)) { asm volatile("; PHASE_BEGIN_9"); ph_combine(F.ws, F.lds, l, karg_in(IN_LN2G), karg_in(IN_LN2B), xout); SEAM(p0 + 9); }
}
#undef IN
#undef SEAM
__global__ void __launch_bounds__(NWAVES * 64, 2) fwd_kernel(Args A) {
    extern __shared__ __attribute__((aligned(16))) unsigned char lds[];
    Frame F;
    F.lds = (LAS unsigned char*)lds;
    F.tid = threadIdx.x; F.lane = F.tid & 63; F.wave = __builtin_amdgcn_readfirstlane(F.tid >> 6);
    F.G = gridDim.x; { const int bx = blockIdx.x; F.vcu = (F.G % 8 == 0) ? (bx % 8) * (F.G / 8) + bx / 8 : bx; }
    F.ws = A.ws; F.ctl = (gu32*)(A.ws + WS_CTL);
    volatile LAS unsigned* MISC = (volatile LAS unsigned*)(F.lds + MISC_OFF);
    if (F.tid < 32) MISC[F.tid] = 0u;
    __syncthreads();
    const int lo = A.ph_lo, hi = A.ph_hi;
    const bool multi = (hi - lo) > 1;
    XcdBarrier bar; bar.bar = (unsigned*)(F.ctl + CW_BAR); bar.x = 0; bar.st = nullptr;
    if (multi) bar = xcd_barrier_post((unsigned*)(F.ctl + CW_BAR), MISC + 8);
#define IN(k) (lo <= (k) && (k) < hi)
#define SEAM(k) do { if (IN(k) && IN((k) + 1)) xcd_barrier(bar); } while (0)

    if (((PHMASK >> 10) & 1) && IN(0)) { asm volatile("; PHASE_BEGIN_11"); ph_prologue(F.ws, F.lds, karg_in(IN_WIN), karg_in(IN_WOUT), karg_in(IN_WGU), karg_in(IN_WDN), karg_in(IN_X)); SEAM(0); }
    layer_phases<0>(F, bar, lo, hi);
    layer_phases<1>(F, bar, lo, hi);
#undef IN
#undef SEAM
}


#ifdef DUMP_OFF
__global__ void dump_kernel(const unsigned* w, size_t nwords, float* out, int n) {
    const int i = blockIdx.x * blockDim.x + threadIdx.x; if (i >= n) return;
#ifdef DUMP_NAN_ALL
    { bool bad = false; for (size_t j = (size_t)i; j < nwords; j += (size_t)n) { const unsigned x = w[j]; bad |= ((x & 0x7f80u) == 0x7f80u) || ((x & 0x7f800000u) == 0x7f800000u); } out[i] = bad ? 1e6f : 0.f; return; }
#endif
#ifdef DUMP_MASKCHECK
    { out[i] = 0.f; if ((i & 1023) == 0) { const int t = i >> 10, sq = t & 4095; const unsigned long long* mt = (const unsigned long long*)w + ((size_t)(t >> 12) * 64) * 4096 + sq; int pc = 0; bool beyond = false;
        for (int j = 0; j < 64; ++j) { const unsigned long long m = mt[(size_t)j * 4096]; pc += __popcll(m); for (int bb = 0; bb < 64; ++bb) if (((m >> bb) & 1ull) && 64 * j + bb > sq) beyond = true; }
        const int expect = sq + 1 < 256 ? sq + 1 : 256;
#if DUMP_MASKCHECK == 1
        if (pc != expect) out[i] = 1e6f;
#else
        if (beyond) out[i] = 1e6f;
#endif
      } return; }
#endif
#ifdef DUMP_NANCHECK
#if DUMP_NANCHECK == 2
    { size_t wi = (size_t)i;
#ifdef DUMP_ROWW
      wi = ((size_t)i / DUMP_COLW) * DUMP_ROWW + ((size_t)i % DUMP_COLW);
#endif
      if (wi >= nwords) { out[i] = 0.f; return; } const unsigned x = w[wi]; const bool bad = ((x & 0x7f80u) == 0x7f80u) || ((x & 0x7f800000u) == 0x7f800000u);
#ifdef DUMP_LOC
      { const int sq = (int)(wi / 512) & 4095; out[i] = bad ? 1000.f * (float)(DUMP_LOC == 1 ? sq + 1 : 4096 - sq) : 0.f; return; }
#endif
      out[i] = bad ? 1e6f : 0.f; return; }
#else
    { const float v = ((const float*)w)[i]; out[i] = (v == v && fabsf(v) < 1e30f) ? 0.f : 1e6f; return; }
#endif
#endif
#ifdef DUMP_VIA_ROWOF
    unsigned h; { const unsigned short* src = (const unsigned short*)w; const int* rowof = (const int*)((const char*)w - (size_t)(DUMP_OFF) + WS_ROUTE) + 12 * T; const int t = i >> 10, c = i & 1023;
        h = 0u; for (int k = 0; k < 4; ++k) h = h * 0x9E3779B1u + src[(size_t)rowof[4 * t + k] * 1024 + c]; }
#elif defined(DUMP_ROWW)
    unsigned h = 0u; { const size_t row = (size_t)i / DUMP_COLW, cw = (size_t)i % DUMP_COLW; if (row * DUMP_ROWW + cw < nwords) h = w[row * DUMP_ROWW + cw]; }
#else
    unsigned h = 0u; int k = 1; for (size_t j = (size_t)i; j < nwords; j += (size_t)n, k += 2) h ^= w[j] * (unsigned)k;
#endif
    out[i] = (float)((h ^ (h >> 11) ^ (h >> 22)) & 0xFFFFFu);
}
#endif
#ifndef MK_ONE_LAUNCH
#define MK_ONE_LAUNCH 0
#endif
extern "C" void kernel_launch(void* const* d_in, const int* in_sizes, int n_in, void* d_out, int out_size, void* d_ws, size_t ws_size, hipStream_t stream) {
    static int grid = 0;
    if (grid == 0) {
        if (n_in != N_IN || in_sizes[0] != T * D || out_size != T * D || ws_size < WS_END) { fprintf(stderr, "kernel_launch: unexpected shapes (n_in %d, in0 %d, out %d, ws %zu, need %zu); nothing launched\n", n_in, n_in > 0 ? in_sizes[0] : -1, out_size, ws_size, (size_t)WS_END); grid = -1; return; }
        int dev = 0, cus = 0, per_cu = 0;
        if (hipGetDevice(&dev) != hipSuccess || hipDeviceGetAttribute(&cus, hipDeviceAttributeMultiprocessorCount, dev) != hipSuccess) { grid = -1; return; }
        if (hipFuncSetAttribute((const void*)fwd_kernel, hipFuncAttributeMaxDynamicSharedMemorySize, LDS_BYTES) != hipSuccess) { fprintf(stderr, "kernel_launch: hipFuncSetAttribute failed\n"); grid = -1; return; }
        if (hipOccupancyMaxActiveBlocksPerMultiprocessor(&per_cu, (const void*)fwd_kernel, NWAVES * 64, LDS_BYTES) != hipSuccess || per_cu < 1) fprintf(stderr, "kernel_launch: occupancy query reports %d\n", per_cu);
        (void)hipGetLastError();
        grid = cus;
        if (grid != 256) { fprintf(stderr, "kernel_launch: built for 256 CUs, found %d; nothing launched\n", cus); grid = -1; return; }
    }
    if (grid < 0) return;
    if (hipMemsetAsync((char*)d_ws + WS_CTL, 0, CTL_ZERO_BYTES, stream) != hipSuccess) return;
    Args a{};
    for (int i = 0; i < N_IN; ++i) a.in[i] = (const float*)d_in[i];
    a.out = (float*)d_out; a.ws = (unsigned char*)d_ws;
#if MK_ONE_LAUNCH
    a.ph_lo = 0; a.ph_hi = N_PHASES;
    hipLaunchKernelGGL(fwd_kernel, dim3(grid), dim3(NWAVES * 64), LDS_BYTES, stream, a);
#else
#ifdef DUMP_OFF
    for (int p = 0; p < DUMP_STOP; ++p) { a.ph_lo = p; a.ph_hi = p + 1; hipLaunchKernelGGL(fwd_kernel, dim3(grid), dim3(NWAVES * 64), LDS_BYTES, stream, a); }
    hipLaunchKernelGGL(dump_kernel, dim3((T * D + 255) / 256), dim3(256), 0, stream, (const unsigned*)((const char*)d_ws + (size_t)(DUMP_OFF)), (size_t)(DUMP_WORDS), (float*)d_out, T * D);
    return;
#endif
    for (int p = 0; p < N_PHASES; ++p) { a.ph_lo = p; a.ph_hi = p + 1; hipLaunchKernelGGL(fwd_kernel, dim3(grid), dim3(NWAVES * 64), LDS_BYTES, stream, a);
#ifdef DBL_PHASE
        if ((p == 0 && DBL_PHASE == 10) || (p > 0 && (p - 1) % PH_PER_LAYER == DBL_PHASE)) hipLaunchKernelGGL(fwd_kernel, dim3(grid), dim3(NWAVES * 64), LDS_BYTES, stream, a);
#endif
    }
#endif
}
```

```cpp
#include <hip/hip_runtime.h>
#include <cstdio>
#include <cstdint>

#define MK_ONE_LAUNCH 1
#define BAR_EARLY_INV 1
#ifndef WT_STORES
#define WT_STORES 0
#endif
__device__ __forceinline__ void st16_wt(void* p, unsigned x, unsigned y, unsigned z, unsigned w) {
    typedef unsigned u4_ __attribute__((ext_vector_type(4))); const u4_ v = {x, y, z, w};
#if WT_STORES
    asm volatile("global_store_dwordx4 %0, %1, off sc1\n\ts_nop 2" :: "v"((__attribute__((address_space(1))) void*)p), "v"(v) : "memory");
#else
    *(__attribute__((address_space(1))) u4_*)p = v;
#endif
}
__device__ __forceinline__ void st8_wt(void* p, unsigned x, unsigned y) {
    typedef unsigned u2_ __attribute__((ext_vector_type(2))); const u2_ v = {x, y};
#if WT_STORES
    asm volatile("global_store_dwordx2 %0, %1, off sc1" :: "v"((__attribute__((address_space(1))) void*)p), "v"(v) : "memory");
#else
    *(__attribute__((address_space(1))) u2_*)p = v;
#endif
}
namespace pg8 {
#define PG8_LAS __attribute__((address_space(3)))
typedef unsigned short bf16_t;
typedef short bf16x8 __attribute__((ext_vector_type(8)));
typedef float f32x4 __attribute__((ext_vector_type(4)));
typedef unsigned u32x4 __attribute__((ext_vector_type(4)));
typedef int v4i_t __attribute__((ext_vector_type(4)));
typedef int v8i_t __attribute__((ext_vector_type(8)));
constexpr int BM = 256, BK = 64, HALF = 128, HTB = HALF * BK * 2  , STAGE_BYTES = 8 * HTB, NXCD = 8, WGM = 8;

__host__ __device__ __forceinline__ int lds_byte(int r, int c) { const int st = (r >> 4) * 2 + (c >> 5), rr = r & 15, cc = c & 31, ob = rr * 64 + cc * 2; return st * 1024 + (ob ^ (((ob >> 9) & 1) << 5)); }
__host__ __device__ __forceinline__ void stage_rc(int b, int& R, int& C) { const int st = b / 1024, sb = b % 1024, swz = sb ^ (((sb >> 9) & 1) << 5); R = (st >> 1) * 16 + swz / 64; C = (st & 1) * 32 + (swz % 64) / 2; }
__host__ __device__ __forceinline__ int perm32(int rho) { const int n = rho >> 4, i = rho & 15; return 8 * (i >> 2) + 4 * n + (i & 3); }

struct Unit { int pm, pn; };
struct Gemm { const bf16_t* A; const bf16_t* Bt; int M, N, K; };

struct StaticOrder {
    int nM, nN, nwg, G, c;
    __host__ __device__ void init(int M, int N, int G_, int c_) { nM = M / BM; nN = N / BM; nwg = nM * nN; G = G_; c = c_; }
    __host__ __device__ bool next(int i, Unit& u) const {
        const long L = (long)i * G + c; if (L >= nwg) return false;
        int wgid = (int)L; { const int q = nwg / NXCD, r = nwg % NXCD, xcd = wgid % NXCD, off = wgid / NXCD; wgid = (xcd < r ? xcd * (q + 1) : r * (q + 1) + (xcd - r) * q) + off; }
        const int nig = WGM * nN, gid = wgid / nig, fm = gid * WGM, gsz = (nM - fm) < WGM ? (nM - fm) : WGM;
        u.pm = fm + ((wgid % nig) % gsz); u.pn = (wgid % nig) / gsz; return true;
    }
    __device__ __forceinline__ void a_ready(const Unit&) const {}
    __device__ __forceinline__ void done(const Unit&) const {}
};

__device__ __forceinline__ unsigned cvt_pk_bf16(float lo, float hi) { unsigned r; asm volatile("v_cvt_pk_bf16_f32 %0, %1, %2" : "=v"(r) : "v"(lo), "v"(hi)); return r; }
typedef float f32x2 __attribute__((ext_vector_type(2)));
__device__ __forceinline__ f32x2 gelu_pk(f32x2 v) {
    const f32x2 av = __builtin_elementwise_abs(v), d = av * 0.2316418882f + 1.0f;
    f32x2 t; t.x = __builtin_amdgcn_rcpf(d.x); t.y = __builtin_amdgcn_rcpf(d.y);
    f32x2 q = t * 0.5307027145f + (-0.7265760135f); q = q * t + 0.7107068705f; q = q * t + (-0.142248368f); q = q * t + 0.127414796f; q = q * t;
    const f32x2 s = (v * v) * (-0.72134752044f);
    f32x2 e; e.x = __builtin_amdgcn_exp2f(s.x); e.y = __builtin_amdgcn_exp2f(s.y);
    const f32x2 m = v * (q * e), r = v - m;
    f32x2 o; o.x = v.x < 0.f ? m.x : r.x; o.y = v.y < 0.f ? m.y : r.y; return o;
}

template <int ACT  > struct EpiBf16 {
    static constexpr bool PERM = true, AFTER_DRAIN = false; static_assert(ACT == 0 || ACT == 1, "EpiBf16: ACT is 0 (none) or 1 (gelu_pk)");
    bf16_t* O; int ldc; const float* bias; int split_cols; size_t split_stride; float scale0;
    __device__ __forceinline__ void operator()(const f32x4 (&acc)[2][2][4][2], const Unit& u, int wr, int wc, int fr, int fq) const {
        const int row0 = u.pm * BM + wr * 64 + fr; int colt = u.pn * BM; bf16_t* base = O;
        float sc = 1.f; if (split_cols) { const int t = colt / split_cols; base += (size_t)t * split_stride; colt -= t * split_cols; if (t == 0) sc = scale0; }
        const int col0 = colt + wc * 32 + 8 * fq, bcol0 = u.pn * BM + wc * 32 + 8 * fq;
        f32x4 bv[2][2];
#pragma unroll
        for (int bj = 0; bj < 2; ++bj)
#pragma unroll
            for (int n = 0; n < 2; ++n) bv[bj][n] = bias ? *(const __attribute__((address_space(1))) f32x4*)(bias + bcol0 + bj * HALF + 4 * n) : (f32x4){0.f, 0.f, 0.f, 0.f};
#pragma unroll
        for (int ai = 0; ai < 2; ++ai)
#pragma unroll
            for (int m = 0; m < 4; ++m) { bf16_t* rowp = base + (size_t)(row0 + ai * HALF + m * 16) * ldc + col0;
#pragma unroll
                for (int bj = 0; bj < 2; ++bj) { f32x4 v0 = acc[ai][bj][m][0] + bv[bj][0], v1 = acc[ai][bj][m][1] + bv[bj][1];
                    if (ACT == 1) { f32x2 a = gelu_pk((f32x2){v0[0], v0[1]}), b = gelu_pk((f32x2){v0[2], v0[3]}), c = gelu_pk((f32x2){v1[0], v1[1]}), d = gelu_pk((f32x2){v1[2], v1[3]});
                        v0 = (f32x4){a.x, a.y, b.x, b.y}; v1 = (f32x4){c.x, c.y, d.x, d.y}; }
                    v0 = v0 * sc; v1 = v1 * sc; u32x4 w; w.x = cvt_pk_bf16(v0[0], v0[1]); w.y = cvt_pk_bf16(v0[2], v0[3]); w.z = cvt_pk_bf16(v1[0], v1[1]); w.w = cvt_pk_bf16(v1[2], v1[3]);
                    st16_wt(rowp + bj * HALF, w.x, w.y, w.z, w.w); } }
    }
};

struct PanelStats {
    unsigned* xbuf;
    unsigned* cnt;
    unsigned* tmo;
    int ntn; float eps;
    unsigned code;
    __device__ __forceinline__ bool run(const f32x4 (&v)[2][2][4][2], const Unit& u, int wr, int wc, int fr, int fq, PG8_LAS unsigned char* lds, int wid, int lane) const {
        typedef float f32x2v __attribute__((ext_vector_type(2)));
        PG8_LAS f32x2v* P = (PG8_LAS f32x2v*)lds;
        PG8_LAS f32x2v* S = (PG8_LAS f32x2v*)(lds + 8192);
        PG8_LAS unsigned* flag = (PG8_LAS unsigned*)(lds + 8192 + 2048);
#pragma unroll
        for (int ai = 0; ai < 2; ++ai)
#pragma unroll
            for (int m = 0; m < 4; ++m) {
                float s = 0.f;
#pragma unroll
                for (int bj = 0; bj < 2; ++bj)
#pragma unroll
                    for (int n = 0; n < 2; ++n) { const f32x4 x = v[ai][bj][m][n]; s += (x[0] + x[1]) + (x[2] + x[3]); }
                s += __shfl_xor(s, 16); s += __shfl_xor(s, 32);
                const float mw = s * (1.0f / 64.0f); float q = 0.f;
#pragma unroll
                for (int bj = 0; bj < 2; ++bj)
#pragma unroll
                    for (int n = 0; n < 2; ++n) { const f32x4 d = v[ai][bj][m][n] - mw; q += (d[0] * d[0] + d[1] * d[1]) + (d[2] * d[2] + d[3] * d[3]); }
                q += __shfl_xor(q, 16); q += __shfl_xor(q, 32);
                if (fq == 0) P[(ai * HALF + wr * 64 + m * 16 + fr) * 4 + wc] = (f32x2v){mw, q};
            }
        asm volatile("s_waitcnt lgkmcnt(0)" ::: "memory"); __builtin_amdgcn_s_barrier(); asm volatile("" ::: "memory");
#if defined(BROKEN_EXCHANGE_NO_WAIT)
#warning BROKEN CONTROL BUILD: the row-statistics exchange does not wait; results are wrong by design
        if (blockIdx.x >= 64) { const long long t0_ = clock64(); while (clock64() - t0_ < 60000) __builtin_amdgcn_s_sleep(8); }
#endif
        const int row = wid * 32 + (lane & 31);
        if (lane < 32) {
            const f32x2v a = P[row * 4 + 0], b = P[row * 4 + 1], c = P[row * 4 + 2], d = P[row * 4 + 3];
            const float mt = (a.x + b.x + c.x + d.x) * 0.25f;
            const float da = a.x - mt, db = b.x - mt, dc = c.x - mt, dd = d.x - mt;
            const float m2 = (a.y + b.y) + (c.y + d.y) + 64.0f * ((da * da + db * db) + (dc * dc + dd * dd));
            unsigned long long* slot = (unsigned long long*)xbuf + ((size_t)(u.pm * BM + row) * 4 + u.pn);
            __hip_atomic_store(slot, ((unsigned long long)__float_as_uint(m2) << 32) | __float_as_uint(mt), __ATOMIC_RELAXED, __HIP_MEMORY_SCOPE_AGENT);
        }
        asm volatile("s_waitcnt vmcnt(0)" ::: "memory");
        if (lane == 0) __hip_atomic_fetch_add(cnt + 64 * u.pm, 1u, __ATOMIC_RELAXED, __HIP_MEMORY_SCOPE_AGENT);
        if (wid == 0) {
            bool dead = false; const unsigned long long t0 = __builtin_amdgcn_s_memrealtime(); const unsigned want = 8u * (unsigned)ntn;
            for (;;) {
#if defined(BROKEN_EXCHANGE_NO_WAIT)
                break;
#endif
                if ((unsigned)__builtin_amdgcn_readfirstlane(__hip_atomic_load(cnt + 64 * u.pm, __ATOMIC_RELAXED, __HIP_MEMORY_SCOPE_AGENT)) >= want) break;
                if (__builtin_amdgcn_s_memrealtime() - t0 > 2000000ull) {
                    if (lane == 0) { unsigned expect = 0u; __hip_atomic_compare_exchange_strong(tmo + 1, &expect, code | (unsigned)(u.pm & 0xff), __ATOMIC_RELAXED, __ATOMIC_RELAXED, __HIP_MEMORY_SCOPE_AGENT);
                                     __hip_atomic_store(tmo, 1u, __ATOMIC_RELAXED, __HIP_MEMORY_SCOPE_AGENT); }
                    dead = true; break; }
                __builtin_amdgcn_s_sleep(2);
            }
            __builtin_amdgcn_fence(__ATOMIC_ACQUIRE, "agent");
            if (lane == 0) flag[0] = dead ? 1u : 0u;
        }
        asm volatile("s_waitcnt vmcnt(0) lgkmcnt(0)" ::: "memory"); __builtin_amdgcn_s_barrier(); asm volatile("" ::: "memory");
        const bool bad = flag[0] != 0u;
        if (lane < 32) {
            const unsigned long long* slot = (const unsigned long long*)xbuf + (size_t)(u.pm * BM + row) * 4; float mt[4], m2[4]; float ms = 0.f;
#pragma unroll
            for (int t = 0; t < 4; ++t) { if (t < ntn) { const unsigned long long w = __hip_atomic_load(slot + t, __ATOMIC_RELAXED, __HIP_MEMORY_SCOPE_AGENT); mt[t] = __uint_as_float((unsigned)w); m2[t] = __uint_as_float((unsigned)(w >> 32)); } else { mt[t] = 0.f; m2[t] = 0.f; } ms += mt[t]; }
            const float mean = ms / (float)ntn; float q = 0.f;
#pragma unroll
            for (int t = 0; t < 4; ++t) if (t < ntn) { const float dm = mt[t] - mean; q += m2[t] + 256.0f * dm * dm; }
            S[row] = (f32x2v){mean, 1.0f / sqrtf(q / (256.0f * (float)ntn) + eps)};
        }
        asm volatile("s_waitcnt lgkmcnt(0)" ::: "memory"); __builtin_amdgcn_s_barrier(); asm volatile("" ::: "memory");
        return bad;
    }
};
struct EpiLnRes {
    static constexpr bool PERM = false, AFTER_DRAIN = true;
    const float* base; float* out; int ldc; const float* bias; PanelStats st; unsigned poison;
    __device__ __forceinline__ void fused(f32x4 (&acc)[2][2][4][2], const Unit& u, int wr, int wc, int fr, int fq, PG8_LAS unsigned char* lds, int wid, int lane) const {
        typedef float f32x2v __attribute__((ext_vector_type(2)));
        const PG8_LAS f32x2v* S = (const PG8_LAS f32x2v*)(lds + 8192);
        const int col0 = u.pn * BM + wc * 32 + 4 * fq;
#pragma unroll
        for (int bj = 0; bj < 2; ++bj)
#pragma unroll
            for (int n = 0; n < 2; ++n) { const f32x4 bv = bias ? *(const f32x4*)(bias + col0 + bj * HALF + n * 16) : (f32x4){0.f, 0.f, 0.f, 0.f};
#pragma unroll
                for (int ai = 0; ai < 2; ++ai)
#pragma unroll
                    for (int m = 0; m < 4; ++m) acc[ai][bj][m][n] += bv; }
        f32x4 pre[4][2][2];
#pragma unroll
        for (int m = 0; m < 4; ++m) { const size_t off = (size_t)(u.pm * BM + wr * 64 + m * 16 + fr) * ldc + col0;
#pragma unroll
            for (int bj = 0; bj < 2; ++bj)
#pragma unroll
                for (int n = 0; n < 2; ++n) pre[m][bj][n] = *(const f32x4*)(base + off + bj * HALF + n * 16); }
        const bool bad = st.run(acc, u, wr, wc, fr, fq, lds, wid, lane) || poison != 0u;
        const float qnan = __builtin_nanf("");
#pragma unroll
        for (int ai = 0; ai < 2; ++ai)
#pragma unroll
            for (int m = 0; m < 4; ++m) { const int r = ai * HALF + wr * 64 + m * 16 + fr; const f32x2v sr = S[r]; const size_t off = (size_t)(u.pm * BM + r) * ldc + col0;
#pragma unroll
                for (int bj = 0; bj < 2; ++bj)
#pragma unroll
                    for (int n = 0; n < 2; ++n) { const f32x4 bs = ai == 0 ? pre[m][bj][n] : *(const f32x4*)(base + off + bj * HALF + n * 16); f32x4 o = bs + (acc[ai][bj][m][n] - sr.x) * sr.y;
                        if (bad) o = (f32x4){qnan, qnan, qnan, qnan}; *(f32x4*)(out + off + bj * HALF + n * 16) = o; }
                if (m & 1) asm volatile("" ::: "memory"); }
    }
};
struct EpiLnResLn {
    static constexpr bool PERM = false, AFTER_DRAIN = true;
    const float* base; float* out; bf16_t* xn; int ldc; const float* bias; PanelStats st1, st2; unsigned poison;
    __device__ __forceinline__ void fused(f32x4 (&acc)[2][2][4][2], const Unit& u, int wr, int wc, int fr, int fq, PG8_LAS unsigned char* lds, int wid, int lane) const {
        typedef float f32x2v __attribute__((ext_vector_type(2))); typedef unsigned u32x2v __attribute__((ext_vector_type(2)));
        const PG8_LAS f32x2v* S = (const PG8_LAS f32x2v*)(lds + 8192);
        const int col0 = u.pn * BM + wc * 32 + 4 * fq;
#pragma unroll
        for (int bj = 0; bj < 2; ++bj)
#pragma unroll
            for (int n = 0; n < 2; ++n) { const f32x4 bv = bias ? *(const f32x4*)(bias + col0 + bj * HALF + n * 16) : (f32x4){0.f, 0.f, 0.f, 0.f};
#pragma unroll
                for (int ai = 0; ai < 2; ++ai)
#pragma unroll
                    for (int m = 0; m < 4; ++m) acc[ai][bj][m][n] += bv; }
        bool bad = st1.run(acc, u, wr, wc, fr, fq, lds, wid, lane) || poison != 0u;
        const float qnan = __builtin_nanf("");
#pragma unroll
        for (int ai = 0; ai < 2; ++ai)
#pragma unroll
            for (int m = 0; m < 4; ++m) { const int r = ai * HALF + wr * 64 + m * 16 + fr; const f32x2v sr = S[r]; const size_t off = (size_t)(u.pm * BM + r) * ldc + col0;
#pragma unroll
                for (int bj = 0; bj < 2; ++bj)
#pragma unroll
                    for (int n = 0; n < 2; ++n) { const f32x4 bs = *(const f32x4*)(base + off + bj * HALF + n * 16); acc[ai][bj][m][n] = bs + (acc[ai][bj][m][n] - sr.x) * sr.y; }
                asm volatile("" : "+v"(acc[ai][0][m][0]), "+v"(acc[ai][0][m][1]), "+v"(acc[ai][1][m][0]), "+v"(acc[ai][1][m][1]));
                if (m & 1) asm volatile("" ::: "memory"); }
        const bool bad1 = bad;
        bad = st2.run(acc, u, wr, wc, fr, fq, lds, wid, lane) || bad;
#pragma unroll
        for (int ai = 0; ai < 2; ++ai)
#pragma unroll
            for (int m = 0; m < 4; ++m) { const int r = ai * HALF + wr * 64 + m * 16 + fr; const f32x2v sr = S[r]; const size_t off = (size_t)(u.pm * BM + r) * ldc + col0;
#pragma unroll
                for (int bj = 0; bj < 2; ++bj)
#pragma unroll
                    for (int n = 0; n < 2; ++n) { const f32x4 x1 = acc[ai][bj][m][n]; *(f32x4*)(out + off + bj * HALF + n * 16) = bad1 ? (f32x4){qnan, qnan, qnan, qnan} : x1;
                        const f32x4 o = (x1 - sr.x) * sr.y; u32x2v w; w.x = cvt_pk_bf16(o[0], o[1]); w.y = cvt_pk_bf16(o[2], o[3]);
                        if (bad) { w.x = 0x7fc07fc0u; w.y = 0x7fc07fc0u; } *(u32x2v*)(xn + off + bj * HALF + n * 16) = w; }
                asm volatile("" ::: "memory"); }
    }
};

__device__ __forceinline__ void glds_saddr(unsigned voff, const char* sbase, unsigned lds_dst) { unsigned keep;
    asm volatile("s_mov_b32 %0, m0\n\ts_mov_b32 m0, %3\n\ts_nop 0\n\tglobal_load_lds_dwordx4 %1, %2\n\ts_mov_b32 m0, %0" : "=&s"(keep) : "v"(voff), "s"(sbase), "s"(lds_dst) : "memory"); }
template <class Epi, class Sched, bool ALIGN_EPI = false, bool SP2 = false, int EB = 2, bool GATHER = false>
__device__ __forceinline__ void gemm_phase(PG8_LAS unsigned char* lds, const Gemm g, const Sched& S, const Epi& E, const int* rowtok = nullptr) {
    static_assert(!GATHER || (EB == 1 && SP2), "gathered A rows: fp8 path (SGPR-base staging) with the two-super-phase loop only");
    const int tid = threadIdx.x, wid = __builtin_amdgcn_readfirstlane(tid >> 6), lane = tid & 63, wr = wid >> 2, wc = wid & 3, fr = lane & 15, fq = lane >> 4;
    const int K = g.K, nt = K * EB / (BK * 2);
    unsigned voffA[2], voffB[2]; int gR[2]; unsigned gC[2];
#pragma unroll
    for (int i = 0; i < 2; ++i) { int R, C; stage_rc(tid * 16 + i * 8192, R, C); const int Rb = Epi::PERM ? ((R & ~31) + perm32(R & 31)) : R;
        voffA[i] = (unsigned)(R * K * EB + C * 2); voffB[i] = (unsigned)(Rb * K * EB + C * 2); gR[i] = R; gC[i] = (unsigned)(C * 2); }
    const size_t kstep = (size_t)(BK * 2);
    const size_t hstep = (size_t)HALF * K * EB;
    const size_t tstep = 2 * hstep;
    const unsigned ldsw = (unsigned)wid * 1024u; const unsigned lds0 = (unsigned)(uintptr_t)lds;
    const int aoff = lds_byte(wr * 64 + fr, fq * 8), boff = lds_byte(wc * 32 + fr, fq * 8);
#define PG8_SA(b, h) (((b) * 2 + (h)) * HTB)
#define PG8_SB(b, h) ((4 + (b) * 2 + (h)) * HTB)
#define PG8_STAGE(bufoff, gbase, voff) do { if constexpr (EB == 2) { _Pragma("unroll") for (int _i = 0; _i < 2; ++_i) \
        __builtin_amdgcn_global_load_lds((const unsigned*)((const char*)(gbase) + (voff)[_i]), (PG8_LAS unsigned*)(lds + (bufoff) + ldsw + _i * 8192), 16, 0, 0); } \
        else { _Pragma("unroll") for (int _i = 0; _i < 2; ++_i) glds_saddr((voff)[_i], (const char*)(gbase), (unsigned)__builtin_amdgcn_readfirstlane((int)(lds0 + (unsigned)(bufoff) + ldsw + (unsigned)(_i * 8192)))); } } while (0)
#define PG8_GLOAD(vo, u) do { _Pragma("unroll") for (int _h = 0; _h < 2; ++_h) _Pragma("unroll") for (int _i = 0; _i < 2; ++_i) vo[_h][_i] = (unsigned)rowtok[(size_t)(u).pm * BM + _h * HALF + gR[_i]] * (unsigned)(K * EB) + gC[_i]; } while (0)
#define PG8_STAGE_A(bufoff, pplain, kofs, h, VS) do { if constexpr (!GATHER) { PG8_STAGE(bufoff, pplain, voffA); } else { _Pragma("unroll") for (int _i = 0; _i < 2; ++_i) \
        glds_saddr(VS[h][_i], (const char*)g.A + (kofs), (unsigned)__builtin_amdgcn_readfirstlane((int)(lds0 + (unsigned)(bufoff) + ldsw + (unsigned)(_i * 8192)))); } } while (0)
#define PG8_LD8(p) __builtin_shufflevector(*(const PG8_LAS v4i_t*)(p), *(const PG8_LAS v4i_t*)((p) + 1024), 0, 1, 2, 3, 4, 5, 6, 7)
#define PG8_LDA(dst, b, h) do { if constexpr (EB == 2) { _Pragma("unroll") for (int m = 0; m < 4; ++m) _Pragma("unroll") for (int k = 0; k < 2; ++k) dst[m][k] = *(const PG8_LAS bf16x8*)(lds + PG8_SA(b, h) + aoff + m * 2048 + k * 1024); } \
        else { _Pragma("unroll") for (int m = 0; m < 4; ++m) dst##8[m] = PG8_LD8(lds + PG8_SA(b, h) + aoff + m * 2048); } } while (0)
#define PG8_LDB(dst, b, h) do { if constexpr (EB == 2) { _Pragma("unroll") for (int n = 0; n < 2; ++n) _Pragma("unroll") for (int k = 0; k < 2; ++k) dst[n][k] = *(const PG8_LAS bf16x8*)(lds + PG8_SB(b, h) + boff + n * 2048 + k * 1024); } \
        else { _Pragma("unroll") for (int n = 0; n < 2; ++n) dst##8[n] = PG8_LD8(lds + PG8_SB(b, h) + boff + n * 2048); } } while (0)
#define PG8_CAT8(x, y) __builtin_shufflevector(__builtin_bit_cast(v4i_t, x), __builtin_bit_cast(v4i_t, y), 0, 1, 2, 3, 4, 5, 6, 7)
#define PG8_MMA(ai, bj, At, Bt) do { __builtin_amdgcn_s_setprio(1); if constexpr (EB == 2) { _Pragma("unroll") for (int m = 0; m < 4; ++m) _Pragma("unroll") for (int n = 0; n < 2; ++n) _Pragma("unroll") for (int k = 0; k < 2; ++k) \
        acc[ai][bj][m][n] = __builtin_amdgcn_mfma_f32_16x16x32_bf16(Bt[n][k], At[m][k], acc[ai][bj][m][n], 0, 0, 0); } else { _Pragma("unroll") for (int m = 0; m < 4; ++m) _Pragma("unroll") for (int n = 0; n < 2; ++n) \
        asm volatile("v_mfma_scale_f32_16x16x128_f8f6f4 %0, %1, %2, %0, %3, %3 op_sel_hi:[0,0,0]" : "+v"(acc[ai][bj][m][n]) : "v"(Bt##8[n]), "v"(At##8[m]), "v"(mx_one)); }     __builtin_amdgcn_s_setprio(0); } while (0)
#define PG8_WAIT_V(n) asm volatile("s_waitcnt vmcnt(" #n ")" ::: "memory")
#define PG8_WAIT_L(n) asm volatile("s_waitcnt lgkmcnt(" #n ")" ::: "memory")
#define PG8_BAR __builtin_amdgcn_s_barrier()
#define PG8_SCHED __builtin_amdgcn_sched_barrier(0)
    Unit cur, nxt; int ui = 0;
    if (!S.next(0, cur)) return;
    f32x4 acc[2][2][4][2];
#pragma unroll
    for (int a = 0; a < 2; ++a)
#pragma unroll
        for (int b = 0; b < 2; ++b)
#pragma unroll
            for (int m = 0; m < 4; ++m)
#pragma unroll
                for (int n = 0; n < 2; ++n) acc[a][b][m][n] = (f32x4){0.f, 0.f, 0.f, 0.f};
    const int mx_one = 0x7f7f7f7f;
    bf16x8 At[4][2], B0[2][2], B1[2][2]; v8i_t At8[4], B08[2], B18[2];
    const char* cA = (const char*)g.A + (size_t)cur.pm * tstep; const char* cB = (const char*)g.Bt + (size_t)cur.pn * tstep;
    S.a_ready(cur);
    unsigned voffC[2][2], voffN[2][2];
    if constexpr (GATHER) PG8_GLOAD(voffC, cur);
    if constexpr (SP2) {
        PG8_STAGE(PG8_SB(0, 0), cB, voffB); PG8_STAGE(PG8_SB(0, 1), cB + hstep, voffB); PG8_STAGE_A(PG8_SA(0, 0), cA, 0, 0, voffC); PG8_STAGE_A(PG8_SA(0, 1), cA + hstep, 0, 1, voffC);
        if (wr == 1) PG8_BAR;
        PG8_WAIT_V(2); PG8_BAR;
        PG8_STAGE(PG8_SB(1, 0), cB + kstep, voffB); PG8_STAGE_A(PG8_SA(1, 0), cA + kstep, kstep, 0, voffC); PG8_STAGE(PG8_SB(1, 1), cB + hstep + kstep, voffB);
        PG8_WAIT_V(6); PG8_BAR;
    } else {
        PG8_STAGE(PG8_SB(0, 0), cB, voffB); PG8_STAGE(PG8_SA(0, 0), cA, voffA); PG8_STAGE(PG8_SB(0, 1), cB + hstep, voffB); PG8_STAGE(PG8_SA(0, 1), cA + hstep, voffA);
        if (wr == 1) PG8_BAR;
        PG8_WAIT_V(4); PG8_BAR;
        PG8_STAGE(PG8_SB(1, 0), cB + kstep, voffB); PG8_STAGE(PG8_SA(1, 0), cA + kstep, voffA); PG8_STAGE(PG8_SB(1, 1), cB + hstep + kstep, voffB);
        PG8_WAIT_V(6); PG8_BAR;
    }
    for (;;) {
        const bool has_next = S.next(ui + 1, nxt);
        if constexpr (GATHER) { if (has_next) PG8_GLOAD(voffN, nxt); else { _Pragma("unroll") for (int _h = 0; _h < 2; ++_h) _Pragma("unroll") for (int _i = 0; _i < 2; ++_i) voffN[_h][_i] = voffC[_h][_i]; } }
        const char* nA = has_next ? (const char*)g.A + (size_t)nxt.pm * tstep : cA; const char* nB = has_next ? (const char*)g.Bt + (size_t)nxt.pn * tstep : cB;
#pragma nounroll
        for (int t = 0; t < nt; t += 2) {
            const bool last = (t == nt - 2);
            const char* a1 = cA + (size_t)(t + 1) * kstep;
            const char* a2 = last ? nA : cA + (size_t)(t + 2) * kstep; const char* b2 = last ? nB : cB + (size_t)(t + 2) * kstep;
            const char* a3 = a2 + kstep; const char* b3 = b2 + kstep;
            const size_t k2 = last ? (size_t)0 : (size_t)(t + 2) * kstep; unsigned voffS[2][2];
            if constexpr (GATHER) { _Pragma("unroll") for (int _h = 0; _h < 2; ++_h) _Pragma("unroll") for (int _i = 0; _i < 2; ++_i) voffS[_h][_i] = last ? voffN[_h][_i] : voffC[_h][_i]; }
            if (last && has_next) S.a_ready(nxt);
            if constexpr (SP2) {
            PG8_LDB(B0, 0, 0); PG8_LDB(B1, 0, 1); PG8_SCHED; PG8_LDA(At, 0, 0); PG8_STAGE_A(PG8_SA(1, 1), a1 + hstep, (size_t)(t + 1) * kstep, 1, voffC);
            PG8_WAIT_V(8); PG8_WAIT_L(0); PG8_BAR; PG8_MMA(0, 0, At, B0); PG8_MMA(0, 1, At, B1); PG8_BAR; PG8_SCHED;
            PG8_LDA(At, 0, 1); PG8_STAGE(PG8_SB(0, 0), b2, voffB); PG8_STAGE(PG8_SB(0, 1), b2 + hstep, voffB); PG8_STAGE_A(PG8_SA(0, 0), a2, k2, 0, voffS);
            PG8_WAIT_V(8); PG8_WAIT_L(0); PG8_BAR; PG8_MMA(1, 0, At, B0); PG8_MMA(1, 1, At, B1); PG8_BAR; PG8_SCHED;
            PG8_LDB(B0, 1, 0); PG8_LDB(B1, 1, 1); PG8_SCHED; PG8_LDA(At, 1, 0); PG8_STAGE_A(PG8_SA(0, 1), a2 + hstep, k2, 1, voffS);
            PG8_WAIT_V(8); PG8_WAIT_L(0); PG8_BAR; PG8_MMA(0, 0, At, B0); PG8_MMA(0, 1, At, B1); PG8_BAR; PG8_SCHED;
            PG8_LDA(At, 1, 1); PG8_STAGE(PG8_SB(1, 0), b3, voffB); PG8_STAGE(PG8_SB(1, 1), b3 + hstep, voffB); PG8_STAGE_A(PG8_SA(1, 0), a3, k2 + kstep, 0, voffS);
            PG8_WAIT_V(8); PG8_WAIT_L(0); PG8_BAR; PG8_MMA(1, 0, At, B0); PG8_MMA(1, 1, At, B1); PG8_BAR; PG8_SCHED;
            } else {
            PG8_LDB(B0, 0, 0); PG8_SCHED; PG8_LDA(At, 0, 0); PG8_STAGE(PG8_SA(1, 1), a1 + hstep, voffA);
            PG8_WAIT_L(8); PG8_BAR; PG8_WAIT_L(0); PG8_MMA(0, 0, At, B0); PG8_BAR; PG8_SCHED;
            PG8_LDB(B1, 0, 1); PG8_STAGE(PG8_SB(0, 0), b2, voffB);
            PG8_BAR; PG8_WAIT_L(0); PG8_MMA(0, 1, At, B1); PG8_BAR;
            PG8_LDA(At, 0, 1); PG8_STAGE(PG8_SA(0, 0), a2, voffA);
            PG8_BAR; PG8_WAIT_L(0); PG8_MMA(1, 0, At, B0); PG8_BAR; PG8_SCHED;
            PG8_STAGE(PG8_SB(0, 1), b2 + hstep, voffB);
            PG8_WAIT_V(6); PG8_BAR; PG8_MMA(1, 1, At, B1); PG8_BAR;
            PG8_LDB(B0, 1, 0); PG8_SCHED; PG8_LDA(At, 1, 0); PG8_STAGE(PG8_SA(0, 1), a2 + hstep, voffA);
            PG8_WAIT_L(8); PG8_BAR; PG8_WAIT_L(0); PG8_MMA(0, 0, At, B0); PG8_BAR; PG8_SCHED;
            PG8_LDB(B1, 1, 1); PG8_STAGE(PG8_SB(1, 0), b3, voffB);
            PG8_BAR; PG8_WAIT_L(0); PG8_MMA(0, 1, At, B1); PG8_BAR;
            PG8_LDA(At, 1, 1); PG8_STAGE(PG8_SA(1, 0), a3, voffA);
            PG8_BAR; PG8_WAIT_L(0); PG8_MMA(1, 0, At, B0); PG8_BAR; PG8_SCHED;
            PG8_STAGE(PG8_SB(1, 1), b3 + hstep, voffB);
            PG8_WAIT_V(6); PG8_BAR; PG8_MMA(1, 1, At, B1); PG8_BAR;
            }
        }
        if constexpr (ALIGN_EPI) { if (wr == 0) PG8_BAR; }
        if constexpr (EB == 1) asm volatile("s_nop 15\n\ts_nop 15" ::: "memory");
        if constexpr (!Epi::AFTER_DRAIN) { E(acc, cur, wr, wc, fr, fq); S.done(cur); }
        if (!has_next) break;
#pragma unroll
        for (int a = 0; a < 2; ++a)
#pragma unroll
            for (int b = 0; b < 2; ++b)
#pragma unroll
                for (int m = 0; m < 4; ++m)
#pragma unroll
                    for (int n = 0; n < 2; ++n) acc[a][b][m][n] = (f32x4){0.f, 0.f, 0.f, 0.f};
        cur = nxt; cA = nA; cB = nB; ++ui;
        if constexpr (GATHER) { _Pragma("unroll") for (int _h = 0; _h < 2; ++_h) _Pragma("unroll") for (int _i = 0; _i < 2; ++_i) voffC[_h][_i] = voffN[_h][_i]; }
        if constexpr (ALIGN_EPI) { if (wr == 1) PG8_BAR; }
    }
    PG8_WAIT_V(0);
    if constexpr (!ALIGN_EPI) { if (wr == 0) PG8_BAR; }
    PG8_BAR;
    if constexpr (Epi::AFTER_DRAIN) { E.fused(acc, cur, wr, wc, fr, fq, lds, wid, lane); S.done(cur); }
#undef PG8_SA
#undef PG8_SB
#undef PG8_STAGE
#undef PG8_LDA
#undef PG8_GLOAD
#undef PG8_STAGE_A
#undef PG8_LD8
#undef PG8_LDB
#undef PG8_MMA
#undef PG8_CAT8
#undef PG8_WAIT_V
#undef PG8_WAIT_L
#undef PG8_BAR
#undef PG8_SCHED
}
}
#ifndef PG8_SP2
#define PG8_SP2 true
#endif
#ifndef MOE_SP2
#define MOE_SP2 true
#endif
#ifndef PG8_ALIGN
#define PG8_ALIGN true
#endif
constexpr int NWAVES = 8;
constexpr int NB = 4, SEQ = 4096, T = NB * SEQ, D = 1024, NIN = 2856, NINP = 3072, NE = 32, DEPTH = 2;
constexpr int C_H = 0, C_GB = 256, C_GC = 512, C_P = 768, C_Q = 1024, C_K = 1536, C_V = 2048, C_QI = 2560, C_KI = 2816, C_WI = 2848;
constexpr int NSEL = 256;
#ifndef SEL_CAND_CAP
#define SEL_CAND_CAP 64
#endif
constexpr int MAXROWS = 4 * T + NE * 256;
constexpr float ATT_C2 = 0.125f * 1.4426950408889634f;
constexpr float LN_EPS = 1e-5f, DN_ALPHA = 1.41421356237309515f;
enum { IN_X = 0, IN_WIN, IN_CONVW, IN_WPOOL, IN_PSCALE, IN_KNG, IN_KNB, IN_WOUT, IN_LN1G, IN_LN1B, IN_RW, IN_RB, IN_WGU, IN_BGU, IN_WDN, IN_BDN, IN_LN2G, IN_LN2B, N_IN };

constexpr size_t MiB = 1u << 20;
constexpr size_t WS_CTL = 0, CTL_ZERO_BYTES = 1 * MiB;
constexpr size_t WS_WIN = 2 * MiB;
constexpr size_t WS_WOUT = 14 * MiB;
constexpr size_t WS_WGU = 18 * MiB;
constexpr size_t WS_WDN = 274 * MiB;
constexpr size_t WS_XB = 402 * MiB;
constexpr size_t WS_XF = 434 * MiB;
constexpr size_t WS_Y1 = 498 * MiB;
constexpr size_t WS_PROJ = 562 * MiB;
constexpr size_t WS_CAT = 658 * MiB;
constexpr size_t WS_KIN = 690 * MiB;
constexpr size_t WS_MASK = 691 * MiB;
constexpr size_t WS_ROUTE = 699 * MiB;
constexpr size_t WS_CNTW = 699 * MiB + 256 * 1024;
constexpr size_t WS_SC = 700 * MiB;
constexpr size_t WS_XS = 956 * MiB;
constexpr size_t WS_ACT = 1100 * MiB;
constexpr size_t WS_YS = 1244 * MiB;
constexpr size_t WS_XB8 = 1388 * MiB;
constexpr size_t WS_END = 1404 * MiB;
constexpr int CW_TMO = 0;
constexpr int CW_CNT = 1024;
constexpr int CW_BAR = 4096;
constexpr int RING_BYTES = 131072;
constexpr int TAB_OFF = RING_BYTES;
constexpr int MISC_OFF = RING_BYTES + 1024;
constexpr int LDS_BYTES = 147456;

#define GAS __attribute__((address_space(1)))
#define LAS __attribute__((address_space(3)))
typedef unsigned short bf16;
typedef unsigned v4u __attribute__((ext_vector_type(4)));
typedef unsigned v2u __attribute__((ext_vector_type(2)));
typedef float f32x4 __attribute__((ext_vector_type(4)));
typedef short bf16x8 __attribute__((ext_vector_type(8)));
typedef GAS unsigned gu32;
typedef unsigned long long u64;
#define RLX_AGENT __ATOMIC_RELAXED, __HIP_MEMORY_SCOPE_AGENT
#define LDS_WAIT() asm volatile("s_waitcnt lgkmcnt(0)" ::: "memory")
#define VM_WAIT() asm volatile("s_waitcnt vmcnt(0)" ::: "memory")
__device__ __forceinline__ unsigned f2bf(float f) { unsigned u = __builtin_bit_cast(unsigned, f); return (u + 0x7fffu + ((u >> 16) & 1u)) >> 16; }
__device__ __forceinline__ unsigned pk2(float lo, float hi) { return f2bf(lo) | (f2bf(hi) << 16); }
__device__ __forceinline__ unsigned pk4_fp8(float a, float b, float c, float d) { int w = 0; w = __builtin_amdgcn_cvt_pk_fp8_f32(a, b, w, false); w = __builtin_amdgcn_cvt_pk_fp8_f32(c, d, w, true); return (unsigned)w; }
constexpr float WGU_SCALE = 32.f, WDN_SCALE = 64.f;
__device__ __forceinline__ float bf2f(bf16 v) { return __builtin_bit_cast(float, (unsigned)v << 16); }
__device__ __forceinline__ float bflo(unsigned w) { return __builtin_bit_cast(float, w << 16); }
__device__ __forceinline__ float bfhi(unsigned w) { return __builtin_bit_cast(float, w & 0xffff0000u); }
template <int CTRL> __device__ __forceinline__ float dppx(float v) { return __builtin_bit_cast(float, __builtin_amdgcn_update_dpp(0, __builtin_bit_cast(int, v), CTRL, 0xf, 0xf, false)); }
__device__ __forceinline__ float wave_sum(float v) {
    v += dppx<0xB1>(v); v += dppx<0x4E>(v); v += dppx<0x141>(v); v += dppx<0x140>(v);
    const float a = __builtin_bit_cast(float, __builtin_amdgcn_readlane(__builtin_bit_cast(int, v), 0)), b = __builtin_bit_cast(float, __builtin_amdgcn_readlane(__builtin_bit_cast(int, v), 16));
    const float c = __builtin_bit_cast(float, __builtin_amdgcn_readlane(__builtin_bit_cast(int, v), 32)), d = __builtin_bit_cast(float, __builtin_amdgcn_readlane(__builtin_bit_cast(int, v), 48));
    return (a + b) + (c + d);
}
__device__ __forceinline__ float wave_max(float v) {
#pragma unroll
    for (int o = 1; o < 64; o <<= 1) v = fmaxf(v, __shfl_xor(v, o));
    return v;
}
__device__ __forceinline__ float wave_max_dpp(float v) {
    v = fmaxf(v, dppx<0xB1>(v)); v = fmaxf(v, dppx<0x4E>(v)); v = fmaxf(v, dppx<0x141>(v)); v = fmaxf(v, dppx<0x140>(v));
    const float a = __builtin_bit_cast(float, __builtin_amdgcn_readlane(__builtin_bit_cast(int, v), 0)), b = __builtin_bit_cast(float, __builtin_amdgcn_readlane(__builtin_bit_cast(int, v), 16));
    const float c = __builtin_bit_cast(float, __builtin_amdgcn_readlane(__builtin_bit_cast(int, v), 32)), d = __builtin_bit_cast(float, __builtin_amdgcn_readlane(__builtin_bit_cast(int, v), 48));
    return fmaxf(fmaxf(a, b), fmaxf(c, d));
}
__device__ __forceinline__ float sum32(float v) {
#pragma unroll
    for (int o = 1; o < 32; o <<= 1) v += __shfl_xor(v, o);
    return v;
}
#define XB_TMO      128
#define XB_XCNT(j)  (256  + 64 * (j))
#define XB_XSUB(j)  (1280 + 64 * (j))
#define XB_XGEN(j)  (2304 + 64 * (j))
#define XB_TOP      3328
#define XB_TOPGEN   3392
#define XCD_BAR_WORDS 3456
#define XB_SPIN_CAP (1u << 18)

__device__ __forceinline__ unsigned xb_ld(unsigned* p)              { return __hip_atomic_load(p, __ATOMIC_RELAXED, __HIP_MEMORY_SCOPE_AGENT); }
__device__ __forceinline__ unsigned xb_add(unsigned* p, unsigned v) { return __hip_atomic_fetch_add(p, v, __ATOMIC_RELAXED, __HIP_MEMORY_SCOPE_AGENT); }
__device__ __forceinline__ unsigned xb_xcc_id() { return (unsigned)__builtin_amdgcn_s_getreg((3 << 11) | 20) & 0xFu; }
#define XB_SPIN(cond, bar) do { unsigned _sp = 0; while (cond) { __builtin_amdgcn_s_sleep(1); \
    if ((++_sp & 255u) == 0u) { if (xb_ld(&(bar)[XB_TMO])) break; if (_sp > XB_SPIN_CAP) { atomicAdd(&(bar)[XB_TMO], 1u); break; } } } } while (0)

struct XcdBarrier {
    unsigned* bar; unsigned x;
    volatile LAS unsigned* st;
};

__device__ __forceinline__ XcdBarrier xcd_barrier_post(unsigned* bar, volatile LAS unsigned* st) {
    XcdBarrier b; b.bar = bar; b.x = xb_xcc_id(); b.st = st;
    if (threadIdx.x == 0) (void)xb_add(&bar[XB_XCNT(b.x)], 1u);
    return b;
}
__device__ __forceinline__ void xcd_barrier_complete(unsigned* bar, unsigned x, unsigned& nloc, unsigned& nx) {
    const unsigned G = gridDim.x * gridDim.y * gridDim.z;
    unsigned sum, cnt, mine, sp = 0u;
    for (;;) {
        sum = 0u; cnt = 0u; mine = 0u;
#pragma unroll
        for (unsigned j = 0; j < 16; ++j) { const unsigned c = xb_ld(&bar[XB_XCNT(j)]); sum += c; cnt += (c > 0u) ? 1u : 0u; mine = (j == x) ? c : mine; }
        if (sum == G) break;
        __builtin_amdgcn_s_sleep(1);
        if ((++sp & 255u) == 0u) { if (xb_ld(&bar[XB_TMO])) break; if (sp > XB_SPIN_CAP) { atomicAdd(&bar[XB_TMO], 1u); break; } }
    }
    nloc = mine > 0u ? mine : 1u; nx = cnt > 0u ? cnt : 1u;
}

__device__ __forceinline__ void xcd_barrier(const XcdBarrier& b) {
    asm volatile("s_waitcnt vmcnt(0)" ::: "memory");
    __syncthreads();
    if (threadIdx.x == 0) {
        unsigned* bar = b.bar;
        __builtin_amdgcn_s_waitcnt(0);
        unsigned nloc = b.st[0], nx = b.st[1];
        if (nloc == 0u) { xcd_barrier_complete(bar, b.x, nloc, nx); b.st[0] = nloc; b.st[1] = nx; }
        const unsigned old = xb_add(&bar[XB_XSUB(b.x)], 1u);
        const unsigned gen = old / nloc;
        if (old + 1u == (gen + 1u) * nloc) {
            __builtin_amdgcn_fence(__ATOMIC_RELEASE, "agent");
            asm volatile("s_waitcnt vmcnt(0)" ::: "memory");
#ifdef BAR_EARLY_INV
            __builtin_amdgcn_fence(__ATOMIC_ACQUIRE, "agent");
            (void)xb_add(&bar[XB_TOP], 1u);
            { const unsigned target = (gen + 1u) * nx; XB_SPIN(xb_ld(&bar[XB_TOP]) < target, bar); }
            xb_add(&bar[XB_XGEN(b.x)], 1u);
            asm volatile("s_waitcnt vmcnt(0)" ::: "memory");
#else
            const unsigned og = xb_add(&bar[XB_TOP], 1u);
            const unsigned tg = og / nx;
            if (og + 1u == (tg + 1u) * nx) xb_add(&bar[XB_TOPGEN], 1u);
            else XB_SPIN(xb_ld(&bar[XB_TOPGEN]) == tg, bar);
            __builtin_amdgcn_fence(__ATOMIC_ACQUIRE, "agent");
            xb_add(&bar[XB_XGEN(b.x)], 1u);
            asm volatile("s_waitcnt vmcnt(0)" ::: "memory");
#endif
        } else {
#ifdef BAR_EARLY_INV
            __builtin_amdgcn_fence(__ATOMIC_ACQUIRE, "agent"); asm volatile("s_waitcnt vmcnt(0)" ::: "memory");
            XB_SPIN(xb_ld(&bar[XB_XGEN(b.x)]) == gen, bar);
            asm volatile("" ::: "memory");
#else
            XB_SPIN(xb_ld(&bar[XB_XGEN(b.x)]) == gen, bar);
            __builtin_amdgcn_fence(__ATOMIC_ACQUIRE, "agent");
            asm volatile("s_waitcnt vmcnt(0)" ::: "memory");
#endif
        }
    }
    __syncthreads();
}
struct Args { const float* in[N_IN]; float* out; unsigned char* ws; int ph_lo, ph_hi; };
struct Frame {
    LAS unsigned char* lds;
    gu32* ctl;
    unsigned char* ws;
    int tid, lane, wave, vcu, G;
};
#define WSP(type, off) ((type*)(GAS type*)(F.ws + (off)))
__device__ __forceinline__ const float* uni(const float* p) { const u64 v = (u64)p; return (const float*)(const GAS float*)(((u64)(unsigned)__builtin_amdgcn_readfirstlane((int)(v >> 32)) << 32) | (u64)(unsigned)__builtin_amdgcn_readfirstlane((int)v)); }
__device__ __forceinline__ Frame make_frame(unsigned char* ws_, LAS unsigned char* lds_) {
    Frame F; const u64 v = (u64)ws_;
    F.ws = (unsigned char*)(((u64)(unsigned)__builtin_amdgcn_readfirstlane((int)(v >> 32)) << 32) | (u64)(unsigned)__builtin_amdgcn_readfirstlane((int)v));
    F.lds = (LAS unsigned char*)(unsigned)__builtin_amdgcn_readfirstlane((int)(unsigned)(uintptr_t)lds_);
    F.ctl = (gu32*)(F.ws + WS_CTL);
    { int t_ = threadIdx.x; asm volatile("" : "+v"(t_)); F.tid = t_; }
    F.lane = F.tid & 63; F.wave = __builtin_amdgcn_readfirstlane(F.tid >> 6);
    F.G = gridDim.x; { const int bx = blockIdx.x; F.vcu = (F.G % 8 == 0) ? (bx % 8) * (F.G / 8) + bx / 8 : bx; }
    return F;
}
struct In6 { const float* p[6]; };

__device__ __forceinline__ void tr_block(Frame& F, const float* W_, int N, bf16* WT, int k0, int n0, int mode  , size_t drow_base, float scale) {
    LAS unsigned* img = (LAS unsigned*)F.lds; const int lane = F.lane, wave = F.wave, tid = F.tid; const GAS float* W = (const GAS float*)W_;
    f32x4 va[4][2], vb[4][2];
#pragma unroll
    for (int i = 0; i < 4; ++i) { const int kp = wave * 4 + i; const GAS float* r0 = W + (size_t)(k0 + 2 * kp) * N + n0; const GAS float* r1 = r0 + N;
#pragma unroll
        for (int q = 0; q < 2; ++q) { const int c4 = lane + 64 * q; va[i][q] = (f32x4){0.f, 0.f, 0.f, 0.f}; vb[i][q] = va[i][q];
            if (n0 + 4 * c4 < N) { va[i][q] = __builtin_nontemporal_load((const GAS f32x4*)(r0 + 4 * c4)); vb[i][q] = __builtin_nontemporal_load((const GAS f32x4*)(r1 + 4 * c4)); } } }
#pragma unroll
    for (int i = 0; i < 4; ++i) { const int kp = wave * 4 + i;
#pragma unroll
        for (int q = 0; q < 2; ++q) { const int c4 = lane + 64 * q; const f32x4 a = va[i][q], b = vb[i][q];
            v4u o; o.x = pk2(a.x * scale, b.x * scale); o.y = pk2(a.y * scale, b.y * scale); o.z = pk2(a.z * scale, b.z * scale); o.w = pk2(a.w * scale, b.w * scale);
            *(LAS v4u*)(img + kp * 516 + 4 * c4) = o; } }
    __syncthreads();
    const int c = tid & 7;
#pragma unroll
    for (int i = 0; i < 8; ++i) { const int n = (tid >> 3) + 64 * i; const LAS unsigned* p = img + (4 * c) * 516 + n;
        v4u o; o.x = p[0]; o.y = p[516]; o.z = p[2 * 516]; o.w = p[3 * 516];
        const int ng = n0 + n; size_t dr;
        if (mode == 1) dr = ng < 1024 ? (size_t)((ng >> 7) * 256 + (ng & 127)) : (size_t)((((ng - 1024) >> 7) * 256) + 128 + ((ng - 1024) & 127)); else dr = (size_t)ng;
        *(GAS v4u*)((GAS bf16*)WT + (drow_base + dr) * D + k0 + 8 * c) = o; }
    __syncthreads();
}
__device__ __forceinline__ void tr_block8(Frame& F, const float* W_, int N, unsigned char* WT, int k0, int n0, int mode, size_t drow_base, float scale) {
    LAS unsigned* img = (LAS unsigned*)F.lds; const int lane = F.lane, wave = F.wave, tid = F.tid; const GAS float* W = (const GAS float*)W_;
    f32x4 vv[4][2][4];
#pragma unroll
    for (int i = 0; i < 4; ++i) { const int kq = wave * 4 + i; const GAS float* r0 = W + (size_t)(k0 + 4 * kq) * N + n0;
#pragma unroll
        for (int q = 0; q < 2; ++q) { const int c4 = lane + 64 * q;
#pragma unroll
            for (int j = 0; j < 4; ++j) vv[i][q][j] = __builtin_nontemporal_load((const GAS f32x4*)(r0 + (size_t)j * N + 4 * c4)); } }
#pragma unroll
    for (int i = 0; i < 4; ++i) { const int kq = wave * 4 + i;
#pragma unroll
        for (int q = 0; q < 2; ++q) { const int c4 = lane + 64 * q; const f32x4 a = vv[i][q][0] * scale, b = vv[i][q][1] * scale, c = vv[i][q][2] * scale, d = vv[i][q][3] * scale;
            v4u o; o.x = pk4_fp8(a.x, b.x, c.x, d.x); o.y = pk4_fp8(a.y, b.y, c.y, d.y); o.z = pk4_fp8(a.z, b.z, c.z, d.z); o.w = pk4_fp8(a.w, b.w, c.w, d.w);
            *(LAS v4u*)(img + kq * 516 + 4 * c4) = o; } }
    __syncthreads();
    const int c = tid & 7;
#pragma unroll
    for (int i = 0; i < 8; ++i) { const int n = (tid >> 3) + 64 * i; const LAS unsigned* p = img + (4 * c) * 516 + n;
        v4u o; o.x = p[0]; o.y = p[516]; o.z = p[2 * 516]; o.w = p[3 * 516];
        const int ng = n0 + n; size_t dr;
        if (mode == 1) dr = ng < 1024 ? (size_t)((ng >> 7) * 256 + (ng & 127)) : (size_t)((((ng - 1024) >> 7) * 256) + 128 + ((ng - 1024) & 127)); else dr = (size_t)ng;
        __builtin_nontemporal_store(o, (GAS v4u*)((GAS unsigned char*)WT + (drow_base + dr) * D + k0 + 16 * c)); }
    __syncthreads();
}
__device__ __forceinline__ void p_prologue(Frame& F, const In6& A) {
    constexpr int I_IN = 16 * 6, I_OUT = 16 * 2, I_GU = NE * 8 * 4, I_DN = NE * 8 * 2, I_L = I_IN + I_OUT + I_GU + I_DN;
    for (int it = F.vcu; it < DEPTH * I_L; it += F.G) {
        const int l = it / I_L; int r = it % I_L;
        if (r < I_IN) { const int kb = r / 6, nb = r % 6; tr_block(F, A.p[0] + (size_t)l * D * NIN, NIN, WSP(bf16, WS_WIN) + (size_t)l * NINP * D, kb * 64, nb * 512, 0, 0, nb == 2 ? ATT_C2 : 1.f); continue; }
        r -= I_IN;
        if (r < I_OUT) { const int kb = r / 2, nb = r % 2; tr_block(F, A.p[1] + (size_t)l * D * D, D, WSP(bf16, WS_WOUT) + (size_t)l * D * D, kb * 64, nb * 512, 0, 0, 1.f); continue; }
        r -= I_OUT;
        if (r < I_GU) { const int e = r / 32, rr = r % 32, kb = rr / 4, nb = rr % 4; tr_block8(F, A.p[2] + (size_t)(l * NE + e) * D * 2048, 2048, WSP(unsigned char, WS_WGU) + (size_t)l * NE * 2048 * D * 2, kb * 128, nb * 512, 1, (size_t)e * 2048, WGU_SCALE); continue; }
        r -= I_GU;
        { const int e = r / 16, rr = r % 16, kb = rr / 2, nb = rr % 2; tr_block8(F, A.p[3] + (size_t)(l * NE + e) * D * D, D, WSP(unsigned char, WS_WDN) + (size_t)l * NE * D * D * 2, kb * 128, nb * 512, 0, (size_t)e * 1024, WDN_SCALE); }
    }
    const int gw = F.vcu * NWAVES + F.wave, NGW = F.G * NWAVES, lane = F.lane;
    const GAS float* x = (const GAS float*)A.p[4]; GAS bf16* xb = (GAS bf16*)WSP(bf16, WS_XB);
    for (int m = gw; m < T; m += 2 * NGW) {
        const GAS f32x4* xr = (const GAS f32x4*)(x + (size_t)m * D) + lane; GAS u64* o8 = (GAS u64*)(xb + (size_t)m * D) + lane;
        const GAS f32x4* xr2 = xr + (size_t)NGW * (D / 4); GAS u64* o82 = o8 + (size_t)NGW * (D / 4);
        f32x4 v[4], w[4];
#pragma unroll
        for (int j = 0; j < 4; ++j) { v[j] = __builtin_nontemporal_load(xr + 64 * j); w[j] = __builtin_nontemporal_load(xr2 + 64 * j); }
#pragma unroll
        for (int j = 0; j < 4; ++j) { o8[64 * j] = (u64)pk2(v[j].x, v[j].y) | ((u64)pk2(v[j].z, v[j].w) << 32); o82[64 * j] = (u64)pk2(w[j].x, w[j].y) | ((u64)pk2(w[j].z, w[j].w) << 32); }
    }
}

__device__ __forceinline__ void bf8_to_f(const v4u q, float (&f)[8]) { f[0] = bflo(q.x); f[1] = bfhi(q.x); f[2] = bflo(q.y); f[3] = bfhi(q.y); f[4] = bflo(q.z); f[5] = bfhi(q.z); f[6] = bflo(q.w); f[7] = bfhi(q.w); }
__device__ __forceinline__ void p_local(Frame& F, const In6& A, int l) {
    typedef float f32x16 __attribute__((ext_vector_type(16)));
    constexpr int MROW = 528, WROW = 144;
    LAS unsigned char* mixb = F.lds;
    LAS unsigned char* wpt = F.lds + 64 * MROW;
    const GAS float* wpool = (const GAS float*)(A.p[0] + (size_t)l * 4 * 64 * 64);
    const GAS float* convw = (const GAS float*)(A.p[1] + l * 768); const GAS float* pscale = (const GAS float*)(A.p[2] + l * 256);
    const GAS float* kng = (const GAS float*)(A.p[3] + l * 32); const GAS float* knb = (const GAS float*)(A.p[4] + l * 32);
    const GAS bf16* PROJ = (const GAS bf16*)(F.ws + WS_PROJ); GAS bf16* CAT = (GAS bf16*)(F.ws + WS_CAT); GAS bf16* KIN = (GAS bf16*)(F.ws + WS_KIN);
    const int tid = F.tid, lane = F.lane, wave = F.wave;
    for (int u = F.vcu; u < T / 64; u += F.G) {
        const int t0 = u * 64, s0 = t0 & (SEQ - 1), rowb = t0 - s0;
        __syncthreads();
        f32x4 wr0[4], wr1[4];
#pragma unroll
        for (int i = 0; i < 4; ++i) { const int item = tid + 512 * i, g = item >> 9, cp = (item >> 4) & 31, dq = item & 15;
            wr0[i] = *(const GAS f32x4*)(wpool + g * 4096 + (2 * cp) * 64 + 4 * dq); wr1[i] = *(const GAS f32x4*)(wpool + g * 4096 + (2 * cp + 1) * 64 + 4 * dq); }
        const int cga = tid & 31, tga = tid >> 5, ca0 = cga * 8, sfa = s0 + tga * 4;
        v4u ah[6], ag[6], ab[4];
#pragma unroll
        for (int i = -2; i < 4; ++i) { const int sq = sfa + i; ah[i + 2] = (v4u){0u, 0u, 0u, 0u}; ag[i + 2] = ah[i + 2];
            if (sq >= 0) { const GAS bf16* pr = PROJ + (size_t)(rowb + sq) * NINP; ah[i + 2] = *(const GAS v4u*)(pr + C_H + ca0); ag[i + 2] = *(const GAS v4u*)(pr + C_GC + ca0);
                if (i >= 0) ab[i] = *(const GAS v4u*)(pr + C_GB + ca0); } }
        const int cgb = tid & 63, tgb = tid >> 6, cb0 = cgb * 4, wwin = 2 << (cgb >> 4), sfb = s0 + tgb * 8;
        v2u bq[23];
#pragma unroll
        for (int i = 0; i < 23; ++i) { const int sq = sfb - 15 + i; bq[i] = (v2u){0u, 0u}; if (sq >= 0) bq[i] = *(const GAS v2u*)(PROJ + (size_t)(rowb + sq) * NINP + C_P + cb0); }
        bf16 ck[4];
#pragma unroll
        for (int i = 0; i < 4; ++i) { const int idx = tid + 512 * i; ck[i] = PROJ[(size_t)(t0 + (idx >> 5)) * NINP + C_KI + (idx & 31)]; }
        const float kg = kng[tid & 31], kb = knb[tid & 31];
        float w0[8], w1[8], w2[8];
#pragma unroll
        for (int i = 0; i < 8; ++i) { w0[i] = convw[ca0 + i]; w1[i] = convw[256 + ca0 + i]; w2[i] = convw[512 + ca0 + i]; }
#pragma unroll
        for (int i = 0; i < 4; ++i) { const int item = tid + 512 * i, g = item >> 9, cp = (item >> 4) & 31, dq = item & 15;
#pragma unroll
            for (int k = 0; k < 4; ++k) *(LAS unsigned*)(wpt + (g * 64 + 4 * dq + k) * WROW + cp * 4) = pk2(wr0[i][k], wr1[i][k]); }
        {
            float up2[8], up1[8];
#pragma unroll
            for (int i = 0; i < 8; ++i) { up2[i] = 0.f; up1[i] = 0.f; }
#pragma unroll
            for (int i = -2; i < 4; ++i) { const int sq = sfa + i; float h8[8], g8[8], uu[8];
                bf8_to_f(ah[i + 2], h8); bf8_to_f(ag[i + 2], g8);
#pragma unroll
                for (int k = 0; k < 8; ++k) uu[k] = g8[k] * h8[k];
                if (i >= 0) { float b8[8], y[8]; bf8_to_f(ab[i], b8);
#pragma unroll
                    for (int k = 0; k < 8; ++k) y[k] = b8[k] * (w0[k] * up2[k] + w1[k] * up1[k] + w2[k] * uu[k]);
                    v4u o; o.x = pk2(y[0], y[1]); o.y = pk2(y[2], y[3]); o.z = pk2(y[4], y[5]); o.w = pk2(y[6], y[7]);
                    *(GAS v4u*)(CAT + (size_t)(rowb + sq) * D + ca0) = o; }
#pragma unroll
                for (int k = 0; k < 8; ++k) { up2[k] = up1[k]; up1[k] = uu[k]; } }
        }
        {
            float pv[23][4];
#pragma unroll
            for (int i = 0; i < 23; ++i) { pv[i][0] = bflo(bq[i].x); pv[i][1] = bfhi(bq[i].x); pv[i][2] = bflo(bq[i].y); pv[i][3] = bfhi(bq[i].y); }
#pragma unroll
            for (int i = 0; i < 8; ++i) { const int sq = sfb + i; float a0 = 0.f, a1 = 0.f, a2 = 0.f, a3 = 0.f;
#pragma unroll
                for (int j = 0; j < 16; ++j) { const bool on = j < wwin; a0 += on ? pv[15 + i - j][0] : 0.f; a1 += on ? pv[15 + i - j][1] : 0.f; a2 += on ? pv[15 + i - j][2] : 0.f; a3 += on ? pv[15 + i - j][3] : 0.f; }
                const float rc = 1.f / (float)((sq + 1) < wwin ? (sq + 1) : wwin);
                *(LAS v2u*)(mixb + (tgb * 8 + i) * MROW + cb0 * 2) = (v2u){pk2(a0 * rc - pv[15 + i][0], a1 * rc - pv[15 + i][1]), pk2(a2 * rc - pv[15 + i][2], a3 * rc - pv[15 + i][3])}; }
        }
#pragma unroll
        for (int i = 0; i < 4; ++i) {
            const int idx = tid + 512 * i, tt = idx >> 5, dd = idx & 31; const float v = bf2f(ck[i]);
            const float mean = sum32(v) * (1.f / 32.f); const float dv = v - mean; const float var = sum32(dv * dv) * (1.f / 32.f);
            KIN[(size_t)(t0 + tt) * 32 + dd] = (bf16)f2bf(dv * rsqrtf(var + LN_EPS) * kg + kb);
        }
        __syncthreads();
        {
            const int g = wave >> 1, th = wave & 1, r32 = lane & 31, hi = lane >> 5;
            f32x16 acc[2]; acc[0] = f32x16{}; acc[1] = f32x16{};
#pragma unroll
            for (int kk = 0; kk < 4; ++kk) { const bf16x8 bfr = *(const LAS bf16x8*)(mixb + (th * 32 + r32) * MROW + (g * 64 + kk * 16 + hi * 8) * 2);
#pragma unroll
                for (int dh = 0; dh < 2; ++dh) { const bf16x8 afr = *(const LAS bf16x8*)(wpt + (g * 64 + dh * 32 + r32) * WROW + (kk * 16 + hi * 8) * 2);
                    acc[dh] = __builtin_amdgcn_mfma_f32_32x32x16_bf16(afr, bfr, acc[dh], 0, 0, 0); } }
            GAS bf16* orow = CAT + (size_t)(t0 + th * 32 + r32) * D + 256 + g * 64;
#pragma unroll
            for (int dh = 0; dh < 2; ++dh)
#pragma unroll
                for (int rq = 0; rq < 4; ++rq) { const int d0 = dh * 32 + 8 * rq + 4 * hi; const f32x4 sc = *(const GAS f32x4*)(pscale + g * 64 + d0);
                    *(GAS v2u*)(orow + d0) = (v2u){pk2(acc[dh][4 * rq] * sc.x, acc[dh][4 * rq + 1] * sc.y), pk2(acc[dh][4 * rq + 2] * sc.z, acc[dh][4 * rq + 3] * sc.w)}; }
        }
    }
    __syncthreads();
}

constexpr int SCS = SEQ;
__device__ __forceinline__ unsigned sortable(float v) { const unsigned u = __builtin_bit_cast(unsigned, v); return (u & 0x80000000u) ? ~u : (u | 0x80000000u); }
__device__ __forceinline__ void select_row(int t, const GAS float* SC, GAS unsigned* MASK, LAS unsigned* hist, LAS float* ckey, LAS int* cidx, int lane) {
    const u64 lt = (1ull << lane) - 1ull; const float NINF = -INFINITY;
    const int s = t & (SEQ - 1); GAS u64* mrow = (GAS u64*)MASK + ((size_t)(t >> 12) * 64) * SEQ + s;
    if (s < NSEL) { const int base = 64 * lane; u64 m; if (s >= base + 63) m = ~0ull; else if (s < base) m = 0ull; else m = (2ull << (s - base)) - 1ull; mrow[(size_t)lane * SEQ] = m; return; }
    const int jmax = s >> 6, jb = jmax & ~7;
    float v[64]; const GAS float* srow = SC + (size_t)t * SCS + lane;
#pragma unroll
    for (int j0 = 0; j0 < 64; j0 += 8) {
        if (j0 < jb) {
#pragma unroll
            for (int j = j0; j < j0 + 8; ++j) v[j] = srow[64 * j];
        } else if (j0 == jb) {
#pragma unroll
            for (int j = j0; j < j0 + 8; ++j) { const float x = srow[64 * j]; v[j] = (lane + 64 * j <= s) ? x : NINF; }
        } else {
#pragma unroll
            for (int j = j0; j < j0 + 8; ++j) v[j] = NINF;
        }
    }
    {
    float vmx = NINF, vmn = INFINITY;
#pragma unroll
    for (int j0 = 0; j0 < 64; j0 += 8) {
        if (j0 < jb) {
#pragma unroll
            for (int j = j0; j < j0 + 8; ++j) { vmx = fmaxf(vmx, v[j]); vmn = fminf(vmn, v[j]); }
        } else if (j0 == jb) {
#pragma unroll
            for (int j = j0; j < j0 + 8; ++j) { vmx = fmaxf(vmx, v[j]); vmn = fminf(vmn, v[j] == NINF ? INFINITY : v[j]); }
        }
    }
    vmx = wave_max_dpp(vmx); vmn = -wave_max_dpp(-vmn);
    const float scale = 1023.f / fmaxf(vmx - vmn, 1e-30f), off = -vmn * scale;
#pragma unroll
    for (int i = 0; i < 4; ++i) ((LAS v4u*)hist)[i * 64 + lane] = (v4u){0u, 0u, 0u, 0u};
    LDS_WAIT(); asm volatile("" ::: "memory");
    unsigned bp[32];
#pragma unroll
    for (int j0 = 0; j0 < 64; j0 += 8) {
        if (j0 < jb) {
#pragma unroll
            for (int j = j0; j < j0 + 8; ++j) { unsigned bb = (unsigned)fmaf(v[j], scale, off); bb = bb < 1023u ? bb : 1023u; __hip_atomic_fetch_add(hist + bb, 1u, __ATOMIC_RELAXED, __HIP_MEMORY_SCOPE_WORKGROUP);
                if (j & 1) bp[j >> 1] |= bb << 16; else bp[j >> 1] = bb; }
        } else if (j0 == jb) {
#pragma unroll
            for (int j = j0; j < j0 + 8; ++j) { unsigned bb = (unsigned)fmaf(v[j], scale, off); bb = bb < 1023u ? bb : 1023u; if (v[j] != NINF) __hip_atomic_fetch_add(hist + bb, 1u, __ATOMIC_RELAXED, __HIP_MEMORY_SCOPE_WORKGROUP);
                if (j & 1) bp[j >> 1] |= bb << 16; else bp[j >> 1] = bb; }
        } else {
#pragma unroll
            for (int j = j0; j < j0 + 8; j += 2) bp[j >> 1] = 0u;
        }
    }
    LDS_WAIT(); asm volatile("" ::: "memory");
    unsigned hb[16];
#pragma unroll
    for (int i = 0; i < 4; ++i) { const v4u q = ((const LAS v4u*)hist)[lane * 4 + i]; hb[4 * i] = q.x; hb[4 * i + 1] = q.y; hb[4 * i + 2] = q.z; hb[4 * i + 3] = q.w; }
    int own = 0;
#pragma unroll
    for (int i = 0; i < 16; ++i) own += (int)hb[i];
    int suf = own;
#pragma unroll
    for (int o = 1; o < 64; o <<= 1) { const int x = __shfl_down(suf, o); if (lane + o < 64) suf += x; }
    const u64 ge = __ballot(suf >= NSEL); const int L = 63 - __builtin_clzll(ge);
    int acc = suf - own, tb = 0, ca = 0, found = 0;
#pragma unroll
    for (int i = 15; i >= 0; --i) { if (!found) { if (acc + (int)hb[i] >= NSEL) { found = 1; tb = lane * 16 + i; ca = acc; } else acc += (int)hb[i]; } }
    const int TB = __builtin_amdgcn_readlane(tb, L), CA = __builtin_amdgcn_readlane(ca, L);
    const int need = NSEL - CA;
    int cbase = 0; unsigned mlo = 0u, mhi = 0u;
#pragma unroll
    for (int j0 = 0; j0 < 64; j0 += 8) {
        if (j0 <= jb) {
#pragma unroll
            for (int j = j0; j < j0 + 8; ++j) { const int bb = (int)((j & 1) ? (bp[j >> 1] >> 16) : (bp[j >> 1] & 0xffffu));
                const u64 am = __ballot(bb > TB); const u64 cm = __ballot(bb == TB);
                asm volatile("s_nop 4\n\tv_writelane_b32 %0, %2, %4\n\tv_writelane_b32 %1, %3, %4" : "+v"(mlo), "+v"(mhi) : "s"((unsigned)am), "s"((unsigned)(am >> 32)), "n"(j));
                if (cm) { const int pos = cbase + __popcll(cm & lt); if (bb == TB && pos < 64) { ckey[pos] = v[j]; cidx[pos] = lane + 64 * j; } cbase += __popcll(cm); } }
        }
    }
    LDS_WAIT(); asm volatile("" ::: "memory");
    if (cbase <= SEL_CAND_CAP) {
        LAS unsigned* mw = hist;
        mw[2 * lane] = mlo; mw[2 * lane + 1] = mhi;
        const float myk = lane < cbase ? ckey[lane] : NINF; const int myi = lane < cbase ? cidx[lane] : 0x7fffffff; int rank = 0;
        for (int c = 0; c < cbase; ++c) { const float ok = __builtin_bit_cast(float, __builtin_amdgcn_readlane(__builtin_bit_cast(int, myk), c)); const int oi = __builtin_amdgcn_readlane(myi, c); rank += (ok > myk || (ok == myk && oi < myi)) ? 1 : 0; }
        LDS_WAIT(); asm volatile("" ::: "memory");
        if (lane < cbase && rank < need && myk != NINF) __hip_atomic_fetch_or(mw + (myi >> 5), 1u << (myi & 31), __ATOMIC_RELAXED, __HIP_MEMORY_SCOPE_WORKGROUP);
        LDS_WAIT(); asm volatile("" ::: "memory");
        mrow[(size_t)lane * SEQ] = (u64)mw[2 * lane] | ((u64)mw[2 * lane + 1] << 32);
        LDS_WAIT(); asm volatile("" ::: "memory");
        return;
    }
    unsigned prefix = 0u;
    for (int bit = 31; bit >= 0; --bit) { const unsigned cand = prefix | (1u << bit); int cnt = 0;
#pragma unroll
        for (int j0 = 0; j0 < 64; j0 += 8) {
#pragma unroll
            for (int j = j0; j < j0 + 8; ++j) cnt += __popcll(__ballot(v[j] != NINF && sortable(v[j]) >= cand));
            __builtin_amdgcn_sched_barrier(0); }
        if (cnt >= NSEL) prefix = cand; }
    int ngt = 0;
#pragma unroll
    for (int j = 0; j < 64; ++j) ngt += __popcll(__ballot(v[j] != NINF && sortable(v[j]) > prefix));
    int rem = NSEL - ngt, last = 0;
#pragma unroll
    for (int j = 0; j < 64; ++j) { const u64 em = __ballot(v[j] != NINF && sortable(v[j]) == prefix); const int c = __popcll(em);
        if (rem > 0 && c > 0) { if (c >= rem) { u64 x = em; for (int q = 1; q < rem; ++q) x &= x - 1ull; last = 64 * j + __builtin_ctzll(x); rem = 0; } else rem -= c; } }
    const unsigned pb = (prefix & 0x80000000u) ? (prefix & 0x7fffffffu) : ~prefix; const float Tv = __builtin_bit_cast(float, pb); const int Tidx = last;
    mlo = 0u; mhi = 0u;
#pragma unroll
    for (int j = 0; j < 64; ++j) { const bool sel = (v[j] > Tv) || (v[j] == Tv && lane + 64 * j <= Tidx); const u64 m = __ballot(sel);
        asm volatile("s_nop 4\n\tv_writelane_b32 %0, %2, %4\n\tv_writelane_b32 %1, %3, %4" : "+v"(mlo), "+v"(mhi) : "s"((unsigned)m), "s"((unsigned)(m >> 32)), "n"(j)); }
    mrow[(size_t)lane * SEQ] = (u64)mlo | ((u64)mhi << 32);
    return;
    }
}
__device__ __forceinline__ float relu_i(float x) { const int b = __builtin_bit_cast(int, x); return __builtin_bit_cast(float, b > 0 ? b : 0); }
__device__ __forceinline__ void p_index(Frame& F) {
    const int wave = F.wave;
    const GAS bf16* PROJ = (const GAS bf16*)(F.ws + WS_PROJ); const GAS bf16* KIN = (const GAS bf16*)(F.ws + WS_KIN); GAS float* SC = (GAS float*)(F.ws + WS_SC); GAS unsigned* MASK = (GAS unsigned*)(F.ws + WS_MASK);
    LAS unsigned* hist = (LAS unsigned*)(F.lds + wave * 4096);
    LAS float* ckey = (LAS float*)(F.lds + 32768 + wave * 1024); LAS int* cidx = (LAS int*)(ckey + 64);
    for (int ui = 0; ui < 2; ++ui) {
        const int v = F.vcu; if (v >= 256) break;
        const int b = v & 3, j = v >> 2, qb = ui == 0 ? j : 127 - j, q0 = qb * 32;
        int lane = F.tid & 63; asm volatile("" : "+v"(lane)); const int l15 = lane & 15, l4 = lane >> 4;
        bf16x8 bq[2][8]; float wq[2][8];
#pragma unroll
        for (int hq = 0; hq < 2; ++hq) { const size_t rowq = (size_t)(b * SEQ + q0 + 16 * hq + l15);
#pragma unroll
            for (int h = 0; h < 8; ++h) { bq[hq][h] = *(const GAS bf16x8*)(PROJ + rowq * NINP + C_QI + h * 32 + 8 * l4); wq[hq][h] = bf2f(PROJ[rowq * NINP + C_WI + h]) * 0.0625f; } }
        GAS float* srow = SC + (size_t)(b * SEQ + q0 + l15) * SCS + 4 * l4;
        const int ktl = 2 * qb + 1; const GAS bf16* kin0 = KIN + (size_t)(b * SEQ + l15) * 32 + 8 * l4;
        bf16x8 a = *(const GAS bf16x8*)(kin0 + (size_t)((wave <= ktl ? wave : ktl) * 16) * 32);
        for (int kt = wave; kt <= ktl; kt += NWAVES) {
            const int ktn = kt + NWAVES <= ktl ? kt + NWAVES : kt;
            const bf16x8 an = *(const GAS bf16x8*)(kin0 + (size_t)(ktn * 16) * 32);
#pragma unroll
            for (int hq = 0; hq < 2; ++hq) { f32x4 sc = (f32x4){0.f, 0.f, 0.f, 0.f};
#pragma unroll
                for (int h = 0; h < 8; ++h) { const f32x4 d = __builtin_amdgcn_mfma_f32_16x16x32_bf16(a, bq[hq][h], (f32x4){0.f, 0.f, 0.f, 0.f}, 0, 0, 0);
                    sc.x += relu_i(d.x) * wq[hq][h]; sc.y += relu_i(d.y) * wq[hq][h]; sc.z += relu_i(d.z) * wq[hq][h]; sc.w += relu_i(d.w) * wq[hq][h]; }
                *(GAS f32x4*)(srow + (size_t)(16 * hq) * SCS + kt * 16) = sc; }
            a = an;
        }
        asm volatile("s_waitcnt vmcnt(0)" ::: "memory"); __syncthreads();
        int lane_s = F.tid & 63; asm volatile("" : "+v"(lane_s));
        for (int r = 0; r < 4; ++r) select_row(b * SEQ + q0 + wave * 4 + r, SC, MASK, hist, ckey, cidx, lane_s);
#ifdef EXP_DUP_SELECT
        for (int r = 0; r < 4; ++r) select_row(b * SEQ + q0 + wave * 4 + r, SC, MASK, hist, ckey, cidx, lane_s);
#endif
    }
}

namespace att {
typedef float f32x16 __attribute__((ext_vector_type(16)));
typedef short s16x4 __attribute__((ext_vector_type(4)));
constexpr int NSLOT = 3, SLOTB = 8192, LDS_K = 0, LDS_V = NSLOT * SLOTB, LDS_WS = 2 * NSLOT * SLOTB, LDS_OST = LDS_WS + 8 * 64 * 4, LDS_BYTES_ATT = LDS_OST + 8 * 4096;
constexpr float THR = 100.f;
__device__ __forceinline__ int crow(int r, int hi) { return (r & 3) + 8 * (r >> 2) + 4 * hi; }
__device__ __forceinline__ unsigned cvtpk(float lo, float hi) { typedef float f2 __attribute__((ext_vector_type(2))); typedef __bf16 b2 __attribute__((ext_vector_type(2))); f2 v = {lo, hi}; b2 b = __builtin_convertvector(v, b2); return __builtin_bit_cast(unsigned, b); }
__device__ __forceinline__ float rowmax(const f32x16& p0, const f32x16& p1) {
    float a = fmaxf(fmaxf(p0[0], p0[1]), p1[0]), b = fmaxf(fmaxf(p0[2], p0[3]), p1[1]); a = fmaxf(fmaxf(a, p1[2]), p1[3]);
#pragma unroll
    for (int r = 4; r < 16; r += 4) { a = fmaxf(fmaxf(a, p0[r]), p0[r + 1]); b = fmaxf(fmaxf(b, p0[r + 2]), p0[r + 3]); a = fmaxf(fmaxf(a, p1[r]), p1[r + 1]); b = fmaxf(fmaxf(b, p1[r + 2]), p1[r + 3]); }
    const float m = fmaxf(a, b);
    return fmaxf(m, __shfl_xor(m, 32));
}
__device__ __forceinline__ void pv(f32x16* o, int vb, bf16x8 pa0, bf16x8 pa1, bf16x8 pa2, bf16x8 pa3) {
#pragma unroll
    for (int d0 = 0; d0 < 2; ++d0) { s16x4 lo[4], hi[4];
#pragma unroll
        for (int ks = 0; ks < 4; ++ks) {
            asm volatile("ds_read_b64_tr_b16 %0,%1 offset:%c2" : "=&v"(lo[ks]) : "v"(vb), "i"(d0 * 4096 + ks * 1024) : "memory");
            asm volatile("ds_read_b64_tr_b16 %0,%1 offset:%c2" : "=&v"(hi[ks]) : "v"(vb), "i"(d0 * 4096 + ks * 1024 + 512) : "memory"); }
        asm volatile("s_waitcnt lgkmcnt(0)" ::: "memory"); __builtin_amdgcn_sched_barrier(0);
#define ATT_PK(k) (bf16x8){lo[k][0], lo[k][1], lo[k][2], lo[k][3], hi[k][0], hi[k][1], hi[k][2], hi[k][3]}
        o[d0] = __builtin_amdgcn_mfma_f32_32x32x16_bf16(pa0, ATT_PK(0), o[d0], 0, 0, 0);
        o[d0] = __builtin_amdgcn_mfma_f32_32x32x16_bf16(pa1, ATT_PK(1), o[d0], 0, 0, 0);
        o[d0] = __builtin_amdgcn_mfma_f32_32x32x16_bf16(pa2, ATT_PK(2), o[d0], 0, 0, 0);
        o[d0] = __builtin_amdgcn_mfma_f32_32x32x16_bf16(pa3, ATT_PK(3), o[d0], 0, 0, 0);
#undef ATT_PK
    }
}
}
template <bool grpB> __device__ __forceinline__ void attn_units(Frame& F) {
    using namespace att;
    const int tid = F.tid, lane = tid & 63, r32 = lane & 31, hi = lane >> 5, wid = F.wave;
    const GAS bf16* PROJ = (const GAS bf16*)(F.ws + WS_PROJ); GAS bf16* CAT = (GAS bf16*)(F.ws + WS_CAT); const GAS u64* MASKT = (const GAS u64*)(F.ws + WS_MASK);
    LAS unsigned char* shm = F.lds;
    constexpr int NSV = 4, LDS_V2 = NSLOT * SLOTB, LDS_WS2 = LDS_V2 + NSV * SLOTB, LDS_OST2 = LDS_WS2 + 8 * 64 * 4;
    LAS float* wsf = (LAS float*)(shm + LDS_WS2) + wid * 64;
    const float NEGINF = -INFINITY;
    for (int ui = 0; ui < 2; ++ui) {
        const int v = F.vcu; if (v >= 256) break;
        const int bh = v >> 3, sidx = v & 7, b = bh >> 3, h = bh & 7, qb = ui == 0 ? sidx : 15 - sidx;
        const size_t rowbase = (size_t)b * SEQ; const int q0 = qb * 256, NT = (q0 + 256) / 64;
        const float slope2 = exp2f(-(float)(h + 1)) * 1.4426950408889634f;
        const GAS bf16* Kh = PROJ + rowbase * NINP + C_K + h * 64; const GAS bf16* Vh = PROJ + rowbase * NINP + C_V + h * 64;
        const GAS bf16* ksrc = Kh + (size_t)lane * NINP + wid * 8;
        const GAS bf16* vsrc = Vh + (size_t)(16 * (wid & 3) + (lane >> 2)) * NINP + (wid >> 2) * 32 + (lane & 3) * 8;
#define ATT_DMA(t, ks, vs) do { __builtin_amdgcn_global_load_lds((const GAS unsigned*)(ksrc + (size_t)(t) * 64 * NINP), (LAS unsigned*)(shm + LDS_K + (ks) * SLOTB + wid * 1024), 16, 0, 0); \
                        __builtin_amdgcn_global_load_lds((const GAS unsigned*)(vsrc + (size_t)(t) * 64 * NINP), (LAS unsigned*)(shm + LDS_V2 + (vs) * SLOTB + wid * 1024), 16, 0, 0); } while (0)
        ATT_DMA(0, 0, 0); ATT_DMA(1, 1, 1);
        const GAS bf16* Qw = PROJ + (rowbase + q0 + wid * 32) * NINP + C_Q + h * 64;
        bf16x8 qr[4];
#pragma unroll
        for (int d0 = 0; d0 < 4; ++d0) qr[d0] = *(const GAS bf16x8*)(Qw + (size_t)r32 * NINP + d0 * 16 + hi * 8);
        const GAS u64* mq = MASKT + ((size_t)b * 64) * SEQ + q0 + wid * 32 + r32;
        u64 mnext = mq[0], mprev = 0ull;
        f32x16 o[2], p0 = f32x16{}, p1 = f32x16{}; o[0] = f32x16{}; o[1] = f32x16{};
        float l_reg = 0.f, sq = 0.f;
        const unsigned sl_hi = __builtin_bit_cast(unsigned, slope2) & 0xffff0000u; const unsigned sl_lo = f2bf(slope2 - __builtin_bit_cast(float, sl_hi));
        bf16x8 kx0, kx1;
        { const unsigned j0 = hi ? 0u : (f2bf((float)r32) * 0x10001u), j1 = hi ? 0u : (f2bf((float)(r32 + 32)) * 0x10001u), one2 = hi ? 0u : 0x3f803f80u, one1 = hi ? 0u : 0x3f80u;
          kx0 = __builtin_bit_cast(bf16x8, (v4u){j0, one2, one1, 0u}); kx1 = __builtin_bit_cast(bf16x8, (v4u){j1, one2, one1, 0u}); }
        const int qlast = q0 + wid * 32 + 31;
        const int vb0 = (int)(unsigned)(uintptr_t)(shm + LDS_V2) + ((lane >> 4) & 1) * 32 + (lane & 3) * 8 + (4 * hi + ((lane & 15) >> 2)) * 64;
#define ATT_QK(ks) do { const LAS unsigned char* kb = shm + LDS_K + (ks) * SLOTB + hi * 1024 + r32 * 16; \
            { const unsigned u0_ = __builtin_bit_cast(unsigned, sq), a1_ = u0_ & 0xffff0000u; const float r1_ = sq - __builtin_bit_cast(float, a1_); const unsigned u1_ = __builtin_bit_cast(unsigned, r1_), a2_ = u1_ & 0xffff0000u; \
              const float r2_ = r1_ - __builtin_bit_cast(float, a2_); const unsigned a3_ = __builtin_bit_cast(unsigned, r2_) >> 16; \
              const bf16x8 qx = __builtin_bit_cast(bf16x8, (v4u){hi ? 0u : ((sl_hi >> 16) | (sl_lo << 16)), hi ? 0u : ((a1_ >> 16) | a2_), hi ? 0u : a3_, 0u}); \
              const f32x16 z_ = f32x16{}; p0 = __builtin_amdgcn_mfma_f32_32x32x16_bf16(kx0, qx, z_, 0, 0, 0); p1 = __builtin_amdgcn_mfma_f32_32x32x16_bf16(kx1, qx, z_, 0, 0, 0); } \
            _Pragma("unroll") for (int d0 = 0; d0 < 4; ++d0) { const bf16x8 k0 = *(const LAS bf16x8*)(kb + d0 * 2048), k1 = *(const LAS bf16x8*)(kb + d0 * 2048 + 512); \
                p0 = __builtin_amdgcn_mfma_f32_32x32x16_bf16(k0, qr[d0], p0, 0, 0, 0); p1 = __builtin_amdgcn_mfma_f32_32x32x16_bf16(k1, qr[d0], p1, 0, 0, 0); } } while (0)
#define ATT_SMPV(vs, mw) do { const unsigned w0 = (unsigned)(mw) >> (4 * hi), w1 = (unsigned)((mw) >> 32) >> (4 * hi); \
            asm volatile("s_nop 15\n\ts_nop 7" : "+v"(p0), "+v"(p1));   \
            _Pragma("unroll") for (int r = 0; r < 16; ++r) { const int cr = (r & 3) + 8 * (r >> 2); const int k0_ = __builtin_amdgcn_sbfe((int)w0, cr, 1), k1_ = __builtin_amdgcn_sbfe((int)w1, cr, 1); \
                asm("v_bfi_b32 %0, %1, %0, %2" : "+v"(p0[r]) : "v"(k0_), "v"(NEGINF)); asm("v_bfi_b32 %0, %1, %0, %2" : "+v"(p1[r]) : "v"(k1_), "v"(NEGINF)); } \
            const float rm = rowmax(p0, p1); bool resc = false; \
            if (__any(rm > THR)) { const float dl = fmaxf(rm, 0.f); \
                _Pragma("unroll") for (int r = 0; r < 16; ++r) { p0[r] -= dl; p1[r] -= dl; } sq -= dl; \
                const float f = __builtin_amdgcn_exp2f(-dl); l_reg *= f; if (hi == 0) wsf[r32] = f; resc = true; } \
            float sacc = 0.f; \
            _Pragma("unroll") for (int r = 0; r < 16; ++r) { p0[r] = __builtin_amdgcn_exp2f(p0[r]); p1[r] = __builtin_amdgcn_exp2f(p1[r]); sacc += p0[r] + p1[r]; } \
            l_reg += sacc; \
            if (resc) { asm volatile("s_waitcnt lgkmcnt(0)" ::: "memory"); \
                _Pragma("unroll") for (int d_ = 0; d_ < 2; ++d_) _Pragma("unroll") for (int r = 0; r < 16; ++r) o[d_][r] *= wsf[crow(r, hi)]; } \
            const v4u pw0 = (v4u){cvtpk(p0[0], p0[1]), cvtpk(p0[2], p0[3]), cvtpk(p0[4], p0[5]), cvtpk(p0[6], p0[7])}, pw1 = (v4u){cvtpk(p0[8], p0[9]), cvtpk(p0[10], p0[11]), cvtpk(p0[12], p0[13]), cvtpk(p0[14], p0[15])}; \
            const v4u pw2 = (v4u){cvtpk(p1[0], p1[1]), cvtpk(p1[2], p1[3]), cvtpk(p1[4], p1[5]), cvtpk(p1[6], p1[7])}, pw3 = (v4u){cvtpk(p1[8], p1[9]), cvtpk(p1[10], p1[11]), cvtpk(p1[12], p1[13]), cvtpk(p1[14], p1[15])}; \
            __builtin_amdgcn_sched_barrier(0); \
            pv(o, vb0 + (vs) * SLOTB, __builtin_bit_cast(bf16x8, pw0), __builtin_bit_cast(bf16x8, pw1), __builtin_bit_cast(bf16x8, pw2), __builtin_bit_cast(bf16x8, pw3)); } while (0)
        if constexpr (grpB) __builtin_amdgcn_s_setprio(1);
        const float step = 64.f * slope2;
        int ks = 0, vs = 0;
        u64 mcur = 0ull;
#define ATT_SYNC(t) do { if ((t) + 1 < NT) asm volatile("s_waitcnt vmcnt(2)" ::: "memory"); else asm volatile("s_waitcnt vmcnt(0)" ::: "memory"); \
            asm volatile("s_waitcnt lgkmcnt(0)" ::: "memory"); __builtin_amdgcn_s_barrier(); asm volatile("" ::: "memory"); \
            mprev = mcur; mcur = mnext; if ((t) + 1 < NT) mnext = mq[(size_t)((t) + 1) * SEQ]; \
            __builtin_amdgcn_sched_barrier(0); \
            if ((t) + 2 < NT) ATT_DMA((t) + 2, ks + 2 >= NSLOT ? ks + 2 - NSLOT : ks + 2, vs + 2 >= NSV ? vs + 2 - NSV : vs + 2); \
            __builtin_amdgcn_sched_barrier(0); } while (0)
#define ATT_ADV() do { sq += step; ks = ks + 1 >= NSLOT ? 0 : ks + 1; vs = vs + 1 >= NSV ? 0 : vs + 1; } while (0)
        const int tmax = qlast >> 6;
        if constexpr (!grpB) {
            int t = 0;
            for (; t <= tmax; ++t) { ATT_SYNC(t); ATT_QK(ks); ATT_SMPV(vs, mcur); ATT_ADV(); }
            for (; t < NT; ++t) { ATT_SYNC(t); ATT_ADV(); }
        } else {
            ATT_SYNC(0); ATT_QK(ks); ATT_ADV();
            int t = 1;
            for (; t <= tmax; ++t) { ATT_SYNC(t); ATT_SMPV(vs == 0 ? NSV - 1 : vs - 1, mprev); ATT_QK(ks); ATT_ADV(); }
            if (t < NT) { ATT_SYNC(t); ATT_SMPV(vs == 0 ? NSV - 1 : vs - 1, mprev); ATT_ADV(); ++t;
                for (; t < NT; ++t) { ATT_SYNC(t); ATT_ADV(); } }
            else { ATT_SMPV(vs == 0 ? NSV - 1 : vs - 1, mcur); }
        }
#undef ATT_SYNC
#undef ATT_ADV
        __builtin_amdgcn_s_setprio(0);
        l_reg += __shfl_xor(l_reg, 32);
        if (hi == 0) wsf[32 + r32] = l_reg;
        asm volatile("s_waitcnt lgkmcnt(0)" ::: "memory");
        float rli[16];
#pragma unroll
        for (int r = 0; r < 16; ++r) rli[r] = 1.f / wsf[32 + crow(r, hi)];
        GAS bf16* Ow = CAT + (rowbase + q0 + wid * 32) * D + 512 + h * 64;
        { LAS bf16* stg = (LAS bf16*)(shm + LDS_OST2) + wid * 2048;
#pragma unroll
            for (int r = 0; r < 16; ++r) { const int orow = crow(r, hi);
#pragma unroll
                for (int d0 = 0; d0 < 2; ++d0) stg[orow * 64 + d0 * 32 + r32] = (bf16)f2bf(o[d0][r] * rli[r]); }
            asm volatile("s_waitcnt lgkmcnt(0)" ::: "memory");
#pragma unroll
            for (int i = 0; i < 4; ++i) { const int row = i * 8 + (lane >> 3), ch = lane & 7; const v4u vv = *(const LAS v4u*)(stg + row * 64 + ch * 8); *(GAS v4u*)(Ow + (size_t)row * D + ch * 8) = vv; } }
        asm volatile("s_waitcnt vmcnt(0) lgkmcnt(0)" ::: "memory"); __builtin_amdgcn_s_barrier(); asm volatile("" ::: "memory");
#undef ATT_DMA
#undef ATT_QK
#undef ATT_SMPV
    }
}

__device__ __forceinline__ void p_attn_dense(Frame& F) { if (F.wave >= 4) attn_units<true>(F); else attn_units<false>(F); }

struct EpiResid {
    static constexpr bool PERM = true, AFTER_DRAIN = false;
    const bf16* resid; bf16* out; float alpha;
    __device__ __forceinline__ void operator()(const pg8::f32x4 (&acc)[2][2][4][2], const pg8::Unit& u, int wr, int wc, int fr, int fq) const {
        const int col0 = u.pn * 256 + wc * 32 + 8 * fq;
#pragma unroll
        for (int ai = 0; ai < 2; ++ai)
#pragma unroll
            for (int m = 0; m < 4; ++m) { const size_t off = (size_t)(u.pm * 256 + ai * 128 + wr * 64 + m * 16 + fr) * D + col0;
#pragma unroll
                for (int bj = 0; bj < 2; ++bj) { const v4u xr = *(const GAS v4u*)(resid + off + bj * 128); const f32x4 a0 = acc[ai][bj][m][0], a1 = acc[ai][bj][m][1];
                    v4u w; w.x = pk2(bflo(xr.x) * alpha + a0[0], bfhi(xr.x) * alpha + a0[1]); w.y = pk2(bflo(xr.y) * alpha + a0[2], bfhi(xr.y) * alpha + a0[3]);
                    w.z = pk2(bflo(xr.z) * alpha + a1[0], bfhi(xr.z) * alpha + a1[1]); w.w = pk2(bflo(xr.w) * alpha + a1[2], bfhi(xr.w) * alpha + a1[3]);
                    st16_wt(out + off + bj * 128, w.x, w.y, w.z, w.w); }
                if (m & 1) asm volatile("" ::: "memory"); }
    }
};
struct EpiSwiglu {
    static constexpr bool PERM = true, AFTER_DRAIN = false;
    unsigned char* O; const float* bias;
    __device__ __forceinline__ void operator()(const pg8::f32x4 (&acc)[2][2][4][2], const pg8::Unit& u, int wr, int wc, int fr, int fq) const {
        const int e = u.pn >> 3, nt = u.pn & 7; const int colg = nt * 128 + wc * 32 + 8 * fq;
        f32x4 bg[2], bu[2];
#pragma unroll
        for (int n = 0; n < 2; ++n) { bg[n] = *(const GAS f32x4*)(bias + (size_t)e * 2048 + colg + 4 * n); bu[n] = *(const GAS f32x4*)(bias + (size_t)e * 2048 + 1024 + colg + 4 * n); }
#pragma unroll
        for (int ai = 0; ai < 2; ++ai)
#pragma unroll
            for (int m = 0; m < 4; ++m) { const size_t row = (size_t)(u.pm * 256 + ai * 128 + wr * 64 + m * 16 + fr); float a8[8];
#pragma unroll
                for (int n = 0; n < 2; ++n)
#pragma unroll
                    for (int i = 0; i < 4; ++i) { float g = fmaf(acc[ai][0][m][n][i], 1.f / WGU_SCALE, bg[n][i]), up = fmaf(acc[ai][1][m][n][i], 1.f / WGU_SCALE, bu[n][i]);
                        g = fminf(g, 7.f); up = fminf(fmaxf(up, -7.f), 7.f);
                        a8[n * 4 + i] = g * (up + 1.f) * __builtin_amdgcn_rcpf(1.f + __builtin_amdgcn_exp2f(-1.702f * 1.4426950408889634f * g)); }
                v2u w; w.x = pk4_fp8(a8[0], a8[1], a8[2], a8[3]); w.y = pk4_fp8(a8[4], a8[5], a8[6], a8[7]);
                st8_wt(O + row * 1024 + colg, w.x, w.y); }
    }
};
struct EpiDown {
    static constexpr bool PERM = true, AFTER_DRAIN = false;
    bf16* O; const float* bias;
    __device__ __forceinline__ void operator()(const pg8::f32x4 (&acc)[2][2][4][2], const pg8::Unit& u, int wr, int wc, int fr, int fq) const {
        const int col0 = (u.pn & 3) * 256 + wc * 32 + 8 * fq; const float* bp = bias + (size_t)(u.pn >> 2) * 1024 + col0;
        f32x4 bv[2][2];
#pragma unroll
        for (int bj = 0; bj < 2; ++bj)
#pragma unroll
            for (int n = 0; n < 2; ++n) bv[bj][n] = *(const GAS f32x4*)(bp + bj * 128 + 4 * n);
#pragma unroll
        for (int ai = 0; ai < 2; ++ai)
#pragma unroll
            for (int m = 0; m < 4; ++m) { bf16* rowp = O + (size_t)(u.pm * 256 + ai * 128 + wr * 64 + m * 16 + fr) * 1024 + col0;
#pragma unroll
                for (int bj = 0; bj < 2; ++bj) { const f32x4 v0 = acc[ai][bj][m][0] * (1.f / WDN_SCALE) + bv[bj][0], v1 = acc[ai][bj][m][1] * (1.f / WDN_SCALE) + bv[bj][1];
                    v4u w; w.x = pk2(v0[0], v0[1]); w.y = pk2(v0[2], v0[3]); w.z = pk2(v1[0], v1[1]); w.w = pk2(v1[2], v1[3]);
                    st16_wt(rowp + bj * 128, w.x, w.y, w.z, w.w); } }
    }
};
struct MoeSched {
    const LAS int* tab; int n;
    __device__ __forceinline__ bool next(int i, pg8::Unit& u) const {
        if (i >= n) return false;
        const int v = __builtin_amdgcn_readfirstlane(tab[1 + i]); u.pm = v >> 16; u.pn = v & 0xffff; return true;
    }
    __device__ __forceinline__ void a_ready(const pg8::Unit&) const {}
    __device__ __forceinline__ void done(const pg8::Unit&) const {}
};
#ifndef MOE_UNIT_OWNER
#define MOE_UNIT_OWNER F.vcu
#endif
__device__ __forceinline__ int moe_table(Frame& F, int l, int ntn) {
    LAS int* tab = (LAS int*)(F.lds + TAB_OFF);
    if (F.wave == 0) {
        const int lane = F.lane; const int cnt = lane < NE ? (int)__hip_atomic_load(F.ctl + CW_CNT + 64 * l + lane, RLX_AGENT) : 0; const int mt = (cnt + 255) >> 8; int incl = mt;
#pragma unroll
        for (int o = 1; o < 64; o <<= 1) { const int v = __shfl_up(incl, o); if (lane >= o) incl += v; }
        const int total = __shfl(incl, 63) * ntn; const int c = MOE_UNIT_OWNER;
        const int xcd = c >> 5, jw = c & 31, uq = total >> 3, ur = total & 7, cntx = uq + (xcd < ur ? 1 : 0), basex = xcd * uq + (xcd < ur ? xcd : ur);
        const int nmine = jw < cntx ? (cntx - jw + 31) >> 5 : 0;
        for (int i0 = 0; i0 < nmine && i0 < 200; i0 += 64) { const int i = i0 + lane; const int L = basex + i * 32 + jw; int e = 0;
            for (int k = 0; k < NE; ++k) { const int endk = __shfl(incl, k) * ntn; e += (L >= endk) ? 1 : 0; }
            e = e < NE ? e : NE - 1;
            const int excl_e = __shfl(incl, e) - __shfl(mt, e); int mte = __shfl(mt, e); mte = mte > 0 ? mte : 1; const int idx = L - excl_e * ntn;
            if (i < nmine && i < 200) tab[1 + i] = ((excl_e + idx % mte) << 16) | (e * ntn + idx / mte); }
        if (lane == 0) tab[0] = nmine < 200 ? nmine : 200;
    }
    __syncthreads();
    return __builtin_amdgcn_readfirstlane(tab[0]);
}

__device__ __forceinline__ void p_router(Frame& F, const In6& A, int l) {
    const int lane = F.lane, wave = F.wave, tid = F.tid;
    constexpr int XROW = 2064;
    LAS unsigned char* XH = F.lds; LAS unsigned char* XL = F.lds + 16 * XROW;
    LAS float* part = (LAS float*)(F.lds + 2 * 16 * XROW);
    LAS int* cnt = (LAS int*)(F.lds + 2 * 16 * XROW + 16384);
    LAS float* lgs = (LAS float*)(F.lds + 2 * 16 * XROW + 16384 + 1024);
    LAS float* top = lgs + 512;
    const GAS bf16* Y1 = (const GAS bf16*)(F.ws + WS_Y1); GAS bf16* X1B = (GAS bf16*)(F.ws + WS_Y1 + 32 * MiB); GAS unsigned* XB8 = (GAS unsigned*)(F.ws + WS_XB8);
    GAS int* TOPE = (GAS int*)(F.ws + WS_ROUTE); GAS float* GATE = (GAS float*)(TOPE + 8 * T); GAS int* CNTW = (GAS int*)(F.ws + WS_CNTW);
    const GAS float* g1 = (const GAS float*)(A.p[0] + l * D); const GAS float* b1 = (const GAS float*)(A.p[1] + l * D);
    const GAS float* RW = (const GAS float*)(A.p[2] + (size_t)l * D * NE); const GAS float* RB = (const GAS float*)(A.p[3] + l * NE);
    if (tid < 256) cnt[tid] = 0;
    bf16x8 wh[4][2], wl[4][2];
#pragma unroll
    for (int st = 0; st < 4; ++st)
#pragma unroll
        for (int hf = 0; hf < 2; ++hf) { const GAS float* wp = RW + (size_t)(wave * 128 + st * 32 + (lane >> 4) * 8) * NE + (lane & 15) + 16 * hf;
#pragma unroll
            for (int j = 0; j < 8; ++j) { const float w = wp[(size_t)j * NE]; const unsigned h = f2bf(w); const float r = w - __builtin_bit_cast(float, h << 16); wh[st][hf][j] = (short)h; wl[st][hf][j] = (short)f2bf(r); } }
    f32x4 g1v[4], b1v[4];
#pragma unroll
    for (int j = 0; j < 4; ++j) { g1v[j] = ((const GAS f32x4*)g1)[lane + 64 * j]; b1v[j] = ((const GAS f32x4*)b1)[lane + 64 * j]; }
    const float rb_e = RB[tid & 31];
    v2u yq[2][4];
#pragma unroll
    for (int i = 0; i < 2; ++i) { const GAS v2u* yr = (const GAS v2u*)(Y1 + (size_t)(F.vcu * 64 + wave * 2 + i) * D) + lane;
#pragma unroll
        for (int j = 0; j < 4; ++j) yq[i][j] = yr[64 * j]; }
    for (int g = 0; g < 4; ++g) {
        const int t0 = F.vcu * 64 + g * 16;
#pragma unroll
        for (int i = 0; i < 2; ++i) { const int tl = wave * 2 + i, t = t0 + tl;
            GAS u64* xr1 = (GAS u64*)(X1B + (size_t)t * D) + lane; f32x4 v[4]; float s = 0.f;
#pragma unroll
            for (int j = 0; j < 4; ++j) { const v2u q = yq[i][j]; v[j] = (f32x4){bflo(q.x), bfhi(q.x), bflo(q.y), bfhi(q.y)}; s += (v[j].x + v[j].y) + (v[j].z + v[j].w); }
            if (g < 3) { const GAS v2u* yr = (const GAS v2u*)(Y1 + (size_t)(t + 16) * D) + lane;
#pragma unroll
                for (int j = 0; j < 4; ++j) yq[i][j] = yr[64 * j]; }
            const float mean = wave_sum(s) * (1.f / D); float s2 = 0.f;
#pragma unroll
            for (int j = 0; j < 4; ++j) { v[j] = v[j] - mean; s2 += (v[j].x * v[j].x + v[j].y * v[j].y) + (v[j].z * v[j].z + v[j].w * v[j].w); }
            const float rstd = rsqrtf(wave_sum(s2) * (1.f / D) + LN_EPS);
            GAS unsigned* o8 = XB8 + (size_t)t * (D / 4) + lane;
#pragma unroll
            for (int j = 0; j < 4; ++j) { const f32x4 y = v[j] * rstd * g1v[j] + b1v[j];
                o8[64 * j] = pk4_fp8(y.x, y.y, y.z, y.w);
                const unsigned h0 = f2bf(y.x), h1 = f2bf(y.y), h2 = f2bf(y.z), h3 = f2bf(y.w);
                const u64 hp = (u64)(h0 | (h1 << 16)) | ((u64)(h2 | (h3 << 16)) << 32); xr1[64 * j] = hp;
                const float r0 = y.x - __builtin_bit_cast(float, h0 << 16), r1 = y.y - __builtin_bit_cast(float, h1 << 16), r2 = y.z - __builtin_bit_cast(float, h2 << 16), r3 = y.w - __builtin_bit_cast(float, h3 << 16);
                *(LAS u64*)(XH + tl * XROW + (lane + 64 * j) * 8) = hp;
                *(LAS u64*)(XL + tl * XROW + (lane + 64 * j) * 8) = (u64)pk2(r0, r1) | ((u64)pk2(r2, r3) << 32); } }
        __syncthreads();
        f32x4 acc[2]; acc[0] = (f32x4){0.f, 0.f, 0.f, 0.f}; acc[1] = acc[0];
#pragma unroll
        for (int st = 0; st < 4; ++st) { const int boff = (lane & 15) * XROW + (wave * 128 + st * 32 + (lane >> 4) * 8) * 2;
            const bf16x8 bh = *(const LAS bf16x8*)(XH + boff), bl = *(const LAS bf16x8*)(XL + boff);
#pragma unroll
            for (int hf = 0; hf < 2; ++hf) { acc[hf] = __builtin_amdgcn_mfma_f32_16x16x32_bf16(wh[st][hf], bh, acc[hf], 0, 0, 0); acc[hf] = __builtin_amdgcn_mfma_f32_16x16x32_bf16(wh[st][hf], bl, acc[hf], 0, 0, 0);
                acc[hf] = __builtin_amdgcn_mfma_f32_16x16x32_bf16(wl[st][hf], bh, acc[hf], 0, 0, 0); } }
#pragma unroll
        for (int hf = 0; hf < 2; ++hf)
#pragma unroll
            for (int r = 0; r < 4; ++r) part[((wave * 2 + hf) * 16 + 4 * (lane >> 4) + r) * 16 + (lane & 15)] = acc[hf][r];
        __syncthreads();
        { const int tl = tid >> 5, e = tid & 31, t = t0 + tl; float lg = rb_e;
#pragma unroll
            for (int w = 0; w < 8; ++w) lg += part[((w * 2 + (e >> 4)) * 16 + (e & 15)) * 16 + tl];
            lgs[tl * 32 + e] = lg;
            LDS_WAIT(); asm volatile("" ::: "memory");
            int rank = 0;
#pragma unroll
            for (int q = 0; q < 8; ++q) { const f32x4 o = *(const LAS f32x4*)(lgs + tl * 32 + 4 * q);
#pragma unroll
                for (int i = 0; i < 4; ++i) { const int eo = 4 * q + i; rank += (o[i] > lg || (o[i] == lg && eo < e)) ? 1 : 0; } }
            if (rank < 4) { top[tl * 4 + rank] = lg; __hip_atomic_fetch_add(cnt + ((g * 16 + tl) >> 3) * 32 + e, 1, __ATOMIC_RELAXED, __HIP_MEMORY_SCOPE_WORKGROUP); }
            LDS_WAIT(); asm volatile("" ::: "memory");
            const f32x4 sv = *(const LAS f32x4*)(top + tl * 4);
            const float e1 = expf(sv[1] - sv[0]), e2 = expf(sv[2] - sv[0]), e3 = expf(sv[3] - sv[0]); const float inv = 1.f / (1.f + e1 + e2 + e3);
            if (rank < 4) { const float gk = (rank == 0 ? 1.f : rank == 1 ? e1 : rank == 2 ? e2 : e3) * inv; TOPE[4 * t + rank] = e; GATE[4 * t + rank] = gk; } }
    }
    __syncthreads();
    if (tid < 256) CNTW[(F.vcu * NWAVES + (tid >> 5)) * NE + (tid & 31)] = cnt[tid];
    __syncthreads();
}

__device__ __forceinline__ void p_gather(Frame& F, int l) {
    const int gw = F.vcu * NWAVES + F.wave, NGW = F.G * NWAVES, lane = F.lane, tid = F.tid;
    const int TPW = T / NGW, NIT = TPW * 4;
    const GAS int* CNTW = (const GAS int*)(F.ws + WS_CNTW);
    LAS int* red = (LAS int*)F.lds;
    LAS int* baseE = red + 1024; LAS int* totE = baseE + 32;
    { const int e = tid & 31, part = tid >> 5, first = F.vcu * NWAVES; int sb = 0, st = 0;
        for (int g0 = part; g0 < NGW; g0 += 256) { int c[16];
#pragma unroll
            for (int k = 0; k < 16; ++k) c[k] = g0 + 16 * k < NGW ? CNTW[(g0 + 16 * k) * NE + e] : 0;
#pragma unroll
            for (int k = 0; k < 16; ++k) { st += c[k]; sb += g0 + 16 * k < first ? c[k] : 0; } }
        red[part * 32 + e] = sb; red[512 + part * 32 + e] = st; }
    __syncthreads();
    if (tid < 32) { int sb = 0, st = 0;
#pragma unroll
        for (int p = 0; p < 16; ++p) { sb += red[p * 32 + tid]; st += red[512 + p * 32 + tid]; }
        baseE[tid] = sb; totE[tid] = st;
        if (F.vcu == 0) __hip_atomic_store(F.ctl + CW_CNT + 64 * l + tid, (unsigned)st, RLX_AGENT); }
    __syncthreads();
    int mybase = 0, tot = 0;
    if (lane < NE) { mybase = baseE[lane]; tot = totE[lane]; int cw[NWAVES - 1];
#pragma unroll
        for (int w = 0; w < NWAVES - 1; ++w) cw[w] = CNTW[(F.vcu * NWAVES + w) * NE + lane];
#pragma unroll
        for (int w = 0; w < NWAVES - 1; ++w) mybase += w < F.wave ? cw[w] : 0; }
    const int mt = (tot + 255) >> 8; int incl = mt;
#pragma unroll
    for (int o = 1; o < 64; o <<= 1) { const int v = __shfl_up(incl, o); if (lane >= o) incl += v; }
    const int pstart = (incl - mt) * 256;
    const GAS int* TOPE = (const GAS int*)(F.ws + WS_ROUTE); GAS int* ROWOF = (GAS int*)(F.ws + WS_ROUTE) + 12 * T; GAS int* ROWTOK = (GAS int*)(F.ws + WS_XS);
    if (F.vcu < NE && F.wave == 0) {
        const int e = F.vcu; const int ps = __builtin_amdgcn_readlane(pstart, e), te = __builtin_amdgcn_readlane(tot, e), me = __builtin_amdgcn_readlane(mt, e);
        for (int i = te + lane; i < me * 256; i += 64) ROWTOK[ps + i] = 0; }
    const int it0 = gw * NIT; const int ei = lane < NIT ? TOPE[it0 + lane] : 0; int rk = 0;
    for (int j = 0; j < NIT; ++j) { const int ej = __shfl(ei, j); rk += (j < lane && ej == ei) ? 1 : 0; }
    const int row = __shfl(pstart, ei) + __shfl(mybase, ei) + rk;
    if (lane < NIT) { ROWOF[it0 + lane] = row; ROWTOK[row] = (it0 + lane) >> 2; }
    __syncthreads();
}

__device__ __forceinline__ void p_combine(Frame& F, const In6& A, int l, float* xout_) {
    constexpr int TPW = 8;
    const int gw = F.vcu * NWAVES + F.wave, NGW = F.G * NWAVES, lane = F.lane;
    const GAS int* ROWOF = (const GAS int*)(F.ws + WS_ROUTE) + 12 * T; const GAS float* GATE = (const GAS float*)(F.ws + WS_ROUTE) + 8 * T;
    const GAS bf16* X1B = (const GAS bf16*)(F.ws + WS_Y1 + 32 * MiB); const GAS bf16* YS = (const GAS bf16*)(F.ws + WS_YS); GAS bf16* XB = (GAS bf16*)(F.ws + WS_XB);
    GAS float* xout = (GAS float*)xout_;
    const GAS f32x4* g2 = (const GAS f32x4*)(A.p[0] + l * D) + lane; const GAS f32x4* b2 = (const GAS f32x4*)(A.p[1] + l * D) + lane;
    int rowv = 0; float gatev = 0.f;
    if (lane < 4 * TPW) { const int tk = gw + (lane >> 2) * NGW; rowv = ROWOF[4 * tk + (lane & 3)]; gatev = GATE[4 * tk + (lane & 3)]; }
    f32x4 gg[4], bb[4];
#pragma unroll
    for (int j = 0; j < 4; ++j) { gg[j] = g2[64 * j]; bb[j] = b2[64 * j]; }
    v2u xq[2][4], yq[2][4][4];
#define CMB_ISSUE(k, bf) do { const int t_ = gw + (k) * NGW; const GAS v2u* xr_ = (const GAS v2u*)(X1B + (size_t)t_ * D) + lane; \
        _Pragma("unroll") for (int j = 0; j < 4; ++j) xq[bf][j] = xr_[64 * j]; \
        _Pragma("unroll") for (int c = 0; c < 4; ++c) { const int row_ = __builtin_amdgcn_readlane(rowv, 4 * (k) + c); const GAS v2u* yr_ = (const GAS v2u*)(YS + (size_t)row_ * D) + lane; \
            _Pragma("unroll") for (int j = 0; j < 4; ++j) yq[bf][c][j] = yr_[64 * j]; } } while (0)
    CMB_ISSUE(0, 0);
#pragma unroll
    for (int k = 0; k < TPW; ++k) {
        const int bf = k & 1, t = gw + k * NGW;
        if (k + 1 < TPW) { if (bf == 0) CMB_ISSUE(k + 1, 1); else CMB_ISSUE(k + 1, 0); }
        f32x4 v[4];
#pragma unroll
        for (int j = 0; j < 4; ++j) { const v2u q = xq[bf][j]; v[j] = (f32x4){bflo(q.x), bfhi(q.x), bflo(q.y), bfhi(q.y)} * DN_ALPHA; }
#pragma unroll
        for (int c = 0; c < 4; ++c) { const float gk = __builtin_bit_cast(float, __builtin_amdgcn_readlane(__builtin_bit_cast(int, gatev), 4 * k + c));
#pragma unroll
            for (int j = 0; j < 4; ++j) { const v2u w = yq[bf][c][j]; v[j].x += gk * bflo(w.x); v[j].y += gk * bfhi(w.x); v[j].z += gk * bflo(w.y); v[j].w += gk * bfhi(w.y); } }
        float s = 0.f;
#pragma unroll
        for (int j = 0; j < 4; ++j) s += (v[j].x + v[j].y) + (v[j].z + v[j].w);
        const float mean = wave_sum(s) * (1.f / D); float s2 = 0.f;
#pragma unroll
        for (int j = 0; j < 4; ++j) { v[j] = v[j] - mean; s2 += (v[j].x * v[j].x + v[j].y * v[j].y) + (v[j].z * v[j].z + v[j].w * v[j].w); }
        const float rstd = rsqrtf(wave_sum(s2) * (1.f / D) + LN_EPS);
        GAS f32x4* orow = (GAS f32x4*)(xout + (size_t)t * D) + lane; GAS u64* o8 = (GAS u64*)(XB + (size_t)t * D) + lane;
#pragma unroll
        for (int j = 0; j < 4; ++j) { const f32x4 y = v[j] * rstd * gg[j] + bb[j];
            if (xout_) __builtin_nontemporal_store(y, orow + 64 * j); else o8[64 * j] = (u64)pk2(y.x, y.y) | ((u64)pk2(y.z, y.w) << 32); }
        __builtin_amdgcn_sched_barrier(0);
    }
#undef CMB_ISSUE
}


#define NI __device__ __forceinline__
NI void ph_prologue(unsigned char* ws, LAS unsigned char* lds, const float* a0, const float* a1, const float* a2, const float* a3, const float* a4) { Frame F = make_frame(ws, lds); In6 I{{uni(a0), uni(a1), uni(a2), uni(a3), uni(a4), nullptr}}; p_prologue(F, I); }
NI void ph_local(unsigned char* ws, LAS unsigned char* lds, int l, const float* a0, const float* a1, const float* a2, const float* a3, const float* a4) { Frame F = make_frame(ws, lds); In6 I{{uni(a0), uni(a1), uni(a2), uni(a3), uni(a4), nullptr}}; p_local(F, I, __builtin_amdgcn_readfirstlane(l)); }
NI void ph_scores(unsigned char* ws, LAS unsigned char* lds) { Frame F = make_frame(ws, lds); p_index(F); }
NI void ph_attn(unsigned char* ws, LAS unsigned char* lds) { Frame F = make_frame(ws, lds); p_attn_dense(F); }
NI void ph_router(unsigned char* ws, LAS unsigned char* lds, int l, const float* a0, const float* a1, const float* a2, const float* a3) { Frame F = make_frame(ws, lds); In6 I{{uni(a0), uni(a1), uni(a2), uni(a3), nullptr, nullptr}}; p_router(F, I, __builtin_amdgcn_readfirstlane(l)); }
NI void ph_gather(unsigned char* ws, LAS unsigned char* lds, int l) { Frame F = make_frame(ws, lds); p_gather(F, __builtin_amdgcn_readfirstlane(l)); }
NI void ph_combine(unsigned char* ws, LAS unsigned char* lds, int l, const float* a0, const float* a1, float* xout) { Frame F = make_frame(ws, lds); In6 I{{uni(a0), uni(a1), nullptr, nullptr, nullptr, nullptr}}; p_combine(F, I, __builtin_amdgcn_readfirstlane(l), (float*)uni(xout)); }

NI void ph_gemm_in(unsigned char* ws, LAS unsigned char* lds, int l_) {
    Frame F = make_frame(ws, lds); const int l = __builtin_amdgcn_readfirstlane(l_);
    pg8::Gemm g{WSP(bf16, WS_XB), WSP(bf16, WS_WIN) + (size_t)l * NINP * D, T, NINP, D}; pg8::StaticOrder S; S.init(T, NINP, F.G, (int)blockIdx.x);
    pg8::EpiBf16<0> E{WSP(bf16, WS_PROJ), NINP, nullptr, 0, 0, 1.f};
    pg8::gemm_phase<pg8::EpiBf16<0>, pg8::StaticOrder, PG8_ALIGN, PG8_SP2>(F.lds, g, S, E);
}
NI void ph_gemm_out(unsigned char* ws, LAS unsigned char* lds, int l_, const float* xin) {
    Frame F = make_frame(ws, lds); const int l = __builtin_amdgcn_readfirstlane(l_);
    pg8::Gemm g{WSP(bf16, WS_CAT), WSP(bf16, WS_WOUT) + (size_t)l * D * D, T, D, D}; pg8::StaticOrder S; S.init(T, D, F.G, (int)blockIdx.x);
    EpiResid E{WSP(bf16, WS_XB), WSP(bf16, WS_Y1), DN_ALPHA};
    pg8::gemm_phase<EpiResid, pg8::StaticOrder, PG8_ALIGN, PG8_SP2>(F.lds, g, S, E);
}
NI void ph_gemm_moe1(unsigned char* ws, LAS unsigned char* lds, int l_, const float* bgu) {
    Frame F = make_frame(ws, lds); const int l = __builtin_amdgcn_readfirstlane(l_);
    const int nun = moe_table(F, l, 8);
    pg8::Gemm g{WSP(bf16, WS_XB8), (const bf16*)(WSP(unsigned char, WS_WGU) + (size_t)l * NE * 2048 * D * 2), MAXROWS, NE * 2048, D};
    MoeSched S{(const LAS int*)(F.lds + TAB_OFF), nun};
    EpiSwiglu E{WSP(unsigned char, WS_ACT), uni(bgu) + (size_t)l * NE * 2048};
    pg8::gemm_phase<EpiSwiglu, MoeSched, PG8_ALIGN, true, 1, true>(F.lds, g, S, E, WSP(int, WS_XS));
}
NI void ph_gemm_moe2(unsigned char* ws, LAS unsigned char* lds, int l_, const float* bdn) {
    Frame F = make_frame(ws, lds); const int l = __builtin_amdgcn_readfirstlane(l_);
    const int nun = moe_table(F, l, 4);
    pg8::Gemm g{WSP(bf16, WS_ACT), (const bf16*)(WSP(unsigned char, WS_WDN) + (size_t)l * NE * D * D * 2), MAXROWS, NE * D, D};
    MoeSched S{(const LAS int*)(F.lds + TAB_OFF), nun};
    EpiDown E{WSP(bf16, WS_YS), uni(bdn) + (size_t)l * NE * D};
    pg8::gemm_phase<EpiDown, MoeSched, PG8_ALIGN, MOE_SP2, 1>(F.lds, g, S, E);
}

__device__ __forceinline__ const float* karg_in(int i) { return ((const float* const volatile*)__builtin_amdgcn_kernarg_segment_ptr())[i]; }
__device__ __forceinline__ float* karg_out() { return ((float* const volatile*)__builtin_amdgcn_kernarg_segment_ptr())[N_IN]; }
#ifndef PHMASK
#define PHMASK 0x7FF
#endif
constexpr int PH_PER_LAYER = 10, N_PHASES = 1 + DEPTH * PH_PER_LAYER;
#define IN(k) (lo <= (k) && (k) < hi)
#define SEAM(k) do { if (IN(k) && IN((k) + 1)) xcd_barrier(bar); } while (0)
template <int l> __device__ __forceinline__ void layer_phases(Frame& F, const XcdBarrier& bar, int lo, int hi) {
        const int p0 = 1 + l * PH_PER_LAYER;
        const float* xin = nullptr;
        float* xout = l == DEPTH - 1 ? karg_out() : nullptr;
        if (((PHMASK >> 0) & 1) && IN(p0 + 0)) { asm volatile("; PHASE_BEGIN_0"); ph_gemm_in(F.ws, F.lds, l); SEAM(p0 + 0); }
        if (((PHMASK >> 1) & 1) && IN(p0 + 1)) { asm volatile("; PHASE_BEGIN_1"); ph_local(F.ws, F.lds, l, karg_in(IN_WPOOL), karg_in(IN_CONVW), karg_in(IN_PSCALE), karg_in(IN_KNG), karg_in(IN_KNB)); SEAM(p0 + 1); }
        if (((PHMASK >> 2) & 1) && IN(p0 + 2)) { asm volatile("; PHASE_BEGIN_2"); ph_scores(F.ws, F.lds); SEAM(p0 + 2); }
        if (((PHMASK >> 3) & 1) && IN(p0 + 3)) { asm volatile("; PHASE_BEGIN_3"); ph_attn(F.ws, F.lds); SEAM(p0 + 3); }
        if (((PHMASK >> 4) & 1) && IN(p0 + 4)) { asm volatile("; PHASE_BEGIN_4"); ph_gemm_out(F.ws, F.lds, l, xin); SEAM(p0 + 4); }
        if (((PHMASK >> 5) & 1) && IN(p0 + 5)) { asm volatile("; PHASE_BEGIN_5"); ph_router(F.ws, F.lds, l, karg_in(IN_LN1G), karg_in(IN_LN1B), karg_in(IN_RW), karg_in(IN_RB)); SEAM(p0 + 5); }
        if (((PHMASK >> 6) & 1) && IN(p0 + 6)) { asm volatile("; PHASE_BEGIN_6"); ph_gather(F.ws, F.lds, l); SEAM(p0 + 6); }
        if (((PHMASK >> 7) & 1) && IN(p0 + 7)) { asm volatile("; PHASE_BEGIN_7"); ph_gemm_moe1(F.ws, F.lds, l, karg_in(IN_BGU)); SEAM(p0 + 7); }
        if (((PHMASK >> 8) & 1) && IN(p0 + 8)) { asm volatile("; PHASE_BEGIN_8"); ph_gemm_moe2(F.ws, F.lds, l, karg_in(IN_BDN)); SEAM(p0 + 8); }
        if (((PHMASK >> 9) & 1) && IN(p0 + 9)) { asm volatile("; PHASE_BEGIN_9"); ph_combine(F.ws, F.lds, l, karg_in(IN_LN2G), karg_in(IN_LN2B), xout); SEAM(p0 + 9); }
}
#undef IN
#undef SEAM
__global__ void __launch_bounds__(NWAVES * 64, 2) fwd_kernel(Args A) {
    extern __shared__ __attribute__((aligned(16))) unsigned char lds[];
    Frame F;
    F.lds = (LAS unsigned char*)lds;
    F.tid = threadIdx.x; F.lane = F.tid & 63; F.wave = __builtin_amdgcn_readfirstlane(F.tid >> 6);
    F.G = gridDim.x; { const int bx = blockIdx.x; F.vcu = (F.G % 8 == 0) ? (bx % 8) * (F.G / 8) + bx / 8 : bx; }
    F.ws = A.ws; F.ctl = (gu32*)(A.ws + WS_CTL);
    volatile LAS unsigned* MISC = (volatile LAS unsigned*)(F.lds + MISC_OFF);
    if (F.tid < 32) MISC[F.tid] = 0u;
    __syncthreads();
    const int lo = A.ph_lo, hi = A.ph_hi;
    const bool multi = (hi - lo) > 1;
    XcdBarrier bar; bar.bar = (unsigned*)(F.ctl + CW_BAR); bar.x = 0; bar.st = nullptr;
    if (multi) bar = xcd_barrier_post((unsigned*)(F.ctl + CW_BAR), MISC + 8);
#define IN(k) (lo <= (k) && (k) < hi)
#define SEAM(k) do { if (IN(k) && IN((k) + 1)) xcd_barrier(bar); } while (0)

    if (((PHMASK >> 10) & 1) && IN(0)) { asm volatile("; PHASE_BEGIN_11"); ph_prologue(F.ws, F.lds, karg_in(IN_WIN), karg_in(IN_WOUT), karg_in(IN_WGU), karg_in(IN_WDN), karg_in(IN_X)); SEAM(0); }
    layer_phases<0>(F, bar, lo, hi);
    layer_phases<1>(F, bar, lo, hi);
#undef IN
#undef SEAM
}


#ifdef DUMP_OFF
__global__ void dump_kernel(const unsigned* w, size_t nwords, float* out, int n) {
    const int i = blockIdx.x * blockDim.x + threadIdx.x; if (i >= n) return;
#ifdef DUMP_NAN_ALL
    { bool bad = false; for (size_t j = (size_t)i; j < nwords; j += (size_t)n) { const unsigned x = w[j]; bad |= ((x & 0x7f80u) == 0x7f80u) || ((x & 0x7f800000u) == 0x7f800000u); } out[i] = bad ? 1e6f : 0.f; return; }
#endif
#ifdef DUMP_MASKCHECK
    { out[i] = 0.f; if ((i & 1023) == 0) { const int t = i >> 10, sq = t & 4095; const unsigned long long* mt = (const unsigned long long*)w + ((size_t)(t >> 12) * 64) * 4096 + sq; int pc = 0; bool beyond = false;
        for (int j = 0; j < 64; ++j) { const unsigned long long m = mt[(size_t)j * 4096]; pc += __popcll(m); for (int bb = 0; bb < 64; ++bb) if (((m >> bb) & 1ull) && 64 * j + bb > sq) beyond = true; }
        const int expect = sq + 1 < 256 ? sq + 1 : 256;
#if DUMP_MASKCHECK == 1
        if (pc != expect) out[i] = 1e6f;
#else
        if (beyond) out[i] = 1e6f;
#endif
      } return; }
#endif
#ifdef DUMP_NANCHECK
#if DUMP_NANCHECK == 2
    { size_t wi = (size_t)i;
#ifdef DUMP_ROWW
      wi = ((size_t)i / DUMP_COLW) * DUMP_ROWW + ((size_t)i % DUMP_COLW);
#endif
      if (wi >= nwords) { out[i] = 0.f; return; } const unsigned x = w[wi]; const bool bad = ((x & 0x7f80u) == 0x7f80u) || ((x & 0x7f800000u) == 0x7f800000u);
#ifdef DUMP_LOC
      { const int sq = (int)(wi / 512) & 4095; out[i] = bad ? 1000.f * (float)(DUMP_LOC == 1 ? sq + 1 : 4096 - sq) : 0.f; return; }
#endif
      out[i] = bad ? 1e6f : 0.f; return; }
#else
    { const float v = ((const float*)w)[i]; out[i] = (v == v && fabsf(v) < 1e30f) ? 0.f : 1e6f; return; }
#endif
#endif
#ifdef DUMP_VIA_ROWOF
    unsigned h; { const unsigned short* src = (const unsigned short*)w; const int* rowof = (const int*)((const char*)w - (size_t)(DUMP_OFF) + WS_ROUTE) + 12 * T; const int t = i >> 10, c = i & 1023;
        h = 0u; for (int k = 0; k < 4; ++k) h = h * 0x9E3779B1u + src[(size_t)rowof[4 * t + k] * 1024 + c]; }
#elif defined(DUMP_ROWW)
    unsigned h = 0u; { const size_t row = (size_t)i / DUMP_COLW, cw = (size_t)i % DUMP_COLW; if (row * DUMP_ROWW + cw < nwords) h = w[row * DUMP_ROWW + cw]; }
#else
    unsigned h = 0u; int k = 1; for (size_t j = (size_t)i; j < nwords; j += (size_t)n, k += 2) h ^= w[j] * (unsigned)k;
#endif
    out[i] = (float)((h ^ (h >> 11) ^ (h >> 22)) & 0xFFFFFu);
}
#endif
#ifndef MK_ONE_LAUNCH
#define MK_ONE_LAUNCH 0
#endif
extern "C" void kernel_launch(void* const* d_in, const int* in_sizes, int n_in, void* d_out, int out_size, void* d_ws, size_t ws_size, hipStream_t stream) {
    static int grid = 0;
    if (grid == 0) {
        if (n_in != N_IN || in_sizes[0] != T * D || out_size != T * D || ws_size < WS_END) { fprintf(stderr, "kernel_launch: unexpected shapes (n_in %d, in0 %d, out %d, ws %zu, need %zu); nothing launched\n", n_in, n_in > 0 ? in_sizes[0] : -1, out_size, ws_size, (size_t)WS_END); grid = -1; return; }
        int dev = 0, cus = 0, per_cu = 0;
        if (hipGetDevice(&dev) != hipSuccess || hipDeviceGetAttribute(&cus, hipDeviceAttributeMultiprocessorCount, dev) != hipSuccess) { grid = -1; return; }
        if (hipFuncSetAttribute((const void*)fwd_kernel, hipFuncAttributeMaxDynamicSharedMemorySize, LDS_BYTES) != hipSuccess) { fprintf(stderr, "kernel_launch: hipFuncSetAttribute failed\n"); grid = -1; return; }
        if (hipOccupancyMaxActiveBlocksPerMultiprocessor(&per_cu, (const void*)fwd_kernel, NWAVES * 64, LDS_BYTES) != hipSuccess || per_cu < 1) fprintf(stderr, "kernel_launch: occupancy query reports %d\n", per_cu);
        (void)hipGetLastError();
        grid = cus;
        if (grid != 256) { fprintf(stderr, "kernel_launch: built for 256 CUs, found %d; nothing launched\n", cus); grid = -1; return; }
    }
    if (grid < 0) return;
    if (hipMemsetAsync((char*)d_ws + WS_CTL, 0, CTL_ZERO_BYTES, stream) != hipSuccess) return;
    Args a{};
    for (int i = 0; i < N_IN; ++i) a.in[i] = (const float*)d_in[i];
    a.out = (float*)d_out; a.ws = (unsigned char*)d_ws;
#if MK_ONE_LAUNCH
    a.ph_lo = 0; a.ph_hi = N_PHASES;
    hipLaunchKernelGGL(fwd_kernel, dim3(grid), dim3(NWAVES * 64), LDS_BYTES, stream, a);
#else
#ifdef DUMP_OFF
    for (int p = 0; p < DUMP_STOP; ++p) { a.ph_lo = p; a.ph_hi = p + 1; hipLaunchKernelGGL(fwd_kernel, dim3(grid), dim3(NWAVES * 64), LDS_BYTES, stream, a); }
    hipLaunchKernelGGL(dump_kernel, dim3((T * D + 255) / 256), dim3(256), 0, stream, (const unsigned*)((const char*)d_ws + (size_t)(DUMP_OFF)), (size_t)(DUMP_WORDS), (float*)d_out, T * D);
    return;
#endif
    for (int p = 0; p < N_PHASES; ++p) { a.ph_lo = p; a.ph_hi = p + 1; hipLaunchKernelGGL(fwd_kernel, dim3(grid), dim3(NWAVES * 64), LDS_BYTES, stream, a);
#ifdef DBL_PHASE
        if ((p == 0 && DBL_PHASE == 10) || (p > 0 && (p - 1) % PH_PER_LAYER == DBL_PHASE)) hipLaunchKernelGGL(fwd_kernel, dim3(grid), dim3(NWAVES * 64), LDS_BYTES, stream, a);
#endif
    }
#endif
}
```

```cpp
#include <hip/hip_runtime.h>
#include <cstdio>
#include <cstdint>

#define MK_ONE_LAUNCH 1
#define BAR_EARLY_INV 1
#ifndef WT_STORES
#define WT_STORES 0
#endif
__device__ __forceinline__ void st16_wt(void* p, unsigned x, unsigned y, unsigned z, unsigned w) {
    typedef unsigned u4_ __attribute__((ext_vector_type(4))); const u4_ v = {x, y, z, w};
#if WT_STORES
    asm volatile("global_store_dwordx4 %0, %1, off sc1\n\ts_nop 2" :: "v"((__attribute__((address_space(1))) void*)p), "v"(v) : "memory");
#else
    *(__attribute__((address_space(1))) u4_*)p = v;
#endif
}
__device__ __forceinline__ void st8_wt(void* p, unsigned x, unsigned y) {
    typedef unsigned u2_ __attribute__((ext_vector_type(2))); const u2_ v = {x, y};
#if WT_STORES
    asm volatile("global_store_dwordx2 %0, %1, off sc1" :: "v"((__attribute__((address_space(1))) void*)p), "v"(v) : "memory");
#else
    *(__attribute__((address_space(1))) u2_*)p = v;
#endif
}
namespace pg8 {
#define PG8_LAS __attribute__((address_space(3)))
typedef unsigned short bf16_t;
typedef short bf16x8 __attribute__((ext_vector_type(8)));
typedef float f32x4 __attribute__((ext_vector_type(4)));
typedef unsigned u32x4 __attribute__((ext_vector_type(4)));
typedef int v4i_t __attribute__((ext_vector_type(4)));
typedef int v8i_t __attribute__((ext_vector_type(8)));
constexpr int BM = 256, BK = 64, HALF = 128, HTB = HALF * BK * 2  , STAGE_BYTES = 8 * HTB, NXCD = 8, WGM = 8;

__host__ __device__ __forceinline__ int lds_byte(int r, int c) { const int st = (r >> 4) * 2 + (c >> 5), rr = r & 15, cc = c & 31, ob = rr * 64 + cc * 2; return st * 1024 + (ob ^ (((ob >> 9) & 1) << 5)); }
__host__ __device__ __forceinline__ void stage_rc(int b, int& R, int& C) { const int st = b / 1024, sb = b % 1024, swz = sb ^ (((sb >> 9) & 1) << 5); R = (st >> 1) * 16 + swz / 64; C = (st & 1) * 32 + (swz % 64) / 2; }
__host__ __device__ __forceinline__ int perm32(int rho) { const int n = rho >> 4, i = rho & 15; return 8 * (i >> 2) + 4 * n + (i & 3); }

struct Unit { int pm, pn; };
struct Gemm { const bf16_t* A; const bf16_t* Bt; int M, N, K; };

struct StaticOrder {
    int nM, nN, nwg, G, c;
    __host__ __device__ void init(int M, int N, int G_, int c_) { nM = M / BM; nN = N / BM; nwg = nM * nN; G = G_; c = c_; }
    __host__ __device__ bool next(int i, Unit& u) const {
        const long L = (long)i * G + c; if (L >= nwg) return false;
        int wgid = (int)L; { const int q = nwg / NXCD, r = nwg % NXCD, xcd = wgid % NXCD, off = wgid / NXCD; wgid = (xcd < r ? xcd * (q + 1) : r * (q + 1) + (xcd - r) * q) + off; }
        const int nig = WGM * nN, gid = wgid / nig, fm = gid * WGM, gsz = (nM - fm) < WGM ? (nM - fm) : WGM;
        u.pm = fm + ((wgid % nig) % gsz); u.pn = (wgid % nig) / gsz; return true;
    }
    __device__ __forceinline__ void a_ready(const Unit&) const {}
    __device__ __forceinline__ void done(const Unit&) const {}
};

__device__ __forceinline__ unsigned cvt_pk_bf16(float lo, float hi) { unsigned r; asm volatile("v_cvt_pk_bf16_f32 %0, %1, %2" : "=v"(r) : "v"(lo), "v"(hi)); return r; }
typedef float f32x2 __attribute__((ext_vector_type(2)));
__device__ __forceinline__ f32x2 gelu_pk(f32x2 v) {
    const f32x2 av = __builtin_elementwise_abs(v), d = av * 0.2316418882f + 1.0f;
    f32x2 t; t.x = __builtin_amdgcn_rcpf(d.x); t.y = __builtin_amdgcn_rcpf(d.y);
    f32x2 q = t * 0.5307027145f + (-0.7265760135f); q = q * t + 0.7107068705f; q = q * t + (-0.142248368f); q = q * t + 0.127414796f; q = q * t;
    const f32x2 s = (v * v) * (-0.72134752044f);
    f32x2 e; e.x = __builtin_amdgcn_exp2f(s.x); e.y = __builtin_amdgcn_exp2f(s.y);
    const f32x2 m = v * (q * e), r = v - m;
    f32x2 o; o.x = v.x < 0.f ? m.x : r.x; o.y = v.y < 0.f ? m.y : r.y; return o;
}

template <int ACT  > struct EpiBf16 {
    static constexpr bool PERM = true, AFTER_DRAIN = false; static_assert(ACT == 0 || ACT == 1, "EpiBf16: ACT is 0 (none) or 1 (gelu_pk)");
    bf16_t* O; int ldc; const float* bias; int split_cols; size_t split_stride; float scale0;
    __device__ __forceinline__ void operator()(const f32x4 (&acc)[2][2][4][2], const Unit& u, int wr, int wc, int fr, int fq) const {
        const int row0 = u.pm * BM + wr * 64 + fr; int colt = u.pn * BM; bf16_t* base = O;
        float sc = 1.f; if (split_cols) { const int t = colt / split_cols; base += (size_t)t * split_stride; colt -= t * split_cols; if (t == 0) sc = scale0; }
        const int col0 = colt + wc * 32 + 8 * fq, bcol0 = u.pn * BM + wc * 32 + 8 * fq;
        f32x4 bv[2][2];
#pragma unroll
        for (int bj = 0; bj < 2; ++bj)
#pragma unroll
            for (int n = 0; n < 2; ++n) bv[bj][n] = bias ? *(const __attribute__((address_space(1))) f32x4*)(bias + bcol0 + bj * HALF + 4 * n) : (f32x4){0.f, 0.f, 0.f, 0.f};
#pragma unroll
        for (int ai = 0; ai < 2; ++ai)
#pragma unroll
            for (int m = 0; m < 4; ++m) { bf16_t* rowp = base + (size_t)(row0 + ai * HALF + m * 16) * ldc + col0;
#pragma unroll
                for (int bj = 0; bj < 2; ++bj) { f32x4 v0 = acc[ai][bj][m][0] + bv[bj][0], v1 = acc[ai][bj][m][1] + bv[bj][1];
                    if (ACT == 1) { f32x2 a = gelu_pk((f32x2){v0[0], v0[1]}), b = gelu_pk((f32x2){v0[2], v0[3]}), c = gelu_pk((f32x2){v1[0], v1[1]}), d = gelu_pk((f32x2){v1[2], v1[3]});
                        v0 = (f32x4){a.x, a.y, b.x, b.y}; v1 = (f32x4){c.x, c.y, d.x, d.y}; }
                    v0 = v0 * sc; v1 = v1 * sc; u32x4 w; w.x = cvt_pk_bf16(v0[0], v0[1]); w.y = cvt_pk_bf16(v0[2], v0[3]); w.z = cvt_pk_bf16(v1[0], v1[1]); w.w = cvt_pk_bf16(v1[2], v1[3]);
                    st16_wt(rowp + bj * HALF, w.x, w.y, w.z, w.w); } }
    }
};

struct PanelStats {
    unsigned* xbuf;
    unsigned* cnt;
    unsigned* tmo;
    int ntn; float eps;
    unsigned code;
    __device__ __forceinline__ bool run(const f32x4 (&v)[2][2][4][2], const Unit& u, int wr, int wc, int fr, int fq, PG8_LAS unsigned char* lds, int wid, int lane) const {
        typedef float f32x2v __attribute__((ext_vector_type(2)));
        PG8_LAS f32x2v* P = (PG8_LAS f32x2v*)lds;
        PG8_LAS f32x2v* S = (PG8_LAS f32x2v*)(lds + 8192);
        PG8_LAS unsigned* flag = (PG8_LAS unsigned*)(lds + 8192 + 2048);
#pragma unroll
        for (int ai = 0; ai < 2; ++ai)
#pragma unroll
            for (int m = 0; m < 4; ++m) {
                float s = 0.f;
#pragma unroll
                for (int bj = 0; bj < 2; ++bj)
#pragma unroll
                    for (int n = 0; n < 2; ++n) { const f32x4 x = v[ai][bj][m][n]; s += (x[0] + x[1]) + (x[2] + x[3]); }
                s += __shfl_xor(s, 16); s += __shfl_xor(s, 32);
                const float mw = s * (1.0f / 64.0f); float q = 0.f;
#pragma unroll
                for (int bj = 0; bj < 2; ++bj)
#pragma unroll
                    for (int n = 0; n < 2; ++n) { const f32x4 d = v[ai][bj][m][n] - mw; q += (d[0] * d[0] + d[1] * d[1]) + (d[2] * d[2] + d[3] * d[3]); }
                q += __shfl_xor(q, 16); q += __shfl_xor(q, 32);
                if (fq == 0) P[(ai * HALF + wr * 64 + m * 16 + fr) * 4 + wc] = (f32x2v){mw, q};
            }
        asm volatile("s_waitcnt lgkmcnt(0)" ::: "memory"); __builtin_amdgcn_s_barrier(); asm volatile("" ::: "memory");
#if defined(BROKEN_EXCHANGE_NO_WAIT)
#warning BROKEN CONTROL BUILD: the row-statistics exchange does not wait; results are wrong by design
        if (blockIdx.x >= 64) { const long long t0_ = clock64(); while (clock64() - t0_ < 60000) __builtin_amdgcn_s_sleep(8); }
#endif
        const int row = wid * 32 + (lane & 31);
        if (lane < 32) {
            const f32x2v a = P[row * 4 + 0], b = P[row * 4 + 1], c = P[row * 4 + 2], d = P[row * 4 + 3];
            const float mt = (a.x + b.x + c.x + d.x) * 0.25f;
            const float da = a.x - mt, db = b.x - mt, dc = c.x - mt, dd = d.x - mt;
            const float m2 = (a.y + b.y) + (c.y + d.y) + 64.0f * ((da * da + db * db) + (dc * dc + dd * dd));
            unsigned long long* slot = (unsigned long long*)xbuf + ((size_t)(u.pm * BM + row) * 4 + u.pn);
            __hip_atomic_store(slot, ((unsigned long long)__float_as_uint(m2) << 32) | __float_as_uint(mt), __ATOMIC_RELAXED, __HIP_MEMORY_SCOPE_AGENT);
        }
        asm volatile("s_waitcnt vmcnt(0)" ::: "memory");
        if (lane == 0) __hip_atomic_fetch_add(cnt + 64 * u.pm, 1u, __ATOMIC_RELAXED, __HIP_MEMORY_SCOPE_AGENT);
        if (wid == 0) {
            bool dead = false; const unsigned long long t0 = __builtin_amdgcn_s_memrealtime(); const unsigned want = 8u * (unsigned)ntn;
            for (;;) {
#if defined(BROKEN_EXCHANGE_NO_WAIT)
                break;
#endif
                if ((unsigned)__builtin_amdgcn_readfirstlane(__hip_atomic_load(cnt + 64 * u.pm, __ATOMIC_RELAXED, __HIP_MEMORY_SCOPE_AGENT)) >= want) break;
                if (__builtin_amdgcn_s_memrealtime() - t0 > 2000000ull) {
                    if (lane == 0) { unsigned expect = 0u; __hip_atomic_compare_exchange_strong(tmo + 1, &expect, code | (unsigned)(u.pm & 0xff), __ATOMIC_RELAXED, __ATOMIC_RELAXED, __HIP_MEMORY_SCOPE_AGENT);
                                     __hip_atomic_store(tmo, 1u, __ATOMIC_RELAXED, __HIP_MEMORY_SCOPE_AGENT); }
                    dead = true; break; }
                __builtin_amdgcn_s_sleep(2);
            }
            __builtin_amdgcn_fence(__ATOMIC_ACQUIRE, "agent");
            if (lane == 0) flag[0] = dead ? 1u : 0u;
        }
        asm volatile("s_waitcnt vmcnt(0) lgkmcnt(0)" ::: "memory"); __builtin_amdgcn_s_barrier(); asm volatile("" ::: "memory");
        const bool bad = flag[0] != 0u;
        if (lane < 32) {
            const unsigned long long* slot = (const unsigned long long*)xbuf + (size_t)(u.pm * BM + row) * 4; float mt[4], m2[4]; float ms = 0.f;
#pragma unroll
            for (int t = 0; t < 4; ++t) { if (t < ntn) { const unsigned long long w = __hip_atomic_load(slot + t, __ATOMIC_RELAXED, __HIP_MEMORY_SCOPE_AGENT); mt[t] = __uint_as_float((unsigned)w); m2[t] = __uint_as_float((unsigned)(w >> 32)); } else { mt[t] = 0.f; m2[t] = 0.f; } ms += mt[t]; }
            const float mean = ms / (float)ntn; float q = 0.f;
#pragma unroll
            for (int t = 0; t < 4; ++t) if (t < ntn) { const float dm = mt[t] - mean; q += m2[t] + 256.0f * dm * dm; }
            S[row] = (f32x2v){mean, 1.0f / sqrtf(q / (256.0f * (float)ntn) + eps)};
        }
        asm volatile("s_waitcnt lgkmcnt(0)" ::: "memory"); __builtin_amdgcn_s_barrier(); asm volatile("" ::: "memory");
        return bad;
    }
};
struct EpiLnRes {
    static constexpr bool PERM = false, AFTER_DRAIN = true;
    const float* base; float* out; int ldc; const float* bias; PanelStats st; unsigned poison;
    __device__ __forceinline__ void fused(f32x4 (&acc)[2][2][4][2], const Unit& u, int wr, int wc, int fr, int fq, PG8_LAS unsigned char* lds, int wid, int lane) const {
        typedef float f32x2v __attribute__((ext_vector_type(2)));
        const PG8_LAS f32x2v* S = (const PG8_LAS f32x2v*)(lds + 8192);
        const int col0 = u.pn * BM + wc * 32 + 4 * fq;
#pragma unroll
        for (int bj = 0; bj < 2; ++bj)
#pragma unroll
            for (int n = 0; n < 2; ++n) { const f32x4 bv = bias ? *(const f32x4*)(bias + col0 + bj * HALF + n * 16) : (f32x4){0.f, 0.f, 0.f, 0.f};
#pragma unroll
                for (int ai = 0; ai < 2; ++ai)
#pragma unroll
                    for (int m = 0; m < 4; ++m) acc[ai][bj][m][n] += bv; }
        f32x4 pre[4][2][2];
#pragma unroll
        for (int m = 0; m < 4; ++m) { const size_t off = (size_t)(u.pm * BM + wr * 64 + m * 16 + fr) * ldc + col0;
#pragma unroll
            for (int bj = 0; bj < 2; ++bj)
#pragma unroll
                for (int n = 0; n < 2; ++n) pre[m][bj][n] = *(const f32x4*)(base + off + bj * HALF + n * 16); }
        const bool bad = st.run(acc, u, wr, wc, fr, fq, lds, wid, lane) || poison != 0u;
        const float qnan = __builtin_nanf("");
#pragma unroll
        for (int ai = 0; ai < 2; ++ai)
#pragma unroll
            for (int m = 0; m < 4; ++m) { const int r = ai * HALF + wr * 64 + m * 16 + fr; const f32x2v sr = S[r]; const size_t off = (size_t)(u.pm * BM + r) * ldc + col0;
#pragma unroll
                for (int bj = 0; bj < 2; ++bj)
#pragma unroll
                    for (int n = 0; n < 2; ++n) { const f32x4 bs = ai == 0 ? pre[m][bj][n] : *(const f32x4*)(base + off + bj * HALF + n * 16); f32x4 o = bs + (acc[ai][bj][m][n] - sr.x) * sr.y;
                        if (bad) o = (f32x4){qnan, qnan, qnan, qnan}; *(f32x4*)(out + off + bj * HALF + n * 16) = o; }
                if (m & 1) asm volatile("" ::: "memory"); }
    }
};
struct EpiLnResLn {
    static constexpr bool PERM = false, AFTER_DRAIN = true;
    const float* base; float* out; bf16_t* xn; int ldc; const float* bias; PanelStats st1, st2; unsigned poison;
    __device__ __forceinline__ void fused(f32x4 (&acc)[2][2][4][2], const Unit& u, int wr, int wc, int fr, int fq, PG8_LAS unsigned char* lds, int wid, int lane) const {
        typedef float f32x2v __attribute__((ext_vector_type(2))); typedef unsigned u32x2v __attribute__((ext_vector_type(2)));
        const PG8_LAS f32x2v* S = (const PG8_LAS f32x2v*)(lds + 8192);
        const int col0 = u.pn * BM + wc * 32 + 4 * fq;
#pragma unroll
        for (int bj = 0; bj < 2; ++bj)
#pragma unroll
            for (int n = 0; n < 2; ++n) { const f32x4 bv = bias ? *(const f32x4*)(bias + col0 + bj * HALF + n * 16) : (f32x4){0.f, 0.f, 0.f, 0.f};
#pragma unroll
                for (int ai = 0; ai < 2; ++ai)
#pragma unroll
                    for (int m = 0; m < 4; ++m) acc[ai][bj][m][n] += bv; }
        bool bad = st1.run(acc, u, wr, wc, fr, fq, lds, wid, lane) || poison != 0u;
        const float qnan = __builtin_nanf("");
#pragma unroll
        for (int ai = 0; ai < 2; ++ai)
#pragma unroll
            for (int m = 0; m < 4; ++m) { const int r = ai * HALF + wr * 64 + m * 16 + fr; const f32x2v sr = S[r]; const size_t off = (size_t)(u.pm * BM + r) * ldc + col0;
#pragma unroll
                for (int bj = 0; bj < 2; ++bj)
#pragma unroll
                    for (int n = 0; n < 2; ++n) { const f32x4 bs = *(const f32x4*)(base + off + bj * HALF + n * 16); acc[ai][bj][m][n] = bs + (acc[ai][bj][m][n] - sr.x) * sr.y; }
                asm volatile("" : "+v"(acc[ai][0][m][0]), "+v"(acc[ai][0][m][1]), "+v"(acc[ai][1][m][0]), "+v"(acc[ai][1][m][1]));
                if (m & 1) asm volatile("" ::: "memory"); }
        const bool bad1 = bad;
        bad = st2.run(acc, u, wr, wc, fr, fq, lds, wid, lane) || bad;
#pragma unroll
        for (int ai = 0; ai < 2; ++ai)
#pragma unroll
            for (int m = 0; m < 4; ++m) { const int r = ai * HALF + wr * 64 + m * 16 + fr; const f32x2v sr = S[r]; const size_t off = (size_t)(u.pm * BM + r) * ldc + col0;
#pragma unroll
                for (int bj = 0; bj < 2; ++bj)
#pragma unroll
                    for (int n = 0; n < 2; ++n) { const f32x4 x1 = acc[ai][bj][m][n]; *(f32x4*)(out + off + bj * HALF + n * 16) = bad1 ? (f32x4){qnan, qnan, qnan, qnan} : x1;
                        const f32x4 o = (x1 - sr.x) * sr.y; u32x2v w; w.x = cvt_pk_bf16(o[0], o[1]); w.y = cvt_pk_bf16(o[2], o[3]);
                        if (bad) { w.x = 0x7fc07fc0u; w.y = 0x7fc07fc0u; } *(u32x2v*)(xn + off + bj * HALF + n * 16) = w; }
                asm volatile("" ::: "memory"); }
    }
};

__device__ __forceinline__ void glds_saddr(unsigned voff, const char* sbase, unsigned lds_dst) { unsigned keep;
    asm volatile("s_mov_b32 %0, m0\n\ts_mov_b32 m0, %3\n\ts_nop 0\n\tglobal_load_lds_dwordx4 %1, %2\n\ts_mov_b32 m0, %0" : "=&s"(keep) : "v"(voff), "s"(sbase), "s"(lds_dst) : "memory"); }
template <class Epi, class Sched, bool ALIGN_EPI = false, bool SP2 = false, int EB = 2, bool GATHER = false>
__device__ __forceinline__ void gemm_phase(PG8_LAS unsigned char* lds, const Gemm g, const Sched& S, const Epi& E, const int* rowtok = nullptr) {
    static_assert(!GATHER || (EB == 1 && SP2), "gathered A rows: fp8 path (SGPR-base staging) with the two-super-phase loop only");
    const int tid = threadIdx.x, wid = __builtin_amdgcn_readfirstlane(tid >> 6), lane = tid & 63, wr = wid >> 2, wc = wid & 3, fr = lane & 15, fq = lane >> 4;
    const int K = g.K, nt = K * EB / (BK * 2);
    unsigned voffA[2], voffB[2]; int gR[2]; unsigned gC[2];
#pragma unroll
    for (int i = 0; i < 2; ++i) { int R, C; stage_rc(tid * 16 + i * 8192, R, C); const int Rb = Epi::PERM ? ((R & ~31) + perm32(R & 31)) : R;
        voffA[i] = (unsigned)(R * K * EB + C * 2); voffB[i] = (unsigned)(Rb * K * EB + C * 2); gR[i] = R; gC[i] = (unsigned)(C * 2); }
    const size_t kstep = (size_t)(BK * 2);
    const size_t hstep = (size_t)HALF * K * EB;
    const size_t tstep = 2 * hstep;
    const unsigned ldsw = (unsigned)wid * 1024u; const unsigned lds0 = (unsigned)(uintptr_t)lds;
    const int aoff = lds_byte(wr * 64 + fr, fq * 8), boff = lds_byte(wc * 32 + fr, fq * 8);
#define PG8_SA(b, h) (((b) * 2 + (h)) * HTB)
#define PG8_SB(b, h) ((4 + (b) * 2 + (h)) * HTB)
#define PG8_STAGE(bufoff, gbase, voff) do { if constexpr (EB == 2) { _Pragma("unroll") for (int _i = 0; _i < 2; ++_i) \
        __builtin_amdgcn_global_load_lds((const unsigned*)((const char*)(gbase) + (voff)[_i]), (PG8_LAS unsigned*)(lds + (bufoff) + ldsw + _i * 8192), 16, 0, 0); } \
        else { _Pragma("unroll") for (int _i = 0; _i < 2; ++_i) glds_saddr((voff)[_i], (const char*)(gbase), (unsigned)__builtin_amdgcn_readfirstlane((int)(lds0 + (unsigned)(bufoff) + ldsw + (unsigned)(_i * 8192)))); } } while (0)
#define PG8_GLOAD(vo, u) do { _Pragma("unroll") for (int _h = 0; _h < 2; ++_h) _Pragma("unroll") for (int _i = 0; _i < 2; ++_i) vo[_h][_i] = (unsigned)rowtok[(size_t)(u).pm * BM + _h * HALF + gR[_i]] * (unsigned)(K * EB) + gC[_i]; } while (0)
#define PG8_STAGE_A(bufoff, pplain, kofs, h, VS) do { if constexpr (!GATHER) { PG8_STAGE(bufoff, pplain, voffA); } else { _Pragma("unroll") for (int _i = 0; _i < 2; ++_i) \
        glds_saddr(VS[h][_i], (const char*)g.A + (kofs), (unsigned)__builtin_amdgcn_readfirstlane((int)(lds0 + (unsigned)(bufoff) + ldsw + (unsigned)(_i * 8192)))); } } while (0)
#define PG8_LD8(p) __builtin_shufflevector(*(const PG8_LAS v4i_t*)(p), *(const PG8_LAS v4i_t*)((p) + 1024), 0, 1, 2, 3, 4, 5, 6, 7)
#define PG8_LDA(dst, b, h) do { if constexpr (EB == 2) { _Pragma("unroll") for (int m = 0; m < 4; ++m) _Pragma("unroll") for (int k = 0; k < 2; ++k) dst[m][k] = *(const PG8_LAS bf16x8*)(lds + PG8_SA(b, h) + aoff + m * 2048 + k * 1024); } \
        else { _Pragma("unroll") for (int m = 0; m < 4; ++m) dst##8[m] = PG8_LD8(lds + PG8_SA(b, h) + aoff + m * 2048); } } while (0)
#define PG8_LDB(dst, b, h) do { if constexpr (EB == 2) { _Pragma("unroll") for (int n = 0; n < 2; ++n) _Pragma("unroll") for (int k = 0; k < 2; ++k) dst[n][k] = *(const PG8_LAS bf16x8*)(lds + PG8_SB(b, h) + boff + n * 2048 + k * 1024); } \
        else { _Pragma("unroll") for (int n = 0; n < 2; ++n) dst##8[n] = PG8_LD8(lds + PG8_SB(b, h) + boff + n * 2048); } } while (0)
#define PG8_CAT8(x, y) __builtin_shufflevector(__builtin_bit_cast(v4i_t, x), __builtin_bit_cast(v4i_t, y), 0, 1, 2, 3, 4, 5, 6, 7)
#define PG8_MMA(ai, bj, At, Bt) do { __builtin_amdgcn_s_setprio(1); if constexpr (EB == 2) { _Pragma("unroll") for (int m = 0; m < 4; ++m) _Pragma("unroll") for (int n = 0; n < 2; ++n) _Pragma("unroll") for (int k = 0; k < 2; ++k) \
        acc[ai][bj][m][n] = __builtin_amdgcn_mfma_f32_16x16x32_bf16(Bt[n][k], At[m][k], acc[ai][bj][m][n], 0, 0, 0); } else { _Pragma("unroll") for (int m = 0; m < 4; ++m) _Pragma("unroll") for (int n = 0; n < 2; ++n) \
        asm volatile("v_mfma_scale_f32_16x16x128_f8f6f4 %0, %1, %2, %0, %3, %3 op_sel_hi:[0,0,0]" : "+v"(acc[ai][bj][m][n]) : "v"(Bt##8[n]), "v"(At##8[m]), "v"(mx_one)); }     __builtin_amdgcn_s_setprio(0); } while (0)
#define PG8_WAIT_V(n) asm volatile("s_waitcnt vmcnt(" #n ")" ::: "memory")
#define PG8_WAIT_L(n) asm volatile("s_waitcnt lgkmcnt(" #n ")" ::: "memory")
#define PG8_BAR __builtin_amdgcn_s_barrier()
#define PG8_SCHED __builtin_amdgcn_sched_barrier(0)
    Unit cur, nxt; int ui = 0;
    if (!S.next(0, cur)) return;
    f32x4 acc[2][2][4][2];
#pragma unroll
    for (int a = 0; a < 2; ++a)
#pragma unroll
        for (int b = 0; b < 2; ++b)
#pragma unroll
            for (int m = 0; m < 4; ++m)
#pragma unroll
                for (int n = 0; n < 2; ++n) acc[a][b][m][n] = (f32x4){0.f, 0.f, 0.f, 0.f};
    const int mx_one = 0x7f7f7f7f;
    bf16x8 At[4][2], B0[2][2], B1[2][2]; v8i_t At8[4], B08[2], B18[2];
    const char* cA = (const char*)g.A + (size_t)cur.pm * tstep; const char* cB = (const char*)g.Bt + (size_t)cur.pn * tstep;
    S.a_ready(cur);
    unsigned voffC[2][2], voffN[2][2];
    if constexpr (GATHER) PG8_GLOAD(voffC, cur);
    if constexpr (SP2) {
        PG8_STAGE(PG8_SB(0, 0), cB, voffB); PG8_STAGE(PG8_SB(0, 1), cB + hstep, voffB); PG8_STAGE_A(PG8_SA(0, 0), cA, 0, 0, voffC); PG8_STAGE_A(PG8_SA(0, 1), cA + hstep, 0, 1, voffC);
        if (wr == 1) PG8_BAR;
        PG8_WAIT_V(2); PG8_BAR;
        PG8_STAGE(PG8_SB(1, 0), cB + kstep, voffB); PG8_STAGE_A(PG8_SA(1, 0), cA + kstep, kstep, 0, voffC); PG8_STAGE(PG8_SB(1, 1), cB + hstep + kstep, voffB);
        PG8_WAIT_V(6); PG8_BAR;
    } else {
        PG8_STAGE(PG8_SB(0, 0), cB, voffB); PG8_STAGE(PG8_SA(0, 0), cA, voffA); PG8_STAGE(PG8_SB(0, 1), cB + hstep, voffB); PG8_STAGE(PG8_SA(0, 1), cA + hstep, voffA);
        if (wr == 1) PG8_BAR;
        PG8_WAIT_V(4); PG8_BAR;
        PG8_STAGE(PG8_SB(1, 0), cB + kstep, voffB); PG8_STAGE(PG8_SA(1, 0), cA + kstep, voffA); PG8_STAGE(PG8_SB(1, 1), cB + hstep + kstep, voffB);
        PG8_WAIT_V(6); PG8_BAR;
    }
    for (;;) {
        const bool has_next = S.next(ui + 1, nxt);
        if constexpr (GATHER) { if (has_next) PG8_GLOAD(voffN, nxt); else { _Pragma("unroll") for (int _h = 0; _h < 2; ++_h) _Pragma("unroll") for (int _i = 0; _i < 2; ++_i) voffN[_h][_i] = voffC[_h][_i]; } }
        const char* nA = has_next ? (const char*)g.A + (size_t)nxt.pm * tstep : cA; const char* nB = has_next ? (const char*)g.Bt + (size_t)nxt.pn * tstep : cB;
#pragma nounroll
        for (int t = 0; t < nt; t += 2) {
            const bool last = (t == nt - 2);
            const char* a1 = cA + (size_t)(t + 1) * kstep;
            const char* a2 = last ? nA : cA + (size_t)(t + 2) * kstep; const char* b2 = last ? nB : cB + (size_t)(t + 2) * kstep;
            const char* a3 = a2 + kstep; const char* b3 = b2 + kstep;
            const size_t k2 = last ? (size_t)0 : (size_t)(t + 2) * kstep; unsigned voffS[2][2];
            if constexpr (GATHER) { _Pragma("unroll") for (int _h = 0; _h < 2; ++_h) _Pragma("unroll") for (int _i = 0; _i < 2; ++_i) voffS[_h][_i] = last ? voffN[_h][_i] : voffC[_h][_i]; }
            if (last && has_next) S.a_ready(nxt);
            if constexpr (SP2) {
            PG8_LDB(B0, 0, 0); PG8_LDB(B1, 0, 1); PG8_SCHED; PG8_LDA(At, 0, 0); PG8_STAGE_A(PG8_SA(1, 1), a1 + hstep, (size_t)(t + 1) * kstep, 1, voffC);
            PG8_WAIT_V(8); PG8_WAIT_L(0); PG8_BAR; PG8_MMA(0, 0, At, B0); PG8_MMA(0, 1, At, B1); PG8_BAR; PG8_SCHED;
            PG8_LDA(At, 0, 1); PG8_STAGE(PG8_SB(0, 0), b2, voffB); PG8_STAGE(PG8_SB(0, 1), b2 + hstep, voffB); PG8_STAGE_A(PG8_SA(0, 0), a2, k2, 0, voffS);
            PG8_WAIT_V(8); PG8_WAIT_L(0); PG8_BAR; PG8_MMA(1, 0, At, B0); PG8_MMA(1, 1, At, B1); PG8_BAR; PG8_SCHED;
            PG8_LDB(B0, 1, 0); PG8_LDB(B1, 1, 1); PG8_SCHED; PG8_LDA(At, 1, 0); PG8_STAGE_A(PG8_SA(0, 1), a2 + hstep, k2, 1, voffS);
            PG8_WAIT_V(8); PG8_WAIT_L(0); PG8_BAR; PG8_MMA(0, 0, At, B0); PG8_MMA(0, 1, At, B1); PG8_BAR; PG8_SCHED;
            PG8_LDA(At, 1, 1); PG8_STAGE(PG8_SB(1, 0), b3, voffB); PG8_STAGE(PG8_SB(1, 1), b3 + hstep, voffB); PG8_STAGE_A(PG8_SA(1, 0), a3, k2 + kstep, 0, voffS);
            PG8_WAIT_V(8); PG8_WAIT_L(0); PG8_BAR; PG8_MMA(1, 0, At, B0); PG8_MMA(1, 1, At, B1); PG8_BAR; PG8_SCHED;
            } else {
            PG8_LDB(B0, 0, 0); PG8_SCHED; PG8_LDA(At, 0, 0); PG8_STAGE(PG8_SA(1, 1), a1 + hstep, voffA);
            PG8_WAIT_L(8); PG8_BAR; PG8_WAIT_L(0); PG8_MMA(0, 0, At, B0); PG8_BAR; PG8_SCHED;
            PG8_LDB(B1, 0, 1); PG8_STAGE(PG8_SB(0, 0), b2, voffB);
            PG8_BAR; PG8_WAIT_L(0); PG8_MMA(0, 1, At, B1); PG8_BAR;
            PG8_LDA(At, 0, 1); PG8_STAGE(PG8_SA(0, 0), a2, voffA);
            PG8_BAR; PG8_WAIT_L(0); PG8_MMA(1, 0, At, B0); PG8_BAR; PG8_SCHED;
            PG8_STAGE(PG8_SB(0, 1), b2 + hstep, voffB);
            PG8_WAIT_V(6); PG8_BAR; PG8_MMA(1, 1, At, B1); PG8_BAR;
            PG8_LDB(B0, 1, 0); PG8_SCHED; PG8_LDA(At, 1, 0); PG8_STAGE(PG8_SA(0, 1), a2 + hstep, voffA);
            PG8_WAIT_L(8); PG8_BAR; PG8_WAIT_L(0); PG8_MMA(0, 0, At, B0); PG8_BAR; PG8_SCHED;
            PG8_LDB(B1, 1, 1); PG8_STAGE(PG8_SB(1, 0), b3, voffB);
            PG8_BAR; PG8_WAIT_L(0); PG8_MMA(0, 1, At, B1); PG8_BAR;
            PG8_LDA(At, 1, 1); PG8_STAGE(PG8_SA(1, 0), a3, voffA);
            PG8_BAR; PG8_WAIT_L(0); PG8_MMA(1, 0, At, B0); PG8_BAR; PG8_SCHED;
            PG8_STAGE(PG8_SB(1, 1), b3 + hstep, voffB);
            PG8_WAIT_V(6); PG8_BAR; PG8_MMA(1, 1, At, B1); PG8_BAR;
            }
        }
        if constexpr (ALIGN_EPI) { if (wr == 0) PG8_BAR; }
        if constexpr (EB == 1) asm volatile("s_nop 15\n\ts_nop 15" ::: "memory");
        if constexpr (!Epi::AFTER_DRAIN) { E(acc, cur, wr, wc, fr, fq); S.done(cur); }
        if (!has_next) break;
#pragma unroll
        for (int a = 0; a < 2; ++a)
#pragma unroll
            for (int b = 0; b < 2; ++b)
#pragma unroll
                for (int m = 0; m < 4; ++m)
#pragma unroll
                    for (int n = 0; n < 2; ++n) acc[a][b][m][n] = (f32x4){0.f, 0.f, 0.f, 0.f};
        cur = nxt; cA = nA; cB = nB; ++ui;
        if constexpr (GATHER) { _Pragma("unroll") for (int _h = 0; _h < 2; ++_h) _Pragma("unroll") for (int _i = 0; _i < 2; ++_i) voffC[_h][_i] = voffN[_h][_i]; }
        if constexpr (ALIGN_EPI) { if (wr == 1) PG8_BAR; }
    }
    PG8_WAIT_V(0);
    if constexpr (!ALIGN_EPI) { if (wr == 0) PG8_BAR; }
    PG8_BAR;
    if constexpr (Epi::AFTER_DRAIN) { E.fused(acc, cur, wr, wc, fr, fq, lds, wid, lane); S.done(cur); }
#undef PG8_SA
#undef PG8_SB
#undef PG8_STAGE
#undef PG8_LDA
#undef PG8_GLOAD
#undef PG8_STAGE_A
#undef PG8_LD8
#undef PG8_LDB
#undef PG8_MMA
#undef PG8_CAT8
#undef PG8_WAIT_V
#undef PG8_WAIT_L
#undef PG8_BAR
#undef PG8_SCHED
}
}
#ifndef PG8_SP2
#define PG8_SP2 true
#endif
#ifndef MOE_SP2
#define MOE_SP2 true
#endif
#ifndef PG8_ALIGN
#define PG8_ALIGN true
#endif
constexpr int NWAVES = 8;
constexpr int NB = 4, SEQ = 4096, T = NB * SEQ, D = 1024, NIN = 2856, NINP = 3072, NE = 32, DEPTH = 2;
constexpr int C_H = 0, C_GB = 256, C_GC = 512, C_P = 768, C_Q = 1024, C_K = 1536, C_V = 2048, C_QI = 2560, C_KI = 2816, C_WI = 2848;
constexpr int NSEL = 256;
#ifndef SEL_CAND_CAP
#define SEL_CAND_CAP 64
#endif
constexpr int MAXROWS = 4 * T + NE * 256;
constexpr float ATT_C2 = 0.125f * 1.4426950408889634f;
constexpr float LN_EPS = 1e-5f, DN_ALPHA = 1.41421356237309515f;
enum { IN_X = 0, IN_WIN, IN_CONVW, IN_WPOOL, IN_PSCALE, IN_KNG, IN_KNB, IN_WOUT, IN_LN1G, IN_LN1B, IN_RW, IN_RB, IN_WGU, IN_BGU, IN_WDN, IN_BDN, IN_LN2G, IN_LN2B, N_IN };

constexpr size_t MiB = 1u << 20;
constexpr size_t WS_CTL = 0, CTL_ZERO_BYTES = 1 * MiB;
constexpr size_t WS_WIN = 2 * MiB;
constexpr size_t WS_WOUT = 14 * MiB;
constexpr size_t WS_WGU = 18 * MiB;
constexpr size_t WS_WDN = 274 * MiB;
constexpr size_t WS_XB = 402 * MiB;
constexpr size_t WS_XF = 434 * MiB;
constexpr size_t WS_Y1 = 498 * MiB;
constexpr size_t WS_PROJ = 562 * MiB;
constexpr size_t WS_CAT = 658 * MiB;
constexpr size_t WS_KIN = 690 * MiB;
constexpr size_t WS_MASK = 691 * MiB;
constexpr size_t WS_ROUTE = 699 * MiB;
constexpr size_t WS_CNTW = 699 * MiB + 256 * 1024;
constexpr size_t WS_SC = 700 * MiB;
constexpr size_t WS_XS = 956 * MiB;
constexpr size_t WS_ACT = 1100 * MiB;
constexpr size_t WS_YS = 1244 * MiB;
constexpr size_t WS_XB8 = 1388 * MiB;
constexpr size_t WS_END = 1404 * MiB;
constexpr int CW_TMO = 0;
constexpr int CW_CNT = 1024;
constexpr int CW_BAR = 4096;
constexpr int RING_BYTES = 131072;
constexpr int TAB_OFF = RING_BYTES;
constexpr int MISC_OFF = RING_BYTES + 1024;
constexpr int LDS_BYTES = 147456;

#define GAS __attribute__((address_space(1)))
#define LAS __attribute__((address_space(3)))
typedef unsigned short bf16;
typedef unsigned v4u __attribute__((ext_vector_type(4)));
typedef unsigned v2u __attribute__((ext_vector_type(2)));
typedef float f32x4 __attribute__((ext_vector_type(4)));
typedef short bf16x8 __attribute__((ext_vector_type(8)));
typedef GAS unsigned gu32;
typedef unsigned long long u64;
#define RLX_AGENT __ATOMIC_RELAXED, __HIP_MEMORY_SCOPE_AGENT
#define LDS_WAIT() asm volatile("s_waitcnt lgkmcnt(0)" ::: "memory")
#define VM_WAIT() asm volatile("s_waitcnt vmcnt(0)" ::: "memory")
__device__ __forceinline__ unsigned f2bf(float f) { unsigned u = __builtin_bit_cast(unsigned, f); return (u + 0x7fffu + ((u >> 16) & 1u)) >> 16; }
__device__ __forceinline__ unsigned pk2(float lo, float hi) { return f2bf(lo) | (f2bf(hi) << 16); }
__device__ __forceinline__ unsigned pk4_fp8(float a, float b, float c, float d) { int w = 0; w = __builtin_amdgcn_cvt_pk_fp8_f32(a, b, w, false); w = __builtin_amdgcn_cvt_pk_fp8_f32(c, d, w, true); return (unsigned)w; }
constexpr float WGU_SCALE = 32.f, WDN_SCALE = 64.f;
__device__ __forceinline__ float bf2f(bf16 v) { return __builtin_bit_cast(float, (unsigned)v << 16); }
__device__ __forceinline__ float bflo(unsigned w) { return __builtin_bit_cast(float, w << 16); }
__device__ __forceinline__ float bfhi(unsigned w) { return __builtin_bit_cast(float, w & 0xffff0000u); }
template <int CTRL> __device__ __forceinline__ float dppx(float v) { return __builtin_bit_cast(float, __builtin_amdgcn_update_dpp(0, __builtin_bit_cast(int, v), CTRL, 0xf, 0xf, false)); }
__device__ __forceinline__ float wave_sum(float v) {
    v += dppx<0xB1>(v); v += dppx<0x4E>(v); v += dppx<0x141>(v); v += dppx<0x140>(v);
    const float a = __builtin_bit_cast(float, __builtin_amdgcn_readlane(__builtin_bit_cast(int, v), 0)), b = __builtin_bit_cast(float, __builtin_amdgcn_readlane(__builtin_bit_cast(int, v), 16));
    const float c = __builtin_bit_cast(float, __builtin_amdgcn_readlane(__builtin_bit_cast(int, v), 32)), d = __builtin_bit_cast(float, __builtin_amdgcn_readlane(__builtin_bit_cast(int, v), 48));
    return (a + b) + (c + d);
}
__device__ __forceinline__ float wave_max(float v) {
#pragma unroll
    for (int o = 1; o < 64; o <<= 1) v = fmaxf(v, __shfl_xor(v, o));
    return v;
}
__device__ __forceinline__ float wave_max_dpp(float v) {
    v = fmaxf(v, dppx<0xB1>(v)); v = fmaxf(v, dppx<0x4E>(v)); v = fmaxf(v, dppx<0x141>(v)); v = fmaxf(v, dppx<0x140>(v));
    const float a = __builtin_bit_cast(float, __builtin_amdgcn_readlane(__builtin_bit_cast(int, v), 0)), b = __builtin_bit_cast(float, __builtin_amdgcn_readlane(__builtin_bit_cast(int, v), 16));
    const float c = __builtin_bit_cast(float, __builtin_amdgcn_readlane(__builtin_bit_cast(int, v), 32)), d = __builtin_bit_cast(float, __builtin_amdgcn_readlane(__builtin_bit_cast(int, v), 48));
    return fmaxf(fmaxf(a, b), fmaxf(c, d));
}
__device__ __forceinline__ float sum32(float v) {
#pragma unroll
    for (int o = 1; o < 32; o <<= 1) v += __shfl_xor(v, o);
    return v;
}
#define XB_TMO      128
#define XB_XCNT(j)  (256  + 64 * (j))
#define XB_XSUB(j)  (1280 + 64 * (j))
#define XB_XGEN(j)  (2304 + 64 * (j))
#define XB_TOP      3328
#define XB_TOPGEN   3392
#define XCD_BAR_WORDS 3456
#define XB_SPIN_CAP (1u << 18)

__device__ __forceinline__ unsigned xb_ld(unsigned* p)              { return __hip_atomic_load(p, __ATOMIC_RELAXED, __HIP_MEMORY_SCOPE_AGENT); }
__device__ __forceinline__ unsigned xb_add(unsigned* p, unsigned v) { return __hip_atomic_fetch_add(p, v, __ATOMIC_RELAXED, __HIP_MEMORY_SCOPE_AGENT); }
__device__ __forceinline__ unsigned xb_xcc_id() { return (unsigned)__builtin_amdgcn_s_getreg((3 << 11) | 20) & 0xFu; }
#define XB_SPIN(cond, bar) do { unsigned _sp = 0; while (cond) { __builtin_amdgcn_s_sleep(1); \
    if ((++_sp & 255u) == 0u) { if (xb_ld(&(bar)[XB_TMO])) break; if (_sp > XB_SPIN_CAP) { atomicAdd(&(bar)[XB_TMO], 1u); break; } } } } while (0)

struct XcdBarrier {
    unsigned* bar; unsigned x;
    volatile LAS unsigned* st;
};

__device__ __forceinline__ XcdBarrier xcd_barrier_post(unsigned* bar, volatile LAS unsigned* st) {
    XcdBarrier b; b.bar = bar; b.x = xb_xcc_id(); b.st = st;
    if (threadIdx.x == 0) (void)xb_add(&bar[XB_XCNT(b.x)], 1u);
    return b;
}
__device__ __forceinline__ void xcd_barrier_complete(unsigned* bar, unsigned x, unsigned& nloc, unsigned& nx) {
    const unsigned G = gridDim.x * gridDim.y * gridDim.z;
    unsigned sum, cnt, mine, sp = 0u;
    for (;;) {
        sum = 0u; cnt = 0u; mine = 0u;
#pragma unroll
        for (unsigned j = 0; j < 16; ++j) { const unsigned c = xb_ld(&bar[XB_XCNT(j)]); sum += c; cnt += (c > 0u) ? 1u : 0u; mine = (j == x) ? c : mine; }
        if (sum == G) break;
        __builtin_amdgcn_s_sleep(1);
        if ((++sp & 255u) == 0u) { if (xb_ld(&bar[XB_TMO])) break; if (sp > XB_SPIN_CAP) { atomicAdd(&bar[XB_TMO], 1u); break; } }
    }
    nloc = mine > 0u ? mine : 1u; nx = cnt > 0u ? cnt : 1u;
}

__device__ __forceinline__ void xcd_barrier(const XcdBarrier& b) {
    asm volatile("s_waitcnt vmcnt(0)" ::: "memory");
    __syncthreads();
    if (threadIdx.x == 0) {
        unsigned* bar = b.bar;
        __builtin_amdgcn_s_waitcnt(0);
        unsigned nloc = b.st[0], nx = b.st[1];
        if (nloc == 0u) { xcd_barrier_complete(bar, b.x, nloc, nx); b.st[0] = nloc; b.st[1] = nx; }
        const unsigned old = xb_add(&bar[XB_XSUB(b.x)], 1u);
        const unsigned gen = old / nloc;
        if (old + 1u == (gen + 1u) * nloc) {
            __builtin_amdgcn_fence(__ATOMIC_RELEASE, "agent");
            asm volatile("s_waitcnt vmcnt(0)" ::: "memory");
#ifdef BAR_EARLY_INV
            __builtin_amdgcn_fence(__ATOMIC_ACQUIRE, "agent");
            (void)xb_add(&bar[XB_TOP], 1u);
            { const unsigned target = (gen + 1u) * nx; XB_SPIN(xb_ld(&bar[XB_TOP]) < target, bar); }
            xb_add(&bar[XB_XGEN(b.x)], 1u);
            asm volatile("s_waitcnt vmcnt(0)" ::: "memory");
#else
            const unsigned og = xb_add(&bar[XB_TOP], 1u);
            const unsigned tg = og / nx;
            if (og + 1u == (tg + 1u) * nx) xb_add(&bar[XB_TOPGEN], 1u);
            else XB_SPIN(xb_ld(&bar[XB_TOPGEN]) == tg, bar);
            __builtin_amdgcn_fence(__ATOMIC_ACQUIRE, "agent");
            xb_add(&bar[XB_XGEN(b.x)], 1u);
            asm volatile("s_waitcnt vmcnt(0)" ::: "memory");
#endif
        } else {
#ifdef BAR_EARLY_INV
            __builtin_amdgcn_fence(__ATOMIC_ACQUIRE, "agent"); asm volatile("s_waitcnt vmcnt(0)" ::: "memory");
            XB_SPIN(xb_ld(&bar[XB_XGEN(b.x)]) == gen, bar);
            asm volatile("" ::: "memory");
#else
            XB_SPIN(xb_ld(&bar[XB_XGEN(b.x)]) == gen, bar);
            __builtin_amdgcn_fence(__ATOMIC_ACQUIRE, "agent");
            asm volatile("s_waitcnt vmcnt(0)" ::: "memory");
#endif
        }
    }
    __syncthreads();
}
struct Args { const float* in[N_IN]; float* out; unsigned char* ws; int ph_lo, ph_hi; };
struct Frame {
    LAS unsigned char* lds;
    gu32* ctl;
    unsigned char* ws;
    int tid, lane, wave, vcu, G;
};
#define WSP(type, off) ((type*)(GAS type*)(F.ws + (off)))
__device__ __forceinline__ const float* uni(const float* p) { const u64 v = (u64)p; return (const float*)(const GAS float*)(((u64)(unsigned)__builtin_amdgcn_readfirstlane((int)(v >> 32)) << 32) | (u64)(unsigned)__builtin_amdgcn_readfirstlane((int)v)); }
__device__ __forceinline__ Frame make_frame(unsigned char* ws_, LAS unsigned char* lds_) {
    Frame F; const u64 v = (u64)ws_;
    F.ws = (unsigned char*)(((u64)(unsigned)__builtin_amdgcn_readfirstlane((int)(v >> 32)) << 32) | (u64)(unsigned)__builtin_amdgcn_readfirstlane((int)v));
    F.lds = (LAS unsigned char*)(unsigned)__builtin_amdgcn_readfirstlane((int)(unsigned)(uintptr_t)lds_);
    F.ctl = (gu32*)(F.ws + WS_CTL);
    { int t_ = threadIdx.x; asm volatile("" : "+v"(t_)); F.tid = t_; }
    F.lane = F.tid & 63; F.wave = __builtin_amdgcn_readfirstlane(F.tid >> 6);
    F.G = gridDim.x; { const int bx = blockIdx.x; F.vcu = (F.G % 8 == 0) ? (bx % 8) * (F.G / 8) + bx / 8 : bx; }
    return F;
}
struct In6 { const float* p[6]; };

__device__ __forceinline__ void tr_block(Frame& F, const float* W_, int N, bf16* WT, int k0, int n0, int mode  , size_t drow_base, float scale) {
    LAS unsigned* img = (LAS unsigned*)F.lds; const int lane = F.lane, wave = F.wave, tid = F.tid; const GAS float* W = (const GAS float*)W_;
    f32x4 va[4][2], vb[4][2];
#pragma unroll
    for (int i = 0; i < 4; ++i) { const int kp = wave * 4 + i; const GAS float* r0 = W + (size_t)(k0 + 2 * kp) * N + n0; const GAS float* r1 = r0 + N;
#pragma unroll
        for (int q = 0; q < 2; ++q) { const int c4 = lane + 64 * q; va[i][q] = (f32x4){0.f, 0.f, 0.f, 0.f}; vb[i][q] = va[i][q];
            if (n0 + 4 * c4 < N) { va[i][q] = __builtin_nontemporal_load((const GAS f32x4*)(r0 + 4 * c4)); vb[i][q] = __builtin_nontemporal_load((const GAS f32x4*)(r1 + 4 * c4)); } } }
#pragma unroll
    for (int i = 0; i < 4; ++i) { const int kp = wave * 4 + i;
#pragma unroll
        for (int q = 0; q < 2; ++q) { const int c4 = lane + 64 * q; const f32x4 a = va[i][q], b = vb[i][q];
            v4u o; o.x = pk2(a.x * scale, b.x * scale); o.y = pk2(a.y * scale, b.y * scale); o.z = pk2(a.z * scale, b.z * scale); o.w = pk2(a.w * scale, b.w * scale);
            *(LAS v4u*)(img + kp * 516 + 4 * c4) = o; } }
    __syncthreads();
    const int c = tid & 7;
#pragma unroll
    for (int i = 0; i < 8; ++i) { const int n = (tid >> 3) + 64 * i; const LAS unsigned* p = img + (4 * c) * 516 + n;
        v4u o; o.x = p[0]; o.y = p[516]; o.z = p[2 * 516]; o.w = p[3 * 516];
        const int ng = n0 + n; size_t dr;
        if (mode == 1) dr = ng < 1024 ? (size_t)((ng >> 7) * 256 + (ng & 127)) : (size_t)((((ng - 1024) >> 7) * 256) + 128 + ((ng - 1024) & 127)); else dr = (size_t)ng;
        *(GAS v4u*)((GAS bf16*)WT + (drow_base + dr) * D + k0 + 8 * c) = o; }
    __syncthreads();
}
__device__ __forceinline__ void tr_block8(Frame& F, const float* W_, int N, unsigned char* WT, int k0, int n0, int mode, size_t drow_base, float scale) {
    LAS unsigned* img = (LAS unsigned*)F.lds; const int lane = F.lane, wave = F.wave, tid = F.tid; const GAS float* W = (const GAS float*)W_;
    f32x4 vv[4][2][4];
#pragma unroll
    for (int i = 0; i < 4; ++i) { const int kq = wave * 4 + i; const GAS float* r0 = W + (size_t)(k0 + 4 * kq) * N + n0;
#pragma unroll
        for (int q = 0; q < 2; ++q) { const int c4 = lane + 64 * q;
#pragma unroll
            for (int j = 0; j < 4; ++j) vv[i][q][j] = __builtin_nontemporal_load((const GAS f32x4*)(r0 + (size_t)j * N + 4 * c4)); } }
#pragma unroll
    for (int i = 0; i < 4; ++i) { const int kq = wave * 4 + i;
#pragma unroll
        for (int q = 0; q < 2; ++q) { const int c4 = lane + 64 * q; const f32x4 a = vv[i][q][0] * scale, b = vv[i][q][1] * scale, c = vv[i][q][2] * scale, d = vv[i][q][3] * scale;
            v4u o; o.x = pk4_fp8(a.x, b.x, c.x, d.x); o.y = pk4_fp8(a.y, b.y, c.y, d.y); o.z = pk4_fp8(a.z, b.z, c.z, d.z); o.w = pk4_fp8(a.w, b.w, c.w, d.w);
            *(LAS v4u*)(img + kq * 516 + 4 * c4) = o; } }
    __syncthreads();
    const int c = tid & 7;
#pragma unroll
    for (int i = 0; i < 8; ++i) { const int n = (tid >> 3) + 64 * i; const LAS unsigned* p = img + (4 * c) * 516 + n;
        v4u o; o.x = p[0]; o.y = p[516]; o.z = p[2 * 516]; o.w = p[3 * 516];
        const int ng = n0 + n; size_t dr;
        if (mode == 1) dr = ng < 1024 ? (size_t)((ng >> 7) * 256 + (ng & 127)) : (size_t)((((ng - 1024) >> 7) * 256) + 128 + ((ng - 1024) & 127)); else dr = (size_t)ng;
        __builtin_nontemporal_store(o, (GAS v4u*)((GAS unsigned char*)WT + (drow_base + dr) * D + k0 + 16 * c)); }
    __syncthreads();
}
__device__ __forceinline__ void p_prologue(Frame& F, const In6& A) {
    constexpr int I_IN = 16 * 6, I_OUT = 16 * 2, I_GU = NE * 8 * 4, I_DN = NE * 8 * 2, I_L = I_IN + I_OUT + I_GU + I_DN;
    for (int it = F.vcu; it < DEPTH * I_L; it += F.G) {
        const int l = it / I_L; int r = it % I_L;
        if (r < I_IN) { const int kb = r / 6, nb = r % 6; tr_block(F, A.p[0] + (size_t)l * D * NIN, NIN, WSP(bf16, WS_WIN) + (size_t)l * NINP * D, kb * 64, nb * 512, 0, 0, nb == 2 ? ATT_C2 : 1.f); continue; }
        r -= I_IN;
        if (r < I_OUT) { const int kb = r / 2, nb = r % 2; tr_block(F, A.p[1] + (size_t)l * D * D, D, WSP(bf16, WS_WOUT) + (size_t)l * D * D, kb * 64, nb * 512, 0, 0, 1.f); continue; }
        r -= I_OUT;
        if (r < I_GU) { const int e = r / 32, rr = r % 32, kb = rr / 4, nb = rr % 4; tr_block8(F, A.p[2] + (size_t)(l * NE + e) * D * 2048, 2048, WSP(unsigned char, WS_WGU) + (size_t)l * NE * 2048 * D * 2, kb * 128, nb * 512, 1, (size_t)e * 2048, WGU_SCALE); continue; }
        r -= I_GU;
        { const int e = r / 16, rr = r % 16, kb = rr / 2, nb = rr % 2; tr_block8(F, A.p[3] + (size_t)(l * NE + e) * D * D, D, WSP(unsigned char, WS_WDN) + (size_t)l * NE * D * D * 2, kb * 128, nb * 512, 0, (size_t)e * 1024, WDN_SCALE); }
    }
    const int gw = F.vcu * NWAVES + F.wave, NGW = F.G * NWAVES, lane = F.lane;
    const GAS float* x = (const GAS float*)A.p[4]; GAS bf16* xb = (GAS bf16*)WSP(bf16, WS_XB);
    for (int m = gw; m < T; m += 2 * NGW) {
        const GAS f32x4* xr = (const GAS f32x4*)(x + (size_t)m * D) + lane; GAS u64* o8 = (GAS u64*)(xb + (size_t)m * D) + lane;
        const GAS f32x4* xr2 = xr + (size_t)NGW * (D / 4); GAS u64* o82 = o8 + (size_t)NGW * (D / 4);
        f32x4 v[4], w[4];
#pragma unroll
        for (int j = 0; j < 4; ++j) { v[j] = __builtin_nontemporal_load(xr + 64 * j); w[j] = __builtin_nontemporal_load(xr2 + 64 * j); }
#pragma unroll
        for (int j = 0; j < 4; ++j) { o8[64 * j] = (u64)pk2(v[j].x, v[j].y) | ((u64)pk2(v[j].z, v[j].w) << 32); o82[64 * j] = (u64)pk2(w[j].x, w[j].y) | ((u64)pk2(w[j].z, w[j].w) << 32); }
    }
}

__device__ __forceinline__ void bf8_to_f(const v4u q, float (&f)[8]) { f[0] = bflo(q.x); f[1] = bfhi(q.x); f[2] = bflo(q.y); f[3] = bfhi(q.y); f[4] = bflo(q.z); f[5] = bfhi(q.z); f[6] = bflo(q.w); f[7] = bfhi(q.w); }
__device__ __forceinline__ void p_local(Frame& F, const In6& A, int l) {
    typedef float f32x16 __attribute__((ext_vector_type(16)));
    constexpr int MROW = 528, WROW = 144;
    LAS unsigned char* mixb = F.lds;
    LAS unsigned char* wpt = F.lds + 64 * MROW;
    const GAS float* wpool = (const GAS float*)(A.p[0] + (size_t)l * 4 * 64 * 64);
    const GAS float* convw = (const GAS float*)(A.p[1] + l * 768); const GAS float* pscale = (const GAS float*)(A.p[2] + l * 256);
    const GAS float* kng = (const GAS float*)(A.p[3] + l * 32); const GAS float* knb = (const GAS float*)(A.p[4] + l * 32);
    const GAS bf16* PROJ = (const GAS bf16*)(F.ws + WS_PROJ); GAS bf16* CAT = (GAS bf16*)(F.ws + WS_CAT); GAS bf16* KIN = (GAS bf16*)(F.ws + WS_KIN);
    const int tid = F.tid, lane = F.lane, wave = F.wave;
    for (int u = F.vcu; u < T / 64; u += F.G) {
        const int t0 = u * 64, s0 = t0 & (SEQ - 1), rowb = t0 - s0;
        __syncthreads();
        f32x4 wr0[4], wr1[4];
#pragma unroll
        for (int i = 0; i < 4; ++i) { const int item = tid + 512 * i, g = item >> 9, cp = (item >> 4) & 31, dq = item & 15;
            wr0[i] = *(const GAS f32x4*)(wpool + g * 4096 + (2 * cp) * 64 + 4 * dq); wr1[i] = *(const GAS f32x4*)(wpool + g * 4096 + (2 * cp + 1) * 64 + 4 * dq); }
        const int cga = tid & 31, tga = tid >> 5, ca0 = cga * 8, sfa = s0 + tga * 4;
        v4u ah[6], ag[6], ab[4];
#pragma unroll
        for (int i = -2; i < 4; ++i) { const int sq = sfa + i; ah[i + 2] = (v4u){0u, 0u, 0u, 0u}; ag[i + 2] = ah[i + 2];
            if (sq >= 0) { const GAS bf16* pr = PROJ + (size_t)(rowb + sq) * NINP; ah[i + 2] = *(const GAS v4u*)(pr + C_H + ca0); ag[i + 2] = *(const GAS v4u*)(pr + C_GC + ca0);
                if (i >= 0) ab[i] = *(const GAS v4u*)(pr + C_GB + ca0); } }
        const int cgb = tid & 63, tgb = tid >> 6, cb0 = cgb * 4, wwin = 2 << (cgb >> 4), sfb = s0 + tgb * 8;
        v2u bq[23];
#pragma unroll
        for (int i = 0; i < 23; ++i) { const int sq = sfb - 15 + i; bq[i] = (v2u){0u, 0u}; if (sq >= 0) bq[i] = *(const GAS v2u*)(PROJ + (size_t)(rowb + sq) * NINP + C_P + cb0); }
        bf16 ck[4];
#pragma unroll
        for (int i = 0; i < 4; ++i) { const int idx = tid + 512 * i; ck[i] = PROJ[(size_t)(t0 + (idx >> 5)) * NINP + C_KI + (idx & 31)]; }
        const float kg = kng[tid & 31], kb = knb[tid & 31];
        float w0[8], w1[8], w2[8];
#pragma unroll
        for (int i = 0; i < 8; ++i) { w0[i] = convw[ca0 + i]; w1[i] = convw[256 + ca0 + i]; w2[i] = convw[512 + ca0 + i]; }
#pragma unroll
        for (int i = 0; i < 4; ++i) { const int item = tid + 512 * i, g = item >> 9, cp = (item >> 4) & 31, dq = item & 15;
#pragma unroll
            for (int k = 0; k < 4; ++k) *(LAS unsigned*)(wpt + (g * 64 + 4 * dq + k) * WROW + cp * 4) = pk2(wr0[i][k], wr1[i][k]); }
        {
            float up2[8], up1[8];
#pragma unroll
            for (int i = 0; i < 8; ++i) { up2[i] = 0.f; up1[i] = 0.f; }
#pragma unroll
            for (int i = -2; i < 4; ++i) { const int sq = sfa + i; float h8[8], g8[8], uu[8];
                bf8_to_f(ah[i + 2], h8); bf8_to_f(ag[i + 2], g8);
#pragma unroll
                for (int k = 0; k < 8; ++k) uu[k] = g8[k] * h8[k];
                if (i >= 0) { float b8[8], y[8]; bf8_to_f(ab[i], b8);
#pragma unroll
                    for (int k = 0; k < 8; ++k) y[k] = b8[k] * (w0[k] * up2[k] + w1[k] * up1[k] + w2[k] * uu[k]);
                    v4u o; o.x = pk2(y[0], y[1]); o.y = pk2(y[2], y[3]); o.z = pk2(y[4], y[5]); o.w = pk2(y[6], y[7]);
                    *(GAS v4u*)(CAT + (size_t)(rowb + sq) * D + ca0) = o; }
#pragma unroll
                for (int k = 0; k < 8; ++k) { up2[k] = up1[k]; up1[k] = uu[k]; } }
        }
        {
            float pv[23][4];
#pragma unroll
            for (int i = 0; i < 23; ++i) { pv[i][0] = bflo(bq[i].x); pv[i][1] = bfhi(bq[i].x); pv[i][2] = bflo(bq[i].y); pv[i][3] = bfhi(bq[i].y); }
#pragma unroll
            for (int i = 0; i < 8; ++i) { const int sq = sfb + i; float a0 = 0.f, a1 = 0.f, a2 = 0.f, a3 = 0.f;
#pragma unroll
                for (int j = 0; j < 16; ++j) { const bool on = j < wwin; a0 += on ? pv[15 + i - j][0] : 0.f; a1 += on ? pv[15 + i - j][1] : 0.f; a2 += on ? pv[15 + i - j][2] : 0.f; a3 += on ? pv[15 + i - j][3] : 0.f; }
                const float rc = 1.f / (float)((sq + 1) < wwin ? (sq + 1) : wwin);
                *(LAS v2u*)(mixb + (tgb * 8 + i) * MROW + cb0 * 2) = (v2u){pk2(a0 * rc - pv[15 + i][0], a1 * rc - pv[15 + i][1]), pk2(a2 * rc - pv[15 + i][2], a3 * rc - pv[15 + i][3])}; }
        }
#pragma unroll
        for (int i = 0; i < 4; ++i) {
            const int idx = tid + 512 * i, tt = idx >> 5, dd = idx & 31; const float v = bf2f(ck[i]);
            const float mean = sum32(v) * (1.f / 32.f); const float dv = v - mean; const float var = sum32(dv * dv) * (1.f / 32.f);
            KIN[(size_t)(t0 + tt) * 32 + dd] = (bf16)f2bf(dv * rsqrtf(var + LN_EPS) * kg + kb);
        }
        __syncthreads();
        {
            const int g = wave >> 1, th = wave & 1, r32 = lane & 31, hi = lane >> 5;
            f32x16 acc[2]; acc[0] = f32x16{}; acc[1] = f32x16{};
#pragma unroll
            for (int kk = 0; kk < 4; ++kk) { const bf16x8 bfr = *(const LAS bf16x8*)(mixb + (th * 32 + r32) * MROW + (g * 64 + kk * 16 + hi * 8) * 2);
#pragma unroll
                for (int dh = 0; dh < 2; ++dh) { const bf16x8 afr = *(const LAS bf16x8*)(wpt + (g * 64 + dh * 32 + r32) * WROW + (kk * 16 + hi * 8) * 2);
                    acc[dh] = __builtin_amdgcn_mfma_f32_32x32x16_bf16(afr, bfr, acc[dh], 0, 0, 0); } }
            GAS bf16* orow = CAT + (size_t)(t0 + th * 32 + r32) * D + 256 + g * 64;
#pragma unroll
            for (int dh = 0; dh < 2; ++dh)
#pragma unroll
                for (int rq = 0; rq < 4; ++rq) { const int d0 = dh * 32 + 8 * rq + 4 * hi; const f32x4 sc = *(const GAS f32x4*)(pscale + g * 64 + d0);
                    *(GAS v2u*)(orow + d0) = (v2u){pk2(acc[dh][4 * rq] * sc.x, acc[dh][4 * rq + 1] * sc.y), pk2(acc[dh][4 * rq + 2] * sc.z, acc[dh][4 * rq + 3] * sc.w)}; }
        }
    }
    __syncthreads();
}

constexpr int SCS = SEQ;
__device__ __forceinline__ unsigned sortable(float v) { const unsigned u = __builtin_bit_cast(unsigned, v); return (u & 0x80000000u) ? ~u : (u | 0x80000000u); }
__device__ __forceinline__ void select_row(int t, const GAS float* SC, GAS unsigned* MASK, LAS unsigned* hist, LAS float* ckey, LAS int* cidx, int lane) {
    const u64 lt = (1ull << lane) - 1ull; const float NINF = -INFINITY;
    const int s = t & (SEQ - 1); GAS u64* mrow = (GAS u64*)MASK + ((size_t)(t >> 12) * 64) * SEQ + s;
    if (s < NSEL) { const int base = 64 * lane; u64 m; if (s >= base + 63) m = ~0ull; else if (s < base) m = 0ull; else m = (2ull << (s - base)) - 1ull; mrow[(size_t)lane * SEQ] = m; return; }
    const int jmax = s >> 6, jb = jmax & ~7;
    float v[64]; const GAS float* srow = SC + (size_t)t * SCS + lane;
#pragma unroll
    for (int j0 = 0; j0 < 64; j0 += 8) {
        if (j0 < jb) {
#pragma unroll
            for (int j = j0; j < j0 + 8; ++j) v[j] = srow[64 * j];
        } else if (j0 == jb) {
#pragma unroll
            for (int j = j0; j < j0 + 8; ++j) { const float x = srow[64 * j]; v[j] = (lane + 64 * j <= s) ? x : NINF; }
        } else {
#pragma unroll
            for (int j = j0; j < j0 + 8; ++j) v[j] = NINF;
        }
    }
    {
    float vmx = NINF, vmn = INFINITY;
#pragma unroll
    for (int j0 = 0; j0 < 64; j0 += 8) {
        if (j0 < jb) {
#pragma unroll
            for (int j = j0; j < j0 + 8; ++j) { vmx = fmaxf(vmx, v[j]); vmn = fminf(vmn, v[j]); }
        } else if (j0 == jb) {
#pragma unroll
            for (int j = j0; j < j0 + 8; ++j) { vmx = fmaxf(vmx, v[j]); vmn = fminf(vmn, v[j] == NINF ? INFINITY : v[j]); }
        }
    }
    vmx = wave_max_dpp(vmx); vmn = -wave_max_dpp(-vmn);
    const float scale = 1023.f / fmaxf(vmx - vmn, 1e-30f), off = -vmn * scale;
#pragma unroll
    for (int i = 0; i < 4; ++i) ((LAS v4u*)hist)[i * 64 + lane] = (v4u){0u, 0u, 0u, 0u};
    LDS_WAIT(); asm volatile("" ::: "memory");
    unsigned bp[32];
#pragma unroll
    for (int j0 = 0; j0 < 64; j0 += 8) {
        if (j0 < jb) {
#pragma unroll
            for (int j = j0; j < j0 + 8; ++j) { unsigned bb = (unsigned)fmaf(v[j], scale, off); bb = bb < 1023u ? bb : 1023u; __hip_atomic_fetch_add(hist + bb, 1u, __ATOMIC_RELAXED, __HIP_MEMORY_SCOPE_WORKGROUP);
                if (j & 1) bp[j >> 1] |= bb << 16; else bp[j >> 1] = bb; }
        } else if (j0 == jb) {
#pragma unroll
            for (int j = j0; j < j0 + 8; ++j) { unsigned bb = (unsigned)fmaf(v[j], scale, off); bb = bb < 1023u ? bb : 1023u; if (v[j] != NINF) __hip_atomic_fetch_add(hist + bb, 1u, __ATOMIC_RELAXED, __HIP_MEMORY_SCOPE_WORKGROUP);
                if (j & 1) bp[j >> 1] |= bb << 16; else bp[j >> 1] = bb; }
        } else {
#pragma unroll
            for (int j = j0; j < j0 + 8; j += 2) bp[j >> 1] = 0u;
        }
    }
    LDS_WAIT(); asm volatile("" ::: "memory");
    unsigned hb[16];
#pragma unroll
    for (int i = 0; i < 4; ++i) { const v4u q = ((const LAS v4u*)hist)[lane * 4 + i]; hb[4 * i] = q.x; hb[4 * i + 1] = q.y; hb[4 * i + 2] = q.z; hb[4 * i + 3] = q.w; }
    int own = 0;
#pragma unroll
    for (int i = 0; i < 16; ++i) own += (int)hb[i];
    int suf = own;
#pragma unroll
    for (int o = 1; o < 64; o <<= 1) { const int x = __shfl_down(suf, o); if (lane + o < 64) suf += x; }
    const u64 ge = __ballot(suf >= NSEL); const int L = 63 - __builtin_clzll(ge);
    int acc = suf - own, tb = 0, ca = 0, found = 0;
#pragma unroll
    for (int i = 15; i >= 0; --i) { if (!found) { if (acc + (int)hb[i] >= NSEL) { found = 1; tb = lane * 16 + i; ca = acc; } else acc += (int)hb[i]; } }
    const int TB = __builtin_amdgcn_readlane(tb, L), CA = __builtin_amdgcn_readlane(ca, L);
    const int need = NSEL - CA;
    int cbase = 0; unsigned mlo = 0u, mhi = 0u;
#pragma unroll
    for (int j0 = 0; j0 < 64; j0 += 8) {
        if (j0 <= jb) {
#pragma unroll
            for (int j = j0; j < j0 + 8; ++j) { const int bb = (int)((j & 1) ? (bp[j >> 1] >> 16) : (bp[j >> 1] & 0xffffu));
                const u64 am = __ballot(bb > TB); const u64 cm = __ballot(bb == TB);
                asm volatile("s_nop 4\n\tv_writelane_b32 %0, %2, %4\n\tv_writelane_b32 %1, %3, %4" : "+v"(mlo), "+v"(mhi) : "s"((unsigned)am), "s"((unsigned)(am >> 32)), "n"(j));
                if (cm) { const int pos = cbase + __popcll(cm & lt); if (bb == TB && pos < 64) { ckey[pos] = v[j]; cidx[pos] = lane + 64 * j; } cbase += __popcll(cm); } }
        }
    }
    LDS_WAIT(); asm volatile("" ::: "memory");
    if (cbase <= SEL_CAND_CAP) {
        LAS unsigned* mw = hist;
        mw[2 * lane] = mlo; mw[2 * lane + 1] = mhi;
        const float myk = lane < cbase ? ckey[lane] : NINF; const int myi = lane < cbase ? cidx[lane] : 0x7fffffff; int rank = 0;
        for (int c = 0; c < cbase; ++c) { const float ok = __builtin_bit_cast(float, __builtin_amdgcn_readlane(__builtin_bit_cast(int, myk), c)); const int oi = __builtin_amdgcn_readlane(myi, c); rank += (ok > myk || (ok == myk && oi < myi)) ? 1 : 0; }
        LDS_WAIT(); asm volatile("" ::: "memory");
        if (lane < cbase && rank < need && myk != NINF) __hip_atomic_fetch_or(mw + (myi >> 5), 1u << (myi & 31), __ATOMIC_RELAXED, __HIP_MEMORY_SCOPE_WORKGROUP);
        LDS_WAIT(); asm volatile("" ::: "memory");
        mrow[(size_t)lane * SEQ] = (u64)mw[2 * lane] | ((u64)mw[2 * lane + 1] << 32);
        LDS_WAIT(); asm volatile("" ::: "memory");
        return;
    }
    unsigned prefix = 0u;
    for (int bit = 31; bit >= 0; --bit) { const unsigned cand = prefix | (1u << bit); int cnt = 0;
#pragma unroll
        for (int j0 = 0; j0 < 64; j0 += 8) {
#pragma unroll
            for (int j = j0; j < j0 + 8; ++j) cnt += __popcll(__ballot(v[j] != NINF && sortable(v[j]) >= cand));
            __builtin_amdgcn_sched_barrier(0); }
        if (cnt >= NSEL) prefix = cand; }
    int ngt = 0;
#pragma unroll
    for (int j = 0; j < 64; ++j) ngt += __popcll(__ballot(v[j] != NINF && sortable(v[j]) > prefix));
    int rem = NSEL - ngt, last = 0;
#pragma unroll
    for (int j = 0; j < 64; ++j) { const u64 em = __ballot(v[j] != NINF && sortable(v[j]) == prefix); const int c = __popcll(em);
        if (rem > 0 && c > 0) { if (c >= rem) { u64 x = em; for (int q = 1; q < rem; ++q) x &= x - 1ull; last = 64 * j + __builtin_ctzll(x); rem = 0; } else rem -= c; } }
    const unsigned pb = (prefix & 0x80000000u) ? (prefix & 0x7fffffffu) : ~prefix; const float Tv = __builtin_bit_cast(float, pb); const int Tidx = last;
    mlo = 0u; mhi = 0u;
#pragma unroll
    for (int j = 0; j < 64; ++j) { const bool sel = (v[j] > Tv) || (v[j] == Tv && lane + 64 * j <= Tidx); const u64 m = __ballot(sel);
        asm volatile("s_nop 4\n\tv_writelane_b32 %0, %2, %4\n\tv_writelane_b32 %1, %3, %4" : "+v"(mlo), "+v"(mhi) : "s"((unsigned)m), "s"((unsigned)(m >> 32)), "n"(j)); }
    mrow[(size_t)lane * SEQ] = (u64)mlo | ((u64)mhi << 32);
    return;
    }
}
__device__ __forceinline__ float relu_i(float x) { const int b = __builtin_bit_cast(int, x); return __builtin_bit_cast(float, b > 0 ? b : 0); }
__device__ __forceinline__ void p_index(Frame& F) {
    const int wave = F.wave;
    const GAS bf16* PROJ = (const GAS bf16*)(F.ws + WS_PROJ); const GAS bf16* KIN = (const GAS bf16*)(F.ws + WS_KIN); GAS float* SC = (GAS float*)(F.ws + WS_SC); GAS unsigned* MASK = (GAS unsigned*)(F.ws + WS_MASK);
    LAS unsigned* hist = (LAS unsigned*)(F.lds + wave * 4096);
    LAS float* ckey = (LAS float*)(F.lds + 32768 + wave * 1024); LAS int* cidx = (LAS int*)(ckey + 64);
    for (int ui = 0; ui < 2; ++ui) {
        const int v = F.vcu; if (v >= 256) break;
        const int b = v & 3, j = v >> 2, qb = ui == 0 ? j : 127 - j, q0 = qb * 32;
        int lane = F.tid & 63; asm volatile("" : "+v"(lane)); const int l15 = lane & 15, l4 = lane >> 4;
        bf16x8 bq[2][8]; float wq[2][8];
#pragma unroll
        for (int hq = 0; hq < 2; ++hq) { const size_t rowq = (size_t)(b * SEQ + q0 + 16 * hq + l15);
#pragma unroll
            for (int h = 0; h < 8; ++h) { bq[hq][h] = *(const GAS bf16x8*)(PROJ + rowq * NINP + C_QI + h * 32 + 8 * l4); wq[hq][h] = bf2f(PROJ[rowq * NINP + C_WI + h]) * 0.0625f; } }
        GAS float* srow = SC + (size_t)(b * SEQ + q0 + l15) * SCS + 4 * l4;
        const int ktl = 2 * qb + 1; const GAS bf16* kin0 = KIN + (size_t)(b * SEQ + l15) * 32 + 8 * l4;
        bf16x8 a = *(const GAS bf16x8*)(kin0 + (size_t)((wave <= ktl ? wave : ktl) * 16) * 32);
        for (int kt = wave; kt <= ktl; kt += NWAVES) {
            const int ktn = kt + NWAVES <= ktl ? kt + NWAVES : kt;
            const bf16x8 an = *(const GAS bf16x8*)(kin0 + (size_t)(ktn * 16) * 32);
#pragma unroll
            for (int hq = 0; hq < 2; ++hq) { f32x4 sc = (f32x4){0.f, 0.f, 0.f, 0.f};
#pragma unroll
                for (int h = 0; h < 8; ++h) { const f32x4 d = __builtin_amdgcn_mfma_f32_16x16x32_bf16(a, bq[hq][h], (f32x4){0.f, 0.f, 0.f, 0.f}, 0, 0, 0);
                    sc.x += relu_i(d.x) * wq[hq][h]; sc.y += relu_i(d.y) * wq[hq][h]; sc.z += relu_i(d.z) * wq[hq][h]; sc.w += relu_i(d.w) * wq[hq][h]; }
                *(GAS f32x4*)(srow + (size_t)(16 * hq) * SCS + kt * 16) = sc; }
            a = an;
        }
        asm volatile("s_waitcnt vmcnt(0)" ::: "memory"); __syncthreads();
        int lane_s = F.tid & 63; asm volatile("" : "+v"(lane_s));
        for (int r = 0; r < 4; ++r) select_row(b * SEQ + q0 + wave * 4 + r, SC, MASK, hist, ckey, cidx, lane_s);
#ifdef EXP_DUP_SELECT
        for (int r = 0; r < 4; ++r) select_row(b * SEQ + q0 + wave * 4 + r, SC, MASK, hist, ckey, cidx, lane_s);
#endif
    }
}

namespace att {
typedef float f32x16 __attribute__((ext_vector_type(16)));
typedef short s16x4 __attribute__((ext_vector_type(4)));
constexpr int NSLOT = 3, SLOTB = 8192, LDS_K = 0, LDS_V = NSLOT * SLOTB, LDS_WS = 2 * NSLOT * SLOTB, LDS_OST = LDS_WS + 8 * 64 * 4, LDS_BYTES_ATT = LDS_OST + 8 * 4096;
constexpr float THR = 100.f;
__device__ __forceinline__ int crow(int r, int hi) { return (r & 3) + 8 * (r >> 2) + 4 * hi; }
__device__ __forceinline__ unsigned cvtpk(float lo, float hi) { typedef float f2 __attribute__((ext_vector_type(2))); typedef __bf16 b2 __attribute__((ext_vector_type(2))); f2 v = {lo, hi}; b2 b = __builtin_convertvector(v, b2); return __builtin_bit_cast(unsigned, b); }
__device__ __forceinline__ float rowmax(const f32x16& p0, const f32x16& p1) {
    float a = fmaxf(fmaxf(p0[0], p0[1]), p1[0]), b = fmaxf(fmaxf(p0[2], p0[3]), p1[1]); a = fmaxf(fmaxf(a, p1[2]), p1[3]);
#pragma unroll
    for (int r = 4; r < 16; r += 4) { a = fmaxf(fmaxf(a, p0[r]), p0[r + 1]); b = fmaxf(fmaxf(b, p0[r + 2]), p0[r + 3]); a = fmaxf(fmaxf(a, p1[r]), p1[r + 1]); b = fmaxf(fmaxf(b, p1[r + 2]), p1[r + 3]); }
    const float m = fmaxf(a, b);
    return fmaxf(m, __shfl_xor(m, 32));
}
__device__ __forceinline__ void pv(f32x16* o, int vb, bf16x8 pa0, bf16x8 pa1, bf16x8 pa2, bf16x8 pa3) {
#pragma unroll
    for (int d0 = 0; d0 < 2; ++d0) { s16x4 lo[4], hi[4];
#pragma unroll
        for (int ks = 0; ks < 4; ++ks) {
            asm volatile("ds_read_b64_tr_b16 %0,%1 offset:%c2" : "=&v"(lo[ks]) : "v"(vb), "i"(d0 * 4096 + ks * 1024) : "memory");
            asm volatile("ds_read_b64_tr_b16 %0,%1 offset:%c2" : "=&v"(hi[ks]) : "v"(vb), "i"(d0 * 4096 + ks * 1024 + 512) : "memory"); }
        asm volatile("s_waitcnt lgkmcnt(0)" ::: "memory"); __builtin_amdgcn_sched_barrier(0);
#define ATT_PK(k) (bf16x8){lo[k][0], lo[k][1], lo[k][2], lo[k][3], hi[k][0], hi[k][1], hi[k][2], hi[k][3]}
        o[d0] = __builtin_amdgcn_mfma_f32_32x32x16_bf16(pa0, ATT_PK(0), o[d0], 0, 0, 0);
        o[d0] = __builtin_amdgcn_mfma_f32_32x32x16_bf16(pa1, ATT_PK(1), o[d0], 0, 0, 0);
        o[d0] = __builtin_amdgcn_mfma_f32_32x32x16_bf16(pa2, ATT_PK(2), o[d0], 0, 0, 0);
        o[d0] = __builtin_amdgcn_mfma_f32_32x32x16_bf16(pa3, ATT_PK(3), o[d0], 0, 0, 0);
#undef ATT_PK
    }
}
}
template <bool grpB> __device__ __forceinline__ void attn_units(Frame& F) {
    using namespace att;
    const int tid = F.tid, lane = tid & 63, r32 = lane & 31, hi = lane >> 5, wid = F.wave;
    const GAS bf16* PROJ = (const GAS bf16*)(F.ws + WS_PROJ); GAS bf16* CAT = (GAS bf16*)(F.ws + WS_CAT); const GAS u64* MASKT = (const GAS u64*)(F.ws + WS_MASK);
    LAS unsigned char* shm = F.lds;
    constexpr int NSV = 4, LDS_V2 = NSLOT * SLOTB, LDS_WS2 = LDS_V2 + NSV * SLOTB, LDS_OST2 = LDS_WS2 + 8 * 64 * 4;
    LAS float* wsf = (LAS float*)(shm + LDS_WS2) + wid * 64;
    const float NEGINF = -INFINITY;
    for (int ui = 0; ui < 2; ++ui) {
        const int v = F.vcu; if (v >= 256) break;
        const int bh = v >> 3, sidx = v & 7, b = bh >> 3, h = bh & 7, qb = ui == 0 ? sidx : 15 - sidx;
        const size_t rowbase = (size_t)b * SEQ; const int q0 = qb * 256, NT = (q0 + 256) / 64;
        const float slope2 = exp2f(-(float)(h + 1)) * 1.4426950408889634f;
        const GAS bf16* Kh = PROJ + rowbase * NINP + C_K + h * 64; const GAS bf16* Vh = PROJ + rowbase * NINP + C_V + h * 64;
        const GAS bf16* ksrc = Kh + (size_t)lane * NINP + wid * 8;
        const GAS bf16* vsrc = Vh + (size_t)(16 * (wid & 3) + (lane >> 2)) * NINP + (wid >> 2) * 32 + (lane & 3) * 8;
#define ATT_DMA(t, ks, vs) do { __builtin_amdgcn_global_load_lds((const GAS unsigned*)(ksrc + (size_t)(t) * 64 * NINP), (LAS unsigned*)(shm + LDS_K + (ks) * SLOTB + wid * 1024), 16, 0, 0); \
                        __builtin_amdgcn_global_load_lds((const GAS unsigned*)(vsrc + (size_t)(t) * 64 * NINP), (LAS unsigned*)(shm + LDS_V2 + (vs) * SLOTB + wid * 1024), 16, 0, 0); } while (0)
        ATT_DMA(0, 0, 0); ATT_DMA(1, 1, 1);
        const GAS bf16* Qw = PROJ + (rowbase + q0 + wid * 32) * NINP + C_Q + h * 64;
        bf16x8 qr[4];
#pragma unroll
        for (int d0 = 0; d0 < 4; ++d0) qr[d0] = *(const GAS bf16x8*)(Qw + (size_t)r32 * NINP + d0 * 16 + hi * 8);
        const GAS u64* mq = MASKT + ((size_t)b * 64) * SEQ + q0 + wid * 32 + r32;
        u64 mnext = mq[0], mprev = 0ull;
        f32x16 o[2], p0 = f32x16{}, p1 = f32x16{}; o[0] = f32x16{}; o[1] = f32x16{};
        float l_reg = 0.f, sq = 0.f;
        const unsigned sl_hi = __builtin_bit_cast(unsigned, slope2) & 0xffff0000u; const unsigned sl_lo = f2bf(slope2 - __builtin_bit_cast(float, sl_hi));
        bf16x8 kx0, kx1;
        { const unsigned j0 = hi ? 0u : (f2bf((float)r32) * 0x10001u), j1 = hi ? 0u : (f2bf((float)(r32 + 32)) * 0x10001u), one2 = hi ? 0u : 0x3f803f80u, one1 = hi ? 0u : 0x3f80u;
          kx0 = __builtin_bit_cast(bf16x8, (v4u){j0, one2, one1, 0u}); kx1 = __builtin_bit_cast(bf16x8, (v4u){j1, one2, one1, 0u}); }
        const int qlast = q0 + wid * 32 + 31;
        const int vb0 = (int)(unsigned)(uintptr_t)(shm + LDS_V2) + ((lane >> 4) & 1) * 32 + (lane & 3) * 8 + (4 * hi + ((lane & 15) >> 2)) * 64;
#define ATT_QK(ks) do { const LAS unsigned char* kb = shm + LDS_K + (ks) * SLOTB + hi * 1024 + r32 * 16; \
            { const unsigned u0_ = __builtin_bit_cast(unsigned, sq), a1_ = u0_ & 0xffff0000u; const float r1_ = sq - __builtin_bit_cast(float, a1_); const unsigned u1_ = __builtin_bit_cast(unsigned, r1_), a2_ = u1_ & 0xffff0000u; \
              const float r2_ = r1_ - __builtin_bit_cast(float, a2_); const unsigned a3_ = __builtin_bit_cast(unsigned, r2_) >> 16; \
              const bf16x8 qx = __builtin_bit_cast(bf16x8, (v4u){hi ? 0u : ((sl_hi >> 16) | (sl_lo << 16)), hi ? 0u : ((a1_ >> 16) | a2_), hi ? 0u : a3_, 0u}); \
              const f32x16 z_ = f32x16{}; p0 = __builtin_amdgcn_mfma_f32_32x32x16_bf16(kx0, qx, z_, 0, 0, 0); p1 = __builtin_amdgcn_mfma_f32_32x32x16_bf16(kx1, qx, z_, 0, 0, 0); } \
            _Pragma("unroll") for (int d0 = 0; d0 < 4; ++d0) { const bf16x8 k0 = *(const LAS bf16x8*)(kb + d0 * 2048), k1 = *(const LAS bf16x8*)(kb + d0 * 2048 + 512); \
                p0 = __builtin_amdgcn_mfma_f32_32x32x16_bf16(k0, qr[d0], p0, 0, 0, 0); p1 = __builtin_amdgcn_mfma_f32_32x32x16_bf16(k1, qr[d0], p1, 0, 0, 0); } } while (0)
#define ATT_SMPV(vs, mw) do { const unsigned w0 = (unsigned)(mw) >> (4 * hi), w1 = (unsigned)((mw) >> 32) >> (4 * hi); \
            asm volatile("s_nop 15\n\ts_nop 7" : "+v"(p0), "+v"(p1));   \
            _Pragma("unroll") for (int r = 0; r < 16; ++r) { const int cr = (r & 3) + 8 * (r >> 2); const int k0_ = __builtin_amdgcn_sbfe((int)w0, cr, 1), k1_ = __builtin_amdgcn_sbfe((int)w1, cr, 1); \
                asm("v_bfi_b32 %0, %1, %0, %2" : "+v"(p0[r]) : "v"(k0_), "v"(NEGINF)); asm("v_bfi_b32 %0, %1, %0, %2" : "+v"(p1[r]) : "v"(k1_), "v"(NEGINF)); } \
            const float rm = rowmax(p0, p1); bool resc = false; \
            if (__any(rm > THR)) { const float dl = fmaxf(rm, 0.f); \
                _Pragma("unroll") for (int r = 0; r < 16; ++r) { p0[r] -= dl; p1[r] -= dl; } sq -= dl; \
                const float f = __builtin_amdgcn_exp2f(-dl); l_reg *= f; if (hi == 0) wsf[r32] = f; resc = true; } \
            float sacc = 0.f; \
            _Pragma("unroll") for (int r = 0; r < 16; ++r) { p0[r] = __builtin_amdgcn_exp2f(p0[r]); p1[r] = __builtin_amdgcn_exp2f(p1[r]); sacc += p0[r] + p1[r]; } \
            l_reg += sacc; \
            if (resc) { asm volatile("s_waitcnt lgkmcnt(0)" ::: "memory"); \
                _Pragma("unroll") for (int d_ = 0; d_ < 2; ++d_) _Pragma("unroll") for (int r = 0; r < 16; ++r) o[d_][r] *= wsf[crow(r, hi)]; } \
            const v4u pw0 = (v4u){cvtpk(p0[0], p0[1]), cvtpk(p0[2], p0[3]), cvtpk(p0[4], p0[5]), cvtpk(p0[6], p0[7])}, pw1 = (v4u){cvtpk(p0[8], p0[9]), cvtpk(p0[10], p0[11]), cvtpk(p0[12], p0[13]), cvtpk(p0[14], p0[15])}; \
            const v4u pw2 = (v4u){cvtpk(p1[0], p1[1]), cvtpk(p1[2], p1[3]), cvtpk(p1[4], p1[5]), cvtpk(p1[6], p1[7])}, pw3 = (v4u){cvtpk(p1[8], p1[9]), cvtpk(p1[10], p1[11]), cvtpk(p1[12], p1[13]), cvtpk(p1[14], p1[15])}; \
            __builtin_amdgcn_sched_barrier(0); \
            pv(o, vb0 + (vs) * SLOTB, __builtin_bit_cast(bf16x8, pw0), __builtin_bit_cast(bf16x8, pw1), __builtin_bit_cast(bf16x8, pw2), __builtin_bit_cast(bf16x8, pw3)); } while (0)
        if constexpr (grpB) __builtin_amdgcn_s_setprio(1);
        const float step = 64.f * slope2;
        int ks = 0, vs = 0;
        u64 mcur = 0ull;
#define ATT_SYNC(t) do { if ((t) + 1 < NT) asm volatile("s_waitcnt vmcnt(2)" ::: "memory"); else asm volatile("s_waitcnt vmcnt(0)" ::: "memory"); \
            asm volatile("s_waitcnt lgkmcnt(0)" ::: "memory"); __builtin_amdgcn_s_barrier(); asm volatile("" ::: "memory"); \
            mprev = mcur; mcur = mnext; if ((t) + 1 < NT) mnext = mq[(size_t)((t) + 1) * SEQ]; \
            __builtin_amdgcn_sched_barrier(0); \
            if ((t) + 2 < NT) ATT_DMA((t) + 2, ks + 2 >= NSLOT ? ks + 2 - NSLOT : ks + 2, vs + 2 >= NSV ? vs + 2 - NSV : vs + 2); \
            __builtin_amdgcn_sched_barrier(0); } while (0)
#define ATT_ADV() do { sq += step; ks = ks + 1 >= NSLOT ? 0 : ks + 1; vs = vs + 1 >= NSV ? 0 : vs + 1; } while (0)
        const int tmax = qlast >> 6;
        if constexpr (!grpB) {
            int t = 0;
            for (; t <= tmax; ++t) { ATT_SYNC(t); ATT_QK(ks); ATT_SMPV(vs, mcur); ATT_ADV(); }
            for (; t < NT; ++t) { ATT_SYNC(t); ATT_ADV(); }
        } else {
            ATT_SYNC(0); ATT_QK(ks); ATT_ADV();
            int t = 1;
            for (; t <= tmax; ++t) { ATT_SYNC(t); ATT_SMPV(vs == 0 ? NSV - 1 : vs - 1, mprev); ATT_QK(ks); ATT_ADV(); }
            if (t < NT) { ATT_SYNC(t); ATT_SMPV(vs == 0 ? NSV - 1 : vs - 1, mprev); ATT_ADV(); ++t;
                for (; t < NT; ++t) { ATT_SYNC(t); ATT_ADV(); } }
            else { ATT_SMPV(vs == 0 ? NSV - 1 : vs - 1, mcur); }
        }
#undef ATT_SYNC
#undef ATT_ADV
        __builtin_amdgcn_s_setprio(0);
        l_reg += __shfl_xor(l_reg, 32);
        if (hi == 0) wsf[32 + r32] = l_reg;
        asm volatile("s_waitcnt lgkmcnt(0)" ::: "memory");
        float rli[16];
#pragma unroll
        for (int r = 0; r < 16; ++r) rli[r] = 1.f / wsf[32 + crow(r, hi)];
        GAS bf16* Ow = CAT + (rowbase + q0 + wid * 32) * D + 512 + h * 64;
        { LAS bf16* stg = (LAS bf16*)(shm + LDS_OST2) + wid * 2048;
#pragma unroll
            for (int r = 0; r < 16; ++r) { const int orow = crow(r, hi);
#pragma unroll
                for (int d0 = 0; d0 < 2; ++d0) stg[orow * 64 + d0 * 32 + r32] = (bf16)f2bf(o[d0][r] * rli[r]); }
            asm volatile("s_waitcnt lgkmcnt(0)" ::: "memory");
#pragma unroll
            for (int i = 0; i < 4; ++i) { const int row = i * 8 + (lane >> 3), ch = lane & 7; const v4u vv = *(const LAS v4u*)(stg + row * 64 + ch * 8); *(GAS v4u*)(Ow + (size_t)row * D + ch * 8) = vv; } }
        asm volatile("s_waitcnt vmcnt(0) lgkmcnt(0)" ::: "memory"); __builtin_amdgcn_s_barrier(); asm volatile("" ::: "memory");
#undef ATT_DMA
#undef ATT_QK
#undef ATT_SMPV
    }
}

__device__ __forceinline__ void p_attn_dense(Frame& F) { if (F.wave >= 4) attn_units<true>(F); else attn_units<false>(F); }

struct EpiResid {
    static constexpr bool PERM = true, AFTER_DRAIN = false;
    const bf16* resid; bf16* out; float alpha;
    __device__ __forceinline__ void operator()(const pg8::f32x4 (&acc)[2][2][4][2], const pg8::Unit& u, int wr, int wc, int fr, int fq) const {
        const int col0 = u.pn * 256 + wc * 32 + 8 * fq;
#pragma unroll
        for (int ai = 0; ai < 2; ++ai)
#pragma unroll
            for (int m = 0; m < 4; ++m) { const size_t off = (size_t)(u.pm * 256 + ai * 128 + wr * 64 + m * 16 + fr) * D + col0;
#pragma unroll
                for (int bj = 0; bj < 2; ++bj) { const v4u xr = *(const GAS v4u*)(resid + off + bj * 128); const f32x4 a0 = acc[ai][bj][m][0], a1 = acc[ai][bj][m][1];
                    v4u w; w.x = pk2(bflo(xr.x) * alpha + a0[0], bfhi(xr.x) * alpha + a0[1]); w.y = pk2(bflo(xr.y) * alpha + a0[2], bfhi(xr.y) * alpha + a0[3]);
                    w.z = pk2(bflo(xr.z) * alpha + a1[0], bfhi(xr.z) * alpha + a1[1]); w.w = pk2(bflo(xr.w) * alpha + a1[2], bfhi(xr.w) * alpha + a1[3]);
                    st16_wt(out + off + bj * 128, w.x, w.y, w.z, w.w); }
                if (m & 1) asm volatile("" ::: "memory"); }
    }
};
struct EpiSwiglu {
    static constexpr bool PERM = true, AFTER_DRAIN = false;
    unsigned char* O; const float* bias;
    __device__ __forceinline__ void operator()(const pg8::f32x4 (&acc)[2][2][4][2], const pg8::Unit& u, int wr, int wc, int fr, int fq) const {
        const int e = u.pn >> 3, nt = u.pn & 7; const int colg = nt * 128 + wc * 32 + 8 * fq;
        f32x4 bg[2], bu[2];
#pragma unroll
        for (int n = 0; n < 2; ++n) { bg[n] = *(const GAS f32x4*)(bias + (size_t)e * 2048 + colg + 4 * n); bu[n] = *(const GAS f32x4*)(bias + (size_t)e * 2048 + 1024 + colg + 4 * n); }
#pragma unroll
        for (int ai = 0; ai < 2; ++ai)
#pragma unroll
            for (int m = 0; m < 4; ++m) { const size_t row = (size_t)(u.pm * 256 + ai * 128 + wr * 64 + m * 16 + fr); float a8[8];
#pragma unroll
                for (int n = 0; n < 2; ++n)
#pragma unroll
                    for (int i = 0; i < 4; i += 2) {
                        typedef float f2 __attribute__((ext_vector_type(2)));
                        const f2 ag = {acc[ai][0][m][n][i], acc[ai][0][m][n][i + 1]}, au = {acc[ai][1][m][n][i], acc[ai][1][m][n][i + 1]};
                        const f2 bgv = {bg[n][i], bg[n][i + 1]}, buv = {bu[n][i] + 1.f, bu[n][i + 1] + 1.f};
                        f2 g = ag * (1.f / WGU_SCALE) + bgv, up1 = au * (1.f / WGU_SCALE) + buv;
                        g.x = fminf(g.x, 7.f); g.y = fminf(g.y, 7.f); up1.x = fminf(fmaxf(up1.x, -6.f), 8.f); up1.y = fminf(fmaxf(up1.y, -6.f), 8.f);
                        f2 t = g * (-1.702f * 1.4426950408889634f); t.x = __builtin_amdgcn_exp2f(t.x); t.y = __builtin_amdgcn_exp2f(t.y);
                        f2 d = t + 1.f; d.x = __builtin_amdgcn_rcpf(d.x); d.y = __builtin_amdgcn_rcpf(d.y);
                        const f2 r = g * up1 * d; a8[n * 4 + i] = r.x; a8[n * 4 + i + 1] = r.y; }
                v2u w; w.x = pk4_fp8(a8[0], a8[1], a8[2], a8[3]); w.y = pk4_fp8(a8[4], a8[5], a8[6], a8[7]);
                st8_wt(O + row * 1024 + colg, w.x, w.y); }
    }
};
struct EpiDown {
    static constexpr bool PERM = true, AFTER_DRAIN = false;
    bf16* O; const float* bias;
    __device__ __forceinline__ void operator()(const pg8::f32x4 (&acc)[2][2][4][2], const pg8::Unit& u, int wr, int wc, int fr, int fq) const {
        const int col0 = (u.pn & 3) * 256 + wc * 32 + 8 * fq; const float* bp = bias + (size_t)(u.pn >> 2) * 1024 + col0;
        f32x4 bv[2][2];
#pragma unroll
        for (int bj = 0; bj < 2; ++bj)
#pragma unroll
            for (int n = 0; n < 2; ++n) bv[bj][n] = *(const GAS f32x4*)(bp + bj * 128 + 4 * n);
#pragma unroll
        for (int ai = 0; ai < 2; ++ai)
#pragma unroll
            for (int m = 0; m < 4; ++m) { bf16* rowp = O + (size_t)(u.pm * 256 + ai * 128 + wr * 64 + m * 16 + fr) * 1024 + col0;
#pragma unroll
                for (int bj = 0; bj < 2; ++bj) { const f32x4 v0 = acc[ai][bj][m][0] * (1.f / WDN_SCALE) + bv[bj][0], v1 = acc[ai][bj][m][1] * (1.f / WDN_SCALE) + bv[bj][1];
                    v4u w; w.x = pk2(v0[0], v0[1]); w.y = pk2(v0[2], v0[3]); w.z = pk2(v1[0], v1[1]); w.w = pk2(v1[2], v1[3]);
                    st16_wt(rowp + bj * 128, w.x, w.y, w.z, w.w); } }
    }
};
struct MoeSched {
    const LAS int* tab; int n;
    __device__ __forceinline__ bool next(int i, pg8::Unit& u) const {
        if (i >= n) return false;
        const int v = __builtin_amdgcn_readfirstlane(tab[1 + i]); u.pm = v >> 16; u.pn = v & 0xffff; return true;
    }
    __device__ __forceinline__ void a_ready(const pg8::Unit&) const {}
    __device__ __forceinline__ void done(const pg8::Unit&) const {}
};
#ifndef MOE_UNIT_OWNER
#define MOE_UNIT_OWNER F.vcu
#endif
__device__ __forceinline__ int moe_table(Frame& F, int l, int ntn) {
    LAS int* tab = (LAS int*)(F.lds + TAB_OFF);
    if (F.wave == 0) {
        const int lane = F.lane; const int cnt = lane < NE ? (int)__hip_atomic_load(F.ctl + CW_CNT + 64 * l + lane, RLX_AGENT) : 0; const int mt = (cnt + 255) >> 8; int incl = mt;
#pragma unroll
        for (int o = 1; o < 64; o <<= 1) { const int v = __shfl_up(incl, o); if (lane >= o) incl += v; }
        const int total = __shfl(incl, 63) * ntn; const int c = MOE_UNIT_OWNER;
        const int xcd = c >> 5, jw = c & 31, uq = total >> 3, ur = total & 7, cntx = uq + (xcd < ur ? 1 : 0), basex = xcd * uq + (xcd < ur ? xcd : ur);
        const int nmine = jw < cntx ? (cntx - jw + 31) >> 5 : 0;
        for (int i0 = 0; i0 < nmine && i0 < 200; i0 += 64) { const int i = i0 + lane; const int L = basex + i * 32 + jw; int e = 0;
            for (int k = 0; k < NE; ++k) { const int endk = __shfl(incl, k) * ntn; e += (L >= endk) ? 1 : 0; }
            e = e < NE ? e : NE - 1;
            const int excl_e = __shfl(incl, e) - __shfl(mt, e); int mte = __shfl(mt, e); mte = mte > 0 ? mte : 1; const int idx = L - excl_e * ntn;
            if (i < nmine && i < 200) tab[1 + i] = ((excl_e + idx % mte) << 16) | (e * ntn + idx / mte); }
        if (lane == 0) tab[0] = nmine < 200 ? nmine : 200;
    }
    __syncthreads();
    return __builtin_amdgcn_readfirstlane(tab[0]);
}

__device__ __forceinline__ void p_router(Frame& F, const In6& A, int l) {
    const int lane = F.lane, wave = F.wave, tid = F.tid;
    constexpr int XROW = 2064;
    LAS unsigned char* XH = F.lds; LAS unsigned char* XL = F.lds + 16 * XROW;
    LAS float* part = (LAS float*)(F.lds + 2 * 16 * XROW);
    LAS int* cnt = (LAS int*)(F.lds + 2 * 16 * XROW + 16384);
    LAS float* lgs = (LAS float*)(F.lds + 2 * 16 * XROW + 16384 + 1024);
    LAS float* top = lgs + 512;
    const GAS bf16* Y1 = (const GAS bf16*)(F.ws + WS_Y1); GAS bf16* X1B = (GAS bf16*)(F.ws + WS_Y1 + 32 * MiB); GAS unsigned* XB8 = (GAS unsigned*)(F.ws + WS_XB8);
    GAS int* TOPE = (GAS int*)(F.ws + WS_ROUTE); GAS float* GATE = (GAS float*)(TOPE + 8 * T); GAS int* CNTW = (GAS int*)(F.ws + WS_CNTW);
    const GAS float* g1 = (const GAS float*)(A.p[0] + l * D); const GAS float* b1 = (const GAS float*)(A.p[1] + l * D);
    const GAS float* RW = (const GAS float*)(A.p[2] + (size_t)l * D * NE); const GAS float* RB = (const GAS float*)(A.p[3] + l * NE);
    if (tid < 256) cnt[tid] = 0;
    bf16x8 wh[4][2], wl[4][2];
#pragma unroll
    for (int st = 0; st < 4; ++st)
#pragma unroll
        for (int hf = 0; hf < 2; ++hf) { const GAS float* wp = RW + (size_t)(wave * 128 + st * 32 + (lane >> 4) * 8) * NE + (lane & 15) + 16 * hf;
#pragma unroll
            for (int j = 0; j < 8; ++j) { const float w = wp[(size_t)j * NE]; const unsigned h = f2bf(w); const float r = w - __builtin_bit_cast(float, h << 16); wh[st][hf][j] = (short)h; wl[st][hf][j] = (short)f2bf(r); } }
    f32x4 g1v[4], b1v[4];
#pragma unroll
    for (int j = 0; j < 4; ++j) { g1v[j] = ((const GAS f32x4*)g1)[lane + 64 * j]; b1v[j] = ((const GAS f32x4*)b1)[lane + 64 * j]; }
    const float rb_e = RB[tid & 31];
    v2u yq[2][4];
#pragma unroll
    for (int i = 0; i < 2; ++i) { const GAS v2u* yr = (const GAS v2u*)(Y1 + (size_t)(F.vcu * 64 + wave * 2 + i) * D) + lane;
#pragma unroll
        for (int j = 0; j < 4; ++j) yq[i][j] = yr[64 * j]; }
    for (int g = 0; g < 4; ++g) {
        const int t0 = F.vcu * 64 + g * 16;
#pragma unroll
        for (int i = 0; i < 2; ++i) { const int tl = wave * 2 + i, t = t0 + tl;
            GAS u64* xr1 = (GAS u64*)(X1B + (size_t)t * D) + lane; f32x4 v[4]; float s = 0.f;
#pragma unroll
            for (int j = 0; j < 4; ++j) { const v2u q = yq[i][j]; v[j] = (f32x4){bflo(q.x), bfhi(q.x), bflo(q.y), bfhi(q.y)}; s += (v[j].x + v[j].y) + (v[j].z + v[j].w); }
            if (g < 3) { const GAS v2u* yr = (const GAS v2u*)(Y1 + (size_t)(t + 16) * D) + lane;
#pragma unroll
                for (int j = 0; j < 4; ++j) yq[i][j] = yr[64 * j]; }
            const float mean = wave_sum(s) * (1.f / D); float s2 = 0.f;
#pragma unroll
            for (int j = 0; j < 4; ++j) { v[j] = v[j] - mean; s2 += (v[j].x * v[j].x + v[j].y * v[j].y) + (v[j].z * v[j].z + v[j].w * v[j].w); }
            const float rstd = rsqrtf(wave_sum(s2) * (1.f / D) + LN_EPS);
            GAS unsigned* o8 = XB8 + (size_t)t * (D / 4) + lane;
#pragma unroll
            for (int j = 0; j < 4; ++j) { const f32x4 y = v[j] * rstd * g1v[j] + b1v[j];
                o8[64 * j] = pk4_fp8(y.x, y.y, y.z, y.w);
                const unsigned h0 = f2bf(y.x), h1 = f2bf(y.y), h2 = f2bf(y.z), h3 = f2bf(y.w);
                const u64 hp = (u64)(h0 | (h1 << 16)) | ((u64)(h2 | (h3 << 16)) << 32); xr1[64 * j] = hp;
                const float r0 = y.x - __builtin_bit_cast(float, h0 << 16), r1 = y.y - __builtin_bit_cast(float, h1 << 16), r2 = y.z - __builtin_bit_cast(float, h2 << 16), r3 = y.w - __builtin_bit_cast(float, h3 << 16);
                *(LAS u64*)(XH + tl * XROW + (lane + 64 * j) * 8) = hp;
                *(LAS u64*)(XL + tl * XROW + (lane + 64 * j) * 8) = (u64)pk2(r0, r1) | ((u64)pk2(r2, r3) << 32); } }
        __syncthreads();
        f32x4 acc[2]; acc[0] = (f32x4){0.f, 0.f, 0.f, 0.f}; acc[1] = acc[0];
#pragma unroll
        for (int st = 0; st < 4; ++st) { const int boff = (lane & 15) * XROW + (wave * 128 + st * 32 + (lane >> 4) * 8) * 2;
            const bf16x8 bh = *(const LAS bf16x8*)(XH + boff), bl = *(const LAS bf16x8*)(XL + boff);
#pragma unroll
            for (int hf = 0; hf < 2; ++hf) { acc[hf] = __builtin_amdgcn_mfma_f32_16x16x32_bf16(wh[st][hf], bh, acc[hf], 0, 0, 0); acc[hf] = __builtin_amdgcn_mfma_f32_16x16x32_bf16(wh[st][hf], bl, acc[hf], 0, 0, 0);
                acc[hf] = __builtin_amdgcn_mfma_f32_16x16x32_bf16(wl[st][hf], bh, acc[hf], 0, 0, 0); } }
#pragma unroll
        for (int hf = 0; hf < 2; ++hf)
#pragma unroll
            for (int r = 0; r < 4; ++r) part[((wave * 2 + hf) * 16 + 4 * (lane >> 4) + r) * 16 + (lane & 15)] = acc[hf][r];
        __syncthreads();
        { const int tl = tid >> 5, e = tid & 31, t = t0 + tl; float lg = rb_e;
#pragma unroll
            for (int w = 0; w < 8; ++w) lg += part[((w * 2 + (e >> 4)) * 16 + (e & 15)) * 16 + tl];
            lgs[tl * 32 + e] = lg;
            LDS_WAIT(); asm volatile("" ::: "memory");
            int rank = 0;
#pragma unroll
            for (int q = 0; q < 8; ++q) { const f32x4 o = *(const LAS f32x4*)(lgs + tl * 32 + 4 * q);
#pragma unroll
                for (int i = 0; i < 4; ++i) { const int eo = 4 * q + i; rank += (o[i] > lg || (o[i] == lg && eo < e)) ? 1 : 0; } }
            if (rank < 4) { top[tl * 4 + rank] = lg; __hip_atomic_fetch_add(cnt + ((g * 16 + tl) >> 3) * 32 + e, 1, __ATOMIC_RELAXED, __HIP_MEMORY_SCOPE_WORKGROUP); }
            LDS_WAIT(); asm volatile("" ::: "memory");
            const f32x4 sv = *(const LAS f32x4*)(top + tl * 4);
            const float e1 = expf(sv[1] - sv[0]), e2 = expf(sv[2] - sv[0]), e3 = expf(sv[3] - sv[0]); const float inv = 1.f / (1.f + e1 + e2 + e3);
            if (rank < 4) { const float gk = (rank == 0 ? 1.f : rank == 1 ? e1 : rank == 2 ? e2 : e3) * inv; TOPE[4 * t + rank] = e; GATE[4 * t + rank] = gk; } }
    }
    __syncthreads();
    if (tid < 256) CNTW[(F.vcu * NWAVES + (tid >> 5)) * NE + (tid & 31)] = cnt[tid];
    __syncthreads();
}

__device__ __forceinline__ void p_gather(Frame& F, int l) {
    const int gw = F.vcu * NWAVES + F.wave, NGW = F.G * NWAVES, lane = F.lane, tid = F.tid;
    const int TPW = T / NGW, NIT = TPW * 4;
    const GAS int* CNTW = (const GAS int*)(F.ws + WS_CNTW);
    LAS int* red = (LAS int*)F.lds;
    LAS int* baseE = red + 1024; LAS int* totE = baseE + 32;
    { const int e = tid & 31, part = tid >> 5, first = F.vcu * NWAVES; int sb = 0, st = 0;
        for (int g0 = part; g0 < NGW; g0 += 256) { int c[16];
#pragma unroll
            for (int k = 0; k < 16; ++k) c[k] = g0 + 16 * k < NGW ? CNTW[(g0 + 16 * k) * NE + e] : 0;
#pragma unroll
            for (int k = 0; k < 16; ++k) { st += c[k]; sb += g0 + 16 * k < first ? c[k] : 0; } }
        red[part * 32 + e] = sb; red[512 + part * 32 + e] = st; }
    __syncthreads();
    if (tid < 32) { int sb = 0, st = 0;
#pragma unroll
        for (int p = 0; p < 16; ++p) { sb += red[p * 32 + tid]; st += red[512 + p * 32 + tid]; }
        baseE[tid] = sb; totE[tid] = st;
        if (F.vcu == 0) __hip_atomic_store(F.ctl + CW_CNT + 64 * l + tid, (unsigned)st, RLX_AGENT); }
    __syncthreads();
    int mybase = 0, tot = 0;
    if (lane < NE) { mybase = baseE[lane]; tot = totE[lane]; int cw[NWAVES - 1];
#pragma unroll
        for (int w = 0; w < NWAVES - 1; ++w) cw[w] = CNTW[(F.vcu * NWAVES + w) * NE + lane];
#pragma unroll
        for (int w = 0; w < NWAVES - 1; ++w) mybase += w < F.wave ? cw[w] : 0; }
    const int mt = (tot + 255) >> 8; int incl = mt;
#pragma unroll
    for (int o = 1; o < 64; o <<= 1) { const int v = __shfl_up(incl, o); if (lane >= o) incl += v; }
    const int pstart = (incl - mt) * 256;
    const GAS int* TOPE = (const GAS int*)(F.ws + WS_ROUTE); GAS int* ROWOF = (GAS int*)(F.ws + WS_ROUTE) + 12 * T; GAS int* ROWTOK = (GAS int*)(F.ws + WS_XS);
    if (F.vcu < NE && F.wave == 0) {
        const int e = F.vcu; const int ps = __builtin_amdgcn_readlane(pstart, e), te = __builtin_amdgcn_readlane(tot, e), me = __builtin_amdgcn_readlane(mt, e);
        for (int i = te + lane; i < me * 256; i += 64) ROWTOK[ps + i] = 0; }
    const int it0 = gw * NIT; const int ei = lane < NIT ? TOPE[it0 + lane] : 0; int rk = 0;
    for (int j = 0; j < NIT; ++j) { const int ej = __shfl(ei, j); rk += (j < lane && ej == ei) ? 1 : 0; }
    const int row = __shfl(pstart, ei) + __shfl(mybase, ei) + rk;
    if (lane < NIT) { ROWOF[it0 + lane] = row; ROWTOK[row] = (it0 + lane) >> 2; }
    __syncthreads();
}

__device__ __forceinline__ void p_combine(Frame& F, const In6& A, int l, float* xout_) {
    constexpr int TPW = 8;
    const int gw = F.vcu * NWAVES + F.wave, NGW = F.G * NWAVES, lane = F.lane;
    const GAS int* ROWOF = (const GAS int*)(F.ws + WS_ROUTE) + 12 * T; const GAS float* GATE = (const GAS float*)(F.ws + WS_ROUTE) + 8 * T;
    const GAS bf16* X1B = (const GAS bf16*)(F.ws + WS_Y1 + 32 * MiB); const GAS bf16* YS = (const GAS bf16*)(F.ws + WS_YS); GAS bf16* XB = (GAS bf16*)(F.ws + WS_XB);
    GAS float* xout = (GAS float*)xout_;
    const GAS f32x4* g2 = (const GAS f32x4*)(A.p[0] + l * D) + lane; const GAS f32x4* b2 = (const GAS f32x4*)(A.p[1] + l * D) + lane;
    int rowv = 0; float gatev = 0.f;
    if (lane < 4 * TPW) { const int tk = gw + (lane >> 2) * NGW; rowv = ROWOF[4 * tk + (lane & 3)]; gatev = GATE[4 * tk + (lane & 3)]; }
    f32x4 gg[4], bb[4];
#pragma unroll
    for (int j = 0; j < 4; ++j) { gg[j] = g2[64 * j]; bb[j] = b2[64 * j]; }
    v2u xq[2][4], yq[2][4][4];
#define CMB_ISSUE(k, bf) do { const int t_ = gw + (k) * NGW; const GAS v2u* xr_ = (const GAS v2u*)(X1B + (size_t)t_ * D) + lane; \
        _Pragma("unroll") for (int j = 0; j < 4; ++j) xq[bf][j] = xr_[64 * j]; \
        _Pragma("unroll") for (int c = 0; c < 4; ++c) { const int row_ = __builtin_amdgcn_readlane(rowv, 4 * (k) + c); const GAS v2u* yr_ = (const GAS v2u*)(YS + (size_t)row_ * D) + lane; \
            _Pragma("unroll") for (int j = 0; j < 4; ++j) yq[bf][c][j] = yr_[64 * j]; } } while (0)
    CMB_ISSUE(0, 0);
#pragma unroll
    for (int k = 0; k < TPW; ++k) {
        const int bf = k & 1, t = gw + k * NGW;
        if (k + 1 < TPW) { if (bf == 0) CMB_ISSUE(k + 1, 1); else CMB_ISSUE(k + 1, 0); }
        f32x4 v[4];
#pragma unroll
        for (int j = 0; j < 4; ++j) { const v2u q = xq[bf][j]; v[j] = (f32x4){bflo(q.x), bfhi(q.x), bflo(q.y), bfhi(q.y)} * DN_ALPHA; }
#pragma unroll
        for (int c = 0; c < 4; ++c) { const float gk = __builtin_bit_cast(float, __builtin_amdgcn_readlane(__builtin_bit_cast(int, gatev), 4 * k + c));
#pragma unroll
            for (int j = 0; j < 4; ++j) { const v2u w = yq[bf][c][j]; v[j].x += gk * bflo(w.x); v[j].y += gk * bfhi(w.x); v[j].z += gk * bflo(w.y); v[j].w += gk * bfhi(w.y); } }
        float s = 0.f;
#pragma unroll
        for (int j = 0; j < 4; ++j) s += (v[j].x + v[j].y) + (v[j].z + v[j].w);
        const float mean = wave_sum(s) * (1.f / D); float s2 = 0.f;
#pragma unroll
        for (int j = 0; j < 4; ++j) { v[j] = v[j] - mean; s2 += (v[j].x * v[j].x + v[j].y * v[j].y) + (v[j].z * v[j].z + v[j].w * v[j].w); }
        const float rstd = rsqrtf(wave_sum(s2) * (1.f / D) + LN_EPS);
        GAS f32x4* orow = (GAS f32x4*)(xout + (size_t)t * D) + lane; GAS u64* o8 = (GAS u64*)(XB + (size_t)t * D) + lane;
#pragma unroll
        for (int j = 0; j < 4; ++j) { const f32x4 y = v[j] * rstd * gg[j] + bb[j];
            if (xout_) __builtin_nontemporal_store(y, orow + 64 * j); else o8[64 * j] = (u64)pk2(y.x, y.y) | ((u64)pk2(y.z, y.w) << 32); }
        __builtin_amdgcn_sched_barrier(0);
    }
#undef CMB_ISSUE
}


#define NI __device__ __forceinline__
NI void ph_prologue(unsigned char* ws, LAS unsigned char* lds, const float* a0, const float* a1, const float* a2, const float* a3, const float* a4) { Frame F = make_frame(ws, lds); In6 I{{uni(a0), uni(a1), uni(a2), uni(a3), uni(a4), nullptr}}; p_prologue(F, I); }
NI void ph_local(unsigned char* ws, LAS unsigned char* lds, int l, const float* a0, const float* a1, const float* a2, const float* a3, const float* a4) { Frame F = make_frame(ws, lds); In6 I{{uni(a0), uni(a1), uni(a2), uni(a3), uni(a4), nullptr}}; p_local(F, I, __builtin_amdgcn_readfirstlane(l)); }
NI void ph_scores(unsigned char* ws, LAS unsigned char* lds) { Frame F = make_frame(ws, lds); p_index(F); }
NI void ph_attn(unsigned char* ws, LAS unsigned char* lds) { Frame F = make_frame(ws, lds); p_attn_dense(F); }
NI void ph_router(unsigned char* ws, LAS unsigned char* lds, int l, const float* a0, const float* a1, const float* a2, const float* a3) { Frame F = make_frame(ws, lds); In6 I{{uni(a0), uni(a1), uni(a2), uni(a3), nullptr, nullptr}}; p_router(F, I, __builtin_amdgcn_readfirstlane(l)); }
NI void ph_gather(unsigned char* ws, LAS unsigned char* lds, int l) { Frame F = make_frame(ws, lds); p_gather(F, __builtin_amdgcn_readfirstlane(l)); }
NI void ph_combine(unsigned char* ws, LAS unsigned char* lds, int l, const float* a0, const float* a1, float* xout) { Frame F = make_frame(ws, lds); In6 I{{uni(a0), uni(a1), nullptr, nullptr, nullptr, nullptr}}; p_combine(F, I, __builtin_amdgcn_readfirstlane(l), (float*)uni(xout)); }

NI void ph_gemm_in(unsigned char* ws, LAS unsigned char* lds, int l_) {
    Frame F = make_frame(ws, lds); const int l = __builtin_amdgcn_readfirstlane(l_);
    pg8::Gemm g{WSP(bf16, WS_XB), WSP(bf16, WS_WIN) + (size_t)l * NINP * D, T, NINP, D}; pg8::StaticOrder S; S.init(T, NINP, F.G, (int)blockIdx.x);
    pg8::EpiBf16<0> E{WSP(bf16, WS_PROJ), NINP, nullptr, 0, 0, 1.f};
    pg8::gemm_phase<pg8::EpiBf16<0>, pg8::StaticOrder, PG8_ALIGN, PG8_SP2>(F.lds, g, S, E);
}
NI void ph_gemm_out(unsigned char* ws, LAS unsigned char* lds, int l_, const float* xin) {
    Frame F = make_frame(ws, lds); const int l = __builtin_amdgcn_readfirstlane(l_);
    pg8::Gemm g{WSP(bf16, WS_CAT), WSP(bf16, WS_WOUT) + (size_t)l * D * D, T, D, D}; pg8::StaticOrder S; S.init(T, D, F.G, (int)blockIdx.x);
    EpiResid E{WSP(bf16, WS_XB), WSP(bf16, WS_Y1), DN_ALPHA};
    pg8::gemm_phase<EpiResid, pg8::StaticOrder, PG8_ALIGN, PG8_SP2>(F.lds, g, S, E);
}
NI void ph_gemm_moe1(unsigned char* ws, LAS unsigned char* lds, int l_, const float* bgu) {
    Frame F = make_frame(ws, lds); const int l = __builtin_amdgcn_readfirstlane(l_);
    const int nun = moe_table(F, l, 8);
    pg8::Gemm g{WSP(bf16, WS_XB8), (const bf16*)(WSP(unsigned char, WS_WGU) + (size_t)l * NE * 2048 * D * 2), MAXROWS, NE * 2048, D};
    MoeSched S{(const LAS int*)(F.lds + TAB_OFF), nun};
    EpiSwiglu E{WSP(unsigned char, WS_ACT), uni(bgu) + (size_t)l * NE * 2048};
    pg8::gemm_phase<EpiSwiglu, MoeSched, PG8_ALIGN, true, 1, true>(F.lds, g, S, E, WSP(int, WS_XS));
}
NI void ph_gemm_moe2(unsigned char* ws, LAS unsigned char* lds, int l_, const float* bdn) {
    Frame F = make_frame(ws, lds); const int l = __builtin_amdgcn_readfirstlane(l_);
    const int nun = moe_table(F, l, 4);
    pg8::Gemm g{WSP(bf16, WS_ACT), (const bf16*)(WSP(unsigned char, WS_WDN) + (size_t)l * NE * D * D * 2), MAXROWS, NE * D, D};
    MoeSched S{(const LAS int*)(F.lds + TAB_OFF), nun};
    EpiDown E{WSP(bf16, WS_YS), uni(bdn) + (size_t)l * NE * D};
    pg8::gemm_phase<EpiDown, MoeSched, PG8_ALIGN, MOE_SP2, 1>(F.lds, g, S, E);
}

__device__ __forceinline__ const float* karg_in(int i) { return ((const float* const volatile*)__builtin_amdgcn_kernarg_segment_ptr())[i]; }
__device__ __forceinline__ float* karg_out() { return ((float* const volatile*)__builtin_amdgcn_kernarg_segment_ptr())[N_IN]; }
#ifndef PHMASK
#define PHMASK 0x7FF
#endif
constexpr int PH_PER_LAYER = 10, N_PHASES = 1 + DEPTH * PH_PER_LAYER;
#define IN(k) (lo <= (k) && (k) < hi)
#define SEAM(k) do { if (IN(k) && IN((k) + 1)) xcd_barrier(bar); } while (0)
template <int l> __device__ __forceinline__ void layer_phases(Frame& F, const XcdBarrier& bar, int lo, int hi) {
        const int p0 = 1 + l * PH_PER_LAYER;
        const float* xin = nullptr;
        float* xout = l == DEPTH - 1 ? karg_out() : nullptr;
        if (((PHMASK >> 0) & 1) && IN(p0 + 0)) { asm volatile("; PHASE_BEGIN_0"); ph_gemm_in(F.ws, F.lds, l); SEAM(p0 + 0); }
        if (((PHMASK >> 1) & 1) && IN(p0 + 1)) { asm volatile("; PHASE_BEGIN_1"); ph_local(F.ws, F.lds, l, karg_in(IN_WPOOL), karg_in(IN_CONVW), karg_in(IN_PSCALE), karg_in(IN_KNG), karg_in(IN_KNB)); SEAM(p0 + 1); }
        if (((PHMASK >> 2) & 1) && IN(p0 + 2)) { asm volatile("; PHASE_BEGIN_2"); ph_scores(F.ws, F.lds); SEAM(p0 + 2); }
        if (((PHMASK >> 3) & 1) && IN(p0 + 3)) { asm volatile("; PHASE_BEGIN_3"); ph_attn(F.ws, F.lds); SEAM(p0 + 3); }
        if (((PHMASK >> 4) & 1) && IN(p0 + 4)) { asm volatile("; PHASE_BEGIN_4"); ph_gemm_out(F.ws, F.lds, l, xin); SEAM(p0 + 4); }
        if (((PHMASK >> 5) & 1) && IN(p0 + 5)) { asm volatile("; PHASE_BEGIN_5"); ph_router(F.ws, F.lds, l, karg_in(IN_LN1G), karg_in(IN_LN1B), karg_in(IN_RW), karg_in(IN_RB)); SEAM(p0 + 5); }
        if (((PHMASK >> 6) & 1) && IN(p0 + 6)) { asm volatile("; PHASE_BEGIN_6"); ph_gather(F.ws, F.lds, l); SEAM(p0 + 6); }
        if (((PHMASK >> 7) & 1) && IN(p0 + 7)) { asm volatile("; PHASE_BEGIN_7"); ph_gemm_moe1(F.ws, F.lds, l, karg_in(IN_BGU)); SEAM(p0 + 7); }
        if (((PHMASK >> 8) & 1) && IN(p0 + 8)) { asm volatile("; PHASE_BEGIN_8"); ph_gemm_moe2(F.ws, F.lds, l, karg_in(IN_BDN)); SEAM(p0 + 8); }
        if (((PHMASK >> 9) & 1) && IN(p0 + 9)) { asm volatile("; PHASE_BEGIN_9"); ph_combine(F.ws, F.lds, l, karg_in(IN_LN2G), karg_in(IN_LN2B), xout); SEAM(p0 + 9); }
}
#undef IN
#undef SEAM
__global__ void __launch_bounds__(NWAVES * 64, 2) fwd_kernel(Args A) {
    extern __shared__ __attribute__((aligned(16))) unsigned char lds[];
    Frame F;
    F.lds = (LAS unsigned char*)lds;
    F.tid = threadIdx.x; F.lane = F.tid & 63; F.wave = __builtin_amdgcn_readfirstlane(F.tid >> 6);
    F.G = gridDim.x; { const int bx = blockIdx.x; F.vcu = (F.G % 8 == 0) ? (bx % 8) * (F.G / 8) + bx / 8 : bx; }
    F.ws = A.ws; F.ctl = (gu32*)(A.ws + WS_CTL);
    volatile LAS unsigned* MISC = (volatile LAS unsigned*)(F.lds + MISC_OFF);
    if (F.tid < 32) MISC[F.tid] = 0u;
    __syncthreads();
    const int lo = A.ph_lo, hi = A.ph_hi;
    const bool multi = (hi - lo) > 1;
    XcdBarrier bar; bar.bar = (unsigned*)(F.ctl + CW_BAR); bar.x = 0; bar.st = nullptr;
    if (multi) bar = xcd_barrier_post((unsigned*)(F.ctl + CW_BAR), MISC + 8);
#define IN(k) (lo <= (k) && (k) < hi)
#define SEAM(k) do { if (IN(k) && IN((k) + 1)) xcd_barrier(bar); } while (0)

    if (((PHMASK >> 10) & 1) && IN(0)) { asm volatile("; PHASE_BEGIN_11"); ph_prologue(F.ws, F.lds, karg_in(IN_WIN), karg_in(IN_WOUT), karg_in(IN_WGU), karg_in(IN_WDN), karg_in(IN_X)); SEAM(0); }
    layer_phases<0>(F, bar, lo, hi);
    layer_phases<1>(F, bar, lo, hi);
#undef IN
#undef SEAM
}


#ifdef DUMP_OFF
__global__ void dump_kernel(const unsigned* w, size_t nwords, float* out, int n) {
    const int i = blockIdx.x * blockDim.x + threadIdx.x; if (i >= n) return;
#ifdef DUMP_NAN_ALL
    { bool bad = false; for (size_t j = (size_t)i; j < nwords; j += (size_t)n) { const unsigned x = w[j]; bad |= ((x & 0x7f80u) == 0x7f80u) || ((x & 0x7f800000u) == 0x7f800000u); } out[i] = bad ? 1e6f : 0.f; return; }
#endif
#ifdef DUMP_MASKCHECK
    { out[i] = 0.f; if ((i & 1023) == 0) { const int t = i >> 10, sq = t & 4095; const unsigned long long* mt = (const unsigned long long*)w + ((size_t)(t >> 12) * 64) * 4096 + sq; int pc = 0; bool beyond = false;
        for (int j = 0; j < 64; ++j) { const unsigned long long m = mt[(size_t)j * 4096]; pc += __popcll(m); for (int bb = 0; bb < 64; ++bb) if (((m >> bb) & 1ull) && 64 * j + bb > sq) beyond = true; }
        const int expect = sq + 1 < 256 ? sq + 1 : 256;
#if DUMP_MASKCHECK == 1
        if (pc != expect) out[i] = 1e6f;
#else
        if (beyond) out[i] = 1e6f;
#endif
      } return; }
#endif
#ifdef DUMP_NANCHECK
#if DUMP_NANCHECK == 2
    { size_t wi = (size_t)i;
#ifdef DUMP_ROWW
      wi = ((size_t)i / DUMP_COLW) * DUMP_ROWW + ((size_t)i % DUMP_COLW);
#endif
      if (wi >= nwords) { out[i] = 0.f; return; } const unsigned x = w[wi]; const bool bad = ((x & 0x7f80u) == 0x7f80u) || ((x & 0x7f800000u) == 0x7f800000u);
#ifdef DUMP_LOC
      { const int sq = (int)(wi / 512) & 4095; out[i] = bad ? 1000.f * (float)(DUMP_LOC == 1 ? sq + 1 : 4096 - sq) : 0.f; return; }
#endif
      out[i] = bad ? 1e6f : 0.f; return; }
#else
    { const float v = ((const float*)w)[i]; out[i] = (v == v && fabsf(v) < 1e30f) ? 0.f : 1e6f; return; }
#endif
#endif
#ifdef DUMP_VIA_ROWOF
    unsigned h; { const unsigned short* src = (const unsigned short*)w; const int* rowof = (const int*)((const char*)w - (size_t)(DUMP_OFF) + WS_ROUTE) + 12 * T; const int t = i >> 10, c = i & 1023;
        h = 0u; for (int k = 0; k < 4; ++k) h = h * 0x9E3779B1u + src[(size_t)rowof[4 * t + k] * 1024 + c]; }
#elif defined(DUMP_ROWW)
    unsigned h = 0u; { const size_t row = (size_t)i / DUMP_COLW, cw = (size_t)i % DUMP_COLW; if (row * DUMP_ROWW + cw < nwords) h = w[row * DUMP_ROWW + cw]; }
#else
    unsigned h = 0u; int k = 1; for (size_t j = (size_t)i; j < nwords; j += (size_t)n, k += 2) h ^= w[j] * (unsigned)k;
#endif
    out[i] = (float)((h ^ (h >> 11) ^ (h >> 22)) & 0xFFFFFu);
}
#endif
#ifndef MK_ONE_LAUNCH
#define MK_ONE_LAUNCH 0
#endif
extern "C" void kernel_launch(void* const* d_in, const int* in_sizes, int n_in, void* d_out, int out_size, void* d_ws, size_t ws_size, hipStream_t stream) {
    static int grid = 0;
    if (grid == 0) {
        if (n_in != N_IN || in_sizes[0] != T * D || out_size != T * D || ws_size < WS_END) { fprintf(stderr, "kernel_launch: unexpected shapes (n_in %d, in0 %d, out %d, ws %zu, need %zu); nothing launched\n", n_in, n_in > 0 ? in_sizes[0] : -1, out_size, ws_size, (size_t)WS_END); grid = -1; return; }
        int dev = 0, cus = 0, per_cu = 0;
        if (hipGetDevice(&dev) != hipSuccess || hipDeviceGetAttribute(&cus, hipDeviceAttributeMultiprocessorCount, dev) != hipSuccess) { grid = -1; return; }
        if (hipFuncSetAttribute((const void*)fwd_kernel, hipFuncAttributeMaxDynamicSharedMemorySize, LDS_BYTES) != hipSuccess) { fprintf(stderr, "kernel_launch: hipFuncSetAttribute failed\n"); grid = -1; return; }
        if (hipOccupancyMaxActiveBlocksPerMultiprocessor(&per_cu, (const void*)fwd_kernel, NWAVES * 64, LDS_BYTES) != hipSuccess || per_cu < 1) fprintf(stderr, "kernel_launch: occupancy query reports %d\n", per_cu);
        (void)hipGetLastError();
        grid = cus;
        if (grid != 256) { fprintf(stderr, "kernel_launch: built for 256 CUs, found %d; nothing launched\n", cus); grid = -1; return; }
    }
    if (grid < 0) return;
    if (hipMemsetAsync((char*)d_ws + WS_CTL, 0, CTL_ZERO_BYTES, stream) != hipSuccess) return;
    Args a{};
    for (int i = 0; i < N_IN; ++i) a.in[i] = (const float*)d_in[i];
    a.out = (float*)d_out; a.ws = (unsigned char*)d_ws;
#if MK_ONE_LAUNCH
    a.ph_lo = 0; a.ph_hi = N_PHASES;
    hipLaunchKernelGGL(fwd_kernel, dim3(grid), dim3(NWAVES * 64), LDS_BYTES, stream, a);
#else
#ifdef DUMP_OFF
    for (int p = 0; p < DUMP_STOP; ++p) { a.ph_lo = p; a.ph_hi = p + 1; hipLaunchKernelGGL(fwd_kernel, dim3(grid), dim3(NWAVES * 64), LDS_BYTES, stream, a); }
    hipLaunchKernelGGL(dump_kernel, dim3((T * D + 255) / 256), dim3(256), 0, stream, (const unsigned*)((const char*)d_ws + (size_t)(DUMP_OFF)), (size_t)(DUMP_WORDS), (float*)d_out, T * D);
    return;
#endif
    for (int p = 0; p < N_PHASES; ++p) { a.ph_lo = p; a.ph_hi = p + 1; hipLaunchKernelGGL(fwd_kernel, dim3(grid), dim3(NWAVES * 64), LDS_BYTES, stream, a);
#ifdef DBL_PHASE
        if ((p == 0 && DBL_PHASE == 10) || (p > 0 && (p - 1) % PH_PER_LAYER == DBL_PHASE)) hipLaunchKernelGGL(fwd_kernel, dim3(grid), dim3(NWAVES * 64), LDS_BYTES, stream, a);
#endif
    }
#endif
}
```

```cpp
#include <hip/hip_runtime.h>
#include <cstdio>
#include <cstdint>

#define MK_ONE_LAUNCH 1
#define BAR_EARLY_INV 1
#ifndef WT_STORES
#define WT_STORES 0
#endif
__device__ __forceinline__ void st16_wt(void* p, unsigned x, unsigned y, unsigned z, unsigned w) {
    typedef unsigned u4_ __attribute__((ext_vector_type(4))); const u4_ v = {x, y, z, w};
#if WT_STORES
    asm volatile("global_store_dwordx4 %0, %1, off sc1\n\ts_nop 2" :: "v"((__attribute__((address_space(1))) void*)p), "v"(v) : "memory");
#else
    *(__attribute__((address_space(1))) u4_*)p = v;
#endif
}
__device__ __forceinline__ void st8_wt(void* p, unsigned x, unsigned y) {
    typedef unsigned u2_ __attribute__((ext_vector_type(2))); const u2_ v = {x, y};
#if WT_STORES
    asm volatile("global_store_dwordx2 %0, %1, off sc1" :: "v"((__attribute__((address_space(1))) void*)p), "v"(v) : "memory");
#else
    *(__attribute__((address_space(1))) u2_*)p = v;
#endif
}
namespace pg8 {
#define PG8_LAS __attribute__((address_space(3)))
typedef unsigned short bf16_t;
typedef short bf16x8 __attribute__((ext_vector_type(8)));
typedef float f32x4 __attribute__((ext_vector_type(4)));
typedef unsigned u32x4 __attribute__((ext_vector_type(4)));
typedef int v4i_t __attribute__((ext_vector_type(4)));
typedef int v8i_t __attribute__((ext_vector_type(8)));
constexpr int BM = 256, BK = 64, HALF = 128, HTB = HALF * BK * 2  , STAGE_BYTES = 8 * HTB, NXCD = 8, WGM = 8;

__host__ __device__ __forceinline__ int lds_byte(int r, int c) { const int st = (r >> 4) * 2 + (c >> 5), rr = r & 15, cc = c & 31, ob = rr * 64 + cc * 2; return st * 1024 + (ob ^ (((ob >> 9) & 1) << 5)); }
__host__ __device__ __forceinline__ void stage_rc(int b, int& R, int& C) { const int st = b / 1024, sb = b % 1024, swz = sb ^ (((sb >> 9) & 1) << 5); R = (st >> 1) * 16 + swz / 64; C = (st & 1) * 32 + (swz % 64) / 2; }
__host__ __device__ __forceinline__ int perm32(int rho) { const int n = rho >> 4, i = rho & 15; return 8 * (i >> 2) + 4 * n + (i & 3); }

struct Unit { int pm, pn; };
struct Gemm { const bf16_t* A; const bf16_t* Bt; int M, N, K; };

struct StaticOrder {
    int nM, nN, nwg, G, c;
    __host__ __device__ void init(int M, int N, int G_, int c_) { nM = M / BM; nN = N / BM; nwg = nM * nN; G = G_; c = c_; }
    __host__ __device__ bool next(int i, Unit& u) const {
        const long L = (long)i * G + c; if (L >= nwg) return false;
        int wgid = (int)L; { const int q = nwg / NXCD, r = nwg % NXCD, xcd = wgid % NXCD, off = wgid / NXCD; wgid = (xcd < r ? xcd * (q + 1) : r * (q + 1) + (xcd - r) * q) + off; }
        const int nig = WGM * nN, gid = wgid / nig, fm = gid * WGM, gsz = (nM - fm) < WGM ? (nM - fm) : WGM;
        u.pm = fm + ((wgid % nig) % gsz); u.pn = (wgid % nig) / gsz; return true;
    }
    __device__ __forceinline__ void a_ready(const Unit&) const {}
    __device__ __forceinline__ void done(const Unit&) const {}
};

__device__ __forceinline__ unsigned cvt_pk_bf16(float lo, float hi) { unsigned r; asm volatile("v_cvt_pk_bf16_f32 %0, %1, %2" : "=v"(r) : "v"(lo), "v"(hi)); return r; }
typedef float f32x2 __attribute__((ext_vector_type(2)));
__device__ __forceinline__ f32x2 gelu_pk(f32x2 v) {
    const f32x2 av = __builtin_elementwise_abs(v), d = av * 0.2316418882f + 1.0f;
    f32x2 t; t.x = __builtin_amdgcn_rcpf(d.x); t.y = __builtin_amdgcn_rcpf(d.y);
    f32x2 q = t * 0.5307027145f + (-0.7265760135f); q = q * t + 0.7107068705f; q = q * t + (-0.142248368f); q = q * t + 0.127414796f; q = q * t;
    const f32x2 s = (v * v) * (-0.72134752044f);
    f32x2 e; e.x = __builtin_amdgcn_exp2f(s.x); e.y = __builtin_amdgcn_exp2f(s.y);
    const f32x2 m = v * (q * e), r = v - m;
    f32x2 o; o.x = v.x < 0.f ? m.x : r.x; o.y = v.y < 0.f ? m.y : r.y; return o;
}

template <int ACT  > struct EpiBf16 {
    static constexpr bool PERM = true, AFTER_DRAIN = false; static_assert(ACT == 0 || ACT == 1, "EpiBf16: ACT is 0 (none) or 1 (gelu_pk)");
    bf16_t* O; int ldc; const float* bias; int split_cols; size_t split_stride; float scale0;
    __device__ __forceinline__ void operator()(const f32x4 (&acc)[2][2][4][2], const Unit& u, int wr, int wc, int fr, int fq) const {
        const int row0 = u.pm * BM + wr * 64 + fr; int colt = u.pn * BM; bf16_t* base = O;
        float sc = 1.f; if (split_cols) { const int t = colt / split_cols; base += (size_t)t * split_stride; colt -= t * split_cols; if (t == 0) sc = scale0; }
        const int col0 = colt + wc * 32 + 8 * fq, bcol0 = u.pn * BM + wc * 32 + 8 * fq;
        f32x4 bv[2][2];
#pragma unroll
        for (int bj = 0; bj < 2; ++bj)
#pragma unroll
            for (int n = 0; n < 2; ++n) bv[bj][n] = bias ? *(const __attribute__((address_space(1))) f32x4*)(bias + bcol0 + bj * HALF + 4 * n) : (f32x4){0.f, 0.f, 0.f, 0.f};
#pragma unroll
        for (int ai = 0; ai < 2; ++ai)
#pragma unroll
            for (int m = 0; m < 4; ++m) { bf16_t* rowp = base + (size_t)(row0 + ai * HALF + m * 16) * ldc + col0;
#pragma unroll
                for (int bj = 0; bj < 2; ++bj) { f32x4 v0 = acc[ai][bj][m][0] + bv[bj][0], v1 = acc[ai][bj][m][1] + bv[bj][1];
                    if (ACT == 1) { f32x2 a = gelu_pk((f32x2){v0[0], v0[1]}), b = gelu_pk((f32x2){v0[2], v0[3]}), c = gelu_pk((f32x2){v1[0], v1[1]}), d = gelu_pk((f32x2){v1[2], v1[3]});
                        v0 = (f32x4){a.x, a.y, b.x, b.y}; v1 = (f32x4){c.x, c.y, d.x, d.y}; }
                    v0 = v0 * sc; v1 = v1 * sc; u32x4 w; w.x = cvt_pk_bf16(v0[0], v0[1]); w.y = cvt_pk_bf16(v0[2], v0[3]); w.z = cvt_pk_bf16(v1[0], v1[1]); w.w = cvt_pk_bf16(v1[2], v1[3]);
                    st16_wt(rowp + bj * HALF, w.x, w.y, w.z, w.w); } }
    }
};

struct PanelStats {
    unsigned* xbuf;
    unsigned* cnt;
    unsigned* tmo;
    int ntn; float eps;
    unsigned code;
    __device__ __forceinline__ bool run(const f32x4 (&v)[2][2][4][2], const Unit& u, int wr, int wc, int fr, int fq, PG8_LAS unsigned char* lds, int wid, int lane) const {
        typedef float f32x2v __attribute__((ext_vector_type(2)));
        PG8_LAS f32x2v* P = (PG8_LAS f32x2v*)lds;
        PG8_LAS f32x2v* S = (PG8_LAS f32x2v*)(lds + 8192);
        PG8_LAS unsigned* flag = (PG8_LAS unsigned*)(lds + 8192 + 2048);
#pragma unroll
        for (int ai = 0; ai < 2; ++ai)
#pragma unroll
            for (int m = 0; m < 4; ++m) {
                float s = 0.f;
#pragma unroll
                for (int bj = 0; bj < 2; ++bj)
#pragma unroll
                    for (int n = 0; n < 2; ++n) { const f32x4 x = v[ai][bj][m][n]; s += (x[0] + x[1]) + (x[2] + x[3]); }
                s += __shfl_xor(s, 16); s += __shfl_xor(s, 32);
                const float mw = s * (1.0f / 64.0f); float q = 0.f;
#pragma unroll
                for (int bj = 0; bj < 2; ++bj)
#pragma unroll
                    for (int n = 0; n < 2; ++n) { const f32x4 d = v[ai][bj][m][n] - mw; q += (d[0] * d[0] + d[1] * d[1]) + (d[2] * d[2] + d[3] * d[3]); }
                q += __shfl_xor(q, 16); q += __shfl_xor(q, 32);
                if (fq == 0) P[(ai * HALF + wr * 64 + m * 16 + fr) * 4 + wc] = (f32x2v){mw, q};
            }
        asm volatile("s_waitcnt lgkmcnt(0)" ::: "memory"); __builtin_amdgcn_s_barrier(); asm volatile("" ::: "memory");
#if defined(BROKEN_EXCHANGE_NO_WAIT)
#warning BROKEN CONTROL BUILD: the row-statistics exchange does not wait; results are wrong by design
        if (blockIdx.x >= 64) { const long long t0_ = clock64(); while (clock64() - t0_ < 60000) __builtin_amdgcn_s_sleep(8); }
#endif
        const int row = wid * 32 + (lane & 31);
        if (lane < 32) {
            const f32x2v a = P[row * 4 + 0], b = P[row * 4 + 1], c = P[row * 4 + 2], d = P[row * 4 + 3];
            const float mt = (a.x + b.x + c.x + d.x) * 0.25f;
            const float da = a.x - mt, db = b.x - mt, dc = c.x - mt, dd = d.x - mt;
            const float m2 = (a.y + b.y) + (c.y + d.y) + 64.0f * ((da * da + db * db) + (dc * dc + dd * dd));
            unsigned long long* slot = (unsigned long long*)xbuf + ((size_t)(u.pm * BM + row) * 4 + u.pn);
            __hip_atomic_store(slot, ((unsigned long long)__float_as_uint(m2) << 32) | __float_as_uint(mt), __ATOMIC_RELAXED, __HIP_MEMORY_SCOPE_AGENT);
        }
        asm volatile("s_waitcnt vmcnt(0)" ::: "memory");
        if (lane == 0) __hip_atomic_fetch_add(cnt + 64 * u.pm, 1u, __ATOMIC_RELAXED, __HIP_MEMORY_SCOPE_AGENT);
        if (wid == 0) {
            bool dead = false; const unsigned long long t0 = __builtin_amdgcn_s_memrealtime(); const unsigned want = 8u * (unsigned)ntn;
            for (;;) {
#if defined(BROKEN_EXCHANGE_NO_WAIT)
                break;
#endif
                if ((unsigned)__builtin_amdgcn_readfirstlane(__hip_atomic_load(cnt + 64 * u.pm, __ATOMIC_RELAXED, __HIP_MEMORY_SCOPE_AGENT)) >= want) break;
                if (__builtin_amdgcn_s_memrealtime() - t0 > 2000000ull) {
                    if (lane == 0) { unsigned expect = 0u; __hip_atomic_compare_exchange_strong(tmo + 1, &expect, code | (unsigned)(u.pm & 0xff), __ATOMIC_RELAXED, __ATOMIC_RELAXED, __HIP_MEMORY_SCOPE_AGENT);
                                     __hip_atomic_store(tmo, 1u, __ATOMIC_RELAXED, __HIP_MEMORY_SCOPE_AGENT); }
                    dead = true; break; }
                __builtin_amdgcn_s_sleep(2);
            }
            __builtin_amdgcn_fence(__ATOMIC_ACQUIRE, "agent");
            if (lane == 0) flag[0] = dead ? 1u : 0u;
        }
        asm volatile("s_waitcnt vmcnt(0) lgkmcnt(0)" ::: "memory"); __builtin_amdgcn_s_barrier(); asm volatile("" ::: "memory");
        const bool bad = flag[0] != 0u;
        if (lane < 32) {
            const unsigned long long* slot = (const unsigned long long*)xbuf + (size_t)(u.pm * BM + row) * 4; float mt[4], m2[4]; float ms = 0.f;
#pragma unroll
            for (int t = 0; t < 4; ++t) { if (t < ntn) { const unsigned long long w = __hip_atomic_load(slot + t, __ATOMIC_RELAXED, __HIP_MEMORY_SCOPE_AGENT); mt[t] = __uint_as_float((unsigned)w); m2[t] = __uint_as_float((unsigned)(w >> 32)); } else { mt[t] = 0.f; m2[t] = 0.f; } ms += mt[t]; }
            const float mean = ms / (float)ntn; float q = 0.f;
#pragma unroll
            for (int t = 0; t < 4; ++t) if (t < ntn) { const float dm = mt[t] - mean; q += m2[t] + 256.0f * dm * dm; }
            S[row] = (f32x2v){mean, 1.0f / sqrtf(q / (256.0f * (float)ntn) + eps)};
        }
        asm volatile("s_waitcnt lgkmcnt(0)" ::: "memory"); __builtin_amdgcn_s_barrier(); asm volatile("" ::: "memory");
        return bad;
    }
};
struct EpiLnRes {
    static constexpr bool PERM = false, AFTER_DRAIN = true;
    const float* base; float* out; int ldc; const float* bias; PanelStats st; unsigned poison;
    __device__ __forceinline__ void fused(f32x4 (&acc)[2][2][4][2], const Unit& u, int wr, int wc, int fr, int fq, PG8_LAS unsigned char* lds, int wid, int lane) const {
        typedef float f32x2v __attribute__((ext_vector_type(2)));
        const PG8_LAS f32x2v* S = (const PG8_LAS f32x2v*)(lds + 8192);
        const int col0 = u.pn * BM + wc * 32 + 4 * fq;
#pragma unroll
        for (int bj = 0; bj < 2; ++bj)
#pragma unroll
            for (int n = 0; n < 2; ++n) { const f32x4 bv = bias ? *(const f32x4*)(bias + col0 + bj * HALF + n * 16) : (f32x4){0.f, 0.f, 0.f, 0.f};
#pragma unroll
                for (int ai = 0; ai < 2; ++ai)
#pragma unroll
                    for (int m = 0; m < 4; ++m) acc[ai][bj][m][n] += bv; }
        f32x4 pre[4][2][2];
#pragma unroll
        for (int m = 0; m < 4; ++m) { const size_t off = (size_t)(u.pm * BM + wr * 64 + m * 16 + fr) * ldc + col0;
#pragma unroll
            for (int bj = 0; bj < 2; ++bj)
#pragma unroll
                for (int n = 0; n < 2; ++n) pre[m][bj][n] = *(const f32x4*)(base + off + bj * HALF + n * 16); }
        const bool bad = st.run(acc, u, wr, wc, fr, fq, lds, wid, lane) || poison != 0u;
        const float qnan = __builtin_nanf("");
#pragma unroll
        for (int ai = 0; ai < 2; ++ai)
#pragma unroll
            for (int m = 0; m < 4; ++m) { const int r = ai * HALF + wr * 64 + m * 16 + fr; const f32x2v sr = S[r]; const size_t off = (size_t)(u.pm * BM + r) * ldc + col0;
#pragma unroll
                for (int bj = 0; bj < 2; ++bj)
#pragma unroll
                    for (int n = 0; n < 2; ++n) { const f32x4 bs = ai == 0 ? pre[m][bj][n] : *(const f32x4*)(base + off + bj * HALF + n * 16); f32x4 o = bs + (acc[ai][bj][m][n] - sr.x) * sr.y;
                        if (bad) o = (f32x4){qnan, qnan, qnan, qnan}; *(f32x4*)(out + off + bj * HALF + n * 16) = o; }
                if (m & 1) asm volatile("" ::: "memory"); }
    }
};
struct EpiLnResLn {
    static constexpr bool PERM = false, AFTER_DRAIN = true;
    const float* base; float* out; bf16_t* xn; int ldc; const float* bias; PanelStats st1, st2; unsigned poison;
    __device__ __forceinline__ void fused(f32x4 (&acc)[2][2][4][2], const Unit& u, int wr, int wc, int fr, int fq, PG8_LAS unsigned char* lds, int wid, int lane) const {
        typedef float f32x2v __attribute__((ext_vector_type(2))); typedef unsigned u32x2v __attribute__((ext_vector_type(2)));
        const PG8_LAS f32x2v* S = (const PG8_LAS f32x2v*)(lds + 8192);
        const int col0 = u.pn * BM + wc * 32 + 4 * fq;
#pragma unroll
        for (int bj = 0; bj < 2; ++bj)
#pragma unroll
            for (int n = 0; n < 2; ++n) { const f32x4 bv = bias ? *(const f32x4*)(bias + col0 + bj * HALF + n * 16) : (f32x4){0.f, 0.f, 0.f, 0.f};
#pragma unroll
                for (int ai = 0; ai < 2; ++ai)
#pragma unroll
                    for (int m = 0; m < 4; ++m) acc[ai][bj][m][n] += bv; }
        bool bad = st1.run(acc, u, wr, wc, fr, fq, lds, wid, lane) || poison != 0u;
        const float qnan = __builtin_nanf("");
#pragma unroll
        for (int ai = 0; ai < 2; ++ai)
#pragma unroll
            for (int m = 0; m < 4; ++m) { const int r = ai * HALF + wr * 64 + m * 16 + fr; const f32x2v sr = S[r]; const size_t off = (size_t)(u.pm * BM + r) * ldc + col0;
#pragma unroll
                for (int bj = 0; bj < 2; ++bj)
#pragma unroll
                    for (int n = 0; n < 2; ++n) { const f32x4 bs = *(const f32x4*)(base + off + bj * HALF + n * 16); acc[ai][bj][m][n] = bs + (acc[ai][bj][m][n] - sr.x) * sr.y; }
                asm volatile("" : "+v"(acc[ai][0][m][0]), "+v"(acc[ai][0][m][1]), "+v"(acc[ai][1][m][0]), "+v"(acc[ai][1][m][1]));
                if (m & 1) asm volatile("" ::: "memory"); }
        const bool bad1 = bad;
        bad = st2.run(acc, u, wr, wc, fr, fq, lds, wid, lane) || bad;
#pragma unroll
        for (int ai = 0; ai < 2; ++ai)
#pragma unroll
            for (int m = 0; m < 4; ++m) { const int r = ai * HALF + wr * 64 + m * 16 + fr; const f32x2v sr = S[r]; const size_t off = (size_t)(u.pm * BM + r) * ldc + col0;
#pragma unroll
                for (int bj = 0; bj < 2; ++bj)
#pragma unroll
                    for (int n = 0; n < 2; ++n) { const f32x4 x1 = acc[ai][bj][m][n]; *(f32x4*)(out + off + bj * HALF + n * 16) = bad1 ? (f32x4){qnan, qnan, qnan, qnan} : x1;
                        const f32x4 o = (x1 - sr.x) * sr.y; u32x2v w; w.x = cvt_pk_bf16(o[0], o[1]); w.y = cvt_pk_bf16(o[2], o[3]);
                        if (bad) { w.x = 0x7fc07fc0u; w.y = 0x7fc07fc0u; } *(u32x2v*)(xn + off + bj * HALF + n * 16) = w; }
                asm volatile("" ::: "memory"); }
    }
};

__device__ __forceinline__ void glds_saddr(unsigned voff, const char* sbase, unsigned lds_dst) { unsigned keep;
    asm volatile("s_mov_b32 %0, m0\n\ts_mov_b32 m0, %3\n\ts_nop 0\n\tglobal_load_lds_dwordx4 %1, %2\n\ts_mov_b32 m0, %0" : "=&s"(keep) : "v"(voff), "s"(sbase), "s"(lds_dst) : "memory"); }
template <class Epi, class Sched, bool ALIGN_EPI = false, bool SP2 = false, int EB = 2, bool GATHER = false>
__device__ __forceinline__ void gemm_phase(PG8_LAS unsigned char* lds, const Gemm g, const Sched& S, const Epi& E, const int* rowtok = nullptr) {
    static_assert(!GATHER || (EB == 1 && SP2), "gathered A rows: fp8 path (SGPR-base staging) with the two-super-phase loop only");
    const int tid = threadIdx.x, wid = __builtin_amdgcn_readfirstlane(tid >> 6), lane = tid & 63, wr = wid >> 2, wc = wid & 3, fr = lane & 15, fq = lane >> 4;
    const int K = g.K, nt = K * EB / (BK * 2);
    unsigned voffA[2], voffB[2]; int gR[2]; unsigned gC[2];
#pragma unroll
    for (int i = 0; i < 2; ++i) { int R, C; stage_rc(tid * 16 + i * 8192, R, C); const int Rb = Epi::PERM ? ((R & ~31) + perm32(R & 31)) : R;
        voffA[i] = (unsigned)(R * K * EB + C * 2); voffB[i] = (unsigned)(Rb * K * EB + C * 2); gR[i] = R; gC[i] = (unsigned)(C * 2); }
    const size_t kstep = (size_t)(BK * 2);
    const size_t hstep = (size_t)HALF * K * EB;
    const size_t tstep = 2 * hstep;
    const unsigned ldsw = (unsigned)wid * 1024u; const unsigned lds0 = (unsigned)(uintptr_t)lds;
    const int aoff = lds_byte(wr * 64 + fr, fq * 8), boff = lds_byte(wc * 32 + fr, fq * 8);
#define PG8_SA(b, h) (((b) * 2 + (h)) * HTB)
#define PG8_SB(b, h) ((4 + (b) * 2 + (h)) * HTB)
#define PG8_STAGE(bufoff, gbase, voff) do { if constexpr (EB == 2) { _Pragma("unroll") for (int _i = 0; _i < 2; ++_i) \
        __builtin_amdgcn_global_load_lds((const unsigned*)((const char*)(gbase) + (voff)[_i]), (PG8_LAS unsigned*)(lds + (bufoff) + ldsw + _i * 8192), 16, 0, 0); } \
        else { _Pragma("unroll") for (int _i = 0; _i < 2; ++_i) glds_saddr((voff)[_i], (const char*)(gbase), (unsigned)__builtin_amdgcn_readfirstlane((int)(lds0 + (unsigned)(bufoff) + ldsw + (unsigned)(_i * 8192)))); } } while (0)
#define PG8_GLOAD(vo, u) do { _Pragma("unroll") for (int _h = 0; _h < 2; ++_h) _Pragma("unroll") for (int _i = 0; _i < 2; ++_i) vo[_h][_i] = (unsigned)rowtok[(size_t)(u).pm * BM + _h * HALF + gR[_i]] * (unsigned)(K * EB) + gC[_i]; } while (0)
#define PG8_STAGE_A(bufoff, pplain, kofs, h, VS) do { if constexpr (!GATHER) { PG8_STAGE(bufoff, pplain, voffA); } else { _Pragma("unroll") for (int _i = 0; _i < 2; ++_i) \
        glds_saddr(VS[h][_i], (const char*)g.A + (kofs), (unsigned)__builtin_amdgcn_readfirstlane((int)(lds0 + (unsigned)(bufoff) + ldsw + (unsigned)(_i * 8192)))); } } while (0)
#define PG8_LD8(p) __builtin_shufflevector(*(const PG8_LAS v4i_t*)(p), *(const PG8_LAS v4i_t*)((p) + 1024), 0, 1, 2, 3, 4, 5, 6, 7)
#define PG8_LDA(dst, b, h) do { if constexpr (EB == 2) { _Pragma("unroll") for (int m = 0; m < 4; ++m) _Pragma("unroll") for (int k = 0; k < 2; ++k) dst[m][k] = *(const PG8_LAS bf16x8*)(lds + PG8_SA(b, h) + aoff + m * 2048 + k * 1024); } \
        else { _Pragma("unroll") for (int m = 0; m < 4; ++m) dst##8[m] = PG8_LD8(lds + PG8_SA(b, h) + aoff + m * 2048); } } while (0)
#define PG8_LDB(dst, b, h) do { if constexpr (EB == 2) { _Pragma("unroll") for (int n = 0; n < 2; ++n) _Pragma("unroll") for (int k = 0; k < 2; ++k) dst[n][k] = *(const PG8_LAS bf16x8*)(lds + PG8_SB(b, h) + boff + n * 2048 + k * 1024); } \
        else { _Pragma("unroll") for (int n = 0; n < 2; ++n) dst##8[n] = PG8_LD8(lds + PG8_SB(b, h) + boff + n * 2048); } } while (0)
#define PG8_CAT8(x, y) __builtin_shufflevector(__builtin_bit_cast(v4i_t, x), __builtin_bit_cast(v4i_t, y), 0, 1, 2, 3, 4, 5, 6, 7)
#define PG8_MMA(ai, bj, At, Bt) do { __builtin_amdgcn_s_setprio(1); if constexpr (EB == 2) { _Pragma("unroll") for (int m = 0; m < 4; ++m) _Pragma("unroll") for (int n = 0; n < 2; ++n) _Pragma("unroll") for (int k = 0; k < 2; ++k) \
        acc[ai][bj][m][n] = __builtin_amdgcn_mfma_f32_16x16x32_bf16(Bt[n][k], At[m][k], acc[ai][bj][m][n], 0, 0, 0); } else { _Pragma("unroll") for (int m = 0; m < 4; ++m) _Pragma("unroll") for (int n = 0; n < 2; ++n) \
        asm volatile("v_mfma_scale_f32_16x16x128_f8f6f4 %0, %1, %2, %0, %3, %3 op_sel_hi:[0,0,0]" : "+v"(acc[ai][bj][m][n]) : "v"(Bt##8[n]), "v"(At##8[m]), "v"(mx_one)); }     __builtin_amdgcn_s_setprio(0); } while (0)
#define PG8_WAIT_V(n) asm volatile("s_waitcnt vmcnt(" #n ")" ::: "memory")
#define PG8_WAIT_L(n) asm volatile("s_waitcnt lgkmcnt(" #n ")" ::: "memory")
#define PG8_BAR __builtin_amdgcn_s_barrier()
#define PG8_SCHED __builtin_amdgcn_sched_barrier(0)
    Unit cur, nxt; int ui = 0;
    if (!S.next(0, cur)) return;
    f32x4 acc[2][2][4][2];
#pragma unroll
    for (int a = 0; a < 2; ++a)
#pragma unroll
        for (int b = 0; b < 2; ++b)
#pragma unroll
            for (int m = 0; m < 4; ++m)
#pragma unroll
                for (int n = 0; n < 2; ++n) acc[a][b][m][n] = (f32x4){0.f, 0.f, 0.f, 0.f};
    const int mx_one = 0x7f7f7f7f;
    bf16x8 At[4][2], B0[2][2], B1[2][2]; v8i_t At8[4], B08[2], B18[2];
    const char* cA = (const char*)g.A + (size_t)cur.pm * tstep; const char* cB = (const char*)g.Bt + (size_t)cur.pn * tstep;
    S.a_ready(cur);
    unsigned voffC[2][2], voffN[2][2];
    if constexpr (GATHER) PG8_GLOAD(voffC, cur);
    if constexpr (SP2) {
        PG8_STAGE(PG8_SB(0, 0), cB, voffB); PG8_STAGE(PG8_SB(0, 1), cB + hstep, voffB); PG8_STAGE_A(PG8_SA(0, 0), cA, 0, 0, voffC); PG8_STAGE_A(PG8_SA(0, 1), cA + hstep, 0, 1, voffC);
        if (wr == 1) PG8_BAR;
        PG8_WAIT_V(2); PG8_BAR;
        PG8_STAGE(PG8_SB(1, 0), cB + kstep, voffB); PG8_STAGE_A(PG8_SA(1, 0), cA + kstep, kstep, 0, voffC); PG8_STAGE(PG8_SB(1, 1), cB + hstep + kstep, voffB);
        PG8_WAIT_V(6); PG8_BAR;
    } else {
        PG8_STAGE(PG8_SB(0, 0), cB, voffB); PG8_STAGE(PG8_SA(0, 0), cA, voffA); PG8_STAGE(PG8_SB(0, 1), cB + hstep, voffB); PG8_STAGE(PG8_SA(0, 1), cA + hstep, voffA);
        if (wr == 1) PG8_BAR;
        PG8_WAIT_V(4); PG8_BAR;
        PG8_STAGE(PG8_SB(1, 0), cB + kstep, voffB); PG8_STAGE(PG8_SA(1, 0), cA + kstep, voffA); PG8_STAGE(PG8_SB(1, 1), cB + hstep + kstep, voffB);
        PG8_WAIT_V(6); PG8_BAR;
    }
    for (;;) {
        const bool has_next = S.next(ui + 1, nxt);
        if constexpr (GATHER) { if (has_next) PG8_GLOAD(voffN, nxt); else { _Pragma("unroll") for (int _h = 0; _h < 2; ++_h) _Pragma("unroll") for (int _i = 0; _i < 2; ++_i) voffN[_h][_i] = voffC[_h][_i]; } }
        const char* nA = has_next ? (const char*)g.A + (size_t)nxt.pm * tstep : cA; const char* nB = has_next ? (const char*)g.Bt + (size_t)nxt.pn * tstep : cB;
#pragma nounroll
        for (int t = 0; t < nt; t += 2) {
            const bool last = (t == nt - 2);
            const char* a1 = cA + (size_t)(t + 1) * kstep;
            const char* a2 = last ? nA : cA + (size_t)(t + 2) * kstep; const char* b2 = last ? nB : cB + (size_t)(t + 2) * kstep;
            const char* a3 = a2 + kstep; const char* b3 = b2 + kstep;
            const size_t k2 = last ? (size_t)0 : (size_t)(t + 2) * kstep; unsigned voffS[2][2];
            if constexpr (GATHER) { _Pragma("unroll") for (int _h = 0; _h < 2; ++_h) _Pragma("unroll") for (int _i = 0; _i < 2; ++_i) voffS[_h][_i] = last ? voffN[_h][_i] : voffC[_h][_i]; }
            if (last && has_next) S.a_ready(nxt);
            if constexpr (SP2) {
            PG8_LDB(B0, 0, 0); PG8_LDB(B1, 0, 1); PG8_SCHED; PG8_LDA(At, 0, 0); PG8_STAGE_A(PG8_SA(1, 1), a1 + hstep, (size_t)(t + 1) * kstep, 1, voffC);
            PG8_WAIT_V(8); PG8_WAIT_L(0); PG8_BAR; PG8_MMA(0, 0, At, B0); PG8_MMA(0, 1, At, B1); PG8_BAR; PG8_SCHED;
            PG8_LDA(At, 0, 1); PG8_STAGE(PG8_SB(0, 0), b2, voffB); PG8_STAGE(PG8_SB(0, 1), b2 + hstep, voffB); PG8_STAGE_A(PG8_SA(0, 0), a2, k2, 0, voffS);
            PG8_WAIT_V(8); PG8_WAIT_L(0); PG8_BAR; PG8_MMA(1, 0, At, B0); PG8_MMA(1, 1, At, B1); PG8_BAR; PG8_SCHED;
            PG8_LDB(B0, 1, 0); PG8_LDB(B1, 1, 1); PG8_SCHED; PG8_LDA(At, 1, 0); PG8_STAGE_A(PG8_SA(0, 1), a2 + hstep, k2, 1, voffS);
            PG8_WAIT_V(8); PG8_WAIT_L(0); PG8_BAR; PG8_MMA(0, 0, At, B0); PG8_MMA(0, 1, At, B1); PG8_BAR; PG8_SCHED;
            PG8_LDA(At, 1, 1); PG8_STAGE(PG8_SB(1, 0), b3, voffB); PG8_STAGE(PG8_SB(1, 1), b3 + hstep, voffB); PG8_STAGE_A(PG8_SA(1, 0), a3, k2 + kstep, 0, voffS);
            PG8_WAIT_V(8); PG8_WAIT_L(0); PG8_BAR; PG8_MMA(1, 0, At, B0); PG8_MMA(1, 1, At, B1); PG8_BAR; PG8_SCHED;
            } else {
            PG8_LDB(B0, 0, 0); PG8_SCHED; PG8_LDA(At, 0, 0); PG8_STAGE(PG8_SA(1, 1), a1 + hstep, voffA);
            PG8_WAIT_L(8); PG8_BAR; PG8_WAIT_L(0); PG8_MMA(0, 0, At, B0); PG8_BAR; PG8_SCHED;
            PG8_LDB(B1, 0, 1); PG8_STAGE(PG8_SB(0, 0), b2, voffB);
            PG8_BAR; PG8_WAIT_L(0); PG8_MMA(0, 1, At, B1); PG8_BAR;
            PG8_LDA(At, 0, 1); PG8_STAGE(PG8_SA(0, 0), a2, voffA);
            PG8_BAR; PG8_WAIT_L(0); PG8_MMA(1, 0, At, B0); PG8_BAR; PG8_SCHED;
            PG8_STAGE(PG8_SB(0, 1), b2 + hstep, voffB);
            PG8_WAIT_V(6); PG8_BAR; PG8_MMA(1, 1, At, B1); PG8_BAR;
            PG8_LDB(B0, 1, 0); PG8_SCHED; PG8_LDA(At, 1, 0); PG8_STAGE(PG8_SA(0, 1), a2 + hstep, voffA);
            PG8_WAIT_L(8); PG8_BAR; PG8_WAIT_L(0); PG8_MMA(0, 0, At, B0); PG8_BAR; PG8_SCHED;
            PG8_LDB(B1, 1, 1); PG8_STAGE(PG8_SB(1, 0), b3, voffB);
            PG8_BAR; PG8_WAIT_L(0); PG8_MMA(0, 1, At, B1); PG8_BAR;
            PG8_LDA(At, 1, 1); PG8_STAGE(PG8_SA(1, 0), a3, voffA);
            PG8_BAR; PG8_WAIT_L(0); PG8_MMA(1, 0, At, B0); PG8_BAR; PG8_SCHED;
            PG8_STAGE(PG8_SB(1, 1), b3 + hstep, voffB);
            PG8_WAIT_V(6); PG8_BAR; PG8_MMA(1, 1, At, B1); PG8_BAR;
            }
        }
        if constexpr (ALIGN_EPI) { if (wr == 0) PG8_BAR; }
        if constexpr (EB == 1) asm volatile("s_nop 15\n\ts_nop 15" ::: "memory");
        if constexpr (!Epi::AFTER_DRAIN) { E(acc, cur, wr, wc, fr, fq); S.done(cur); }
        if (!has_next) break;
#pragma unroll
        for (int a = 0; a < 2; ++a)
#pragma unroll
            for (int b = 0; b < 2; ++b)
#pragma unroll
                for (int m = 0; m < 4; ++m)
#pragma unroll
                    for (int n = 0; n < 2; ++n) acc[a][b][m][n] = (f32x4){0.f, 0.f, 0.f, 0.f};
        cur = nxt; cA = nA; cB = nB; ++ui;
        if constexpr (GATHER) { _Pragma("unroll") for (int _h = 0; _h < 2; ++_h) _Pragma("unroll") for (int _i = 0; _i < 2; ++_i) voffC[_h][_i] = voffN[_h][_i]; }
        if constexpr (ALIGN_EPI) { if (wr == 1) PG8_BAR; }
    }
    PG8_WAIT_V(0);
    if constexpr (!ALIGN_EPI) { if (wr == 0) PG8_BAR; }
    PG8_BAR;
    if constexpr (Epi::AFTER_DRAIN) { E.fused(acc, cur, wr, wc, fr, fq, lds, wid, lane); S.done(cur); }
#undef PG8_SA
#undef PG8_SB
#undef PG8_STAGE
#undef PG8_LDA
#undef PG8_GLOAD
#undef PG8_STAGE_A
#undef PG8_LD8
#undef PG8_LDB
#undef PG8_MMA
#undef PG8_CAT8
#undef PG8_WAIT_V
#undef PG8_WAIT_L
#undef PG8_BAR
#undef PG8_SCHED
}
}
#ifndef PG8_SP2
#define PG8_SP2 true
#endif
#ifndef MOE_SP2
#define MOE_SP2 true
#endif
#ifndef PG8_ALIGN
#define PG8_ALIGN true
#endif
constexpr int NWAVES = 8;
constexpr int NB = 4, SEQ = 4096, T = NB * SEQ, D = 1024, NIN = 2856, NINP = 3072, NE = 32, DEPTH = 2;
constexpr int C_H = 0, C_GB = 256, C_GC = 512, C_P = 768, C_Q = 1024, C_K = 1536, C_V = 2048, C_QI = 2560, C_KI = 2816, C_WI = 2848;
constexpr int NSEL = 256;
#ifndef SEL_CAND_CAP
#define SEL_CAND_CAP 64
#endif
constexpr int MAXROWS = 4 * T + NE * 256;
constexpr float ATT_C2 = 0.125f * 1.4426950408889634f;
constexpr float LN_EPS = 1e-5f, DN_ALPHA = 1.41421356237309515f;
enum { IN_X = 0, IN_WIN, IN_CONVW, IN_WPOOL, IN_PSCALE, IN_KNG, IN_KNB, IN_WOUT, IN_LN1G, IN_LN1B, IN_RW, IN_RB, IN_WGU, IN_BGU, IN_WDN, IN_BDN, IN_LN2G, IN_LN2B, N_IN };

constexpr size_t MiB = 1u << 20;
constexpr size_t WS_CTL = 0, CTL_ZERO_BYTES = 1 * MiB;
constexpr size_t WS_WIN = 2 * MiB;
constexpr size_t WS_WOUT = 14 * MiB;
constexpr size_t WS_WGU = 18 * MiB;
constexpr size_t WS_WDN = 274 * MiB;
constexpr size_t WS_XB = 402 * MiB;
constexpr size_t WS_XF = 434 * MiB;
constexpr size_t WS_Y1 = 498 * MiB;
constexpr size_t WS_PROJ = 562 * MiB;
constexpr size_t WS_CAT = 658 * MiB;
constexpr size_t WS_KIN = 690 * MiB;
constexpr size_t WS_MASK = 691 * MiB;
constexpr size_t WS_ROUTE = 699 * MiB;
constexpr size_t WS_CNTW = 699 * MiB + 256 * 1024;
constexpr size_t WS_SC = 700 * MiB;
constexpr size_t WS_XS = 956 * MiB;
constexpr size_t WS_ACT = 1100 * MiB;
constexpr size_t WS_YS = 1244 * MiB;
constexpr size_t WS_XB8 = 1388 * MiB;
constexpr size_t WS_END = 1404 * MiB;
constexpr int CW_TMO = 0;
constexpr int CW_CNT = 1024;
constexpr int CW_BAR = 4096;
constexpr int RING_BYTES = 131072;
constexpr int TAB_OFF = RING_BYTES;
constexpr int MISC_OFF = RING_BYTES + 1024;
constexpr int LDS_BYTES = 147456;

#define GAS __attribute__((address_space(1)))
#define LAS __attribute__((address_space(3)))
typedef unsigned short bf16;
typedef unsigned v4u __attribute__((ext_vector_type(4)));
typedef unsigned v2u __attribute__((ext_vector_type(2)));
typedef float f32x4 __attribute__((ext_vector_type(4)));
typedef short bf16x8 __attribute__((ext_vector_type(8)));
typedef GAS unsigned gu32;
typedef unsigned long long u64;
#define RLX_AGENT __ATOMIC_RELAXED, __HIP_MEMORY_SCOPE_AGENT
#define LDS_WAIT() asm volatile("s_waitcnt lgkmcnt(0)" ::: "memory")
#define VM_WAIT() asm volatile("s_waitcnt vmcnt(0)" ::: "memory")
__device__ __forceinline__ unsigned f2bf(float f) { unsigned u = __builtin_bit_cast(unsigned, f); return (u + 0x7fffu + ((u >> 16) & 1u)) >> 16; }
__device__ __forceinline__ unsigned pk2(float lo, float hi) { return f2bf(lo) | (f2bf(hi) << 16); }
__device__ __forceinline__ unsigned pk4_fp8(float a, float b, float c, float d) { int w = 0; w = __builtin_amdgcn_cvt_pk_fp8_f32(a, b, w, false); w = __builtin_amdgcn_cvt_pk_fp8_f32(c, d, w, true); return (unsigned)w; }
constexpr float WGU_SCALE = 32.f, WDN_SCALE = 64.f;
__device__ __forceinline__ float bf2f(bf16 v) { return __builtin_bit_cast(float, (unsigned)v << 16); }
__device__ __forceinline__ float bflo(unsigned w) { return __builtin_bit_cast(float, w << 16); }
__device__ __forceinline__ float bfhi(unsigned w) { return __builtin_bit_cast(float, w & 0xffff0000u); }
template <int CTRL> __device__ __forceinline__ float dppx(float v) { return __builtin_bit_cast(float, __builtin_amdgcn_update_dpp(0, __builtin_bit_cast(int, v), CTRL, 0xf, 0xf, false)); }
__device__ __forceinline__ float wave_sum(float v) {
    v += dppx<0xB1>(v); v += dppx<0x4E>(v); v += dppx<0x141>(v); v += dppx<0x140>(v);
    const float a = __builtin_bit_cast(float, __builtin_amdgcn_readlane(__builtin_bit_cast(int, v), 0)), b = __builtin_bit_cast(float, __builtin_amdgcn_readlane(__builtin_bit_cast(int, v), 16));
    const float c = __builtin_bit_cast(float, __builtin_amdgcn_readlane(__builtin_bit_cast(int, v), 32)), d = __builtin_bit_cast(float, __builtin_amdgcn_readlane(__builtin_bit_cast(int, v), 48));
    return (a + b) + (c + d);
}
__device__ __forceinline__ float wave_max(float v) {
#pragma unroll
    for (int o = 1; o < 64; o <<= 1) v = fmaxf(v, __shfl_xor(v, o));
    return v;
}
__device__ __forceinline__ float wave_max_dpp(float v) {
    v = fmaxf(v, dppx<0xB1>(v)); v = fmaxf(v, dppx<0x4E>(v)); v = fmaxf(v, dppx<0x141>(v)); v = fmaxf(v, dppx<0x140>(v));
    const float a = __builtin_bit_cast(float, __builtin_amdgcn_readlane(__builtin_bit_cast(int, v), 0)), b = __builtin_bit_cast(float, __builtin_amdgcn_readlane(__builtin_bit_cast(int, v), 16));
    const float c = __builtin_bit_cast(float, __builtin_amdgcn_readlane(__builtin_bit_cast(int, v), 32)), d = __builtin_bit_cast(float, __builtin_amdgcn_readlane(__builtin_bit_cast(int, v), 48));
    return fmaxf(fmaxf(a, b), fmaxf(c, d));
}
__device__ __forceinline__ float sum32(float v) {
#pragma unroll
    for (int o = 1; o < 32; o <<= 1) v += __shfl_xor(v, o);
    return v;
}
#define XB_TMO      128
#define XB_XCNT(j)  (256  + 64 * (j))
#define XB_XSUB(j)  (1280 + 64 * (j))
#define XB_XGEN(j)  (2304 + 64 * (j))
#define XB_TOP      3328
#define XB_TOPGEN   3392
#define XCD_BAR_WORDS 3456
#define XB_SPIN_CAP (1u << 18)

__device__ __forceinline__ unsigned xb_ld(unsigned* p)              { return __hip_atomic_load(p, __ATOMIC_RELAXED, __HIP_MEMORY_SCOPE_AGENT); }
__device__ __forceinline__ unsigned xb_add(unsigned* p, unsigned v) { return __hip_atomic_fetch_add(p, v, __ATOMIC_RELAXED, __HIP_MEMORY_SCOPE_AGENT); }
__device__ __forceinline__ unsigned xb_xcc_id() { return (unsigned)__builtin_amdgcn_s_getreg((3 << 11) | 20) & 0xFu; }
#define XB_SPIN(cond, bar) do { unsigned _sp = 0; while (cond) { __builtin_amdgcn_s_sleep(1); \
    if ((++_sp & 255u) == 0u) { if (xb_ld(&(bar)[XB_TMO])) break; if (_sp > XB_SPIN_CAP) { atomicAdd(&(bar)[XB_TMO], 1u); break; } } } } while (0)

struct XcdBarrier {
    unsigned* bar; unsigned x;
    volatile LAS unsigned* st;
};

__device__ __forceinline__ XcdBarrier xcd_barrier_post(unsigned* bar, volatile LAS unsigned* st) {
    XcdBarrier b; b.bar = bar; b.x = xb_xcc_id(); b.st = st;
    if (threadIdx.x == 0) (void)xb_add(&bar[XB_XCNT(b.x)], 1u);
    return b;
}
__device__ __forceinline__ void xcd_barrier_complete(unsigned* bar, unsigned x, unsigned& nloc, unsigned& nx) {
    const unsigned G = gridDim.x * gridDim.y * gridDim.z;
    unsigned sum, cnt, mine, sp = 0u;
    for (;;) {
        sum = 0u; cnt = 0u; mine = 0u;
#pragma unroll
        for (unsigned j = 0; j < 16; ++j) { const unsigned c = xb_ld(&bar[XB_XCNT(j)]); sum += c; cnt += (c > 0u) ? 1u : 0u; mine = (j == x) ? c : mine; }
        if (sum == G) break;
        __builtin_amdgcn_s_sleep(1);
        if ((++sp & 255u) == 0u) { if (xb_ld(&bar[XB_TMO])) break; if (sp > XB_SPIN_CAP) { atomicAdd(&bar[XB_TMO], 1u); break; } }
    }
    nloc = mine > 0u ? mine : 1u; nx = cnt > 0u ? cnt : 1u;
}

__device__ __forceinline__ void xcd_barrier(const XcdBarrier& b) {
    asm volatile("s_waitcnt vmcnt(0)" ::: "memory");
    __syncthreads();
    if (threadIdx.x == 0) {
        unsigned* bar = b.bar;
        __builtin_amdgcn_s_waitcnt(0);
        unsigned nloc = b.st[0], nx = b.st[1];
        if (nloc == 0u) { xcd_barrier_complete(bar, b.x, nloc, nx); b.st[0] = nloc; b.st[1] = nx; }
        const unsigned old = xb_add(&bar[XB_XSUB(b.x)], 1u);
        const unsigned gen = old / nloc;
        if (old + 1u == (gen + 1u) * nloc) {
            __builtin_amdgcn_fence(__ATOMIC_RELEASE, "agent");
            asm volatile("s_waitcnt vmcnt(0)" ::: "memory");
#ifdef BAR_EARLY_INV
            __builtin_amdgcn_fence(__ATOMIC_ACQUIRE, "agent");
            (void)xb_add(&bar[XB_TOP], 1u);
            { const unsigned target = (gen + 1u) * nx; XB_SPIN(xb_ld(&bar[XB_TOP]) < target, bar); }
            xb_add(&bar[XB_XGEN(b.x)], 1u);
            asm volatile("s_waitcnt vmcnt(0)" ::: "memory");
#else
            const unsigned og = xb_add(&bar[XB_TOP], 1u);
            const unsigned tg = og / nx;
            if (og + 1u == (tg + 1u) * nx) xb_add(&bar[XB_TOPGEN], 1u);
            else XB_SPIN(xb_ld(&bar[XB_TOPGEN]) == tg, bar);
            __builtin_amdgcn_fence(__ATOMIC_ACQUIRE, "agent");
            xb_add(&bar[XB_XGEN(b.x)], 1u);
            asm volatile("s_waitcnt vmcnt(0)" ::: "memory");
#endif
        } else {
#ifdef BAR_EARLY_INV
            __builtin_amdgcn_fence(__ATOMIC_ACQUIRE, "agent"); asm volatile("s_waitcnt vmcnt(0)" ::: "memory");
            XB_SPIN(xb_ld(&bar[XB_XGEN(b.x)]) == gen, bar);
            asm volatile("" ::: "memory");
#else
            XB_SPIN(xb_ld(&bar[XB_XGEN(b.x)]) == gen, bar);
            __builtin_amdgcn_fence(__ATOMIC_ACQUIRE, "agent");
            asm volatile("s_waitcnt vmcnt(0)" ::: "memory");
#endif
        }
    }
    __syncthreads();
}
struct Args { const float* in[N_IN]; float* out; unsigned char* ws; int ph_lo, ph_hi; };
struct Frame {
    LAS unsigned char* lds;
    gu32* ctl;
    unsigned char* ws;
    int tid, lane, wave, vcu, G;
};
#define WSP(type, off) ((type*)(GAS type*)(F.ws + (off)))
__device__ __forceinline__ const float* uni(const float* p) { const u64 v = (u64)p; return (const float*)(const GAS float*)(((u64)(unsigned)__builtin_amdgcn_readfirstlane((int)(v >> 32)) << 32) | (u64)(unsigned)__builtin_amdgcn_readfirstlane((int)v)); }
__device__ __forceinline__ Frame make_frame(unsigned char* ws_, LAS unsigned char* lds_) {
    Frame F; const u64 v = (u64)ws_;
    F.ws = (unsigned char*)(((u64)(unsigned)__builtin_amdgcn_readfirstlane((int)(v >> 32)) << 32) | (u64)(unsigned)__builtin_amdgcn_readfirstlane((int)v));
    F.lds = (LAS unsigned char*)(unsigned)__builtin_amdgcn_readfirstlane((int)(unsigned)(uintptr_t)lds_);
    F.ctl = (gu32*)(F.ws + WS_CTL);
    { int t_ = threadIdx.x; asm volatile("" : "+v"(t_)); F.tid = t_; }
    F.lane = F.tid & 63; F.wave = __builtin_amdgcn_readfirstlane(F.tid >> 6);
    F.G = gridDim.x; { const int bx = blockIdx.x; F.vcu = (F.G % 8 == 0) ? (bx % 8) * (F.G / 8) + bx / 8 : bx; }
    return F;
}
struct In6 { const float* p[6]; };

__device__ __forceinline__ void tr_block(Frame& F, const float* W_, int N, bf16* WT, int k0, int n0, int mode  , size_t drow_base, float scale) {
    LAS unsigned* img = (LAS unsigned*)F.lds; const int lane = F.lane, wave = F.wave, tid = F.tid; const GAS float* W = (const GAS float*)W_;
    f32x4 va[4][2], vb[4][2];
#pragma unroll
    for (int i = 0; i < 4; ++i) { const int kp = wave * 4 + i; const GAS float* r0 = W + (size_t)(k0 + 2 * kp) * N + n0; const GAS float* r1 = r0 + N;
#pragma unroll
        for (int q = 0; q < 2; ++q) { const int c4 = lane + 64 * q; va[i][q] = (f32x4){0.f, 0.f, 0.f, 0.f}; vb[i][q] = va[i][q];
            if (n0 + 4 * c4 < N) { va[i][q] = __builtin_nontemporal_load((const GAS f32x4*)(r0 + 4 * c4)); vb[i][q] = __builtin_nontemporal_load((const GAS f32x4*)(r1 + 4 * c4)); } } }
#pragma unroll
    for (int i = 0; i < 4; ++i) { const int kp = wave * 4 + i;
#pragma unroll
        for (int q = 0; q < 2; ++q) { const int c4 = lane + 64 * q; const f32x4 a = va[i][q], b = vb[i][q];
            v4u o; o.x = pk2(a.x * scale, b.x * scale); o.y = pk2(a.y * scale, b.y * scale); o.z = pk2(a.z * scale, b.z * scale); o.w = pk2(a.w * scale, b.w * scale);
            *(LAS v4u*)(img + kp * 516 + 4 * c4) = o; } }
    __syncthreads();
    const int c = tid & 7;
#pragma unroll
    for (int i = 0; i < 8; ++i) { const int n = (tid >> 3) + 64 * i; const LAS unsigned* p = img + (4 * c) * 516 + n;
        v4u o; o.x = p[0]; o.y = p[516]; o.z = p[2 * 516]; o.w = p[3 * 516];
        const int ng = n0 + n; size_t dr;
        if (mode == 1) dr = ng < 1024 ? (size_t)((ng >> 7) * 256 + (ng & 127)) : (size_t)((((ng - 1024) >> 7) * 256) + 128 + ((ng - 1024) & 127)); else dr = (size_t)ng;
        *(GAS v4u*)((GAS bf16*)WT + (drow_base + dr) * D + k0 + 8 * c) = o; }
    __syncthreads();
}
__device__ __forceinline__ void tr_block8(Frame& F, const float* W_, int N, unsigned char* WT, int k0, int n0, int mode, size_t drow_base, float scale) {
    LAS unsigned* img = (LAS unsigned*)F.lds; const int lane = F.lane, wave = F.wave, tid = F.tid; const GAS float* W = (const GAS float*)W_;
    f32x4 vv[4][2][4];
#pragma unroll
    for (int i = 0; i < 4; ++i) { const int kq = wave * 4 + i; const GAS float* r0 = W + (size_t)(k0 + 4 * kq) * N + n0;
#pragma unroll
        for (int q = 0; q < 2; ++q) { const int c4 = lane + 64 * q;
#pragma unroll
            for (int j = 0; j < 4; ++j) vv[i][q][j] = __builtin_nontemporal_load((const GAS f32x4*)(r0 + (size_t)j * N + 4 * c4)); } }
#pragma unroll
    for (int i = 0; i < 4; ++i) { const int kq = wave * 4 + i;
#pragma unroll
        for (int q = 0; q < 2; ++q) { const int c4 = lane + 64 * q; const f32x4 a = vv[i][q][0] * scale, b = vv[i][q][1] * scale, c = vv[i][q][2] * scale, d = vv[i][q][3] * scale;
            v4u o; o.x = pk4_fp8(a.x, b.x, c.x, d.x); o.y = pk4_fp8(a.y, b.y, c.y, d.y); o.z = pk4_fp8(a.z, b.z, c.z, d.z); o.w = pk4_fp8(a.w, b.w, c.w, d.w);
            *(LAS v4u*)(img + kq * 516 + 4 * c4) = o; } }
    __syncthreads();
    const int c = tid & 7;
#pragma unroll
    for (int i = 0; i < 8; ++i) { const int n = (tid >> 3) + 64 * i; const LAS unsigned* p = img + (4 * c) * 516 + n;
        v4u o; o.x = p[0]; o.y = p[516]; o.z = p[2 * 516]; o.w = p[3 * 516];
        const int ng = n0 + n; size_t dr;
        if (mode == 1) dr = ng < 1024 ? (size_t)((ng >> 7) * 256 + (ng & 127)) : (size_t)((((ng - 1024) >> 7) * 256) + 128 + ((ng - 1024) & 127)); else dr = (size_t)ng;
        __builtin_nontemporal_store(o, (GAS v4u*)((GAS unsigned char*)WT + (drow_base + dr) * D + k0 + 16 * c)); }
    __syncthreads();
}
__device__ __forceinline__ void p_prologue(Frame& F, const In6& A) {
    constexpr int I_IN = 16 * 6, I_OUT = 16 * 2, I_GU = NE * 8 * 4, I_DN = NE * 8 * 2, I_L = I_IN + I_OUT + I_GU + I_DN;
    for (int it = F.vcu; it < DEPTH * I_L; it += F.G) {
        const int l = it / I_L; int r = it % I_L;
        if (r < I_IN) { const int kb = r / 6, nb = r % 6; tr_block(F, A.p[0] + (size_t)l * D * NIN, NIN, WSP(bf16, WS_WIN) + (size_t)l * NINP * D, kb * 64, nb * 512, 0, 0, nb == 2 ? ATT_C2 : 1.f); continue; }
        r -= I_IN;
        if (r < I_OUT) { const int kb = r / 2, nb = r % 2; tr_block(F, A.p[1] + (size_t)l * D * D, D, WSP(bf16, WS_WOUT) + (size_t)l * D * D, kb * 64, nb * 512, 0, 0, 1.f); continue; }
        r -= I_OUT;
        if (r < I_GU) { const int e = r / 32, rr = r % 32, kb = rr / 4, nb = rr % 4; tr_block8(F, A.p[2] + (size_t)(l * NE + e) * D * 2048, 2048, WSP(unsigned char, WS_WGU) + (size_t)l * NE * 2048 * D * 2, kb * 128, nb * 512, 1, (size_t)e * 2048, WGU_SCALE); continue; }
        r -= I_GU;
        { const int e = r / 16, rr = r % 16, kb = rr / 2, nb = rr % 2; tr_block8(F, A.p[3] + (size_t)(l * NE + e) * D * D, D, WSP(unsigned char, WS_WDN) + (size_t)l * NE * D * D * 2, kb * 128, nb * 512, 0, (size_t)e * 1024, WDN_SCALE); }
    }
    const int gw = F.vcu * NWAVES + F.wave, NGW = F.G * NWAVES, lane = F.lane;
    const GAS float* x = (const GAS float*)A.p[4]; GAS bf16* xb = (GAS bf16*)WSP(bf16, WS_XB);
    for (int m = gw; m < T; m += 2 * NGW) {
        const GAS f32x4* xr = (const GAS f32x4*)(x + (size_t)m * D) + lane; GAS u64* o8 = (GAS u64*)(xb + (size_t)m * D) + lane;
        const GAS f32x4* xr2 = xr + (size_t)NGW * (D / 4); GAS u64* o82 = o8 + (size_t)NGW * (D / 4);
        f32x4 v[4], w[4];
#pragma unroll
        for (int j = 0; j < 4; ++j) { v[j] = __builtin_nontemporal_load(xr + 64 * j); w[j] = __builtin_nontemporal_load(xr2 + 64 * j); }
#pragma unroll
        for (int j = 0; j < 4; ++j) { o8[64 * j] = (u64)pk2(v[j].x, v[j].y) | ((u64)pk2(v[j].z, v[j].w) << 32); o82[64 * j] = (u64)pk2(w[j].x, w[j].y) | ((u64)pk2(w[j].z, w[j].w) << 32); }
    }
}

__device__ __forceinline__ void bf8_to_f(const v4u q, float (&f)[8]) { f[0] = bflo(q.x); f[1] = bfhi(q.x); f[2] = bflo(q.y); f[3] = bfhi(q.y); f[4] = bflo(q.z); f[5] = bfhi(q.z); f[6] = bflo(q.w); f[7] = bfhi(q.w); }
__device__ __forceinline__ void p_local(Frame& F, const In6& A, int l) {
    typedef float f32x16 __attribute__((ext_vector_type(16)));
    constexpr int MROW = 528, WROW = 144;
    LAS unsigned char* mixb = F.lds;
    LAS unsigned char* wpt = F.lds + 64 * MROW;
    const GAS float* wpool = (const GAS float*)(A.p[0] + (size_t)l * 4 * 64 * 64);
    const GAS float* convw = (const GAS float*)(A.p[1] + l * 768); const GAS float* pscale = (const GAS float*)(A.p[2] + l * 256);
    const GAS float* kng = (const GAS float*)(A.p[3] + l * 32); const GAS float* knb = (const GAS float*)(A.p[4] + l * 32);
    const GAS bf16* PROJ = (const GAS bf16*)(F.ws + WS_PROJ); GAS bf16* CAT = (GAS bf16*)(F.ws + WS_CAT); GAS bf16* KIN = (GAS bf16*)(F.ws + WS_KIN);
    const int tid = F.tid, lane = F.lane, wave = F.wave;
    for (int u = F.vcu; u < T / 64; u += F.G) {
        const int t0 = u * 64, s0 = t0 & (SEQ - 1), rowb = t0 - s0;
        __syncthreads();
        f32x4 wr0[4], wr1[4];
#pragma unroll
        for (int i = 0; i < 4; ++i) { const int item = tid + 512 * i, g = item >> 9, cp = (item >> 4) & 31, dq = item & 15;
            wr0[i] = *(const GAS f32x4*)(wpool + g * 4096 + (2 * cp) * 64 + 4 * dq); wr1[i] = *(const GAS f32x4*)(wpool + g * 4096 + (2 * cp + 1) * 64 + 4 * dq); }
        const int cga = tid & 31, tga = tid >> 5, ca0 = cga * 8, sfa = s0 + tga * 4;
        v4u ah[6], ag[6], ab[4];
#pragma unroll
        for (int i = -2; i < 4; ++i) { const int sq = sfa + i; ah[i + 2] = (v4u){0u, 0u, 0u, 0u}; ag[i + 2] = ah[i + 2];
            if (sq >= 0) { const GAS bf16* pr = PROJ + (size_t)(rowb + sq) * NINP; ah[i + 2] = *(const GAS v4u*)(pr + C_H + ca0); ag[i + 2] = *(const GAS v4u*)(pr + C_GC + ca0);
                if (i >= 0) ab[i] = *(const GAS v4u*)(pr + C_GB + ca0); } }
        const int cgb = tid & 63, tgb = tid >> 6, cb0 = cgb * 4, wwin = 2 << (cgb >> 4), sfb = s0 + tgb * 8;
        v2u bq[23];
#pragma unroll
        for (int i = 0; i < 23; ++i) { const int sq = sfb - 15 + i; bq[i] = (v2u){0u, 0u}; if (sq >= 0) bq[i] = *(const GAS v2u*)(PROJ + (size_t)(rowb + sq) * NINP + C_P + cb0); }
        bf16 ck[4];
#pragma unroll
        for (int i = 0; i < 4; ++i) { const int idx = tid + 512 * i; ck[i] = PROJ[(size_t)(t0 + (idx >> 5)) * NINP + C_KI + (idx & 31)]; }
        const float kg = kng[tid & 31], kb = knb[tid & 31];
        float w0[8], w1[8], w2[8];
#pragma unroll
        for (int i = 0; i < 8; ++i) { w0[i] = convw[ca0 + i]; w1[i] = convw[256 + ca0 + i]; w2[i] = convw[512 + ca0 + i]; }
#pragma unroll
        for (int i = 0; i < 4; ++i) { const int item = tid + 512 * i, g = item >> 9, cp = (item >> 4) & 31, dq = item & 15;
#pragma unroll
            for (int k = 0; k < 4; ++k) *(LAS unsigned*)(wpt + (g * 64 + 4 * dq + k) * WROW + cp * 4) = pk2(wr0[i][k], wr1[i][k]); }
        {
            float up2[8], up1[8];
#pragma unroll
            for (int i = 0; i < 8; ++i) { up2[i] = 0.f; up1[i] = 0.f; }
#pragma unroll
            for (int i = -2; i < 4; ++i) { const int sq = sfa + i; float h8[8], g8[8], uu[8];
                bf8_to_f(ah[i + 2], h8); bf8_to_f(ag[i + 2], g8);
#pragma unroll
                for (int k = 0; k < 8; ++k) uu[k] = g8[k] * h8[k];
                if (i >= 0) { float b8[8], y[8]; bf8_to_f(ab[i], b8);
#pragma unroll
                    for (int k = 0; k < 8; ++k) y[k] = b8[k] * (w0[k] * up2[k] + w1[k] * up1[k] + w2[k] * uu[k]);
                    v4u o; o.x = pk2(y[0], y[1]); o.y = pk2(y[2], y[3]); o.z = pk2(y[4], y[5]); o.w = pk2(y[6], y[7]);
                    *(GAS v4u*)(CAT + (size_t)(rowb + sq) * D + ca0) = o; }
#pragma unroll
                for (int k = 0; k < 8; ++k) { up2[k] = up1[k]; up1[k] = uu[k]; } }
        }
        {
            float pv[23][4];
#pragma unroll
            for (int i = 0; i < 23; ++i) { pv[i][0] = bflo(bq[i].x); pv[i][1] = bfhi(bq[i].x); pv[i][2] = bflo(bq[i].y); pv[i][3] = bfhi(bq[i].y); }
#pragma unroll
            for (int i = 0; i < 8; ++i) { const int sq = sfb + i; float a0 = 0.f, a1 = 0.f, a2 = 0.f, a3 = 0.f;
#pragma unroll
                for (int j = 0; j < 16; ++j) { const bool on = j < wwin; a0 += on ? pv[15 + i - j][0] : 0.f; a1 += on ? pv[15 + i - j][1] : 0.f; a2 += on ? pv[15 + i - j][2] : 0.f; a3 += on ? pv[15 + i - j][3] : 0.f; }
                const float rc = 1.f / (float)((sq + 1) < wwin ? (sq + 1) : wwin);
                *(LAS v2u*)(mixb + (tgb * 8 + i) * MROW + cb0 * 2) = (v2u){pk2(a0 * rc - pv[15 + i][0], a1 * rc - pv[15 + i][1]), pk2(a2 * rc - pv[15 + i][2], a3 * rc - pv[15 + i][3])}; }
        }
#pragma unroll
        for (int i = 0; i < 4; ++i) {
            const int idx = tid + 512 * i, tt = idx >> 5, dd = idx & 31; const float v = bf2f(ck[i]);
            const float mean = sum32(v) * (1.f / 32.f); const float dv = v - mean; const float var = sum32(dv * dv) * (1.f / 32.f);
            KIN[(size_t)(t0 + tt) * 32 + dd] = (bf16)f2bf(dv * rsqrtf(var + LN_EPS) * kg + kb);
        }
        __syncthreads();
        {
            const int g = wave >> 1, th = wave & 1, r32 = lane & 31, hi = lane >> 5;
            f32x16 acc[2]; acc[0] = f32x16{}; acc[1] = f32x16{};
#pragma unroll
            for (int kk = 0; kk < 4; ++kk) { const bf16x8 bfr = *(const LAS bf16x8*)(mixb + (th * 32 + r32) * MROW + (g * 64 + kk * 16 + hi * 8) * 2);
#pragma unroll
                for (int dh = 0; dh < 2; ++dh) { const bf16x8 afr = *(const LAS bf16x8*)(wpt + (g * 64 + dh * 32 + r32) * WROW + (kk * 16 + hi * 8) * 2);
                    acc[dh] = __builtin_amdgcn_mfma_f32_32x32x16_bf16(afr, bfr, acc[dh], 0, 0, 0); } }
            GAS bf16* orow = CAT + (size_t)(t0 + th * 32 + r32) * D + 256 + g * 64;
#pragma unroll
            for (int dh = 0; dh < 2; ++dh)
#pragma unroll
                for (int rq = 0; rq < 4; ++rq) { const int d0 = dh * 32 + 8 * rq + 4 * hi; const f32x4 sc = *(const GAS f32x4*)(pscale + g * 64 + d0);
                    *(GAS v2u*)(orow + d0) = (v2u){pk2(acc[dh][4 * rq] * sc.x, acc[dh][4 * rq + 1] * sc.y), pk2(acc[dh][4 * rq + 2] * sc.z, acc[dh][4 * rq + 3] * sc.w)}; }
        }
    }
    __syncthreads();
}

constexpr int SCS = SEQ;
__device__ __forceinline__ unsigned sortable(float v) { const unsigned u = __builtin_bit_cast(unsigned, v); return (u & 0x80000000u) ? ~u : (u | 0x80000000u); }
__device__ __forceinline__ void select_row(int t, const GAS float* SC, GAS unsigned* MASK, LAS unsigned* hist, LAS float* ckey, LAS int* cidx, int lane) {
    const u64 lt = (1ull << lane) - 1ull; const float NINF = -INFINITY;
    const int s = t & (SEQ - 1); GAS u64* mrow = (GAS u64*)MASK + ((size_t)(t >> 12) * 64) * SEQ + s;
    if (s < NSEL) { const int base = 64 * lane; u64 m; if (s >= base + 63) m = ~0ull; else if (s < base) m = 0ull; else m = (2ull << (s - base)) - 1ull; mrow[(size_t)lane * SEQ] = m; return; }
    const int jmax = s >> 6, jb = jmax & ~7;
    float v[64]; const GAS float* srow = SC + (size_t)t * SCS + lane;
#pragma unroll
    for (int j0 = 0; j0 < 64; j0 += 8) {
        if (j0 < jb) {
#pragma unroll
            for (int j = j0; j < j0 + 8; ++j) v[j] = srow[64 * j];
        } else if (j0 == jb) {
#pragma unroll
            for (int j = j0; j < j0 + 8; ++j) { const float x = srow[64 * j]; v[j] = (lane + 64 * j <= s) ? x : NINF; }
        } else {
#pragma unroll
            for (int j = j0; j < j0 + 8; ++j) v[j] = NINF;
        }
    }
    {
    float vmx = NINF, vmn = INFINITY;
#pragma unroll
    for (int j0 = 0; j0 < 64; j0 += 8) {
        if (j0 < jb) {
#pragma unroll
            for (int j = j0; j < j0 + 8; ++j) { vmx = fmaxf(vmx, v[j]); vmn = fminf(vmn, v[j]); }
        } else if (j0 == jb) {
#pragma unroll
            for (int j = j0; j < j0 + 8; ++j) { vmx = fmaxf(vmx, v[j]); vmn = fminf(vmn, v[j] == NINF ? INFINITY : v[j]); }
        }
    }
    vmx = wave_max_dpp(vmx); vmn = -wave_max_dpp(-vmn);
    const float scale = 1023.f / fmaxf(vmx - vmn, 1e-30f), off = -vmn * scale;
#pragma unroll
    for (int i = 0; i < 4; ++i) ((LAS v4u*)hist)[i * 64 + lane] = (v4u){0u, 0u, 0u, 0u};
    LDS_WAIT(); asm volatile("" ::: "memory");
    unsigned bp[32];
#pragma unroll
    for (int j0 = 0; j0 < 64; j0 += 8) {
        if (j0 < jb) {
#pragma unroll
            for (int j = j0; j < j0 + 8; ++j) { unsigned bb = (unsigned)fmaf(v[j], scale, off); bb = bb < 1023u ? bb : 1023u; __hip_atomic_fetch_add(hist + bb, 1u, __ATOMIC_RELAXED, __HIP_MEMORY_SCOPE_WORKGROUP);
                if (j & 1) bp[j >> 1] |= bb << 16; else bp[j >> 1] = bb; }
        } else if (j0 == jb) {
#pragma unroll
            for (int j = j0; j < j0 + 8; ++j) { unsigned bb = (unsigned)fmaf(v[j], scale, off); bb = bb < 1023u ? bb : 1023u; if (v[j] != NINF) __hip_atomic_fetch_add(hist + bb, 1u, __ATOMIC_RELAXED, __HIP_MEMORY_SCOPE_WORKGROUP);
                if (j & 1) bp[j >> 1] |= bb << 16; else bp[j >> 1] = bb; }
        } else {
#pragma unroll
            for (int j = j0; j < j0 + 8; j += 2) bp[j >> 1] = 0u;
        }
    }
    LDS_WAIT(); asm volatile("" ::: "memory");
    unsigned hb[16];
#pragma unroll
    for (int i = 0; i < 4; ++i) { const v4u q = ((const LAS v4u*)hist)[lane * 4 + i]; hb[4 * i] = q.x; hb[4 * i + 1] = q.y; hb[4 * i + 2] = q.z; hb[4 * i + 3] = q.w; }
    int own = 0;
#pragma unroll
    for (int i = 0; i < 16; ++i) own += (int)hb[i];
    int suf = own;
    suf += __builtin_amdgcn_update_dpp(0, suf, 0x101, 0xf, 0xf, true); suf += __builtin_amdgcn_update_dpp(0, suf, 0x102, 0xf, 0xf, true);
    suf += __builtin_amdgcn_update_dpp(0, suf, 0x104, 0xf, 0xf, true); suf += __builtin_amdgcn_update_dpp(0, suf, 0x108, 0xf, 0xf, true);
    { const int t1 = __builtin_amdgcn_readlane(suf, 16), t2 = __builtin_amdgcn_readlane(suf, 32), t3 = __builtin_amdgcn_readlane(suf, 48); const int rw = lane >> 4;
      suf += rw == 0 ? t1 + t2 + t3 : rw == 1 ? t2 + t3 : rw == 2 ? t3 : 0; }
    const u64 ge = __ballot(suf >= NSEL); const int L = 63 - __builtin_clzll(ge);
    int acc = suf - own, tb = 0, ca = 0, found = 0;
#pragma unroll
    for (int i = 15; i >= 0; --i) { if (!found) { if (acc + (int)hb[i] >= NSEL) { found = 1; tb = lane * 16 + i; ca = acc; } else acc += (int)hb[i]; } }
    const int TB = __builtin_amdgcn_readlane(tb, L), CA = __builtin_amdgcn_readlane(ca, L);
    const int need = NSEL - CA;
    int cbase = 0; unsigned mlo = 0u, mhi = 0u;
#pragma unroll
    for (int j0 = 0; j0 < 64; j0 += 8) {
        if (j0 <= jb) {
#pragma unroll
            for (int j = j0; j < j0 + 8; ++j) { const int bb = (int)((j & 1) ? (bp[j >> 1] >> 16) : (bp[j >> 1] & 0xffffu));
                const u64 am = __ballot(bb > TB); const u64 cm = __ballot(bb == TB);
                asm volatile("s_nop 4\n\tv_writelane_b32 %0, %2, %4\n\tv_writelane_b32 %1, %3, %4" : "+v"(mlo), "+v"(mhi) : "s"((unsigned)am), "s"((unsigned)(am >> 32)), "n"(j));
                if (cm) { const int pos = cbase + __popcll(cm & lt); if (bb == TB && pos < 64) { ckey[pos] = v[j]; cidx[pos] = lane + 64 * j; } cbase += __popcll(cm); } }
        }
    }
    LDS_WAIT(); asm volatile("" ::: "memory");
    if (cbase <= SEL_CAND_CAP) {
        LAS unsigned* mw = hist;
        mw[2 * lane] = mlo; mw[2 * lane + 1] = mhi;
        const float myk = lane < cbase ? ckey[lane] : NINF; const int myi = lane < cbase ? cidx[lane] : 0x7fffffff; int rank = 0;
        for (int c = 0; c < cbase; ++c) { const float ok = __builtin_bit_cast(float, __builtin_amdgcn_readlane(__builtin_bit_cast(int, myk), c)); const int oi = __builtin_amdgcn_readlane(myi, c); rank += (ok > myk || (ok == myk && oi < myi)) ? 1 : 0; }
        LDS_WAIT(); asm volatile("" ::: "memory");
        if (lane < cbase && rank < need && myk != NINF) __hip_atomic_fetch_or(mw + (myi >> 5), 1u << (myi & 31), __ATOMIC_RELAXED, __HIP_MEMORY_SCOPE_WORKGROUP);
        LDS_WAIT(); asm volatile("" ::: "memory");
        mrow[(size_t)lane * SEQ] = (u64)mw[2 * lane] | ((u64)mw[2 * lane + 1] << 32);
        LDS_WAIT(); asm volatile("" ::: "memory");
        return;
    }
    unsigned prefix = 0u;
    for (int bit = 31; bit >= 0; --bit) { const unsigned cand = prefix | (1u << bit); int cnt = 0;
#pragma unroll
        for (int j0 = 0; j0 < 64; j0 += 8) {
#pragma unroll
            for (int j = j0; j < j0 + 8; ++j) cnt += __popcll(__ballot(v[j] != NINF && sortable(v[j]) >= cand));
            __builtin_amdgcn_sched_barrier(0); }
        if (cnt >= NSEL) prefix = cand; }
    int ngt = 0;
#pragma unroll
    for (int j = 0; j < 64; ++j) ngt += __popcll(__ballot(v[j] != NINF && sortable(v[j]) > prefix));
    int rem = NSEL - ngt, last = 0;
#pragma unroll
    for (int j = 0; j < 64; ++j) { const u64 em = __ballot(v[j] != NINF && sortable(v[j]) == prefix); const int c = __popcll(em);
        if (rem > 0 && c > 0) { if (c >= rem) { u64 x = em; for (int q = 1; q < rem; ++q) x &= x - 1ull; last = 64 * j + __builtin_ctzll(x); rem = 0; } else rem -= c; } }
    const unsigned pb = (prefix & 0x80000000u) ? (prefix & 0x7fffffffu) : ~prefix; const float Tv = __builtin_bit_cast(float, pb); const int Tidx = last;
    mlo = 0u; mhi = 0u;
#pragma unroll
    for (int j = 0; j < 64; ++j) { const bool sel = (v[j] > Tv) || (v[j] == Tv && lane + 64 * j <= Tidx); const u64 m = __ballot(sel);
        asm volatile("s_nop 4\n\tv_writelane_b32 %0, %2, %4\n\tv_writelane_b32 %1, %3, %4" : "+v"(mlo), "+v"(mhi) : "s"((unsigned)m), "s"((unsigned)(m >> 32)), "n"(j)); }
    mrow[(size_t)lane * SEQ] = (u64)mlo | ((u64)mhi << 32);
    return;
    }
}
__device__ __forceinline__ float relu_i(float x) { const int b = __builtin_bit_cast(int, x); return __builtin_bit_cast(float, b > 0 ? b : 0); }
__device__ __forceinline__ void p_index(Frame& F) {
    const int wave = F.wave;
    const GAS bf16* PROJ = (const GAS bf16*)(F.ws + WS_PROJ); const GAS bf16* KIN = (const GAS bf16*)(F.ws + WS_KIN); GAS float* SC = (GAS float*)(F.ws + WS_SC); GAS unsigned* MASK = (GAS unsigned*)(F.ws + WS_MASK);
    LAS unsigned* hist = (LAS unsigned*)(F.lds + wave * 4096);
    LAS float* ckey = (LAS float*)(F.lds + 32768 + wave * 1024); LAS int* cidx = (LAS int*)(ckey + 64);
    for (int ui = 0; ui < 2; ++ui) {
        const int v = F.vcu; if (v >= 256) break;
        const int b = v & 3, j = v >> 2, qb = ui == 0 ? j : 127 - j, q0 = qb * 32;
        int lane = F.tid & 63; asm volatile("" : "+v"(lane)); const int l15 = lane & 15, l4 = lane >> 4;
        bf16x8 bq[2][8]; float wq[2][8];
#pragma unroll
        for (int hq = 0; hq < 2; ++hq) { const size_t rowq = (size_t)(b * SEQ + q0 + 16 * hq + l15);
#pragma unroll
            for (int h = 0; h < 8; ++h) { bq[hq][h] = *(const GAS bf16x8*)(PROJ + rowq * NINP + C_QI + h * 32 + 8 * l4); wq[hq][h] = bf2f(PROJ[rowq * NINP + C_WI + h]) * 0.0625f; } }
        GAS float* srow = SC + (size_t)(b * SEQ + q0 + l15) * SCS + 4 * l4;
        const int ktl = 2 * qb + 1; const GAS bf16* kin0 = KIN + (size_t)(b * SEQ + l15) * 32 + 8 * l4;
        bf16x8 a = *(const GAS bf16x8*)(kin0 + (size_t)((wave <= ktl ? wave : ktl) * 16) * 32);
        for (int kt = wave; kt <= ktl; kt += NWAVES) {
            const int ktn = kt + NWAVES <= ktl ? kt + NWAVES : kt;
            const bf16x8 an = *(const GAS bf16x8*)(kin0 + (size_t)(ktn * 16) * 32);
#pragma unroll
            for (int hq = 0; hq < 2; ++hq) { f32x4 sc = (f32x4){0.f, 0.f, 0.f, 0.f};
#pragma unroll
                for (int h = 0; h < 8; ++h) { const f32x4 d = __builtin_amdgcn_mfma_f32_16x16x32_bf16(a, bq[hq][h], (f32x4){0.f, 0.f, 0.f, 0.f}, 0, 0, 0);
                    sc.x += relu_i(d.x) * wq[hq][h]; sc.y += relu_i(d.y) * wq[hq][h]; sc.z += relu_i(d.z) * wq[hq][h]; sc.w += relu_i(d.w) * wq[hq][h]; }
                *(GAS f32x4*)(srow + (size_t)(16 * hq) * SCS + kt * 16) = sc; }
            a = an;
        }
        asm volatile("s_waitcnt vmcnt(0)" ::: "memory"); __syncthreads();
        int lane_s = F.tid & 63; asm volatile("" : "+v"(lane_s));
        for (int r = 0; r < 4; ++r) select_row(b * SEQ + q0 + wave * 4 + r, SC, MASK, hist, ckey, cidx, lane_s);
#ifdef EXP_DUP_SELECT
        for (int r = 0; r < 4; ++r) select_row(b * SEQ + q0 + wave * 4 + r, SC, MASK, hist, ckey, cidx, lane_s);
#endif
    }
}

namespace att {
typedef float f32x16 __attribute__((ext_vector_type(16)));
typedef short s16x4 __attribute__((ext_vector_type(4)));
constexpr int NSLOT = 3, SLOTB = 8192, LDS_K = 0, LDS_V = NSLOT * SLOTB, LDS_WS = 2 * NSLOT * SLOTB, LDS_OST = LDS_WS + 8 * 64 * 4, LDS_BYTES_ATT = LDS_OST + 8 * 4096;
constexpr float THR = 100.f;
__device__ __forceinline__ int crow(int r, int hi) { return (r & 3) + 8 * (r >> 2) + 4 * hi; }
__device__ __forceinline__ unsigned cvtpk(float lo, float hi) { typedef float f2 __attribute__((ext_vector_type(2))); typedef __bf16 b2 __attribute__((ext_vector_type(2))); f2 v = {lo, hi}; b2 b = __builtin_convertvector(v, b2); return __builtin_bit_cast(unsigned, b); }
__device__ __forceinline__ float rowmax(const f32x16& p0, const f32x16& p1) {
    float a = fmaxf(fmaxf(p0[0], p0[1]), p1[0]), b = fmaxf(fmaxf(p0[2], p0[3]), p1[1]); a = fmaxf(fmaxf(a, p1[2]), p1[3]);
#pragma unroll
    for (int r = 4; r < 16; r += 4) { a = fmaxf(fmaxf(a, p0[r]), p0[r + 1]); b = fmaxf(fmaxf(b, p0[r + 2]), p0[r + 3]); a = fmaxf(fmaxf(a, p1[r]), p1[r + 1]); b = fmaxf(fmaxf(b, p1[r + 2]), p1[r + 3]); }
    const float m = fmaxf(a, b);
    return fmaxf(m, __shfl_xor(m, 32));
}
__device__ __forceinline__ void pv(f32x16* o, int vb, bf16x8 pa0, bf16x8 pa1, bf16x8 pa2, bf16x8 pa3) {
#pragma unroll
    for (int d0 = 0; d0 < 2; ++d0) { s16x4 lo[4], hi[4];
#pragma unroll
        for (int ks = 0; ks < 4; ++ks) {
            asm volatile("ds_read_b64_tr_b16 %0,%1 offset:%c2" : "=&v"(lo[ks]) : "v"(vb), "i"(d0 * 4096 + ks * 1024) : "memory");
            asm volatile("ds_read_b64_tr_b16 %0,%1 offset:%c2" : "=&v"(hi[ks]) : "v"(vb), "i"(d0 * 4096 + ks * 1024 + 512) : "memory"); }
        asm volatile("s_waitcnt lgkmcnt(0)" ::: "memory"); __builtin_amdgcn_sched_barrier(0);
#define ATT_PK(k) (bf16x8){lo[k][0], lo[k][1], lo[k][2], lo[k][3], hi[k][0], hi[k][1], hi[k][2], hi[k][3]}
        o[d0] = __builtin_amdgcn_mfma_f32_32x32x16_bf16(pa0, ATT_PK(0), o[d0], 0, 0, 0);
        o[d0] = __builtin_amdgcn_mfma_f32_32x32x16_bf16(pa1, ATT_PK(1), o[d0], 0, 0, 0);
        o[d0] = __builtin_amdgcn_mfma_f32_32x32x16_bf16(pa2, ATT_PK(2), o[d0], 0, 0, 0);
        o[d0] = __builtin_amdgcn_mfma_f32_32x32x16_bf16(pa3, ATT_PK(3), o[d0], 0, 0, 0);
#undef ATT_PK
    }
}
}
template <bool grpB> __device__ __forceinline__ void attn_units(Frame& F) {
    using namespace att;
    const int tid = F.tid, lane = tid & 63, r32 = lane & 31, hi = lane >> 5, wid = F.wave;
    const GAS bf16* PROJ = (const GAS bf16*)(F.ws + WS_PROJ); GAS bf16* CAT = (GAS bf16*)(F.ws + WS_CAT); const GAS u64* MASKT = (const GAS u64*)(F.ws + WS_MASK);
    LAS unsigned char* shm = F.lds;
    constexpr int NSV = 4, LDS_V2 = NSLOT * SLOTB, LDS_WS2 = LDS_V2 + NSV * SLOTB, LDS_OST2 = LDS_WS2 + 8 * 64 * 4;
    LAS float* wsf = (LAS float*)(shm + LDS_WS2) + wid * 64;
    const float NEGINF = -INFINITY;
    for (int ui = 0; ui < 2; ++ui) {
        const int v = F.vcu; if (v >= 256) break;
        const int bh = v >> 3, sidx = v & 7, b = bh >> 3, h = bh & 7, qb = ui == 0 ? sidx : 15 - sidx;
        const size_t rowbase = (size_t)b * SEQ; const int q0 = qb * 256, NT = (q0 + 256) / 64;
        const float slope2 = exp2f(-(float)(h + 1)) * 1.4426950408889634f;
        const GAS bf16* Kh = PROJ + rowbase * NINP + C_K + h * 64; const GAS bf16* Vh = PROJ + rowbase * NINP + C_V + h * 64;
        const GAS bf16* ksrc = Kh + (size_t)lane * NINP + wid * 8;
        const GAS bf16* vsrc = Vh + (size_t)(16 * (wid & 3) + (lane >> 2)) * NINP + (wid >> 2) * 32 + (lane & 3) * 8;
#define ATT_DMA(t, ks, vs) do { __builtin_amdgcn_global_load_lds((const GAS unsigned*)(ksrc + (size_t)(t) * 64 * NINP), (LAS unsigned*)(shm + LDS_K + (ks) * SLOTB + wid * 1024), 16, 0, 0); \
                        __builtin_amdgcn_global_load_lds((const GAS unsigned*)(vsrc + (size_t)(t) * 64 * NINP), (LAS unsigned*)(shm + LDS_V2 + (vs) * SLOTB + wid * 1024), 16, 0, 0); } while (0)
        ATT_DMA(0, 0, 0); ATT_DMA(1, 1, 1);
        const GAS bf16* Qw = PROJ + (rowbase + q0 + wid * 32) * NINP + C_Q + h * 64;
        bf16x8 qr[4];
#pragma unroll
        for (int d0 = 0; d0 < 4; ++d0) qr[d0] = *(const GAS bf16x8*)(Qw + (size_t)r32 * NINP + d0 * 16 + hi * 8);
        const GAS u64* mq = MASKT + ((size_t)b * 64) * SEQ + q0 + wid * 32 + r32;
        u64 mnext = mq[0], mprev = 0ull;
        f32x16 o[2], p0 = f32x16{}, p1 = f32x16{}; o[0] = f32x16{}; o[1] = f32x16{};
        float l_reg = 0.f, sq = 0.f;
        const unsigned sl_hi = __builtin_bit_cast(unsigned, slope2) & 0xffff0000u; const unsigned sl_lo = f2bf(slope2 - __builtin_bit_cast(float, sl_hi));
        bf16x8 kx0, kx1;
        { const unsigned j0 = hi ? 0u : (f2bf((float)r32) * 0x10001u), j1 = hi ? 0u : (f2bf((float)(r32 + 32)) * 0x10001u), one2 = hi ? 0u : 0x3f803f80u, one1 = hi ? 0u : 0x3f80u;
          kx0 = __builtin_bit_cast(bf16x8, (v4u){j0, one2, one1, 0u}); kx1 = __builtin_bit_cast(bf16x8, (v4u){j1, one2, one1, 0u}); }
        const int qlast = q0 + wid * 32 + 31;
        const int vb0 = (int)(unsigned)(uintptr_t)(shm + LDS_V2) + ((lane >> 4) & 1) * 32 + (lane & 3) * 8 + (4 * hi + ((lane & 15) >> 2)) * 64;
#define ATT_QK(ks) do { const LAS unsigned char* kb = shm + LDS_K + (ks) * SLOTB + hi * 1024 + r32 * 16; \
            { const unsigned u0_ = __builtin_bit_cast(unsigned, sq), a1_ = u0_ & 0xffff0000u; const float r1_ = sq - __builtin_bit_cast(float, a1_); const unsigned u1_ = __builtin_bit_cast(unsigned, r1_), a2_ = u1_ & 0xffff0000u; \
              const float r2_ = r1_ - __builtin_bit_cast(float, a2_); const unsigned a3_ = __builtin_bit_cast(unsigned, r2_) >> 16; \
              const bf16x8 qx = __builtin_bit_cast(bf16x8, (v4u){hi ? 0u : ((sl_hi >> 16) | (sl_lo << 16)), hi ? 0u : ((a1_ >> 16) | a2_), hi ? 0u : a3_, 0u}); \
              const f32x16 z_ = f32x16{}; p0 = __builtin_amdgcn_mfma_f32_32x32x16_bf16(kx0, qx, z_, 0, 0, 0); p1 = __builtin_amdgcn_mfma_f32_32x32x16_bf16(kx1, qx, z_, 0, 0, 0); } \
            _Pragma("unroll") for (int d0 = 0; d0 < 4; ++d0) { const bf16x8 k0 = *(const LAS bf16x8*)(kb + d0 * 2048), k1 = *(const LAS bf16x8*)(kb + d0 * 2048 + 512); \
                p0 = __builtin_amdgcn_mfma_f32_32x32x16_bf16(k0, qr[d0], p0, 0, 0, 0); p1 = __builtin_amdgcn_mfma_f32_32x32x16_bf16(k1, qr[d0], p1, 0, 0, 0); } } while (0)
#define ATT_SMPV(vs, mw) do { const unsigned w0 = (unsigned)(mw) >> (4 * hi), w1 = (unsigned)((mw) >> 32) >> (4 * hi); \
            asm volatile("s_nop 15\n\ts_nop 7" : "+v"(p0), "+v"(p1));   \
            _Pragma("unroll") for (int r = 0; r < 16; ++r) { const int cr = (r & 3) + 8 * (r >> 2); const int k0_ = __builtin_amdgcn_sbfe((int)w0, cr, 1), k1_ = __builtin_amdgcn_sbfe((int)w1, cr, 1); \
                asm("v_bfi_b32 %0, %1, %0, %2" : "+v"(p0[r]) : "v"(k0_), "v"(NEGINF)); asm("v_bfi_b32 %0, %1, %0, %2" : "+v"(p1[r]) : "v"(k1_), "v"(NEGINF)); } \
            const float rm = rowmax(p0, p1); bool resc = false; \
            if (__any(rm > THR)) { const float dl = fmaxf(rm, 0.f); \
                _Pragma("unroll") for (int r = 0; r < 16; ++r) { p0[r] -= dl; p1[r] -= dl; } sq -= dl; \
                const float f = __builtin_amdgcn_exp2f(-dl); l_reg *= f; if (hi == 0) wsf[r32] = f; resc = true; } \
            float sacc = 0.f; \
            _Pragma("unroll") for (int r = 0; r < 16; ++r) { p0[r] = __builtin_amdgcn_exp2f(p0[r]); p1[r] = __builtin_amdgcn_exp2f(p1[r]); sacc += p0[r] + p1[r]; } \
            l_reg += sacc; \
            if (resc) { asm volatile("s_waitcnt lgkmcnt(0)" ::: "memory"); \
                _Pragma("unroll") for (int d_ = 0; d_ < 2; ++d_) _Pragma("unroll") for (int r = 0; r < 16; ++r) o[d_][r] *= wsf[crow(r, hi)]; } \
            const v4u pw0 = (v4u){cvtpk(p0[0], p0[1]), cvtpk(p0[2], p0[3]), cvtpk(p0[4], p0[5]), cvtpk(p0[6], p0[7])}, pw1 = (v4u){cvtpk(p0[8], p0[9]), cvtpk(p0[10], p0[11]), cvtpk(p0[12], p0[13]), cvtpk(p0[14], p0[15])}; \
            const v4u pw2 = (v4u){cvtpk(p1[0], p1[1]), cvtpk(p1[2], p1[3]), cvtpk(p1[4], p1[5]), cvtpk(p1[6], p1[7])}, pw3 = (v4u){cvtpk(p1[8], p1[9]), cvtpk(p1[10], p1[11]), cvtpk(p1[12], p1[13]), cvtpk(p1[14], p1[15])}; \
            __builtin_amdgcn_sched_barrier(0); \
            pv(o, vb0 + (vs) * SLOTB, __builtin_bit_cast(bf16x8, pw0), __builtin_bit_cast(bf16x8, pw1), __builtin_bit_cast(bf16x8, pw2), __builtin_bit_cast(bf16x8, pw3)); } while (0)
        if constexpr (grpB) __builtin_amdgcn_s_setprio(1);
        const float step = 64.f * slope2;
        int ks = 0, vs = 0;
        u64 mcur = 0ull;
#define ATT_SYNC(t) do { if ((t) + 1 < NT) asm volatile("s_waitcnt vmcnt(2)" ::: "memory"); else asm volatile("s_waitcnt vmcnt(0)" ::: "memory"); \
            asm volatile("s_waitcnt lgkmcnt(0)" ::: "memory"); __builtin_amdgcn_s_barrier(); asm volatile("" ::: "memory"); \
            mprev = mcur; mcur = mnext; if ((t) + 1 < NT) mnext = mq[(size_t)((t) + 1) * SEQ]; \
            __builtin_amdgcn_sched_barrier(0); \
            if ((t) + 2 < NT) ATT_DMA((t) + 2, ks + 2 >= NSLOT ? ks + 2 - NSLOT : ks + 2, vs + 2 >= NSV ? vs + 2 - NSV : vs + 2); \
            __builtin_amdgcn_sched_barrier(0); } while (0)
#define ATT_ADV() do { sq += step; ks = ks + 1 >= NSLOT ? 0 : ks + 1; vs = vs + 1 >= NSV ? 0 : vs + 1; } while (0)
        const int tmax = qlast >> 6;
        if constexpr (!grpB) {
            int t = 0;
            for (; t <= tmax; ++t) { ATT_SYNC(t); ATT_QK(ks); ATT_SMPV(vs, mcur); ATT_ADV(); }
            for (; t < NT; ++t) { ATT_SYNC(t); ATT_ADV(); }
        } else {
            ATT_SYNC(0); ATT_QK(ks); ATT_ADV();
            int t = 1;
            for (; t <= tmax; ++t) { ATT_SYNC(t); ATT_SMPV(vs == 0 ? NSV - 1 : vs - 1, mprev); ATT_QK(ks); ATT_ADV(); }
            if (t < NT) { ATT_SYNC(t); ATT_SMPV(vs == 0 ? NSV - 1 : vs - 1, mprev); ATT_ADV(); ++t;
                for (; t < NT; ++t) { ATT_SYNC(t); ATT_ADV(); } }
            else { ATT_SMPV(vs == 0 ? NSV - 1 : vs - 1, mcur); }
        }
#undef ATT_SYNC
#undef ATT_ADV
        __builtin_amdgcn_s_setprio(0);
        l_reg += __shfl_xor(l_reg, 32);
        if (hi == 0) wsf[32 + r32] = l_reg;
        asm volatile("s_waitcnt lgkmcnt(0)" ::: "memory");
        float rli[16];
#pragma unroll
        for (int r = 0; r < 16; ++r) rli[r] = 1.f / wsf[32 + crow(r, hi)];
        GAS bf16* Ow = CAT + (rowbase + q0 + wid * 32) * D + 512 + h * 64;
        { LAS bf16* stg = (LAS bf16*)(shm + LDS_OST2) + wid * 2048;
#pragma unroll
            for (int r = 0; r < 16; ++r) { const int orow = crow(r, hi);
#pragma unroll
                for (int d0 = 0; d0 < 2; ++d0) stg[orow * 64 + d0 * 32 + r32] = (bf16)f2bf(o[d0][r] * rli[r]); }
            asm volatile("s_waitcnt lgkmcnt(0)" ::: "memory");
#pragma unroll
            for (int i = 0; i < 4; ++i) { const int row = i * 8 + (lane >> 3), ch = lane & 7; const v4u vv = *(const LAS v4u*)(stg + row * 64 + ch * 8); *(GAS v4u*)(Ow + (size_t)row * D + ch * 8) = vv; } }
        asm volatile("s_waitcnt vmcnt(0) lgkmcnt(0)" ::: "memory"); __builtin_amdgcn_s_barrier(); asm volatile("" ::: "memory");
#undef ATT_DMA
#undef ATT_QK
#undef ATT_SMPV
    }
}

__device__ __forceinline__ void p_attn_dense(Frame& F) { if (F.wave >= 4) attn_units<true>(F); else attn_units<false>(F); }

struct EpiResid {
    static constexpr bool PERM = true, AFTER_DRAIN = false;
    const bf16* resid; bf16* out; float alpha;
    __device__ __forceinline__ void operator()(const pg8::f32x4 (&acc)[2][2][4][2], const pg8::Unit& u, int wr, int wc, int fr, int fq) const {
        const int col0 = u.pn * 256 + wc * 32 + 8 * fq;
#pragma unroll
        for (int ai = 0; ai < 2; ++ai)
#pragma unroll
            for (int m = 0; m < 4; ++m) { const size_t off = (size_t)(u.pm * 256 + ai * 128 + wr * 64 + m * 16 + fr) * D + col0;
#pragma unroll
                for (int bj = 0; bj < 2; ++bj) { const v4u xr = *(const GAS v4u*)(resid + off + bj * 128); const f32x4 a0 = acc[ai][bj][m][0], a1 = acc[ai][bj][m][1];
                    v4u w; w.x = pk2(bflo(xr.x) * alpha + a0[0], bfhi(xr.x) * alpha + a0[1]); w.y = pk2(bflo(xr.y) * alpha + a0[2], bfhi(xr.y) * alpha + a0[3]);
                    w.z = pk2(bflo(xr.z) * alpha + a1[0], bfhi(xr.z) * alpha + a1[1]); w.w = pk2(bflo(xr.w) * alpha + a1[2], bfhi(xr.w) * alpha + a1[3]);
                    st16_wt(out + off + bj * 128, w.x, w.y, w.z, w.w); }
                if (m & 1) asm volatile("" ::: "memory"); }
    }
};
struct EpiSwiglu {
    static constexpr bool PERM = true, AFTER_DRAIN = false;
    unsigned char* O; const float* bias;
    __device__ __forceinline__ void operator()(const pg8::f32x4 (&acc)[2][2][4][2], const pg8::Unit& u, int wr, int wc, int fr, int fq) const {
        const int e = u.pn >> 3, nt = u.pn & 7; const int colg = nt * 128 + wc * 32 + 8 * fq;
        f32x4 bg[2], bu[2];
#pragma unroll
        for (int n = 0; n < 2; ++n) { bg[n] = *(const GAS f32x4*)(bias + (size_t)e * 2048 + colg + 4 * n); bu[n] = *(const GAS f32x4*)(bias + (size_t)e * 2048 + 1024 + colg + 4 * n); }
#pragma unroll
        for (int ai = 0; ai < 2; ++ai)
#pragma unroll
            for (int m = 0; m < 4; ++m) { const size_t row = (size_t)(u.pm * 256 + ai * 128 + wr * 64 + m * 16 + fr); float a8[8];
#pragma unroll
                for (int n = 0; n < 2; ++n)
#pragma unroll
                    for (int i = 0; i < 4; i += 2) {
                        typedef float f2 __attribute__((ext_vector_type(2)));
                        const f2 ag = {acc[ai][0][m][n][i], acc[ai][0][m][n][i + 1]}, au = {acc[ai][1][m][n][i], acc[ai][1][m][n][i + 1]};
                        const f2 bgv = {bg[n][i], bg[n][i + 1]}, buv = {bu[n][i] + 1.f, bu[n][i + 1] + 1.f};
                        f2 g = ag * (1.f / WGU_SCALE) + bgv, up1 = au * (1.f / WGU_SCALE) + buv;
                        g.x = fminf(g.x, 7.f); g.y = fminf(g.y, 7.f); up1.x = fminf(fmaxf(up1.x, -6.f), 8.f); up1.y = fminf(fmaxf(up1.y, -6.f), 8.f);
                        f2 t = g * (-1.702f * 1.4426950408889634f); t.x = __builtin_amdgcn_exp2f(t.x); t.y = __builtin_amdgcn_exp2f(t.y);
                        f2 d = t + 1.f; d.x = __builtin_amdgcn_rcpf(d.x); d.y = __builtin_amdgcn_rcpf(d.y);
                        const f2 r = g * up1 * d; a8[n * 4 + i] = r.x; a8[n * 4 + i + 1] = r.y; }
                v2u w; w.x = pk4_fp8(a8[0], a8[1], a8[2], a8[3]); w.y = pk4_fp8(a8[4], a8[5], a8[6], a8[7]);
                st8_wt(O + row * 1024 + colg, w.x, w.y); }
    }
};
struct EpiDown {
    static constexpr bool PERM = true, AFTER_DRAIN = false;
    bf16* O; const float* bias;
    __device__ __forceinline__ void operator()(const pg8::f32x4 (&acc)[2][2][4][2], const pg8::Unit& u, int wr, int wc, int fr, int fq) const {
        const int col0 = (u.pn & 3) * 256 + wc * 32 + 8 * fq; const float* bp = bias + (size_t)(u.pn >> 2) * 1024 + col0;
        f32x4 bv[2][2];
#pragma unroll
        for (int bj = 0; bj < 2; ++bj)
#pragma unroll
            for (int n = 0; n < 2; ++n) bv[bj][n] = *(const GAS f32x4*)(bp + bj * 128 + 4 * n);
#pragma unroll
        for (int ai = 0; ai < 2; ++ai)
#pragma unroll
            for (int m = 0; m < 4; ++m) { bf16* rowp = O + (size_t)(u.pm * 256 + ai * 128 + wr * 64 + m * 16 + fr) * 1024 + col0;
#pragma unroll
                for (int bj = 0; bj < 2; ++bj) { const f32x4 v0 = acc[ai][bj][m][0] * (1.f / WDN_SCALE) + bv[bj][0], v1 = acc[ai][bj][m][1] * (1.f / WDN_SCALE) + bv[bj][1];
                    v4u w; w.x = pk2(v0[0], v0[1]); w.y = pk2(v0[2], v0[3]); w.z = pk2(v1[0], v1[1]); w.w = pk2(v1[2], v1[3]);
                    st16_wt(rowp + bj * 128, w.x, w.y, w.z, w.w); } }
    }
};
struct MoeSched {
    const LAS int* tab; int n;
    __device__ __forceinline__ bool next(int i, pg8::Unit& u) const {
        if (i >= n) return false;
        const int v = __builtin_amdgcn_readfirstlane(tab[1 + i]); u.pm = v >> 16; u.pn = v & 0xffff; return true;
    }
    __device__ __forceinline__ void a_ready(const pg8::Unit&) const {}
    __device__ __forceinline__ void done(const pg8::Unit&) const {}
};
#ifndef MOE_UNIT_OWNER
#define MOE_UNIT_OWNER F.vcu
#endif
__device__ __forceinline__ int moe_table(Frame& F, int l, int ntn) {
    LAS int* tab = (LAS int*)(F.lds + TAB_OFF);
    if (F.wave == 0) {
        const int lane = F.lane; const int cnt = lane < NE ? (int)__hip_atomic_load(F.ctl + CW_CNT + 64 * l + lane, RLX_AGENT) : 0; const int mt = (cnt + 255) >> 8; int incl = mt;
#pragma unroll
        for (int o = 1; o < 64; o <<= 1) { const int v = __shfl_up(incl, o); if (lane >= o) incl += v; }
        const int total = __shfl(incl, 63) * ntn; const int c = MOE_UNIT_OWNER;
        const int xcd = c >> 5, jw = c & 31, uq = total >> 3, ur = total & 7, cntx = uq + (xcd < ur ? 1 : 0), basex = xcd * uq + (xcd < ur ? xcd : ur);
        const int nmine = jw < cntx ? (cntx - jw + 31) >> 5 : 0;
        for (int i0 = 0; i0 < nmine && i0 < 200; i0 += 64) { const int i = i0 + lane; const int L = basex + i * 32 + jw; int e = 0;
            for (int k = 0; k < NE; ++k) { const int endk = __shfl(incl, k) * ntn; e += (L >= endk) ? 1 : 0; }
            e = e < NE ? e : NE - 1;
            const int excl_e = __shfl(incl, e) - __shfl(mt, e); int mte = __shfl(mt, e); mte = mte > 0 ? mte : 1; const int idx = L - excl_e * ntn;
            if (i < nmine && i < 200) tab[1 + i] = ((excl_e + idx % mte) << 16) | (e * ntn + idx / mte); }
        if (lane == 0) tab[0] = nmine < 200 ? nmine : 200;
    }
    __syncthreads();
    return __builtin_amdgcn_readfirstlane(tab[0]);
}

__device__ __forceinline__ void p_router(Frame& F, const In6& A, int l) {
    const int lane = F.lane, wave = F.wave, tid = F.tid;
    constexpr int XROW = 2064;
    LAS unsigned char* XH = F.lds; LAS unsigned char* XL = F.lds + 16 * XROW;
    LAS float* part = (LAS float*)(F.lds + 2 * 16 * XROW);
    LAS int* cnt = (LAS int*)(F.lds + 2 * 16 * XROW + 16384);
    LAS float* lgs = (LAS float*)(F.lds + 2 * 16 * XROW + 16384 + 1024);
    LAS float* top = lgs + 512;
    const GAS bf16* Y1 = (const GAS bf16*)(F.ws + WS_Y1); GAS bf16* X1B = (GAS bf16*)(F.ws + WS_Y1 + 32 * MiB); GAS unsigned* XB8 = (GAS unsigned*)(F.ws + WS_XB8);
    GAS int* TOPE = (GAS int*)(F.ws + WS_ROUTE); GAS float* GATE = (GAS float*)(TOPE + 8 * T); GAS int* CNTW = (GAS int*)(F.ws + WS_CNTW);
    const GAS float* g1 = (const GAS float*)(A.p[0] + l * D); const GAS float* b1 = (const GAS float*)(A.p[1] + l * D);
    const GAS float* RW = (const GAS float*)(A.p[2] + (size_t)l * D * NE); const GAS float* RB = (const GAS float*)(A.p[3] + l * NE);
    if (tid < 256) cnt[tid] = 0;
    bf16x8 wh[4][2], wl[4][2];
#pragma unroll
    for (int st = 0; st < 4; ++st)
#pragma unroll
        for (int hf = 0; hf < 2; ++hf) { const GAS float* wp = RW + (size_t)(wave * 128 + st * 32 + (lane >> 4) * 8) * NE + (lane & 15) + 16 * hf;
#pragma unroll
            for (int j = 0; j < 8; ++j) { const float w = wp[(size_t)j * NE]; const unsigned h = f2bf(w); const float r = w - __builtin_bit_cast(float, h << 16); wh[st][hf][j] = (short)h; wl[st][hf][j] = (short)f2bf(r); } }
    f32x4 g1v[4], b1v[4];
#pragma unroll
    for (int j = 0; j < 4; ++j) { g1v[j] = ((const GAS f32x4*)g1)[lane + 64 * j]; b1v[j] = ((const GAS f32x4*)b1)[lane + 64 * j]; }
    const float rb_e = RB[tid & 31];
    v2u yq[2][4];
#pragma unroll
    for (int i = 0; i < 2; ++i) { const GAS v2u* yr = (const GAS v2u*)(Y1 + (size_t)(F.vcu * 64 + wave * 2 + i) * D) + lane;
#pragma unroll
        for (int j = 0; j < 4; ++j) yq[i][j] = yr[64 * j]; }
    for (int g = 0; g < 4; ++g) {
        const int t0 = F.vcu * 64 + g * 16;
#pragma unroll
        for (int i = 0; i < 2; ++i) { const int tl = wave * 2 + i, t = t0 + tl;
            GAS u64* xr1 = (GAS u64*)(X1B + (size_t)t * D) + lane; f32x4 v[4]; float s = 0.f;
#pragma unroll
            for (int j = 0; j < 4; ++j) { const v2u q = yq[i][j]; v[j] = (f32x4){bflo(q.x), bfhi(q.x), bflo(q.y), bfhi(q.y)}; s += (v[j].x + v[j].y) + (v[j].z + v[j].w); }
            if (g < 3) { const GAS v2u* yr = (const GAS v2u*)(Y1 + (size_t)(t + 16) * D) + lane;
#pragma unroll
                for (int j = 0; j < 4; ++j) yq[i][j] = yr[64 * j]; }
            const float mean = wave_sum(s) * (1.f / D); float s2 = 0.f;
#pragma unroll
            for (int j = 0; j < 4; ++j) { v[j] = v[j] - mean; s2 += (v[j].x * v[j].x + v[j].y * v[j].y) + (v[j].z * v[j].z + v[j].w * v[j].w); }
            const float rstd = rsqrtf(wave_sum(s2) * (1.f / D) + LN_EPS);
            GAS unsigned* o8 = XB8 + (size_t)t * (D / 4) + lane;
#pragma unroll
            for (int j = 0; j < 4; ++j) { const f32x4 y = v[j] * rstd * g1v[j] + b1v[j];
                o8[64 * j] = pk4_fp8(y.x, y.y, y.z, y.w);
                const unsigned h0 = f2bf(y.x), h1 = f2bf(y.y), h2 = f2bf(y.z), h3 = f2bf(y.w);
                const u64 hp = (u64)(h0 | (h1 << 16)) | ((u64)(h2 | (h3 << 16)) << 32); xr1[64 * j] = hp;
                const float r0 = y.x - __builtin_bit_cast(float, h0 << 16), r1 = y.y - __builtin_bit_cast(float, h1 << 16), r2 = y.z - __builtin_bit_cast(float, h2 << 16), r3 = y.w - __builtin_bit_cast(float, h3 << 16);
                *(LAS u64*)(XH + tl * XROW + (lane + 64 * j) * 8) = hp;
                *(LAS u64*)(XL + tl * XROW + (lane + 64 * j) * 8) = (u64)pk2(r0, r1) | ((u64)pk2(r2, r3) << 32); } }
        __syncthreads();
        f32x4 acc[2]; acc[0] = (f32x4){0.f, 0.f, 0.f, 0.f}; acc[1] = acc[0];
#pragma unroll
        for (int st = 0; st < 4; ++st) { const int boff = (lane & 15) * XROW + (wave * 128 + st * 32 + (lane >> 4) * 8) * 2;
            const bf16x8 bh = *(const LAS bf16x8*)(XH + boff), bl = *(const LAS bf16x8*)(XL + boff);
#pragma unroll
            for (int hf = 0; hf < 2; ++hf) { acc[hf] = __builtin_amdgcn_mfma_f32_16x16x32_bf16(wh[st][hf], bh, acc[hf], 0, 0, 0); acc[hf] = __builtin_amdgcn_mfma_f32_16x16x32_bf16(wh[st][hf], bl, acc[hf], 0, 0, 0);
                acc[hf] = __builtin_amdgcn_mfma_f32_16x16x32_bf16(wl[st][hf], bh, acc[hf], 0, 0, 0); } }
#pragma unroll
        for (int hf = 0; hf < 2; ++hf)
#pragma unroll
            for (int r = 0; r < 4; ++r) part[((wave * 2 + hf) * 16 + 4 * (lane >> 4) + r) * 16 + (lane & 15)] = acc[hf][r];
        __syncthreads();
        { const int tl = tid >> 5, e = tid & 31, t = t0 + tl; float lg = rb_e;
#pragma unroll
            for (int w = 0; w < 8; ++w) lg += part[((w * 2 + (e >> 4)) * 16 + (e & 15)) * 16 + tl];
            lgs[tl * 32 + e] = lg;
            LDS_WAIT(); asm volatile("" ::: "memory");
            int rank = 0;
#pragma unroll
            for (int q = 0; q < 8; ++q) { const f32x4 o = *(const LAS f32x4*)(lgs + tl * 32 + 4 * q);
#pragma unroll
                for (int i = 0; i < 4; ++i) { const int eo = 4 * q + i; rank += (o[i] > lg || (o[i] == lg && eo < e)) ? 1 : 0; } }
            if (rank < 4) { top[tl * 4 + rank] = lg; __hip_atomic_fetch_add(cnt + ((g * 16 + tl) >> 3) * 32 + e, 1, __ATOMIC_RELAXED, __HIP_MEMORY_SCOPE_WORKGROUP); }
            LDS_WAIT(); asm volatile("" ::: "memory");
            const f32x4 sv = *(const LAS f32x4*)(top + tl * 4);
            const float e1 = expf(sv[1] - sv[0]), e2 = expf(sv[2] - sv[0]), e3 = expf(sv[3] - sv[0]); const float inv = 1.f / (1.f + e1 + e2 + e3);
            if (rank < 4) { const float gk = (rank == 0 ? 1.f : rank == 1 ? e1 : rank == 2 ? e2 : e3) * inv; TOPE[4 * t + rank] = e; GATE[4 * t + rank] = gk; } }
    }
    __syncthreads();
    if (tid < 256) CNTW[(F.vcu * NWAVES + (tid >> 5)) * NE + (tid & 31)] = cnt[tid];
    __syncthreads();
}

__device__ __forceinline__ void p_gather(Frame& F, int l) {
    const int gw = F.vcu * NWAVES + F.wave, NGW = F.G * NWAVES, lane = F.lane, tid = F.tid;
    const int TPW = T / NGW, NIT = TPW * 4;
    const GAS int* CNTW = (const GAS int*)(F.ws + WS_CNTW);
    LAS int* red = (LAS int*)F.lds;
    LAS int* baseE = red + 1024; LAS int* totE = baseE + 32;
    { const int e = tid & 31, part = tid >> 5, first = F.vcu * NWAVES; int sb = 0, st = 0;
        for (int g0 = part; g0 < NGW; g0 += 256) { int c[16];
#pragma unroll
            for (int k = 0; k < 16; ++k) c[k] = g0 + 16 * k < NGW ? CNTW[(g0 + 16 * k) * NE + e] : 0;
#pragma unroll
            for (int k = 0; k < 16; ++k) { st += c[k]; sb += g0 + 16 * k < first ? c[k] : 0; } }
        red[part * 32 + e] = sb; red[512 + part * 32 + e] = st; }
    __syncthreads();
    if (tid < 32) { int sb = 0, st = 0;
#pragma unroll
        for (int p = 0; p < 16; ++p) { sb += red[p * 32 + tid]; st += red[512 + p * 32 + tid]; }
        baseE[tid] = sb; totE[tid] = st;
        if (F.vcu == 0) __hip_atomic_store(F.ctl + CW_CNT + 64 * l + tid, (unsigned)st, RLX_AGENT); }
    __syncthreads();
    int mybase = 0, tot = 0;
    if (lane < NE) { mybase = baseE[lane]; tot = totE[lane]; int cw[NWAVES - 1];
#pragma unroll
        for (int w = 0; w < NWAVES - 1; ++w) cw[w] = CNTW[(F.vcu * NWAVES + w) * NE + lane];
#pragma unroll
        for (int w = 0; w < NWAVES - 1; ++w) mybase += w < F.wave ? cw[w] : 0; }
    const int mt = (tot + 255) >> 8; int incl = mt;
#pragma unroll
    for (int o = 1; o < 64; o <<= 1) { const int v = __shfl_up(incl, o); if (lane >= o) incl += v; }
    const int pstart = (incl - mt) * 256;
    const GAS int* TOPE = (const GAS int*)(F.ws + WS_ROUTE); GAS int* ROWOF = (GAS int*)(F.ws + WS_ROUTE) + 12 * T; GAS int* ROWTOK = (GAS int*)(F.ws + WS_XS);
    if (F.vcu < NE && F.wave == 0) {
        const int e = F.vcu; const int ps = __builtin_amdgcn_readlane(pstart, e), te = __builtin_amdgcn_readlane(tot, e), me = __builtin_amdgcn_readlane(mt, e);
        for (int i = te + lane; i < me * 256; i += 64) ROWTOK[ps + i] = 0; }
    const int it0 = gw * NIT; const int ei = lane < NIT ? TOPE[it0 + lane] : 0; int rk = 0;
    for (int j = 0; j < NIT; ++j) { const int ej = __shfl(ei, j); rk += (j < lane && ej == ei) ? 1 : 0; }
    const int row = __shfl(pstart, ei) + __shfl(mybase, ei) + rk;
    if (lane < NIT) { ROWOF[it0 + lane] = row; ROWTOK[row] = (it0 + lane) >> 2; }
    __syncthreads();
}

__device__ __forceinline__ void p_combine(Frame& F, const In6& A, int l, float* xout_) {
    constexpr int TPW = 8;
    const int gw = F.vcu * NWAVES + F.wave, NGW = F.G * NWAVES, lane = F.lane;
    const GAS int* ROWOF = (const GAS int*)(F.ws + WS_ROUTE) + 12 * T; const GAS float* GATE = (const GAS float*)(F.ws + WS_ROUTE) + 8 * T;
    const GAS bf16* X1B = (const GAS bf16*)(F.ws + WS_Y1 + 32 * MiB); const GAS bf16* YS = (const GAS bf16*)(F.ws + WS_YS); GAS bf16* XB = (GAS bf16*)(F.ws + WS_XB);
    GAS float* xout = (GAS float*)xout_;
    const GAS f32x4* g2 = (const GAS f32x4*)(A.p[0] + l * D) + lane; const GAS f32x4* b2 = (const GAS f32x4*)(A.p[1] + l * D) + lane;
    int rowv = 0; float gatev = 0.f;
    if (lane < 4 * TPW) { const int tk = gw + (lane >> 2) * NGW; rowv = ROWOF[4 * tk + (lane & 3)]; gatev = GATE[4 * tk + (lane & 3)]; }
    f32x4 gg[4], bb[4];
#pragma unroll
    for (int j = 0; j < 4; ++j) { gg[j] = g2[64 * j]; bb[j] = b2[64 * j]; }
    v2u xq[2][4], yq[2][4][4];
#define CMB_ISSUE(k, bf) do { const int t_ = gw + (k) * NGW; const GAS v2u* xr_ = (const GAS v2u*)(X1B + (size_t)t_ * D) + lane; \
        _Pragma("unroll") for (int j = 0; j < 4; ++j) xq[bf][j] = xr_[64 * j]; \
        _Pragma("unroll") for (int c = 0; c < 4; ++c) { const int row_ = __builtin_amdgcn_readlane(rowv, 4 * (k) + c); const GAS v2u* yr_ = (const GAS v2u*)(YS + (size_t)row_ * D) + lane; \
            _Pragma("unroll") for (int j = 0; j < 4; ++j) yq[bf][c][j] = yr_[64 * j]; } } while (0)
    CMB_ISSUE(0, 0);
#pragma unroll
    for (int k = 0; k < TPW; ++k) {
        const int bf = k & 1, t = gw + k * NGW;
        if (k + 1 < TPW) { if (bf == 0) CMB_ISSUE(k + 1, 1); else CMB_ISSUE(k + 1, 0); }
        f32x4 v[4];
#pragma unroll
        for (int j = 0; j < 4; ++j) { const v2u q = xq[bf][j]; v[j] = (f32x4){bflo(q.x), bfhi(q.x), bflo(q.y), bfhi(q.y)} * DN_ALPHA; }
#pragma unroll
        for (int c = 0; c < 4; ++c) { const float gk = __builtin_bit_cast(float, __builtin_amdgcn_readlane(__builtin_bit_cast(int, gatev), 4 * k + c));
#pragma unroll
            for (int j = 0; j < 4; ++j) { const v2u w = yq[bf][c][j]; v[j].x += gk * bflo(w.x); v[j].y += gk * bfhi(w.x); v[j].z += gk * bflo(w.y); v[j].w += gk * bfhi(w.y); } }
        float s = 0.f;
#pragma unroll
        for (int j = 0; j < 4; ++j) s += (v[j].x + v[j].y) + (v[j].z + v[j].w);
        const float mean = wave_sum(s) * (1.f / D); float s2 = 0.f;
#pragma unroll
        for (int j = 0; j < 4; ++j) { v[j] = v[j] - mean; s2 += (v[j].x * v[j].x + v[j].y * v[j].y) + (v[j].z * v[j].z + v[j].w * v[j].w); }
        const float rstd = rsqrtf(wave_sum(s2) * (1.f / D) + LN_EPS);
        GAS f32x4* orow = (GAS f32x4*)(xout + (size_t)t * D) + lane; GAS u64* o8 = (GAS u64*)(XB + (size_t)t * D) + lane;
#pragma unroll
        for (int j = 0; j < 4; ++j) { const f32x4 y = v[j] * rstd * gg[j] + bb[j];
            if (xout_) __builtin_nontemporal_store(y, orow + 64 * j); else o8[64 * j] = (u64)pk2(y.x, y.y) | ((u64)pk2(y.z, y.w) << 32); }
        __builtin_amdgcn_sched_barrier(0);
    }
#undef CMB_ISSUE
}


#define NI __device__ __forceinline__
NI void ph_prologue(unsigned char* ws, LAS unsigned char* lds, const float* a0, const float* a1, const float* a2, const float* a3, const float* a4) { Frame F = make_frame(ws, lds); In6 I{{uni(a0), uni(a1), uni(a2), uni(a3), uni(a4), nullptr}}; p_prologue(F, I); }
NI void ph_local(unsigned char* ws, LAS unsigned char* lds, int l, const float* a0, const float* a1, const float* a2, const float* a3, const float* a4) { Frame F = make_frame(ws, lds); In6 I{{uni(a0), uni(a1), uni(a2), uni(a3), uni(a4), nullptr}}; p_local(F, I, __builtin_amdgcn_readfirstlane(l)); }
NI void ph_scores(unsigned char* ws, LAS unsigned char* lds) { Frame F = make_frame(ws, lds); p_index(F); }
NI void ph_attn(unsigned char* ws, LAS unsigned char* lds) { Frame F = make_frame(ws, lds); p_attn_dense(F); }
NI void ph_router(unsigned char* ws, LAS unsigned char* lds, int l, const float* a0, const float* a1, const float* a2, const float* a3) { Frame F = make_frame(ws, lds); In6 I{{uni(a0), uni(a1), uni(a2), uni(a3), nullptr, nullptr}}; p_router(F, I, __builtin_amdgcn_readfirstlane(l)); }
NI void ph_gather(unsigned char* ws, LAS unsigned char* lds, int l) { Frame F = make_frame(ws, lds); p_gather(F, __builtin_amdgcn_readfirstlane(l)); }
NI void ph_combine(unsigned char* ws, LAS unsigned char* lds, int l, const float* a0, const float* a1, float* xout) { Frame F = make_frame(ws, lds); In6 I{{uni(a0), uni(a1), nullptr, nullptr, nullptr, nullptr}}; p_combine(F, I, __builtin_amdgcn_readfirstlane(l), (float*)uni(xout)); }

NI void ph_gemm_in(unsigned char* ws, LAS unsigned char* lds, int l_) {
    Frame F = make_frame(ws, lds); const int l = __builtin_amdgcn_readfirstlane(l_);
    pg8::Gemm g{WSP(bf16, WS_XB), WSP(bf16, WS_WIN) + (size_t)l * NINP * D, T, NINP, D}; pg8::StaticOrder S; S.init(T, NINP, F.G, (int)blockIdx.x);
    pg8::EpiBf16<0> E{WSP(bf16, WS_PROJ), NINP, nullptr, 0, 0, 1.f};
    pg8::gemm_phase<pg8::EpiBf16<0>, pg8::StaticOrder, PG8_ALIGN, PG8_SP2>(F.lds, g, S, E);
}
NI void ph_gemm_out(unsigned char* ws, LAS unsigned char* lds, int l_, const float* xin) {
    Frame F = make_frame(ws, lds); const int l = __builtin_amdgcn_readfirstlane(l_);
    pg8::Gemm g{WSP(bf16, WS_CAT), WSP(bf16, WS_WOUT) + (size_t)l * D * D, T, D, D}; pg8::StaticOrder S; S.init(T, D, F.G, (int)blockIdx.x);
    EpiResid E{WSP(bf16, WS_XB), WSP(bf16, WS_Y1), DN_ALPHA};
    pg8::gemm_phase<EpiResid, pg8::StaticOrder, PG8_ALIGN, PG8_SP2>(F.lds, g, S, E);
}
NI void ph_gemm_moe1(unsigned char* ws, LAS unsigned char* lds, int l_, const float* bgu) {
    Frame F = make_frame(ws, lds); const int l = __builtin_amdgcn_readfirstlane(l_);
    const int nun = moe_table(F, l, 8);
    pg8::Gemm g{WSP(bf16, WS_XB8), (const bf16*)(WSP(unsigned char, WS_WGU) + (size_t)l * NE * 2048 * D * 2), MAXROWS, NE * 2048, D};
    MoeSched S{(const LAS int*)(F.lds + TAB_OFF), nun};
    EpiSwiglu E{WSP(unsigned char, WS_ACT), uni(bgu) + (size_t)l * NE * 2048};
    pg8::gemm_phase<EpiSwiglu, MoeSched, PG8_ALIGN, true, 1, true>(F.lds, g, S, E, WSP(int, WS_XS));
}
NI void ph_gemm_moe2(unsigned char* ws, LAS unsigned char* lds, int l_, const float* bdn) {
    Frame F = make_frame(ws, lds); const int l = __builtin_amdgcn_readfirstlane(l_);
    const int nun = moe_table(F, l, 4);
    pg8::Gemm g{WSP(bf16, WS_ACT), (const bf16*)(WSP(unsigned char, WS_WDN) + (size_t)l * NE * D * D * 2), MAXROWS, NE * D, D};
    MoeSched S{(const LAS int*)(F.lds + TAB_OFF), nun};
    EpiDown E{WSP(bf16, WS_YS), uni(bdn) + (size_t)l * NE * D};
    pg8::gemm_phase<EpiDown, MoeSched, PG8_ALIGN, MOE_SP2, 1>(F.lds, g, S, E);
}

__device__ __forceinline__ const float* karg_in(int i) { return ((const float* const volatile*)__builtin_amdgcn_kernarg_segment_ptr())[i]; }
__device__ __forceinline__ float* karg_out() { return ((float* const volatile*)__builtin_amdgcn_kernarg_segment_ptr())[N_IN]; }
#ifndef PHMASK
#define PHMASK 0x7FF
#endif
constexpr int PH_PER_LAYER = 10, N_PHASES = 1 + DEPTH * PH_PER_LAYER;
#define IN(k) (lo <= (k) && (k) < hi)
#define SEAM(k) do { if (IN(k) && IN((k) + 1)) xcd_barrier(bar); } while (0)
template <int l> __device__ __forceinline__ void layer_phases(Frame& F, const XcdBarrier& bar, int lo, int hi) {
        const int p0 = 1 + l * PH_PER_LAYER;
        const float* xin = nullptr;
        float* xout = l == DEPTH - 1 ? karg_out() : nullptr;
        if (((PHMASK >> 0) & 1) && IN(p0 + 0)) { asm volatile("; PHASE_BEGIN_0"); ph_gemm_in(F.ws, F.lds, l); SEAM(p0 + 0); }
        if (((PHMASK >> 1) & 1) && IN(p0 + 1)) { asm volatile("; PHASE_BEGIN_1"); ph_local(F.ws, F.lds, l, karg_in(IN_WPOOL), karg_in(IN_CONVW), karg_in(IN_PSCALE), karg_in(IN_KNG), karg_in(IN_KNB)); SEAM(p0 + 1); }
        if (((PHMASK >> 2) & 1) && IN(p0 + 2)) { asm volatile("; PHASE_BEGIN_2"); ph_scores(F.ws, F.lds); SEAM(p0 + 2); }
        if (((PHMASK >> 3) & 1) && IN(p0 + 3)) { asm volatile("; PHASE_BEGIN_3"); ph_attn(F.ws, F.lds); SEAM(p0 + 3); }
        if (((PHMASK >> 4) & 1) && IN(p0 + 4)) { asm volatile("; PHASE_BEGIN_4"); ph_gemm_out(F.ws, F.lds, l, xin); SEAM(p0 + 4); }
        if (((PHMASK >> 5) & 1) && IN(p0 + 5)) { asm volatile("; PHASE_BEGIN_5"); ph_router(F.ws, F.lds, l, karg_in(IN_LN1G), karg_in(IN_LN1B), karg_in(IN_RW), karg_in(IN_RB)); SEAM(p0 + 5); }
        if (((PHMASK >> 6) & 1) && IN(p0 + 6)) { asm volatile("; PHASE_BEGIN_6"); ph_gather(F.ws, F.lds, l); SEAM(p0 + 6); }
        if (((PHMASK >> 7) & 1) && IN(p0 + 7)) { asm volatile("; PHASE_BEGIN_7"); ph_gemm_moe1(F.ws, F.lds, l, karg_in(IN_BGU)); SEAM(p0 + 7); }
        if (((PHMASK >> 8) & 1) && IN(p0 + 8)) { asm volatile("; PHASE_BEGIN_8"); ph_gemm_moe2(F.ws, F.lds, l, karg_in(IN_BDN)); SEAM(p0 + 8); }
        if (((PHMASK >> 9) & 1) && IN(p0 + 9)) { asm volatile("; PHASE_BEGIN_9"); ph_combine(F.ws, F.lds, l, karg_in(IN_LN2G), karg_in(IN_LN2B), xout); SEAM(p0 + 9); }
}
#undef IN
#undef SEAM
__global__ void __launch_bounds__(NWAVES * 64, 2) fwd_kernel(Args A) {
    extern __shared__ __attribute__((aligned(16))) unsigned char lds[];
    Frame F;
    F.lds = (LAS unsigned char*)lds;
    F.tid = threadIdx.x; F.lane = F.tid & 63; F.wave = __builtin_amdgcn_readfirstlane(F.tid >> 6);
    F.G = gridDim.x; { const int bx = blockIdx.x; F.vcu = (F.G % 8 == 0) ? (bx % 8) * (F.G / 8) + bx / 8 : bx; }
    F.ws = A.ws; F.ctl = (gu32*)(A.ws + WS_CTL);
    volatile LAS unsigned* MISC = (volatile LAS unsigned*)(F.lds + MISC_OFF);
    if (F.tid < 32) MISC[F.tid] = 0u;
    __syncthreads();
    const int lo = A.ph_lo, hi = A.ph_hi;
    const bool multi = (hi - lo) > 1;
    XcdBarrier bar; bar.bar = (unsigned*)(F.ctl + CW_BAR); bar.x = 0; bar.st = nullptr;
    if (multi) bar = xcd_barrier_post((unsigned*)(F.ctl + CW_BAR), MISC + 8);
#define IN(k) (lo <= (k) && (k) < hi)
#define SEAM(k) do { if (IN(k) && IN((k) + 1)) xcd_barrier(bar); } while (0)

    if (((PHMASK >> 10) & 1) && IN(0)) { asm volatile("; PHASE_BEGIN_11"); ph_prologue(F.ws, F.lds, karg_in(IN_WIN), karg_in(IN_WOUT), karg_in(IN_WGU), karg_in(IN_WDN), karg_in(IN_X)); SEAM(0); }
    layer_phases<0>(F, bar, lo, hi);
    layer_phases<1>(F, bar, lo, hi);
#undef IN
#undef SEAM
}


#ifdef DUMP_OFF
__global__ void dump_kernel(const unsigned* w, size_t nwords, float* out, int n) {
    const int i = blockIdx.x * blockDim.x + threadIdx.x; if (i >= n) return;
#ifdef DUMP_NAN_ALL
    { bool bad = false; for (size_t j = (size_t)i; j < nwords; j += (size_t)n) { const unsigned x = w[j]; bad |= ((x & 0x7f80u) == 0x7f80u) || ((x & 0x7f800000u) == 0x7f800000u); } out[i] = bad ? 1e6f : 0.f; return; }
#endif
#ifdef DUMP_MASKCHECK
    { out[i] = 0.f; if ((i & 1023) == 0) { const int t = i >> 10, sq = t & 4095; const unsigned long long* mt = (const unsigned long long*)w + ((size_t)(t >> 12) * 64) * 4096 + sq; int pc = 0; bool beyond = false;
        for (int j = 0; j < 64; ++j) { const unsigned long long m = mt[(size_t)j * 4096]; pc += __popcll(m); for (int bb = 0; bb < 64; ++bb) if (((m >> bb) & 1ull) && 64 * j + bb > sq) beyond = true; }
        const int expect = sq + 1 < 256 ? sq + 1 : 256;
#if DUMP_MASKCHECK == 1
        if (pc != expect) out[i] = 1e6f;
#else
        if (beyond) out[i] = 1e6f;
#endif
      } return; }
#endif
#ifdef DUMP_NANCHECK
#if DUMP_NANCHECK == 2
    { size_t wi = (size_t)i;
#ifdef DUMP_ROWW
      wi = ((size_t)i / DUMP_COLW) * DUMP_ROWW + ((size_t)i % DUMP_COLW);
#endif
      if (wi >= nwords) { out[i] = 0.f; return; } const unsigned x = w[wi]; const bool bad = ((x & 0x7f80u) == 0x7f80u) || ((x & 0x7f800000u) == 0x7f800000u);
#ifdef DUMP_LOC
      { const int sq = (int)(wi / 512) & 4095; out[i] = bad ? 1000.f * (float)(DUMP_LOC == 1 ? sq + 1 : 4096 - sq) : 0.f; return; }
#endif
      out[i] = bad ? 1e6f : 0.f; return; }
#else
    { const float v = ((const float*)w)[i]; out[i] = (v == v && fabsf(v) < 1e30f) ? 0.f : 1e6f; return; }
#endif
#endif
#ifdef DUMP_VIA_ROWOF
    unsigned h; { const unsigned short* src = (const unsigned short*)w; const int* rowof = (const int*)((const char*)w - (size_t)(DUMP_OFF) + WS_ROUTE) + 12 * T; const int t = i >> 10, c = i & 1023;
        h = 0u; for (int k = 0; k < 4; ++k) h = h * 0x9E3779B1u + src[(size_t)rowof[4 * t + k] * 1024 + c]; }
#elif defined(DUMP_ROWW)
    unsigned h = 0u; { const size_t row = (size_t)i / DUMP_COLW, cw = (size_t)i % DUMP_COLW; if (row * DUMP_ROWW + cw < nwords) h = w[row * DUMP_ROWW + cw]; }
#else
    unsigned h = 0u; int k = 1; for (size_t j = (size_t)i; j < nwords; j += (size_t)n, k += 2) h ^= w[j] * (unsigned)k;
#endif
    out[i] = (float)((h ^ (h >> 11) ^ (h >> 22)) & 0xFFFFFu);
}
#endif
#ifndef MK_ONE_LAUNCH
#define MK_ONE_LAUNCH 0
#endif
extern "C" void kernel_launch(void* const* d_in, const int* in_sizes, int n_in, void* d_out, int out_size, void* d_ws, size_t ws_size, hipStream_t stream) {
    static int grid = 0;
    if (grid == 0) {
        if (n_in != N_IN || in_sizes[0] != T * D || out_size != T * D || ws_size < WS_END) { fprintf(stderr, "kernel_launch: unexpected shapes (n_in %d, in0 %d, out %d, ws %zu, need %zu); nothing launched\n", n_in, n_in > 0 ? in_sizes[0] : -1, out_size, ws_size, (size_t)WS_END); grid = -1; return; }
        int dev = 0, cus = 0, per_cu = 0;
        if (hipGetDevice(&dev) != hipSuccess || hipDeviceGetAttribute(&cus, hipDeviceAttributeMultiprocessorCount, dev) != hipSuccess) { grid = -1; return; }
        if (hipFuncSetAttribute((const void*)fwd_kernel, hipFuncAttributeMaxDynamicSharedMemorySize, LDS_BYTES) != hipSuccess) { fprintf(stderr, "kernel_launch: hipFuncSetAttribute failed\n"); grid = -1; return; }
        if (hipOccupancyMaxActiveBlocksPerMultiprocessor(&per_cu, (const void*)fwd_kernel, NWAVES * 64, LDS_BYTES) != hipSuccess || per_cu < 1) fprintf(stderr, "kernel_launch: occupancy query reports %d\n", per_cu);
        (void)hipGetLastError();
        grid = cus;
        if (grid != 256) { fprintf(stderr, "kernel_launch: built for 256 CUs, found %d; nothing launched\n", cus); grid = -1; return; }
    }
    if (grid < 0) return;
    if (hipMemsetAsync((char*)d_ws + WS_CTL, 0, CTL_ZERO_BYTES, stream) != hipSuccess) return;
    Args a{};
    for (int i = 0; i < N_IN; ++i) a.in[i] = (const float*)d_in[i];
    a.out = (float*)d_out; a.ws = (unsigned char*)d_ws;
#if MK_ONE_LAUNCH
    a.ph_lo = 0; a.ph_hi = N_PHASES;
    hipLaunchKernelGGL(fwd_kernel, dim3(grid), dim3(NWAVES * 64), LDS_BYTES, stream, a);
#else
#ifdef DUMP_OFF
    for (int p = 0; p < DUMP_STOP; ++p) { a.ph_lo = p; a.ph_hi = p + 1; hipLaunchKernelGGL(fwd_kernel, dim3(grid), dim3(NWAVES * 64), LDS_BYTES, stream, a); }
    hipLaunchKernelGGL(dump_kernel, dim3((T * D + 255) / 256), dim3(256), 0, stream, (const unsigned*)((const char*)d_ws + (size_t)(DUMP_OFF)), (size_t)(DUMP_WORDS), (float*)d_out, T * D);
    return;
#endif
    for (int p = 0; p < N_PHASES; ++p) { a.ph_lo = p; a.ph_hi = p + 1; hipLaunchKernelGGL(fwd_kernel, dim3(grid), dim3(NWAVES * 64), LDS_BYTES, stream, a);
#ifdef DBL_PHASE
        if ((p == 0 && DBL_PHASE == 10) || (p > 0 && (p - 1) % PH_PER_LAYER == DBL_PHASE)) hipLaunchKernelGGL(fwd_kernel, dim3(grid), dim3(NWAVES * 64), LDS_BYTES, stream, a);
#endif
    }
#endif
}
```

```cpp
#include <hip/hip_runtime.h>
#include <cstdio>
#include <cstdint>

#define MK_ONE_LAUNCH 1
#define BAR_EARLY_INV 1
#ifndef WT_STORES
#define WT_STORES 0
#endif
__device__ __forceinline__ void st16_wt(void* p, unsigned x, unsigned y, unsigned z, unsigned w) {
    typedef unsigned u4_ __attribute__((ext_vector_type(4))); const u4_ v = {x, y, z, w};
#if WT_STORES
    asm volatile("global_store_dwordx4 %0, %1, off sc1\n\ts_nop 2" :: "v"((__attribute__((address_space(1))) void*)p), "v"(v) : "memory");
#else
    *(__attribute__((address_space(1))) u4_*)p = v;
#endif
}
__device__ __forceinline__ void st8_wt(void* p, unsigned x, unsigned y) {
    typedef unsigned u2_ __attribute__((ext_vector_type(2))); const u2_ v = {x, y};
#if WT_STORES
    asm volatile("global_store_dwordx2 %0, %1, off sc1" :: "v"((__attribute__((address_space(1))) void*)p), "v"(v) : "memory");
#else
    *(__attribute__((address_space(1))) u2_*)p = v;
#endif
}
namespace pg8 {
#define PG8_LAS __attribute__((address_space(3)))
typedef unsigned short bf16_t;
typedef short bf16x8 __attribute__((ext_vector_type(8)));
typedef float f32x4 __attribute__((ext_vector_type(4)));
typedef unsigned u32x4 __attribute__((ext_vector_type(4)));
typedef int v4i_t __attribute__((ext_vector_type(4)));
typedef int v8i_t __attribute__((ext_vector_type(8)));
constexpr int BM = 256, BK = 64, HALF = 128, HTB = HALF * BK * 2  , STAGE_BYTES = 8 * HTB, NXCD = 8, WGM = 8;

__host__ __device__ __forceinline__ int lds_byte(int r, int c) { const int st = (r >> 4) * 2 + (c >> 5), rr = r & 15, cc = c & 31, ob = rr * 64 + cc * 2; return st * 1024 + (ob ^ (((ob >> 9) & 1) << 5)); }
__host__ __device__ __forceinline__ void stage_rc(int b, int& R, int& C) { const int st = b / 1024, sb = b % 1024, swz = sb ^ (((sb >> 9) & 1) << 5); R = (st >> 1) * 16 + swz / 64; C = (st & 1) * 32 + (swz % 64) / 2; }
__host__ __device__ __forceinline__ int perm32(int rho) { const int n = rho >> 4, i = rho & 15; return 8 * (i >> 2) + 4 * n + (i & 3); }

struct Unit { int pm, pn; };
struct Gemm { const bf16_t* A; const bf16_t* Bt; int M, N, K; };

struct StaticOrder {
    int nM, nN, nwg, G, c;
    __host__ __device__ void init(int M, int N, int G_, int c_) { nM = M / BM; nN = N / BM; nwg = nM * nN; G = G_; c = c_; }
    __host__ __device__ bool next(int i, Unit& u) const {
        const long L = (long)i * G + c; if (L >= nwg) return false;
        int wgid = (int)L; { const int q = nwg / NXCD, r = nwg % NXCD, xcd = wgid % NXCD, off = wgid / NXCD; wgid = (xcd < r ? xcd * (q + 1) : r * (q + 1) + (xcd - r) * q) + off; }
        const int nig = WGM * nN, gid = wgid / nig, fm = gid * WGM, gsz = (nM - fm) < WGM ? (nM - fm) : WGM;
        u.pm = fm + ((wgid % nig) % gsz); u.pn = (wgid % nig) / gsz; return true;
    }
    __device__ __forceinline__ void a_ready(const Unit&) const {}
    __device__ __forceinline__ void done(const Unit&) const {}
};

__device__ __forceinline__ unsigned cvt_pk_bf16(float lo, float hi) { unsigned r; asm volatile("v_cvt_pk_bf16_f32 %0, %1, %2" : "=v"(r) : "v"(lo), "v"(hi)); return r; }
typedef float f32x2 __attribute__((ext_vector_type(2)));
__device__ __forceinline__ f32x2 gelu_pk(f32x2 v) {
    const f32x2 av = __builtin_elementwise_abs(v), d = av * 0.2316418882f + 1.0f;
    f32x2 t; t.x = __builtin_amdgcn_rcpf(d.x); t.y = __builtin_amdgcn_rcpf(d.y);
    f32x2 q = t * 0.5307027145f + (-0.7265760135f); q = q * t + 0.7107068705f; q = q * t + (-0.142248368f); q = q * t + 0.127414796f; q = q * t;
    const f32x2 s = (v * v) * (-0.72134752044f);
    f32x2 e; e.x = __builtin_amdgcn_exp2f(s.x); e.y = __builtin_amdgcn_exp2f(s.y);
    const f32x2 m = v * (q * e), r = v - m;
    f32x2 o; o.x = v.x < 0.f ? m.x : r.x; o.y = v.y < 0.f ? m.y : r.y; return o;
}

template <int ACT  > struct EpiBf16 {
    static constexpr bool PERM = true, AFTER_DRAIN = false; static_assert(ACT == 0 || ACT == 1, "EpiBf16: ACT is 0 (none) or 1 (gelu_pk)");
    bf16_t* O; int ldc; const float* bias; int split_cols; size_t split_stride; float scale0;
    __device__ __forceinline__ void operator()(const f32x4 (&acc)[2][2][4][2], const Unit& u, int wr, int wc, int fr, int fq) const {
        const int row0 = u.pm * BM + wr * 64 + fr; int colt = u.pn * BM; bf16_t* base = O;
        float sc = 1.f; if (split_cols) { const int t = colt / split_cols; base += (size_t)t * split_stride; colt -= t * split_cols; if (t == 0) sc = scale0; }
        const int col0 = colt + wc * 32 + 8 * fq, bcol0 = u.pn * BM + wc * 32 + 8 * fq;
        f32x4 bv[2][2];
#pragma unroll
        for (int bj = 0; bj < 2; ++bj)
#pragma unroll
            for (int n = 0; n < 2; ++n) bv[bj][n] = bias ? *(const __attribute__((address_space(1))) f32x4*)(bias + bcol0 + bj * HALF + 4 * n) : (f32x4){0.f, 0.f, 0.f, 0.f};
#pragma unroll
        for (int ai = 0; ai < 2; ++ai)
#pragma unroll
            for (int m = 0; m < 4; ++m) { bf16_t* rowp = base + (size_t)(row0 + ai * HALF + m * 16) * ldc + col0;
#pragma unroll
                for (int bj = 0; bj < 2; ++bj) { f32x4 v0 = acc[ai][bj][m][0] + bv[bj][0], v1 = acc[ai][bj][m][1] + bv[bj][1];
                    if (ACT == 1) { f32x2 a = gelu_pk((f32x2){v0[0], v0[1]}), b = gelu_pk((f32x2){v0[2], v0[3]}), c = gelu_pk((f32x2){v1[0], v1[1]}), d = gelu_pk((f32x2){v1[2], v1[3]});
                        v0 = (f32x4){a.x, a.y, b.x, b.y}; v1 = (f32x4){c.x, c.y, d.x, d.y}; }
                    v0 = v0 * sc; v1 = v1 * sc; u32x4 w; w.x = cvt_pk_bf16(v0[0], v0[1]); w.y = cvt_pk_bf16(v0[2], v0[3]); w.z = cvt_pk_bf16(v1[0], v1[1]); w.w = cvt_pk_bf16(v1[2], v1[3]);
                    st16_wt(rowp + bj * HALF, w.x, w.y, w.z, w.w); } }
    }
};

struct PanelStats {
    unsigned* xbuf;
    unsigned* cnt;
    unsigned* tmo;
    int ntn; float eps;
    unsigned code;
    __device__ __forceinline__ bool run(const f32x4 (&v)[2][2][4][2], const Unit& u, int wr, int wc, int fr, int fq, PG8_LAS unsigned char* lds, int wid, int lane) const {
        typedef float f32x2v __attribute__((ext_vector_type(2)));
        PG8_LAS f32x2v* P = (PG8_LAS f32x2v*)lds;
        PG8_LAS f32x2v* S = (PG8_LAS f32x2v*)(lds + 8192);
        PG8_LAS unsigned* flag = (PG8_LAS unsigned*)(lds + 8192 + 2048);
#pragma unroll
        for (int ai = 0; ai < 2; ++ai)
#pragma unroll
            for (int m = 0; m < 4; ++m) {
                float s = 0.f;
#pragma unroll
                for (int bj = 0; bj < 2; ++bj)
#pragma unroll
                    for (int n = 0; n < 2; ++n) { const f32x4 x = v[ai][bj][m][n]; s += (x[0] + x[1]) + (x[2] + x[3]); }
                s += __shfl_xor(s, 16); s += __shfl_xor(s, 32);
                const float mw = s * (1.0f / 64.0f); float q = 0.f;
#pragma unroll
                for (int bj = 0; bj < 2; ++bj)
#pragma unroll
                    for (int n = 0; n < 2; ++n) { const f32x4 d = v[ai][bj][m][n] - mw; q += (d[0] * d[0] + d[1] * d[1]) + (d[2] * d[2] + d[3] * d[3]); }
                q += __shfl_xor(q, 16); q += __shfl_xor(q, 32);
                if (fq == 0) P[(ai * HALF + wr * 64 + m * 16 + fr) * 4 + wc] = (f32x2v){mw, q};
            }
        asm volatile("s_waitcnt lgkmcnt(0)" ::: "memory"); __builtin_amdgcn_s_barrier(); asm volatile("" ::: "memory");
#if defined(BROKEN_EXCHANGE_NO_WAIT)
#warning BROKEN CONTROL BUILD: the row-statistics exchange does not wait; results are wrong by design
        if (blockIdx.x >= 64) { const long long t0_ = clock64(); while (clock64() - t0_ < 60000) __builtin_amdgcn_s_sleep(8); }
#endif
        const int row = wid * 32 + (lane & 31);
        if (lane < 32) {
            const f32x2v a = P[row * 4 + 0], b = P[row * 4 + 1], c = P[row * 4 + 2], d = P[row * 4 + 3];
            const float mt = (a.x + b.x + c.x + d.x) * 0.25f;
            const float da = a.x - mt, db = b.x - mt, dc = c.x - mt, dd = d.x - mt;
            const float m2 = (a.y + b.y) + (c.y + d.y) + 64.0f * ((da * da + db * db) + (dc * dc + dd * dd));
            unsigned long long* slot = (unsigned long long*)xbuf + ((size_t)(u.pm * BM + row) * 4 + u.pn);
            __hip_atomic_store(slot, ((unsigned long long)__float_as_uint(m2) << 32) | __float_as_uint(mt), __ATOMIC_RELAXED, __HIP_MEMORY_SCOPE_AGENT);
        }
        asm volatile("s_waitcnt vmcnt(0)" ::: "memory");
        if (lane == 0) __hip_atomic_fetch_add(cnt + 64 * u.pm, 1u, __ATOMIC_RELAXED, __HIP_MEMORY_SCOPE_AGENT);
        if (wid == 0) {
            bool dead = false; const unsigned long long t0 = __builtin_amdgcn_s_memrealtime(); const unsigned want = 8u * (unsigned)ntn;
            for (;;) {
#if defined(BROKEN_EXCHANGE_NO_WAIT)
                break;
#endif
                if ((unsigned)__builtin_amdgcn_readfirstlane(__hip_atomic_load(cnt + 64 * u.pm, __ATOMIC_RELAXED, __HIP_MEMORY_SCOPE_AGENT)) >= want) break;
                if (__builtin_amdgcn_s_memrealtime() - t0 > 2000000ull) {
                    if (lane == 0) { unsigned expect = 0u; __hip_atomic_compare_exchange_strong(tmo + 1, &expect, code | (unsigned)(u.pm & 0xff), __ATOMIC_RELAXED, __ATOMIC_RELAXED, __HIP_MEMORY_SCOPE_AGENT);
                                     __hip_atomic_store(tmo, 1u, __ATOMIC_RELAXED, __HIP_MEMORY_SCOPE_AGENT); }
                    dead = true; break; }
                __builtin_amdgcn_s_sleep(2);
            }
            __builtin_amdgcn_fence(__ATOMIC_ACQUIRE, "agent");
            if (lane == 0) flag[0] = dead ? 1u : 0u;
        }
        asm volatile("s_waitcnt vmcnt(0) lgkmcnt(0)" ::: "memory"); __builtin_amdgcn_s_barrier(); asm volatile("" ::: "memory");
        const bool bad = flag[0] != 0u;
        if (lane < 32) {
            const unsigned long long* slot = (const unsigned long long*)xbuf + (size_t)(u.pm * BM + row) * 4; float mt[4], m2[4]; float ms = 0.f;
#pragma unroll
            for (int t = 0; t < 4; ++t) { if (t < ntn) { const unsigned long long w = __hip_atomic_load(slot + t, __ATOMIC_RELAXED, __HIP_MEMORY_SCOPE_AGENT); mt[t] = __uint_as_float((unsigned)w); m2[t] = __uint_as_float((unsigned)(w >> 32)); } else { mt[t] = 0.f; m2[t] = 0.f; } ms += mt[t]; }
            const float mean = ms / (float)ntn; float q = 0.f;
#pragma unroll
            for (int t = 0; t < 4; ++t) if (t < ntn) { const float dm = mt[t] - mean; q += m2[t] + 256.0f * dm * dm; }
            S[row] = (f32x2v){mean, 1.0f / sqrtf(q / (256.0f * (float)ntn) + eps)};
        }
        asm volatile("s_waitcnt lgkmcnt(0)" ::: "memory"); __builtin_amdgcn_s_barrier(); asm volatile("" ::: "memory");
        return bad;
    }
};
struct EpiLnRes {
    static constexpr bool PERM = false, AFTER_DRAIN = true;
    const float* base; float* out; int ldc; const float* bias; PanelStats st; unsigned poison;
    __device__ __forceinline__ void fused(f32x4 (&acc)[2][2][4][2], const Unit& u, int wr, int wc, int fr, int fq, PG8_LAS unsigned char* lds, int wid, int lane) const {
        typedef float f32x2v __attribute__((ext_vector_type(2)));
        const PG8_LAS f32x2v* S = (const PG8_LAS f32x2v*)(lds + 8192);
        const int col0 = u.pn * BM + wc * 32 + 4 * fq;
#pragma unroll
        for (int bj = 0; bj < 2; ++bj)
#pragma unroll
            for (int n = 0; n < 2; ++n) { const f32x4 bv = bias ? *(const f32x4*)(bias + col0 + bj * HALF + n * 16) : (f32x4){0.f, 0.f, 0.f, 0.f};
#pragma unroll
                for (int ai = 0; ai < 2; ++ai)
#pragma unroll
                    for (int m = 0; m < 4; ++m) acc[ai][bj][m][n] += bv; }
        f32x4 pre[4][2][2];
#pragma unroll
        for (int m = 0; m < 4; ++m) { const size_t off = (size_t)(u.pm * BM + wr * 64 + m * 16 + fr) * ldc + col0;
#pragma unroll
            for (int bj = 0; bj < 2; ++bj)
#pragma unroll
                for (int n = 0; n < 2; ++n) pre[m][bj][n] = *(const f32x4*)(base + off + bj * HALF + n * 16); }
        const bool bad = st.run(acc, u, wr, wc, fr, fq, lds, wid, lane) || poison != 0u;
        const float qnan = __builtin_nanf("");
#pragma unroll
        for (int ai = 0; ai < 2; ++ai)
#pragma unroll
            for (int m = 0; m < 4; ++m) { const int r = ai * HALF + wr * 64 + m * 16 + fr; const f32x2v sr = S[r]; const size_t off = (size_t)(u.pm * BM + r) * ldc + col0;
#pragma unroll
                for (int bj = 0; bj < 2; ++bj)
#pragma unroll
                    for (int n = 0; n < 2; ++n) { const f32x4 bs = ai == 0 ? pre[m][bj][n] : *(const f32x4*)(base + off + bj * HALF + n * 16); f32x4 o = bs + (acc[ai][bj][m][n] - sr.x) * sr.y;
                        if (bad) o = (f32x4){qnan, qnan, qnan, qnan}; *(f32x4*)(out + off + bj * HALF + n * 16) = o; }
                if (m & 1) asm volatile("" ::: "memory"); }
    }
};
struct EpiLnResLn {
    static constexpr bool PERM = false, AFTER_DRAIN = true;
    const float* base; float* out; bf16_t* xn; int ldc; const float* bias; PanelStats st1, st2; unsigned poison;
    __device__ __forceinline__ void fused(f32x4 (&acc)[2][2][4][2], const Unit& u, int wr, int wc, int fr, int fq, PG8_LAS unsigned char* lds, int wid, int lane) const {
        typedef float f32x2v __attribute__((ext_vector_type(2))); typedef unsigned u32x2v __attribute__((ext_vector_type(2)));
        const PG8_LAS f32x2v* S = (const PG8_LAS f32x2v*)(lds + 8192);
        const int col0 = u.pn * BM + wc * 32 + 4 * fq;
#pragma unroll
        for (int bj = 0; bj < 2; ++bj)
#pragma unroll
            for (int n = 0; n < 2; ++n) { const f32x4 bv = bias ? *(const f32x4*)(bias + col0 + bj * HALF + n * 16) : (f32x4){0.f, 0.f, 0.f, 0.f};
#pragma unroll
                for (int ai = 0; ai < 2; ++ai)
#pragma unroll
                    for (int m = 0; m < 4; ++m) acc[ai][bj][m][n] += bv; }
        bool bad = st1.run(acc, u, wr, wc, fr, fq, lds, wid, lane) || poison != 0u;
        const float qnan = __builtin_nanf("");
#pragma unroll
        for (int ai = 0; ai < 2; ++ai)
#pragma unroll
            for (int m = 0; m < 4; ++m) { const int r = ai * HALF + wr * 64 + m * 16 + fr; const f32x2v sr = S[r]; const size_t off = (size_t)(u.pm * BM + r) * ldc + col0;
#pragma unroll
                for (int bj = 0; bj < 2; ++bj)
#pragma unroll
                    for (int n = 0; n < 2; ++n) { const f32x4 bs = *(const f32x4*)(base + off + bj * HALF + n * 16); acc[ai][bj][m][n] = bs + (acc[ai][bj][m][n] - sr.x) * sr.y; }
                asm volatile("" : "+v"(acc[ai][0][m][0]), "+v"(acc[ai][0][m][1]), "+v"(acc[ai][1][m][0]), "+v"(acc[ai][1][m][1]));
                if (m & 1) asm volatile("" ::: "memory"); }
        const bool bad1 = bad;
        bad = st2.run(acc, u, wr, wc, fr, fq, lds, wid, lane) || bad;
#pragma unroll
        for (int ai = 0; ai < 2; ++ai)
#pragma unroll
            for (int m = 0; m < 4; ++m) { const int r = ai * HALF + wr * 64 + m * 16 + fr; const f32x2v sr = S[r]; const size_t off = (size_t)(u.pm * BM + r) * ldc + col0;
#pragma unroll
                for (int bj = 0; bj < 2; ++bj)
#pragma unroll
                    for (int n = 0; n < 2; ++n) { const f32x4 x1 = acc[ai][bj][m][n]; *(f32x4*)(out + off + bj * HALF + n * 16) = bad1 ? (f32x4){qnan, qnan, qnan, qnan} : x1;
                        const f32x4 o = (x1 - sr.x) * sr.y; u32x2v w; w.x = cvt_pk_bf16(o[0], o[1]); w.y = cvt_pk_bf16(o[2], o[3]);
                        if (bad) { w.x = 0x7fc07fc0u; w.y = 0x7fc07fc0u; } *(u32x2v*)(xn + off + bj * HALF + n * 16) = w; }
                asm volatile("" ::: "memory"); }
    }
};

__device__ __forceinline__ void glds_saddr(unsigned voff, const char* sbase, unsigned lds_dst) { unsigned keep;
    asm volatile("s_mov_b32 %0, m0\n\ts_mov_b32 m0, %3\n\ts_nop 0\n\tglobal_load_lds_dwordx4 %1, %2\n\ts_mov_b32 m0, %0" : "=&s"(keep) : "v"(voff), "s"(sbase), "s"(lds_dst) : "memory"); }
template <class Epi, class Sched, bool ALIGN_EPI = false, bool SP2 = false, int EB = 2, bool GATHER = false>
__device__ __forceinline__ void gemm_phase(PG8_LAS unsigned char* lds, const Gemm g, const Sched& S, const Epi& E, const int* rowtok = nullptr) {
    static_assert(!GATHER || (EB == 1 && SP2), "gathered A rows: fp8 path (SGPR-base staging) with the two-super-phase loop only");
    const int tid = threadIdx.x, wid = __builtin_amdgcn_readfirstlane(tid >> 6), lane = tid & 63, wr = wid >> 2, wc = wid & 3, fr = lane & 15, fq = lane >> 4;
    const int K = g.K, nt = K * EB / (BK * 2);
    unsigned voffA[2], voffB[2]; int gR[2]; unsigned gC[2];
#pragma unroll
    for (int i = 0; i < 2; ++i) { int R, C; stage_rc(tid * 16 + i * 8192, R, C); const int Rb = Epi::PERM ? ((R & ~31) + perm32(R & 31)) : R;
        voffA[i] = (unsigned)(R * K * EB + C * 2); voffB[i] = (unsigned)(Rb * K * EB + C * 2); gR[i] = R; gC[i] = (unsigned)(C * 2); }
    const size_t kstep = (size_t)(BK * 2);
    const size_t hstep = (size_t)HALF * K * EB;
    const size_t tstep = 2 * hstep;
    const unsigned ldsw = (unsigned)wid * 1024u; const unsigned lds0 = (unsigned)(uintptr_t)lds;
    const int aoff = lds_byte(wr * 64 + fr, fq * 8), boff = lds_byte(wc * 32 + fr, fq * 8);
#define PG8_SA(b, h) (((b) * 2 + (h)) * HTB)
#define PG8_SB(b, h) ((4 + (b) * 2 + (h)) * HTB)
#define PG8_STAGE(bufoff, gbase, voff) do { if constexpr (EB == 2) { _Pragma("unroll") for (int _i = 0; _i < 2; ++_i) \
        __builtin_amdgcn_global_load_lds((const unsigned*)((const char*)(gbase) + (voff)[_i]), (PG8_LAS unsigned*)(lds + (bufoff) + ldsw + _i * 8192), 16, 0, 0); } \
        else { _Pragma("unroll") for (int _i = 0; _i < 2; ++_i) glds_saddr((voff)[_i], (const char*)(gbase), (unsigned)__builtin_amdgcn_readfirstlane((int)(lds0 + (unsigned)(bufoff) + ldsw + (unsigned)(_i * 8192)))); } } while (0)
#define PG8_GLOAD(vo, u) do { _Pragma("unroll") for (int _h = 0; _h < 2; ++_h) _Pragma("unroll") for (int _i = 0; _i < 2; ++_i) vo[_h][_i] = (unsigned)rowtok[(size_t)(u).pm * BM + _h * HALF + gR[_i]] * (unsigned)(K * EB) + gC[_i]; } while (0)
#define PG8_STAGE_A(bufoff, pplain, kofs, h, VS) do { if constexpr (!GATHER) { PG8_STAGE(bufoff, pplain, voffA); } else { _Pragma("unroll") for (int _i = 0; _i < 2; ++_i) \
        glds_saddr(VS[h][_i], (const char*)g.A + (kofs), (unsigned)__builtin_amdgcn_readfirstlane((int)(lds0 + (unsigned)(bufoff) + ldsw + (unsigned)(_i * 8192)))); } } while (0)
#define PG8_LD8(p) __builtin_shufflevector(*(const PG8_LAS v4i_t*)(p), *(const PG8_LAS v4i_t*)((p) + 1024), 0, 1, 2, 3, 4, 5, 6, 7)
#define PG8_LDA(dst, b, h) do { if constexpr (EB == 2) { _Pragma("unroll") for (int m = 0; m < 4; ++m) _Pragma("unroll") for (int k = 0; k < 2; ++k) dst[m][k] = *(const PG8_LAS bf16x8*)(lds + PG8_SA(b, h) + aoff + m * 2048 + k * 1024); } \
        else { _Pragma("unroll") for (int m = 0; m < 4; ++m) dst##8[m] = PG8_LD8(lds + PG8_SA(b, h) + aoff + m * 2048); } } while (0)
#define PG8_LDB(dst, b, h) do { if constexpr (EB == 2) { _Pragma("unroll") for (int n = 0; n < 2; ++n) _Pragma("unroll") for (int k = 0; k < 2; ++k) dst[n][k] = *(const PG8_LAS bf16x8*)(lds + PG8_SB(b, h) + boff + n * 2048 + k * 1024); } \
        else { _Pragma("unroll") for (int n = 0; n < 2; ++n) dst##8[n] = PG8_LD8(lds + PG8_SB(b, h) + boff + n * 2048); } } while (0)
#define PG8_CAT8(x, y) __builtin_shufflevector(__builtin_bit_cast(v4i_t, x), __builtin_bit_cast(v4i_t, y), 0, 1, 2, 3, 4, 5, 6, 7)
#define PG8_MMA(ai, bj, At, Bt) do { __builtin_amdgcn_s_setprio(1); if constexpr (EB == 2) { _Pragma("unroll") for (int m = 0; m < 4; ++m) _Pragma("unroll") for (int n = 0; n < 2; ++n) _Pragma("unroll") for (int k = 0; k < 2; ++k) \
        acc[ai][bj][m][n] = __builtin_amdgcn_mfma_f32_16x16x32_bf16(Bt[n][k], At[m][k], acc[ai][bj][m][n], 0, 0, 0); } else { _Pragma("unroll") for (int m = 0; m < 4; ++m) _Pragma("unroll") for (int n = 0; n < 2; ++n) \
        asm volatile("v_mfma_scale_f32_16x16x128_f8f6f4 %0, %1, %2, %0, %3, %3 op_sel_hi:[0,0,0]" : "+v"(acc[ai][bj][m][n]) : "v"(Bt##8[n]), "v"(At##8[m]), "v"(mx_one)); }     __builtin_amdgcn_s_setprio(0); } while (0)
#define PG8_WAIT_V(n) asm volatile("s_waitcnt vmcnt(" #n ")" ::: "memory")
#define PG8_WAIT_L(n) asm volatile("s_waitcnt lgkmcnt(" #n ")" ::: "memory")
#define PG8_BAR __builtin_amdgcn_s_barrier()
#define PG8_SCHED __builtin_amdgcn_sched_barrier(0)
    Unit cur, nxt; int ui = 0;
    if (!S.next(0, cur)) return;
    f32x4 acc[2][2][4][2];
#pragma unroll
    for (int a = 0; a < 2; ++a)
#pragma unroll
        for (int b = 0; b < 2; ++b)
#pragma unroll
            for (int m = 0; m < 4; ++m)
#pragma unroll
                for (int n = 0; n < 2; ++n) acc[a][b][m][n] = (f32x4){0.f, 0.f, 0.f, 0.f};
    const int mx_one = 0x7f7f7f7f;
    bf16x8 At[4][2], B0[2][2], B1[2][2]; v8i_t At8[4], B08[2], B18[2];
    const char* cA = (const char*)g.A + (size_t)cur.pm * tstep; const char* cB = (const char*)g.Bt + (size_t)cur.pn * tstep;
    S.a_ready(cur);
    unsigned voffC[2][2], voffN[2][2];
    if constexpr (GATHER) PG8_GLOAD(voffC, cur);
    if constexpr (SP2) {
        PG8_STAGE(PG8_SB(0, 0), cB, voffB); PG8_STAGE(PG8_SB(0, 1), cB + hstep, voffB); PG8_STAGE_A(PG8_SA(0, 0), cA, 0, 0, voffC); PG8_STAGE_A(PG8_SA(0, 1), cA + hstep, 0, 1, voffC);
        if (wr == 1) PG8_BAR;
        PG8_WAIT_V(2); PG8_BAR;
        PG8_STAGE(PG8_SB(1, 0), cB + kstep, voffB); PG8_STAGE_A(PG8_SA(1, 0), cA + kstep, kstep, 0, voffC); PG8_STAGE(PG8_SB(1, 1), cB + hstep + kstep, voffB);
        PG8_WAIT_V(6); PG8_BAR;
    } else {
        PG8_STAGE(PG8_SB(0, 0), cB, voffB); PG8_STAGE(PG8_SA(0, 0), cA, voffA); PG8_STAGE(PG8_SB(0, 1), cB + hstep, voffB); PG8_STAGE(PG8_SA(0, 1), cA + hstep, voffA);
        if (wr == 1) PG8_BAR;
        PG8_WAIT_V(4); PG8_BAR;
        PG8_STAGE(PG8_SB(1, 0), cB + kstep, voffB); PG8_STAGE(PG8_SA(1, 0), cA + kstep, voffA); PG8_STAGE(PG8_SB(1, 1), cB + hstep + kstep, voffB);
        PG8_WAIT_V(6); PG8_BAR;
    }
    for (;;) {
        const bool has_next = S.next(ui + 1, nxt);
        if constexpr (GATHER) { if (has_next) PG8_GLOAD(voffN, nxt); else { _Pragma("unroll") for (int _h = 0; _h < 2; ++_h) _Pragma("unroll") for (int _i = 0; _i < 2; ++_i) voffN[_h][_i] = voffC[_h][_i]; } }
        const char* nA = has_next ? (const char*)g.A + (size_t)nxt.pm * tstep : cA; const char* nB = has_next ? (const char*)g.Bt + (size_t)nxt.pn * tstep : cB;
#pragma nounroll
        for (int t = 0; t < nt; t += 2) {
            const bool last = (t == nt - 2);
            const char* a1 = cA + (size_t)(t + 1) * kstep;
            const char* a2 = last ? nA : cA + (size_t)(t + 2) * kstep; const char* b2 = last ? nB : cB + (size_t)(t + 2) * kstep;
            const char* a3 = a2 + kstep; const char* b3 = b2 + kstep;
            const size_t k2 = last ? (size_t)0 : (size_t)(t + 2) * kstep; unsigned voffS[2][2];
            if constexpr (GATHER) { _Pragma("unroll") for (int _h = 0; _h < 2; ++_h) _Pragma("unroll") for (int _i = 0; _i < 2; ++_i) voffS[_h][_i] = last ? voffN[_h][_i] : voffC[_h][_i]; }
            if (last && has_next) S.a_ready(nxt);
            if constexpr (SP2) {
            PG8_LDB(B0, 0, 0); PG8_LDB(B1, 0, 1); PG8_SCHED; PG8_LDA(At, 0, 0); PG8_STAGE_A(PG8_SA(1, 1), a1 + hstep, (size_t)(t + 1) * kstep, 1, voffC);
            PG8_WAIT_V(8); PG8_WAIT_L(0); PG8_BAR; PG8_MMA(0, 0, At, B0); PG8_MMA(0, 1, At, B1); PG8_BAR; PG8_SCHED;
            PG8_LDA(At, 0, 1); PG8_STAGE(PG8_SB(0, 0), b2, voffB); PG8_STAGE(PG8_SB(0, 1), b2 + hstep, voffB); PG8_STAGE_A(PG8_SA(0, 0), a2, k2, 0, voffS);
            PG8_WAIT_V(8); PG8_WAIT_L(0); PG8_BAR; PG8_MMA(1, 0, At, B0); PG8_MMA(1, 1, At, B1); PG8_BAR; PG8_SCHED;
            PG8_LDB(B0, 1, 0); PG8_LDB(B1, 1, 1); PG8_SCHED; PG8_LDA(At, 1, 0); PG8_STAGE_A(PG8_SA(0, 1), a2 + hstep, k2, 1, voffS);
            PG8_WAIT_V(8); PG8_WAIT_L(0); PG8_BAR; PG8_MMA(0, 0, At, B0); PG8_MMA(0, 1, At, B1); PG8_BAR; PG8_SCHED;
            PG8_LDA(At, 1, 1); PG8_STAGE(PG8_SB(1, 0), b3, voffB); PG8_STAGE(PG8_SB(1, 1), b3 + hstep, voffB); PG8_STAGE_A(PG8_SA(1, 0), a3, k2 + kstep, 0, voffS);
            PG8_WAIT_V(8); PG8_WAIT_L(0); PG8_BAR; PG8_MMA(1, 0, At, B0); PG8_MMA(1, 1, At, B1); PG8_BAR; PG8_SCHED;
            } else {
            PG8_LDB(B0, 0, 0); PG8_SCHED; PG8_LDA(At, 0, 0); PG8_STAGE(PG8_SA(1, 1), a1 + hstep, voffA);
            PG8_WAIT_L(8); PG8_BAR; PG8_WAIT_L(0); PG8_MMA(0, 0, At, B0); PG8_BAR; PG8_SCHED;
            PG8_LDB(B1, 0, 1); PG8_STAGE(PG8_SB(0, 0), b2, voffB);
            PG8_BAR; PG8_WAIT_L(0); PG8_MMA(0, 1, At, B1); PG8_BAR;
            PG8_LDA(At, 0, 1); PG8_STAGE(PG8_SA(0, 0), a2, voffA);
            PG8_BAR; PG8_WAIT_L(0); PG8_MMA(1, 0, At, B0); PG8_BAR; PG8_SCHED;
            PG8_STAGE(PG8_SB(0, 1), b2 + hstep, voffB);
            PG8_WAIT_V(6); PG8_BAR; PG8_MMA(1, 1, At, B1); PG8_BAR;
            PG8_LDB(B0, 1, 0); PG8_SCHED; PG8_LDA(At, 1, 0); PG8_STAGE(PG8_SA(0, 1), a2 + hstep, voffA);
            PG8_WAIT_L(8); PG8_BAR; PG8_WAIT_L(0); PG8_MMA(0, 0, At, B0); PG8_BAR; PG8_SCHED;
            PG8_LDB(B1, 1, 1); PG8_STAGE(PG8_SB(1, 0), b3, voffB);
            PG8_BAR; PG8_WAIT_L(0); PG8_MMA(0, 1, At, B1); PG8_BAR;
            PG8_LDA(At, 1, 1); PG8_STAGE(PG8_SA(1, 0), a3, voffA);
            PG8_BAR; PG8_WAIT_L(0); PG8_MMA(1, 0, At, B0); PG8_BAR; PG8_SCHED;
            PG8_STAGE(PG8_SB(1, 1), b3 + hstep, voffB);
            PG8_WAIT_V(6); PG8_BAR; PG8_MMA(1, 1, At, B1); PG8_BAR;
            }
        }
        if constexpr (ALIGN_EPI) { if (wr == 0) PG8_BAR; }
        if constexpr (EB == 1) asm volatile("s_nop 15\n\ts_nop 15" ::: "memory");
        if constexpr (!Epi::AFTER_DRAIN) { E(acc, cur, wr, wc, fr, fq); S.done(cur); }
        if (!has_next) break;
#pragma unroll
        for (int a = 0; a < 2; ++a)
#pragma unroll
            for (int b = 0; b < 2; ++b)
#pragma unroll
                for (int m = 0; m < 4; ++m)
#pragma unroll
                    for (int n = 0; n < 2; ++n) acc[a][b][m][n] = (f32x4){0.f, 0.f, 0.f, 0.f};
        cur = nxt; cA = nA; cB = nB; ++ui;
        if constexpr (GATHER) { _Pragma("unroll") for (int _h = 0; _h < 2; ++_h) _Pragma("unroll") for (int _i = 0; _i < 2; ++_i) voffC[_h][_i] = voffN[_h][_i]; }
        if constexpr (ALIGN_EPI) { if (wr == 1) PG8_BAR; }
    }
    PG8_WAIT_V(0);
    if constexpr (!ALIGN_EPI) { if (wr == 0) PG8_BAR; }
    PG8_BAR;
    if constexpr (Epi::AFTER_DRAIN) { E.fused(acc, cur, wr, wc, fr, fq, lds, wid, lane); S.done(cur); }
#undef PG8_SA
#undef PG8_SB
#undef PG8_STAGE
#undef PG8_LDA
#undef PG8_GLOAD
#undef PG8_STAGE_A
#undef PG8_LD8
#undef PG8_LDB
#undef PG8_MMA
#undef PG8_CAT8
#undef PG8_WAIT_V
#undef PG8_WAIT_L
#undef PG8_BAR
#undef PG8_SCHED
}
}
#ifndef PG8_SP2
#define PG8_SP2 true
#endif
#ifndef MOE_SP2
#define MOE_SP2 true
#endif
#ifndef PG8_ALIGN
#define PG8_ALIGN true
#endif
constexpr int NWAVES = 8;
constexpr int NB = 4, SEQ = 4096, T = NB * SEQ, D = 1024, NIN = 2856, NINP = 3072, NE = 32, DEPTH = 2;
constexpr int C_H = 0, C_GB = 256, C_GC = 512, C_P = 768, C_Q = 1024, C_K = 1536, C_V = 2048, C_QI = 2560, C_KI = 2816, C_WI = 2848;
constexpr int NSEL = 256;
#ifndef SEL_CAND_CAP
#define SEL_CAND_CAP 64
#endif
constexpr int MAXROWS = 4 * T + NE * 256;
constexpr float ATT_C2 = 0.125f * 1.4426950408889634f;
constexpr float LN_EPS = 1e-5f, DN_ALPHA = 1.41421356237309515f;
enum { IN_X = 0, IN_WIN, IN_CONVW, IN_WPOOL, IN_PSCALE, IN_KNG, IN_KNB, IN_WOUT, IN_LN1G, IN_LN1B, IN_RW, IN_RB, IN_WGU, IN_BGU, IN_WDN, IN_BDN, IN_LN2G, IN_LN2B, N_IN };

constexpr size_t MiB = 1u << 20;
constexpr size_t WS_CTL = 0, CTL_ZERO_BYTES = 1 * MiB;
constexpr size_t WS_WIN = 2 * MiB;
constexpr size_t WS_WOUT = 14 * MiB;
constexpr size_t WS_WGU = 18 * MiB;
constexpr size_t WS_WDN = 274 * MiB;
constexpr size_t WS_XB = 402 * MiB;
constexpr size_t WS_XF = 434 * MiB;
constexpr size_t WS_Y1 = 498 * MiB;
constexpr size_t WS_PROJ = 562 * MiB;
constexpr size_t WS_CAT = 658 * MiB;
constexpr size_t WS_KIN = 690 * MiB;
constexpr size_t WS_MASK = 691 * MiB;
constexpr size_t WS_ROUTE = 699 * MiB;
constexpr size_t WS_CNTW = 699 * MiB + 256 * 1024;
constexpr size_t WS_SC = 700 * MiB;
constexpr size_t WS_XS = 956 * MiB;
constexpr size_t WS_ACT = 1100 * MiB;
constexpr size_t WS_YS = 1244 * MiB;
constexpr size_t WS_XB8 = 1388 * MiB;
constexpr size_t WS_END = 1404 * MiB;
constexpr int CW_TMO = 0;
constexpr int CW_CNT = 1024;
constexpr int CW_BAR = 4096;
constexpr int RING_BYTES = 131072;
constexpr int TAB_OFF = RING_BYTES;
constexpr int MISC_OFF = RING_BYTES + 1024;
constexpr int LDS_BYTES = 147456;

#define GAS __attribute__((address_space(1)))
#define LAS __attribute__((address_space(3)))
typedef unsigned short bf16;
typedef unsigned v4u __attribute__((ext_vector_type(4)));
typedef unsigned v2u __attribute__((ext_vector_type(2)));
typedef float f32x4 __attribute__((ext_vector_type(4)));
typedef short bf16x8 __attribute__((ext_vector_type(8)));
typedef GAS unsigned gu32;
typedef unsigned long long u64;
#define RLX_AGENT __ATOMIC_RELAXED, __HIP_MEMORY_SCOPE_AGENT
#define LDS_WAIT() asm volatile("s_waitcnt lgkmcnt(0)" ::: "memory")
#define VM_WAIT() asm volatile("s_waitcnt vmcnt(0)" ::: "memory")
__device__ __forceinline__ unsigned f2bf(float f) { unsigned u = __builtin_bit_cast(unsigned, f); return (u + 0x7fffu + ((u >> 16) & 1u)) >> 16; }
__device__ __forceinline__ unsigned pk2(float lo, float hi) {
    typedef float f2_ __attribute__((ext_vector_type(2))); typedef __bf16 b2_ __attribute__((ext_vector_type(2))); const f2_ v = {lo, hi}; return __builtin_bit_cast(unsigned, __builtin_convertvector(v, b2_)); }
__device__ __forceinline__ unsigned pk4_fp8(float a, float b, float c, float d) { int w = 0; w = __builtin_amdgcn_cvt_pk_fp8_f32(a, b, w, false); w = __builtin_amdgcn_cvt_pk_fp8_f32(c, d, w, true); return (unsigned)w; }
constexpr float WGU_SCALE = 32.f, WDN_SCALE = 64.f;
__device__ __forceinline__ float bf2f(bf16 v) { return __builtin_bit_cast(float, (unsigned)v << 16); }
__device__ __forceinline__ float bflo(unsigned w) { return __builtin_bit_cast(float, w << 16); }
__device__ __forceinline__ float bfhi(unsigned w) { return __builtin_bit_cast(float, w & 0xffff0000u); }
template <int CTRL> __device__ __forceinline__ float dppx(float v) { return __builtin_bit_cast(float, __builtin_amdgcn_update_dpp(0, __builtin_bit_cast(int, v), CTRL, 0xf, 0xf, false)); }
__device__ __forceinline__ float wave_sum(float v) {
    v += dppx<0xB1>(v); v += dppx<0x4E>(v); v += dppx<0x141>(v); v += dppx<0x140>(v);
    const float a = __builtin_bit_cast(float, __builtin_amdgcn_readlane(__builtin_bit_cast(int, v), 0)), b = __builtin_bit_cast(float, __builtin_amdgcn_readlane(__builtin_bit_cast(int, v), 16));
    const float c = __builtin_bit_cast(float, __builtin_amdgcn_readlane(__builtin_bit_cast(int, v), 32)), d = __builtin_bit_cast(float, __builtin_amdgcn_readlane(__builtin_bit_cast(int, v), 48));
    return (a + b) + (c + d);
}
__device__ __forceinline__ float wave_max(float v) {
#pragma unroll
    for (int o = 1; o < 64; o <<= 1) v = fmaxf(v, __shfl_xor(v, o));
    return v;
}
__device__ __forceinline__ float wave_max_dpp(float v) {
    v = fmaxf(v, dppx<0xB1>(v)); v = fmaxf(v, dppx<0x4E>(v)); v = fmaxf(v, dppx<0x141>(v)); v = fmaxf(v, dppx<0x140>(v));
    const float a = __builtin_bit_cast(float, __builtin_amdgcn_readlane(__builtin_bit_cast(int, v), 0)), b = __builtin_bit_cast(float, __builtin_amdgcn_readlane(__builtin_bit_cast(int, v), 16));
    const float c = __builtin_bit_cast(float, __builtin_amdgcn_readlane(__builtin_bit_cast(int, v), 32)), d = __builtin_bit_cast(float, __builtin_amdgcn_readlane(__builtin_bit_cast(int, v), 48));
    return fmaxf(fmaxf(a, b), fmaxf(c, d));
}
__device__ __forceinline__ float sum32(float v) {
#pragma unroll
    for (int o = 1; o < 32; o <<= 1) v += __shfl_xor(v, o);
    return v;
}
#define XB_TMO      128
#define XB_XCNT(j)  (256  + 64 * (j))
#define XB_XSUB(j)  (1280 + 64 * (j))
#define XB_XGEN(j)  (2304 + 64 * (j))
#define XB_TOP      3328
#define XB_TOPGEN   3392
#define XCD_BAR_WORDS 3456
#define XB_SPIN_CAP (1u << 18)

__device__ __forceinline__ unsigned xb_ld(unsigned* p)              { return __hip_atomic_load(p, __ATOMIC_RELAXED, __HIP_MEMORY_SCOPE_AGENT); }
__device__ __forceinline__ unsigned xb_add(unsigned* p, unsigned v) { return __hip_atomic_fetch_add(p, v, __ATOMIC_RELAXED, __HIP_MEMORY_SCOPE_AGENT); }
__device__ __forceinline__ unsigned xb_xcc_id() { return (unsigned)__builtin_amdgcn_s_getreg((3 << 11) | 20) & 0xFu; }
#define XB_SPIN(cond, bar) do { unsigned _sp = 0; while (cond) { __builtin_amdgcn_s_sleep(1); \
    if ((++_sp & 255u) == 0u) { if (xb_ld(&(bar)[XB_TMO])) break; if (_sp > XB_SPIN_CAP) { atomicAdd(&(bar)[XB_TMO], 1u); break; } } } } while (0)

struct XcdBarrier {
    unsigned* bar; unsigned x;
    volatile LAS unsigned* st;
};

__device__ __forceinline__ XcdBarrier xcd_barrier_post(unsigned* bar, volatile LAS unsigned* st) {
    XcdBarrier b; b.bar = bar; b.x = xb_xcc_id(); b.st = st;
    if (threadIdx.x == 0) (void)xb_add(&bar[XB_XCNT(b.x)], 1u);
    return b;
}
__device__ __forceinline__ void xcd_barrier_complete(unsigned* bar, unsigned x, unsigned& nloc, unsigned& nx) {
    const unsigned G = gridDim.x * gridDim.y * gridDim.z;
    unsigned sum, cnt, mine, sp = 0u;
    for (;;) {
        sum = 0u; cnt = 0u; mine = 0u;
#pragma unroll
        for (unsigned j = 0; j < 16; ++j) { const unsigned c = xb_ld(&bar[XB_XCNT(j)]); sum += c; cnt += (c > 0u) ? 1u : 0u; mine = (j == x) ? c : mine; }
        if (sum == G) break;
        __builtin_amdgcn_s_sleep(1);
        if ((++sp & 255u) == 0u) { if (xb_ld(&bar[XB_TMO])) break; if (sp > XB_SPIN_CAP) { atomicAdd(&bar[XB_TMO], 1u); break; } }
    }
    nloc = mine > 0u ? mine : 1u; nx = cnt > 0u ? cnt : 1u;
}

__device__ __forceinline__ void xcd_barrier(const XcdBarrier& b) {
    asm volatile("s_waitcnt vmcnt(0)" ::: "memory");
    __syncthreads();
    if (threadIdx.x == 0) {
        unsigned* bar = b.bar;
        __builtin_amdgcn_s_waitcnt(0);
        unsigned nloc = b.st[0], nx = b.st[1];
        if (nloc == 0u) { xcd_barrier_complete(bar, b.x, nloc, nx); b.st[0] = nloc; b.st[1] = nx; }
        const unsigned old = xb_add(&bar[XB_XSUB(b.x)], 1u);
        const unsigned gen = old / nloc;
        if (old + 1u == (gen + 1u) * nloc) {
            __builtin_amdgcn_fence(__ATOMIC_RELEASE, "agent");
            asm volatile("s_waitcnt vmcnt(0)" ::: "memory");
#ifdef BAR_EARLY_INV
            __builtin_amdgcn_fence(__ATOMIC_ACQUIRE, "agent");
            (void)xb_add(&bar[XB_TOP], 1u);
            { const unsigned target = (gen + 1u) * nx; XB_SPIN(xb_ld(&bar[XB_TOP]) < target, bar); }
            xb_add(&bar[XB_XGEN(b.x)], 1u);
            asm volatile("s_waitcnt vmcnt(0)" ::: "memory");
#else
            const unsigned og = xb_add(&bar[XB_TOP], 1u);
            const unsigned tg = og / nx;
            if (og + 1u == (tg + 1u) * nx) xb_add(&bar[XB_TOPGEN], 1u);
            else XB_SPIN(xb_ld(&bar[XB_TOPGEN]) == tg, bar);
            __builtin_amdgcn_fence(__ATOMIC_ACQUIRE, "agent");
            xb_add(&bar[XB_XGEN(b.x)], 1u);
            asm volatile("s_waitcnt vmcnt(0)" ::: "memory");
#endif
        } else {
#ifdef BAR_EARLY_INV
            __builtin_amdgcn_fence(__ATOMIC_ACQUIRE, "agent"); asm volatile("s_waitcnt vmcnt(0)" ::: "memory");
            XB_SPIN(xb_ld(&bar[XB_XGEN(b.x)]) == gen, bar);
            asm volatile("" ::: "memory");
#else
            XB_SPIN(xb_ld(&bar[XB_XGEN(b.x)]) == gen, bar);
            __builtin_amdgcn_fence(__ATOMIC_ACQUIRE, "agent");
            asm volatile("s_waitcnt vmcnt(0)" ::: "memory");
#endif
        }
    }
    __syncthreads();
}
struct Args { const float* in[N_IN]; float* out; unsigned char* ws; int ph_lo, ph_hi; };
struct Frame {
    LAS unsigned char* lds;
    gu32* ctl;
    unsigned char* ws;
    int tid, lane, wave, vcu, G;
};
#define WSP(type, off) ((type*)(GAS type*)(F.ws + (off)))
__device__ __forceinline__ const float* uni(const float* p) { const u64 v = (u64)p; return (const float*)(const GAS float*)(((u64)(unsigned)__builtin_amdgcn_readfirstlane((int)(v >> 32)) << 32) | (u64)(unsigned)__builtin_amdgcn_readfirstlane((int)v)); }
__device__ __forceinline__ Frame make_frame(unsigned char* ws_, LAS unsigned char* lds_) {
    Frame F; const u64 v = (u64)ws_;
    F.ws = (unsigned char*)(((u64)(unsigned)__builtin_amdgcn_readfirstlane((int)(v >> 32)) << 32) | (u64)(unsigned)__builtin_amdgcn_readfirstlane((int)v));
    F.lds = (LAS unsigned char*)(unsigned)__builtin_amdgcn_readfirstlane((int)(unsigned)(uintptr_t)lds_);
    F.ctl = (gu32*)(F.ws + WS_CTL);
    { int t_ = threadIdx.x; asm volatile("" : "+v"(t_)); F.tid = t_; }
    F.lane = F.tid & 63; F.wave = __builtin_amdgcn_readfirstlane(F.tid >> 6);
    F.G = gridDim.x; { const int bx = blockIdx.x; F.vcu = (F.G % 8 == 0) ? (bx % 8) * (F.G / 8) + bx / 8 : bx; }
    return F;
}
struct In6 { const float* p[6]; };

__device__ __forceinline__ void tr_block(Frame& F, const float* W_, int N, bf16* WT, int k0, int n0, int mode  , size_t drow_base, float scale) {
    LAS unsigned* img = (LAS unsigned*)F.lds; const int lane = F.lane, wave = F.wave, tid = F.tid; const GAS float* W = (const GAS float*)W_;
    f32x4 va[4][2], vb[4][2];
#pragma unroll
    for (int i = 0; i < 4; ++i) { const int kp = wave * 4 + i; const GAS float* r0 = W + (size_t)(k0 + 2 * kp) * N + n0; const GAS float* r1 = r0 + N;
#pragma unroll
        for (int q = 0; q < 2; ++q) { const int c4 = lane + 64 * q; va[i][q] = (f32x4){0.f, 0.f, 0.f, 0.f}; vb[i][q] = va[i][q];
            if (n0 + 4 * c4 < N) { va[i][q] = __builtin_nontemporal_load((const GAS f32x4*)(r0 + 4 * c4)); vb[i][q] = __builtin_nontemporal_load((const GAS f32x4*)(r1 + 4 * c4)); } } }
#pragma unroll
    for (int i = 0; i < 4; ++i) { const int kp = wave * 4 + i;
#pragma unroll
        for (int q = 0; q < 2; ++q) { const int c4 = lane + 64 * q; const f32x4 a = va[i][q], b = vb[i][q];
            v4u o; o.x = pk2(a.x * scale, b.x * scale); o.y = pk2(a.y * scale, b.y * scale); o.z = pk2(a.z * scale, b.z * scale); o.w = pk2(a.w * scale, b.w * scale);
            *(LAS v4u*)(img + kp * 516 + 4 * c4) = o; } }
    __syncthreads();
    const int c = tid & 7;
#pragma unroll
    for (int i = 0; i < 8; ++i) { const int n = (tid >> 3) + 64 * i; const LAS unsigned* p = img + (4 * c) * 516 + n;
        v4u o; o.x = p[0]; o.y = p[516]; o.z = p[2 * 516]; o.w = p[3 * 516];
        const int ng = n0 + n; size_t dr;
        if (mode == 1) dr = ng < 1024 ? (size_t)((ng >> 7) * 256 + (ng & 127)) : (size_t)((((ng - 1024) >> 7) * 256) + 128 + ((ng - 1024) & 127)); else dr = (size_t)ng;
        *(GAS v4u*)((GAS bf16*)WT + (drow_base + dr) * D + k0 + 8 * c) = o; }
    __syncthreads();
}
__device__ __forceinline__ void tr_block8(Frame& F, const float* W_, int N, unsigned char* WT, int k0, int n0, int mode, size_t drow_base, float scale) {
    LAS unsigned* img = (LAS unsigned*)F.lds; const int lane = F.lane, wave = F.wave, tid = F.tid; const GAS float* W = (const GAS float*)W_;
    f32x4 vv[4][2][4];
#pragma unroll
    for (int i = 0; i < 4; ++i) { const int kq = wave * 4 + i; const GAS float* r0 = W + (size_t)(k0 + 4 * kq) * N + n0;
#pragma unroll
        for (int q = 0; q < 2; ++q) { const int c4 = lane + 64 * q;
#pragma unroll
            for (int j = 0; j < 4; ++j) vv[i][q][j] = __builtin_nontemporal_load((const GAS f32x4*)(r0 + (size_t)j * N + 4 * c4)); } }
#pragma unroll
    for (int i = 0; i < 4; ++i) { const int kq = wave * 4 + i;
#pragma unroll
        for (int q = 0; q < 2; ++q) { const int c4 = lane + 64 * q; const f32x4 a = vv[i][q][0] * scale, b = vv[i][q][1] * scale, c = vv[i][q][2] * scale, d = vv[i][q][3] * scale;
            v4u o; o.x = pk4_fp8(a.x, b.x, c.x, d.x); o.y = pk4_fp8(a.y, b.y, c.y, d.y); o.z = pk4_fp8(a.z, b.z, c.z, d.z); o.w = pk4_fp8(a.w, b.w, c.w, d.w);
            *(LAS v4u*)(img + kq * 516 + 4 * c4) = o; } }
    __syncthreads();
    const int c = tid & 7;
#pragma unroll
    for (int i = 0; i < 8; ++i) { const int n = (tid >> 3) + 64 * i; const LAS unsigned* p = img + (4 * c) * 516 + n;
        v4u o; o.x = p[0]; o.y = p[516]; o.z = p[2 * 516]; o.w = p[3 * 516];
        const int ng = n0 + n; size_t dr;
        if (mode == 1) dr = ng < 1024 ? (size_t)((ng >> 7) * 256 + (ng & 127)) : (size_t)((((ng - 1024) >> 7) * 256) + 128 + ((ng - 1024) & 127)); else dr = (size_t)ng;
        __builtin_nontemporal_store(o, (GAS v4u*)((GAS unsigned char*)WT + (drow_base + dr) * D + k0 + 16 * c)); }
    __syncthreads();
}
__device__ __forceinline__ void p_prologue(Frame& F, const In6& A) {
    constexpr int I_IN = 16 * 6, I_OUT = 16 * 2, I_GU = NE * 8 * 4, I_DN = NE * 8 * 2, I_L = I_IN + I_OUT + I_GU + I_DN;
    for (int it = F.vcu; it < DEPTH * I_L; it += F.G) {
        const int l = it / I_L; int r = it % I_L;
        if (r < I_IN) { const int kb = r / 6, nb = r % 6; tr_block(F, A.p[0] + (size_t)l * D * NIN, NIN, WSP(bf16, WS_WIN) + (size_t)l * NINP * D, kb * 64, nb * 512, 0, 0, nb == 2 ? ATT_C2 : 1.f); continue; }
        r -= I_IN;
        if (r < I_OUT) { const int kb = r / 2, nb = r % 2; tr_block(F, A.p[1] + (size_t)l * D * D, D, WSP(bf16, WS_WOUT) + (size_t)l * D * D, kb * 64, nb * 512, 0, 0, 1.f); continue; }
        r -= I_OUT;
        if (r < I_GU) { const int e = r / 32, rr = r % 32, kb = rr / 4, nb = rr % 4; tr_block8(F, A.p[2] + (size_t)(l * NE + e) * D * 2048, 2048, WSP(unsigned char, WS_WGU) + (size_t)l * NE * 2048 * D * 2, kb * 128, nb * 512, 1, (size_t)e * 2048, WGU_SCALE); continue; }
        r -= I_GU;
        { const int e = r / 16, rr = r % 16, kb = rr / 2, nb = rr % 2; tr_block8(F, A.p[3] + (size_t)(l * NE + e) * D * D, D, WSP(unsigned char, WS_WDN) + (size_t)l * NE * D * D * 2, kb * 128, nb * 512, 0, (size_t)e * 1024, WDN_SCALE); }
    }
    const int gw = F.vcu * NWAVES + F.wave, NGW = F.G * NWAVES, lane = F.lane;
    const GAS float* x = (const GAS float*)A.p[4]; GAS bf16* xb = (GAS bf16*)WSP(bf16, WS_XB);
    for (int m = gw; m < T; m += 2 * NGW) {
        const GAS f32x4* xr = (const GAS f32x4*)(x + (size_t)m * D) + lane; GAS u64* o8 = (GAS u64*)(xb + (size_t)m * D) + lane;
        const GAS f32x4* xr2 = xr + (size_t)NGW * (D / 4); GAS u64* o82 = o8 + (size_t)NGW * (D / 4);
        f32x4 v[4], w[4];
#pragma unroll
        for (int j = 0; j < 4; ++j) { v[j] = __builtin_nontemporal_load(xr + 64 * j); w[j] = __builtin_nontemporal_load(xr2 + 64 * j); }
#pragma unroll
        for (int j = 0; j < 4; ++j) { o8[64 * j] = (u64)pk2(v[j].x, v[j].y) | ((u64)pk2(v[j].z, v[j].w) << 32); o82[64 * j] = (u64)pk2(w[j].x, w[j].y) | ((u64)pk2(w[j].z, w[j].w) << 32); }
    }
}

__device__ __forceinline__ void bf8_to_f(const v4u q, float (&f)[8]) { f[0] = bflo(q.x); f[1] = bfhi(q.x); f[2] = bflo(q.y); f[3] = bfhi(q.y); f[4] = bflo(q.z); f[5] = bfhi(q.z); f[6] = bflo(q.w); f[7] = bfhi(q.w); }
__device__ __forceinline__ void p_local(Frame& F, const In6& A, int l) {
    typedef float f32x16 __attribute__((ext_vector_type(16)));
    constexpr int MROW = 528, WROW = 144;
    LAS unsigned char* mixb = F.lds;
    LAS unsigned char* wpt = F.lds + 64 * MROW;
    const GAS float* wpool = (const GAS float*)(A.p[0] + (size_t)l * 4 * 64 * 64);
    const GAS float* convw = (const GAS float*)(A.p[1] + l * 768); const GAS float* pscale = (const GAS float*)(A.p[2] + l * 256);
    const GAS float* kng = (const GAS float*)(A.p[3] + l * 32); const GAS float* knb = (const GAS float*)(A.p[4] + l * 32);
    const GAS bf16* PROJ = (const GAS bf16*)(F.ws + WS_PROJ); GAS bf16* CAT = (GAS bf16*)(F.ws + WS_CAT); GAS bf16* KIN = (GAS bf16*)(F.ws + WS_KIN);
    const int tid = F.tid, lane = F.lane, wave = F.wave;
    for (int u = F.vcu; u < T / 64; u += F.G) {
        const int t0 = u * 64, s0 = t0 & (SEQ - 1), rowb = t0 - s0;
        __syncthreads();
        f32x4 wr0[4], wr1[4];
#pragma unroll
        for (int i = 0; i < 4; ++i) { const int item = tid + 512 * i, g = item >> 9, cp = (item >> 4) & 31, dq = item & 15;
            wr0[i] = *(const GAS f32x4*)(wpool + g * 4096 + (2 * cp) * 64 + 4 * dq); wr1[i] = *(const GAS f32x4*)(wpool + g * 4096 + (2 * cp + 1) * 64 + 4 * dq); }
        const int cga = tid & 31, tga = tid >> 5, ca0 = cga * 8, sfa = s0 + tga * 4;
        v4u ah[6], ag[6], ab[4];
#pragma unroll
        for (int i = -2; i < 4; ++i) { const int sq = sfa + i; ah[i + 2] = (v4u){0u, 0u, 0u, 0u}; ag[i + 2] = ah[i + 2];
            if (sq >= 0) { const GAS bf16* pr = PROJ + (size_t)(rowb + sq) * NINP; ah[i + 2] = *(const GAS v4u*)(pr + C_H + ca0); ag[i + 2] = *(const GAS v4u*)(pr + C_GC + ca0);
                if (i >= 0) ab[i] = *(const GAS v4u*)(pr + C_GB + ca0); } }
        const int cgb = tid & 63, tgb = tid >> 6, cb0 = cgb * 4, wwin = 2 << (cgb >> 4), sfb = s0 + tgb * 8;
        v2u bq[23];
#pragma unroll
        for (int i = 0; i < 23; ++i) { const int sq = sfb - 15 + i; bq[i] = (v2u){0u, 0u}; if (sq >= 0) bq[i] = *(const GAS v2u*)(PROJ + (size_t)(rowb + sq) * NINP + C_P + cb0); }
        bf16 ck[4];
#pragma unroll
        for (int i = 0; i < 4; ++i) { const int idx = tid + 512 * i; ck[i] = PROJ[(size_t)(t0 + (idx >> 5)) * NINP + C_KI + (idx & 31)]; }
        const float kg = kng[tid & 31], kb = knb[tid & 31];
        float w0[8], w1[8], w2[8];
#pragma unroll
        for (int i = 0; i < 8; ++i) { w0[i] = convw[ca0 + i]; w1[i] = convw[256 + ca0 + i]; w2[i] = convw[512 + ca0 + i]; }
#pragma unroll
        for (int i = 0; i < 4; ++i) { const int item = tid + 512 * i, g = item >> 9, cp = (item >> 4) & 31, dq = item & 15;
#pragma unroll
            for (int k = 0; k < 4; ++k) *(LAS unsigned*)(wpt + (g * 64 + 4 * dq + k) * WROW + cp * 4) = pk2(wr0[i][k], wr1[i][k]); }
        {
            float up2[8], up1[8];
#pragma unroll
            for (int i = 0; i < 8; ++i) { up2[i] = 0.f; up1[i] = 0.f; }
#pragma unroll
            for (int i = -2; i < 4; ++i) { const int sq = sfa + i; float h8[8], g8[8], uu[8];
                bf8_to_f(ah[i + 2], h8); bf8_to_f(ag[i + 2], g8);
#pragma unroll
                for (int k = 0; k < 8; ++k) uu[k] = g8[k] * h8[k];
                if (i >= 0) { float b8[8], y[8]; bf8_to_f(ab[i], b8);
#pragma unroll
                    for (int k = 0; k < 8; ++k) y[k] = b8[k] * (w0[k] * up2[k] + w1[k] * up1[k] + w2[k] * uu[k]);
                    v4u o; o.x = pk2(y[0], y[1]); o.y = pk2(y[2], y[3]); o.z = pk2(y[4], y[5]); o.w = pk2(y[6], y[7]);
                    *(GAS v4u*)(CAT + (size_t)(rowb + sq) * D + ca0) = o; }
#pragma unroll
                for (int k = 0; k < 8; ++k) { up2[k] = up1[k]; up1[k] = uu[k]; } }
        }
        {
            float pv[23][4];
#pragma unroll
            for (int i = 0; i < 23; ++i) { pv[i][0] = bflo(bq[i].x); pv[i][1] = bfhi(bq[i].x); pv[i][2] = bflo(bq[i].y); pv[i][3] = bfhi(bq[i].y); }
#pragma unroll
            for (int i = 0; i < 8; ++i) { const int sq = sfb + i; float a0 = 0.f, a1 = 0.f, a2 = 0.f, a3 = 0.f;
#pragma unroll
                for (int j = 0; j < 16; ++j) { const bool on = j < wwin; a0 += on ? pv[15 + i - j][0] : 0.f; a1 += on ? pv[15 + i - j][1] : 0.f; a2 += on ? pv[15 + i - j][2] : 0.f; a3 += on ? pv[15 + i - j][3] : 0.f; }
                const float rc = 1.f / (float)((sq + 1) < wwin ? (sq + 1) : wwin);
                *(LAS v2u*)(mixb + (tgb * 8 + i) * MROW + cb0 * 2) = (v2u){pk2(a0 * rc - pv[15 + i][0], a1 * rc - pv[15 + i][1]), pk2(a2 * rc - pv[15 + i][2], a3 * rc - pv[15 + i][3])}; }
        }
#pragma unroll
        for (int i = 0; i < 4; ++i) {
            const int idx = tid + 512 * i, tt = idx >> 5, dd = idx & 31; const float v = bf2f(ck[i]);
            const float mean = sum32(v) * (1.f / 32.f); const float dv = v - mean; const float var = sum32(dv * dv) * (1.f / 32.f);
            KIN[(size_t)(t0 + tt) * 32 + dd] = (bf16)f2bf(dv * rsqrtf(var + LN_EPS) * kg + kb);
        }
        __syncthreads();
        {
            const int g = wave >> 1, th = wave & 1, r32 = lane & 31, hi = lane >> 5;
            f32x16 acc[2]; acc[0] = f32x16{}; acc[1] = f32x16{};
#pragma unroll
            for (int kk = 0; kk < 4; ++kk) { const bf16x8 bfr = *(const LAS bf16x8*)(mixb + (th * 32 + r32) * MROW + (g * 64 + kk * 16 + hi * 8) * 2);
#pragma unroll
                for (int dh = 0; dh < 2; ++dh) { const bf16x8 afr = *(const LAS bf16x8*)(wpt + (g * 64 + dh * 32 + r32) * WROW + (kk * 16 + hi * 8) * 2);
                    acc[dh] = __builtin_amdgcn_mfma_f32_32x32x16_bf16(afr, bfr, acc[dh], 0, 0, 0); } }
            GAS bf16* orow = CAT + (size_t)(t0 + th * 32 + r32) * D + 256 + g * 64;
#pragma unroll
            for (int dh = 0; dh < 2; ++dh)
#pragma unroll
                for (int rq = 0; rq < 4; ++rq) { const int d0 = dh * 32 + 8 * rq + 4 * hi; const f32x4 sc = *(const GAS f32x4*)(pscale + g * 64 + d0);
                    *(GAS v2u*)(orow + d0) = (v2u){pk2(acc[dh][4 * rq] * sc.x, acc[dh][4 * rq + 1] * sc.y), pk2(acc[dh][4 * rq + 2] * sc.z, acc[dh][4 * rq + 3] * sc.w)}; }
        }
    }
    __syncthreads();
}

constexpr int SCS = SEQ;
__device__ __forceinline__ unsigned sortable(float v) { const unsigned u = __builtin_bit_cast(unsigned, v); return (u & 0x80000000u) ? ~u : (u | 0x80000000u); }
__device__ __forceinline__ void select_row(int t, const GAS float* SC, GAS unsigned* MASK, LAS unsigned* hist, LAS float* ckey, LAS int* cidx, int lane) {
    const u64 lt = (1ull << lane) - 1ull; const float NINF = -INFINITY;
    const int s = t & (SEQ - 1); GAS u64* mrow = (GAS u64*)MASK + ((size_t)(t >> 12) * 64) * SEQ + s;
    if (s < NSEL) { const int base = 64 * lane; u64 m; if (s >= base + 63) m = ~0ull; else if (s < base) m = 0ull; else m = (2ull << (s - base)) - 1ull; mrow[(size_t)lane * SEQ] = m; return; }
    const int jmax = s >> 6, jb = jmax & ~7;
    float v[64]; const GAS float* srow = SC + (size_t)t * SCS + lane;
#pragma unroll
    for (int j0 = 0; j0 < 64; j0 += 8) {
        if (j0 < jb) {
#pragma unroll
            for (int j = j0; j < j0 + 8; ++j) v[j] = srow[64 * j];
        } else if (j0 == jb) {
#pragma unroll
            for (int j = j0; j < j0 + 8; ++j) { const float x = srow[64 * j]; v[j] = (lane + 64 * j <= s) ? x : NINF; }
        } else {
#pragma unroll
            for (int j = j0; j < j0 + 8; ++j) v[j] = NINF;
        }
    }
    {
    float vmx = NINF, vmn = INFINITY;
#pragma unroll
    for (int j0 = 0; j0 < 64; j0 += 8) {
        if (j0 < jb) {
#pragma unroll
            for (int j = j0; j < j0 + 8; ++j) { vmx = fmaxf(vmx, v[j]); vmn = fminf(vmn, v[j]); }
        } else if (j0 == jb) {
#pragma unroll
            for (int j = j0; j < j0 + 8; ++j) { vmx = fmaxf(vmx, v[j]); vmn = fminf(vmn, v[j] == NINF ? INFINITY : v[j]); }
        }
    }
    vmx = wave_max_dpp(vmx); vmn = -wave_max_dpp(-vmn);
    const float scale = 1023.f / fmaxf(vmx - vmn, 1e-30f), off = -vmn * scale;
#pragma unroll
    for (int i = 0; i < 4; ++i) ((LAS v4u*)hist)[i * 64 + lane] = (v4u){0u, 0u, 0u, 0u};
    LDS_WAIT(); asm volatile("" ::: "memory");
    unsigned bp[32];
#pragma unroll
    for (int j0 = 0; j0 < 64; j0 += 8) {
        if (j0 < jb) {
#pragma unroll
            for (int j = j0; j < j0 + 8; ++j) { unsigned bb = (unsigned)fmaf(v[j], scale, off); bb = bb < 1023u ? bb : 1023u; __hip_atomic_fetch_add(hist + bb, 1u, __ATOMIC_RELAXED, __HIP_MEMORY_SCOPE_WORKGROUP);
                if (j & 1) bp[j >> 1] |= bb << 16; else bp[j >> 1] = bb; }
        } else if (j0 == jb) {
#pragma unroll
            for (int j = j0; j < j0 + 8; ++j) { unsigned bb = (unsigned)fmaf(v[j], scale, off); bb = bb < 1023u ? bb : 1023u; if (v[j] != NINF) __hip_atomic_fetch_add(hist + bb, 1u, __ATOMIC_RELAXED, __HIP_MEMORY_SCOPE_WORKGROUP);
                if (j & 1) bp[j >> 1] |= bb << 16; else bp[j >> 1] = bb; }
        } else {
#pragma unroll
            for (int j = j0; j < j0 + 8; j += 2) bp[j >> 1] = 0u;
        }
    }
    LDS_WAIT(); asm volatile("" ::: "memory");
    unsigned hb[16];
#pragma unroll
    for (int i = 0; i < 4; ++i) { const v4u q = ((const LAS v4u*)hist)[lane * 4 + i]; hb[4 * i] = q.x; hb[4 * i + 1] = q.y; hb[4 * i + 2] = q.z; hb[4 * i + 3] = q.w; }
    int own = 0;
#pragma unroll
    for (int i = 0; i < 16; ++i) own += (int)hb[i];
    int suf = own;
    suf += __builtin_amdgcn_update_dpp(0, suf, 0x101, 0xf, 0xf, true); suf += __builtin_amdgcn_update_dpp(0, suf, 0x102, 0xf, 0xf, true);
    suf += __builtin_amdgcn_update_dpp(0, suf, 0x104, 0xf, 0xf, true); suf += __builtin_amdgcn_update_dpp(0, suf, 0x108, 0xf, 0xf, true);
    { const int t1 = __builtin_amdgcn_readlane(suf, 16), t2 = __builtin_amdgcn_readlane(suf, 32), t3 = __builtin_amdgcn_readlane(suf, 48); const int rw = lane >> 4;
      suf += rw == 0 ? t1 + t2 + t3 : rw == 1 ? t2 + t3 : rw == 2 ? t3 : 0; }
    const u64 ge = __ballot(suf >= NSEL); const int L = 63 - __builtin_clzll(ge);
    int acc = suf - own, tb = 0, ca = 0, found = 0;
#pragma unroll
    for (int i = 15; i >= 0; --i) { if (!found) { if (acc + (int)hb[i] >= NSEL) { found = 1; tb = lane * 16 + i; ca = acc; } else acc += (int)hb[i]; } }
    const int TB = __builtin_amdgcn_readlane(tb, L), CA = __builtin_amdgcn_readlane(ca, L);
    const int need = NSEL - CA;
    int cbase = 0; unsigned mlo = 0u, mhi = 0u;
#pragma unroll
    for (int j0 = 0; j0 < 64; j0 += 8) {
        if (j0 <= jb) {
#pragma unroll
            for (int j = j0; j < j0 + 8; ++j) { const int bb = (int)((j & 1) ? (bp[j >> 1] >> 16) : (bp[j >> 1] & 0xffffu));
                const u64 am = __ballot(bb > TB); const u64 cm = __ballot(bb == TB);
                asm volatile("s_nop 4\n\tv_writelane_b32 %0, %2, %4\n\tv_writelane_b32 %1, %3, %4" : "+v"(mlo), "+v"(mhi) : "s"((unsigned)am), "s"((unsigned)(am >> 32)), "n"(j));
                if (cm) { const int pos = cbase + __popcll(cm & lt); if (bb == TB && pos < 64) { ckey[pos] = v[j]; cidx[pos] = lane + 64 * j; } cbase += __popcll(cm); } }
        }
    }
    LDS_WAIT(); asm volatile("" ::: "memory");
    if (cbase <= SEL_CAND_CAP) {
        LAS unsigned* mw = hist;
        mw[2 * lane] = mlo; mw[2 * lane + 1] = mhi;
        const float myk = lane < cbase ? ckey[lane] : NINF; const int myi = lane < cbase ? cidx[lane] : 0x7fffffff; int rank = 0;
        for (int c = 0; c < cbase; ++c) { const float ok = __builtin_bit_cast(float, __builtin_amdgcn_readlane(__builtin_bit_cast(int, myk), c)); const int oi = __builtin_amdgcn_readlane(myi, c); rank += (ok > myk || (ok == myk && oi < myi)) ? 1 : 0; }
        LDS_WAIT(); asm volatile("" ::: "memory");
        if (lane < cbase && rank < need && myk != NINF) __hip_atomic_fetch_or(mw + (myi >> 5), 1u << (myi & 31), __ATOMIC_RELAXED, __HIP_MEMORY_SCOPE_WORKGROUP);
        LDS_WAIT(); asm volatile("" ::: "memory");
        mrow[(size_t)lane * SEQ] = (u64)mw[2 * lane] | ((u64)mw[2 * lane + 1] << 32);
        LDS_WAIT(); asm volatile("" ::: "memory");
        return;
    }
    unsigned prefix = 0u;
    for (int bit = 31; bit >= 0; --bit) { const unsigned cand = prefix | (1u << bit); int cnt = 0;
#pragma unroll
        for (int j0 = 0; j0 < 64; j0 += 8) {
#pragma unroll
            for (int j = j0; j < j0 + 8; ++j) cnt += __popcll(__ballot(v[j] != NINF && sortable(v[j]) >= cand));
            __builtin_amdgcn_sched_barrier(0); }
        if (cnt >= NSEL) prefix = cand; }
    int ngt = 0;
#pragma unroll
    for (int j = 0; j < 64; ++j) ngt += __popcll(__ballot(v[j] != NINF && sortable(v[j]) > prefix));
    int rem = NSEL - ngt, last = 0;
#pragma unroll
    for (int j = 0; j < 64; ++j) { const u64 em = __ballot(v[j] != NINF && sortable(v[j]) == prefix); const int c = __popcll(em);
        if (rem > 0 && c > 0) { if (c >= rem) { u64 x = em; for (int q = 1; q < rem; ++q) x &= x - 1ull; last = 64 * j + __builtin_ctzll(x); rem = 0; } else rem -= c; } }
    const unsigned pb = (prefix & 0x80000000u) ? (prefix & 0x7fffffffu) : ~prefix; const float Tv = __builtin_bit_cast(float, pb); const int Tidx = last;
    mlo = 0u; mhi = 0u;
#pragma unroll
    for (int j = 0; j < 64; ++j) { const bool sel = (v[j] > Tv) || (v[j] == Tv && lane + 64 * j <= Tidx); const u64 m = __ballot(sel);
        asm volatile("s_nop 4\n\tv_writelane_b32 %0, %2, %4\n\tv_writelane_b32 %1, %3, %4" : "+v"(mlo), "+v"(mhi) : "s"((unsigned)m), "s"((unsigned)(m >> 32)), "n"(j)); }
    mrow[(size_t)lane * SEQ] = (u64)mlo | ((u64)mhi << 32);
    return;
    }
}
__device__ __forceinline__ float relu_i(float x) { const int b = __builtin_bit_cast(int, x); return __builtin_bit_cast(float, b > 0 ? b : 0); }
__device__ __forceinline__ void p_index(Frame& F) {
    const int wave = F.wave;
    const GAS bf16* PROJ = (const GAS bf16*)(F.ws + WS_PROJ); const GAS bf16* KIN = (const GAS bf16*)(F.ws + WS_KIN); GAS float* SC = (GAS float*)(F.ws + WS_SC); GAS unsigned* MASK = (GAS unsigned*)(F.ws + WS_MASK);
    LAS unsigned* hist = (LAS unsigned*)(F.lds + wave * 4096);
    LAS float* ckey = (LAS float*)(F.lds + 32768 + wave * 1024); LAS int* cidx = (LAS int*)(ckey + 64);
    for (int ui = 0; ui < 2; ++ui) {
        const int v = F.vcu; if (v >= 256) break;
        const int b = v & 3, j = v >> 2, qb = ui == 0 ? j : 127 - j, q0 = qb * 32;
        int lane = F.tid & 63; asm volatile("" : "+v"(lane)); const int l15 = lane & 15, l4 = lane >> 4;
        bf16x8 bq[2][8]; float wq[2][8];
#pragma unroll
        for (int hq = 0; hq < 2; ++hq) { const size_t rowq = (size_t)(b * SEQ + q0 + 16 * hq + l15);
#pragma unroll
            for (int h = 0; h < 8; ++h) { bq[hq][h] = *(const GAS bf16x8*)(PROJ + rowq * NINP + C_QI + h * 32 + 8 * l4); wq[hq][h] = bf2f(PROJ[rowq * NINP + C_WI + h]) * 0.0625f; } }
        GAS float* srow = SC + (size_t)(b * SEQ + q0 + l15) * SCS + 4 * l4;
        const int ktl = 2 * qb + 1; const GAS bf16* kin0 = KIN + (size_t)(b * SEQ + l15) * 32 + 8 * l4;
        bf16x8 a = *(const GAS bf16x8*)(kin0 + (size_t)((wave <= ktl ? wave : ktl) * 16) * 32);
        for (int kt = wave; kt <= ktl; kt += NWAVES) {
            const int ktn = kt + NWAVES <= ktl ? kt + NWAVES : kt;
            const bf16x8 an = *(const GAS bf16x8*)(kin0 + (size_t)(ktn * 16) * 32);
#pragma unroll
            for (int hq = 0; hq < 2; ++hq) { f32x4 sc = (f32x4){0.f, 0.f, 0.f, 0.f};
#pragma unroll
                for (int h = 0; h < 8; ++h) { const f32x4 d = __builtin_amdgcn_mfma_f32_16x16x32_bf16(a, bq[hq][h], (f32x4){0.f, 0.f, 0.f, 0.f}, 0, 0, 0);
                    sc.x += relu_i(d.x) * wq[hq][h]; sc.y += relu_i(d.y) * wq[hq][h]; sc.z += relu_i(d.z) * wq[hq][h]; sc.w += relu_i(d.w) * wq[hq][h]; }
                *(GAS f32x4*)(srow + (size_t)(16 * hq) * SCS + kt * 16) = sc; }
            a = an;
        }
        asm volatile("s_waitcnt vmcnt(0)" ::: "memory"); __syncthreads();
        int lane_s = F.tid & 63; asm volatile("" : "+v"(lane_s));
        for (int r = 0; r < 4; ++r) select_row(b * SEQ + q0 + wave * 4 + r, SC, MASK, hist, ckey, cidx, lane_s);
#ifdef EXP_DUP_SELECT
        for (int r = 0; r < 4; ++r) select_row(b * SEQ + q0 + wave * 4 + r, SC, MASK, hist, ckey, cidx, lane_s);
#endif
    }
}

namespace att {
typedef float f32x16 __attribute__((ext_vector_type(16)));
typedef short s16x4 __attribute__((ext_vector_type(4)));
constexpr int NSLOT = 3, SLOTB = 8192, LDS_K = 0, LDS_V = NSLOT * SLOTB, LDS_WS = 2 * NSLOT * SLOTB, LDS_OST = LDS_WS + 8 * 64 * 4, LDS_BYTES_ATT = LDS_OST + 8 * 4096;
constexpr float THR = 100.f;
__device__ __forceinline__ int crow(int r, int hi) { return (r & 3) + 8 * (r >> 2) + 4 * hi; }
__device__ __forceinline__ unsigned cvtpk(float lo, float hi) { typedef float f2 __attribute__((ext_vector_type(2))); typedef __bf16 b2 __attribute__((ext_vector_type(2))); f2 v = {lo, hi}; b2 b = __builtin_convertvector(v, b2); return __builtin_bit_cast(unsigned, b); }
__device__ __forceinline__ float rowmax(const f32x16& p0, const f32x16& p1) {
    float a = fmaxf(fmaxf(p0[0], p0[1]), p1[0]), b = fmaxf(fmaxf(p0[2], p0[3]), p1[1]); a = fmaxf(fmaxf(a, p1[2]), p1[3]);
#pragma unroll
    for (int r = 4; r < 16; r += 4) { a = fmaxf(fmaxf(a, p0[r]), p0[r + 1]); b = fmaxf(fmaxf(b, p0[r + 2]), p0[r + 3]); a = fmaxf(fmaxf(a, p1[r]), p1[r + 1]); b = fmaxf(fmaxf(b, p1[r + 2]), p1[r + 3]); }
    const float m = fmaxf(a, b);
    return fmaxf(m, __shfl_xor(m, 32));
}
__device__ __forceinline__ void pv(f32x16* o, int vb, bf16x8 pa0, bf16x8 pa1, bf16x8 pa2, bf16x8 pa3) {
#pragma unroll
    for (int d0 = 0; d0 < 2; ++d0) { s16x4 lo[4], hi[4];
#pragma unroll
        for (int ks = 0; ks < 4; ++ks) {
            asm volatile("ds_read_b64_tr_b16 %0,%1 offset:%c2" : "=&v"(lo[ks]) : "v"(vb), "i"(d0 * 4096 + ks * 1024) : "memory");
            asm volatile("ds_read_b64_tr_b16 %0,%1 offset:%c2" : "=&v"(hi[ks]) : "v"(vb), "i"(d0 * 4096 + ks * 1024 + 512) : "memory"); }
        asm volatile("s_waitcnt lgkmcnt(0)" ::: "memory"); __builtin_amdgcn_sched_barrier(0);
#define ATT_PK(k) (bf16x8){lo[k][0], lo[k][1], lo[k][2], lo[k][3], hi[k][0], hi[k][1], hi[k][2], hi[k][3]}
        o[d0] = __builtin_amdgcn_mfma_f32_32x32x16_bf16(pa0, ATT_PK(0), o[d0], 0, 0, 0);
        o[d0] = __builtin_amdgcn_mfma_f32_32x32x16_bf16(pa1, ATT_PK(1), o[d0], 0, 0, 0);
        o[d0] = __builtin_amdgcn_mfma_f32_32x32x16_bf16(pa2, ATT_PK(2), o[d0], 0, 0, 0);
        o[d0] = __builtin_amdgcn_mfma_f32_32x32x16_bf16(pa3, ATT_PK(3), o[d0], 0, 0, 0);
#undef ATT_PK
    }
}
}
template <bool grpB> __device__ __forceinline__ void attn_units(Frame& F) {
    using namespace att;
    const int tid = F.tid, lane = tid & 63, r32 = lane & 31, hi = lane >> 5, wid = F.wave;
    const GAS bf16* PROJ = (const GAS bf16*)(F.ws + WS_PROJ); GAS bf16* CAT = (GAS bf16*)(F.ws + WS_CAT); const GAS u64* MASKT = (const GAS u64*)(F.ws + WS_MASK);
    LAS unsigned char* shm = F.lds;
    constexpr int NSV = 4, LDS_V2 = NSLOT * SLOTB, LDS_WS2 = LDS_V2 + NSV * SLOTB, LDS_OST2 = LDS_WS2 + 8 * 64 * 4;
    LAS float* wsf = (LAS float*)(shm + LDS_WS2) + wid * 64;
    const float NEGINF = -INFINITY;
    for (int ui = 0; ui < 2; ++ui) {
        const int v = F.vcu; if (v >= 256) break;
        const int bh = v >> 3, sidx = v & 7, b = bh >> 3, h = bh & 7, qb = ui == 0 ? sidx : 15 - sidx;
        const size_t rowbase = (size_t)b * SEQ; const int q0 = qb * 256, NT = (q0 + 256) / 64;
        const float slope2 = exp2f(-(float)(h + 1)) * 1.4426950408889634f;
        const GAS bf16* Kh = PROJ + rowbase * NINP + C_K + h * 64; const GAS bf16* Vh = PROJ + rowbase * NINP + C_V + h * 64;
        const GAS bf16* ksrc = Kh + (size_t)lane * NINP + wid * 8;
        const GAS bf16* vsrc = Vh + (size_t)(16 * (wid & 3) + (lane >> 2)) * NINP + (wid >> 2) * 32 + (lane & 3) * 8;
#define ATT_DMA(t, ks, vs) do { __builtin_amdgcn_global_load_lds((const GAS unsigned*)(ksrc + (size_t)(t) * 64 * NINP), (LAS unsigned*)(shm + LDS_K + (ks) * SLOTB + wid * 1024), 16, 0, 0); \
                        __builtin_amdgcn_global_load_lds((const GAS unsigned*)(vsrc + (size_t)(t) * 64 * NINP), (LAS unsigned*)(shm + LDS_V2 + (vs) * SLOTB + wid * 1024), 16, 0, 0); } while (0)
        ATT_DMA(0, 0, 0); ATT_DMA(1, 1, 1);
        const GAS bf16* Qw = PROJ + (rowbase + q0 + wid * 32) * NINP + C_Q + h * 64;
        bf16x8 qr[4];
#pragma unroll
        for (int d0 = 0; d0 < 4; ++d0) qr[d0] = *(const GAS bf16x8*)(Qw + (size_t)r32 * NINP + d0 * 16 + hi * 8);
        const GAS u64* mq = MASKT + ((size_t)b * 64) * SEQ + q0 + wid * 32 + r32;
        u64 mnext = mq[0], mprev = 0ull;
        f32x16 o[2], p0 = f32x16{}, p1 = f32x16{}; o[0] = f32x16{}; o[1] = f32x16{};
        float l_reg = 0.f, sq = 0.f;
        const unsigned sl_hi = __builtin_bit_cast(unsigned, slope2) & 0xffff0000u; const unsigned sl_lo = f2bf(slope2 - __builtin_bit_cast(float, sl_hi));
        bf16x8 kx0, kx1;
        { const unsigned j0 = hi ? 0u : (f2bf((float)r32) * 0x10001u), j1 = hi ? 0u : (f2bf((float)(r32 + 32)) * 0x10001u), one2 = hi ? 0u : 0x3f803f80u, one1 = hi ? 0u : 0x3f80u;
          kx0 = __builtin_bit_cast(bf16x8, (v4u){j0, one2, one1, 0u}); kx1 = __builtin_bit_cast(bf16x8, (v4u){j1, one2, one1, 0u}); }
        const int qlast = q0 + wid * 32 + 31;
        const int vb0 = (int)(unsigned)(uintptr_t)(shm + LDS_V2) + ((lane >> 4) & 1) * 32 + (lane & 3) * 8 + (4 * hi + ((lane & 15) >> 2)) * 64;
#define ATT_QK(ks) do { const LAS unsigned char* kb = shm + LDS_K + (ks) * SLOTB + hi * 1024 + r32 * 16; \
            { const unsigned u0_ = __builtin_bit_cast(unsigned, sq), a1_ = u0_ & 0xffff0000u; const float r1_ = sq - __builtin_bit_cast(float, a1_); const unsigned u1_ = __builtin_bit_cast(unsigned, r1_), a2_ = u1_ & 0xffff0000u; \
              const float r2_ = r1_ - __builtin_bit_cast(float, a2_); const unsigned a3_ = __builtin_bit_cast(unsigned, r2_) >> 16; \
              const bf16x8 qx = __builtin_bit_cast(bf16x8, (v4u){hi ? 0u : ((sl_hi >> 16) | (sl_lo << 16)), hi ? 0u : ((a1_ >> 16) | a2_), hi ? 0u : a3_, 0u}); \
              const f32x16 z_ = f32x16{}; p0 = __builtin_amdgcn_mfma_f32_32x32x16_bf16(kx0, qx, z_, 0, 0, 0); p1 = __builtin_amdgcn_mfma_f32_32x32x16_bf16(kx1, qx, z_, 0, 0, 0); } \
            _Pragma("unroll") for (int d0 = 0; d0 < 4; ++d0) { const bf16x8 k0 = *(const LAS bf16x8*)(kb + d0 * 2048), k1 = *(const LAS bf16x8*)(kb + d0 * 2048 + 512); \
                p0 = __builtin_amdgcn_mfma_f32_32x32x16_bf16(k0, qr[d0], p0, 0, 0, 0); p1 = __builtin_amdgcn_mfma_f32_32x32x16_bf16(k1, qr[d0], p1, 0, 0, 0); } } while (0)
#define ATT_SMPV(vs, mw) do { const unsigned w0 = (unsigned)(mw) >> (4 * hi), w1 = (unsigned)((mw) >> 32) >> (4 * hi); \
            asm volatile("s_nop 15\n\ts_nop 7" : "+v"(p0), "+v"(p1));   \
            _Pragma("unroll") for (int r = 0; r < 16; ++r) { const int cr = (r & 3) + 8 * (r >> 2); const int k0_ = __builtin_amdgcn_sbfe((int)w0, cr, 1), k1_ = __builtin_amdgcn_sbfe((int)w1, cr, 1); \
                asm("v_bfi_b32 %0, %1, %0, %2" : "+v"(p0[r]) : "v"(k0_), "v"(NEGINF)); asm("v_bfi_b32 %0, %1, %0, %2" : "+v"(p1[r]) : "v"(k1_), "v"(NEGINF)); } \
            const float rm = rowmax(p0, p1); bool resc = false; \
            if (__any(rm > THR)) { const float dl = fmaxf(rm, 0.f); \
                _Pragma("unroll") for (int r = 0; r < 16; ++r) { p0[r] -= dl; p1[r] -= dl; } sq -= dl; \
                const float f = __builtin_amdgcn_exp2f(-dl); l_reg *= f; if (hi == 0) wsf[r32] = f; resc = true; } \
            float sacc = 0.f; \
            _Pragma("unroll") for (int r = 0; r < 16; ++r) { p0[r] = __builtin_amdgcn_exp2f(p0[r]); p1[r] = __builtin_amdgcn_exp2f(p1[r]); sacc += p0[r] + p1[r]; } \
            l_reg += sacc; \
            if (resc) { asm volatile("s_waitcnt lgkmcnt(0)" ::: "memory"); \
                _Pragma("unroll") for (int d_ = 0; d_ < 2; ++d_) _Pragma("unroll") for (int r = 0; r < 16; ++r) o[d_][r] *= wsf[crow(r, hi)]; } \
            const v4u pw0 = (v4u){cvtpk(p0[0], p0[1]), cvtpk(p0[2], p0[3]), cvtpk(p0[4], p0[5]), cvtpk(p0[6], p0[7])}, pw1 = (v4u){cvtpk(p0[8], p0[9]), cvtpk(p0[10], p0[11]), cvtpk(p0[12], p0[13]), cvtpk(p0[14], p0[15])}; \
            const v4u pw2 = (v4u){cvtpk(p1[0], p1[1]), cvtpk(p1[2], p1[3]), cvtpk(p1[4], p1[5]), cvtpk(p1[6], p1[7])}, pw3 = (v4u){cvtpk(p1[8], p1[9]), cvtpk(p1[10], p1[11]), cvtpk(p1[12], p1[13]), cvtpk(p1[14], p1[15])}; \
            __builtin_amdgcn_sched_barrier(0); \
            pv(o, vb0 + (vs) * SLOTB, __builtin_bit_cast(bf16x8, pw0), __builtin_bit_cast(bf16x8, pw1), __builtin_bit_cast(bf16x8, pw2), __builtin_bit_cast(bf16x8, pw3)); } while (0)
        if constexpr (grpB) __builtin_amdgcn_s_setprio(1);
        const float step = 64.f * slope2;
        int ks = 0, vs = 0;
        u64 mcur = 0ull;
#define ATT_SYNC(t) do { if ((t) + 1 < NT) asm volatile("s_waitcnt vmcnt(2)" ::: "memory"); else asm volatile("s_waitcnt vmcnt(0)" ::: "memory"); \
            asm volatile("s_waitcnt lgkmcnt(0)" ::: "memory"); __builtin_amdgcn_s_barrier(); asm volatile("" ::: "memory"); \
            mprev = mcur; mcur = mnext; if ((t) + 1 < NT) mnext = mq[(size_t)((t) + 1) * SEQ]; \
            __builtin_amdgcn_sched_barrier(0); \
            if ((t) + 2 < NT) ATT_DMA((t) + 2, ks + 2 >= NSLOT ? ks + 2 - NSLOT : ks + 2, vs + 2 >= NSV ? vs + 2 - NSV : vs + 2); \
            __builtin_amdgcn_sched_barrier(0); } while (0)
#define ATT_ADV() do { sq += step; ks = ks + 1 >= NSLOT ? 0 : ks + 1; vs = vs + 1 >= NSV ? 0 : vs + 1; } while (0)
        const int tmax = qlast >> 6;
        if constexpr (!grpB) {
            int t = 0;
            for (; t <= tmax; ++t) { ATT_SYNC(t); ATT_QK(ks); ATT_SMPV(vs, mcur); ATT_ADV(); }
            for (; t < NT; ++t) { ATT_SYNC(t); ATT_ADV(); }
        } else {
            ATT_SYNC(0); ATT_QK(ks); ATT_ADV();
            int t = 1;
            for (; t <= tmax; ++t) { ATT_SYNC(t); ATT_SMPV(vs == 0 ? NSV - 1 : vs - 1, mprev); ATT_QK(ks); ATT_ADV(); }
            if (t < NT) { ATT_SYNC(t); ATT_SMPV(vs == 0 ? NSV - 1 : vs - 1, mprev); ATT_ADV(); ++t;
                for (; t < NT; ++t) { ATT_SYNC(t); ATT_ADV(); } }
            else { ATT_SMPV(vs == 0 ? NSV - 1 : vs - 1, mcur); }
        }
#undef ATT_SYNC
#undef ATT_ADV
        __builtin_amdgcn_s_setprio(0);
        l_reg += __shfl_xor(l_reg, 32);
        if (hi == 0) wsf[32 + r32] = l_reg;
        asm volatile("s_waitcnt lgkmcnt(0)" ::: "memory");
        float rli[16];
#pragma unroll
        for (int r = 0; r < 16; ++r) rli[r] = 1.f / wsf[32 + crow(r, hi)];
        GAS bf16* Ow = CAT + (rowbase + q0 + wid * 32) * D + 512 + h * 64;
        { LAS bf16* stg = (LAS bf16*)(shm + LDS_OST2) + wid * 2048;
#pragma unroll
            for (int r = 0; r < 16; ++r) { const int orow = crow(r, hi);
#pragma unroll
                for (int d0 = 0; d0 < 2; ++d0) stg[orow * 64 + d0 * 32 + r32] = (bf16)f2bf(o[d0][r] * rli[r]); }
            asm volatile("s_waitcnt lgkmcnt(0)" ::: "memory");
#pragma unroll
            for (int i = 0; i < 4; ++i) { const int row = i * 8 + (lane >> 3), ch = lane & 7; const v4u vv = *(const LAS v4u*)(stg + row * 64 + ch * 8); *(GAS v4u*)(Ow + (size_t)row * D + ch * 8) = vv; } }
        asm volatile("s_waitcnt vmcnt(0) lgkmcnt(0)" ::: "memory"); __builtin_amdgcn_s_barrier(); asm volatile("" ::: "memory");
#undef ATT_DMA
#undef ATT_QK
#undef ATT_SMPV
    }
}

__device__ __forceinline__ void p_attn_dense(Frame& F) { if (F.wave >= 4) attn_units<true>(F); else attn_units<false>(F); }

struct EpiResid {
    static constexpr bool PERM = true, AFTER_DRAIN = false;
    const bf16* resid; bf16* out; float alpha;
    __device__ __forceinline__ void operator()(const pg8::f32x4 (&acc)[2][2][4][2], const pg8::Unit& u, int wr, int wc, int fr, int fq) const {
        const int col0 = u.pn * 256 + wc * 32 + 8 * fq;
#pragma unroll
        for (int ai = 0; ai < 2; ++ai)
#pragma unroll
            for (int m = 0; m < 4; ++m) { const size_t off = (size_t)(u.pm * 256 + ai * 128 + wr * 64 + m * 16 + fr) * D + col0;
#pragma unroll
                for (int bj = 0; bj < 2; ++bj) { const v4u xr = *(const GAS v4u*)(resid + off + bj * 128); const f32x4 a0 = acc[ai][bj][m][0], a1 = acc[ai][bj][m][1];
                    v4u w; w.x = pk2(bflo(xr.x) * alpha + a0[0], bfhi(xr.x) * alpha + a0[1]); w.y = pk2(bflo(xr.y) * alpha + a0[2], bfhi(xr.y) * alpha + a0[3]);
                    w.z = pk2(bflo(xr.z) * alpha + a1[0], bfhi(xr.z) * alpha + a1[1]); w.w = pk2(bflo(xr.w) * alpha + a1[2], bfhi(xr.w) * alpha + a1[3]);
                    st16_wt(out + off + bj * 128, w.x, w.y, w.z, w.w); }
                if (m & 1) asm volatile("" ::: "memory"); }
    }
};
struct EpiSwiglu {
    static constexpr bool PERM = true, AFTER_DRAIN = false;
    unsigned char* O; const float* bias;
    __device__ __forceinline__ void operator()(const pg8::f32x4 (&acc)[2][2][4][2], const pg8::Unit& u, int wr, int wc, int fr, int fq) const {
        const int e = u.pn >> 3, nt = u.pn & 7; const int colg = nt * 128 + wc * 32 + 8 * fq;
        f32x4 bg[2], bu[2];
#pragma unroll
        for (int n = 0; n < 2; ++n) { bg[n] = *(const GAS f32x4*)(bias + (size_t)e * 2048 + colg + 4 * n); bu[n] = *(const GAS f32x4*)(bias + (size_t)e * 2048 + 1024 + colg + 4 * n); }
#pragma unroll
        for (int ai = 0; ai < 2; ++ai)
#pragma unroll
            for (int m = 0; m < 4; ++m) { const size_t row = (size_t)(u.pm * 256 + ai * 128 + wr * 64 + m * 16 + fr); float a8[8];
#pragma unroll
                for (int n = 0; n < 2; ++n)
#pragma unroll
                    for (int i = 0; i < 4; i += 2) {
                        typedef float f2 __attribute__((ext_vector_type(2)));
                        const f2 ag = {acc[ai][0][m][n][i], acc[ai][0][m][n][i + 1]}, au = {acc[ai][1][m][n][i], acc[ai][1][m][n][i + 1]};
                        const f2 bgv = {bg[n][i], bg[n][i + 1]}, buv = {bu[n][i] + 1.f, bu[n][i + 1] + 1.f};
                        f2 g = ag * (1.f / WGU_SCALE) + bgv, up1 = au * (1.f / WGU_SCALE) + buv;
                        g.x = fminf(g.x, 7.f); g.y = fminf(g.y, 7.f); up1.x = fminf(fmaxf(up1.x, -6.f), 8.f); up1.y = fminf(fmaxf(up1.y, -6.f), 8.f);
                        f2 t = g * (-1.702f * 1.4426950408889634f); t.x = __builtin_amdgcn_exp2f(t.x); t.y = __builtin_amdgcn_exp2f(t.y);
                        f2 d = t + 1.f; d.x = __builtin_amdgcn_rcpf(d.x); d.y = __builtin_amdgcn_rcpf(d.y);
                        const f2 r = g * up1 * d; a8[n * 4 + i] = r.x; a8[n * 4 + i + 1] = r.y; }
                v2u w; w.x = pk4_fp8(a8[0], a8[1], a8[2], a8[3]); w.y = pk4_fp8(a8[4], a8[5], a8[6], a8[7]);
                st8_wt(O + row * 1024 + colg, w.x, w.y); }
    }
};
struct EpiDown {
    static constexpr bool PERM = true, AFTER_DRAIN = false;
    bf16* O; const float* bias;
    __device__ __forceinline__ void operator()(const pg8::f32x4 (&acc)[2][2][4][2], const pg8::Unit& u, int wr, int wc, int fr, int fq) const {
        const int col0 = (u.pn & 3) * 256 + wc * 32 + 8 * fq; const float* bp = bias + (size_t)(u.pn >> 2) * 1024 + col0;
        f32x4 bv[2][2];
#pragma unroll
        for (int bj = 0; bj < 2; ++bj)
#pragma unroll
            for (int n = 0; n < 2; ++n) bv[bj][n] = *(const GAS f32x4*)(bp + bj * 128 + 4 * n);
#pragma unroll
        for (int ai = 0; ai < 2; ++ai)
#pragma unroll
            for (int m = 0; m < 4; ++m) { bf16* rowp = O + (size_t)(u.pm * 256 + ai * 128 + wr * 64 + m * 16 + fr) * 1024 + col0;
#pragma unroll
                for (int bj = 0; bj < 2; ++bj) { const f32x4 v0 = acc[ai][bj][m][0] * (1.f / WDN_SCALE) + bv[bj][0], v1 = acc[ai][bj][m][1] * (1.f / WDN_SCALE) + bv[bj][1];
                    v4u w; w.x = pk2(v0[0], v0[1]); w.y = pk2(v0[2], v0[3]); w.z = pk2(v1[0], v1[1]); w.w = pk2(v1[2], v1[3]);
                    st16_wt(rowp + bj * 128, w.x, w.y, w.z, w.w); } }
    }
};
struct MoeSched {
    const LAS int* tab; int n;
    __device__ __forceinline__ bool next(int i, pg8::Unit& u) const {
        if (i >= n) return false;
        const int v = __builtin_amdgcn_readfirstlane(tab[1 + i]); u.pm = v >> 16; u.pn = v & 0xffff; return true;
    }
    __device__ __forceinline__ void a_ready(const pg8::Unit&) const {}
    __device__ __forceinline__ void done(const pg8::Unit&) const {}
};
#ifndef MOE_UNIT_OWNER
#define MOE_UNIT_OWNER F.vcu
#endif
__device__ __forceinline__ int moe_table(Frame& F, int l, int ntn) {
    LAS int* tab = (LAS int*)(F.lds + TAB_OFF);
    if (F.wave == 0) {
        const int lane = F.lane; const int cnt = lane < NE ? (int)__hip_atomic_load(F.ctl + CW_CNT + 64 * l + lane, RLX_AGENT) : 0; const int mt = (cnt + 255) >> 8; int incl = mt;
#pragma unroll
        for (int o = 1; o < 64; o <<= 1) { const int v = __shfl_up(incl, o); if (lane >= o) incl += v; }
        const int total = __shfl(incl, 63) * ntn; const int c = MOE_UNIT_OWNER;
        const int xcd = c >> 5, jw = c & 31, uq = total >> 3, ur = total & 7, cntx = uq + (xcd < ur ? 1 : 0), basex = xcd * uq + (xcd < ur ? xcd : ur);
        const int nmine = jw < cntx ? (cntx - jw + 31) >> 5 : 0;
        for (int i0 = 0; i0 < nmine && i0 < 200; i0 += 64) { const int i = i0 + lane; const int L = basex + i * 32 + jw; int e = 0;
            for (int k = 0; k < NE; ++k) { const int endk = __shfl(incl, k) * ntn; e += (L >= endk) ? 1 : 0; }
            e = e < NE ? e : NE - 1;
            const int excl_e = __shfl(incl, e) - __shfl(mt, e); int mte = __shfl(mt, e); mte = mte > 0 ? mte : 1; const int idx = L - excl_e * ntn;
            if (i < nmine && i < 200) tab[1 + i] = ((excl_e + idx % mte) << 16) | (e * ntn + idx / mte); }
        if (lane == 0) tab[0] = nmine < 200 ? nmine : 200;
    }
    __syncthreads();
    return __builtin_amdgcn_readfirstlane(tab[0]);
}

__device__ __forceinline__ void p_router(Frame& F, const In6& A, int l) {
    const int lane = F.lane, wave = F.wave, tid = F.tid;
    constexpr int XROW = 2064;
    LAS unsigned char* XH = F.lds; LAS unsigned char* XL = F.lds + 16 * XROW;
    LAS float* part = (LAS float*)(F.lds + 2 * 16 * XROW);
    LAS int* cnt = (LAS int*)(F.lds + 2 * 16 * XROW + 16384);
    LAS float* lgs = (LAS float*)(F.lds + 2 * 16 * XROW + 16384 + 1024);
    LAS float* top = lgs + 512;
    const GAS bf16* Y1 = (const GAS bf16*)(F.ws + WS_Y1); GAS bf16* X1B = (GAS bf16*)(F.ws + WS_Y1 + 32 * MiB); GAS unsigned* XB8 = (GAS unsigned*)(F.ws + WS_XB8);
    GAS int* TOPE = (GAS int*)(F.ws + WS_ROUTE); GAS float* GATE = (GAS float*)(TOPE + 8 * T); GAS int* CNTW = (GAS int*)(F.ws + WS_CNTW);
    const GAS float* g1 = (const GAS float*)(A.p[0] + l * D); const GAS float* b1 = (const GAS float*)(A.p[1] + l * D);
    const GAS float* RW = (const GAS float*)(A.p[2] + (size_t)l * D * NE); const GAS float* RB = (const GAS float*)(A.p[3] + l * NE);
    if (tid < 256) cnt[tid] = 0;
    bf16x8 wh[4][2], wl[4][2];
#pragma unroll
    for (int st = 0; st < 4; ++st)
#pragma unroll
        for (int hf = 0; hf < 2; ++hf) { const GAS float* wp = RW + (size_t)(wave * 128 + st * 32 + (lane >> 4) * 8) * NE + (lane & 15) + 16 * hf;
#pragma unroll
            for (int j = 0; j < 8; ++j) { const float w = wp[(size_t)j * NE]; const unsigned h = f2bf(w); const float r = w - __builtin_bit_cast(float, h << 16); wh[st][hf][j] = (short)h; wl[st][hf][j] = (short)f2bf(r); } }
    f32x4 g1v[4], b1v[4];
#pragma unroll
    for (int j = 0; j < 4; ++j) { g1v[j] = ((const GAS f32x4*)g1)[lane + 64 * j]; b1v[j] = ((const GAS f32x4*)b1)[lane + 64 * j]; }
    const float rb_e = RB[tid & 31];
    v2u yq[2][4];
#pragma unroll
    for (int i = 0; i < 2; ++i) { const GAS v2u* yr = (const GAS v2u*)(Y1 + (size_t)(F.vcu * 64 + wave * 2 + i) * D) + lane;
#pragma unroll
        for (int j = 0; j < 4; ++j) yq[i][j] = yr[64 * j]; }
    for (int g = 0; g < 4; ++g) {
        const int t0 = F.vcu * 64 + g * 16;
#pragma unroll
        for (int i = 0; i < 2; ++i) { const int tl = wave * 2 + i, t = t0 + tl;
            GAS u64* xr1 = (GAS u64*)(X1B + (size_t)t * D) + lane; f32x4 v[4]; float s = 0.f;
#pragma unroll
            for (int j = 0; j < 4; ++j) { const v2u q = yq[i][j]; v[j] = (f32x4){bflo(q.x), bfhi(q.x), bflo(q.y), bfhi(q.y)}; s += (v[j].x + v[j].y) + (v[j].z + v[j].w); }
            if (g < 3) { const GAS v2u* yr = (const GAS v2u*)(Y1 + (size_t)(t + 16) * D) + lane;
#pragma unroll
                for (int j = 0; j < 4; ++j) yq[i][j] = yr[64 * j]; }
            const float mean = wave_sum(s) * (1.f / D); float s2 = 0.f;
#pragma unroll
            for (int j = 0; j < 4; ++j) { v[j] = v[j] - mean; s2 += (v[j].x * v[j].x + v[j].y * v[j].y) + (v[j].z * v[j].z + v[j].w * v[j].w); }
            const float rstd = rsqrtf(wave_sum(s2) * (1.f / D) + LN_EPS);
            GAS unsigned* o8 = XB8 + (size_t)t * (D / 4) + lane;
#pragma unroll
            for (int j = 0; j < 4; ++j) { const f32x4 y = v[j] * rstd * g1v[j] + b1v[j];
                o8[64 * j] = pk4_fp8(y.x, y.y, y.z, y.w);
                const unsigned h0 = f2bf(y.x), h1 = f2bf(y.y), h2 = f2bf(y.z), h3 = f2bf(y.w);
                const u64 hp = (u64)(h0 | (h1 << 16)) | ((u64)(h2 | (h3 << 16)) << 32); xr1[64 * j] = hp;
                const float r0 = y.x - __builtin_bit_cast(float, h0 << 16), r1 = y.y - __builtin_bit_cast(float, h1 << 16), r2 = y.z - __builtin_bit_cast(float, h2 << 16), r3 = y.w - __builtin_bit_cast(float, h3 << 16);
                *(LAS u64*)(XH + tl * XROW + (lane + 64 * j) * 8) = hp;
                *(LAS u64*)(XL + tl * XROW + (lane + 64 * j) * 8) = (u64)pk2(r0, r1) | ((u64)pk2(r2, r3) << 32); } }
        __syncthreads();
        f32x4 acc[2]; acc[0] = (f32x4){0.f, 0.f, 0.f, 0.f}; acc[1] = acc[0];
#pragma unroll
        for (int st = 0; st < 4; ++st) { const int boff = (lane & 15) * XROW + (wave * 128 + st * 32 + (lane >> 4) * 8) * 2;
            const bf16x8 bh = *(const LAS bf16x8*)(XH + boff), bl = *(const LAS bf16x8*)(XL + boff);
#pragma unroll
            for (int hf = 0; hf < 2; ++hf) { acc[hf] = __builtin_amdgcn_mfma_f32_16x16x32_bf16(wh[st][hf], bh, acc[hf], 0, 0, 0); acc[hf] = __builtin_amdgcn_mfma_f32_16x16x32_bf16(wh[st][hf], bl, acc[hf], 0, 0, 0);
                acc[hf] = __builtin_amdgcn_mfma_f32_16x16x32_bf16(wl[st][hf], bh, acc[hf], 0, 0, 0); } }
#pragma unroll
        for (int hf = 0; hf < 2; ++hf)
#pragma unroll
            for (int r = 0; r < 4; ++r) part[((wave * 2 + hf) * 16 + 4 * (lane >> 4) + r) * 16 + (lane & 15)] = acc[hf][r];
        __syncthreads();
        { const int tl = tid >> 5, e = tid & 31, t = t0 + tl; float lg = rb_e;
#pragma unroll
            for (int w = 0; w < 8; ++w) lg += part[((w * 2 + (e >> 4)) * 16 + (e & 15)) * 16 + tl];
            lgs[tl * 32 + e] = lg;
            LDS_WAIT(); asm volatile("" ::: "memory");
            int rank = 0;
#pragma unroll
            for (int q = 0; q < 8; ++q) { const f32x4 o = *(const LAS f32x4*)(lgs + tl * 32 + 4 * q);
#pragma unroll
                for (int i = 0; i < 4; ++i) { const int eo = 4 * q + i; rank += (o[i] > lg || (o[i] == lg && eo < e)) ? 1 : 0; } }
            if (rank < 4) { top[tl * 4 + rank] = lg; __hip_atomic_fetch_add(cnt + ((g * 16 + tl) >> 3) * 32 + e, 1, __ATOMIC_RELAXED, __HIP_MEMORY_SCOPE_WORKGROUP); }
            LDS_WAIT(); asm volatile("" ::: "memory");
            const f32x4 sv = *(const LAS f32x4*)(top + tl * 4);
            const float e1 = expf(sv[1] - sv[0]), e2 = expf(sv[2] - sv[0]), e3 = expf(sv[3] - sv[0]); const float inv = 1.f / (1.f + e1 + e2 + e3);
            if (rank < 4) { const float gk = (rank == 0 ? 1.f : rank == 1 ? e1 : rank == 2 ? e2 : e3) * inv; TOPE[4 * t + rank] = e; GATE[4 * t + rank] = gk; } }
    }
    __syncthreads();
    if (tid < 256) CNTW[(F.vcu * NWAVES + (tid >> 5)) * NE + (tid & 31)] = cnt[tid];
    __syncthreads();
}

__device__ __forceinline__ void p_gather(Frame& F, int l) {
    const int gw = F.vcu * NWAVES + F.wave, NGW = F.G * NWAVES, lane = F.lane, tid = F.tid;
    const int TPW = T / NGW, NIT = TPW * 4;
    const GAS int* CNTW = (const GAS int*)(F.ws + WS_CNTW);
    LAS int* red = (LAS int*)F.lds;
    LAS int* baseE = red + 1024; LAS int* totE = baseE + 32;
    { const int e = tid & 31, part = tid >> 5, first = F.vcu * NWAVES; int sb = 0, st = 0;
        for (int g0 = part; g0 < NGW; g0 += 256) { int c[16];
#pragma unroll
            for (int k = 0; k < 16; ++k) c[k] = g0 + 16 * k < NGW ? CNTW[(g0 + 16 * k) * NE + e] : 0;
#pragma unroll
            for (int k = 0; k < 16; ++k) { st += c[k]; sb += g0 + 16 * k < first ? c[k] : 0; } }
        red[part * 32 + e] = sb; red[512 + part * 32 + e] = st; }
    __syncthreads();
    if (tid < 32) { int sb = 0, st = 0;
#pragma unroll
        for (int p = 0; p < 16; ++p) { sb += red[p * 32 + tid]; st += red[512 + p * 32 + tid]; }
        baseE[tid] = sb; totE[tid] = st;
        if (F.vcu == 0) __hip_atomic_store(F.ctl + CW_CNT + 64 * l + tid, (unsigned)st, RLX_AGENT); }
    __syncthreads();
    int mybase = 0, tot = 0;
    if (lane < NE) { mybase = baseE[lane]; tot = totE[lane]; int cw[NWAVES - 1];
#pragma unroll
        for (int w = 0; w < NWAVES - 1; ++w) cw[w] = CNTW[(F.vcu * NWAVES + w) * NE + lane];
#pragma unroll
        for (int w = 0; w < NWAVES - 1; ++w) mybase += w < F.wave ? cw[w] : 0; }
    const int mt = (tot + 255) >> 8; int incl = mt;
#pragma unroll
    for (int o = 1; o < 64; o <<= 1) { const int v = __shfl_up(incl, o); if (lane >= o) incl += v; }
    const int pstart = (incl - mt) * 256;
    const GAS int* TOPE = (const GAS int*)(F.ws + WS_ROUTE); GAS int* ROWOF = (GAS int*)(F.ws + WS_ROUTE) + 12 * T; GAS int* ROWTOK = (GAS int*)(F.ws + WS_XS);
    if (F.vcu < NE && F.wave == 0) {
        const int e = F.vcu; const int ps = __builtin_amdgcn_readlane(pstart, e), te = __builtin_amdgcn_readlane(tot, e), me = __builtin_amdgcn_readlane(mt, e);
        for (int i = te + lane; i < me * 256; i += 64) ROWTOK[ps + i] = 0; }
    const int it0 = gw * NIT; const int ei = lane < NIT ? TOPE[it0 + lane] : 0; int rk = 0;
    for (int j = 0; j < NIT; ++j) { const int ej = __shfl(ei, j); rk += (j < lane && ej == ei) ? 1 : 0; }
    const int row = __shfl(pstart, ei) + __shfl(mybase, ei) + rk;
    if (lane < NIT) { ROWOF[it0 + lane] = row; ROWTOK[row] = (it0 + lane) >> 2; }
    __syncthreads();
}

__device__ __forceinline__ void p_combine(Frame& F, const In6& A, int l, float* xout_) {
    constexpr int TPW = 8;
    const int gw = F.vcu * NWAVES + F.wave, NGW = F.G * NWAVES, lane = F.lane;
    const GAS int* ROWOF = (const GAS int*)(F.ws + WS_ROUTE) + 12 * T; const GAS float* GATE = (const GAS float*)(F.ws + WS_ROUTE) + 8 * T;
    const GAS bf16* X1B = (const GAS bf16*)(F.ws + WS_Y1 + 32 * MiB); const GAS bf16* YS = (const GAS bf16*)(F.ws + WS_YS); GAS bf16* XB = (GAS bf16*)(F.ws + WS_XB);
    GAS float* xout = (GAS float*)xout_;
    const GAS f32x4* g2 = (const GAS f32x4*)(A.p[0] + l * D) + lane; const GAS f32x4* b2 = (const GAS f32x4*)(A.p[1] + l * D) + lane;
    int rowv = 0; float gatev = 0.f;
    if (lane < 4 * TPW) { const int tk = gw + (lane >> 2) * NGW; rowv = ROWOF[4 * tk + (lane & 3)]; gatev = GATE[4 * tk + (lane & 3)]; }
    f32x4 gg[4], bb[4];
#pragma unroll
    for (int j = 0; j < 4; ++j) { gg[j] = g2[64 * j]; bb[j] = b2[64 * j]; }
    v2u xq[2][4], yq[2][4][4];
#define CMB_ISSUE(k, bf) do { const int t_ = gw + (k) * NGW; const GAS v2u* xr_ = (const GAS v2u*)(X1B + (size_t)t_ * D) + lane; \
        _Pragma("unroll") for (int j = 0; j < 4; ++j) xq[bf][j] = xr_[64 * j]; \
        _Pragma("unroll") for (int c = 0; c < 4; ++c) { const int row_ = __builtin_amdgcn_readlane(rowv, 4 * (k) + c); const GAS v2u* yr_ = (const GAS v2u*)(YS + (size_t)row_ * D) + lane; \
            _Pragma("unroll") for (int j = 0; j < 4; ++j) yq[bf][c][j] = yr_[64 * j]; } } while (0)
    CMB_ISSUE(0, 0);
#pragma unroll
    for (int k = 0; k < TPW; ++k) {
        const int bf = k & 1, t = gw + k * NGW;
        if (k + 1 < TPW) { if (bf == 0) CMB_ISSUE(k + 1, 1); else CMB_ISSUE(k + 1, 0); }
        f32x4 v[4];
#pragma unroll
        for (int j = 0; j < 4; ++j) { const v2u q = xq[bf][j]; v[j] = (f32x4){bflo(q.x), bfhi(q.x), bflo(q.y), bfhi(q.y)} * DN_ALPHA; }
#pragma unroll
        for (int c = 0; c < 4; ++c) { const float gk = __builtin_bit_cast(float, __builtin_amdgcn_readlane(__builtin_bit_cast(int, gatev), 4 * k + c));
#pragma unroll
            for (int j = 0; j < 4; ++j) { const v2u w = yq[bf][c][j]; v[j].x += gk * bflo(w.x); v[j].y += gk * bfhi(w.x); v[j].z += gk * bflo(w.y); v[j].w += gk * bfhi(w.y); } }
        float s = 0.f;
#pragma unroll
        for (int j = 0; j < 4; ++j) s += (v[j].x + v[j].y) + (v[j].z + v[j].w);
        const float mean = wave_sum(s) * (1.f / D); float s2 = 0.f;
#pragma unroll
        for (int j = 0; j < 4; ++j) { v[j] = v[j] - mean; s2 += (v[j].x * v[j].x + v[j].y * v[j].y) + (v[j].z * v[j].z + v[j].w * v[j].w); }
        const float rstd = rsqrtf(wave_sum(s2) * (1.f / D) + LN_EPS);
        GAS f32x4* orow = (GAS f32x4*)(xout + (size_t)t * D) + lane; GAS u64* o8 = (GAS u64*)(XB + (size_t)t * D) + lane;
#pragma unroll
        for (int j = 0; j < 4; ++j) { const f32x4 y = v[j] * rstd * gg[j] + bb[j];
            if (xout_) __builtin_nontemporal_store(y, orow + 64 * j); else o8[64 * j] = (u64)pk2(y.x, y.y) | ((u64)pk2(y.z, y.w) << 32); }
        __builtin_amdgcn_sched_barrier(0);
    }
#undef CMB_ISSUE
}


#define NI __device__ __forceinline__
NI void ph_prologue(unsigned char* ws, LAS unsigned char* lds, const float* a0, const float* a1, const float* a2, const float* a3, const float* a4) { Frame F = make_frame(ws, lds); In6 I{{uni(a0), uni(a1), uni(a2), uni(a3), uni(a4), nullptr}}; p_prologue(F, I); }
NI void ph_local(unsigned char* ws, LAS unsigned char* lds, int l, const float* a0, const float* a1, const float* a2, const float* a3, const float* a4) { Frame F = make_frame(ws, lds); In6 I{{uni(a0), uni(a1), uni(a2), uni(a3), uni(a4), nullptr}}; p_local(F, I, __builtin_amdgcn_readfirstlane(l)); }
NI void ph_scores(unsigned char* ws, LAS unsigned char* lds) { Frame F = make_frame(ws, lds); p_index(F); }
NI void ph_attn(unsigned char* ws, LAS unsigned char* lds) { Frame F = make_frame(ws, lds); p_attn_dense(F); }
NI void ph_router(unsigned char* ws, LAS unsigned char* lds, int l, const float* a0, const float* a1, const float* a2, const float* a3) { Frame F = make_frame(ws, lds); In6 I{{uni(a0), uni(a1), uni(a2), uni(a3), nullptr, nullptr}}; p_router(F, I, __builtin_amdgcn_readfirstlane(l)); }
NI void ph_gather(unsigned char* ws, LAS unsigned char* lds, int l) { Frame F = make_frame(ws, lds); p_gather(F, __builtin_amdgcn_readfirstlane(l)); }
NI void ph_combine(unsigned char* ws, LAS unsigned char* lds, int l, const float* a0, const float* a1, float* xout) { Frame F = make_frame(ws, lds); In6 I{{uni(a0), uni(a1), nullptr, nullptr, nullptr, nullptr}}; p_combine(F, I, __builtin_amdgcn_readfirstlane(l), (float*)uni(xout)); }

NI void ph_gemm_in(unsigned char* ws, LAS unsigned char* lds, int l_) {
    Frame F = make_frame(ws, lds); const int l = __builtin_amdgcn_readfirstlane(l_);
    pg8::Gemm g{WSP(bf16, WS_XB), WSP(bf16, WS_WIN) + (size_t)l * NINP * D, T, NINP, D}; pg8::StaticOrder S; S.init(T, NINP, F.G, (int)blockIdx.x);
    pg8::EpiBf16<0> E{WSP(bf16, WS_PROJ), NINP, nullptr, 0, 0, 1.f};
    pg8::gemm_phase<pg8::EpiBf16<0>, pg8::StaticOrder, PG8_ALIGN, PG8_SP2>(F.lds, g, S, E);
}
NI void ph_gemm_out(unsigned char* ws, LAS unsigned char* lds, int l_, const float* xin) {
    Frame F = make_frame(ws, lds); const int l = __builtin_amdgcn_readfirstlane(l_);
    pg8::Gemm g{WSP(bf16, WS_CAT), WSP(bf16, WS_WOUT) + (size_t)l * D * D, T, D, D}; pg8::StaticOrder S; S.init(T, D, F.G, (int)blockIdx.x);
    EpiResid E{WSP(bf16, WS_XB), WSP(bf16, WS_Y1), DN_ALPHA};
    pg8::gemm_phase<EpiResid, pg8::StaticOrder, PG8_ALIGN, PG8_SP2>(F.lds, g, S, E);
}
NI void ph_gemm_moe1(unsigned char* ws, LAS unsigned char* lds, int l_, const float* bgu) {
    Frame F = make_frame(ws, lds); const int l = __builtin_amdgcn_readfirstlane(l_);
    const int nun = moe_table(F, l, 8);
    pg8::Gemm g{WSP(bf16, WS_XB8), (const bf16*)(WSP(unsigned char, WS_WGU) + (size_t)l * NE * 2048 * D * 2), MAXROWS, NE * 2048, D};
    MoeSched S{(const LAS int*)(F.lds + TAB_OFF), nun};
    EpiSwiglu E{WSP(unsigned char, WS_ACT), uni(bgu) + (size_t)l * NE * 2048};
    pg8::gemm_phase<EpiSwiglu, MoeSched, PG8_ALIGN, true, 1, true>(F.lds, g, S, E, WSP(int, WS_XS));
}
NI void ph_gemm_moe2(unsigned char* ws, LAS unsigned char* lds, int l_, const float* bdn) {
    Frame F = make_frame(ws, lds); const int l = __builtin_amdgcn_readfirstlane(l_);
    const int nun = moe_table(F, l, 4);
    pg8::Gemm g{WSP(bf16, WS_ACT), (const bf16*)(WSP(unsigned char, WS_WDN) + (size_t)l * NE * D * D * 2), MAXROWS, NE * D, D};
    MoeSched S{(const LAS int*)(F.lds + TAB_OFF), nun};
    EpiDown E{WSP(bf16, WS_YS), uni(bdn) + (size_t)l * NE * D};
    pg8::gemm_phase<EpiDown, MoeSched, PG8_ALIGN, MOE_SP2, 1>(F.lds, g, S, E);
}

__device__ __forceinline__ const float* karg_in(int i) { return ((const float* const volatile*)__builtin_amdgcn_kernarg_segment_ptr())[i]; }
__device__ __forceinline__ float* karg_out() { return ((float* const volatile*)__builtin_amdgcn_kernarg_segment_ptr())[N_IN]; }
#ifndef PHMASK
#define PHMASK 0x7FF
#endif
constexpr int PH_PER_LAYER = 10, N_PHASES = 1 + DEPTH * PH_PER_LAYER;
#define IN(k) (lo <= (k) && (k) < hi)
#define SEAM(k) do { if (IN(k) && IN((k) + 1)) xcd_barrier(bar); } while (0)
template <int l> __device__ __forceinline__ void layer_phases(Frame& F, const XcdBarrier& bar, int lo, int hi) {
        const int p0 = 1 + l * PH_PER_LAYER;
        const float* xin = nullptr;
        float* xout = l == DEPTH - 1 ? karg_out() : nullptr;
        if (((PHMASK >> 0) & 1) && IN(p0 + 0)) { asm volatile("; PHASE_BEGIN_0"); ph_gemm_in(F.ws, F.lds, l); SEAM(p0 + 0); }
        if (((PHMASK >> 1) & 1) && IN(p0 + 1)) { asm volatile("; PHASE_BEGIN_1"); ph_local(F.ws, F.lds, l, karg_in(IN_WPOOL), karg_in(IN_CONVW), karg_in(IN_PSCALE), karg_in(IN_KNG), karg_in(IN_KNB)); SEAM(p0 + 1); }
        if (((PHMASK >> 2) & 1) && IN(p0 + 2)) { asm volatile("; PHASE_BEGIN_2"); ph_scores(F.ws, F.lds); SEAM(p0 + 2); }
        if (((PHMASK >> 3) & 1) && IN(p0 + 3)) { asm volatile("; PHASE_BEGIN_3"); ph_attn(F.ws, F.lds); SEAM(p0 + 3); }
        if (((PHMASK >> 4) & 1) && IN(p0 + 4)) { asm volatile("; PHASE_BEGIN_4"); ph_gemm_out(F.ws, F.lds, l, xin); SEAM(p0 + 4); }
        if (((PHMASK >> 5) & 1) && IN(p0 + 5)) { asm volatile("; PHASE_BEGIN_5"); ph_router(F.ws, F.lds, l, karg_in(IN_LN1G), karg_in(IN_LN1B), karg_in(IN_RW), karg_in(IN_RB)); SEAM(p0 + 5); }
        if (((PHMASK >> 6) & 1) && IN(p0 + 6)) { asm volatile("; PHASE_BEGIN_6"); ph_gather(F.ws, F.lds, l); SEAM(p0 + 6); }
        if (((PHMASK >> 7) & 1) && IN(p0 + 7)) { asm volatile("; PHASE_BEGIN_7"); ph_gemm_moe1(F.ws, F.lds, l, karg_in(IN_BGU)); SEAM(p0 + 7); }
        if (((PHMASK >> 8) & 1) && IN(p0 + 8)) { asm volatile("; PHASE_BEGIN_8"); ph_gemm_moe2(F.ws, F.lds, l, karg_in(IN_BDN)); SEAM(p0 + 8); }
        if (((PHMASK >> 9) & 1) && IN(p0 + 9)) { asm volatile("; PHASE_BEGIN_9"); ph_combine(F.ws, F.lds, l, karg_in(IN_LN2G), karg_in(IN_LN2B), xout); SEAM(p0 + 9); }
}
#undef IN
#undef SEAM
__global__ void __launch_bounds__(NWAVES * 64, 2) fwd_kernel(Args A) {
    extern __shared__ __attribute__((aligned(16))) unsigned char lds[];
    Frame F;
    F.lds = (LAS unsigned char*)lds;
    F.tid = threadIdx.x; F.lane = F.tid & 63; F.wave = __builtin_amdgcn_readfirstlane(F.tid >> 6);
    F.G = gridDim.x; { const int bx = blockIdx.x; F.vcu = (F.G % 8 == 0) ? (bx % 8) * (F.G / 8) + bx / 8 : bx; }
    F.ws = A.ws; F.ctl = (gu32*)(A.ws + WS_CTL);
    volatile LAS unsigned* MISC = (volatile LAS unsigned*)(F.lds + MISC_OFF);
    if (F.tid < 32) MISC[F.tid] = 0u;
    __syncthreads();
    const int lo = A.ph_lo, hi = A.ph_hi;
    const bool multi = (hi - lo) > 1;
    XcdBarrier bar; bar.bar = (unsigned*)(F.ctl + CW_BAR); bar.x = 0; bar.st = nullptr;
    if (multi) bar = xcd_barrier_post((unsigned*)(F.ctl + CW_BAR), MISC + 8);
#define IN(k) (lo <= (k) && (k) < hi)
#define SEAM(k) do { if (IN(k) && IN((k) + 1)) xcd_barrier(bar); } while (0)

    if (((PHMASK >> 10) & 1) && IN(0)) { asm volatile("; PHASE_BEGIN_11"); ph_prologue(F.ws, F.lds, karg_in(IN_WIN), karg_in(IN_WOUT), karg_in(IN_WGU), karg_in(IN_WDN), karg_in(IN_X)); SEAM(0); }
    layer_phases<0>(F, bar, lo, hi);
    layer_phases<1>(F, bar, lo, hi);
#undef IN
#undef SEAM
}


#ifdef DUMP_OFF
__global__ void dump_kernel(const unsigned* w, size_t nwords, float* out, int n) {
    const int i = blockIdx.x * blockDim.x + threadIdx.x; if (i >= n) return;
#ifdef DUMP_NAN_ALL
    { bool bad = false; for (size_t j = (size_t)i; j < nwords; j += (size_t)n) { const unsigned x = w[j]; bad |= ((x & 0x7f80u) == 0x7f80u) || ((x & 0x7f800000u) == 0x7f800000u); } out[i] = bad ? 1e6f : 0.f; return; }
#endif
#ifdef DUMP_MASKCHECK
    { out[i] = 0.f; if ((i & 1023) == 0) { const int t = i >> 10, sq = t & 4095; const unsigned long long* mt = (const unsigned long long*)w + ((size_t)(t >> 12) * 64) * 4096 + sq; int pc = 0; bool beyond = false;
        for (int j = 0; j < 64; ++j) { const unsigned long long m = mt[(size_t)j * 4096]; pc += __popcll(m); for (int bb = 0; bb < 64; ++bb) if (((m >> bb) & 1ull) && 64 * j + bb > sq) beyond = true; }
        const int expect = sq + 1 < 256 ? sq + 1 : 256;
#if DUMP_MASKCHECK == 1
        if (pc != expect) out[i] = 1e6f;
#else
        if (beyond) out[i] = 1e6f;
#endif
      } return; }
#endif
#ifdef DUMP_NANCHECK
#if DUMP_NANCHECK == 2
    { size_t wi = (size_t)i;
#ifdef DUMP_ROWW
      wi = ((size_t)i / DUMP_COLW) * DUMP_ROWW + ((size_t)i % DUMP_COLW);
#endif
      if (wi >= nwords) { out[i] = 0.f; return; } const unsigned x = w[wi]; const bool bad = ((x & 0x7f80u) == 0x7f80u) || ((x & 0x7f800000u) == 0x7f800000u);
#ifdef DUMP_LOC
      { const int sq = (int)(wi / 512) & 4095; out[i] = bad ? 1000.f * (float)(DUMP_LOC == 1 ? sq + 1 : 4096 - sq) : 0.f; return; }
#endif
      out[i] = bad ? 1e6f : 0.f; return; }
#else
    { const float v = ((const float*)w)[i]; out[i] = (v == v && fabsf(v) < 1e30f) ? 0.f : 1e6f; return; }
#endif
#endif
#ifdef DUMP_VIA_ROWOF
    unsigned h; { const unsigned short* src = (const unsigned short*)w; const int* rowof = (const int*)((const char*)w - (size_t)(DUMP_OFF) + WS_ROUTE) + 12 * T; const int t = i >> 10, c = i & 1023;
        h = 0u; for (int k = 0; k < 4; ++k) h = h * 0x9E3779B1u + src[(size_t)rowof[4 * t + k] * 1024 + c]; }
#elif defined(DUMP_ROWW)
    unsigned h = 0u; { const size_t row = (size_t)i / DUMP_COLW, cw = (size_t)i % DUMP_COLW; if (row * DUMP_ROWW + cw < nwords) h = w[row * DUMP_ROWW + cw]; }
#else
    unsigned h = 0u; int k = 1; for (size_t j = (size_t)i; j < nwords; j += (size_t)n, k += 2) h ^= w[j] * (unsigned)k;
#endif
    out[i] = (float)((h ^ (h >> 11) ^ (h >> 22)) & 0xFFFFFu);
}
#endif
#ifndef MK_ONE_LAUNCH
#define MK_ONE_LAUNCH 0
#endif
extern "C" void kernel_launch(void* const* d_in, const int* in_sizes, int n_in, void* d_out, int out_size, void* d_ws, size_t ws_size, hipStream_t stream) {
    static int grid = 0;
    if (grid == 0) {
        if (n_in != N_IN || in_sizes[0] != T * D || out_size != T * D || ws_size < WS_END) { fprintf(stderr, "kernel_launch: unexpected shapes (n_in %d, in0 %d, out %d, ws %zu, need %zu); nothing launched\n", n_in, n_in > 0 ? in_sizes[0] : -1, out_size, ws_size, (size_t)WS_END); grid = -1; return; }
        int dev = 0, cus = 0, per_cu = 0;
        if (hipGetDevice(&dev) != hipSuccess || hipDeviceGetAttribute(&cus, hipDeviceAttributeMultiprocessorCount, dev) != hipSuccess) { grid = -1; return; }
        if (hipFuncSetAttribute((const void*)fwd_kernel, hipFuncAttributeMaxDynamicSharedMemorySize, LDS_BYTES) != hipSuccess) { fprintf(stderr, "kernel_launch: hipFuncSetAttribute failed\n"); grid = -1; return; }
        if (hipOccupancyMaxActiveBlocksPerMultiprocessor(&per_cu, (const void*)fwd_kernel, NWAVES * 64, LDS_BYTES) != hipSuccess || per_cu < 1) fprintf(stderr, "kernel_launch: occupancy query reports %d\n", per_cu);
        (void)hipGetLastError();
        grid = cus;
        if (grid != 256) { fprintf(stderr, "kernel_launch: built for 256 CUs, found %d; nothing launched\n", cus); grid = -1; return; }
    }
    if (grid < 0) return;
    if (hipMemsetAsync((char*)d_ws + WS_CTL, 0, CTL_ZERO_BYTES, stream) != hipSuccess) return;
    Args a{};
    for (int i = 0; i < N_IN; ++i) a.in[i] = (const float*)d_in[i];
    a.out = (float*)d_out; a.ws = (unsigned char*)d_ws;
#if MK_ONE_LAUNCH
    a.ph_lo = 0; a.ph_hi = N_PHASES;
    hipLaunchKernelGGL(fwd_kernel, dim3(grid), dim3(NWAVES * 64), LDS_BYTES, stream, a);
#else
#ifdef DUMP_OFF
    for (int p = 0; p < DUMP_STOP; ++p) { a.ph_lo = p; a.ph_hi = p + 1; hipLaunchKernelGGL(fwd_kernel, dim3(grid), dim3(NWAVES * 64), LDS_BYTES, stream, a); }
    hipLaunchKernelGGL(dump_kernel, dim3((T * D + 255) / 256), dim3(256), 0, stream, (const unsigned*)((const char*)d_ws + (size_t)(DUMP_OFF)), (size_t)(DUMP_WORDS), (float*)d_out, T * D);
    return;
#endif
    for (int p = 0; p < N_PHASES; ++p) { a.ph_lo = p; a.ph_hi = p + 1; hipLaunchKernelGGL(fwd_kernel, dim3(grid), dim3(NWAVES * 64), LDS_BYTES, stream, a);
#ifdef DBL_PHASE
        if ((p == 0 && DBL_PHASE == 10) || (p > 0 && (p - 1) % PH_PER_LAYER == DBL_PHASE)) hipLaunchKernelGGL(fwd_kernel, dim3(grid), dim3(NWAVES * 64), LDS_BYTES, stream, a);
#endif
    }
#endif
}
```

```cpp
#include <hip/hip_runtime.h>
#include <cstdio>
#include <cstdint>

#define MK_ONE_LAUNCH 1
#define BAR_EARLY_INV 1
#ifndef WT_STORES
#define WT_STORES 0
#endif
__device__ __forceinline__ void st16_wt(void* p, unsigned x, unsigned y, unsigned z, unsigned w) {
    typedef unsigned u4_ __attribute__((ext_vector_type(4))); const u4_ v = {x, y, z, w};
#if WT_STORES
    asm volatile("global_store_dwordx4 %0, %1, off sc1\n\ts_nop 2" :: "v"((__attribute__((address_space(1))) void*)p), "v"(v) : "memory");
#else
    *(__attribute__((address_space(1))) u4_*)p = v;
#endif
}
__device__ __forceinline__ void st8_wt(void* p, unsigned x, unsigned y) {
    typedef unsigned u2_ __attribute__((ext_vector_type(2))); const u2_ v = {x, y};
#if WT_STORES
    asm volatile("global_store_dwordx2 %0, %1, off sc1" :: "v"((__attribute__((address_space(1))) void*)p), "v"(v) : "memory");
#else
    *(__attribute__((address_space(1))) u2_*)p = v;
#endif
}
namespace pg8 {
#define PG8_LAS __attribute__((address_space(3)))
typedef unsigned short bf16_t;
typedef short bf16x8 __attribute__((ext_vector_type(8)));
typedef float f32x4 __attribute__((ext_vector_type(4)));
typedef unsigned u32x4 __attribute__((ext_vector_type(4)));
typedef int v4i_t __attribute__((ext_vector_type(4)));
typedef int v8i_t __attribute__((ext_vector_type(8)));
constexpr int BM = 256, BK = 64, HALF = 128, HTB = HALF * BK * 2  , STAGE_BYTES = 8 * HTB, NXCD = 8, WGM = 8;

__host__ __device__ __forceinline__ int lds_byte(int r, int c) { const int st = (r >> 4) * 2 + (c >> 5), rr = r & 15, cc = c & 31, ob = rr * 64 + cc * 2; return st * 1024 + (ob ^ (((ob >> 9) & 1) << 5)); }
__host__ __device__ __forceinline__ void stage_rc(int b, int& R, int& C) { const int st = b / 1024, sb = b % 1024, swz = sb ^ (((sb >> 9) & 1) << 5); R = (st >> 1) * 16 + swz / 64; C = (st & 1) * 32 + (swz % 64) / 2; }
__host__ __device__ __forceinline__ int perm32(int rho) { const int n = rho >> 4, i = rho & 15; return 8 * (i >> 2) + 4 * n + (i & 3); }

struct Unit { int pm, pn; };
struct Gemm { const bf16_t* A; const bf16_t* Bt; int M, N, K; };

struct StaticOrder {
    int nM, nN, nwg, G, c;
    __host__ __device__ void init(int M, int N, int G_, int c_) { nM = M / BM; nN = N / BM; nwg = nM * nN; G = G_; c = c_; }
    __host__ __device__ bool next(int i, Unit& u) const {
        const long L = (long)i * G + c; if (L >= nwg) return false;
        int wgid = (int)L; { const int q = nwg / NXCD, r = nwg % NXCD, xcd = wgid % NXCD, off = wgid / NXCD; wgid = (xcd < r ? xcd * (q + 1) : r * (q + 1) + (xcd - r) * q) + off; }
        const int nig = WGM * nN, gid = wgid / nig, fm = gid * WGM, gsz = (nM - fm) < WGM ? (nM - fm) : WGM;
        u.pm = fm + ((wgid % nig) % gsz); u.pn = (wgid % nig) / gsz; return true;
    }
    __device__ __forceinline__ void a_ready(const Unit&) const {}
    __device__ __forceinline__ void done(const Unit&) const {}
};

__device__ __forceinline__ unsigned cvt_pk_bf16(float lo, float hi) { unsigned r; asm volatile("v_cvt_pk_bf16_f32 %0, %1, %2" : "=v"(r) : "v"(lo), "v"(hi)); return r; }
typedef float f32x2 __attribute__((ext_vector_type(2)));
__device__ __forceinline__ f32x2 gelu_pk(f32x2 v) {
    const f32x2 av = __builtin_elementwise_abs(v), d = av * 0.2316418882f + 1.0f;
    f32x2 t; t.x = __builtin_amdgcn_rcpf(d.x); t.y = __builtin_amdgcn_rcpf(d.y);
    f32x2 q = t * 0.5307027145f + (-0.7265760135f); q = q * t + 0.7107068705f; q = q * t + (-0.142248368f); q = q * t + 0.127414796f; q = q * t;
    const f32x2 s = (v * v) * (-0.72134752044f);
    f32x2 e; e.x = __builtin_amdgcn_exp2f(s.x); e.y = __builtin_amdgcn_exp2f(s.y);
    const f32x2 m = v * (q * e), r = v - m;
    f32x2 o; o.x = v.x < 0.f ? m.x : r.x; o.y = v.y < 0.f ? m.y : r.y; return o;
}

template <int ACT  > struct EpiBf16 {
    static constexpr bool PERM = true, AFTER_DRAIN = false; static_assert(ACT == 0 || ACT == 1, "EpiBf16: ACT is 0 (none) or 1 (gelu_pk)");
    bf16_t* O; int ldc; const float* bias; int split_cols; size_t split_stride; float scale0;
    __device__ __forceinline__ void operator()(const f32x4 (&acc)[2][2][4][2], const Unit& u, int wr, int wc, int fr, int fq) const {
        const int row0 = u.pm * BM + wr * 64 + fr; int colt = u.pn * BM; bf16_t* base = O;
        float sc = 1.f; if (split_cols) { const int t = colt / split_cols; base += (size_t)t * split_stride; colt -= t * split_cols; if (t == 0) sc = scale0; }
        const int col0 = colt + wc * 32 + 8 * fq, bcol0 = u.pn * BM + wc * 32 + 8 * fq;
        f32x4 bv[2][2];
#pragma unroll
        for (int bj = 0; bj < 2; ++bj)
#pragma unroll
            for (int n = 0; n < 2; ++n) bv[bj][n] = bias ? *(const __attribute__((address_space(1))) f32x4*)(bias + bcol0 + bj * HALF + 4 * n) : (f32x4){0.f, 0.f, 0.f, 0.f};
#pragma unroll
        for (int ai = 0; ai < 2; ++ai)
#pragma unroll
            for (int m = 0; m < 4; ++m) { bf16_t* rowp = base + (size_t)(row0 + ai * HALF + m * 16) * ldc + col0;
#pragma unroll
                for (int bj = 0; bj < 2; ++bj) { f32x4 v0 = acc[ai][bj][m][0] + bv[bj][0], v1 = acc[ai][bj][m][1] + bv[bj][1];
                    if (ACT == 1) { f32x2 a = gelu_pk((f32x2){v0[0], v0[1]}), b = gelu_pk((f32x2){v0[2], v0[3]}), c = gelu_pk((f32x2){v1[0], v1[1]}), d = gelu_pk((f32x2){v1[2], v1[3]});
                        v0 = (f32x4){a.x, a.y, b.x, b.y}; v1 = (f32x4){c.x, c.y, d.x, d.y}; }
                    v0 = v0 * sc; v1 = v1 * sc; u32x4 w; w.x = cvt_pk_bf16(v0[0], v0[1]); w.y = cvt_pk_bf16(v0[2], v0[3]); w.z = cvt_pk_bf16(v1[0], v1[1]); w.w = cvt_pk_bf16(v1[2], v1[3]);
                    st16_wt(rowp + bj * HALF, w.x, w.y, w.z, w.w); } }
    }
};

struct PanelStats {
    unsigned* xbuf;
    unsigned* cnt;
    unsigned* tmo;
    int ntn; float eps;
    unsigned code;
    __device__ __forceinline__ bool run(const f32x4 (&v)[2][2][4][2], const Unit& u, int wr, int wc, int fr, int fq, PG8_LAS unsigned char* lds, int wid, int lane) const {
        typedef float f32x2v __attribute__((ext_vector_type(2)));
        PG8_LAS f32x2v* P = (PG8_LAS f32x2v*)lds;
        PG8_LAS f32x2v* S = (PG8_LAS f32x2v*)(lds + 8192);
        PG8_LAS unsigned* flag = (PG8_LAS unsigned*)(lds + 8192 + 2048);
#pragma unroll
        for (int ai = 0; ai < 2; ++ai)
#pragma unroll
            for (int m = 0; m < 4; ++m) {
                float s = 0.f;
#pragma unroll
                for (int bj = 0; bj < 2; ++bj)
#pragma unroll
                    for (int n = 0; n < 2; ++n) { const f32x4 x = v[ai][bj][m][n]; s += (x[0] + x[1]) + (x[2] + x[3]); }
                s += __shfl_xor(s, 16); s += __shfl_xor(s, 32);
                const float mw = s * (1.0f / 64.0f); float q = 0.f;
#pragma unroll
                for (int bj = 0; bj < 2; ++bj)
#pragma unroll
                    for (int n = 0; n < 2; ++n) { const f32x4 d = v[ai][bj][m][n] - mw; q += (d[0] * d[0] + d[1] * d[1]) + (d[2] * d[2] + d[3] * d[3]); }
                q += __shfl_xor(q, 16); q += __shfl_xor(q, 32);
                if (fq == 0) P[(ai * HALF + wr * 64 + m * 16 + fr) * 4 + wc] = (f32x2v){mw, q};
            }
        asm volatile("s_waitcnt lgkmcnt(0)" ::: "memory"); __builtin_amdgcn_s_barrier(); asm volatile("" ::: "memory");
#if defined(BROKEN_EXCHANGE_NO_WAIT)
#warning BROKEN CONTROL BUILD: the row-statistics exchange does not wait; results are wrong by design
        if (blockIdx.x >= 64) { const long long t0_ = clock64(); while (clock64() - t0_ < 60000) __builtin_amdgcn_s_sleep(8); }
#endif
        const int row = wid * 32 + (lane & 31);
        if (lane < 32) {
            const f32x2v a = P[row * 4 + 0], b = P[row * 4 + 1], c = P[row * 4 + 2], d = P[row * 4 + 3];
            const float mt = (a.x + b.x + c.x + d.x) * 0.25f;
            const float da = a.x - mt, db = b.x - mt, dc = c.x - mt, dd = d.x - mt;
            const float m2 = (a.y + b.y) + (c.y + d.y) + 64.0f * ((da * da + db * db) + (dc * dc + dd * dd));
            unsigned long long* slot = (unsigned long long*)xbuf + ((size_t)(u.pm * BM + row) * 4 + u.pn);
            __hip_atomic_store(slot, ((unsigned long long)__float_as_uint(m2) << 32) | __float_as_uint(mt), __ATOMIC_RELAXED, __HIP_MEMORY_SCOPE_AGENT);
        }
        asm volatile("s_waitcnt vmcnt(0)" ::: "memory");
        if (lane == 0) __hip_atomic_fetch_add(cnt + 64 * u.pm, 1u, __ATOMIC_RELAXED, __HIP_MEMORY_SCOPE_AGENT);
        if (wid == 0) {
            bool dead = false; const unsigned long long t0 = __builtin_amdgcn_s_memrealtime(); const unsigned want = 8u * (unsigned)ntn;
            for (;;) {
#if defined(BROKEN_EXCHANGE_NO_WAIT)
                break;
#endif
                if ((unsigned)__builtin_amdgcn_readfirstlane(__hip_atomic_load(cnt + 64 * u.pm, __ATOMIC_RELAXED, __HIP_MEMORY_SCOPE_AGENT)) >= want) break;
                if (__builtin_amdgcn_s_memrealtime() - t0 > 2000000ull) {
                    if (lane == 0) { unsigned expect = 0u; __hip_atomic_compare_exchange_strong(tmo + 1, &expect, code | (unsigned)(u.pm & 0xff), __ATOMIC_RELAXED, __ATOMIC_RELAXED, __HIP_MEMORY_SCOPE_AGENT);
                                     __hip_atomic_store(tmo, 1u, __ATOMIC_RELAXED, __HIP_MEMORY_SCOPE_AGENT); }
                    dead = true; break; }
                __builtin_amdgcn_s_sleep(2);
            }
            __builtin_amdgcn_fence(__ATOMIC_ACQUIRE, "agent");
            if (lane == 0) flag[0] = dead ? 1u : 0u;
        }
        asm volatile("s_waitcnt vmcnt(0) lgkmcnt(0)" ::: "memory"); __builtin_amdgcn_s_barrier(); asm volatile("" ::: "memory");
        const bool bad = flag[0] != 0u;
        if (lane < 32) {
            const unsigned long long* slot = (const unsigned long long*)xbuf + (size_t)(u.pm * BM + row) * 4; float mt[4], m2[4]; float ms = 0.f;
#pragma unroll
            for (int t = 0; t < 4; ++t) { if (t < ntn) { const unsigned long long w = __hip_atomic_load(slot + t, __ATOMIC_RELAXED, __HIP_MEMORY_SCOPE_AGENT); mt[t] = __uint_as_float((unsigned)w); m2[t] = __uint_as_float((unsigned)(w >> 32)); } else { mt[t] = 0.f; m2[t] = 0.f; } ms += mt[t]; }
            const float mean = ms / (float)ntn; float q = 0.f;
#pragma unroll
            for (int t = 0; t < 4; ++t) if (t < ntn) { const float dm = mt[t] - mean; q += m2[t] + 256.0f * dm * dm; }
            S[row] = (f32x2v){mean, 1.0f / sqrtf(q / (256.0f * (float)ntn) + eps)};
        }
        asm volatile("s_waitcnt lgkmcnt(0)" ::: "memory"); __builtin_amdgcn_s_barrier(); asm volatile("" ::: "memory");
        return bad;
    }
};
struct EpiLnRes {
    static constexpr bool PERM = false, AFTER_DRAIN = true;
    const float* base; float* out; int ldc; const float* bias; PanelStats st; unsigned poison;
    __device__ __forceinline__ void fused(f32x4 (&acc)[2][2][4][2], const Unit& u, int wr, int wc, int fr, int fq, PG8_LAS unsigned char* lds, int wid, int lane) const {
        typedef float f32x2v __attribute__((ext_vector_type(2)));
        const PG8_LAS f32x2v* S = (const PG8_LAS f32x2v*)(lds + 8192);
        const int col0 = u.pn * BM + wc * 32 + 4 * fq;
#pragma unroll
        for (int bj = 0; bj < 2; ++bj)
#pragma unroll
            for (int n = 0; n < 2; ++n) { const f32x4 bv = bias ? *(const f32x4*)(bias + col0 + bj * HALF + n * 16) : (f32x4){0.f, 0.f, 0.f, 0.f};
#pragma unroll
                for (int ai = 0; ai < 2; ++ai)
#pragma unroll
                    for (int m = 0; m < 4; ++m) acc[ai][bj][m][n] += bv; }
        f32x4 pre[4][2][2];
#pragma unroll
        for (int m = 0; m < 4; ++m) { const size_t off = (size_t)(u.pm * BM + wr * 64 + m * 16 + fr) * ldc + col0;
#pragma unroll
            for (int bj = 0; bj < 2; ++bj)
#pragma unroll
                for (int n = 0; n < 2; ++n) pre[m][bj][n] = *(const f32x4*)(base + off + bj * HALF + n * 16); }
        const bool bad = st.run(acc, u, wr, wc, fr, fq, lds, wid, lane) || poison != 0u;
        const float qnan = __builtin_nanf("");
#pragma unroll
        for (int ai = 0; ai < 2; ++ai)
#pragma unroll
            for (int m = 0; m < 4; ++m) { const int r = ai * HALF + wr * 64 + m * 16 + fr; const f32x2v sr = S[r]; const size_t off = (size_t)(u.pm * BM + r) * ldc + col0;
#pragma unroll
                for (int bj = 0; bj < 2; ++bj)
#pragma unroll
                    for (int n = 0; n < 2; ++n) { const f32x4 bs = ai == 0 ? pre[m][bj][n] : *(const f32x4*)(base + off + bj * HALF + n * 16); f32x4 o = bs + (acc[ai][bj][m][n] - sr.x) * sr.y;
                        if (bad) o = (f32x4){qnan, qnan, qnan, qnan}; *(f32x4*)(out + off + bj * HALF + n * 16) = o; }
                if (m & 1) asm volatile("" ::: "memory"); }
    }
};
struct EpiLnResLn {
    static constexpr bool PERM = false, AFTER_DRAIN = true;
    const float* base; float* out; bf16_t* xn; int ldc; const float* bias; PanelStats st1, st2; unsigned poison;
    __device__ __forceinline__ void fused(f32x4 (&acc)[2][2][4][2], const Unit& u, int wr, int wc, int fr, int fq, PG8_LAS unsigned char* lds, int wid, int lane) const {
        typedef float f32x2v __attribute__((ext_vector_type(2))); typedef unsigned u32x2v __attribute__((ext_vector_type(2)));
        const PG8_LAS f32x2v* S = (const PG8_LAS f32x2v*)(lds + 8192);
        const int col0 = u.pn * BM + wc * 32 + 4 * fq;
#pragma unroll
        for (int bj = 0; bj < 2; ++bj)
#pragma unroll
            for (int n = 0; n < 2; ++n) { const f32x4 bv = bias ? *(const f32x4*)(bias + col0 + bj * HALF + n * 16) : (f32x4){0.f, 0.f, 0.f, 0.f};
#pragma unroll
                for (int ai = 0; ai < 2; ++ai)
#pragma unroll
                    for (int m = 0; m < 4; ++m) acc[ai][bj][m][n] += bv; }
        bool bad = st1.run(acc, u, wr, wc, fr, fq, lds, wid, lane) || poison != 0u;
        const float qnan = __builtin_nanf("");
#pragma unroll
        for (int ai = 0; ai < 2; ++ai)
#pragma unroll
            for (int m = 0; m < 4; ++m) { const int r = ai * HALF + wr * 64 + m * 16 + fr; const f32x2v sr = S[r]; const size_t off = (size_t)(u.pm * BM + r) * ldc + col0;
#pragma unroll
                for (int bj = 0; bj < 2; ++bj)
#pragma unroll
                    for (int n = 0; n < 2; ++n) { const f32x4 bs = *(const f32x4*)(base + off + bj * HALF + n * 16); acc[ai][bj][m][n] = bs + (acc[ai][bj][m][n] - sr.x) * sr.y; }
                asm volatile("" : "+v"(acc[ai][0][m][0]), "+v"(acc[ai][0][m][1]), "+v"(acc[ai][1][m][0]), "+v"(acc[ai][1][m][1]));
                if (m & 1) asm volatile("" ::: "memory"); }
        const bool bad1 = bad;
        bad = st2.run(acc, u, wr, wc, fr, fq, lds, wid, lane) || bad;
#pragma unroll
        for (int ai = 0; ai < 2; ++ai)
#pragma unroll
            for (int m = 0; m < 4; ++m) { const int r = ai * HALF + wr * 64 + m * 16 + fr; const f32x2v sr = S[r]; const size_t off = (size_t)(u.pm * BM + r) * ldc + col0;
#pragma unroll
                for (int bj = 0; bj < 2; ++bj)
#pragma unroll
                    for (int n = 0; n < 2; ++n) { const f32x4 x1 = acc[ai][bj][m][n]; *(f32x4*)(out + off + bj * HALF + n * 16) = bad1 ? (f32x4){qnan, qnan, qnan, qnan} : x1;
                        const f32x4 o = (x1 - sr.x) * sr.y; u32x2v w; w.x = cvt_pk_bf16(o[0], o[1]); w.y = cvt_pk_bf16(o[2], o[3]);
                        if (bad) { w.x = 0x7fc07fc0u; w.y = 0x7fc07fc0u; } *(u32x2v*)(xn + off + bj * HALF + n * 16) = w; }
                asm volatile("" ::: "memory"); }
    }
};

__device__ __forceinline__ void glds_saddr(unsigned voff, const char* sbase, unsigned lds_dst) { unsigned keep;
    asm volatile("s_mov_b32 %0, m0\n\ts_mov_b32 m0, %3\n\ts_nop 0\n\tglobal_load_lds_dwordx4 %1, %2\n\ts_mov_b32 m0, %0" : "=&s"(keep) : "v"(voff), "s"(sbase), "s"(lds_dst) : "memory"); }
template <class Epi, class Sched, bool ALIGN_EPI = false, bool SP2 = false, int EB = 2, bool GATHER = false>
__device__ __forceinline__ void gemm_phase(PG8_LAS unsigned char* lds, const Gemm g, const Sched& S, const Epi& E, const int* rowtok = nullptr) {
    static_assert(!GATHER || (EB == 1 && SP2), "gathered A rows: fp8 path (SGPR-base staging) with the two-super-phase loop only");
    const int tid = threadIdx.x, wid = __builtin_amdgcn_readfirstlane(tid >> 6), lane = tid & 63, wr = wid >> 2, wc = wid & 3, fr = lane & 15, fq = lane >> 4;
    const int K = g.K, nt = K * EB / (BK * 2);
    unsigned voffA[2], voffB[2]; int gR[2]; unsigned gC[2];
#pragma unroll
    for (int i = 0; i < 2; ++i) { int R, C; stage_rc(tid * 16 + i * 8192, R, C); const int Rb = Epi::PERM ? ((R & ~31) + perm32(R & 31)) : R;
        voffA[i] = (unsigned)(R * K * EB + C * 2); voffB[i] = (unsigned)(Rb * K * EB + C * 2); gR[i] = R; gC[i] = (unsigned)(C * 2); }
    const size_t kstep = (size_t)(BK * 2);
    const size_t hstep = (size_t)HALF * K * EB;
    const size_t tstep = 2 * hstep;
    const unsigned ldsw = (unsigned)wid * 1024u; const unsigned lds0 = (unsigned)(uintptr_t)lds;
    const int aoff = lds_byte(wr * 64 + fr, fq * 8), boff = lds_byte(wc * 32 + fr, fq * 8);
#define PG8_SA(b, h) (((b) * 2 + (h)) * HTB)
#define PG8_SB(b, h) ((4 + (b) * 2 + (h)) * HTB)
#define PG8_STAGE(bufoff, gbase, voff) do { if constexpr (EB == 2) { _Pragma("unroll") for (int _i = 0; _i < 2; ++_i) \
        __builtin_amdgcn_global_load_lds((const unsigned*)((const char*)(gbase) + (voff)[_i]), (PG8_LAS unsigned*)(lds + (bufoff) + ldsw + _i * 8192), 16, 0, 0); } \
        else { _Pragma("unroll") for (int _i = 0; _i < 2; ++_i) glds_saddr((voff)[_i], (const char*)(gbase), (unsigned)__builtin_amdgcn_readfirstlane((int)(lds0 + (unsigned)(bufoff) + ldsw + (unsigned)(_i * 8192)))); } } while (0)
#define PG8_GLOAD(vo, u) do { _Pragma("unroll") for (int _h = 0; _h < 2; ++_h) _Pragma("unroll") for (int _i = 0; _i < 2; ++_i) vo[_h][_i] = (unsigned)rowtok[(size_t)(u).pm * BM + _h * HALF + gR[_i]] * (unsigned)(K * EB) + gC[_i]; } while (0)
#define PG8_STAGE_A(bufoff, pplain, kofs, h, VS) do { if constexpr (!GATHER) { PG8_STAGE(bufoff, pplain, voffA); } else { _Pragma("unroll") for (int _i = 0; _i < 2; ++_i) \
        glds_saddr(VS[h][_i], (const char*)g.A + (kofs), (unsigned)__builtin_amdgcn_readfirstlane((int)(lds0 + (unsigned)(bufoff) + ldsw + (unsigned)(_i * 8192)))); } } while (0)
#define PG8_LD8(p) __builtin_shufflevector(*(const PG8_LAS v4i_t*)(p), *(const PG8_LAS v4i_t*)((p) + 1024), 0, 1, 2, 3, 4, 5, 6, 7)
#define PG8_LDA(dst, b, h) do { if constexpr (EB == 2) { _Pragma("unroll") for (int m = 0; m < 4; ++m) _Pragma("unroll") for (int k = 0; k < 2; ++k) dst[m][k] = *(const PG8_LAS bf16x8*)(lds + PG8_SA(b, h) + aoff + m * 2048 + k * 1024); } \
        else { _Pragma("unroll") for (int m = 0; m < 4; ++m) dst##8[m] = PG8_LD8(lds + PG8_SA(b, h) + aoff + m * 2048); } } while (0)
#define PG8_LDB(dst, b, h) do { if constexpr (EB == 2) { _Pragma("unroll") for (int n = 0; n < 2; ++n) _Pragma("unroll") for (int k = 0; k < 2; ++k) dst[n][k] = *(const PG8_LAS bf16x8*)(lds + PG8_SB(b, h) + boff + n * 2048 + k * 1024); } \
        else { _Pragma("unroll") for (int n = 0; n < 2; ++n) dst##8[n] = PG8_LD8(lds + PG8_SB(b, h) + boff + n * 2048); } } while (0)
#define PG8_CAT8(x, y) __builtin_shufflevector(__builtin_bit_cast(v4i_t, x), __builtin_bit_cast(v4i_t, y), 0, 1, 2, 3, 4, 5, 6, 7)
#define PG8_MMA(ai, bj, At, Bt) do { __builtin_amdgcn_s_setprio(1); if constexpr (EB == 2) { _Pragma("unroll") for (int m = 0; m < 4; ++m) _Pragma("unroll") for (int n = 0; n < 2; ++n) _Pragma("unroll") for (int k = 0; k < 2; ++k) \
        acc[ai][bj][m][n] = __builtin_amdgcn_mfma_f32_16x16x32_bf16(Bt[n][k], At[m][k], acc[ai][bj][m][n], 0, 0, 0); } else { _Pragma("unroll") for (int m = 0; m < 4; ++m) _Pragma("unroll") for (int n = 0; n < 2; ++n) \
        asm volatile("v_mfma_scale_f32_16x16x128_f8f6f4 %0, %1, %2, %0, %3, %3 op_sel_hi:[0,0,0]" : "+v"(acc[ai][bj][m][n]) : "v"(Bt##8[n]), "v"(At##8[m]), "v"(mx_one)); }     __builtin_amdgcn_s_setprio(0); } while (0)
#define PG8_WAIT_V(n) asm volatile("s_waitcnt vmcnt(" #n ")" ::: "memory")
#define PG8_WAIT_L(n) asm volatile("s_waitcnt lgkmcnt(" #n ")" ::: "memory")
#define PG8_BAR __builtin_amdgcn_s_barrier()
#define PG8_SCHED __builtin_amdgcn_sched_barrier(0)
    Unit cur, nxt; int ui = 0;
    if (!S.next(0, cur)) return;
    f32x4 acc[2][2][4][2];
#pragma unroll
    for (int a = 0; a < 2; ++a)
#pragma unroll
        for (int b = 0; b < 2; ++b)
#pragma unroll
            for (int m = 0; m < 4; ++m)
#pragma unroll
                for (int n = 0; n < 2; ++n) acc[a][b][m][n] = (f32x4){0.f, 0.f, 0.f, 0.f};
    const int mx_one = 0x7f7f7f7f;
    bf16x8 At[4][2], B0[2][2], B1[2][2]; v8i_t At8[4], B08[2], B18[2];
    const char* cA = (const char*)g.A + (size_t)cur.pm * tstep; const char* cB = (const char*)g.Bt + (size_t)cur.pn * tstep;
    S.a_ready(cur);
    unsigned voffC[2][2], voffN[2][2];
    if constexpr (GATHER) PG8_GLOAD(voffC, cur);
    if constexpr (SP2) {
        PG8_STAGE(PG8_SB(0, 0), cB, voffB); PG8_STAGE(PG8_SB(0, 1), cB + hstep, voffB); PG8_STAGE_A(PG8_SA(0, 0), cA, 0, 0, voffC); PG8_STAGE_A(PG8_SA(0, 1), cA + hstep, 0, 1, voffC);
        if (wr == 1) PG8_BAR;
        PG8_WAIT_V(2); PG8_BAR;
        PG8_STAGE(PG8_SB(1, 0), cB + kstep, voffB); PG8_STAGE_A(PG8_SA(1, 0), cA + kstep, kstep, 0, voffC); PG8_STAGE(PG8_SB(1, 1), cB + hstep + kstep, voffB);
        PG8_WAIT_V(6); PG8_BAR;
    } else {
        PG8_STAGE(PG8_SB(0, 0), cB, voffB); PG8_STAGE(PG8_SA(0, 0), cA, voffA); PG8_STAGE(PG8_SB(0, 1), cB + hstep, voffB); PG8_STAGE(PG8_SA(0, 1), cA + hstep, voffA);
        if (wr == 1) PG8_BAR;
        PG8_WAIT_V(4); PG8_BAR;
        PG8_STAGE(PG8_SB(1, 0), cB + kstep, voffB); PG8_STAGE(PG8_SA(1, 0), cA + kstep, voffA); PG8_STAGE(PG8_SB(1, 1), cB + hstep + kstep, voffB);
        PG8_WAIT_V(6); PG8_BAR;
    }
    for (;;) {
        const bool has_next = S.next(ui + 1, nxt);
        if constexpr (GATHER) { if (has_next) PG8_GLOAD(voffN, nxt); else { _Pragma("unroll") for (int _h = 0; _h < 2; ++_h) _Pragma("unroll") for (int _i = 0; _i < 2; ++_i) voffN[_h][_i] = voffC[_h][_i]; } }
        const char* nA = has_next ? (const char*)g.A + (size_t)nxt.pm * tstep : cA; const char* nB = has_next ? (const char*)g.Bt + (size_t)nxt.pn * tstep : cB;
#pragma nounroll
        for (int t = 0; t < nt; t += 2) {
            const bool last = (t == nt - 2);
            const char* a1 = cA + (size_t)(t + 1) * kstep;
            const char* a2 = last ? nA : cA + (size_t)(t + 2) * kstep; const char* b2 = last ? nB : cB + (size_t)(t + 2) * kstep;
            const char* a3 = a2 + kstep; const char* b3 = b2 + kstep;
            const size_t k2 = last ? (size_t)0 : (size_t)(t + 2) * kstep; unsigned voffS[2][2];
            if constexpr (GATHER) { _Pragma("unroll") for (int _h = 0; _h < 2; ++_h) _Pragma("unroll") for (int _i = 0; _i < 2; ++_i) voffS[_h][_i] = last ? voffN[_h][_i] : voffC[_h][_i]; }
            if (last && has_next) S.a_ready(nxt);
            if constexpr (SP2) {
            PG8_LDB(B0, 0, 0); PG8_LDB(B1, 0, 1); PG8_SCHED; PG8_LDA(At, 0, 0); PG8_STAGE_A(PG8_SA(1, 1), a1 + hstep, (size_t)(t + 1) * kstep, 1, voffC);
            PG8_WAIT_V(8); PG8_WAIT_L(0); PG8_BAR; PG8_MMA(0, 0, At, B0); PG8_MMA(0, 1, At, B1); PG8_BAR; PG8_SCHED;
            PG8_LDA(At, 0, 1); PG8_STAGE(PG8_SB(0, 0), b2, voffB); PG8_STAGE(PG8_SB(0, 1), b2 + hstep, voffB); PG8_STAGE_A(PG8_SA(0, 0), a2, k2, 0, voffS);
            PG8_WAIT_V(8); PG8_WAIT_L(0); PG8_BAR; PG8_MMA(1, 0, At, B0); PG8_MMA(1, 1, At, B1); PG8_BAR; PG8_SCHED;
            PG8_LDB(B0, 1, 0); PG8_LDB(B1, 1, 1); PG8_SCHED; PG8_LDA(At, 1, 0); PG8_STAGE_A(PG8_SA(0, 1), a2 + hstep, k2, 1, voffS);
            PG8_WAIT_V(8); PG8_WAIT_L(0); PG8_BAR; PG8_MMA(0, 0, At, B0); PG8_MMA(0, 1, At, B1); PG8_BAR; PG8_SCHED;
            PG8_LDA(At, 1, 1); PG8_STAGE(PG8_SB(1, 0), b3, voffB); PG8_STAGE(PG8_SB(1, 1), b3 + hstep, voffB); PG8_STAGE_A(PG8_SA(1, 0), a3, k2 + kstep, 0, voffS);
            PG8_WAIT_V(8); PG8_WAIT_L(0); PG8_BAR; PG8_MMA(1, 0, At, B0); PG8_MMA(1, 1, At, B1); PG8_BAR; PG8_SCHED;
            } else {
            PG8_LDB(B0, 0, 0); PG8_SCHED; PG8_LDA(At, 0, 0); PG8_STAGE(PG8_SA(1, 1), a1 + hstep, voffA);
            PG8_WAIT_L(8); PG8_BAR; PG8_WAIT_L(0); PG8_MMA(0, 0, At, B0); PG8_BAR; PG8_SCHED;
            PG8_LDB(B1, 0, 1); PG8_STAGE(PG8_SB(0, 0), b2, voffB);
            PG8_BAR; PG8_WAIT_L(0); PG8_MMA(0, 1, At, B1); PG8_BAR;
            PG8_LDA(At, 0, 1); PG8_STAGE(PG8_SA(0, 0), a2, voffA);
            PG8_BAR; PG8_WAIT_L(0); PG8_MMA(1, 0, At, B0); PG8_BAR; PG8_SCHED;
            PG8_STAGE(PG8_SB(0, 1), b2 + hstep, voffB);
            PG8_WAIT_V(6); PG8_BAR; PG8_MMA(1, 1, At, B1); PG8_BAR;
            PG8_LDB(B0, 1, 0); PG8_SCHED; PG8_LDA(At, 1, 0); PG8_STAGE(PG8_SA(0, 1), a2 + hstep, voffA);
            PG8_WAIT_L(8); PG8_BAR; PG8_WAIT_L(0); PG8_MMA(0, 0, At, B0); PG8_BAR; PG8_SCHED;
            PG8_LDB(B1, 1, 1); PG8_STAGE(PG8_SB(1, 0), b3, voffB);
            PG8_BAR; PG8_WAIT_L(0); PG8_MMA(0, 1, At, B1); PG8_BAR;
            PG8_LDA(At, 1, 1); PG8_STAGE(PG8_SA(1, 0), a3, voffA);
            PG8_BAR; PG8_WAIT_L(0); PG8_MMA(1, 0, At, B0); PG8_BAR; PG8_SCHED;
            PG8_STAGE(PG8_SB(1, 1), b3 + hstep, voffB);
            PG8_WAIT_V(6); PG8_BAR; PG8_MMA(1, 1, At, B1); PG8_BAR;
            }
        }
        if constexpr (ALIGN_EPI) { if (wr == 0) PG8_BAR; }
        if constexpr (EB == 1) asm volatile("s_nop 15\n\ts_nop 15" ::: "memory");
        if constexpr (!Epi::AFTER_DRAIN) { E(acc, cur, wr, wc, fr, fq); S.done(cur); }
        if (!has_next) break;
#pragma unroll
        for (int a = 0; a < 2; ++a)
#pragma unroll
            for (int b = 0; b < 2; ++b)
#pragma unroll
                for (int m = 0; m < 4; ++m)
#pragma unroll
                    for (int n = 0; n < 2; ++n) acc[a][b][m][n] = (f32x4){0.f, 0.f, 0.f, 0.f};
        cur = nxt; cA = nA; cB = nB; ++ui;
        if constexpr (GATHER) { _Pragma("unroll") for (int _h = 0; _h < 2; ++_h) _Pragma("unroll") for (int _i = 0; _i < 2; ++_i) voffC[_h][_i] = voffN[_h][_i]; }
        if constexpr (ALIGN_EPI) { if (wr == 1) PG8_BAR; }
    }
    PG8_WAIT_V(0);
    if constexpr (!ALIGN_EPI) { if (wr == 0) PG8_BAR; }
    PG8_BAR;
    if constexpr (Epi::AFTER_DRAIN) { E.fused(acc, cur, wr, wc, fr, fq, lds, wid, lane); S.done(cur); }
#undef PG8_SA
#undef PG8_SB
#undef PG8_STAGE
#undef PG8_LDA
#undef PG8_GLOAD
#undef PG8_STAGE_A
#undef PG8_LD8
#undef PG8_LDB
#undef PG8_MMA
#undef PG8_CAT8
#undef PG8_WAIT_V
#undef PG8_WAIT_L
#undef PG8_BAR
#undef PG8_SCHED
}
}
#ifndef PG8_SP2
#define PG8_SP2 true
#endif
#ifndef MOE_SP2
#define MOE_SP2 true
#endif
#ifndef PG8_ALIGN
#define PG8_ALIGN true
#endif
constexpr int NWAVES = 8;
constexpr int NB = 4, SEQ = 4096, T = NB * SEQ, D = 1024, NIN = 2856, NINP = 3072, NE = 32, DEPTH = 2;
constexpr int C_H = 0, C_GB = 256, C_GC = 512, C_P = 768, C_Q = 1024, C_K = 1536, C_V = 2048, C_QI = 2560, C_KI = 2816, C_WI = 2848;
constexpr int NSEL = 256;
#ifndef SEL_CAND_CAP
#define SEL_CAND_CAP 64
#endif
constexpr int MAXROWS = 4 * T + NE * 256;
constexpr float ATT_C2 = 0.125f * 1.4426950408889634f;
constexpr float LN_EPS = 1e-5f, DN_ALPHA = 1.41421356237309515f;
enum { IN_X = 0, IN_WIN, IN_CONVW, IN_WPOOL, IN_PSCALE, IN_KNG, IN_KNB, IN_WOUT, IN_LN1G, IN_LN1B, IN_RW, IN_RB, IN_WGU, IN_BGU, IN_WDN, IN_BDN, IN_LN2G, IN_LN2B, N_IN };

constexpr size_t MiB = 1u << 20;
constexpr size_t WS_CTL = 0, CTL_ZERO_BYTES = 1 * MiB;
constexpr size_t WS_WIN = 2 * MiB;
constexpr size_t WS_WOUT = 14 * MiB;
constexpr size_t WS_WGU = 18 * MiB;
constexpr size_t WS_WDN = 274 * MiB;
constexpr size_t WS_XB = 402 * MiB;
constexpr size_t WS_XF = 434 * MiB;
constexpr size_t WS_Y1 = 498 * MiB;
constexpr size_t WS_PROJ = 562 * MiB;
constexpr size_t WS_CAT = 658 * MiB;
constexpr size_t WS_KIN = 690 * MiB;
constexpr size_t WS_MASK = 691 * MiB;
constexpr size_t WS_ROUTE = 699 * MiB;
constexpr size_t WS_CNTW = 699 * MiB + 256 * 1024;
constexpr size_t WS_SC = 700 * MiB;
constexpr size_t WS_XS = 956 * MiB;
constexpr size_t WS_ACT = 1100 * MiB;
constexpr size_t WS_YS = 1244 * MiB;
constexpr size_t WS_XB8 = 1388 * MiB;
constexpr size_t WS_END = 1404 * MiB;
constexpr int CW_TMO = 0;
constexpr int CW_CNT = 1024;
constexpr int CW_BAR = 4096;
constexpr int RING_BYTES = 131072;
constexpr int TAB_OFF = RING_BYTES;
constexpr int MISC_OFF = RING_BYTES + 1024;
constexpr int LDS_BYTES = 147456;

#define GAS __attribute__((address_space(1)))
#define LAS __attribute__((address_space(3)))
typedef unsigned short bf16;
typedef unsigned v4u __attribute__((ext_vector_type(4)));
typedef unsigned v2u __attribute__((ext_vector_type(2)));
typedef float f32x4 __attribute__((ext_vector_type(4)));
typedef short bf16x8 __attribute__((ext_vector_type(8)));
typedef GAS unsigned gu32;
typedef unsigned long long u64;
#define RLX_AGENT __ATOMIC_RELAXED, __HIP_MEMORY_SCOPE_AGENT
#define LDS_WAIT() asm volatile("s_waitcnt lgkmcnt(0)" ::: "memory")
#define VM_WAIT() asm volatile("s_waitcnt vmcnt(0)" ::: "memory")
__device__ __forceinline__ unsigned f2bf(float f) { unsigned u = __builtin_bit_cast(unsigned, f); return (u + 0x7fffu + ((u >> 16) & 1u)) >> 16; }
__device__ __forceinline__ unsigned pk2(float lo, float hi) {
    typedef float f2_ __attribute__((ext_vector_type(2))); typedef __bf16 b2_ __attribute__((ext_vector_type(2))); const f2_ v = {lo, hi}; return __builtin_bit_cast(unsigned, __builtin_convertvector(v, b2_)); }
__device__ __forceinline__ unsigned pk4_fp8(float a, float b, float c, float d) { int w = 0; w = __builtin_amdgcn_cvt_pk_fp8_f32(a, b, w, false); w = __builtin_amdgcn_cvt_pk_fp8_f32(c, d, w, true); return (unsigned)w; }
constexpr float WGU_SCALE = 32.f, WDN_SCALE = 64.f;
__device__ __forceinline__ float bf2f(bf16 v) { return __builtin_bit_cast(float, (unsigned)v << 16); }
__device__ __forceinline__ float bflo(unsigned w) { return __builtin_bit_cast(float, w << 16); }
__device__ __forceinline__ float bfhi(unsigned w) { return __builtin_bit_cast(float, w & 0xffff0000u); }
template <int CTRL> __device__ __forceinline__ float dppx(float v) { return __builtin_bit_cast(float, __builtin_amdgcn_update_dpp(0, __builtin_bit_cast(int, v), CTRL, 0xf, 0xf, false)); }
__device__ __forceinline__ float wave_sum(float v) {
    v += dppx<0xB1>(v); v += dppx<0x4E>(v); v += dppx<0x141>(v); v += dppx<0x140>(v);
    const float a = __builtin_bit_cast(float, __builtin_amdgcn_readlane(__builtin_bit_cast(int, v), 0)), b = __builtin_bit_cast(float, __builtin_amdgcn_readlane(__builtin_bit_cast(int, v), 16));
    const float c = __builtin_bit_cast(float, __builtin_amdgcn_readlane(__builtin_bit_cast(int, v), 32)), d = __builtin_bit_cast(float, __builtin_amdgcn_readlane(__builtin_bit_cast(int, v), 48));
    return (a + b) + (c + d);
}
__device__ __forceinline__ float wave_max(float v) {
#pragma unroll
    for (int o = 1; o < 64; o <<= 1) v = fmaxf(v, __shfl_xor(v, o));
    return v;
}
__device__ __forceinline__ float wave_max_dpp(float v) {
    v = fmaxf(v, dppx<0xB1>(v)); v = fmaxf(v, dppx<0x4E>(v)); v = fmaxf(v, dppx<0x141>(v)); v = fmaxf(v, dppx<0x140>(v));
    const float a = __builtin_bit_cast(float, __builtin_amdgcn_readlane(__builtin_bit_cast(int, v), 0)), b = __builtin_bit_cast(float, __builtin_amdgcn_readlane(__builtin_bit_cast(int, v), 16));
    const float c = __builtin_bit_cast(float, __builtin_amdgcn_readlane(__builtin_bit_cast(int, v), 32)), d = __builtin_bit_cast(float, __builtin_amdgcn_readlane(__builtin_bit_cast(int, v), 48));
    return fmaxf(fmaxf(a, b), fmaxf(c, d));
}
__device__ __forceinline__ float sum32(float v) {
#pragma unroll
    for (int o = 1; o < 32; o <<= 1) v += __shfl_xor(v, o);
    return v;
}
#define XB_TMO      128
#define XB_XCNT(j)  (256  + 64 * (j))
#define XB_XSUB(j)  (1280 + 64 * (j))
#define XB_XGEN(j)  (2304 + 64 * (j))
#define XB_TOP      3328
#define XB_TOPGEN   3392
#define XCD_BAR_WORDS 3456
#define XB_SPIN_CAP (1u << 18)

__device__ __forceinline__ unsigned xb_ld(unsigned* p)              { return __hip_atomic_load(p, __ATOMIC_RELAXED, __HIP_MEMORY_SCOPE_AGENT); }
__device__ __forceinline__ unsigned xb_add(unsigned* p, unsigned v) { return __hip_atomic_fetch_add(p, v, __ATOMIC_RELAXED, __HIP_MEMORY_SCOPE_AGENT); }
__device__ __forceinline__ unsigned xb_xcc_id() { return (unsigned)__builtin_amdgcn_s_getreg((3 << 11) | 20) & 0xFu; }
#define XB_SPIN(cond, bar) do { unsigned _sp = 0; while (cond) { __builtin_amdgcn_s_sleep(1); \
    if ((++_sp & 255u) == 0u) { if (xb_ld(&(bar)[XB_TMO])) break; if (_sp > XB_SPIN_CAP) { atomicAdd(&(bar)[XB_TMO], 1u); break; } } } } while (0)

struct XcdBarrier {
    unsigned* bar; unsigned x;
    volatile LAS unsigned* st;
};

__device__ __forceinline__ XcdBarrier xcd_barrier_post(unsigned* bar, volatile LAS unsigned* st) {
    XcdBarrier b; b.bar = bar; b.x = xb_xcc_id(); b.st = st;
    if (threadIdx.x == 0) (void)xb_add(&bar[XB_XCNT(b.x)], 1u);
    return b;
}
__device__ __forceinline__ void xcd_barrier_complete(unsigned* bar, unsigned x, unsigned& nloc, unsigned& nx) {
    const unsigned G = gridDim.x * gridDim.y * gridDim.z;
    unsigned sum, cnt, mine, sp = 0u;
    for (;;) {
        sum = 0u; cnt = 0u; mine = 0u;
#pragma unroll
        for (unsigned j = 0; j < 16; ++j) { const unsigned c = xb_ld(&bar[XB_XCNT(j)]); sum += c; cnt += (c > 0u) ? 1u : 0u; mine = (j == x) ? c : mine; }
        if (sum == G) break;
        __builtin_amdgcn_s_sleep(1);
        if ((++sp & 255u) == 0u) { if (xb_ld(&bar[XB_TMO])) break; if (sp > XB_SPIN_CAP) { atomicAdd(&bar[XB_TMO], 1u); break; } }
    }
    nloc = mine > 0u ? mine : 1u; nx = cnt > 0u ? cnt : 1u;
}

__device__ __forceinline__ void xcd_barrier(const XcdBarrier& b) {
    asm volatile("s_waitcnt vmcnt(0)" ::: "memory");
    __syncthreads();
    if (threadIdx.x == 0) {
        unsigned* bar = b.bar;
        __builtin_amdgcn_s_waitcnt(0);
        unsigned nloc = b.st[0], nx = b.st[1];
        if (nloc == 0u) { xcd_barrier_complete(bar, b.x, nloc, nx); b.st[0] = nloc; b.st[1] = nx; }
        const unsigned old = xb_add(&bar[XB_XSUB(b.x)], 1u);
        const unsigned gen = old / nloc;
        if (old + 1u == (gen + 1u) * nloc) {
            __builtin_amdgcn_fence(__ATOMIC_RELEASE, "agent");
            asm volatile("s_waitcnt vmcnt(0)" ::: "memory");
#ifdef BAR_EARLY_INV
            __builtin_amdgcn_fence(__ATOMIC_ACQUIRE, "agent");
            (void)xb_add(&bar[XB_TOP], 1u);
            { const unsigned target = (gen + 1u) * nx; XB_SPIN(xb_ld(&bar[XB_TOP]) < target, bar); }
            xb_add(&bar[XB_XGEN(b.x)], 1u);
            asm volatile("s_waitcnt vmcnt(0)" ::: "memory");
#else
            const unsigned og = xb_add(&bar[XB_TOP], 1u);
            const unsigned tg = og / nx;
            if (og + 1u == (tg + 1u) * nx) xb_add(&bar[XB_TOPGEN], 1u);
            else XB_SPIN(xb_ld(&bar[XB_TOPGEN]) == tg, bar);
            __builtin_amdgcn_fence(__ATOMIC_ACQUIRE, "agent");
            xb_add(&bar[XB_XGEN(b.x)], 1u);
            asm volatile("s_waitcnt vmcnt(0)" ::: "memory");
#endif
        } else {
#ifdef BAR_EARLY_INV
            __builtin_amdgcn_fence(__ATOMIC_ACQUIRE, "agent"); asm volatile("s_waitcnt vmcnt(0)" ::: "memory");
            XB_SPIN(xb_ld(&bar[XB_XGEN(b.x)]) == gen, bar);
            asm volatile("" ::: "memory");
#else
            XB_SPIN(xb_ld(&bar[XB_XGEN(b.x)]) == gen, bar);
            __builtin_amdgcn_fence(__ATOMIC_ACQUIRE, "agent");
            asm volatile("s_waitcnt vmcnt(0)" ::: "memory");
#endif
        }
    }
    __syncthreads();
}
struct Args { const float* in[N_IN]; float* out; unsigned char* ws; int ph_lo, ph_hi; };
struct Frame {
    LAS unsigned char* lds;
    gu32* ctl;
    unsigned char* ws;
    int tid, lane, wave, vcu, G;
};
#define WSP(type, off) ((type*)(GAS type*)(F.ws + (off)))
__device__ __forceinline__ const float* uni(const float* p) { const u64 v = (u64)p; return (const float*)(const GAS float*)(((u64)(unsigned)__builtin_amdgcn_readfirstlane((int)(v >> 32)) << 32) | (u64)(unsigned)__builtin_amdgcn_readfirstlane((int)v)); }
__device__ __forceinline__ Frame make_frame(unsigned char* ws_, LAS unsigned char* lds_) {
    Frame F; const u64 v = (u64)ws_;
    F.ws = (unsigned char*)(((u64)(unsigned)__builtin_amdgcn_readfirstlane((int)(v >> 32)) << 32) | (u64)(unsigned)__builtin_amdgcn_readfirstlane((int)v));
    F.lds = (LAS unsigned char*)(unsigned)__builtin_amdgcn_readfirstlane((int)(unsigned)(uintptr_t)lds_);
    F.ctl = (gu32*)(F.ws + WS_CTL);
    { int t_ = threadIdx.x; asm volatile("" : "+v"(t_)); F.tid = t_; }
    F.lane = F.tid & 63; F.wave = __builtin_amdgcn_readfirstlane(F.tid >> 6);
    F.G = gridDim.x; { const int bx = blockIdx.x; F.vcu = (F.G % 8 == 0) ? (bx % 8) * (F.G / 8) + bx / 8 : bx; }
    return F;
}
struct In6 { const float* p[6]; };

__device__ __forceinline__ void tr_block(Frame& F, const float* W_, int N, bf16* WT, int k0, int n0, int mode  , size_t drow_base, float scale) {
    LAS unsigned* img = (LAS unsigned*)F.lds; const int lane = F.lane, wave = F.wave, tid = F.tid; const GAS float* W = (const GAS float*)W_;
    f32x4 va[4][2], vb[4][2];
#pragma unroll
    for (int i = 0; i < 4; ++i) { const int kp = wave * 4 + i; const GAS float* r0 = W + (size_t)(k0 + 2 * kp) * N + n0; const GAS float* r1 = r0 + N;
#pragma unroll
        for (int q = 0; q < 2; ++q) { const int c4 = lane + 64 * q; va[i][q] = (f32x4){0.f, 0.f, 0.f, 0.f}; vb[i][q] = va[i][q];
            if (n0 + 4 * c4 < N) { va[i][q] = __builtin_nontemporal_load((const GAS f32x4*)(r0 + 4 * c4)); vb[i][q] = __builtin_nontemporal_load((const GAS f32x4*)(r1 + 4 * c4)); } } }
#pragma unroll
    for (int i = 0; i < 4; ++i) { const int kp = wave * 4 + i;
#pragma unroll
        for (int q = 0; q < 2; ++q) { const int c4 = lane + 64 * q; const f32x4 a = va[i][q], b = vb[i][q];
            v4u o; o.x = pk2(a.x * scale, b.x * scale); o.y = pk2(a.y * scale, b.y * scale); o.z = pk2(a.z * scale, b.z * scale); o.w = pk2(a.w * scale, b.w * scale);
            *(LAS v4u*)(img + kp * 516 + 4 * c4) = o; } }
    __syncthreads();
    const int c = tid & 7;
#pragma unroll
    for (int i = 0; i < 8; ++i) { const int n = (tid >> 3) + 64 * i; const LAS unsigned* p = img + (4 * c) * 516 + n;
        v4u o; o.x = p[0]; o.y = p[516]; o.z = p[2 * 516]; o.w = p[3 * 516];
        const int ng = n0 + n; size_t dr;
        if (mode == 1) dr = ng < 1024 ? (size_t)((ng >> 7) * 256 + (ng & 127)) : (size_t)((((ng - 1024) >> 7) * 256) + 128 + ((ng - 1024) & 127)); else dr = (size_t)ng;
        *(GAS v4u*)((GAS bf16*)WT + (drow_base + dr) * D + k0 + 8 * c) = o; }
    __syncthreads();
}
__device__ __forceinline__ void tr_block8(Frame& F, const float* W_, int N, unsigned char* WT, int k0, int n0, int mode, size_t drow_base, float scale) {
    LAS unsigned* img = (LAS unsigned*)F.lds; const int lane = F.lane, wave = F.wave, tid = F.tid; const GAS float* W = (const GAS float*)W_;
    f32x4 vv[4][2][4];
#pragma unroll
    for (int i = 0; i < 4; ++i) { const int kq = wave * 4 + i; const GAS float* r0 = W + (size_t)(k0 + 4 * kq) * N + n0;
#pragma unroll
        for (int q = 0; q < 2; ++q) { const int c4 = lane + 64 * q;
#pragma unroll
            for (int j = 0; j < 4; ++j) vv[i][q][j] = __builtin_nontemporal_load((const GAS f32x4*)(r0 + (size_t)j * N + 4 * c4)); } }
#pragma unroll
    for (int i = 0; i < 4; ++i) { const int kq = wave * 4 + i;
#pragma unroll
        for (int q = 0; q < 2; ++q) { const int c4 = lane + 64 * q; const f32x4 a = vv[i][q][0] * scale, b = vv[i][q][1] * scale, c = vv[i][q][2] * scale, d = vv[i][q][3] * scale;
            v4u o; o.x = pk4_fp8(a.x, b.x, c.x, d.x); o.y = pk4_fp8(a.y, b.y, c.y, d.y); o.z = pk4_fp8(a.z, b.z, c.z, d.z); o.w = pk4_fp8(a.w, b.w, c.w, d.w);
            *(LAS v4u*)(img + kq * 516 + 4 * c4) = o; } }
    __syncthreads();
    const int c = tid & 7;
#pragma unroll
    for (int i = 0; i < 8; ++i) { const int n = (tid >> 3) + 64 * i; const LAS unsigned* p = img + (4 * c) * 516 + n;
        v4u o; o.x = p[0]; o.y = p[516]; o.z = p[2 * 516]; o.w = p[3 * 516];
        const int ng = n0 + n; size_t dr;
        if (mode == 1) dr = ng < 1024 ? (size_t)((ng >> 7) * 256 + (ng & 127)) : (size_t)((((ng - 1024) >> 7) * 256) + 128 + ((ng - 1024) & 127)); else dr = (size_t)ng;
        __builtin_nontemporal_store(o, (GAS v4u*)((GAS unsigned char*)WT + (drow_base + dr) * D + k0 + 16 * c)); }
    __syncthreads();
}
__device__ __forceinline__ void p_prologue(Frame& F, const In6& A) {
    constexpr int I_IN = 16 * 6, I_OUT = 16 * 2, I_GU = NE * 8 * 4, I_DN = NE * 8 * 2, I_L = I_IN + I_OUT + I_GU + I_DN;
    for (int it = F.vcu; it < DEPTH * I_L; it += F.G) {
        const int l = it / I_L; int r = it % I_L;
        if (r < I_IN) { const int kb = r / 6, nb = r % 6; tr_block(F, A.p[0] + (size_t)l * D * NIN, NIN, WSP(bf16, WS_WIN) + (size_t)l * NINP * D, kb * 64, nb * 512, 0, 0, nb == 2 ? ATT_C2 : 1.f); continue; }
        r -= I_IN;
        if (r < I_OUT) { const int kb = r / 2, nb = r % 2; tr_block(F, A.p[1] + (size_t)l * D * D, D, WSP(bf16, WS_WOUT) + (size_t)l * D * D, kb * 64, nb * 512, 0, 0, 1.f); continue; }
        r -= I_OUT;
        if (r < I_GU) { const int e = r / 32, rr = r % 32, kb = rr / 4, nb = rr % 4; tr_block8(F, A.p[2] + (size_t)(l * NE + e) * D * 2048, 2048, WSP(unsigned char, WS_WGU) + (size_t)l * NE * 2048 * D * 2, kb * 128, nb * 512, 1, (size_t)e * 2048, WGU_SCALE); continue; }
        r -= I_GU;
        { const int e = r / 16, rr = r % 16, kb = rr / 2, nb = rr % 2; tr_block8(F, A.p[3] + (size_t)(l * NE + e) * D * D, D, WSP(unsigned char, WS_WDN) + (size_t)l * NE * D * D * 2, kb * 128, nb * 512, 0, (size_t)e * 1024, WDN_SCALE); }
    }
    const int gw = F.vcu * NWAVES + F.wave, NGW = F.G * NWAVES, lane = F.lane;
    const GAS float* x = (const GAS float*)A.p[4]; GAS bf16* xb = (GAS bf16*)WSP(bf16, WS_XB);
    for (int m = gw; m < T; m += 2 * NGW) {
        const GAS f32x4* xr = (const GAS f32x4*)(x + (size_t)m * D) + lane; GAS u64* o8 = (GAS u64*)(xb + (size_t)m * D) + lane;
        const GAS f32x4* xr2 = xr + (size_t)NGW * (D / 4); GAS u64* o82 = o8 + (size_t)NGW * (D / 4);
        f32x4 v[4], w[4];
#pragma unroll
        for (int j = 0; j < 4; ++j) { v[j] = __builtin_nontemporal_load(xr + 64 * j); w[j] = __builtin_nontemporal_load(xr2 + 64 * j); }
#pragma unroll
        for (int j = 0; j < 4; ++j) { o8[64 * j] = (u64)pk2(v[j].x, v[j].y) | ((u64)pk2(v[j].z, v[j].w) << 32); o82[64 * j] = (u64)pk2(w[j].x, w[j].y) | ((u64)pk2(w[j].z, w[j].w) << 32); }
    }
}

__device__ __forceinline__ void bf8_to_f(const v4u q, float (&f)[8]) { f[0] = bflo(q.x); f[1] = bfhi(q.x); f[2] = bflo(q.y); f[3] = bfhi(q.y); f[4] = bflo(q.z); f[5] = bfhi(q.z); f[6] = bflo(q.w); f[7] = bfhi(q.w); }
__device__ __forceinline__ void p_local(Frame& F, const In6& A, int l) {
    typedef float f32x16 __attribute__((ext_vector_type(16)));
    constexpr int MROW = 528, WROW = 144;
    LAS unsigned char* mixb = F.lds;
    LAS unsigned char* wpt = F.lds + 64 * MROW;
    const GAS float* wpool = (const GAS float*)(A.p[0] + (size_t)l * 4 * 64 * 64);
    const GAS float* convw = (const GAS float*)(A.p[1] + l * 768); const GAS float* pscale = (const GAS float*)(A.p[2] + l * 256);
    const GAS float* kng = (const GAS float*)(A.p[3] + l * 32); const GAS float* knb = (const GAS float*)(A.p[4] + l * 32);
    const GAS bf16* PROJ = (const GAS bf16*)(F.ws + WS_PROJ); GAS bf16* CAT = (GAS bf16*)(F.ws + WS_CAT); GAS bf16* KIN = (GAS bf16*)(F.ws + WS_KIN);
    const int tid = F.tid, lane = F.lane, wave = F.wave;
    for (int u = F.vcu; u < T / 64; u += F.G) {
        const int t0 = u * 64, s0 = t0 & (SEQ - 1), rowb = t0 - s0;
        __syncthreads();
        f32x4 wr0[4], wr1[4];
#pragma unroll
        for (int i = 0; i < 4; ++i) { const int item = tid + 512 * i, g = item >> 9, cp = (item >> 4) & 31, dq = item & 15;
            wr0[i] = *(const GAS f32x4*)(wpool + g * 4096 + (2 * cp) * 64 + 4 * dq); wr1[i] = *(const GAS f32x4*)(wpool + g * 4096 + (2 * cp + 1) * 64 + 4 * dq); }
        const int cga = tid & 31, tga = tid >> 5, ca0 = cga * 8, sfa = s0 + tga * 4;
        v4u ah[6], ag[6], ab[4];
#pragma unroll
        for (int i = -2; i < 4; ++i) { const int sq = sfa + i; ah[i + 2] = (v4u){0u, 0u, 0u, 0u}; ag[i + 2] = ah[i + 2];
            if (sq >= 0) { const GAS bf16* pr = PROJ + (size_t)(rowb + sq) * NINP; ah[i + 2] = *(const GAS v4u*)(pr + C_H + ca0); ag[i + 2] = *(const GAS v4u*)(pr + C_GC + ca0);
                if (i >= 0) ab[i] = *(const GAS v4u*)(pr + C_GB + ca0); } }
        const int cgb = tid & 63, tgb = tid >> 6, cb0 = cgb * 4, wwin = 2 << (cgb >> 4), sfb = s0 + tgb * 8;
        v2u bq[23];
#pragma unroll
        for (int i = 0; i < 23; ++i) { const int sq = sfb - 15 + i; bq[i] = (v2u){0u, 0u}; if (sq >= 0) bq[i] = *(const GAS v2u*)(PROJ + (size_t)(rowb + sq) * NINP + C_P + cb0); }
        bf16 ck[4];
#pragma unroll
        for (int i = 0; i < 4; ++i) { const int idx = tid + 512 * i; ck[i] = PROJ[(size_t)(t0 + (idx >> 5)) * NINP + C_KI + (idx & 31)]; }
        const float kg = kng[tid & 31], kb = knb[tid & 31];
        float w0[8], w1[8], w2[8];
#pragma unroll
        for (int i = 0; i < 8; ++i) { w0[i] = convw[ca0 + i]; w1[i] = convw[256 + ca0 + i]; w2[i] = convw[512 + ca0 + i]; }
#pragma unroll
        for (int i = 0; i < 4; ++i) { const int item = tid + 512 * i, g = item >> 9, cp = (item >> 4) & 31, dq = item & 15;
#pragma unroll
            for (int k = 0; k < 4; ++k) *(LAS unsigned*)(wpt + (g * 64 + 4 * dq + k) * WROW + cp * 4) = pk2(wr0[i][k], wr1[i][k]); }
        {
            float up2[8], up1[8];
#pragma unroll
            for (int i = 0; i < 8; ++i) { up2[i] = 0.f; up1[i] = 0.f; }
#pragma unroll
            for (int i = -2; i < 4; ++i) { const int sq = sfa + i; float h8[8], g8[8], uu[8];
                bf8_to_f(ah[i + 2], h8); bf8_to_f(ag[i + 2], g8);
#pragma unroll
                for (int k = 0; k < 8; ++k) uu[k] = g8[k] * h8[k];
                if (i >= 0) { float b8[8], y[8]; bf8_to_f(ab[i], b8);
#pragma unroll
                    for (int k = 0; k < 8; ++k) y[k] = b8[k] * (w0[k] * up2[k] + w1[k] * up1[k] + w2[k] * uu[k]);
                    v4u o; o.x = pk2(y[0], y[1]); o.y = pk2(y[2], y[3]); o.z = pk2(y[4], y[5]); o.w = pk2(y[6], y[7]);
                    *(GAS v4u*)(CAT + (size_t)(rowb + sq) * D + ca0) = o; }
#pragma unroll
                for (int k = 0; k < 8; ++k) { up2[k] = up1[k]; up1[k] = uu[k]; } }
        }
        {
            float pv[23][4];
#pragma unroll
            for (int i = 0; i < 23; ++i) { pv[i][0] = bflo(bq[i].x); pv[i][1] = bfhi(bq[i].x); pv[i][2] = bflo(bq[i].y); pv[i][3] = bfhi(bq[i].y); }
#pragma unroll
            for (int i = 0; i < 8; ++i) { const int sq = sfb + i; float a0 = 0.f, a1 = 0.f, a2 = 0.f, a3 = 0.f;
#pragma unroll
                for (int j = 0; j < 16; ++j) { const bool on = j < wwin; a0 += on ? pv[15 + i - j][0] : 0.f; a1 += on ? pv[15 + i - j][1] : 0.f; a2 += on ? pv[15 + i - j][2] : 0.f; a3 += on ? pv[15 + i - j][3] : 0.f; }
                const float rc = 1.f / (float)((sq + 1) < wwin ? (sq + 1) : wwin);
                *(LAS v2u*)(mixb + (tgb * 8 + i) * MROW + cb0 * 2) = (v2u){pk2(a0 * rc - pv[15 + i][0], a1 * rc - pv[15 + i][1]), pk2(a2 * rc - pv[15 + i][2], a3 * rc - pv[15 + i][3])}; }
        }
#pragma unroll
        for (int i = 0; i < 4; ++i) {
            const int idx = tid + 512 * i, tt = idx >> 5, dd = idx & 31; const float v = bf2f(ck[i]);
            const float mean = sum32(v) * (1.f / 32.f); const float dv = v - mean; const float var = sum32(dv * dv) * (1.f / 32.f);
            KIN[(size_t)(t0 + tt) * 32 + dd] = (bf16)f2bf(dv * rsqrtf(var + LN_EPS) * kg + kb);
        }
        __syncthreads();
        {
            const int g = wave >> 1, th = wave & 1, r32 = lane & 31, hi = lane >> 5;
            f32x16 acc[2]; acc[0] = f32x16{}; acc[1] = f32x16{};
#pragma unroll
            for (int kk = 0; kk < 4; ++kk) { const bf16x8 bfr = *(const LAS bf16x8*)(mixb + (th * 32 + r32) * MROW + (g * 64 + kk * 16 + hi * 8) * 2);
#pragma unroll
                for (int dh = 0; dh < 2; ++dh) { const bf16x8 afr = *(const LAS bf16x8*)(wpt + (g * 64 + dh * 32 + r32) * WROW + (kk * 16 + hi * 8) * 2);
                    acc[dh] = __builtin_amdgcn_mfma_f32_32x32x16_bf16(afr, bfr, acc[dh], 0, 0, 0); } }
            GAS bf16* orow = CAT + (size_t)(t0 + th * 32 + r32) * D + 256 + g * 64;
#pragma unroll
            for (int dh = 0; dh < 2; ++dh)
#pragma unroll
                for (int rq = 0; rq < 4; ++rq) { const int d0 = dh * 32 + 8 * rq + 4 * hi; const f32x4 sc = *(const GAS f32x4*)(pscale + g * 64 + d0);
                    *(GAS v2u*)(orow + d0) = (v2u){pk2(acc[dh][4 * rq] * sc.x, acc[dh][4 * rq + 1] * sc.y), pk2(acc[dh][4 * rq + 2] * sc.z, acc[dh][4 * rq + 3] * sc.w)}; }
        }
    }
    __syncthreads();
}

constexpr int SCS = SEQ;
__device__ __forceinline__ unsigned sortable(float v) { const unsigned u = __builtin_bit_cast(unsigned, v); return (u & 0x80000000u) ? ~u : (u | 0x80000000u); }
__device__ __forceinline__ void select_row(int t, const GAS float* SC, GAS unsigned* MASK, LAS unsigned* hist, LAS float* ckey, LAS int* cidx, int lane) {
    const u64 lt = (1ull << lane) - 1ull; const float NINF = -INFINITY;
    const int s = t & (SEQ - 1); GAS u64* mrow = (GAS u64*)MASK + ((size_t)(t >> 12) * 64) * SEQ + s;
    if (s < NSEL) { const int base = 64 * lane; u64 m; if (s >= base + 63) m = ~0ull; else if (s < base) m = 0ull; else m = (2ull << (s - base)) - 1ull; mrow[(size_t)lane * SEQ] = m; return; }
    const int jmax = s >> 6, jb = jmax & ~7;
    float v[64]; const GAS float* srow = SC + (size_t)t * SCS + lane;
#pragma unroll
    for (int j0 = 0; j0 < 64; j0 += 8) {
        if (j0 < jb) {
#pragma unroll
            for (int j = j0; j < j0 + 8; ++j) v[j] = srow[64 * j];
        } else if (j0 == jb) {
#pragma unroll
            for (int j = j0; j < j0 + 8; ++j) { const float x = srow[64 * j]; v[j] = (lane + 64 * j <= s) ? x : NINF; }
        } else {
#pragma unroll
            for (int j = j0; j < j0 + 8; ++j) v[j] = NINF;
        }
    }
    {
    float vmx = NINF, vmn = INFINITY;
#pragma unroll
    for (int j0 = 0; j0 < 64; j0 += 8) {
        if (j0 < jb) {
#pragma unroll
            for (int j = j0; j < j0 + 8; ++j) { vmx = fmaxf(vmx, v[j]); vmn = fminf(vmn, v[j]); }
        } else if (j0 == jb) {
#pragma unroll
            for (int j = j0; j < j0 + 8; ++j) { vmx = fmaxf(vmx, v[j]); vmn = fminf(vmn, v[j] == NINF ? INFINITY : v[j]); }
        }
    }
    vmx = wave_max_dpp(vmx); vmn = -wave_max_dpp(-vmn);
    const float scale = 1023.f / fmaxf(vmx - vmn, 1e-30f), off = -vmn * scale;
#pragma unroll
    for (int i = 0; i < 4; ++i) ((LAS v4u*)hist)[i * 64 + lane] = (v4u){0u, 0u, 0u, 0u};
    LDS_WAIT(); asm volatile("" ::: "memory");
    unsigned bp[32];
#pragma unroll
    for (int j0 = 0; j0 < 64; j0 += 8) {
        if (j0 < jb) {
#pragma unroll
            for (int j = j0; j < j0 + 8; ++j) { unsigned bb = (unsigned)fmaf(v[j], scale, off); bb = bb < 1023u ? bb : 1023u; __hip_atomic_fetch_add(hist + bb, 1u, __ATOMIC_RELAXED, __HIP_MEMORY_SCOPE_WORKGROUP);
                if (j & 1) bp[j >> 1] |= bb << 16; else bp[j >> 1] = bb; }
        } else if (j0 == jb) {
#pragma unroll
            for (int j = j0; j < j0 + 8; ++j) { unsigned bb = (unsigned)fmaf(v[j], scale, off); bb = bb < 1023u ? bb : 1023u; if (v[j] != NINF) __hip_atomic_fetch_add(hist + bb, 1u, __ATOMIC_RELAXED, __HIP_MEMORY_SCOPE_WORKGROUP);
                if (j & 1) bp[j >> 1] |= bb << 16; else bp[j >> 1] = bb; }
        } else {
#pragma unroll
            for (int j = j0; j < j0 + 8; j += 2) bp[j >> 1] = 0u;
        }
    }
    LDS_WAIT(); asm volatile("" ::: "memory");
    unsigned hb[16];
#pragma unroll
    for (int i = 0; i < 4; ++i) { const v4u q = ((const LAS v4u*)hist)[lane * 4 + i]; hb[4 * i] = q.x; hb[4 * i + 1] = q.y; hb[4 * i + 2] = q.z; hb[4 * i + 3] = q.w; }
    int own = 0;
#pragma unroll
    for (int i = 0; i < 16; ++i) own += (int)hb[i];
    int suf = own;
    suf += __builtin_amdgcn_update_dpp(0, suf, 0x101, 0xf, 0xf, true); suf += __builtin_amdgcn_update_dpp(0, suf, 0x102, 0xf, 0xf, true);
    suf += __builtin_amdgcn_update_dpp(0, suf, 0x104, 0xf, 0xf, true); suf += __builtin_amdgcn_update_dpp(0, suf, 0x108, 0xf, 0xf, true);
    { const int t1 = __builtin_amdgcn_readlane(suf, 16), t2 = __builtin_amdgcn_readlane(suf, 32), t3 = __builtin_amdgcn_readlane(suf, 48); const int rw = lane >> 4;
      suf += rw == 0 ? t1 + t2 + t3 : rw == 1 ? t2 + t3 : rw == 2 ? t3 : 0; }
    const u64 ge = __ballot(suf >= NSEL); const int L = 63 - __builtin_clzll(ge);
    int acc = suf - own, tb = 0, ca = 0, found = 0;
#pragma unroll
    for (int i = 15; i >= 0; --i) { if (!found) { if (acc + (int)hb[i] >= NSEL) { found = 1; tb = lane * 16 + i; ca = acc; } else acc += (int)hb[i]; } }
    const int TB = __builtin_amdgcn_readlane(tb, L), CA = __builtin_amdgcn_readlane(ca, L);
    const int need = NSEL - CA;
    int cbase = 0; unsigned mlo = 0u, mhi = 0u;
#pragma unroll
    for (int j0 = 0; j0 < 64; j0 += 8) {
        if (j0 <= jb) {
#pragma unroll
            for (int j = j0; j < j0 + 8; ++j) { const int bb = (int)((j & 1) ? (bp[j >> 1] >> 16) : (bp[j >> 1] & 0xffffu));
                const u64 am = __ballot(bb > TB); const u64 cm = __ballot(bb == TB);
                asm volatile("s_nop 4\n\tv_writelane_b32 %0, %2, %4\n\tv_writelane_b32 %1, %3, %4" : "+v"(mlo), "+v"(mhi) : "s"((unsigned)am), "s"((unsigned)(am >> 32)), "n"(j));
                if (cm) { const int pos = cbase + __popcll(cm & lt); if (bb == TB && pos < 64) { ckey[pos] = v[j]; cidx[pos] = lane + 64 * j; } cbase += __popcll(cm); } }
        }
    }
    LDS_WAIT(); asm volatile("" ::: "memory");
    if (cbase <= SEL_CAND_CAP) {
        LAS unsigned* mw = hist;
        mw[2 * lane] = mlo; mw[2 * lane + 1] = mhi;
        const float myk = lane < cbase ? ckey[lane] : NINF; const int myi = lane < cbase ? cidx[lane] : 0x7fffffff; int rank = 0;
        for (int c = 0; c < cbase; ++c) { const float ok = __builtin_bit_cast(float, __builtin_amdgcn_readlane(__builtin_bit_cast(int, myk), c)); const int oi = __builtin_amdgcn_readlane(myi, c); rank += (ok > myk || (ok == myk && oi < myi)) ? 1 : 0; }
        LDS_WAIT(); asm volatile("" ::: "memory");
        if (lane < cbase && rank < need && myk != NINF) __hip_atomic_fetch_or(mw + (myi >> 5), 1u << (myi & 31), __ATOMIC_RELAXED, __HIP_MEMORY_SCOPE_WORKGROUP);
        LDS_WAIT(); asm volatile("" ::: "memory");
        mrow[(size_t)lane * SEQ] = (u64)mw[2 * lane] | ((u64)mw[2 * lane + 1] << 32);
        LDS_WAIT(); asm volatile("" ::: "memory");
        return;
    }
    unsigned prefix = 0u;
    for (int bit = 31; bit >= 0; --bit) { const unsigned cand = prefix | (1u << bit); int cnt = 0;
#pragma unroll
        for (int j0 = 0; j0 < 64; j0 += 8) {
#pragma unroll
            for (int j = j0; j < j0 + 8; ++j) cnt += __popcll(__ballot(v[j] != NINF && sortable(v[j]) >= cand));
            __builtin_amdgcn_sched_barrier(0); }
        if (cnt >= NSEL) prefix = cand; }
    int ngt = 0;
#pragma unroll
    for (int j = 0; j < 64; ++j) ngt += __popcll(__ballot(v[j] != NINF && sortable(v[j]) > prefix));
    int rem = NSEL - ngt, last = 0;
#pragma unroll
    for (int j = 0; j < 64; ++j) { const u64 em = __ballot(v[j] != NINF && sortable(v[j]) == prefix); const int c = __popcll(em);
        if (rem > 0 && c > 0) { if (c >= rem) { u64 x = em; for (int q = 1; q < rem; ++q) x &= x - 1ull; last = 64 * j + __builtin_ctzll(x); rem = 0; } else rem -= c; } }
    const unsigned pb = (prefix & 0x80000000u) ? (prefix & 0x7fffffffu) : ~prefix; const float Tv = __builtin_bit_cast(float, pb); const int Tidx = last;
    mlo = 0u; mhi = 0u;
#pragma unroll
    for (int j = 0; j < 64; ++j) { const bool sel = (v[j] > Tv) || (v[j] == Tv && lane + 64 * j <= Tidx); const u64 m = __ballot(sel);
        asm volatile("s_nop 4\n\tv_writelane_b32 %0, %2, %4\n\tv_writelane_b32 %1, %3, %4" : "+v"(mlo), "+v"(mhi) : "s"((unsigned)m), "s"((unsigned)(m >> 32)), "n"(j)); }
    mrow[(size_t)lane * SEQ] = (u64)mlo | ((u64)mhi << 32);
    return;
    }
}
__device__ __forceinline__ float relu_i(float x) { const int b = __builtin_bit_cast(int, x); return __builtin_bit_cast(float, b > 0 ? b : 0); }
__device__ __forceinline__ void p_index(Frame& F) {
    const int wave = F.wave;
    const GAS bf16* PROJ = (const GAS bf16*)(F.ws + WS_PROJ); const GAS bf16* KIN = (const GAS bf16*)(F.ws + WS_KIN); GAS float* SC = (GAS float*)(F.ws + WS_SC); GAS unsigned* MASK = (GAS unsigned*)(F.ws + WS_MASK);
    LAS unsigned* hist = (LAS unsigned*)(F.lds + wave * 4096);
    LAS float* ckey = (LAS float*)(F.lds + 32768 + wave * 1024); LAS int* cidx = (LAS int*)(ckey + 64);
    for (int ui = 0; ui < 2; ++ui) {
        const int v = F.vcu; if (v >= 256) break;
        const int b = v & 3, j = v >> 2, qb = ui == 0 ? j : 127 - j, q0 = qb * 32;
        int lane = F.tid & 63; asm volatile("" : "+v"(lane)); const int l15 = lane & 15, l4 = lane >> 4;
        bf16x8 bq[2][8]; float wq[2][8];
#pragma unroll
        for (int hq = 0; hq < 2; ++hq) { const size_t rowq = (size_t)(b * SEQ + q0 + 16 * hq + l15);
#pragma unroll
            for (int h = 0; h < 8; ++h) { bq[hq][h] = *(const GAS bf16x8*)(PROJ + rowq * NINP + C_QI + h * 32 + 8 * l4); wq[hq][h] = bf2f(PROJ[rowq * NINP + C_WI + h]) * 0.0625f; } }
        GAS float* srow = SC + (size_t)(b * SEQ + q0 + l15) * SCS + 4 * l4;
        const int ktl = 2 * qb + 1; const GAS bf16* kin0 = KIN + (size_t)(b * SEQ + l15) * 32 + 8 * l4;
        bf16x8 a = *(const GAS bf16x8*)(kin0 + (size_t)((wave <= ktl ? wave : ktl) * 16) * 32);
        for (int kt = wave; kt <= ktl; kt += NWAVES) {
            const int ktn = kt + NWAVES <= ktl ? kt + NWAVES : kt;
            const bf16x8 an = *(const GAS bf16x8*)(kin0 + (size_t)(ktn * 16) * 32);
#pragma unroll
            for (int hq = 0; hq < 2; ++hq) { f32x4 sc = (f32x4){0.f, 0.f, 0.f, 0.f};
#pragma unroll
                for (int h = 0; h < 8; ++h) { const f32x4 d = __builtin_amdgcn_mfma_f32_16x16x32_bf16(a, bq[hq][h], (f32x4){0.f, 0.f, 0.f, 0.f}, 0, 0, 0);
                    sc.x += relu_i(d.x) * wq[hq][h]; sc.y += relu_i(d.y) * wq[hq][h]; sc.z += relu_i(d.z) * wq[hq][h]; sc.w += relu_i(d.w) * wq[hq][h]; }
                *(GAS f32x4*)(srow + (size_t)(16 * hq) * SCS + kt * 16) = sc; }
            a = an;
        }
        asm volatile("s_waitcnt vmcnt(0)" ::: "memory"); __syncthreads();
        int lane_s = F.tid & 63; asm volatile("" : "+v"(lane_s));
        for (int r = 0; r < 4; ++r) select_row(b * SEQ + q0 + wave * 4 + r, SC, MASK, hist, ckey, cidx, lane_s);
#ifdef EXP_DUP_SELECT
        for (int r = 0; r < 4; ++r) select_row(b * SEQ + q0 + wave * 4 + r, SC, MASK, hist, ckey, cidx, lane_s);
#endif
    }
}

namespace att {
typedef float f32x16 __attribute__((ext_vector_type(16)));
typedef short s16x4 __attribute__((ext_vector_type(4)));
constexpr int NSLOT = 3, SLOTB = 8192, LDS_K = 0, LDS_V = NSLOT * SLOTB, LDS_WS = 2 * NSLOT * SLOTB, LDS_OST = LDS_WS + 8 * 64 * 4, LDS_BYTES_ATT = LDS_OST + 8 * 4096;
constexpr float THR = 100.f;
__device__ __forceinline__ int crow(int r, int hi) { return (r & 3) + 8 * (r >> 2) + 4 * hi; }
__device__ __forceinline__ unsigned cvtpk(float lo, float hi) { typedef float f2 __attribute__((ext_vector_type(2))); typedef __bf16 b2 __attribute__((ext_vector_type(2))); f2 v = {lo, hi}; b2 b = __builtin_convertvector(v, b2); return __builtin_bit_cast(unsigned, b); }
__device__ __forceinline__ float rowmax(const f32x16& p0, const f32x16& p1) {
    float a = fmaxf(fmaxf(p0[0], p0[1]), p1[0]), b = fmaxf(fmaxf(p0[2], p0[3]), p1[1]); a = fmaxf(fmaxf(a, p1[2]), p1[3]);
#pragma unroll
    for (int r = 4; r < 16; r += 4) { a = fmaxf(fmaxf(a, p0[r]), p0[r + 1]); b = fmaxf(fmaxf(b, p0[r + 2]), p0[r + 3]); a = fmaxf(fmaxf(a, p1[r]), p1[r + 1]); b = fmaxf(fmaxf(b, p1[r + 2]), p1[r + 3]); }
    const float m = fmaxf(a, b);
    return fmaxf(m, __shfl_xor(m, 32));
}
__device__ __forceinline__ void pv(f32x16* o, int vb, bf16x8 pa0, bf16x8 pa1, bf16x8 pa2, bf16x8 pa3) {
#pragma unroll
    for (int d0 = 0; d0 < 2; ++d0) { s16x4 lo[4], hi[4];
#pragma unroll
        for (int ks = 0; ks < 4; ++ks) {
            asm volatile("ds_read_b64_tr_b16 %0,%1 offset:%c2" : "=&v"(lo[ks]) : "v"(vb), "i"(d0 * 4096 + ks * 1024) : "memory");
            asm volatile("ds_read_b64_tr_b16 %0,%1 offset:%c2" : "=&v"(hi[ks]) : "v"(vb), "i"(d0 * 4096 + ks * 1024 + 512) : "memory"); }
        asm volatile("s_waitcnt lgkmcnt(0)" ::: "memory"); __builtin_amdgcn_sched_barrier(0);
#define ATT_PK(k) (bf16x8){lo[k][0], lo[k][1], lo[k][2], lo[k][3], hi[k][0], hi[k][1], hi[k][2], hi[k][3]}
        o[d0] = __builtin_amdgcn_mfma_f32_32x32x16_bf16(pa0, ATT_PK(0), o[d0], 0, 0, 0);
        o[d0] = __builtin_amdgcn_mfma_f32_32x32x16_bf16(pa1, ATT_PK(1), o[d0], 0, 0, 0);
        o[d0] = __builtin_amdgcn_mfma_f32_32x32x16_bf16(pa2, ATT_PK(2), o[d0], 0, 0, 0);
        o[d0] = __builtin_amdgcn_mfma_f32_32x32x16_bf16(pa3, ATT_PK(3), o[d0], 0, 0, 0);
#undef ATT_PK
    }
}
}
template <bool grpB> __device__ __forceinline__ void attn_units(Frame& F) {
    using namespace att;
    const int tid = F.tid, lane = tid & 63, r32 = lane & 31, hi = lane >> 5, wid = F.wave;
    const GAS bf16* PROJ = (const GAS bf16*)(F.ws + WS_PROJ); GAS bf16* CAT = (GAS bf16*)(F.ws + WS_CAT); const GAS u64* MASKT = (const GAS u64*)(F.ws + WS_MASK);
    LAS unsigned char* shm = F.lds;
    constexpr int NSV = 4, LDS_V2 = NSLOT * SLOTB, LDS_WS2 = LDS_V2 + NSV * SLOTB, LDS_OST2 = LDS_WS2 + 8 * 64 * 4;
    LAS float* wsf = (LAS float*)(shm + LDS_WS2) + wid * 64;
    const float NEGINF = -INFINITY;
    for (int ui = 0; ui < 2; ++ui) {
        const int v = F.vcu; if (v >= 256) break;
        const int bh = v >> 3, sidx = v & 7, b = bh >> 3, h = bh & 7, qb = ui == 0 ? sidx : 15 - sidx;
        const size_t rowbase = (size_t)b * SEQ; const int q0 = qb * 256, NT = (q0 + 256) / 64;
        const float slope2 = exp2f(-(float)(h + 1)) * 1.4426950408889634f;
        const GAS bf16* Kh = PROJ + rowbase * NINP + C_K + h * 64; const GAS bf16* Vh = PROJ + rowbase * NINP + C_V + h * 64;
        const GAS bf16* ksrc = Kh + (size_t)lane * NINP + wid * 8;
        const GAS bf16* vsrc = Vh + (size_t)(16 * (wid & 3) + (lane >> 2)) * NINP + (wid >> 2) * 32 + (lane & 3) * 8;
#define ATT_DMA(t, ks, vs) do { __builtin_amdgcn_global_load_lds((const GAS unsigned*)(ksrc + (size_t)(t) * 64 * NINP), (LAS unsigned*)(shm + LDS_K + (ks) * SLOTB + wid * 1024), 16, 0, 0); \
                        __builtin_amdgcn_global_load_lds((const GAS unsigned*)(vsrc + (size_t)(t) * 64 * NINP), (LAS unsigned*)(shm + LDS_V2 + (vs) * SLOTB + wid * 1024), 16, 0, 0); } while (0)
        ATT_DMA(0, 0, 0); ATT_DMA(1, 1, 1);
        const GAS bf16* Qw = PROJ + (rowbase + q0 + wid * 32) * NINP + C_Q + h * 64;
        bf16x8 qr[4];
#pragma unroll
        for (int d0 = 0; d0 < 4; ++d0) qr[d0] = *(const GAS bf16x8*)(Qw + (size_t)r32 * NINP + d0 * 16 + hi * 8);
        const GAS u64* mq = MASKT + ((size_t)b * 64) * SEQ + q0 + wid * 32 + r32;
        u64 mnext = mq[0], mprev = 0ull;
        f32x16 o[2], p0 = f32x16{}, p1 = f32x16{}; o[0] = f32x16{}; o[1] = f32x16{};
        float l_reg = 0.f, sq = 0.f;
        const unsigned sl_hi = __builtin_bit_cast(unsigned, slope2) & 0xffff0000u; const unsigned sl_lo = f2bf(slope2 - __builtin_bit_cast(float, sl_hi));
        bf16x8 kx0, kx1;
        { const unsigned j0 = hi ? 0u : (f2bf((float)r32) * 0x10001u), j1 = hi ? 0u : (f2bf((float)(r32 + 32)) * 0x10001u), one2 = hi ? 0u : 0x3f803f80u, one1 = hi ? 0u : 0x3f80u;
          kx0 = __builtin_bit_cast(bf16x8, (v4u){j0, one2, one1, 0u}); kx1 = __builtin_bit_cast(bf16x8, (v4u){j1, one2, one1, 0u}); }
        const int qlast = q0 + wid * 32 + 31;
        const int vb0 = (int)(unsigned)(uintptr_t)(shm + LDS_V2) + ((lane >> 4) & 1) * 32 + (lane & 3) * 8 + (4 * hi + ((lane & 15) >> 2)) * 64;
#define ATT_QK(ks) do { const LAS unsigned char* kb = shm + LDS_K + (ks) * SLOTB + hi * 1024 + r32 * 16; \
            { const unsigned u0_ = __builtin_bit_cast(unsigned, sq), a1_ = u0_ & 0xffff0000u; const float r1_ = sq - __builtin_bit_cast(float, a1_); const unsigned u1_ = __builtin_bit_cast(unsigned, r1_), a2_ = u1_ & 0xffff0000u; \
              const float r2_ = r1_ - __builtin_bit_cast(float, a2_); const unsigned a3_ = __builtin_bit_cast(unsigned, r2_) >> 16; \
              const bf16x8 qx = __builtin_bit_cast(bf16x8, (v4u){hi ? 0u : ((sl_hi >> 16) | (sl_lo << 16)), hi ? 0u : ((a1_ >> 16) | a2_), hi ? 0u : a3_, 0u}); \
              const f32x16 z_ = f32x16{}; p0 = __builtin_amdgcn_mfma_f32_32x32x16_bf16(kx0, qx, z_, 0, 0, 0); p1 = __builtin_amdgcn_mfma_f32_32x32x16_bf16(kx1, qx, z_, 0, 0, 0); } \
            _Pragma("unroll") for (int d0 = 0; d0 < 4; ++d0) { const bf16x8 k0 = *(const LAS bf16x8*)(kb + d0 * 2048), k1 = *(const LAS bf16x8*)(kb + d0 * 2048 + 512); \
                p0 = __builtin_amdgcn_mfma_f32_32x32x16_bf16(k0, qr[d0], p0, 0, 0, 0); p1 = __builtin_amdgcn_mfma_f32_32x32x16_bf16(k1, qr[d0], p1, 0, 0, 0); } } while (0)
#define ATT_SMPV(vs, mw) do { const unsigned w0 = (unsigned)(mw) >> (4 * hi), w1 = (unsigned)((mw) >> 32) >> (4 * hi); \
            asm volatile("s_nop 15\n\ts_nop 7" : "+v"(p0), "+v"(p1));   \
            _Pragma("unroll") for (int r = 0; r < 16; ++r) { const int cr = (r & 3) + 8 * (r >> 2); const int k0_ = __builtin_amdgcn_sbfe((int)w0, cr, 1), k1_ = __builtin_amdgcn_sbfe((int)w1, cr, 1); \
                asm("v_bfi_b32 %0, %1, %0, %2" : "+v"(p0[r]) : "v"(k0_), "v"(NEGINF)); asm("v_bfi_b32 %0, %1, %0, %2" : "+v"(p1[r]) : "v"(k1_), "v"(NEGINF)); } \
            const float rm = rowmax(p0, p1); bool resc = false; \
            if (__any(rm > THR)) { const float dl = fmaxf(rm, 0.f); \
                _Pragma("unroll") for (int r = 0; r < 16; ++r) { p0[r] -= dl; p1[r] -= dl; } sq -= dl; \
                const float f = __builtin_amdgcn_exp2f(-dl); l_reg *= f; if (hi == 0) wsf[r32] = f; resc = true; } \
            float sacc = 0.f; \
            _Pragma("unroll") for (int r = 0; r < 16; ++r) { p0[r] = __builtin_amdgcn_exp2f(p0[r]); p1[r] = __builtin_amdgcn_exp2f(p1[r]); sacc += p0[r] + p1[r]; } \
            l_reg += sacc; \
            if (resc) { asm volatile("s_waitcnt lgkmcnt(0)" ::: "memory"); \
                _Pragma("unroll") for (int d_ = 0; d_ < 2; ++d_) _Pragma("unroll") for (int r = 0; r < 16; ++r) o[d_][r] *= wsf[crow(r, hi)]; } \
            const v4u pw0 = (v4u){cvtpk(p0[0], p0[1]), cvtpk(p0[2], p0[3]), cvtpk(p0[4], p0[5]), cvtpk(p0[6], p0[7])}, pw1 = (v4u){cvtpk(p0[8], p0[9]), cvtpk(p0[10], p0[11]), cvtpk(p0[12], p0[13]), cvtpk(p0[14], p0[15])}; \
            const v4u pw2 = (v4u){cvtpk(p1[0], p1[1]), cvtpk(p1[2], p1[3]), cvtpk(p1[4], p1[5]), cvtpk(p1[6], p1[7])}, pw3 = (v4u){cvtpk(p1[8], p1[9]), cvtpk(p1[10], p1[11]), cvtpk(p1[12], p1[13]), cvtpk(p1[14], p1[15])}; \
            __builtin_amdgcn_sched_barrier(0); \
            pv(o, vb0 + (vs) * SLOTB, __builtin_bit_cast(bf16x8, pw0), __builtin_bit_cast(bf16x8, pw1), __builtin_bit_cast(bf16x8, pw2), __builtin_bit_cast(bf16x8, pw3)); } while (0)
        if constexpr (grpB) __builtin_amdgcn_s_setprio(1);
        const float step = 64.f * slope2;
        int ks = 0, vs = 0;
        u64 mcur = 0ull;
#define ATT_SYNC(t) do { if ((t) + 1 < NT) asm volatile("s_waitcnt vmcnt(2)" ::: "memory"); else asm volatile("s_waitcnt vmcnt(0)" ::: "memory"); \
            asm volatile("s_waitcnt lgkmcnt(0)" ::: "memory"); __builtin_amdgcn_s_barrier(); asm volatile("" ::: "memory"); \
            mprev = mcur; mcur = mnext; if ((t) + 1 < NT) mnext = mq[(size_t)((t) + 1) * SEQ]; \
            __builtin_amdgcn_sched_barrier(0); \
            if ((t) + 2 < NT) ATT_DMA((t) + 2, ks + 2 >= NSLOT ? ks + 2 - NSLOT : ks + 2, vs + 2 >= NSV ? vs + 2 - NSV : vs + 2); \
            __builtin_amdgcn_sched_barrier(0); } while (0)
#define ATT_ADV() do { sq += step; ks = ks + 1 >= NSLOT ? 0 : ks + 1; vs = vs + 1 >= NSV ? 0 : vs + 1; } while (0)
        const int tmax = qlast >> 6;
        if constexpr (!grpB) {
            int t = 0;
            for (; t <= tmax; ++t) { ATT_SYNC(t); ATT_QK(ks); ATT_SMPV(vs, mcur); ATT_ADV(); }
            for (; t < NT; ++t) { ATT_SYNC(t); ATT_ADV(); }
        } else {
            ATT_SYNC(0); ATT_QK(ks); ATT_ADV();
            int t = 1;
            for (; t <= tmax; ++t) { ATT_SYNC(t); ATT_SMPV(vs == 0 ? NSV - 1 : vs - 1, mprev); ATT_QK(ks); ATT_ADV(); }
            if (t < NT) { ATT_SYNC(t); ATT_SMPV(vs == 0 ? NSV - 1 : vs - 1, mprev); ATT_ADV(); ++t;
                for (; t < NT; ++t) { ATT_SYNC(t); ATT_ADV(); } }
            else { ATT_SMPV(vs == 0 ? NSV - 1 : vs - 1, mcur); }
        }
#undef ATT_SYNC
#undef ATT_ADV
        __builtin_amdgcn_s_setprio(0);
        l_reg += __shfl_xor(l_reg, 32);
        if (hi == 0) wsf[32 + r32] = l_reg;
        asm volatile("s_waitcnt lgkmcnt(0)" ::: "memory");
        float rli[16];
#pragma unroll
        for (int r = 0; r < 16; ++r) rli[r] = 1.f / wsf[32 + crow(r, hi)];
        GAS bf16* Ow = CAT + (rowbase + q0 + wid * 32) * D + 512 + h * 64;
        { LAS bf16* stg = (LAS bf16*)(shm + LDS_OST2) + wid * 2048;
#pragma unroll
            for (int r = 0; r < 16; ++r) { const int orow = crow(r, hi);
#pragma unroll
                for (int d0 = 0; d0 < 2; ++d0) stg[orow * 64 + d0 * 32 + r32] = (bf16)f2bf(o[d0][r] * rli[r]); }
            asm volatile("s_waitcnt lgkmcnt(0)" ::: "memory");
#pragma unroll
            for (int i = 0; i < 4; ++i) { const int row = i * 8 + (lane >> 3), ch = lane & 7; const v4u vv = *(const LAS v4u*)(stg + row * 64 + ch * 8); *(GAS v4u*)(Ow + (size_t)row * D + ch * 8) = vv; } }
        asm volatile("s_waitcnt vmcnt(0) lgkmcnt(0)" ::: "memory"); __builtin_amdgcn_s_barrier(); asm volatile("" ::: "memory");
#undef ATT_DMA
#undef ATT_QK
#undef ATT_SMPV
    }
}

__device__ __forceinline__ void p_attn_dense(Frame& F) { if (F.wave >= 4) attn_units<true>(F); else attn_units<false>(F); }

struct EpiResid {
    static constexpr bool PERM = true, AFTER_DRAIN = false;
    const bf16* resid; bf16* out; float alpha;
    __device__ __forceinline__ void operator()(const pg8::f32x4 (&acc)[2][2][4][2], const pg8::Unit& u, int wr, int wc, int fr, int fq) const {
        const int col0 = u.pn * 256 + wc * 32 + 8 * fq;
#pragma unroll
        for (int ai = 0; ai < 2; ++ai)
#pragma unroll
            for (int m = 0; m < 4; ++m) { const size_t off = (size_t)(u.pm * 256 + ai * 128 + wr * 64 + m * 16 + fr) * D + col0;
#pragma unroll
                for (int bj = 0; bj < 2; ++bj) { const v4u xr = *(const GAS v4u*)(resid + off + bj * 128); const f32x4 a0 = acc[ai][bj][m][0], a1 = acc[ai][bj][m][1];
                    v4u w; w.x = pk2(bflo(xr.x) * alpha + a0[0], bfhi(xr.x) * alpha + a0[1]); w.y = pk2(bflo(xr.y) * alpha + a0[2], bfhi(xr.y) * alpha + a0[3]);
                    w.z = pk2(bflo(xr.z) * alpha + a1[0], bfhi(xr.z) * alpha + a1[1]); w.w = pk2(bflo(xr.w) * alpha + a1[2], bfhi(xr.w) * alpha + a1[3]);
                    st16_wt(out + off + bj * 128, w.x, w.y, w.z, w.w); }
                if (m & 1) asm volatile("" ::: "memory"); }
    }
};
struct EpiSwiglu {
    static constexpr bool PERM = true, AFTER_DRAIN = false;
    unsigned char* O; const float* bias;
    __device__ __forceinline__ void operator()(const pg8::f32x4 (&acc)[2][2][4][2], const pg8::Unit& u, int wr, int wc, int fr, int fq) const {
        const int e = u.pn >> 3, nt = u.pn & 7; const int colg = nt * 128 + wc * 32 + 8 * fq;
        f32x4 bg[2], bu[2];
#pragma unroll
        for (int n = 0; n < 2; ++n) { bg[n] = *(const GAS f32x4*)(bias + (size_t)e * 2048 + colg + 4 * n); bu[n] = *(const GAS f32x4*)(bias + (size_t)e * 2048 + 1024 + colg + 4 * n); }
#pragma unroll
        for (int ai = 0; ai < 2; ++ai)
#pragma unroll
            for (int m = 0; m < 4; ++m) { const size_t row = (size_t)(u.pm * 256 + ai * 128 + wr * 64 + m * 16 + fr); float a8[8];
#pragma unroll
                for (int n = 0; n < 2; ++n)
#pragma unroll
                    for (int i = 0; i < 4; i += 2) {
                        typedef float f2 __attribute__((ext_vector_type(2)));
                        const f2 ag = {acc[ai][0][m][n][i], acc[ai][0][m][n][i + 1]}, au = {acc[ai][1][m][n][i], acc[ai][1][m][n][i + 1]};
                        const f2 bgv = {bg[n][i], bg[n][i + 1]}, buv = {bu[n][i] + 1.f, bu[n][i + 1] + 1.f};
                        f2 g = ag * (1.f / WGU_SCALE) + bgv, up1 = au * (1.f / WGU_SCALE) + buv;
                        g.x = fminf(g.x, 7.f); g.y = fminf(g.y, 7.f); up1.x = fminf(fmaxf(up1.x, -6.f), 8.f); up1.y = fminf(fmaxf(up1.y, -6.f), 8.f);
                        f2 t = g * (-1.702f * 1.4426950408889634f); t.x = __builtin_amdgcn_exp2f(t.x); t.y = __builtin_amdgcn_exp2f(t.y);
                        f2 d = t + 1.f; d.x = __builtin_amdgcn_rcpf(d.x); d.y = __builtin_amdgcn_rcpf(d.y);
                        const f2 r = g * up1 * d; a8[n * 4 + i] = r.x; a8[n * 4 + i + 1] = r.y; }
                v2u w; w.x = pk4_fp8(a8[0], a8[1], a8[2], a8[3]); w.y = pk4_fp8(a8[4], a8[5], a8[6], a8[7]);
                st8_wt(O + row * 1024 + colg, w.x, w.y); }
    }
};
struct EpiDown {
    static constexpr bool PERM = true, AFTER_DRAIN = false;
    unsigned char* O; const float* bias;
    __device__ __forceinline__ void operator()(const pg8::f32x4 (&acc)[2][2][4][2], const pg8::Unit& u, int wr, int wc, int fr, int fq) const {
        const int col0 = (u.pn & 3) * 256 + wc * 32 + 8 * fq; const float* bp = bias + (size_t)(u.pn >> 2) * 1024 + col0;
        f32x4 bv[2][2];
#pragma unroll
        for (int bj = 0; bj < 2; ++bj)
#pragma unroll
            for (int n = 0; n < 2; ++n) bv[bj][n] = *(const GAS f32x4*)(bp + bj * 128 + 4 * n);
#pragma unroll
        for (int ai = 0; ai < 2; ++ai)
#pragma unroll
            for (int m = 0; m < 4; ++m) { unsigned char* rowp = O + (size_t)(u.pm * 256 + ai * 128 + wr * 64 + m * 16 + fr) * 1024 + col0;
#pragma unroll
                for (int bj = 0; bj < 2; ++bj) { const f32x4 v0 = acc[ai][bj][m][0] * (1.f / WDN_SCALE) + bv[bj][0], v1 = acc[ai][bj][m][1] * (1.f / WDN_SCALE) + bv[bj][1];
                    st8_wt(rowp + bj * 128, pk4_fp8(v0[0], v0[1], v0[2], v0[3]), pk4_fp8(v1[0], v1[1], v1[2], v1[3])); } }
    }
};
struct MoeSched {
    const LAS int* tab; int n;
    __device__ __forceinline__ bool next(int i, pg8::Unit& u) const {
        if (i >= n) return false;
        const int v = __builtin_amdgcn_readfirstlane(tab[1 + i]); u.pm = v >> 16; u.pn = v & 0xffff; return true;
    }
    __device__ __forceinline__ void a_ready(const pg8::Unit&) const {}
    __device__ __forceinline__ void done(const pg8::Unit&) const {}
};
#ifndef MOE_UNIT_OWNER
#define MOE_UNIT_OWNER F.vcu
#endif
__device__ __forceinline__ int moe_table(Frame& F, int l, int ntn) {
    LAS int* tab = (LAS int*)(F.lds + TAB_OFF);
    if (F.wave == 0) {
        const int lane = F.lane; const int cnt = lane < NE ? (int)__hip_atomic_load(F.ctl + CW_CNT + 64 * l + lane, RLX_AGENT) : 0; const int mt = (cnt + 255) >> 8; int incl = mt;
#pragma unroll
        for (int o = 1; o < 64; o <<= 1) { const int v = __shfl_up(incl, o); if (lane >= o) incl += v; }
        const int total = __shfl(incl, 63) * ntn; const int c = MOE_UNIT_OWNER;
        const int xcd = c >> 5, jw = c & 31, uq = total >> 3, ur = total & 7, cntx = uq + (xcd < ur ? 1 : 0), basex = xcd * uq + (xcd < ur ? xcd : ur);
        const int nmine = jw < cntx ? (cntx - jw + 31) >> 5 : 0;
        for (int i0 = 0; i0 < nmine && i0 < 200; i0 += 64) { const int i = i0 + lane; const int L = basex + i * 32 + jw; int e = 0;
            for (int k = 0; k < NE; ++k) { const int endk = __shfl(incl, k) * ntn; e += (L >= endk) ? 1 : 0; }
            e = e < NE ? e : NE - 1;
            const int excl_e = __shfl(incl, e) - __shfl(mt, e); int mte = __shfl(mt, e); mte = mte > 0 ? mte : 1; const int idx = L - excl_e * ntn;
            if (i < nmine && i < 200) tab[1 + i] = ((excl_e + idx % mte) << 16) | (e * ntn + idx / mte); }
        if (lane == 0) tab[0] = nmine < 200 ? nmine : 200;
    }
    __syncthreads();
    return __builtin_amdgcn_readfirstlane(tab[0]);
}

__device__ __forceinline__ void p_router(Frame& F, const In6& A, int l) {
    const int lane = F.lane, wave = F.wave, tid = F.tid;
    constexpr int XROW = 2064;
    LAS unsigned char* XH = F.lds; LAS unsigned char* XL = F.lds + 16 * XROW;
    LAS float* part = (LAS float*)(F.lds + 2 * 16 * XROW);
    LAS int* cnt = (LAS int*)(F.lds + 2 * 16 * XROW + 16384);
    LAS float* lgs = (LAS float*)(F.lds + 2 * 16 * XROW + 16384 + 1024);
    LAS float* top = lgs + 512;
    const GAS bf16* Y1 = (const GAS bf16*)(F.ws + WS_Y1); GAS bf16* X1B = (GAS bf16*)(F.ws + WS_Y1 + 32 * MiB); GAS unsigned* XB8 = (GAS unsigned*)(F.ws + WS_XB8);
    GAS int* TOPE = (GAS int*)(F.ws + WS_ROUTE); GAS float* GATE = (GAS float*)(TOPE + 8 * T); GAS int* CNTW = (GAS int*)(F.ws + WS_CNTW);
    const GAS float* g1 = (const GAS float*)(A.p[0] + l * D); const GAS float* b1 = (const GAS float*)(A.p[1] + l * D);
    const GAS float* RW = (const GAS float*)(A.p[2] + (size_t)l * D * NE); const GAS float* RB = (const GAS float*)(A.p[3] + l * NE);
    if (tid < 256) cnt[tid] = 0;
    bf16x8 wh[4][2], wl[4][2];
#pragma unroll
    for (int st = 0; st < 4; ++st)
#pragma unroll
        for (int hf = 0; hf < 2; ++hf) { const GAS float* wp = RW + (size_t)(wave * 128 + st * 32 + (lane >> 4) * 8) * NE + (lane & 15) + 16 * hf;
#pragma unroll
            for (int j = 0; j < 8; ++j) { const float w = wp[(size_t)j * NE]; const unsigned h = f2bf(w); const float r = w - __builtin_bit_cast(float, h << 16); wh[st][hf][j] = (short)h; wl[st][hf][j] = (short)f2bf(r); } }
    f32x4 g1v[4], b1v[4];
#pragma unroll
    for (int j = 0; j < 4; ++j) { g1v[j] = ((const GAS f32x4*)g1)[lane + 64 * j]; b1v[j] = ((const GAS f32x4*)b1)[lane + 64 * j]; }
    const float rb_e = RB[tid & 31];
    v2u yq[2][4];
#pragma unroll
    for (int i = 0; i < 2; ++i) { const GAS v2u* yr = (const GAS v2u*)(Y1 + (size_t)(F.vcu * 64 + wave * 2 + i) * D) + lane;
#pragma unroll
        for (int j = 0; j < 4; ++j) yq[i][j] = yr[64 * j]; }
    for (int g = 0; g < 4; ++g) {
        const int t0 = F.vcu * 64 + g * 16;
#pragma unroll
        for (int i = 0; i < 2; ++i) { const int tl = wave * 2 + i, t = t0 + tl;
            GAS u64* xr1 = (GAS u64*)(X1B + (size_t)t * D) + lane; f32x4 v[4]; float s = 0.f;
#pragma unroll
            for (int j = 0; j < 4; ++j) { const v2u q = yq[i][j]; v[j] = (f32x4){bflo(q.x), bfhi(q.x), bflo(q.y), bfhi(q.y)}; s += (v[j].x + v[j].y) + (v[j].z + v[j].w); }
            if (g < 3) { const GAS v2u* yr = (const GAS v2u*)(Y1 + (size_t)(t + 16) * D) + lane;
#pragma unroll
                for (int j = 0; j < 4; ++j) yq[i][j] = yr[64 * j]; }
            const float mean = wave_sum(s) * (1.f / D); float s2 = 0.f;
#pragma unroll
            for (int j = 0; j < 4; ++j) { v[j] = v[j] - mean; s2 += (v[j].x * v[j].x + v[j].y * v[j].y) + (v[j].z * v[j].z + v[j].w * v[j].w); }
            const float rstd = rsqrtf(wave_sum(s2) * (1.f / D) + LN_EPS);
            GAS unsigned* o8 = XB8 + (size_t)t * (D / 4) + lane;
#pragma unroll
            for (int j = 0; j < 4; ++j) { const f32x4 y = v[j] * rstd * g1v[j] + b1v[j];
                o8[64 * j] = pk4_fp8(y.x, y.y, y.z, y.w);
                const unsigned h0 = f2bf(y.x), h1 = f2bf(y.y), h2 = f2bf(y.z), h3 = f2bf(y.w);
                const u64 hp = (u64)(h0 | (h1 << 16)) | ((u64)(h2 | (h3 << 16)) << 32); xr1[64 * j] = hp;
                const float r0 = y.x - __builtin_bit_cast(float, h0 << 16), r1 = y.y - __builtin_bit_cast(float, h1 << 16), r2 = y.z - __builtin_bit_cast(float, h2 << 16), r3 = y.w - __builtin_bit_cast(float, h3 << 16);
                *(LAS u64*)(XH + tl * XROW + (lane + 64 * j) * 8) = hp;
                *(LAS u64*)(XL + tl * XROW + (lane + 64 * j) * 8) = (u64)pk2(r0, r1) | ((u64)pk2(r2, r3) << 32); } }
        __syncthreads();
        f32x4 acc[2]; acc[0] = (f32x4){0.f, 0.f, 0.f, 0.f}; acc[1] = acc[0];
#pragma unroll
        for (int st = 0; st < 4; ++st) { const int boff = (lane & 15) * XROW + (wave * 128 + st * 32 + (lane >> 4) * 8) * 2;
            const bf16x8 bh = *(const LAS bf16x8*)(XH + boff), bl = *(const LAS bf16x8*)(XL + boff);
#pragma unroll
            for (int hf = 0; hf < 2; ++hf) { acc[hf] = __builtin_amdgcn_mfma_f32_16x16x32_bf16(wh[st][hf], bh, acc[hf], 0, 0, 0); acc[hf] = __builtin_amdgcn_mfma_f32_16x16x32_bf16(wh[st][hf], bl, acc[hf], 0, 0, 0);
                acc[hf] = __builtin_amdgcn_mfma_f32_16x16x32_bf16(wl[st][hf], bh, acc[hf], 0, 0, 0); } }
#pragma unroll
        for (int hf = 0; hf < 2; ++hf)
#pragma unroll
            for (int r = 0; r < 4; ++r) part[((wave * 2 + hf) * 16 + 4 * (lane >> 4) + r) * 16 + (lane & 15)] = acc[hf][r];
        __syncthreads();
        { const int tl = tid >> 5, e = tid & 31, t = t0 + tl; float lg = rb_e;
#pragma unroll
            for (int w = 0; w < 8; ++w) lg += part[((w * 2 + (e >> 4)) * 16 + (e & 15)) * 16 + tl];
            lgs[tl * 32 + e] = lg;
            LDS_WAIT(); asm volatile("" ::: "memory");
            int rank = 0;
#pragma unroll
            for (int q = 0; q < 8; ++q) { const f32x4 o = *(const LAS f32x4*)(lgs + tl * 32 + 4 * q);
#pragma unroll
                for (int i = 0; i < 4; ++i) { const int eo = 4 * q + i; rank += (o[i] > lg || (o[i] == lg && eo < e)) ? 1 : 0; } }
            if (rank < 4) { top[tl * 4 + rank] = lg; __hip_atomic_fetch_add(cnt + ((g * 16 + tl) >> 3) * 32 + e, 1, __ATOMIC_RELAXED, __HIP_MEMORY_SCOPE_WORKGROUP); }
            LDS_WAIT(); asm volatile("" ::: "memory");
            const f32x4 sv = *(const LAS f32x4*)(top + tl * 4);
            const float e1 = expf(sv[1] - sv[0]), e2 = expf(sv[2] - sv[0]), e3 = expf(sv[3] - sv[0]); const float inv = 1.f / (1.f + e1 + e2 + e3);
            if (rank < 4) { const float gk = (rank == 0 ? 1.f : rank == 1 ? e1 : rank == 2 ? e2 : e3) * inv; TOPE[4 * t + rank] = e; GATE[4 * t + rank] = gk; } }
    }
    __syncthreads();
    if (tid < 256) CNTW[(F.vcu * NWAVES + (tid >> 5)) * NE + (tid & 31)] = cnt[tid];
    __syncthreads();
}

__device__ __forceinline__ void p_gather(Frame& F, int l) {
    const int gw = F.vcu * NWAVES + F.wave, NGW = F.G * NWAVES, lane = F.lane, tid = F.tid;
    const int TPW = T / NGW, NIT = TPW * 4;
    const GAS int* CNTW = (const GAS int*)(F.ws + WS_CNTW);
    LAS int* red = (LAS int*)F.lds;
    LAS int* baseE = red + 1024; LAS int* totE = baseE + 32;
    { const int e = tid & 31, part = tid >> 5, first = F.vcu * NWAVES; int sb = 0, st = 0;
        for (int g0 = part; g0 < NGW; g0 += 256) { int c[16];
#pragma unroll
            for (int k = 0; k < 16; ++k) c[k] = g0 + 16 * k < NGW ? CNTW[(g0 + 16 * k) * NE + e] : 0;
#pragma unroll
            for (int k = 0; k < 16; ++k) { st += c[k]; sb += g0 + 16 * k < first ? c[k] : 0; } }
        red[part * 32 + e] = sb; red[512 + part * 32 + e] = st; }
    __syncthreads();
    if (tid < 32) { int sb = 0, st = 0;
#pragma unroll
        for (int p = 0; p < 16; ++p) { sb += red[p * 32 + tid]; st += red[512 + p * 32 + tid]; }
        baseE[tid] = sb; totE[tid] = st;
        if (F.vcu == 0) __hip_atomic_store(F.ctl + CW_CNT + 64 * l + tid, (unsigned)st, RLX_AGENT); }
    __syncthreads();
    int mybase = 0, tot = 0;
    if (lane < NE) { mybase = baseE[lane]; tot = totE[lane]; int cw[NWAVES - 1];
#pragma unroll
        for (int w = 0; w < NWAVES - 1; ++w) cw[w] = CNTW[(F.vcu * NWAVES + w) * NE + lane];
#pragma unroll
        for (int w = 0; w < NWAVES - 1; ++w) mybase += w < F.wave ? cw[w] : 0; }
    const int mt = (tot + 255) >> 8; int incl = mt;
#pragma unroll
    for (int o = 1; o < 64; o <<= 1) { const int v = __shfl_up(incl, o); if (lane >= o) incl += v; }
    const int pstart = (incl - mt) * 256;
    const GAS int* TOPE = (const GAS int*)(F.ws + WS_ROUTE); GAS int* ROWOF = (GAS int*)(F.ws + WS_ROUTE) + 12 * T; GAS int* ROWTOK = (GAS int*)(F.ws + WS_XS);
    if (F.vcu < NE && F.wave == 0) {
        const int e = F.vcu; const int ps = __builtin_amdgcn_readlane(pstart, e), te = __builtin_amdgcn_readlane(tot, e), me = __builtin_amdgcn_readlane(mt, e);
        for (int i = te + lane; i < me * 256; i += 64) ROWTOK[ps + i] = 0; }
    const int it0 = gw * NIT; const int ei = lane < NIT ? TOPE[it0 + lane] : 0; int rk = 0;
    for (int j = 0; j < NIT; ++j) { const int ej = __shfl(ei, j); rk += (j < lane && ej == ei) ? 1 : 0; }
    const int row = __shfl(pstart, ei) + __shfl(mybase, ei) + rk;
    if (lane < NIT) { ROWOF[it0 + lane] = row; ROWTOK[row] = (it0 + lane) >> 2; }
    __syncthreads();
}

__device__ __forceinline__ void p_combine(Frame& F, const In6& A, int l, float* xout_) {
    constexpr int TPW = 8;
    const int gw = F.vcu * NWAVES + F.wave, NGW = F.G * NWAVES, lane = F.lane;
    const GAS int* ROWOF = (const GAS int*)(F.ws + WS_ROUTE) + 12 * T; const GAS float* GATE = (const GAS float*)(F.ws + WS_ROUTE) + 8 * T;
    const GAS bf16* X1B = (const GAS bf16*)(F.ws + WS_Y1 + 32 * MiB); const GAS unsigned char* YS = (const GAS unsigned char*)(F.ws + WS_YS); GAS bf16* XB = (GAS bf16*)(F.ws + WS_XB);
    GAS float* xout = (GAS float*)xout_;
    const GAS f32x4* g2 = (const GAS f32x4*)(A.p[0] + l * D) + lane; const GAS f32x4* b2 = (const GAS f32x4*)(A.p[1] + l * D) + lane;
    int rowv = 0; float gatev = 0.f;
    if (lane < 4 * TPW) { const int tk = gw + (lane >> 2) * NGW; rowv = ROWOF[4 * tk + (lane & 3)]; gatev = GATE[4 * tk + (lane & 3)]; }
    f32x4 gg[4], bb[4];
#pragma unroll
    for (int j = 0; j < 4; ++j) { gg[j] = g2[64 * j]; bb[j] = b2[64 * j]; }
    v2u xq[2][4]; unsigned yq[2][4][4];
#define CMB_ISSUE(k, bf) do { const int t_ = gw + (k) * NGW; const GAS v2u* xr_ = (const GAS v2u*)(X1B + (size_t)t_ * D) + lane; \
        _Pragma("unroll") for (int j = 0; j < 4; ++j) xq[bf][j] = xr_[64 * j]; \
        _Pragma("unroll") for (int c = 0; c < 4; ++c) { const int row_ = __builtin_amdgcn_readlane(rowv, 4 * (k) + c); const GAS unsigned* yr_ = (const GAS unsigned*)(YS + (size_t)row_ * D) + lane; \
            _Pragma("unroll") for (int j = 0; j < 4; ++j) yq[bf][c][j] = yr_[64 * j]; } } while (0)
    CMB_ISSUE(0, 0);
#pragma unroll
    for (int k = 0; k < TPW; ++k) {
        const int bf = k & 1, t = gw + k * NGW;
        if (k + 1 < TPW) { if (bf == 0) CMB_ISSUE(k + 1, 1); else CMB_ISSUE(k + 1, 0); }
        f32x4 v[4];
#pragma unroll
        for (int j = 0; j < 4; ++j) { const v2u q = xq[bf][j]; v[j] = (f32x4){bflo(q.x), bfhi(q.x), bflo(q.y), bfhi(q.y)} * DN_ALPHA; }
#pragma unroll
        for (int c = 0; c < 4; ++c) { const float gk = __builtin_bit_cast(float, __builtin_amdgcn_readlane(__builtin_bit_cast(int, gatev), 4 * k + c));
#pragma unroll
            for (int j = 0; j < 4; ++j) { const int w = (int)yq[bf][c][j]; v[j].x += gk * __builtin_amdgcn_cvt_f32_fp8(w, 0); v[j].y += gk * __builtin_amdgcn_cvt_f32_fp8(w, 1); v[j].z += gk * __builtin_amdgcn_cvt_f32_fp8(w, 2); v[j].w += gk * __builtin_amdgcn_cvt_f32_fp8(w, 3); } }
        float s = 0.f;
#pragma unroll
        for (int j = 0; j < 4; ++j) s += (v[j].x + v[j].y) + (v[j].z + v[j].w);
        const float mean = wave_sum(s) * (1.f / D); float s2 = 0.f;
#pragma unroll
        for (int j = 0; j < 4; ++j) { v[j] = v[j] - mean; s2 += (v[j].x * v[j].x + v[j].y * v[j].y) + (v[j].z * v[j].z + v[j].w * v[j].w); }
        const float rstd = rsqrtf(wave_sum(s2) * (1.f / D) + LN_EPS);
        GAS f32x4* orow = (GAS f32x4*)(xout + (size_t)t * D) + lane; GAS u64* o8 = (GAS u64*)(XB + (size_t)t * D) + lane;
#pragma unroll
        for (int j = 0; j < 4; ++j) { const f32x4 y = v[j] * rstd * gg[j] + bb[j];
            if (xout_) __builtin_nontemporal_store(y, orow + 64 * j); else o8[64 * j] = (u64)pk2(y.x, y.y) | ((u64)pk2(y.z, y.w) << 32); }
        __builtin_amdgcn_sched_barrier(0);
    }
#undef CMB_ISSUE
}


#define NI __device__ __forceinline__
NI void ph_prologue(unsigned char* ws, LAS unsigned char* lds, const float* a0, const float* a1, const float* a2, const float* a3, const float* a4) { Frame F = make_frame(ws, lds); In6 I{{uni(a0), uni(a1), uni(a2), uni(a3), uni(a4), nullptr}}; p_prologue(F, I); }
NI void ph_local(unsigned char* ws, LAS unsigned char* lds, int l, const float* a0, const float* a1, const float* a2, const float* a3, const float* a4) { Frame F = make_frame(ws, lds); In6 I{{uni(a0), uni(a1), uni(a2), uni(a3), uni(a4), nullptr}}; p_local(F, I, __builtin_amdgcn_readfirstlane(l)); }
NI void ph_scores(unsigned char* ws, LAS unsigned char* lds) { Frame F = make_frame(ws, lds); p_index(F); }
NI void ph_attn(unsigned char* ws, LAS unsigned char* lds) { Frame F = make_frame(ws, lds); p_attn_dense(F); }
NI void ph_router(unsigned char* ws, LAS unsigned char* lds, int l, const float* a0, const float* a1, const float* a2, const float* a3) { Frame F = make_frame(ws, lds); In6 I{{uni(a0), uni(a1), uni(a2), uni(a3), nullptr, nullptr}}; p_router(F, I, __builtin_amdgcn_readfirstlane(l)); }
NI void ph_gather(unsigned char* ws, LAS unsigned char* lds, int l) { Frame F = make_frame(ws, lds); p_gather(F, __builtin_amdgcn_readfirstlane(l)); }
NI void ph_combine(unsigned char* ws, LAS unsigned char* lds, int l, const float* a0, const float* a1, float* xout) { Frame F = make_frame(ws, lds); In6 I{{uni(a0), uni(a1), nullptr, nullptr, nullptr, nullptr}}; p_combine(F, I, __builtin_amdgcn_readfirstlane(l), (float*)uni(xout)); }

NI void ph_gemm_in(unsigned char* ws, LAS unsigned char* lds, int l_) {
    Frame F = make_frame(ws, lds); const int l = __builtin_amdgcn_readfirstlane(l_);
    pg8::Gemm g{WSP(bf16, WS_XB), WSP(bf16, WS_WIN) + (size_t)l * NINP * D, T, NINP, D}; pg8::StaticOrder S; S.init(T, NINP, F.G, (int)blockIdx.x);
    pg8::EpiBf16<0> E{WSP(bf16, WS_PROJ), NINP, nullptr, 0, 0, 1.f};
    pg8::gemm_phase<pg8::EpiBf16<0>, pg8::StaticOrder, PG8_ALIGN, PG8_SP2>(F.lds, g, S, E);
}
NI void ph_gemm_out(unsigned char* ws, LAS unsigned char* lds, int l_, const float* xin) {
    Frame F = make_frame(ws, lds); const int l = __builtin_amdgcn_readfirstlane(l_);
    pg8::Gemm g{WSP(bf16, WS_CAT), WSP(bf16, WS_WOUT) + (size_t)l * D * D, T, D, D}; pg8::StaticOrder S; S.init(T, D, F.G, (int)blockIdx.x);
    EpiResid E{WSP(bf16, WS_XB), WSP(bf16, WS_Y1), DN_ALPHA};
    pg8::gemm_phase<EpiResid, pg8::StaticOrder, PG8_ALIGN, PG8_SP2>(F.lds, g, S, E);
}
NI void ph_gemm_moe1(unsigned char* ws, LAS unsigned char* lds, int l_, const float* bgu) {
    Frame F = make_frame(ws, lds); const int l = __builtin_amdgcn_readfirstlane(l_);
    const int nun = moe_table(F, l, 8);
    pg8::Gemm g{WSP(bf16, WS_XB8), (const bf16*)(WSP(unsigned char, WS_WGU) + (size_t)l * NE * 2048 * D * 2), MAXROWS, NE * 2048, D};
    MoeSched S{(const LAS int*)(F.lds + TAB_OFF), nun};
    EpiSwiglu E{WSP(unsigned char, WS_ACT), uni(bgu) + (size_t)l * NE * 2048};
    pg8::gemm_phase<EpiSwiglu, MoeSched, PG8_ALIGN, true, 1, true>(F.lds, g, S, E, WSP(int, WS_XS));
}
NI void ph_gemm_moe2(unsigned char* ws, LAS unsigned char* lds, int l_, const float* bdn) {
    Frame F = make_frame(ws, lds); const int l = __builtin_amdgcn_readfirstlane(l_);
    const int nun = moe_table(F, l, 4);
    pg8::Gemm g{WSP(bf16, WS_ACT), (const bf16*)(WSP(unsigned char, WS_WDN) + (size_t)l * NE * D * D * 2), MAXROWS, NE * D, D};
    MoeSched S{(const LAS int*)(F.lds + TAB_OFF), nun};
    EpiDown E{WSP(unsigned char, WS_YS), uni(bdn) + (size_t)l * NE * D};
    pg8::gemm_phase<EpiDown, MoeSched, PG8_ALIGN, MOE_SP2, 1>(F.lds, g, S, E);
}

__device__ __forceinline__ const float* karg_in(int i) { return ((const float* const volatile*)__builtin_amdgcn_kernarg_segment_ptr())[i]; }
__device__ __forceinline__ float* karg_out() { return ((float* const volatile*)__builtin_amdgcn_kernarg_segment_ptr())[N_IN]; }
#ifndef PHMASK
#define PHMASK 0x7FF
#endif
constexpr int PH_PER_LAYER = 10, N_PHASES = 1 + DEPTH * PH_PER_LAYER;
#define IN(k) (lo <= (k) && (k) < hi)
#define SEAM(k) do { if (IN(k) && IN((k) + 1)) xcd_barrier(bar); } while (0)
template <int l> __device__ __forceinline__ void layer_phases(Frame& F, const XcdBarrier& bar, int lo, int hi) {
        const int p0 = 1 + l * PH_PER_LAYER;
        const float* xin = nullptr;
        float* xout = l == DEPTH - 1 ? karg_out() : nullptr;
        if (((PHMASK >> 0) & 1) && IN(p0 + 0)) { asm volatile("; PHASE_BEGIN_0"); ph_gemm_in(F.ws, F.lds, l); SEAM(p0 + 0); }
        if (((PHMASK >> 1) & 1) && IN(p0 + 1)) { asm volatile("; PHASE_BEGIN_1"); ph_local(F.ws, F.lds, l, karg_in(IN_WPOOL), karg_in(IN_CONVW), karg_in(IN_PSCALE), karg_in(IN_KNG), karg_in(IN_KNB)); SEAM(p0 + 1); }
        if (((PHMASK >> 2) & 1) && IN(p0 + 2)) { asm volatile("; PHASE_BEGIN_2"); ph_scores(F.ws, F.lds); SEAM(p0 + 2); }
        if (((PHMASK >> 3) & 1) && IN(p0 + 3)) { asm volatile("; PHASE_BEGIN_3"); ph_attn(F.ws, F.lds); SEAM(p0 + 3); }
        if (((PHMASK >> 4) & 1) && IN(p0 + 4)) { asm volatile("; PHASE_BEGIN_4"); ph_gemm_out(F.ws, F.lds, l, xin); SEAM(p0 + 4); }
        if (((PHMASK >> 5) & 1) && IN(p0 + 5)) { asm volatile("; PHASE_BEGIN_5"); ph_router(F.ws, F.lds, l, karg_in(IN_LN1G), karg_in(IN_LN1B), karg_in(IN_RW), karg_in(IN_RB)); SEAM(p0 + 5); }
        if (((PHMASK >> 6) & 1) && IN(p0 + 6)) { asm volatile("; PHASE_BEGIN_6"); ph_gather(F.ws, F.lds, l); SEAM(p0 + 6); }
        if (((PHMASK >> 7) & 1) && IN(p0 + 7)) { asm volatile("; PHASE_BEGIN_7"); ph_gemm_moe1(F.ws, F.lds, l, karg_in(IN_BGU)); SEAM(p0 + 7); }
        if (((PHMASK >> 8) & 1) && IN(p0 + 8)) { asm volatile("; PHASE_BEGIN_8"); ph_gemm_moe2(F.ws, F.lds, l, karg_in(IN_BDN)); SEAM(p0 + 8); }
        if (((PHMASK >> 9) & 1) && IN(p0 + 9)) { asm volatile("; PHASE_BEGIN_9"); ph_combine(F.ws, F.lds, l, karg_in(IN_LN2G), karg_in(IN_LN2B), xout); SEAM(p0 + 9); }
}
#undef IN
#undef SEAM
__global__ void __launch_bounds__(NWAVES * 64, 2) fwd_kernel(Args A) {
    extern __shared__ __attribute__((aligned(16))) unsigned char lds[];
    Frame F;
    F.lds = (LAS unsigned char*)lds;
    F.tid = threadIdx.x; F.lane = F.tid & 63; F.wave = __builtin_amdgcn_readfirstlane(F.tid >> 6);
    F.G = gridDim.x; { const int bx = blockIdx.x; F.vcu = (F.G % 8 == 0) ? (bx % 8) * (F.G / 8) + bx / 8 : bx; }
    F.ws = A.ws; F.ctl = (gu32*)(A.ws + WS_CTL);
    volatile LAS unsigned* MISC = (volatile LAS unsigned*)(F.lds + MISC_OFF);
    if (F.tid < 32) MISC[F.tid] = 0u;
    __syncthreads();
    const int lo = A.ph_lo, hi = A.ph_hi;
    const bool multi = (hi - lo) > 1;
    XcdBarrier bar; bar.bar = (unsigned*)(F.ctl + CW_BAR); bar.x = 0; bar.st = nullptr;
    if (multi) bar = xcd_barrier_post((unsigned*)(F.ctl + CW_BAR), MISC + 8);
#define IN(k) (lo <= (k) && (k) < hi)
#define SEAM(k) do { if (IN(k) && IN((k) + 1)) xcd_barrier(bar); } while (0)

    if (((PHMASK >> 10) & 1) && IN(0)) { asm volatile("; PHASE_BEGIN_11"); ph_prologue(F.ws, F.lds, karg_in(IN_WIN), karg_in(IN_WOUT), karg_in(IN_WGU), karg_in(IN_WDN), karg_in(IN_X)); SEAM(0); }
    layer_phases<0>(F, bar, lo, hi);
    layer_phases<1>(F, bar, lo, hi);
#undef IN
#undef SEAM
}


#ifdef DUMP_OFF
__global__ void dump_kernel(const unsigned* w, size_t nwords, float* out, int n) {
    const int i = blockIdx.x * blockDim.x + threadIdx.x; if (i >= n) return;
#ifdef DUMP_NAN_ALL
    { bool bad = false; for (size_t j = (size_t)i; j < nwords; j += (size_t)n) { const unsigned x = w[j]; bad |= ((x & 0x7f80u) == 0x7f80u) || ((x & 0x7f800000u) == 0x7f800000u); } out[i] = bad ? 1e6f : 0.f; return; }
#endif
#ifdef DUMP_MASKCHECK
    { out[i] = 0.f; if ((i & 1023) == 0) { const int t = i >> 10, sq = t & 4095; const unsigned long long* mt = (const unsigned long long*)w + ((size_t)(t >> 12) * 64) * 4096 + sq; int pc = 0; bool beyond = false;
        for (int j = 0; j < 64; ++j) { const unsigned long long m = mt[(size_t)j * 4096]; pc += __popcll(m); for (int bb = 0; bb < 64; ++bb) if (((m >> bb) & 1ull) && 64 * j + bb > sq) beyond = true; }
        const int expect = sq + 1 < 256 ? sq + 1 : 256;
#if DUMP_MASKCHECK == 1
        if (pc != expect) out[i] = 1e6f;
#else
        if (beyond) out[i] = 1e6f;
#endif
      } return; }
#endif
#ifdef DUMP_NANCHECK
#if DUMP_NANCHECK == 2
    { size_t wi = (size_t)i;
#ifdef DUMP_ROWW
      wi = ((size_t)i / DUMP_COLW) * DUMP_ROWW + ((size_t)i % DUMP_COLW);
#endif
      if (wi >= nwords) { out[i] = 0.f; return; } const unsigned x = w[wi]; const bool bad = ((x & 0x7f80u) == 0x7f80u) || ((x & 0x7f800000u) == 0x7f800000u);
#ifdef DUMP_LOC
      { const int sq = (int)(wi / 512) & 4095; out[i] = bad ? 1000.f * (float)(DUMP_LOC == 1 ? sq + 1 : 4096 - sq) : 0.f; return; }
#endif
      out[i] = bad ? 1e6f : 0.f; return; }
#else
    { const float v = ((const float*)w)[i]; out[i] = (v == v && fabsf(v) < 1e30f) ? 0.f : 1e6f; return; }
#endif
#endif
#ifdef DUMP_VIA_ROWOF
    unsigned h; { const unsigned short* src = (const unsigned short*)w; const int* rowof = (const int*)((const char*)w - (size_t)(DUMP_OFF) + WS_ROUTE) + 12 * T; const int t = i >> 10, c = i & 1023;
        h = 0u; for (int k = 0; k < 4; ++k) h = h * 0x9E3779B1u + src[(size_t)rowof[4 * t + k] * 1024 + c]; }
#elif defined(DUMP_ROWW)
    unsigned h = 0u; { const size_t row = (size_t)i / DUMP_COLW, cw = (size_t)i % DUMP_COLW; if (row * DUMP_ROWW + cw < nwords) h = w[row * DUMP_ROWW + cw]; }
#else
    unsigned h = 0u; int k = 1; for (size_t j = (size_t)i; j < nwords; j += (size_t)n, k += 2) h ^= w[j] * (unsigned)k;
#endif
    out[i] = (float)((h ^ (h >> 11) ^ (h >> 22)) & 0xFFFFFu);
}
#endif
#ifndef MK_ONE_LAUNCH
#define MK_ONE_LAUNCH 0
#endif
extern "C" void kernel_launch(void* const* d_in, const int* in_sizes, int n_in, void* d_out, int out_size, void* d_ws, size_t ws_size, hipStream_t stream) {
    static int grid = 0;
    if (grid == 0) {
        if (n_in != N_IN || in_sizes[0] != T * D || out_size != T * D || ws_size < WS_END) { fprintf(stderr, "kernel_launch: unexpected shapes (n_in %d, in0 %d, out %d, ws %zu, need %zu); nothing launched\n", n_in, n_in > 0 ? in_sizes[0] : -1, out_size, ws_size, (size_t)WS_END); grid = -1; return; }
        int dev = 0, cus = 0, per_cu = 0;
        if (hipGetDevice(&dev) != hipSuccess || hipDeviceGetAttribute(&cus, hipDeviceAttributeMultiprocessorCount, dev) != hipSuccess) { grid = -1; return; }
        if (hipFuncSetAttribute((const void*)fwd_kernel, hipFuncAttributeMaxDynamicSharedMemorySize, LDS_BYTES) != hipSuccess) { fprintf(stderr, "kernel_launch: hipFuncSetAttribute failed\n"); grid = -1; return; }
        if (hipOccupancyMaxActiveBlocksPerMultiprocessor(&per_cu, (const void*)fwd_kernel, NWAVES * 64, LDS_BYTES) != hipSuccess || per_cu < 1) fprintf(stderr, "kernel_launch: occupancy query reports %d\n", per_cu);
        (void)hipGetLastError();
        grid = cus;
        if (grid != 256) { fprintf(stderr, "kernel_launch: built for 256 CUs, found %d; nothing launched\n", cus); grid = -1; return; }
    }
    if (grid < 0) return;
    if (hipMemsetAsync((char*)d_ws + WS_CTL, 0, CTL_ZERO_BYTES, stream) != hipSuccess) return;
    Args a{};
    for (int i = 0; i < N_IN; ++i) a.in[i] = (const float*)d_in[i];
    a.out = (float*)d_out; a.ws = (unsigned char*)d_ws;
#if MK_ONE_LAUNCH
    a.ph_lo = 0; a.ph_hi = N_PHASES;
    hipLaunchKernelGGL(fwd_kernel, dim3(grid), dim3(NWAVES * 64), LDS_BYTES, stream, a);
#else
#ifdef DUMP_OFF
    for (int p = 0; p < DUMP_STOP; ++p) { a.ph_lo = p; a.ph_hi = p + 1; hipLaunchKernelGGL(fwd_kernel, dim3(grid), dim3(NWAVES * 64), LDS_BYTES, stream, a); }
    hipLaunchKernelGGL(dump_kernel, dim3((T * D + 255) / 256), dim3(256), 0, stream, (const unsigned*)((const char*)d_ws + (size_t)(DUMP_OFF)), (size_t)(DUMP_WORDS), (float*)d_out, T * D);
    return;
#endif
    for (int p = 0; p < N_PHASES; ++p) { a.ph_lo = p; a.ph_hi = p + 1; hipLaunchKernelGGL(fwd_kernel, dim3(grid), dim3(NWAVES * 64), LDS_BYTES, stream, a);
#ifdef DBL_PHASE
        if ((p == 0 && DBL_PHASE == 10) || (p > 0 && (p - 1) % PH_PER_LAYER == DBL_PHASE)) hipLaunchKernelGGL(fwd_kernel, dim3(grid), dim3(NWAVES * 64), LDS_BYTES, stream, a);
#endif
    }
#endif
}
```

```cpp
#include <hip/hip_runtime.h>
#include <cstdio>
#include <cstdint>

#define MK_ONE_LAUNCH 1
#define BAR_EARLY_INV 1
#ifndef WT_STORES
#define WT_STORES 0
#endif
__device__ __forceinline__ void st16_wt(void* p, unsigned x, unsigned y, unsigned z, unsigned w) {
    typedef unsigned u4_ __attribute__((ext_vector_type(4))); const u4_ v = {x, y, z, w};
#if WT_STORES
    asm volatile("global_store_dwordx4 %0, %1, off sc1\n\ts_nop 2" :: "v"((__attribute__((address_space(1))) void*)p), "v"(v) : "memory");
#else
    *(__attribute__((address_space(1))) u4_*)p = v;
#endif
}
__device__ __forceinline__ void st8_wt(void* p, unsigned x, unsigned y) {
    typedef unsigned u2_ __attribute__((ext_vector_type(2))); const u2_ v = {x, y};
#if WT_STORES
    asm volatile("global_store_dwordx2 %0, %1, off sc1" :: "v"((__attribute__((address_space(1))) void*)p), "v"(v) : "memory");
#else
    *(__attribute__((address_space(1))) u2_*)p = v;
#endif
}
namespace pg8 {
#define PG8_LAS __attribute__((address_space(3)))
typedef unsigned short bf16_t;
typedef short bf16x8 __attribute__((ext_vector_type(8)));
typedef float f32x4 __attribute__((ext_vector_type(4)));
typedef unsigned u32x4 __attribute__((ext_vector_type(4)));
typedef int v4i_t __attribute__((ext_vector_type(4)));
typedef int v8i_t __attribute__((ext_vector_type(8)));
constexpr int BM = 256, BK = 64, HALF = 128, HTB = HALF * BK * 2  , STAGE_BYTES = 8 * HTB, NXCD = 8, WGM = 8;

__host__ __device__ __forceinline__ int lds_byte(int r, int c) { const int st = (r >> 4) * 2 + (c >> 5), rr = r & 15, cc = c & 31, ob = rr * 64 + cc * 2; return st * 1024 + (ob ^ (((ob >> 9) & 1) << 5)); }
__host__ __device__ __forceinline__ void stage_rc(int b, int& R, int& C) { const int st = b / 1024, sb = b % 1024, swz = sb ^ (((sb >> 9) & 1) << 5); R = (st >> 1) * 16 + swz / 64; C = (st & 1) * 32 + (swz % 64) / 2; }
__host__ __device__ __forceinline__ int perm32(int rho) { const int n = rho >> 4, i = rho & 15; return 8 * (i >> 2) + 4 * n + (i & 3); }

struct Unit { int pm, pn; };
struct Gemm { const bf16_t* A; const bf16_t* Bt; int M, N, K; };

struct StaticOrder {
    int nM, nN, nwg, G, c;
    __host__ __device__ void init(int M, int N, int G_, int c_) { nM = M / BM; nN = N / BM; nwg = nM * nN; G = G_; c = c_; }
    __host__ __device__ bool next(int i, Unit& u) const {
        const long L = (long)i * G + c; if (L >= nwg) return false;
        int wgid = (int)L; { const int q = nwg / NXCD, r = nwg % NXCD, xcd = wgid % NXCD, off = wgid / NXCD; wgid = (xcd < r ? xcd * (q + 1) : r * (q + 1) + (xcd - r) * q) + off; }
        const int nig = WGM * nN, gid = wgid / nig, fm = gid * WGM, gsz = (nM - fm) < WGM ? (nM - fm) : WGM;
        u.pm = fm + ((wgid % nig) % gsz); u.pn = (wgid % nig) / gsz; return true;
    }
    __device__ __forceinline__ void a_ready(const Unit&) const {}
    __device__ __forceinline__ void done(const Unit&) const {}
};

__device__ __forceinline__ unsigned cvt_pk_bf16(float lo, float hi) { unsigned r; asm volatile("v_cvt_pk_bf16_f32 %0, %1, %2" : "=v"(r) : "v"(lo), "v"(hi)); return r; }
typedef float f32x2 __attribute__((ext_vector_type(2)));
__device__ __forceinline__ f32x2 gelu_pk(f32x2 v) {
    const f32x2 av = __builtin_elementwise_abs(v), d = av * 0.2316418882f + 1.0f;
    f32x2 t; t.x = __builtin_amdgcn_rcpf(d.x); t.y = __builtin_amdgcn_rcpf(d.y);
    f32x2 q = t * 0.5307027145f + (-0.7265760135f); q = q * t + 0.7107068705f; q = q * t + (-0.142248368f); q = q * t + 0.127414796f; q = q * t;
    const f32x2 s = (v * v) * (-0.72134752044f);
    f32x2 e; e.x = __builtin_amdgcn_exp2f(s.x); e.y = __builtin_amdgcn_exp2f(s.y);
    const f32x2 m = v * (q * e), r = v - m;
    f32x2 o; o.x = v.x < 0.f ? m.x : r.x; o.y = v.y < 0.f ? m.y : r.y; return o;
}

template <int ACT  > struct EpiBf16 {
    static constexpr bool PERM = true, AFTER_DRAIN = false; static_assert(ACT == 0 || ACT == 1, "EpiBf16: ACT is 0 (none) or 1 (gelu_pk)");
    bf16_t* O; int ldc; const float* bias; int split_cols; size_t split_stride; float scale0;
    __device__ __forceinline__ void operator()(const f32x4 (&acc)[2][2][4][2], const Unit& u, int wr, int wc, int fr, int fq) const {
        const int row0 = u.pm * BM + wr * 64 + fr; int colt = u.pn * BM; bf16_t* base = O;
        float sc = 1.f; if (split_cols) { const int t = colt / split_cols; base += (size_t)t * split_stride; colt -= t * split_cols; if (t == 0) sc = scale0; }
        const int col0 = colt + wc * 32 + 8 * fq, bcol0 = u.pn * BM + wc * 32 + 8 * fq;
        f32x4 bv[2][2];
#pragma unroll
        for (int bj = 0; bj < 2; ++bj)
#pragma unroll
            for (int n = 0; n < 2; ++n) bv[bj][n] = bias ? *(const __attribute__((address_space(1))) f32x4*)(bias + bcol0 + bj * HALF + 4 * n) : (f32x4){0.f, 0.f, 0.f, 0.f};
#pragma unroll
        for (int ai = 0; ai < 2; ++ai)
#pragma unroll
            for (int m = 0; m < 4; ++m) { bf16_t* rowp = base + (size_t)(row0 + ai * HALF + m * 16) * ldc + col0;
#pragma unroll
                for (int bj = 0; bj < 2; ++bj) { f32x4 v0 = acc[ai][bj][m][0] + bv[bj][0], v1 = acc[ai][bj][m][1] + bv[bj][1];
                    if (ACT == 1) { f32x2 a = gelu_pk((f32x2){v0[0], v0[1]}), b = gelu_pk((f32x2){v0[2], v0[3]}), c = gelu_pk((f32x2){v1[0], v1[1]}), d = gelu_pk((f32x2){v1[2], v1[3]});
                        v0 = (f32x4){a.x, a.y, b.x, b.y}; v1 = (f32x4){c.x, c.y, d.x, d.y}; }
                    v0 = v0 * sc; v1 = v1 * sc; u32x4 w; w.x = cvt_pk_bf16(v0[0], v0[1]); w.y = cvt_pk_bf16(v0[2], v0[3]); w.z = cvt_pk_bf16(v1[0], v1[1]); w.w = cvt_pk_bf16(v1[2], v1[3]);
                    st16_wt(rowp + bj * HALF, w.x, w.y, w.z, w.w); } }
    }
};

struct PanelStats {
    unsigned* xbuf;
    unsigned* cnt;
    unsigned* tmo;
    int ntn; float eps;
    unsigned code;
    __device__ __forceinline__ bool run(const f32x4 (&v)[2][2][4][2], const Unit& u, int wr, int wc, int fr, int fq, PG8_LAS unsigned char* lds, int wid, int lane) const {
        typedef float f32x2v __attribute__((ext_vector_type(2)));
        PG8_LAS f32x2v* P = (PG8_LAS f32x2v*)lds;
        PG8_LAS f32x2v* S = (PG8_LAS f32x2v*)(lds + 8192);
        PG8_LAS unsigned* flag = (PG8_LAS unsigned*)(lds + 8192 + 2048);
#pragma unroll
        for (int ai = 0; ai < 2; ++ai)
#pragma unroll
            for (int m = 0; m < 4; ++m) {
                float s = 0.f;
#pragma unroll
                for (int bj = 0; bj < 2; ++bj)
#pragma unroll
                    for (int n = 0; n < 2; ++n) { const f32x4 x = v[ai][bj][m][n]; s += (x[0] + x[1]) + (x[2] + x[3]); }
                s += __shfl_xor(s, 16); s += __shfl_xor(s, 32);
                const float mw = s * (1.0f / 64.0f); float q = 0.f;
#pragma unroll
                for (int bj = 0; bj < 2; ++bj)
#pragma unroll
                    for (int n = 0; n < 2; ++n) { const f32x4 d = v[ai][bj][m][n] - mw; q += (d[0] * d[0] + d[1] * d[1]) + (d[2] * d[2] + d[3] * d[3]); }
                q += __shfl_xor(q, 16); q += __shfl_xor(q, 32);
                if (fq == 0) P[(ai * HALF + wr * 64 + m * 16 + fr) * 4 + wc] = (f32x2v){mw, q};
            }
        asm volatile("s_waitcnt lgkmcnt(0)" ::: "memory"); __builtin_amdgcn_s_barrier(); asm volatile("" ::: "memory");
#if defined(BROKEN_EXCHANGE_NO_WAIT)
#warning BROKEN CONTROL BUILD: the row-statistics exchange does not wait; results are wrong by design
        if (blockIdx.x >= 64) { const long long t0_ = clock64(); while (clock64() - t0_ < 60000) __builtin_amdgcn_s_sleep(8); }
#endif
        const int row = wid * 32 + (lane & 31);
        if (lane < 32) {
            const f32x2v a = P[row * 4 + 0], b = P[row * 4 + 1], c = P[row * 4 + 2], d = P[row * 4 + 3];
            const float mt = (a.x + b.x + c.x + d.x) * 0.25f;
            const float da = a.x - mt, db = b.x - mt, dc = c.x - mt, dd = d.x - mt;
            const float m2 = (a.y + b.y) + (c.y + d.y) + 64.0f * ((da * da + db * db) + (dc * dc + dd * dd));
            unsigned long long* slot = (unsigned long long*)xbuf + ((size_t)(u.pm * BM + row) * 4 + u.pn);
            __hip_atomic_store(slot, ((unsigned long long)__float_as_uint(m2) << 32) | __float_as_uint(mt), __ATOMIC_RELAXED, __HIP_MEMORY_SCOPE_AGENT);
        }
        asm volatile("s_waitcnt vmcnt(0)" ::: "memory");
        if (lane == 0) __hip_atomic_fetch_add(cnt + 64 * u.pm, 1u, __ATOMIC_RELAXED, __HIP_MEMORY_SCOPE_AGENT);
        if (wid == 0) {
            bool dead = false; const unsigned long long t0 = __builtin_amdgcn_s_memrealtime(); const unsigned want = 8u * (unsigned)ntn;
            for (;;) {
#if defined(BROKEN_EXCHANGE_NO_WAIT)
                break;
#endif
                if ((unsigned)__builtin_amdgcn_readfirstlane(__hip_atomic_load(cnt + 64 * u.pm, __ATOMIC_RELAXED, __HIP_MEMORY_SCOPE_AGENT)) >= want) break;
                if (__builtin_amdgcn_s_memrealtime() - t0 > 2000000ull) {
                    if (lane == 0) { unsigned expect = 0u; __hip_atomic_compare_exchange_strong(tmo + 1, &expect, code | (unsigned)(u.pm & 0xff), __ATOMIC_RELAXED, __ATOMIC_RELAXED, __HIP_MEMORY_SCOPE_AGENT);
                                     __hip_atomic_store(tmo, 1u, __ATOMIC_RELAXED, __HIP_MEMORY_SCOPE_AGENT); }
                    dead = true; break; }
                __builtin_amdgcn_s_sleep(2);
            }
            __builtin_amdgcn_fence(__ATOMIC_ACQUIRE, "agent");
            if (lane == 0) flag[0] = dead ? 1u : 0u;
        }
        asm volatile("s_waitcnt vmcnt(0) lgkmcnt(0)" ::: "memory"); __builtin_amdgcn_s_barrier(); asm volatile("" ::: "memory");
        const bool bad = flag[0] != 0u;
        if (lane < 32) {
            const unsigned long long* slot = (const unsigned long long*)xbuf + (size_t)(u.pm * BM + row) * 4; float mt[4], m2[4]; float ms = 0.f;
#pragma unroll
            for (int t = 0; t < 4; ++t) { if (t < ntn) { const unsigned long long w = __hip_atomic_load(slot + t, __ATOMIC_RELAXED, __HIP_MEMORY_SCOPE_AGENT); mt[t] = __uint_as_float((unsigned)w); m2[t] = __uint_as_float((unsigned)(w >> 32)); } else { mt[t] = 0.f; m2[t] = 0.f; } ms += mt[t]; }
            const float mean = ms / (float)ntn; float q = 0.f;
#pragma unroll
            for (int t = 0; t < 4; ++t) if (t < ntn) { const float dm = mt[t] - mean; q += m2[t] + 256.0f * dm * dm; }
            S[row] = (f32x2v){mean, 1.0f / sqrtf(q / (256.0f * (float)ntn) + eps)};
        }
        asm volatile("s_waitcnt lgkmcnt(0)" ::: "memory"); __builtin_amdgcn_s_barrier(); asm volatile("" ::: "memory");
        return bad;
    }
};
struct EpiLnRes {
    static constexpr bool PERM = false, AFTER_DRAIN = true;
    const float* base; float* out; int ldc; const float* bias; PanelStats st; unsigned poison;
    __device__ __forceinline__ void fused(f32x4 (&acc)[2][2][4][2], const Unit& u, int wr, int wc, int fr, int fq, PG8_LAS unsigned char* lds, int wid, int lane) const {
        typedef float f32x2v __attribute__((ext_vector_type(2)));
        const PG8_LAS f32x2v* S = (const PG8_LAS f32x2v*)(lds + 8192);
        const int col0 = u.pn * BM + wc * 32 + 4 * fq;
#pragma unroll
        for (int bj = 0; bj < 2; ++bj)
#pragma unroll
            for (int n = 0; n < 2; ++n) { const f32x4 bv = bias ? *(const f32x4*)(bias + col0 + bj * HALF + n * 16) : (f32x4){0.f, 0.f, 0.f, 0.f};
#pragma unroll
                for (int ai = 0; ai < 2; ++ai)
#pragma unroll
                    for (int m = 0; m < 4; ++m) acc[ai][bj][m][n] += bv; }
        f32x4 pre[4][2][2];
#pragma unroll
        for (int m = 0; m < 4; ++m) { const size_t off = (size_t)(u.pm * BM + wr * 64 + m * 16 + fr) * ldc + col0;
#pragma unroll
            for (int bj = 0; bj < 2; ++bj)
#pragma unroll
                for (int n = 0; n < 2; ++n) pre[m][bj][n] = *(const f32x4*)(base + off + bj * HALF + n * 16); }
        const bool bad = st.run(acc, u, wr, wc, fr, fq, lds, wid, lane) || poison != 0u;
        const float qnan = __builtin_nanf("");
#pragma unroll
        for (int ai = 0; ai < 2; ++ai)
#pragma unroll
            for (int m = 0; m < 4; ++m) { const int r = ai * HALF + wr * 64 + m * 16 + fr; const f32x2v sr = S[r]; const size_t off = (size_t)(u.pm * BM + r) * ldc + col0;
#pragma unroll
                for (int bj = 0; bj < 2; ++bj)
#pragma unroll
                    for (int n = 0; n < 2; ++n) { const f32x4 bs = ai == 0 ? pre[m][bj][n] : *(const f32x4*)(base + off + bj * HALF + n * 16); f32x4 o = bs + (acc[ai][bj][m][n] - sr.x) * sr.y;
                        if (bad) o = (f32x4){qnan, qnan, qnan, qnan}; *(f32x4*)(out + off + bj * HALF + n * 16) = o; }
                if (m & 1) asm volatile("" ::: "memory"); }
    }
};
struct EpiLnResLn {
    static constexpr bool PERM = false, AFTER_DRAIN = true;
    const float* base; float* out; bf16_t* xn; int ldc; const float* bias; PanelStats st1, st2; unsigned poison;
    __device__ __forceinline__ void fused(f32x4 (&acc)[2][2][4][2], const Unit& u, int wr, int wc, int fr, int fq, PG8_LAS unsigned char* lds, int wid, int lane) const {
        typedef float f32x2v __attribute__((ext_vector_type(2))); typedef unsigned u32x2v __attribute__((ext_vector_type(2)));
        const PG8_LAS f32x2v* S = (const PG8_LAS f32x2v*)(lds + 8192);
        const int col0 = u.pn * BM + wc * 32 + 4 * fq;
#pragma unroll
        for (int bj = 0; bj < 2; ++bj)
#pragma unroll
            for (int n = 0; n < 2; ++n) { const f32x4 bv = bias ? *(const f32x4*)(bias + col0 + bj * HALF + n * 16) : (f32x4){0.f, 0.f, 0.f, 0.f};
#pragma unroll
                for (int ai = 0; ai < 2; ++ai)
#pragma unroll
                    for (int m = 0; m < 4; ++m) acc[ai][bj][m][n] += bv; }
        bool bad = st1.run(acc, u, wr, wc, fr, fq, lds, wid, lane) || poison != 0u;
        const float qnan = __builtin_nanf("");
#pragma unroll
        for (int ai = 0; ai < 2; ++ai)
#pragma unroll
            for (int m = 0; m < 4; ++m) { const int r = ai * HALF + wr * 64 + m * 16 + fr; const f32x2v sr = S[r]; const size_t off = (size_t)(u.pm * BM + r) * ldc + col0;
#pragma unroll
                for (int bj = 0; bj < 2; ++bj)
#pragma unroll
                    for (int n = 0; n < 2; ++n) { const f32x4 bs = *(const f32x4*)(base + off + bj * HALF + n * 16); acc[ai][bj][m][n] = bs + (acc[ai][bj][m][n] - sr.x) * sr.y; }
                asm volatile("" : "+v"(acc[ai][0][m][0]), "+v"(acc[ai][0][m][1]), "+v"(acc[ai][1][m][0]), "+v"(acc[ai][1][m][1]));
                if (m & 1) asm volatile("" ::: "memory"); }
        const bool bad1 = bad;
        bad = st2.run(acc, u, wr, wc, fr, fq, lds, wid, lane) || bad;
#pragma unroll
        for (int ai = 0; ai < 2; ++ai)
#pragma unroll
            for (int m = 0; m < 4; ++m) { const int r = ai * HALF + wr * 64 + m * 16 + fr; const f32x2v sr = S[r]; const size_t off = (size_t)(u.pm * BM + r) * ldc + col0;
#pragma unroll
                for (int bj = 0; bj < 2; ++bj)
#pragma unroll
                    for (int n = 0; n < 2; ++n) { const f32x4 x1 = acc[ai][bj][m][n]; *(f32x4*)(out + off + bj * HALF + n * 16) = bad1 ? (f32x4){qnan, qnan, qnan, qnan} : x1;
                        const f32x4 o = (x1 - sr.x) * sr.y; u32x2v w; w.x = cvt_pk_bf16(o[0], o[1]); w.y = cvt_pk_bf16(o[2], o[3]);
                        if (bad) { w.x = 0x7fc07fc0u; w.y = 0x7fc07fc0u; } *(u32x2v*)(xn + off + bj * HALF + n * 16) = w; }
                asm volatile("" ::: "memory"); }
    }
};

__device__ __forceinline__ void glds_saddr(unsigned voff, const char* sbase, unsigned lds_dst) { unsigned keep;
    asm volatile("s_mov_b32 %0, m0\n\ts_mov_b32 m0, %3\n\ts_nop 0\n\tglobal_load_lds_dwordx4 %1, %2\n\ts_mov_b32 m0, %0" : "=&s"(keep) : "v"(voff), "s"(sbase), "s"(lds_dst) : "memory"); }
template <class Epi, class Sched, bool ALIGN_EPI = false, bool SP2 = false, int EB = 2, bool GATHER = false>
__device__ __forceinline__ void gemm_phase(PG8_LAS unsigned char* lds, const Gemm g, const Sched& S, const Epi& E, const int* rowtok = nullptr) {
    static_assert(!GATHER || (EB == 1 && SP2), "gathered A rows: fp8 path (SGPR-base staging) with the two-super-phase loop only");
    const int tid = threadIdx.x, wid = __builtin_amdgcn_readfirstlane(tid >> 6), lane = tid & 63, wr = wid >> 2, wc = wid & 3, fr = lane & 15, fq = lane >> 4;
    const int K = g.K, nt = K * EB / (BK * 2);
    unsigned voffA[2], voffB[2]; int gR[2]; unsigned gC[2];
#pragma unroll
    for (int i = 0; i < 2; ++i) { int R, C; stage_rc(tid * 16 + i * 8192, R, C); const int Rb = Epi::PERM ? ((R & ~31) + perm32(R & 31)) : R;
        voffA[i] = (unsigned)(R * K * EB + C * 2); voffB[i] = (unsigned)(Rb * K * EB + C * 2); gR[i] = R; gC[i] = (unsigned)(C * 2); }
    const size_t kstep = (size_t)(BK * 2);
    const size_t hstep = (size_t)HALF * K * EB;
    const size_t tstep = 2 * hstep;
    const unsigned ldsw = (unsigned)wid * 1024u; const unsigned lds0 = (unsigned)(uintptr_t)lds;
    const int aoff = lds_byte(wr * 64 + fr, fq * 8), boff = lds_byte(wc * 32 + fr, fq * 8);
#define PG8_SA(b, h) (((b) * 2 + (h)) * HTB)
#define PG8_SB(b, h) ((4 + (b) * 2 + (h)) * HTB)
#define PG8_STAGE(bufoff, gbase, voff) do { if constexpr (EB == 2) { _Pragma("unroll") for (int _i = 0; _i < 2; ++_i) \
        __builtin_amdgcn_global_load_lds((const unsigned*)((const char*)(gbase) + (voff)[_i]), (PG8_LAS unsigned*)(lds + (bufoff) + ldsw + _i * 8192), 16, 0, 0); } \
        else { _Pragma("unroll") for (int _i = 0; _i < 2; ++_i) glds_saddr((voff)[_i], (const char*)(gbase), (unsigned)__builtin_amdgcn_readfirstlane((int)(lds0 + (unsigned)(bufoff) + ldsw + (unsigned)(_i * 8192)))); } } while (0)
#define PG8_GLOAD(vo, u) do { _Pragma("unroll") for (int _h = 0; _h < 2; ++_h) _Pragma("unroll") for (int _i = 0; _i < 2; ++_i) vo[_h][_i] = (unsigned)rowtok[(size_t)(u).pm * BM + _h * HALF + gR[_i]] * (unsigned)(K * EB) + gC[_i]; } while (0)
#define PG8_STAGE_A(bufoff, pplain, kofs, h, VS) do { if constexpr (!GATHER) { PG8_STAGE(bufoff, pplain, voffA); } else { _Pragma("unroll") for (int _i = 0; _i < 2; ++_i) \
        glds_saddr(VS[h][_i], (const char*)g.A + (kofs), (unsigned)__builtin_amdgcn_readfirstlane((int)(lds0 + (unsigned)(bufoff) + ldsw + (unsigned)(_i * 8192)))); } } while (0)
#define PG8_LD8(p) __builtin_shufflevector(*(const PG8_LAS v4i_t*)(p), *(const PG8_LAS v4i_t*)((p) + 1024), 0, 1, 2, 3, 4, 5, 6, 7)
#define PG8_LDA(dst, b, h) do { if constexpr (EB == 2) { _Pragma("unroll") for (int m = 0; m < 4; ++m) _Pragma("unroll") for (int k = 0; k < 2; ++k) dst[m][k] = *(const PG8_LAS bf16x8*)(lds + PG8_SA(b, h) + aoff + m * 2048 + k * 1024); } \
        else { _Pragma("unroll") for (int m = 0; m < 4; ++m) dst##8[m] = PG8_LD8(lds + PG8_SA(b, h) + aoff + m * 2048); } } while (0)
#define PG8_LDB(dst, b, h) do { if constexpr (EB == 2) { _Pragma("unroll") for (int n = 0; n < 2; ++n) _Pragma("unroll") for (int k = 0; k < 2; ++k) dst[n][k] = *(const PG8_LAS bf16x8*)(lds + PG8_SB(b, h) + boff + n * 2048 + k * 1024); } \
        else { _Pragma("unroll") for (int n = 0; n < 2; ++n) dst##8[n] = PG8_LD8(lds + PG8_SB(b, h) + boff + n * 2048); } } while (0)
#define PG8_CAT8(x, y) __builtin_shufflevector(__builtin_bit_cast(v4i_t, x), __builtin_bit_cast(v4i_t, y), 0, 1, 2, 3, 4, 5, 6, 7)
#define PG8_MMA(ai, bj, At, Bt) do { __builtin_amdgcn_s_setprio(1); if constexpr (EB == 2) { _Pragma("unroll") for (int m = 0; m < 4; ++m) _Pragma("unroll") for (int n = 0; n < 2; ++n) _Pragma("unroll") for (int k = 0; k < 2; ++k) \
        acc[ai][bj][m][n] = __builtin_amdgcn_mfma_f32_16x16x32_bf16(Bt[n][k], At[m][k], acc[ai][bj][m][n], 0, 0, 0); } else { _Pragma("unroll") for (int m = 0; m < 4; ++m) _Pragma("unroll") for (int n = 0; n < 2; ++n) \
        asm volatile("v_mfma_scale_f32_16x16x128_f8f6f4 %0, %1, %2, %0, %3, %3 op_sel_hi:[0,0,0]" : "+v"(acc[ai][bj][m][n]) : "v"(Bt##8[n]), "v"(At##8[m]), "v"(mx_one)); }     __builtin_amdgcn_s_setprio(0); } while (0)
#define PG8_WAIT_V(n) asm volatile("s_waitcnt vmcnt(" #n ")" ::: "memory")
#define PG8_WAIT_L(n) asm volatile("s_waitcnt lgkmcnt(" #n ")" ::: "memory")
#define PG8_BAR __builtin_amdgcn_s_barrier()
#define PG8_SCHED __builtin_amdgcn_sched_barrier(0)
    Unit cur, nxt; int ui = 0;
    if (!S.next(0, cur)) return;
    f32x4 acc[2][2][4][2];
#pragma unroll
    for (int a = 0; a < 2; ++a)
#pragma unroll
        for (int b = 0; b < 2; ++b)
#pragma unroll
            for (int m = 0; m < 4; ++m)
#pragma unroll
                for (int n = 0; n < 2; ++n) acc[a][b][m][n] = (f32x4){0.f, 0.f, 0.f, 0.f};
    const int mx_one = 0x7f7f7f7f;
    bf16x8 At[4][2], B0[2][2], B1[2][2]; v8i_t At8[4], B08[2], B18[2];
    const char* cA = (const char*)g.A + (size_t)cur.pm * tstep; const char* cB = (const char*)g.Bt + (size_t)cur.pn * tstep;
    S.a_ready(cur);
    unsigned voffC[2][2], voffN[2][2];
    if constexpr (GATHER) PG8_GLOAD(voffC, cur);
    if constexpr (SP2) {
        PG8_STAGE(PG8_SB(0, 0), cB, voffB); PG8_STAGE(PG8_SB(0, 1), cB + hstep, voffB); PG8_STAGE_A(PG8_SA(0, 0), cA, 0, 0, voffC); PG8_STAGE_A(PG8_SA(0, 1), cA + hstep, 0, 1, voffC);
        if (wr == 1) PG8_BAR;
        PG8_WAIT_V(2); PG8_BAR;
        PG8_STAGE(PG8_SB(1, 0), cB + kstep, voffB); PG8_STAGE_A(PG8_SA(1, 0), cA + kstep, kstep, 0, voffC); PG8_STAGE(PG8_SB(1, 1), cB + hstep + kstep, voffB);
        PG8_WAIT_V(6); PG8_BAR;
    } else {
        PG8_STAGE(PG8_SB(0, 0), cB, voffB); PG8_STAGE(PG8_SA(0, 0), cA, voffA); PG8_STAGE(PG8_SB(0, 1), cB + hstep, voffB); PG8_STAGE(PG8_SA(0, 1), cA + hstep, voffA);
        if (wr == 1) PG8_BAR;
        PG8_WAIT_V(4); PG8_BAR;
        PG8_STAGE(PG8_SB(1, 0), cB + kstep, voffB); PG8_STAGE(PG8_SA(1, 0), cA + kstep, voffA); PG8_STAGE(PG8_SB(1, 1), cB + hstep + kstep, voffB);
        PG8_WAIT_V(6); PG8_BAR;
    }
    for (;;) {
        const bool has_next = S.next(ui + 1, nxt);
        if constexpr (GATHER) { if (has_next) PG8_GLOAD(voffN, nxt); else { _Pragma("unroll") for (int _h = 0; _h < 2; ++_h) _Pragma("unroll") for (int _i = 0; _i < 2; ++_i) voffN[_h][_i] = voffC[_h][_i]; } }
        const char* nA = has_next ? (const char*)g.A + (size_t)nxt.pm * tstep : cA; const char* nB = has_next ? (const char*)g.Bt + (size_t)nxt.pn * tstep : cB;
#pragma nounroll
        for (int t = 0; t < nt; t += 2) {
            const bool last = (t == nt - 2);
            const char* a1 = cA + (size_t)(t + 1) * kstep;
            const char* a2 = last ? nA : cA + (size_t)(t + 2) * kstep; const char* b2 = last ? nB : cB + (size_t)(t + 2) * kstep;
            const char* a3 = a2 + kstep; const char* b3 = b2 + kstep;
            const size_t k2 = last ? (size_t)0 : (size_t)(t + 2) * kstep; unsigned voffS[2][2];
            if constexpr (GATHER) { _Pragma("unroll") for (int _h = 0; _h < 2; ++_h) _Pragma("unroll") for (int _i = 0; _i < 2; ++_i) voffS[_h][_i] = last ? voffN[_h][_i] : voffC[_h][_i]; }
            if (last && has_next) S.a_ready(nxt);
            if constexpr (SP2) {
            PG8_LDB(B0, 0, 0); PG8_LDB(B1, 0, 1); PG8_SCHED; PG8_LDA(At, 0, 0); PG8_STAGE_A(PG8_SA(1, 1), a1 + hstep, (size_t)(t + 1) * kstep, 1, voffC);
            PG8_WAIT_V(8); PG8_WAIT_L(0); PG8_BAR; PG8_MMA(0, 0, At, B0); PG8_MMA(0, 1, At, B1); PG8_BAR; PG8_SCHED;
            PG8_LDA(At, 0, 1); PG8_STAGE(PG8_SB(0, 0), b2, voffB); PG8_STAGE(PG8_SB(0, 1), b2 + hstep, voffB); PG8_STAGE_A(PG8_SA(0, 0), a2, k2, 0, voffS);
            PG8_WAIT_V(8); PG8_WAIT_L(0); PG8_BAR; PG8_MMA(1, 0, At, B0); PG8_MMA(1, 1, At, B1); PG8_BAR; PG8_SCHED;
            PG8_LDB(B0, 1, 0); PG8_LDB(B1, 1, 1); PG8_SCHED; PG8_LDA(At, 1, 0); PG8_STAGE_A(PG8_SA(0, 1), a2 + hstep, k2, 1, voffS);
            PG8_WAIT_V(8); PG8_WAIT_L(0); PG8_BAR; PG8_MMA(0, 0, At, B0); PG8_MMA(0, 1, At, B1); PG8_BAR; PG8_SCHED;
            PG8_LDA(At, 1, 1); PG8_STAGE(PG8_SB(1, 0), b3, voffB); PG8_STAGE(PG8_SB(1, 1), b3 + hstep, voffB); PG8_STAGE_A(PG8_SA(1, 0), a3, k2 + kstep, 0, voffS);
            PG8_WAIT_V(8); PG8_WAIT_L(0); PG8_BAR; PG8_MMA(1, 0, At, B0); PG8_MMA(1, 1, At, B1); PG8_BAR; PG8_SCHED;
            } else {
            PG8_LDB(B0, 0, 0); PG8_SCHED; PG8_LDA(At, 0, 0); PG8_STAGE(PG8_SA(1, 1), a1 + hstep, voffA);
            PG8_WAIT_L(8); PG8_BAR; PG8_WAIT_L(0); PG8_MMA(0, 0, At, B0); PG8_BAR; PG8_SCHED;
            PG8_LDB(B1, 0, 1); PG8_STAGE(PG8_SB(0, 0), b2, voffB);
            PG8_BAR; PG8_WAIT_L(0); PG8_MMA(0, 1, At, B1); PG8_BAR;
            PG8_LDA(At, 0, 1); PG8_STAGE(PG8_SA(0, 0), a2, voffA);
            PG8_BAR; PG8_WAIT_L(0); PG8_MMA(1, 0, At, B0); PG8_BAR; PG8_SCHED;
            PG8_STAGE(PG8_SB(0, 1), b2 + hstep, voffB);
            PG8_WAIT_V(6); PG8_BAR; PG8_MMA(1, 1, At, B1); PG8_BAR;
            PG8_LDB(B0, 1, 0); PG8_SCHED; PG8_LDA(At, 1, 0); PG8_STAGE(PG8_SA(0, 1), a2 + hstep, voffA);
            PG8_WAIT_L(8); PG8_BAR; PG8_WAIT_L(0); PG8_MMA(0, 0, At, B0); PG8_BAR; PG8_SCHED;
            PG8_LDB(B1, 1, 1); PG8_STAGE(PG8_SB(1, 0), b3, voffB);
            PG8_BAR; PG8_WAIT_L(0); PG8_MMA(0, 1, At, B1); PG8_BAR;
            PG8_LDA(At, 1, 1); PG8_STAGE(PG8_SA(1, 0), a3, voffA);
            PG8_BAR; PG8_WAIT_L(0); PG8_MMA(1, 0, At, B0); PG8_BAR; PG8_SCHED;
            PG8_STAGE(PG8_SB(1, 1), b3 + hstep, voffB);
            PG8_WAIT_V(6); PG8_BAR; PG8_MMA(1, 1, At, B1); PG8_BAR;
            }
        }
        if constexpr (ALIGN_EPI) { if (wr == 0) PG8_BAR; }
        if constexpr (EB == 1) asm volatile("s_nop 15\n\ts_nop 15" ::: "memory");
        if constexpr (!Epi::AFTER_DRAIN) { E(acc, cur, wr, wc, fr, fq); S.done(cur); }
        if (!has_next) break;
#pragma unroll
        for (int a = 0; a < 2; ++a)
#pragma unroll
            for (int b = 0; b < 2; ++b)
#pragma unroll
                for (int m = 0; m < 4; ++m)
#pragma unroll
                    for (int n = 0; n < 2; ++n) acc[a][b][m][n] = (f32x4){0.f, 0.f, 0.f, 0.f};
        cur = nxt; cA = nA; cB = nB; ++ui;
        if constexpr (GATHER) { _Pragma("unroll") for (int _h = 0; _h < 2; ++_h) _Pragma("unroll") for (int _i = 0; _i < 2; ++_i) voffC[_h][_i] = voffN[_h][_i]; }
        if constexpr (ALIGN_EPI) { if (wr == 1) PG8_BAR; }
    }
    PG8_WAIT_V(0);
    if constexpr (!ALIGN_EPI) { if (wr == 0) PG8_BAR; }
    PG8_BAR;
    if constexpr (Epi::AFTER_DRAIN) { E.fused(acc, cur, wr, wc, fr, fq, lds, wid, lane); S.done(cur); }
#undef PG8_SA
#undef PG8_SB
#undef PG8_STAGE
#undef PG8_LDA
#undef PG8_GLOAD
#undef PG8_STAGE_A
#undef PG8_LD8
#undef PG8_LDB
#undef PG8_MMA
#undef PG8_CAT8
#undef PG8_WAIT_V
#undef PG8_WAIT_L
#undef PG8_BAR
#undef PG8_SCHED
}
}
#ifndef PG8_SP2
#define PG8_SP2 true
#endif
#ifndef MOE_SP2
#define MOE_SP2 true
#endif
#ifndef PG8_ALIGN
#define PG8_ALIGN true
#endif
constexpr int NWAVES = 8;
constexpr int NB = 4, SEQ = 4096, T = NB * SEQ, D = 1024, NIN = 2856, NINP = 3072, NE = 32, DEPTH = 2;
constexpr int C_H = 0, C_GB = 256, C_GC = 512, C_P = 768, C_Q = 1024, C_K = 1536, C_V = 2048, C_QI = 2560, C_KI = 2816, C_WI = 2848;
constexpr int NSEL = 256;
#ifndef SEL_CAND_CAP
#define SEL_CAND_CAP 64
#endif
constexpr int MAXROWS = 4 * T + NE * 256;
constexpr float ATT_C2 = 0.125f * 1.4426950408889634f;
constexpr float LN_EPS = 1e-5f, DN_ALPHA = 1.41421356237309515f;
enum { IN_X = 0, IN_WIN, IN_CONVW, IN_WPOOL, IN_PSCALE, IN_KNG, IN_KNB, IN_WOUT, IN_LN1G, IN_LN1B, IN_RW, IN_RB, IN_WGU, IN_BGU, IN_WDN, IN_BDN, IN_LN2G, IN_LN2B, N_IN };

constexpr size_t MiB = 1u << 20;
constexpr size_t WS_CTL = 0, CTL_ZERO_BYTES = 1 * MiB;
constexpr size_t WS_WIN = 2 * MiB;
constexpr size_t WS_WOUT = 14 * MiB;
constexpr size_t WS_WGU = 18 * MiB;
constexpr size_t WS_WDN = 274 * MiB;
constexpr size_t WS_XB = 402 * MiB;
constexpr size_t WS_XF = 434 * MiB;
constexpr size_t WS_Y1 = 498 * MiB;
constexpr size_t WS_PROJ = 562 * MiB;
constexpr size_t WS_CAT = 658 * MiB;
constexpr size_t WS_KIN = 690 * MiB;
constexpr size_t WS_MASK = 691 * MiB;
constexpr size_t WS_ROUTE = 699 * MiB;
constexpr size_t WS_CNTW = 699 * MiB + 256 * 1024;
constexpr size_t WS_SC = 700 * MiB;
constexpr size_t WS_XS = 956 * MiB;
constexpr size_t WS_ACT = 1100 * MiB;
constexpr size_t WS_YS = 1244 * MiB;
constexpr size_t WS_XB8 = 1388 * MiB;
constexpr size_t WS_END = 1404 * MiB;
constexpr int CW_TMO = 0;
constexpr int CW_CNT = 1024;
constexpr int CW_BAR = 4096;
constexpr int RING_BYTES = 131072;
constexpr int TAB_OFF = RING_BYTES;
constexpr int MISC_OFF = RING_BYTES + 1024;
constexpr int LDS_BYTES = 147456;

#define GAS __attribute__((address_space(1)))
#define LAS __attribute__((address_space(3)))
typedef unsigned short bf16;
typedef unsigned v4u __attribute__((ext_vector_type(4)));
typedef unsigned v2u __attribute__((ext_vector_type(2)));
typedef float f32x4 __attribute__((ext_vector_type(4)));
typedef short bf16x8 __attribute__((ext_vector_type(8)));
typedef GAS unsigned gu32;
typedef unsigned long long u64;
#define RLX_AGENT __ATOMIC_RELAXED, __HIP_MEMORY_SCOPE_AGENT
#define LDS_WAIT() asm volatile("s_waitcnt lgkmcnt(0)" ::: "memory")
#define VM_WAIT() asm volatile("s_waitcnt vmcnt(0)" ::: "memory")
__device__ __forceinline__ unsigned f2bf(float f) { unsigned u = __builtin_bit_cast(unsigned, f); return (u + 0x7fffu + ((u >> 16) & 1u)) >> 16; }
__device__ __forceinline__ unsigned pk2(float lo, float hi) {
    typedef float f2_ __attribute__((ext_vector_type(2))); typedef __bf16 b2_ __attribute__((ext_vector_type(2))); const f2_ v = {lo, hi}; return __builtin_bit_cast(unsigned, __builtin_convertvector(v, b2_)); }
__device__ __forceinline__ unsigned pk4_fp8(float a, float b, float c, float d) { int w = 0; w = __builtin_amdgcn_cvt_pk_fp8_f32(a, b, w, false); w = __builtin_amdgcn_cvt_pk_fp8_f32(c, d, w, true); return (unsigned)w; }
constexpr float WGU_SCALE = 32.f, WDN_SCALE = 64.f;
__device__ __forceinline__ float bf2f(bf16 v) { return __builtin_bit_cast(float, (unsigned)v << 16); }
__device__ __forceinline__ float bflo(unsigned w) { return __builtin_bit_cast(float, w << 16); }
__device__ __forceinline__ float bfhi(unsigned w) { return __builtin_bit_cast(float, w & 0xffff0000u); }
template <int CTRL> __device__ __forceinline__ float dppx(float v) { return __builtin_bit_cast(float, __builtin_amdgcn_update_dpp(0, __builtin_bit_cast(int, v), CTRL, 0xf, 0xf, false)); }
__device__ __forceinline__ float wave_sum(float v) {
    v += dppx<0xB1>(v); v += dppx<0x4E>(v); v += dppx<0x141>(v); v += dppx<0x140>(v);
    const float a = __builtin_bit_cast(float, __builtin_amdgcn_readlane(__builtin_bit_cast(int, v), 0)), b = __builtin_bit_cast(float, __builtin_amdgcn_readlane(__builtin_bit_cast(int, v), 16));
    const float c = __builtin_bit_cast(float, __builtin_amdgcn_readlane(__builtin_bit_cast(int, v), 32)), d = __builtin_bit_cast(float, __builtin_amdgcn_readlane(__builtin_bit_cast(int, v), 48));
    return (a + b) + (c + d);
}
__device__ __forceinline__ float wave_max(float v) {
#pragma unroll
    for (int o = 1; o < 64; o <<= 1) v = fmaxf(v, __shfl_xor(v, o));
    return v;
}
__device__ __forceinline__ float wave_max_dpp(float v) {
    v = fmaxf(v, dppx<0xB1>(v)); v = fmaxf(v, dppx<0x4E>(v)); v = fmaxf(v, dppx<0x141>(v)); v = fmaxf(v, dppx<0x140>(v));
    const float a = __builtin_bit_cast(float, __builtin_amdgcn_readlane(__builtin_bit_cast(int, v), 0)), b = __builtin_bit_cast(float, __builtin_amdgcn_readlane(__builtin_bit_cast(int, v), 16));
    const float c = __builtin_bit_cast(float, __builtin_amdgcn_readlane(__builtin_bit_cast(int, v), 32)), d = __builtin_bit_cast(float, __builtin_amdgcn_readlane(__builtin_bit_cast(int, v), 48));
    return fmaxf(fmaxf(a, b), fmaxf(c, d));
}
__device__ __forceinline__ float sum32(float v) {
#pragma unroll
    for (int o = 1; o < 32; o <<= 1) v += __shfl_xor(v, o);
    return v;
}
#define XB_TMO      128
#define XB_XCNT(j)  (256  + 64 * (j))
#define XB_XSUB(j)  (1280 + 64 * (j))
#define XB_XGEN(j)  (2304 + 64 * (j))
#define XB_TOP      3328
#define XB_TOPGEN   3392
#define XCD_BAR_WORDS 3456
#define XB_SPIN_CAP (1u << 18)

__device__ __forceinline__ unsigned xb_ld(unsigned* p)              { return __hip_atomic_load(p, __ATOMIC_RELAXED, __HIP_MEMORY_SCOPE_AGENT); }
__device__ __forceinline__ unsigned xb_add(unsigned* p, unsigned v) { return __hip_atomic_fetch_add(p, v, __ATOMIC_RELAXED, __HIP_MEMORY_SCOPE_AGENT); }
__device__ __forceinline__ unsigned xb_xcc_id() { return (unsigned)__builtin_amdgcn_s_getreg((3 << 11) | 20) & 0xFu; }
#define XB_SPIN(cond, bar) do { unsigned _sp = 0; while (cond) { __builtin_amdgcn_s_sleep(1); \
    if ((++_sp & 255u) == 0u) { if (xb_ld(&(bar)[XB_TMO])) break; if (_sp > XB_SPIN_CAP) { atomicAdd(&(bar)[XB_TMO], 1u); break; } } } } while (0)

struct XcdBarrier {
    unsigned* bar; unsigned x;
    volatile LAS unsigned* st;
};

__device__ __forceinline__ XcdBarrier xcd_barrier_post(unsigned* bar, volatile LAS unsigned* st) {
    XcdBarrier b; b.bar = bar; b.x = xb_xcc_id(); b.st = st;
    if (threadIdx.x == 0) (void)xb_add(&bar[XB_XCNT(b.x)], 1u);
    return b;
}
__device__ __forceinline__ void xcd_barrier_complete(unsigned* bar, unsigned x, unsigned& nloc, unsigned& nx) {
    const unsigned G = gridDim.x * gridDim.y * gridDim.z;
    unsigned sum, cnt, mine, sp = 0u;
    for (;;) {
        sum = 0u; cnt = 0u; mine = 0u;
#pragma unroll
        for (unsigned j = 0; j < 16; ++j) { const unsigned c = xb_ld(&bar[XB_XCNT(j)]); sum += c; cnt += (c > 0u) ? 1u : 0u; mine = (j == x) ? c : mine; }
        if (sum == G) break;
        __builtin_amdgcn_s_sleep(1);
        if ((++sp & 255u) == 0u) { if (xb_ld(&bar[XB_TMO])) break; if (sp > XB_SPIN_CAP) { atomicAdd(&bar[XB_TMO], 1u); break; } }
    }
    nloc = mine > 0u ? mine : 1u; nx = cnt > 0u ? cnt : 1u;
}

__device__ __forceinline__ void xcd_barrier(const XcdBarrier& b) {
    asm volatile("s_waitcnt vmcnt(0)" ::: "memory");
    __syncthreads();
    if (threadIdx.x == 0) {
        unsigned* bar = b.bar;
        __builtin_amdgcn_s_waitcnt(0);
        unsigned nloc = b.st[0], nx = b.st[1];
        if (nloc == 0u) { xcd_barrier_complete(bar, b.x, nloc, nx); b.st[0] = nloc; b.st[1] = nx; }
        const unsigned old = xb_add(&bar[XB_XSUB(b.x)], 1u);
        const unsigned gen = old / nloc;
        if (old + 1u == (gen + 1u) * nloc) {
            __builtin_amdgcn_fence(__ATOMIC_RELEASE, "agent");
            asm volatile("s_waitcnt vmcnt(0)" ::: "memory");
#ifdef BAR_EARLY_INV
            __builtin_amdgcn_fence(__ATOMIC_ACQUIRE, "agent");
            (void)xb_add(&bar[XB_TOP], 1u);
            { const unsigned target = (gen + 1u) * nx; XB_SPIN(xb_ld(&bar[XB_TOP]) < target, bar); }
            xb_add(&bar[XB_XGEN(b.x)], 1u);
            asm volatile("s_waitcnt vmcnt(0)" ::: "memory");
#else
            const unsigned og = xb_add(&bar[XB_TOP], 1u);
            const unsigned tg = og / nx;
            if (og + 1u == (tg + 1u) * nx) xb_add(&bar[XB_TOPGEN], 1u);
            else XB_SPIN(xb_ld(&bar[XB_TOPGEN]) == tg, bar);
            __builtin_amdgcn_fence(__ATOMIC_ACQUIRE, "agent");
            xb_add(&bar[XB_XGEN(b.x)], 1u);
            asm volatile("s_waitcnt vmcnt(0)" ::: "memory");
#endif
        } else {
#ifdef BAR_EARLY_INV
            __builtin_amdgcn_fence(__ATOMIC_ACQUIRE, "agent"); asm volatile("s_waitcnt vmcnt(0)" ::: "memory");
            XB_SPIN(xb_ld(&bar[XB_XGEN(b.x)]) == gen, bar);
            asm volatile("" ::: "memory");
#else
            XB_SPIN(xb_ld(&bar[XB_XGEN(b.x)]) == gen, bar);
            __builtin_amdgcn_fence(__ATOMIC_ACQUIRE, "agent");
            asm volatile("s_waitcnt vmcnt(0)" ::: "memory");
#endif
        }
    }
    __syncthreads();
}
struct Args { const float* in[N_IN]; float* out; unsigned char* ws; int ph_lo, ph_hi; };
struct Frame {
    LAS unsigned char* lds;
    gu32* ctl;
    unsigned char* ws;
    int tid, lane, wave, vcu, G;
};
#define WSP(type, off) ((type*)(GAS type*)(F.ws + (off)))
__device__ __forceinline__ const float* uni(const float* p) { const u64 v = (u64)p; return (const float*)(const GAS float*)(((u64)(unsigned)__builtin_amdgcn_readfirstlane((int)(v >> 32)) << 32) | (u64)(unsigned)__builtin_amdgcn_readfirstlane((int)v)); }
__device__ __forceinline__ Frame make_frame(unsigned char* ws_, LAS unsigned char* lds_) {
    Frame F; const u64 v = (u64)ws_;
    F.ws = (unsigned char*)(((u64)(unsigned)__builtin_amdgcn_readfirstlane((int)(v >> 32)) << 32) | (u64)(unsigned)__builtin_amdgcn_readfirstlane((int)v));
    F.lds = (LAS unsigned char*)(unsigned)__builtin_amdgcn_readfirstlane((int)(unsigned)(uintptr_t)lds_);
    F.ctl = (gu32*)(F.ws + WS_CTL);
    { int t_ = threadIdx.x; asm volatile("" : "+v"(t_)); F.tid = t_; }
    F.lane = F.tid & 63; F.wave = __builtin_amdgcn_readfirstlane(F.tid >> 6);
    F.G = gridDim.x; { const int bx = blockIdx.x; F.vcu = (F.G % 8 == 0) ? (bx % 8) * (F.G / 8) + bx / 8 : bx; }
    return F;
}
struct In6 { const float* p[6]; };

__device__ __forceinline__ void tr_block(Frame& F, const float* W_, int N, bf16* WT, int k0, int n0, int mode  , size_t drow_base, float scale) {
    LAS unsigned* img = (LAS unsigned*)F.lds; const int lane = F.lane, wave = F.wave, tid = F.tid; const GAS float* W = (const GAS float*)W_;
    f32x4 va[4][2], vb[4][2];
#pragma unroll
    for (int i = 0; i < 4; ++i) { const int kp = wave * 4 + i; const GAS float* r0 = W + (size_t)(k0 + 2 * kp) * N + n0; const GAS float* r1 = r0 + N;
#pragma unroll
        for (int q = 0; q < 2; ++q) { const int c4 = lane + 64 * q; va[i][q] = (f32x4){0.f, 0.f, 0.f, 0.f}; vb[i][q] = va[i][q];
            if (n0 + 4 * c4 < N) { va[i][q] = __builtin_nontemporal_load((const GAS f32x4*)(r0 + 4 * c4)); vb[i][q] = __builtin_nontemporal_load((const GAS f32x4*)(r1 + 4 * c4)); } } }
#pragma unroll
    for (int i = 0; i < 4; ++i) { const int kp = wave * 4 + i;
#pragma unroll
        for (int q = 0; q < 2; ++q) { const int c4 = lane + 64 * q; const f32x4 a = va[i][q], b = vb[i][q];
            v4u o; o.x = pk2(a.x * scale, b.x * scale); o.y = pk2(a.y * scale, b.y * scale); o.z = pk2(a.z * scale, b.z * scale); o.w = pk2(a.w * scale, b.w * scale);
            *(LAS v4u*)(img + kp * 516 + 4 * c4) = o; } }
    __syncthreads();
    const int c = tid & 7;
#pragma unroll
    for (int i = 0; i < 8; ++i) { const int n = (tid >> 3) + 64 * i; const LAS unsigned* p = img + (4 * c) * 516 + n;
        v4u o; o.x = p[0]; o.y = p[516]; o.z = p[2 * 516]; o.w = p[3 * 516];
        const int ng = n0 + n; size_t dr;
        if (mode == 1) dr = ng < 1024 ? (size_t)((ng >> 7) * 256 + (ng & 127)) : (size_t)((((ng - 1024) >> 7) * 256) + 128 + ((ng - 1024) & 127)); else dr = (size_t)ng;
        *(GAS v4u*)((GAS bf16*)WT + (drow_base + dr) * D + k0 + 8 * c) = o; }
    __syncthreads();
}
__device__ __forceinline__ void tr_block8(Frame& F, const float* W_, int N, unsigned char* WT, int k0, int n0, int mode, size_t drow_base, float scale) {
    LAS unsigned* img = (LAS unsigned*)F.lds; const int lane = F.lane, wave = F.wave, tid = F.tid; const GAS float* W = (const GAS float*)W_;
    f32x4 vv[4][2][4];
#pragma unroll
    for (int i = 0; i < 4; ++i) { const int kq = wave * 4 + i; const GAS float* r0 = W + (size_t)(k0 + 4 * kq) * N + n0;
#pragma unroll
        for (int q = 0; q < 2; ++q) { const int c4 = lane + 64 * q;
#pragma unroll
            for (int j = 0; j < 4; ++j) vv[i][q][j] = __builtin_nontemporal_load((const GAS f32x4*)(r0 + (size_t)j * N + 4 * c4)); } }
#pragma unroll
    for (int i = 0; i < 4; ++i) { const int kq = wave * 4 + i;
#pragma unroll
        for (int q = 0; q < 2; ++q) { const int c4 = lane + 64 * q; const f32x4 a = vv[i][q][0] * scale, b = vv[i][q][1] * scale, c = vv[i][q][2] * scale, d = vv[i][q][3] * scale;
            v4u o; o.x = pk4_fp8(a.x, b.x, c.x, d.x); o.y = pk4_fp8(a.y, b.y, c.y, d.y); o.z = pk4_fp8(a.z, b.z, c.z, d.z); o.w = pk4_fp8(a.w, b.w, c.w, d.w);
            *(LAS v4u*)(img + kq * 516 + 4 * c4) = o; } }
    __syncthreads();
    const int c = tid & 7;
#pragma unroll
    for (int i = 0; i < 8; ++i) { const int n = (tid >> 3) + 64 * i; const LAS unsigned* p = img + (4 * c) * 516 + n;
        v4u o; o.x = p[0]; o.y = p[516]; o.z = p[2 * 516]; o.w = p[3 * 516];
        const int ng = n0 + n; size_t dr;
        if (mode == 1) dr = ng < 1024 ? (size_t)((ng >> 7) * 256 + (ng & 127)) : (size_t)((((ng - 1024) >> 7) * 256) + 128 + ((ng - 1024) & 127)); else dr = (size_t)ng;
        __builtin_nontemporal_store(o, (GAS v4u*)((GAS unsigned char*)WT + (drow_base + dr) * D + k0 + 16 * c)); }
    __syncthreads();
}
__device__ __forceinline__ void p_prologue(Frame& F, const In6& A) {
    constexpr int I_IN = 16 * 6, I_OUT = 16 * 2, I_L = I_IN + I_OUT;
    for (int it = F.vcu; it < DEPTH * I_L; it += F.G) {
        const int l = it / I_L; int r = it % I_L;
        if (r < I_IN) { const int kb = r / 6, nb = r % 6; tr_block(F, A.p[0] + (size_t)l * D * NIN, NIN, WSP(bf16, WS_WIN) + (size_t)l * NINP * D, kb * 64, nb * 512, 0, 0, nb == 2 ? ATT_C2 : 1.f); continue; }
        r -= I_IN;
        { const int kb = r / 2, nb = r % 2; tr_block(F, A.p[1] + (size_t)l * D * D, D, WSP(bf16, WS_WOUT) + (size_t)l * D * D, kb * 64, nb * 512, 0, 0, 1.f); }
    }
    const int gw = F.vcu * NWAVES + F.wave, NGW = F.G * NWAVES, lane = F.lane;
    const GAS float* x = (const GAS float*)A.p[4]; GAS bf16* xb = (GAS bf16*)WSP(bf16, WS_XB);
    for (int m = gw; m < T; m += 2 * NGW) {
        const GAS f32x4* xr = (const GAS f32x4*)(x + (size_t)m * D) + lane; GAS u64* o8 = (GAS u64*)(xb + (size_t)m * D) + lane;
        const GAS f32x4* xr2 = xr + (size_t)NGW * (D / 4); GAS u64* o82 = o8 + (size_t)NGW * (D / 4);
        f32x4 v[4], w[4];
#pragma unroll
        for (int j = 0; j < 4; ++j) { v[j] = __builtin_nontemporal_load(xr + 64 * j); w[j] = __builtin_nontemporal_load(xr2 + 64 * j); }
#pragma unroll
        for (int j = 0; j < 4; ++j) { o8[64 * j] = (u64)pk2(v[j].x, v[j].y) | ((u64)pk2(v[j].z, v[j].w) << 32); o82[64 * j] = (u64)pk2(w[j].x, w[j].y) | ((u64)pk2(w[j].z, w[j].w) << 32); }
    }
}

__device__ __forceinline__ void convert_experts(Frame& F, const float* wgu, const float* wdn, int l) {
    constexpr int I_GU = NE * 8 * 4, I_DN = NE * 8 * 2, PER = (I_GU + I_DN) / 256;
    for (int q = 0; q < PER; ++q) { int r = F.vcu * PER + q;
        if (r < I_GU) { const int e = r / 32, rr = r % 32, kb = rr / 4, nb = rr % 4; tr_block8(F, wgu + (size_t)(l * NE + e) * D * 2048, 2048, WSP(unsigned char, WS_WGU) + (size_t)l * NE * 2048 * D * 2, kb * 128, nb * 512, 1, (size_t)e * 2048, WGU_SCALE); }
        else { r -= I_GU; const int e = r / 16, rr = r % 16, kb = rr / 2, nb = rr % 2; tr_block8(F, wdn + (size_t)(l * NE + e) * D * D, D, WSP(unsigned char, WS_WDN) + (size_t)l * NE * D * D * 2, kb * 128, nb * 512, 0, (size_t)e * 1024, WDN_SCALE); } }
}

__device__ __forceinline__ void bf8_to_f(const v4u q, float (&f)[8]) { f[0] = bflo(q.x); f[1] = bfhi(q.x); f[2] = bflo(q.y); f[3] = bfhi(q.y); f[4] = bflo(q.z); f[5] = bfhi(q.z); f[6] = bflo(q.w); f[7] = bfhi(q.w); }
__device__ __forceinline__ void p_local(Frame& F, const In6& A, int l) {
    typedef float f32x16 __attribute__((ext_vector_type(16)));
    constexpr int MROW = 528, WROW = 144;
    LAS unsigned char* mixb = F.lds;
    LAS unsigned char* wpt = F.lds + 64 * MROW;
    const GAS float* wpool = (const GAS float*)(A.p[0] + (size_t)l * 4 * 64 * 64);
    const GAS float* convw = (const GAS float*)(A.p[1] + l * 768); const GAS float* pscale = (const GAS float*)(A.p[2] + l * 256);
    const GAS float* kng = (const GAS float*)(A.p[3] + l * 32); const GAS float* knb = (const GAS float*)(A.p[4] + l * 32);
    const GAS bf16* PROJ = (const GAS bf16*)(F.ws + WS_PROJ); GAS bf16* CAT = (GAS bf16*)(F.ws + WS_CAT); GAS bf16* KIN = (GAS bf16*)(F.ws + WS_KIN);
    const int tid = F.tid, lane = F.lane, wave = F.wave;
    for (int u = F.vcu; u < T / 64; u += F.G) {
        const int t0 = u * 64, s0 = t0 & (SEQ - 1), rowb = t0 - s0;
        __syncthreads();
        f32x4 wr0[4], wr1[4];
#pragma unroll
        for (int i = 0; i < 4; ++i) { const int item = tid + 512 * i, g = item >> 9, cp = (item >> 4) & 31, dq = item & 15;
            wr0[i] = *(const GAS f32x4*)(wpool + g * 4096 + (2 * cp) * 64 + 4 * dq); wr1[i] = *(const GAS f32x4*)(wpool + g * 4096 + (2 * cp + 1) * 64 + 4 * dq); }
        const int cga = tid & 31, tga = tid >> 5, ca0 = cga * 8, sfa = s0 + tga * 4;
        v4u ah[6], ag[6], ab[4];
#pragma unroll
        for (int i = -2; i < 4; ++i) { const int sq = sfa + i; ah[i + 2] = (v4u){0u, 0u, 0u, 0u}; ag[i + 2] = ah[i + 2];
            if (sq >= 0) { const GAS bf16* pr = PROJ + (size_t)(rowb + sq) * NINP; ah[i + 2] = *(const GAS v4u*)(pr + C_H + ca0); ag[i + 2] = *(const GAS v4u*)(pr + C_GC + ca0);
                if (i >= 0) ab[i] = *(const GAS v4u*)(pr + C_GB + ca0); } }
        const int cgb = tid & 63, tgb = tid >> 6, cb0 = cgb * 4, wwin = 2 << (cgb >> 4), sfb = s0 + tgb * 8;
        v2u bq[23];
#pragma unroll
        for (int i = 0; i < 23; ++i) { const int sq = sfb - 15 + i; bq[i] = (v2u){0u, 0u}; if (sq >= 0) bq[i] = *(const GAS v2u*)(PROJ + (size_t)(rowb + sq) * NINP + C_P + cb0); }
        bf16 ck[4];
#pragma unroll
        for (int i = 0; i < 4; ++i) { const int idx = tid + 512 * i; ck[i] = PROJ[(size_t)(t0 + (idx >> 5)) * NINP + C_KI + (idx & 31)]; }
        const float kg = kng[tid & 31], kb = knb[tid & 31];
        float w0[8], w1[8], w2[8];
#pragma unroll
        for (int i = 0; i < 8; ++i) { w0[i] = convw[ca0 + i]; w1[i] = convw[256 + ca0 + i]; w2[i] = convw[512 + ca0 + i]; }
#pragma unroll
        for (int i = 0; i < 4; ++i) { const int item = tid + 512 * i, g = item >> 9, cp = (item >> 4) & 31, dq = item & 15;
#pragma unroll
            for (int k = 0; k < 4; ++k) *(LAS unsigned*)(wpt + (g * 64 + 4 * dq + k) * WROW + cp * 4) = pk2(wr0[i][k], wr1[i][k]); }
        {
            float up2[8], up1[8];
#pragma unroll
            for (int i = 0; i < 8; ++i) { up2[i] = 0.f; up1[i] = 0.f; }
#pragma unroll
            for (int i = -2; i < 4; ++i) { const int sq = sfa + i; float h8[8], g8[8], uu[8];
                bf8_to_f(ah[i + 2], h8); bf8_to_f(ag[i + 2], g8);
#pragma unroll
                for (int k = 0; k < 8; ++k) uu[k] = g8[k] * h8[k];
                if (i >= 0) { float b8[8], y[8]; bf8_to_f(ab[i], b8);
#pragma unroll
                    for (int k = 0; k < 8; ++k) y[k] = b8[k] * (w0[k] * up2[k] + w1[k] * up1[k] + w2[k] * uu[k]);
                    v4u o; o.x = pk2(y[0], y[1]); o.y = pk2(y[2], y[3]); o.z = pk2(y[4], y[5]); o.w = pk2(y[6], y[7]);
                    *(GAS v4u*)(CAT + (size_t)(rowb + sq) * D + ca0) = o; }
#pragma unroll
                for (int k = 0; k < 8; ++k) { up2[k] = up1[k]; up1[k] = uu[k]; } }
        }
        {
            float pv[23][4];
#pragma unroll
            for (int i = 0; i < 23; ++i) { pv[i][0] = bflo(bq[i].x); pv[i][1] = bfhi(bq[i].x); pv[i][2] = bflo(bq[i].y); pv[i][3] = bfhi(bq[i].y); }
#pragma unroll
            for (int i = 0; i < 8; ++i) { const int sq = sfb + i; float a0 = 0.f, a1 = 0.f, a2 = 0.f, a3 = 0.f;
#pragma unroll
                for (int j = 0; j < 16; ++j) { const bool on = j < wwin; a0 += on ? pv[15 + i - j][0] : 0.f; a1 += on ? pv[15 + i - j][1] : 0.f; a2 += on ? pv[15 + i - j][2] : 0.f; a3 += on ? pv[15 + i - j][3] : 0.f; }
                const float rc = 1.f / (float)((sq + 1) < wwin ? (sq + 1) : wwin);
                *(LAS v2u*)(mixb + (tgb * 8 + i) * MROW + cb0 * 2) = (v2u){pk2(a0 * rc - pv[15 + i][0], a1 * rc - pv[15 + i][1]), pk2(a2 * rc - pv[15 + i][2], a3 * rc - pv[15 + i][3])}; }
        }
#pragma unroll
        for (int i = 0; i < 4; ++i) {
            const int idx = tid + 512 * i, tt = idx >> 5, dd = idx & 31; const float v = bf2f(ck[i]);
            const float mean = sum32(v) * (1.f / 32.f); const float dv = v - mean; const float var = sum32(dv * dv) * (1.f / 32.f);
            KIN[(size_t)(t0 + tt) * 32 + dd] = (bf16)f2bf(dv * rsqrtf(var + LN_EPS) * kg + kb);
        }
        __syncthreads();
        {
            const int g = wave >> 1, th = wave & 1, r32 = lane & 31, hi = lane >> 5;
            f32x16 acc[2]; acc[0] = f32x16{}; acc[1] = f32x16{};
#pragma unroll
            for (int kk = 0; kk < 4; ++kk) { const bf16x8 bfr = *(const LAS bf16x8*)(mixb + (th * 32 + r32) * MROW + (g * 64 + kk * 16 + hi * 8) * 2);
#pragma unroll
                for (int dh = 0; dh < 2; ++dh) { const bf16x8 afr = *(const LAS bf16x8*)(wpt + (g * 64 + dh * 32 + r32) * WROW + (kk * 16 + hi * 8) * 2);
                    acc[dh] = __builtin_amdgcn_mfma_f32_32x32x16_bf16(afr, bfr, acc[dh], 0, 0, 0); } }
            GAS bf16* orow = CAT + (size_t)(t0 + th * 32 + r32) * D + 256 + g * 64;
#pragma unroll
            for (int dh = 0; dh < 2; ++dh)
#pragma unroll
                for (int rq = 0; rq < 4; ++rq) { const int d0 = dh * 32 + 8 * rq + 4 * hi; const f32x4 sc = *(const GAS f32x4*)(pscale + g * 64 + d0);
                    *(GAS v2u*)(orow + d0) = (v2u){pk2(acc[dh][4 * rq] * sc.x, acc[dh][4 * rq + 1] * sc.y), pk2(acc[dh][4 * rq + 2] * sc.z, acc[dh][4 * rq + 3] * sc.w)}; }
        }
    }
    __syncthreads();
}

constexpr int SCS = SEQ;
__device__ __forceinline__ unsigned sortable(float v) { const unsigned u = __builtin_bit_cast(unsigned, v); return (u & 0x80000000u) ? ~u : (u | 0x80000000u); }
__device__ __forceinline__ void select_row(int t, const GAS float* SC, GAS unsigned* MASK, LAS unsigned* hist, LAS float* ckey, LAS int* cidx, int lane) {
    const u64 lt = (1ull << lane) - 1ull; const float NINF = -INFINITY;
    const int s = t & (SEQ - 1); GAS u64* mrow = (GAS u64*)MASK + ((size_t)(t >> 12) * 64) * SEQ + s;
    if (s < NSEL) { const int base = 64 * lane; u64 m; if (s >= base + 63) m = ~0ull; else if (s < base) m = 0ull; else m = (2ull << (s - base)) - 1ull; mrow[(size_t)lane * SEQ] = m; return; }
    const int jmax = s >> 6, jb = jmax & ~7;
    float v[64]; const GAS float* srow = SC + (size_t)t * SCS + lane;
#pragma unroll
    for (int j0 = 0; j0 < 64; j0 += 8) {
        if (j0 < jb) {
#pragma unroll
            for (int j = j0; j < j0 + 8; ++j) v[j] = srow[64 * j];
        } else if (j0 == jb) {
#pragma unroll
            for (int j = j0; j < j0 + 8; ++j) { const float x = srow[64 * j]; v[j] = (lane + 64 * j <= s) ? x : NINF; }
        } else {
#pragma unroll
            for (int j = j0; j < j0 + 8; ++j) v[j] = NINF;
        }
    }
    {
    float vmx = NINF, vmn = INFINITY;
#pragma unroll
    for (int j0 = 0; j0 < 64; j0 += 8) {
        if (j0 < jb) {
#pragma unroll
            for (int j = j0; j < j0 + 8; ++j) { vmx = fmaxf(vmx, v[j]); vmn = fminf(vmn, v[j]); }
        } else if (j0 == jb) {
#pragma unroll
            for (int j = j0; j < j0 + 8; ++j) { vmx = fmaxf(vmx, v[j]); vmn = fminf(vmn, v[j] == NINF ? INFINITY : v[j]); }
        }
    }
    vmx = wave_max_dpp(vmx); vmn = -wave_max_dpp(-vmn);
    const float scale = 1023.f / fmaxf(vmx - vmn, 1e-30f), off = -vmn * scale;
#pragma unroll
    for (int i = 0; i < 4; ++i) ((LAS v4u*)hist)[i * 64 + lane] = (v4u){0u, 0u, 0u, 0u};
    LDS_WAIT(); asm volatile("" ::: "memory");
    unsigned bp[32];
#pragma unroll
    for (int j0 = 0; j0 < 64; j0 += 8) {
        if (j0 < jb) {
#pragma unroll
            for (int j = j0; j < j0 + 8; ++j) { unsigned bb = (unsigned)fmaf(v[j], scale, off); bb = bb < 1023u ? bb : 1023u; __hip_atomic_fetch_add(hist + bb, 1u, __ATOMIC_RELAXED, __HIP_MEMORY_SCOPE_WORKGROUP);
                if (j & 1) bp[j >> 1] |= bb << 16; else bp[j >> 1] = bb; }
        } else if (j0 == jb) {
#pragma unroll
            for (int j = j0; j < j0 + 8; ++j) { unsigned bb = (unsigned)fmaf(v[j], scale, off); bb = bb < 1023u ? bb : 1023u; if (v[j] != NINF) __hip_atomic_fetch_add(hist + bb, 1u, __ATOMIC_RELAXED, __HIP_MEMORY_SCOPE_WORKGROUP);
                if (j & 1) bp[j >> 1] |= bb << 16; else bp[j >> 1] = bb; }
        } else {
#pragma unroll
            for (int j = j0; j < j0 + 8; j += 2) bp[j >> 1] = 0u;
        }
    }
    LDS_WAIT(); asm volatile("" ::: "memory");
    unsigned hb[16];
#pragma unroll
    for (int i = 0; i < 4; ++i) { const v4u q = ((const LAS v4u*)hist)[lane * 4 + i]; hb[4 * i] = q.x; hb[4 * i + 1] = q.y; hb[4 * i + 2] = q.z; hb[4 * i + 3] = q.w; }
    int own = 0;
#pragma unroll
    for (int i = 0; i < 16; ++i) own += (int)hb[i];
    int suf = own;
    suf += __builtin_amdgcn_update_dpp(0, suf, 0x101, 0xf, 0xf, true); suf += __builtin_amdgcn_update_dpp(0, suf, 0x102, 0xf, 0xf, true);
    suf += __builtin_amdgcn_update_dpp(0, suf, 0x104, 0xf, 0xf, true); suf += __builtin_amdgcn_update_dpp(0, suf, 0x108, 0xf, 0xf, true);
    { const int t1 = __builtin_amdgcn_readlane(suf, 16), t2 = __builtin_amdgcn_readlane(suf, 32), t3 = __builtin_amdgcn_readlane(suf, 48); const int rw = lane >> 4;
      suf += rw == 0 ? t1 + t2 + t3 : rw == 1 ? t2 + t3 : rw == 2 ? t3 : 0; }
    const u64 ge = __ballot(suf >= NSEL); const int L = 63 - __builtin_clzll(ge);
    int acc = suf - own, tb = 0, ca = 0, found = 0;
#pragma unroll
    for (int i = 15; i >= 0; --i) { if (!found) { if (acc + (int)hb[i] >= NSEL) { found = 1; tb = lane * 16 + i; ca = acc; } else acc += (int)hb[i]; } }
    const int TB = __builtin_amdgcn_readlane(tb, L), CA = __builtin_amdgcn_readlane(ca, L);
    const int need = NSEL - CA;
    int cbase = 0; unsigned mlo = 0u, mhi = 0u;
#pragma unroll
    for (int j0 = 0; j0 < 64; j0 += 8) {
        if (j0 <= jb) {
#pragma unroll
            for (int j = j0; j < j0 + 8; ++j) { const int bb = (int)((j & 1) ? (bp[j >> 1] >> 16) : (bp[j >> 1] & 0xffffu));
                const u64 am = __ballot(bb > TB); const u64 cm = __ballot(bb == TB);
                asm volatile("s_nop 4\n\tv_writelane_b32 %0, %2, %4\n\tv_writelane_b32 %1, %3, %4" : "+v"(mlo), "+v"(mhi) : "s"((unsigned)am), "s"((unsigned)(am >> 32)), "n"(j));
                if (cm) { const int pos = cbase + __popcll(cm & lt); if (bb == TB && pos < 64) { ckey[pos] = v[j]; cidx[pos] = lane + 64 * j; } cbase += __popcll(cm); } }
        }
    }
    LDS_WAIT(); asm volatile("" ::: "memory");
    if (cbase <= SEL_CAND_CAP) {
        LAS unsigned* mw = hist;
        mw[2 * lane] = mlo; mw[2 * lane + 1] = mhi;
        const float myk = lane < cbase ? ckey[lane] : NINF; const int myi = lane < cbase ? cidx[lane] : 0x7fffffff; int rank = 0;
        for (int c = 0; c < cbase; ++c) { const float ok = __builtin_bit_cast(float, __builtin_amdgcn_readlane(__builtin_bit_cast(int, myk), c)); const int oi = __builtin_amdgcn_readlane(myi, c); rank += (ok > myk || (ok == myk && oi < myi)) ? 1 : 0; }
        LDS_WAIT(); asm volatile("" ::: "memory");
        if (lane < cbase && rank < need && myk != NINF) __hip_atomic_fetch_or(mw + (myi >> 5), 1u << (myi & 31), __ATOMIC_RELAXED, __HIP_MEMORY_SCOPE_WORKGROUP);
        LDS_WAIT(); asm volatile("" ::: "memory");
        mrow[(size_t)lane * SEQ] = (u64)mw[2 * lane] | ((u64)mw[2 * lane + 1] << 32);
        LDS_WAIT(); asm volatile("" ::: "memory");
        return;
    }
    unsigned prefix = 0u;
    for (int bit = 31; bit >= 0; --bit) { const unsigned cand = prefix | (1u << bit); int cnt = 0;
#pragma unroll
        for (int j0 = 0; j0 < 64; j0 += 8) {
#pragma unroll
            for (int j = j0; j < j0 + 8; ++j) cnt += __popcll(__ballot(v[j] != NINF && sortable(v[j]) >= cand));
            __builtin_amdgcn_sched_barrier(0); }
        if (cnt >= NSEL) prefix = cand; }
    int ngt = 0;
#pragma unroll
    for (int j = 0; j < 64; ++j) ngt += __popcll(__ballot(v[j] != NINF && sortable(v[j]) > prefix));
    int rem = NSEL - ngt, last = 0;
#pragma unroll
    for (int j = 0; j < 64; ++j) { const u64 em = __ballot(v[j] != NINF && sortable(v[j]) == prefix); const int c = __popcll(em);
        if (rem > 0 && c > 0) { if (c >= rem) { u64 x = em; for (int q = 1; q < rem; ++q) x &= x - 1ull; last = 64 * j + __builtin_ctzll(x); rem = 0; } else rem -= c; } }
    const unsigned pb = (prefix & 0x80000000u) ? (prefix & 0x7fffffffu) : ~prefix; const float Tv = __builtin_bit_cast(float, pb); const int Tidx = last;
    mlo = 0u; mhi = 0u;
#pragma unroll
    for (int j = 0; j < 64; ++j) { const bool sel = (v[j] > Tv) || (v[j] == Tv && lane + 64 * j <= Tidx); const u64 m = __ballot(sel);
        asm volatile("s_nop 4\n\tv_writelane_b32 %0, %2, %4\n\tv_writelane_b32 %1, %3, %4" : "+v"(mlo), "+v"(mhi) : "s"((unsigned)m), "s"((unsigned)(m >> 32)), "n"(j)); }
    mrow[(size_t)lane * SEQ] = (u64)mlo | ((u64)mhi << 32);
    return;
    }
}
__device__ __forceinline__ float relu_i(float x) { const int b = __builtin_bit_cast(int, x); return __builtin_bit_cast(float, b > 0 ? b : 0); }
__device__ __forceinline__ void p_index(Frame& F) {
    const int wave = F.wave;
    const GAS bf16* PROJ = (const GAS bf16*)(F.ws + WS_PROJ); const GAS bf16* KIN = (const GAS bf16*)(F.ws + WS_KIN); GAS float* SC = (GAS float*)(F.ws + WS_SC); GAS unsigned* MASK = (GAS unsigned*)(F.ws + WS_MASK);
    LAS unsigned* hist = (LAS unsigned*)(F.lds + wave * 4096);
    LAS float* ckey = (LAS float*)(F.lds + 32768 + wave * 1024); LAS int* cidx = (LAS int*)(ckey + 64);
    for (int ui = 0; ui < 2; ++ui) {
        const int v = F.vcu; if (v >= 256) break;
        const int b = v & 3, j = v >> 2, qb = ui == 0 ? j : 127 - j, q0 = qb * 32;
        int lane = F.tid & 63; asm volatile("" : "+v"(lane)); const int l15 = lane & 15, l4 = lane >> 4;
        bf16x8 bq[2][8]; float wq[2][8];
#pragma unroll
        for (int hq = 0; hq < 2; ++hq) { const size_t rowq = (size_t)(b * SEQ + q0 + 16 * hq + l15);
#pragma unroll
            for (int h = 0; h < 8; ++h) { bq[hq][h] = *(const GAS bf16x8*)(PROJ + rowq * NINP + C_QI + h * 32 + 8 * l4); wq[hq][h] = bf2f(PROJ[rowq * NINP + C_WI + h]) * 0.0625f; } }
        GAS float* srow = SC + (size_t)(b * SEQ + q0 + l15) * SCS + 4 * l4;
        const int ktl = 2 * qb + 1; const GAS bf16* kin0 = KIN + (size_t)(b * SEQ + l15) * 32 + 8 * l4;
        bf16x8 a = *(const GAS bf16x8*)(kin0 + (size_t)((wave <= ktl ? wave : ktl) * 16) * 32);
        for (int kt = wave; kt <= ktl; kt += NWAVES) {
            const int ktn = kt + NWAVES <= ktl ? kt + NWAVES : kt;
            const bf16x8 an = *(const GAS bf16x8*)(kin0 + (size_t)(ktn * 16) * 32);
#pragma unroll
            for (int hq = 0; hq < 2; ++hq) { f32x4 sc = (f32x4){0.f, 0.f, 0.f, 0.f};
#pragma unroll
                for (int h = 0; h < 8; ++h) { const f32x4 d = __builtin_amdgcn_mfma_f32_16x16x32_bf16(a, bq[hq][h], (f32x4){0.f, 0.f, 0.f, 0.f}, 0, 0, 0);
                    sc.x += relu_i(d.x) * wq[hq][h]; sc.y += relu_i(d.y) * wq[hq][h]; sc.z += relu_i(d.z) * wq[hq][h]; sc.w += relu_i(d.w) * wq[hq][h]; }
                *(GAS f32x4*)(srow + (size_t)(16 * hq) * SCS + kt * 16) = sc; }
            a = an;
        }
        asm volatile("s_waitcnt vmcnt(0)" ::: "memory"); __syncthreads();
        int lane_s = F.tid & 63; asm volatile("" : "+v"(lane_s));
        for (int r = 0; r < 4; ++r) select_row(b * SEQ + q0 + wave * 4 + r, SC, MASK, hist, ckey, cidx, lane_s);
#ifdef EXP_DUP_SELECT
        for (int r = 0; r < 4; ++r) select_row(b * SEQ + q0 + wave * 4 + r, SC, MASK, hist, ckey, cidx, lane_s);
#endif
    }
}

namespace att {
typedef float f32x16 __attribute__((ext_vector_type(16)));
typedef short s16x4 __attribute__((ext_vector_type(4)));
constexpr int NSLOT = 3, SLOTB = 8192, LDS_K = 0, LDS_V = NSLOT * SLOTB, LDS_WS = 2 * NSLOT * SLOTB, LDS_OST = LDS_WS + 8 * 64 * 4, LDS_BYTES_ATT = LDS_OST + 8 * 4096;
constexpr float THR = 100.f;
__device__ __forceinline__ int crow(int r, int hi) { return (r & 3) + 8 * (r >> 2) + 4 * hi; }
__device__ __forceinline__ unsigned cvtpk(float lo, float hi) { typedef float f2 __attribute__((ext_vector_type(2))); typedef __bf16 b2 __attribute__((ext_vector_type(2))); f2 v = {lo, hi}; b2 b = __builtin_convertvector(v, b2); return __builtin_bit_cast(unsigned, b); }
__device__ __forceinline__ float rowmax(const f32x16& p0, const f32x16& p1) {
    float a = fmaxf(fmaxf(p0[0], p0[1]), p1[0]), b = fmaxf(fmaxf(p0[2], p0[3]), p1[1]); a = fmaxf(fmaxf(a, p1[2]), p1[3]);
#pragma unroll
    for (int r = 4; r < 16; r += 4) { a = fmaxf(fmaxf(a, p0[r]), p0[r + 1]); b = fmaxf(fmaxf(b, p0[r + 2]), p0[r + 3]); a = fmaxf(fmaxf(a, p1[r]), p1[r + 1]); b = fmaxf(fmaxf(b, p1[r + 2]), p1[r + 3]); }
    const float m = fmaxf(a, b);
    return fmaxf(m, __shfl_xor(m, 32));
}
__device__ __forceinline__ void pv(f32x16* o, int vb, bf16x8 pa0, bf16x8 pa1, bf16x8 pa2, bf16x8 pa3) {
#pragma unroll
    for (int d0 = 0; d0 < 2; ++d0) { s16x4 lo[4], hi[4];
#pragma unroll
        for (int ks = 0; ks < 4; ++ks) {
            asm volatile("ds_read_b64_tr_b16 %0,%1 offset:%c2" : "=&v"(lo[ks]) : "v"(vb), "i"(d0 * 4096 + ks * 1024) : "memory");
            asm volatile("ds_read_b64_tr_b16 %0,%1 offset:%c2" : "=&v"(hi[ks]) : "v"(vb), "i"(d0 * 4096 + ks * 1024 + 512) : "memory"); }
        asm volatile("s_waitcnt lgkmcnt(0)" ::: "memory"); __builtin_amdgcn_sched_barrier(0);
#define ATT_PK(k) (bf16x8){lo[k][0], lo[k][1], lo[k][2], lo[k][3], hi[k][0], hi[k][1], hi[k][2], hi[k][3]}
        o[d0] = __builtin_amdgcn_mfma_f32_32x32x16_bf16(pa0, ATT_PK(0), o[d0], 0, 0, 0);
        o[d0] = __builtin_amdgcn_mfma_f32_32x32x16_bf16(pa1, ATT_PK(1), o[d0], 0, 0, 0);
        o[d0] = __builtin_amdgcn_mfma_f32_32x32x16_bf16(pa2, ATT_PK(2), o[d0], 0, 0, 0);
        o[d0] = __builtin_amdgcn_mfma_f32_32x32x16_bf16(pa3, ATT_PK(3), o[d0], 0, 0, 0);
#undef ATT_PK
    }
}
}
template <bool grpB> __device__ __forceinline__ void attn_units(Frame& F, const float* wgu, const float* wdn, int l) {
    using namespace att;
    const int tid = F.tid, lane = tid & 63, r32 = lane & 31, hi = lane >> 5, wid = F.wave;
    const GAS bf16* PROJ = (const GAS bf16*)(F.ws + WS_PROJ); GAS bf16* CAT = (GAS bf16*)(F.ws + WS_CAT); const GAS u64* MASKT = (const GAS u64*)(F.ws + WS_MASK);
    LAS unsigned char* shm = F.lds;
    constexpr int NSV = 4, LDS_V2 = NSLOT * SLOTB, LDS_WS2 = LDS_V2 + NSV * SLOTB, LDS_OST2 = LDS_WS2 + 8 * 64 * 4;
    LAS float* wsf = (LAS float*)(shm + LDS_WS2) + wid * 64;
    const float NEGINF = -INFINITY;
    const int cslot = F.vcu % 3;
    for (int ui = 0; ui < 2; ++ui) {
        const int v = F.vcu; if (v >= 256) break;
        if (cslot == ui) convert_experts(F, wgu, wdn, l);
        const int bh = v >> 3, sidx = v & 7, b = bh >> 3, h = bh & 7, qb = ui == 0 ? sidx : 15 - sidx;
        const size_t rowbase = (size_t)b * SEQ; const int q0 = qb * 256, NT = (q0 + 256) / 64;
        const float slope2 = exp2f(-(float)(h + 1)) * 1.4426950408889634f;
        const GAS bf16* Kh = PROJ + rowbase * NINP + C_K + h * 64; const GAS bf16* Vh = PROJ + rowbase * NINP + C_V + h * 64;
        const GAS bf16* ksrc = Kh + (size_t)lane * NINP + wid * 8;
        const GAS bf16* vsrc = Vh + (size_t)(16 * (wid & 3) + (lane >> 2)) * NINP + (wid >> 2) * 32 + (lane & 3) * 8;
#define ATT_DMA(t, ks, vs) do { __builtin_amdgcn_global_load_lds((const GAS unsigned*)(ksrc + (size_t)(t) * 64 * NINP), (LAS unsigned*)(shm + LDS_K + (ks) * SLOTB + wid * 1024), 16, 0, 0); \
                        __builtin_amdgcn_global_load_lds((const GAS unsigned*)(vsrc + (size_t)(t) * 64 * NINP), (LAS unsigned*)(shm + LDS_V2 + (vs) * SLOTB + wid * 1024), 16, 0, 0); } while (0)
        ATT_DMA(0, 0, 0); ATT_DMA(1, 1, 1);
        const GAS bf16* Qw = PROJ + (rowbase + q0 + wid * 32) * NINP + C_Q + h * 64;
        bf16x8 qr[4];
#pragma unroll
        for (int d0 = 0; d0 < 4; ++d0) qr[d0] = *(const GAS bf16x8*)(Qw + (size_t)r32 * NINP + d0 * 16 + hi * 8);
        const GAS u64* mq = MASKT + ((size_t)b * 64) * SEQ + q0 + wid * 32 + r32;
        u64 mnext = mq[0], mprev = 0ull;
        f32x16 o[2], p0 = f32x16{}, p1 = f32x16{}; o[0] = f32x16{}; o[1] = f32x16{};
        float l_reg = 0.f, sq = 0.f;
        const unsigned sl_hi = __builtin_bit_cast(unsigned, slope2) & 0xffff0000u; const unsigned sl_lo = f2bf(slope2 - __builtin_bit_cast(float, sl_hi));
        bf16x8 kx0, kx1;
        { const unsigned j0 = hi ? 0u : (f2bf((float)r32) * 0x10001u), j1 = hi ? 0u : (f2bf((float)(r32 + 32)) * 0x10001u), one2 = hi ? 0u : 0x3f803f80u, one1 = hi ? 0u : 0x3f80u;
          kx0 = __builtin_bit_cast(bf16x8, (v4u){j0, one2, one1, 0u}); kx1 = __builtin_bit_cast(bf16x8, (v4u){j1, one2, one1, 0u}); }
        const int qlast = q0 + wid * 32 + 31;
        const int vb0 = (int)(unsigned)(uintptr_t)(shm + LDS_V2) + ((lane >> 4) & 1) * 32 + (lane & 3) * 8 + (4 * hi + ((lane & 15) >> 2)) * 64;
#define ATT_QK(ks) do { const LAS unsigned char* kb = shm + LDS_K + (ks) * SLOTB + hi * 1024 + r32 * 16; \
            { const unsigned u0_ = __builtin_bit_cast(unsigned, sq), a1_ = u0_ & 0xffff0000u; const float r1_ = sq - __builtin_bit_cast(float, a1_); const unsigned u1_ = __builtin_bit_cast(unsigned, r1_), a2_ = u1_ & 0xffff0000u; \
              const float r2_ = r1_ - __builtin_bit_cast(float, a2_); const unsigned a3_ = __builtin_bit_cast(unsigned, r2_) >> 16; \
              const bf16x8 qx = __builtin_bit_cast(bf16x8, (v4u){hi ? 0u : ((sl_hi >> 16) | (sl_lo << 16)), hi ? 0u : ((a1_ >> 16) | a2_), hi ? 0u : a3_, 0u}); \
              const f32x16 z_ = f32x16{}; p0 = __builtin_amdgcn_mfma_f32_32x32x16_bf16(kx0, qx, z_, 0, 0, 0); p1 = __builtin_amdgcn_mfma_f32_32x32x16_bf16(kx1, qx, z_, 0, 0, 0); } \
            _Pragma("unroll") for (int d0 = 0; d0 < 4; ++d0) { const bf16x8 k0 = *(const LAS bf16x8*)(kb + d0 * 2048), k1 = *(const LAS bf16x8*)(kb + d0 * 2048 + 512); \
                p0 = __builtin_amdgcn_mfma_f32_32x32x16_bf16(k0, qr[d0], p0, 0, 0, 0); p1 = __builtin_amdgcn_mfma_f32_32x32x16_bf16(k1, qr[d0], p1, 0, 0, 0); } } while (0)
#define ATT_SMPV(vs, mw) do { const unsigned w0 = (unsigned)(mw) >> (4 * hi), w1 = (unsigned)((mw) >> 32) >> (4 * hi); \
            asm volatile("s_nop 15\n\ts_nop 7" : "+v"(p0), "+v"(p1));   \
            _Pragma("unroll") for (int r = 0; r < 16; ++r) { const int cr = (r & 3) + 8 * (r >> 2); const int k0_ = __builtin_amdgcn_sbfe((int)w0, cr, 1), k1_ = __builtin_amdgcn_sbfe((int)w1, cr, 1); \
                asm("v_bfi_b32 %0, %1, %0, %2" : "+v"(p0[r]) : "v"(k0_), "v"(NEGINF)); asm("v_bfi_b32 %0, %1, %0, %2" : "+v"(p1[r]) : "v"(k1_), "v"(NEGINF)); } \
            const float rm = rowmax(p0, p1); bool resc = false; \
            if (__any(rm > THR)) { const float dl = fmaxf(rm, 0.f); \
                _Pragma("unroll") for (int r = 0; r < 16; ++r) { p0[r] -= dl; p1[r] -= dl; } sq -= dl; \
                const float f = __builtin_amdgcn_exp2f(-dl); l_reg *= f; if (hi == 0) wsf[r32] = f; resc = true; } \
            float sacc = 0.f; \
            _Pragma("unroll") for (int r = 0; r < 16; ++r) { p0[r] = __builtin_amdgcn_exp2f(p0[r]); p1[r] = __builtin_amdgcn_exp2f(p1[r]); sacc += p0[r] + p1[r]; } \
            l_reg += sacc; \
            if (resc) { asm volatile("s_waitcnt lgkmcnt(0)" ::: "memory"); \
                _Pragma("unroll") for (int d_ = 0; d_ < 2; ++d_) _Pragma("unroll") for (int r = 0; r < 16; ++r) o[d_][r] *= wsf[crow(r, hi)]; } \
            const v4u pw0 = (v4u){cvtpk(p0[0], p0[1]), cvtpk(p0[2], p0[3]), cvtpk(p0[4], p0[5]), cvtpk(p0[6], p0[7])}, pw1 = (v4u){cvtpk(p0[8], p0[9]), cvtpk(p0[10], p0[11]), cvtpk(p0[12], p0[13]), cvtpk(p0[14], p0[15])}; \
            const v4u pw2 = (v4u){cvtpk(p1[0], p1[1]), cvtpk(p1[2], p1[3]), cvtpk(p1[4], p1[5]), cvtpk(p1[6], p1[7])}, pw3 = (v4u){cvtpk(p1[8], p1[9]), cvtpk(p1[10], p1[11]), cvtpk(p1[12], p1[13]), cvtpk(p1[14], p1[15])}; \
            __builtin_amdgcn_sched_barrier(0); \
            pv(o, vb0 + (vs) * SLOTB, __builtin_bit_cast(bf16x8, pw0), __builtin_bit_cast(bf16x8, pw1), __builtin_bit_cast(bf16x8, pw2), __builtin_bit_cast(bf16x8, pw3)); } while (0)
        if constexpr (grpB) __builtin_amdgcn_s_setprio(1);
        const float step = 64.f * slope2;
        int ks = 0, vs = 0;
        u64 mcur = 0ull;
#define ATT_SYNC(t) do { if ((t) + 1 < NT) asm volatile("s_waitcnt vmcnt(2)" ::: "memory"); else asm volatile("s_waitcnt vmcnt(0)" ::: "memory"); \
            asm volatile("s_waitcnt lgkmcnt(0)" ::: "memory"); __builtin_amdgcn_s_barrier(); asm volatile("" ::: "memory"); \
            mprev = mcur; mcur = mnext; if ((t) + 1 < NT) mnext = mq[(size_t)((t) + 1) * SEQ]; \
            __builtin_amdgcn_sched_barrier(0); \
            if ((t) + 2 < NT) ATT_DMA((t) + 2, ks + 2 >= NSLOT ? ks + 2 - NSLOT : ks + 2, vs + 2 >= NSV ? vs + 2 - NSV : vs + 2); \
            __builtin_amdgcn_sched_barrier(0); } while (0)
#define ATT_ADV() do { sq += step; ks = ks + 1 >= NSLOT ? 0 : ks + 1; vs = vs + 1 >= NSV ? 0 : vs + 1; } while (0)
        const int tmax = qlast >> 6;
        if constexpr (!grpB) {
            int t = 0;
            for (; t <= tmax; ++t) { ATT_SYNC(t); ATT_QK(ks); ATT_SMPV(vs, mcur); ATT_ADV(); }
            for (; t < NT; ++t) { ATT_SYNC(t); ATT_ADV(); }
        } else {
            ATT_SYNC(0); ATT_QK(ks); ATT_ADV();
            int t = 1;
            for (; t <= tmax; ++t) { ATT_SYNC(t); ATT_SMPV(vs == 0 ? NSV - 1 : vs - 1, mprev); ATT_QK(ks); ATT_ADV(); }
            if (t < NT) { ATT_SYNC(t); ATT_SMPV(vs == 0 ? NSV - 1 : vs - 1, mprev); ATT_ADV(); ++t;
                for (; t < NT; ++t) { ATT_SYNC(t); ATT_ADV(); } }
            else { ATT_SMPV(vs == 0 ? NSV - 1 : vs - 1, mcur); }
        }
#undef ATT_SYNC
#undef ATT_ADV
        __builtin_amdgcn_s_setprio(0);
        l_reg += __shfl_xor(l_reg, 32);
        if (hi == 0) wsf[32 + r32] = l_reg;
        asm volatile("s_waitcnt lgkmcnt(0)" ::: "memory");
        float rli[16];
#pragma unroll
        for (int r = 0; r < 16; ++r) rli[r] = 1.f / wsf[32 + crow(r, hi)];
        GAS bf16* Ow = CAT + (rowbase + q0 + wid * 32) * D + 512 + h * 64;
        { LAS bf16* stg = (LAS bf16*)(shm + LDS_OST2) + wid * 2048;
#pragma unroll
            for (int r = 0; r < 16; ++r) { const int orow = crow(r, hi);
#pragma unroll
                for (int d0 = 0; d0 < 2; ++d0) stg[orow * 64 + d0 * 32 + r32] = (bf16)f2bf(o[d0][r] * rli[r]); }
            asm volatile("s_waitcnt lgkmcnt(0)" ::: "memory");
#pragma unroll
            for (int i = 0; i < 4; ++i) { const int row = i * 8 + (lane >> 3), ch = lane & 7; const v4u vv = *(const LAS v4u*)(stg + row * 64 + ch * 8); *(GAS v4u*)(Ow + (size_t)row * D + ch * 8) = vv; } }
        asm volatile("s_waitcnt vmcnt(0) lgkmcnt(0)" ::: "memory"); __builtin_amdgcn_s_barrier(); asm volatile("" ::: "memory");
#undef ATT_DMA
#undef ATT_QK
#undef ATT_SMPV
    }
    if (cslot == 2) convert_experts(F, wgu, wdn, l);
}

__device__ __forceinline__ void p_attn_dense(Frame& F, const float* wgu, const float* wdn, int l) { if (F.wave >= 4) attn_units<true>(F, wgu, wdn, l); else attn_units<false>(F, wgu, wdn, l); }

struct EpiResid {
    static constexpr bool PERM = true, AFTER_DRAIN = false;
    const bf16* resid; bf16* out; float alpha;
    __device__ __forceinline__ void operator()(const pg8::f32x4 (&acc)[2][2][4][2], const pg8::Unit& u, int wr, int wc, int fr, int fq) const {
        const int col0 = u.pn * 256 + wc * 32 + 8 * fq;
#pragma unroll
        for (int ai = 0; ai < 2; ++ai)
#pragma unroll
            for (int m = 0; m < 4; ++m) { const size_t off = (size_t)(u.pm * 256 + ai * 128 + wr * 64 + m * 16 + fr) * D + col0;
#pragma unroll
                for (int bj = 0; bj < 2; ++bj) { const v4u xr = *(const GAS v4u*)(resid + off + bj * 128); const f32x4 a0 = acc[ai][bj][m][0], a1 = acc[ai][bj][m][1];
                    v4u w; w.x = pk2(bflo(xr.x) * alpha + a0[0], bfhi(xr.x) * alpha + a0[1]); w.y = pk2(bflo(xr.y) * alpha + a0[2], bfhi(xr.y) * alpha + a0[3]);
                    w.z = pk2(bflo(xr.z) * alpha + a1[0], bfhi(xr.z) * alpha + a1[1]); w.w = pk2(bflo(xr.w) * alpha + a1[2], bfhi(xr.w) * alpha + a1[3]);
                    st16_wt(out + off + bj * 128, w.x, w.y, w.z, w.w); }
                if (m & 1) asm volatile("" ::: "memory"); }
    }
};
struct EpiSwiglu {
    static constexpr bool PERM = true, AFTER_DRAIN = false;
    unsigned char* O; const float* bias;
    __device__ __forceinline__ void operator()(const pg8::f32x4 (&acc)[2][2][4][2], const pg8::Unit& u, int wr, int wc, int fr, int fq) const {
        const int e = u.pn >> 3, nt = u.pn & 7; const int colg = nt * 128 + wc * 32 + 8 * fq;
        f32x4 bg[2], bu[2];
#pragma unroll
        for (int n = 0; n < 2; ++n) { bg[n] = *(const GAS f32x4*)(bias + (size_t)e * 2048 + colg + 4 * n); bu[n] = *(const GAS f32x4*)(bias + (size_t)e * 2048 + 1024 + colg + 4 * n); }
#pragma unroll
        for (int ai = 0; ai < 2; ++ai)
#pragma unroll
            for (int m = 0; m < 4; ++m) { const size_t row = (size_t)(u.pm * 256 + ai * 128 + wr * 64 + m * 16 + fr); float a8[8];
#pragma unroll
                for (int n = 0; n < 2; ++n)
#pragma unroll
                    for (int i = 0; i < 4; i += 2) {
                        typedef float f2 __attribute__((ext_vector_type(2)));
                        const f2 ag = {acc[ai][0][m][n][i], acc[ai][0][m][n][i + 1]}, au = {acc[ai][1][m][n][i], acc[ai][1][m][n][i + 1]};
                        const f2 bgv = {bg[n][i], bg[n][i + 1]}, buv = {bu[n][i] + 1.f, bu[n][i + 1] + 1.f};
                        f2 g = ag * (1.f / WGU_SCALE) + bgv, up1 = au * (1.f / WGU_SCALE) + buv;
                        g.x = fminf(g.x, 7.f); g.y = fminf(g.y, 7.f); up1.x = fminf(fmaxf(up1.x, -6.f), 8.f); up1.y = fminf(fmaxf(up1.y, -6.f), 8.f);
                        f2 t = g * (-1.702f * 1.4426950408889634f); t.x = __builtin_amdgcn_exp2f(t.x); t.y = __builtin_amdgcn_exp2f(t.y);
                        f2 d = t + 1.f; d.x = __builtin_amdgcn_rcpf(d.x); d.y = __builtin_amdgcn_rcpf(d.y);
                        const f2 r = g * up1 * d; a8[n * 4 + i] = r.x; a8[n * 4 + i + 1] = r.y; }
                v2u w; w.x = pk4_fp8(a8[0], a8[1], a8[2], a8[3]); w.y = pk4_fp8(a8[4], a8[5], a8[6], a8[7]);
                st8_wt(O + row * 1024 + colg, w.x, w.y); }
    }
};
struct EpiDown {
    static constexpr bool PERM = true, AFTER_DRAIN = false;
    unsigned char* O; const float* bias;
    __device__ __forceinline__ void operator()(const pg8::f32x4 (&acc)[2][2][4][2], const pg8::Unit& u, int wr, int wc, int fr, int fq) const {
        const int col0 = (u.pn & 3) * 256 + wc * 32 + 8 * fq; const float* bp = bias + (size_t)(u.pn >> 2) * 1024 + col0;
        f32x4 bv[2][2];
#pragma unroll
        for (int bj = 0; bj < 2; ++bj)
#pragma unroll
            for (int n = 0; n < 2; ++n) bv[bj][n] = *(const GAS f32x4*)(bp + bj * 128 + 4 * n);
#pragma unroll
        for (int ai = 0; ai < 2; ++ai)
#pragma unroll
            for (int m = 0; m < 4; ++m) { unsigned char* rowp = O + (size_t)(u.pm * 256 + ai * 128 + wr * 64 + m * 16 + fr) * 1024 + col0;
#pragma unroll
                for (int bj = 0; bj < 2; ++bj) { const f32x4 v0 = acc[ai][bj][m][0] * (1.f / WDN_SCALE) + bv[bj][0], v1 = acc[ai][bj][m][1] * (1.f / WDN_SCALE) + bv[bj][1];
                    st8_wt(rowp + bj * 128, pk4_fp8(v0[0], v0[1], v0[2], v0[3]), pk4_fp8(v1[0], v1[1], v1[2], v1[3])); } }
    }
};
struct MoeSched {
    const LAS int* tab; int n;
    __device__ __forceinline__ bool next(int i, pg8::Unit& u) const {
        if (i >= n) return false;
        const int v = __builtin_amdgcn_readfirstlane(tab[1 + i]); u.pm = v >> 16; u.pn = v & 0xffff; return true;
    }
    __device__ __forceinline__ void a_ready(const pg8::Unit&) const {}
    __device__ __forceinline__ void done(const pg8::Unit&) const {}
};
#ifndef MOE_UNIT_OWNER
#define MOE_UNIT_OWNER F.vcu
#endif
__device__ __forceinline__ int moe_table(Frame& F, int l, int ntn) {
    LAS int* tab = (LAS int*)(F.lds + TAB_OFF);
    if (F.wave == 0) {
        const int lane = F.lane; const int cnt = lane < NE ? (int)__hip_atomic_load(F.ctl + CW_CNT + 64 * l + lane, RLX_AGENT) : 0; const int mt = (cnt + 255) >> 8; int incl = mt;
#pragma unroll
        for (int o = 1; o < 64; o <<= 1) { const int v = __shfl_up(incl, o); if (lane >= o) incl += v; }
        const int total = __shfl(incl, 63) * ntn; const int c = MOE_UNIT_OWNER;
        const int xcd = c >> 5, jw = c & 31, uq = total >> 3, ur = total & 7, cntx = uq + (xcd < ur ? 1 : 0), basex = xcd * uq + (xcd < ur ? xcd : ur);
        const int nmine = jw < cntx ? (cntx - jw + 31) >> 5 : 0;
        for (int i0 = 0; i0 < nmine && i0 < 200; i0 += 64) { const int i = i0 + lane; const int L = basex + i * 32 + jw; int e = 0;
            for (int k = 0; k < NE; ++k) { const int endk = __shfl(incl, k) * ntn; e += (L >= endk) ? 1 : 0; }
            e = e < NE ? e : NE - 1;
            const int excl_e = __shfl(incl, e) - __shfl(mt, e); int mte = __shfl(mt, e); mte = mte > 0 ? mte : 1; const int idx = L - excl_e * ntn;
            if (i < nmine && i < 200) tab[1 + i] = ((excl_e + idx % mte) << 16) | (e * ntn + idx / mte); }
        if (lane == 0) tab[0] = nmine < 200 ? nmine : 200;
    }
    __syncthreads();
    return __builtin_amdgcn_readfirstlane(tab[0]);
}

__device__ __forceinline__ void p_router(Frame& F, const In6& A, int l) {
    const int lane = F.lane, wave = F.wave, tid = F.tid;
    constexpr int XROW = 2064;
    LAS unsigned char* XH = F.lds; LAS unsigned char* XL = F.lds + 16 * XROW;
    LAS float* part = (LAS float*)(F.lds + 2 * 16 * XROW);
    LAS int* cnt = (LAS int*)(F.lds + 2 * 16 * XROW + 16384);
    LAS float* lgs = (LAS float*)(F.lds + 2 * 16 * XROW + 16384 + 1024);
    LAS float* top = lgs + 512;
    const GAS bf16* Y1 = (const GAS bf16*)(F.ws + WS_Y1); GAS bf16* X1B = (GAS bf16*)(F.ws + WS_Y1 + 32 * MiB); GAS unsigned* XB8 = (GAS unsigned*)(F.ws + WS_XB8);
    GAS int* TOPE = (GAS int*)(F.ws + WS_ROUTE); GAS float* GATE = (GAS float*)(TOPE + 8 * T); GAS int* CNTW = (GAS int*)(F.ws + WS_CNTW);
    const GAS float* g1 = (const GAS float*)(A.p[0] + l * D); const GAS float* b1 = (const GAS float*)(A.p[1] + l * D);
    const GAS float* RW = (const GAS float*)(A.p[2] + (size_t)l * D * NE); const GAS float* RB = (const GAS float*)(A.p[3] + l * NE);
    if (tid < 256) cnt[tid] = 0;
    bf16x8 wh[4][2], wl[4][2];
#pragma unroll
    for (int st = 0; st < 4; ++st)
#pragma unroll
        for (int hf = 0; hf < 2; ++hf) { const GAS float* wp = RW + (size_t)(wave * 128 + st * 32 + (lane >> 4) * 8) * NE + (lane & 15) + 16 * hf;
#pragma unroll
            for (int j = 0; j < 8; ++j) { const float w = wp[(size_t)j * NE]; const unsigned h = f2bf(w); const float r = w - __builtin_bit_cast(float, h << 16); wh[st][hf][j] = (short)h; wl[st][hf][j] = (short)f2bf(r); } }
    f32x4 g1v[4], b1v[4];
#pragma unroll
    for (int j = 0; j < 4; ++j) { g1v[j] = ((const GAS f32x4*)g1)[lane + 64 * j]; b1v[j] = ((const GAS f32x4*)b1)[lane + 64 * j]; }
    const float rb_e = RB[tid & 31];
    v2u yq[2][4];
#pragma unroll
    for (int i = 0; i < 2; ++i) { const GAS v2u* yr = (const GAS v2u*)(Y1 + (size_t)(F.vcu * 64 + wave * 2 + i) * D) + lane;
#pragma unroll
        for (int j = 0; j < 4; ++j) yq[i][j] = yr[64 * j]; }
    for (int g = 0; g < 4; ++g) {
        const int t0 = F.vcu * 64 + g * 16;
#pragma unroll
        for (int i = 0; i < 2; ++i) { const int tl = wave * 2 + i, t = t0 + tl;
            GAS u64* xr1 = (GAS u64*)(X1B + (size_t)t * D) + lane; f32x4 v[4]; float s = 0.f;
#pragma unroll
            for (int j = 0; j < 4; ++j) { const v2u q = yq[i][j]; v[j] = (f32x4){bflo(q.x), bfhi(q.x), bflo(q.y), bfhi(q.y)}; s += (v[j].x + v[j].y) + (v[j].z + v[j].w); }
            if (g < 3) { const GAS v2u* yr = (const GAS v2u*)(Y1 + (size_t)(t + 16) * D) + lane;
#pragma unroll
                for (int j = 0; j < 4; ++j) yq[i][j] = yr[64 * j]; }
            const float mean = wave_sum(s) * (1.f / D); float s2 = 0.f;
#pragma unroll
            for (int j = 0; j < 4; ++j) { v[j] = v[j] - mean; s2 += (v[j].x * v[j].x + v[j].y * v[j].y) + (v[j].z * v[j].z + v[j].w * v[j].w); }
            const float rstd = rsqrtf(wave_sum(s2) * (1.f / D) + LN_EPS);
            GAS unsigned* o8 = XB8 + (size_t)t * (D / 4) + lane;
#pragma unroll
            for (int j = 0; j < 4; ++j) { const f32x4 y = v[j] * rstd * g1v[j] + b1v[j];
                o8[64 * j] = pk4_fp8(y.x, y.y, y.z, y.w);
                const unsigned h0 = f2bf(y.x), h1 = f2bf(y.y), h2 = f2bf(y.z), h3 = f2bf(y.w);
                const u64 hp = (u64)(h0 | (h1 << 16)) | ((u64)(h2 | (h3 << 16)) << 32); xr1[64 * j] = hp;
                const float r0 = y.x - __builtin_bit_cast(float, h0 << 16), r1 = y.y - __builtin_bit_cast(float, h1 << 16), r2 = y.z - __builtin_bit_cast(float, h2 << 16), r3 = y.w - __builtin_bit_cast(float, h3 << 16);
                *(LAS u64*)(XH + tl * XROW + (lane + 64 * j) * 8) = hp;
                *(LAS u64*)(XL + tl * XROW + (lane + 64 * j) * 8) = (u64)pk2(r0, r1) | ((u64)pk2(r2, r3) << 32); } }
        __syncthreads();
        f32x4 acc[2]; acc[0] = (f32x4){0.f, 0.f, 0.f, 0.f}; acc[1] = acc[0];
#pragma unroll
        for (int st = 0; st < 4; ++st) { const int boff = (lane & 15) * XROW + (wave * 128 + st * 32 + (lane >> 4) * 8) * 2;
            const bf16x8 bh = *(const LAS bf16x8*)(XH + boff), bl = *(const LAS bf16x8*)(XL + boff);
#pragma unroll
            for (int hf = 0; hf < 2; ++hf) { acc[hf] = __builtin_amdgcn_mfma_f32_16x16x32_bf16(wh[st][hf], bh, acc[hf], 0, 0, 0); acc[hf] = __builtin_amdgcn_mfma_f32_16x16x32_bf16(wh[st][hf], bl, acc[hf], 0, 0, 0);
                acc[hf] = __builtin_amdgcn_mfma_f32_16x16x32_bf16(wl[st][hf], bh, acc[hf], 0, 0, 0); } }
#pragma unroll
        for (int hf = 0; hf < 2; ++hf)
#pragma unroll
            for (int r = 0; r < 4; ++r) part[((wave * 2 + hf) * 16 + 4 * (lane >> 4) + r) * 16 + (lane & 15)] = acc[hf][r];
        __syncthreads();
        { const int tl = tid >> 5, e = tid & 31, t = t0 + tl; float lg = rb_e;
#pragma unroll
            for (int w = 0; w < 8; ++w) lg += part[((w * 2 + (e >> 4)) * 16 + (e & 15)) * 16 + tl];
            lgs[tl * 32 + e] = lg;
            LDS_WAIT(); asm volatile("" ::: "memory");
            int rank = 0;
#pragma unroll
            for (int q = 0; q < 8; ++q) { const f32x4 o = *(const LAS f32x4*)(lgs + tl * 32 + 4 * q);
#pragma unroll
                for (int i = 0; i < 4; ++i) { const int eo = 4 * q + i; rank += (o[i] > lg || (o[i] == lg && eo < e)) ? 1 : 0; } }
            if (rank < 4) { top[tl * 4 + rank] = lg; __hip_atomic_fetch_add(cnt + ((g * 16 + tl) >> 3) * 32 + e, 1, __ATOMIC_RELAXED, __HIP_MEMORY_SCOPE_WORKGROUP); }
            LDS_WAIT(); asm volatile("" ::: "memory");
            const f32x4 sv = *(const LAS f32x4*)(top + tl * 4);
            const float e1 = expf(sv[1] - sv[0]), e2 = expf(sv[2] - sv[0]), e3 = expf(sv[3] - sv[0]); const float inv = 1.f / (1.f + e1 + e2 + e3);
            if (rank < 4) { const float gk = (rank == 0 ? 1.f : rank == 1 ? e1 : rank == 2 ? e2 : e3) * inv; TOPE[4 * t + rank] = e; GATE[4 * t + rank] = gk; } }
    }
    __syncthreads();
    if (tid < 256) CNTW[(F.vcu * NWAVES + (tid >> 5)) * NE + (tid & 31)] = cnt[tid];
    __syncthreads();
}

__device__ __forceinline__ void p_gather(Frame& F, int l) {
    const int gw = F.vcu * NWAVES + F.wave, NGW = F.G * NWAVES, lane = F.lane, tid = F.tid;
    const int TPW = T / NGW, NIT = TPW * 4;
    const GAS int* CNTW = (const GAS int*)(F.ws + WS_CNTW);
    LAS int* red = (LAS int*)F.lds;
    LAS int* baseE = red + 1024; LAS int* totE = baseE + 32;
    { const int e = tid & 31, part = tid >> 5, first = F.vcu * NWAVES; int sb = 0, st = 0;
        for (int g0 = part; g0 < NGW; g0 += 256) { int c[16];
#pragma unroll
            for (int k = 0; k < 16; ++k) c[k] = g0 + 16 * k < NGW ? CNTW[(g0 + 16 * k) * NE + e] : 0;
#pragma unroll
            for (int k = 0; k < 16; ++k) { st += c[k]; sb += g0 + 16 * k < first ? c[k] : 0; } }
        red[part * 32 + e] = sb; red[512 + part * 32 + e] = st; }
    __syncthreads();
    if (tid < 32) { int sb = 0, st = 0;
#pragma unroll
        for (int p = 0; p < 16; ++p) { sb += red[p * 32 + tid]; st += red[512 + p * 32 + tid]; }
        baseE[tid] = sb; totE[tid] = st;
        if (F.vcu == 0) __hip_atomic_store(F.ctl + CW_CNT + 64 * l + tid, (unsigned)st, RLX_AGENT); }
    __syncthreads();
    int mybase = 0, tot = 0;
    if (lane < NE) { mybase = baseE[lane]; tot = totE[lane]; int cw[NWAVES - 1];
#pragma unroll
        for (int w = 0; w < NWAVES - 1; ++w) cw[w] = CNTW[(F.vcu * NWAVES + w) * NE + lane];
#pragma unroll
        for (int w = 0; w < NWAVES - 1; ++w) mybase += w < F.wave ? cw[w] : 0; }
    const int mt = (tot + 255) >> 8; int incl = mt;
#pragma unroll
    for (int o = 1; o < 64; o <<= 1) { const int v = __shfl_up(incl, o); if (lane >= o) incl += v; }
    const int pstart = (incl - mt) * 256;
    const GAS int* TOPE = (const GAS int*)(F.ws + WS_ROUTE); GAS int* ROWOF = (GAS int*)(F.ws + WS_ROUTE) + 12 * T; GAS int* ROWTOK = (GAS int*)(F.ws + WS_XS);
    if (F.vcu < NE && F.wave == 0) {
        const int e = F.vcu; const int ps = __builtin_amdgcn_readlane(pstart, e), te = __builtin_amdgcn_readlane(tot, e), me = __builtin_amdgcn_readlane(mt, e);
        for (int i = te + lane; i < me * 256; i += 64) ROWTOK[ps + i] = 0; }
    const int it0 = gw * NIT; const int ei = lane < NIT ? TOPE[it0 + lane] : 0; int rk = 0;
    for (int j = 0; j < NIT; ++j) { const int ej = __shfl(ei, j); rk += (j < lane && ej == ei) ? 1 : 0; }
    const int row = __shfl(pstart, ei) + __shfl(mybase, ei) + rk;
    if (lane < NIT) { ROWOF[it0 + lane] = row; ROWTOK[row] = (it0 + lane) >> 2; }
    __syncthreads();
}

__device__ __forceinline__ void p_combine(Frame& F, const In6& A, int l, float* xout_) {
    constexpr int TPW = 8;
    const int gw = F.vcu * NWAVES + F.wave, NGW = F.G * NWAVES, lane = F.lane;
    const GAS int* ROWOF = (const GAS int*)(F.ws + WS_ROUTE) + 12 * T; const GAS float* GATE = (const GAS float*)(F.ws + WS_ROUTE) + 8 * T;
    const GAS bf16* X1B = (const GAS bf16*)(F.ws + WS_Y1 + 32 * MiB); const GAS unsigned char* YS = (const GAS unsigned char*)(F.ws + WS_YS); GAS bf16* XB = (GAS bf16*)(F.ws + WS_XB);
    GAS float* xout = (GAS float*)xout_;
    const GAS f32x4* g2 = (const GAS f32x4*)(A.p[0] + l * D) + lane; const GAS f32x4* b2 = (const GAS f32x4*)(A.p[1] + l * D) + lane;
    int rowv = 0; float gatev = 0.f;
    if (lane < 4 * TPW) { const int tk = gw + (lane >> 2) * NGW; rowv = ROWOF[4 * tk + (lane & 3)]; gatev = GATE[4 * tk + (lane & 3)]; }
    f32x4 gg[4], bb[4];
#pragma unroll
    for (int j = 0; j < 4; ++j) { gg[j] = g2[64 * j]; bb[j] = b2[64 * j]; }
    v2u xq[2][4]; unsigned yq[2][4][4];
#define CMB_ISSUE(k, bf) do { const int t_ = gw + (k) * NGW; const GAS v2u* xr_ = (const GAS v2u*)(X1B + (size_t)t_ * D) + lane; \
        _Pragma("unroll") for (int j = 0; j < 4; ++j) xq[bf][j] = xr_[64 * j]; \
        _Pragma("unroll") for (int c = 0; c < 4; ++c) { const int row_ = __builtin_amdgcn_readlane(rowv, 4 * (k) + c); const GAS unsigned* yr_ = (const GAS unsigned*)(YS + (size_t)row_ * D) + lane; \
            _Pragma("unroll") for (int j = 0; j < 4; ++j) yq[bf][c][j] = yr_[64 * j]; } } while (0)
    CMB_ISSUE(0, 0);
#pragma unroll
    for (int k = 0; k < TPW; ++k) {
        const int bf = k & 1, t = gw + k * NGW;
        if (k + 1 < TPW) { if (bf == 0) CMB_ISSUE(k + 1, 1); else CMB_ISSUE(k + 1, 0); }
        f32x4 v[4];
#pragma unroll
        for (int j = 0; j < 4; ++j) { const v2u q = xq[bf][j]; v[j] = (f32x4){bflo(q.x), bfhi(q.x), bflo(q.y), bfhi(q.y)} * DN_ALPHA; }
#pragma unroll
        for (int c = 0; c < 4; ++c) { const float gk = __builtin_bit_cast(float, __builtin_amdgcn_readlane(__builtin_bit_cast(int, gatev), 4 * k + c));
#pragma unroll
            for (int j = 0; j < 4; ++j) { const int w = (int)yq[bf][c][j]; v[j].x += gk * __builtin_amdgcn_cvt_f32_fp8(w, 0); v[j].y += gk * __builtin_amdgcn_cvt_f32_fp8(w, 1); v[j].z += gk * __builtin_amdgcn_cvt_f32_fp8(w, 2); v[j].w += gk * __builtin_amdgcn_cvt_f32_fp8(w, 3); } }
        float s = 0.f;
#pragma unroll
        for (int j = 0; j < 4; ++j) s += (v[j].x + v[j].y) + (v[j].z + v[j].w);
        const float mean = wave_sum(s) * (1.f / D); float s2 = 0.f;
#pragma unroll
        for (int j = 0; j < 4; ++j) { v[j] = v[j] - mean; s2 += (v[j].x * v[j].x + v[j].y * v[j].y) + (v[j].z * v[j].z + v[j].w * v[j].w); }
        const float rstd = rsqrtf(wave_sum(s2) * (1.f / D) + LN_EPS);
        GAS f32x4* orow = (GAS f32x4*)(xout + (size_t)t * D) + lane; GAS u64* o8 = (GAS u64*)(XB + (size_t)t * D) + lane;
#pragma unroll
        for (int j = 0; j < 4; ++j) { const f32x4 y = v[j] * rstd * gg[j] + bb[j];
            if (xout_) __builtin_nontemporal_store(y, orow + 64 * j); else o8[64 * j] = (u64)pk2(y.x, y.y) | ((u64)pk2(y.z, y.w) << 32); }
        __builtin_amdgcn_sched_barrier(0);
    }
#undef CMB_ISSUE
}


#define NI __device__ __forceinline__
NI void ph_prologue(unsigned char* ws, LAS unsigned char* lds, const float* a0, const float* a1, const float* a2, const float* a3, const float* a4) { Frame F = make_frame(ws, lds); In6 I{{uni(a0), uni(a1), uni(a2), uni(a3), uni(a4), nullptr}}; p_prologue(F, I); }
NI void ph_local(unsigned char* ws, LAS unsigned char* lds, int l, const float* a0, const float* a1, const float* a2, const float* a3, const float* a4) { Frame F = make_frame(ws, lds); In6 I{{uni(a0), uni(a1), uni(a2), uni(a3), uni(a4), nullptr}}; p_local(F, I, __builtin_amdgcn_readfirstlane(l)); }
NI void ph_scores(unsigned char* ws, LAS unsigned char* lds) { Frame F = make_frame(ws, lds); p_index(F); }
NI void ph_attn(unsigned char* ws, LAS unsigned char* lds, int l, const float* a0, const float* a1) { Frame F = make_frame(ws, lds); p_attn_dense(F, uni(a0), uni(a1), __builtin_amdgcn_readfirstlane(l)); }
NI void ph_router(unsigned char* ws, LAS unsigned char* lds, int l, const float* a0, const float* a1, const float* a2, const float* a3) { Frame F = make_frame(ws, lds); In6 I{{uni(a0), uni(a1), uni(a2), uni(a3), nullptr, nullptr}}; p_router(F, I, __builtin_amdgcn_readfirstlane(l)); }
NI void ph_gather(unsigned char* ws, LAS unsigned char* lds, int l) { Frame F = make_frame(ws, lds); p_gather(F, __builtin_amdgcn_readfirstlane(l)); }
NI void ph_combine(unsigned char* ws, LAS unsigned char* lds, int l, const float* a0, const float* a1, float* xout) { Frame F = make_frame(ws, lds); In6 I{{uni(a0), uni(a1), nullptr, nullptr, nullptr, nullptr}}; p_combine(F, I, __builtin_amdgcn_readfirstlane(l), (float*)uni(xout)); }

NI void ph_gemm_in(unsigned char* ws, LAS unsigned char* lds, int l_) {
    Frame F = make_frame(ws, lds); const int l = __builtin_amdgcn_readfirstlane(l_);
    pg8::Gemm g{WSP(bf16, WS_XB), WSP(bf16, WS_WIN) + (size_t)l * NINP * D, T, NINP, D}; pg8::StaticOrder S; S.init(T, NINP, F.G, (int)blockIdx.x);
    pg8::EpiBf16<0> E{WSP(bf16, WS_PROJ), NINP, nullptr, 0, 0, 1.f};
    pg8::gemm_phase<pg8::EpiBf16<0>, pg8::StaticOrder, PG8_ALIGN, PG8_SP2>(F.lds, g, S, E);
}
NI void ph_gemm_out(unsigned char* ws, LAS unsigned char* lds, int l_, const float* xin) {
    Frame F = make_frame(ws, lds); const int l = __builtin_amdgcn_readfirstlane(l_);
    pg8::Gemm g{WSP(bf16, WS_CAT), WSP(bf16, WS_WOUT) + (size_t)l * D * D, T, D, D}; pg8::StaticOrder S; S.init(T, D, F.G, (int)blockIdx.x);
    EpiResid E{WSP(bf16, WS_XB), WSP(bf16, WS_Y1), DN_ALPHA};
    pg8::gemm_phase<EpiResid, pg8::StaticOrder, PG8_ALIGN, PG8_SP2>(F.lds, g, S, E);
}
NI void ph_gemm_moe1(unsigned char* ws, LAS unsigned char* lds, int l_, const float* bgu) {
    Frame F = make_frame(ws, lds); const int l = __builtin_amdgcn_readfirstlane(l_);
    const int nun = moe_table(F, l, 8);
    pg8::Gemm g{WSP(bf16, WS_XB8), (const bf16*)(WSP(unsigned char, WS_WGU) + (size_t)l * NE * 2048 * D * 2), MAXROWS, NE * 2048, D};
    MoeSched S{(const LAS int*)(F.lds + TAB_OFF), nun};
    EpiSwiglu E{WSP(unsigned char, WS_ACT), uni(bgu) + (size_t)l * NE * 2048};
    pg8::gemm_phase<EpiSwiglu, MoeSched, PG8_ALIGN, true, 1, true>(F.lds, g, S, E, WSP(int, WS_XS));
}
NI void ph_gemm_moe2(unsigned char* ws, LAS unsigned char* lds, int l_, const float* bdn) {
    Frame F = make_frame(ws, lds); const int l = __builtin_amdgcn_readfirstlane(l_);
    const int nun = moe_table(F, l, 4);
    pg8::Gemm g{WSP(bf16, WS_ACT), (const bf16*)(WSP(unsigned char, WS_WDN) + (size_t)l * NE * D * D * 2), MAXROWS, NE * D, D};
    MoeSched S{(const LAS int*)(F.lds + TAB_OFF), nun};
    EpiDown E{WSP(unsigned char, WS_YS), uni(bdn) + (size_t)l * NE * D};
    pg8::gemm_phase<EpiDown, MoeSched, PG8_ALIGN, MOE_SP2, 1>(F.lds, g, S, E);
}

__device__ __forceinline__ const float* karg_in(int i) { return ((const float* const volatile*)__builtin_amdgcn_kernarg_segment_ptr())[i]; }
__device__ __forceinline__ float* karg_out() { return ((float* const volatile*)__builtin_amdgcn_kernarg_segment_ptr())[N_IN]; }
#ifndef PHMASK
#define PHMASK 0x7FF
#endif
constexpr int PH_PER_LAYER = 10, N_PHASES = 1 + DEPTH * PH_PER_LAYER;
#define IN(k) (lo <= (k) && (k) < hi)
#define SEAM(k) do { if (IN(k) && IN((k) + 1)) xcd_barrier(bar); } while (0)
template <int l> __device__ __forceinline__ void layer_phases(Frame& F, const XcdBarrier& bar, int lo, int hi) {
        const int p0 = 1 + l * PH_PER_LAYER;
        const float* xin = nullptr;
        float* xout = l == DEPTH - 1 ? karg_out() : nullptr;
        if (((PHMASK >> 0) & 1) && IN(p0 + 0)) { asm volatile("; PHASE_BEGIN_0"); ph_gemm_in(F.ws, F.lds, l); SEAM(p0 + 0); }
        if (((PHMASK >> 1) & 1) && IN(p0 + 1)) { asm volatile("; PHASE_BEGIN_1"); ph_local(F.ws, F.lds, l, karg_in(IN_WPOOL), karg_in(IN_CONVW), karg_in(IN_PSCALE), karg_in(IN_KNG), karg_in(IN_KNB)); SEAM(p0 + 1); }
        if (((PHMASK >> 2) & 1) && IN(p0 + 2)) { asm volatile("; PHASE_BEGIN_2"); ph_scores(F.ws, F.lds); SEAM(p0 + 2); }
        if (((PHMASK >> 3) & 1) && IN(p0 + 3)) { asm volatile("; PHASE_BEGIN_3"); ph_attn(F.ws, F.lds, l, karg_in(IN_WGU), karg_in(IN_WDN)); SEAM(p0 + 3); }
        if (((PHMASK >> 4) & 1) && IN(p0 + 4)) { asm volatile("; PHASE_BEGIN_4"); ph_gemm_out(F.ws, F.lds, l, xin); SEAM(p0 + 4); }
        if (((PHMASK >> 5) & 1) && IN(p0 + 5)) { asm volatile("; PHASE_BEGIN_5"); ph_router(F.ws, F.lds, l, karg_in(IN_LN1G), karg_in(IN_LN1B), karg_in(IN_RW), karg_in(IN_RB)); SEAM(p0 + 5); }
        if (((PHMASK >> 6) & 1) && IN(p0 + 6)) { asm volatile("; PHASE_BEGIN_6"); ph_gather(F.ws, F.lds, l); SEAM(p0 + 6); }
        if (((PHMASK >> 7) & 1) && IN(p0 + 7)) { asm volatile("; PHASE_BEGIN_7"); ph_gemm_moe1(F.ws, F.lds, l, karg_in(IN_BGU)); SEAM(p0 + 7); }
        if (((PHMASK >> 8) & 1) && IN(p0 + 8)) { asm volatile("; PHASE_BEGIN_8"); ph_gemm_moe2(F.ws, F.lds, l, karg_in(IN_BDN)); SEAM(p0 + 8); }
        if (((PHMASK >> 9) & 1) && IN(p0 + 9)) { asm volatile("; PHASE_BEGIN_9"); ph_combine(F.ws, F.lds, l, karg_in(IN_LN2G), karg_in(IN_LN2B), xout); SEAM(p0 + 9); }
}
#undef IN
#undef SEAM
__global__ void __launch_bounds__(NWAVES * 64, 2) fwd_kernel(Args A) {
    extern __shared__ __attribute__((aligned(16))) unsigned char lds[];
    Frame F;
    F.lds = (LAS unsigned char*)lds;
    F.tid = threadIdx.x; F.lane = F.tid & 63; F.wave = __builtin_amdgcn_readfirstlane(F.tid >> 6);
    F.G = gridDim.x; { const int bx = blockIdx.x; F.vcu = (F.G % 8 == 0) ? (bx % 8) * (F.G / 8) + bx / 8 : bx; }
    F.ws = A.ws; F.ctl = (gu32*)(A.ws + WS_CTL);
    volatile LAS unsigned* MISC = (volatile LAS unsigned*)(F.lds + MISC_OFF);
    if (F.tid < 32) MISC[F.tid] = 0u;
    __syncthreads();
    const int lo = A.ph_lo, hi = A.ph_hi;
    const bool multi = (hi - lo) > 1;
    XcdBarrier bar; bar.bar = (unsigned*)(F.ctl + CW_BAR); bar.x = 0; bar.st = nullptr;
    if (multi) bar = xcd_barrier_post((unsigned*)(F.ctl + CW_BAR), MISC + 8);
#define IN(k) (lo <= (k) && (k) < hi)
#define SEAM(k) do { if (IN(k) && IN((k) + 1)) xcd_barrier(bar); } while (0)

    if (((PHMASK >> 10) & 1) && IN(0)) { asm volatile("; PHASE_BEGIN_11"); ph_prologue(F.ws, F.lds, karg_in(IN_WIN), karg_in(IN_WOUT), karg_in(IN_WGU), karg_in(IN_WDN), karg_in(IN_X)); SEAM(0); }
    layer_phases<0>(F, bar, lo, hi);
    layer_phases<1>(F, bar, lo, hi);
#undef IN
#undef SEAM
}


#ifdef DUMP_OFF
__global__ void dump_kernel(const unsigned* w, size_t nwords, float* out, int n) {
    const int i = blockIdx.x * blockDim.x + threadIdx.x; if (i >= n) return;
#ifdef DUMP_NAN_ALL
    { bool bad = false; for (size_t j = (size_t)i; j < nwords; j += (size_t)n) { const unsigned x = w[j]; bad |= ((x & 0x7f80u) == 0x7f80u) || ((x & 0x7f800000u) == 0x7f800000u); } out[i] = bad ? 1e6f : 0.f; return; }
#endif
#ifdef DUMP_MASKCHECK
    { out[i] = 0.f; if ((i & 1023) == 0) { const int t = i >> 10, sq = t & 4095; const unsigned long long* mt = (const unsigned long long*)w + ((size_t)(t >> 12) * 64) * 4096 + sq; int pc = 0; bool beyond = false;
        for (int j = 0; j < 64; ++j) { const unsigned long long m = mt[(size_t)j * 4096]; pc += __popcll(m); for (int bb = 0; bb < 64; ++bb) if (((m >> bb) & 1ull) && 64 * j + bb > sq) beyond = true; }
        const int expect = sq + 1 < 256 ? sq + 1 : 256;
#if DUMP_MASKCHECK == 1
        if (pc != expect) out[i] = 1e6f;
#else
        if (beyond) out[i] = 1e6f;
#endif
      } return; }
#endif
#ifdef DUMP_NANCHECK
#if DUMP_NANCHECK == 2
    { size_t wi = (size_t)i;
#ifdef DUMP_ROWW
      wi = ((size_t)i / DUMP_COLW) * DUMP_ROWW + ((size_t)i % DUMP_COLW);
#endif
      if (wi >= nwords) { out[i] = 0.f; return; } const unsigned x = w[wi]; const bool bad = ((x & 0x7f80u) == 0x7f80u) || ((x & 0x7f800000u) == 0x7f800000u);
#ifdef DUMP_LOC
      { const int sq = (int)(wi / 512) & 4095; out[i] = bad ? 1000.f * (float)(DUMP_LOC == 1 ? sq + 1 : 4096 - sq) : 0.f; return; }
#endif
      out[i] = bad ? 1e6f : 0.f; return; }
#else
    { const float v = ((const float*)w)[i]; out[i] = (v == v && fabsf(v) < 1e30f) ? 0.f : 1e6f; return; }
#endif
#endif
#ifdef DUMP_VIA_ROWOF
    unsigned h; { const unsigned short* src = (const unsigned short*)w; const int* rowof = (const int*)((const char*)w - (size_t)(DUMP_OFF) + WS_ROUTE) + 12 * T; const int t = i >> 10, c = i & 1023;
        h = 0u; for (int k = 0; k < 4; ++k) h = h * 0x9E3779B1u + src[(size_t)rowof[4 * t + k] * 1024 + c]; }
#elif defined(DUMP_ROWW)
    unsigned h = 0u; { const size_t row = (size_t)i / DUMP_COLW, cw = (size_t)i % DUMP_COLW; if (row * DUMP_ROWW + cw < nwords) h = w[row * DUMP_ROWW + cw]; }
#else
    unsigned h = 0u; int k = 1; for (size_t j = (size_t)i; j < nwords; j += (size_t)n, k += 2) h ^= w[j] * (unsigned)k;
#endif
    out[i] = (float)((h ^ (h >> 11) ^ (h >> 22)) & 0xFFFFFu);
}
#endif
#ifndef MK_ONE_LAUNCH
#define MK_ONE_LAUNCH 0
#endif
extern "C" void kernel_launch(void* const* d_in, const int* in_sizes, int n_in, void* d_out, int out_size, void* d_ws, size_t ws_size, hipStream_t stream) {
    static int grid = 0;
    if (grid == 0) {
        if (n_in != N_IN || in_sizes[0] != T * D || out_size != T * D || ws_size < WS_END) { fprintf(stderr, "kernel_launch: unexpected shapes (n_in %d, in0 %d, out %d, ws %zu, need %zu); nothing launched\n", n_in, n_in > 0 ? in_sizes[0] : -1, out_size, ws_size, (size_t)WS_END); grid = -1; return; }
        int dev = 0, cus = 0, per_cu = 0;
        if (hipGetDevice(&dev) != hipSuccess || hipDeviceGetAttribute(&cus, hipDeviceAttributeMultiprocessorCount, dev) != hipSuccess) { grid = -1; return; }
        if (hipFuncSetAttribute((const void*)fwd_kernel, hipFuncAttributeMaxDynamicSharedMemorySize, LDS_BYTES) != hipSuccess) { fprintf(stderr, "kernel_launch: hipFuncSetAttribute failed\n"); grid = -1; return; }
        if (hipOccupancyMaxActiveBlocksPerMultiprocessor(&per_cu, (const void*)fwd_kernel, NWAVES * 64, LDS_BYTES) != hipSuccess || per_cu < 1) fprintf(stderr, "kernel_launch: occupancy query reports %d\n", per_cu);
        (void)hipGetLastError();
        grid = cus;
        if (grid != 256) { fprintf(stderr, "kernel_launch: built for 256 CUs, found %d; nothing launched\n", cus); grid = -1; return; }
    }
    if (grid < 0) return;
    if (hipMemsetAsync((char*)d_ws + WS_CTL, 0, CTL_ZERO_BYTES, stream) != hipSuccess) return;
    Args a{};
    for (int i = 0; i < N_IN; ++i) a.in[i] = (const float*)d_in[i];
    a.out = (float*)d_out; a.ws = (unsigned char*)d_ws;
#if MK_ONE_LAUNCH
    a.ph_lo = 0; a.ph_hi = N_PHASES;
    hipLaunchKernelGGL(fwd_kernel, dim3(grid), dim3(NWAVES * 64), LDS_BYTES, stream, a);
#else
#ifdef DUMP_OFF
    for (int p = 0; p < DUMP_STOP; ++p) { a.ph_lo = p; a.ph_hi = p + 1; hipLaunchKernelGGL(fwd_kernel, dim3(grid), dim3(NWAVES * 64), LDS_BYTES, stream, a); }
    hipLaunchKernelGGL(dump_kernel, dim3((T * D + 255) / 256), dim3(256), 0, stream, (const unsigned*)((const char*)d_ws + (size_t)(DUMP_OFF)), (size_t)(DUMP_WORDS), (float*)d_out, T * D);
    return;
#endif
    for (int p = 0; p < N_PHASES; ++p) { a.ph_lo = p; a.ph_hi = p + 1; hipLaunchKernelGGL(fwd_kernel, dim3(grid), dim3(NWAVES * 64), LDS_BYTES, stream, a);
#ifdef DBL_PHASE
        if ((p == 0 && DBL_PHASE == 10) || (p > 0 && (p - 1) % PH_PER_LAYER == DBL_PHASE)) hipLaunchKernelGGL(fwd_kernel, dim3(grid), dim3(NWAVES * 64), LDS_BYTES, stream, a);
#endif
    }
#endif
}
```
